# Optimizing an MI355X kernel written in HIP

```python
import math
import jax
import jax.numpy as jnp
from jax import lax
import numpy as np

D_MODEL = 1024
BATCH = 8
SEQ = 4096
DEPTH = 2

GRID_W = 64
CTX_LEN = 256
N_MIXERS = 2
N_MAMBA = (DEPTH + 1) // 2
N_HYENA = DEPTH // 2
DEEPNORM_ALPHA = (2 * DEPTH) ** 0.25
DEEPNORM_BETA = (8 * DEPTH) ** -0.25
LN_EPS = 1e-5
RMS_EPS = 1e-5

SSM_INNER = 2 * D_MODEL
SSM_HEAD_DIM = 64
SSM_HEADS = SSM_INNER // SSM_HEAD_DIM
SSM_GROUPS = 4
SSM_STATE = 128
SSM_CHUNK = 128
SSM_CONV = 3
SSM_CONV_DIM = SSM_INNER + 2 * SSM_GROUPS * SSM_STATE
SSM_IN_DIM = SSM_INNER + SSM_CONV_DIM + 2 * SSM_HEADS

HYENA_ORDER = 2
HYENA_SHORT = 3
HYENA_EMB = 33
HYENA_FF = 64
HYENA_INNER_MLPS = 2
HYENA_STEEP_DECAY = 0.3
HYENA_GENTLE_DECAY = 1.5
HYENA_TARGET = 1e-2
HYENA_NORM_EPS = 1e-6

PEER_HEADS = 8
PEER_NKEYS = 128
PEER_EXPERTS = PEER_NKEYS * PEER_NKEYS
PEER_DK = 256
PEER_TOPK = 16
PEER_BLOCK = 128

kernel_name = 'hybrid_ssd_hyena_peer_dit'


def layer_norm(x, g, b):
    xf = x.astype(jnp.float32)
    mu = jnp.mean(xf, axis=-1, keepdims=True)
    var = jnp.mean(jnp.square(xf - mu), axis=-1, keepdims=True)
    return ((xf - mu) * lax.rsqrt(var + LN_EPS) * g.astype(jnp.float32) + b.astype(jnp.float32)).astype(x.dtype)


def gated_group_rmsnorm(y, z, w):
    b, L, _ = y.shape
    u = (y * jax.nn.silu(z)).astype(jnp.float32).reshape(b, L, SSM_GROUPS, -1)
    u = u * lax.rsqrt(jnp.mean(jnp.square(u), axis=-1, keepdims=True) + RMS_EPS)
    return (u.reshape(b, L, SSM_INNER) * w.astype(jnp.float32)).astype(y.dtype)


def depthwise_conv_grid(u, w, bias, rows, cols):
    b, L, C = u.shape
    out = lax.conv_general_dilated(u.reshape(b, rows, cols, C), w.astype(u.dtype)[:, :, None, :],
                                   window_strides=(1, 1), padding='SAME',
                                   dimension_numbers=('NHWC', 'HWIO', 'NHWC'), feature_group_count=C)
    return out.reshape(b, L, C) + bias


def ssd_scan(xs, dt, a_neg, bm, cm, init, want_y):
    f32 = jnp.float32
    b, L, H, P = xs.shape
    G, N = bm.shape[2], bm.shape[3]
    R = H // G
    Q = SSM_CHUNK
    nc = L // Q
    xdt = (xs.astype(f32) * dt[..., None]).reshape(b, nc, Q, G, R, P)
    bc = bm.astype(f32).reshape(b, nc, Q, G, N)
    cc = cm.astype(f32).reshape(b, nc, Q, G, N)
    a = (dt * a_neg.astype(f32)).reshape(b, nc, Q, G, R)
    a_cum = jnp.cumsum(a, axis=2)
    decay_to_end = jnp.exp(a_cum[:, :, -1:] - a_cum)
    chunk_states = jnp.einsum('bclgn,bclgrp->bcgrpn', bc, xdt * decay_to_end[..., None])
    chunk_decay = jnp.exp(a_cum[:, :, -1])

    def step(state, inp):
        cs, cd = inp
        return state * cd[..., None, None] + cs, state

    final, prev = lax.scan(step, init.astype(f32).reshape(b, G, R, P, N),
                           (jnp.moveaxis(chunk_states, 1, 0), jnp.moveaxis(chunk_decay, 1, 0)))
    final = final.reshape(b, H, P, N)
    if not want_y:
        return None, final
    prev = jnp.moveaxis(prev, 0, 1)
    seg = a_cum[:, :, :, None] - a_cum[:, :, None, :]
    lower = jnp.tril(jnp.ones((Q, Q), dtype=bool))[None, None, :, :, None, None]
    decay_ls = jnp.exp(jnp.where(lower, seg, -jnp.inf))
    cb = jnp.einsum('bclgn,bcsgn->bclsg', cc, bc)
    y_diag = jnp.einsum('bclsgr,bcsgrp->bclgrp', cb[..., None] * decay_ls, xdt)
    y_off = jnp.einsum('bclgn,bcgrpn->bclgrp', cc, prev) * jnp.exp(a_cum)[..., None]
    y = (y_diag + y_off).reshape(b, L, H, P)
    return y.astype(xs.dtype), final


def mamba2_mixer(h_lat, h_ctx, rows, w_in, conv_w, conv_b, a_log, dt_bias, d_skip, norm_w, w_out, ctx_out):
    f32 = jnp.float32
    a_neg = -jnp.exp(a_log.astype(f32))
    G, N = SSM_GROUPS, SSM_STATE

    def branch(h, rows_, cols_, need_z):
        bb, LL, _ = h.shape
        proj = h @ (w_in if need_z else w_in[:, SSM_INNER:])
        z = None
        if need_z:
            z, proj = proj[..., :SSM_INNER], proj[..., SSM_INNER:]
        xbc = jax.nn.silu(depthwise_conv_grid(proj[..., :SSM_CONV_DIM], conv_w, conv_b, rows_, cols_))
        dt = jax.nn.softplus(proj[..., SSM_CONV_DIM:].astype(f32).reshape(bb, LL, 2, SSM_HEADS)
                             + dt_bias.astype(f32))
        xs = xbc[..., :SSM_INNER].reshape(bb, LL, SSM_HEADS, SSM_HEAD_DIM)
        bm = xbc[..., SSM_INNER:SSM_INNER + G * N].reshape(bb, LL, G, N)
        cm = xbc[..., SSM_INNER + G * N:].reshape(bb, LL, G, N)
        return z, xs, bm, cm, dt

    def scans(xs, bm, cm, dt, init_f, init_b, want_y):
        y_f, s_f = ssd_scan(xs, dt[:, :, 0], a_neg[0], bm, cm, init_f, want_y)
        y_b, s_b = ssd_scan(jnp.flip(xs, 1), jnp.flip(dt[:, :, 1], 1), a_neg[1],
                            jnp.flip(bm, 1), jnp.flip(cm, 1), init_b, want_y)
        y = None
        if want_y:
            y = y_f + jnp.flip(y_b, 1) + xs * d_skip[:, None]
        return y, s_f, s_b

    def finish(y, z):
        bb, LL = y.shape[:2]
        return gated_group_rmsnorm(y.reshape(bb, LL, SSM_INNER), z, norm_w) @ w_out

    bsz = h_ctx.shape[0]
    zeros = jnp.zeros((bsz, SSM_HEADS, SSM_HEAD_DIM, SSM_STATE), f32)
    zc, xc, bmc, cmc, dtc = branch(h_ctx, 1, h_ctx.shape[1], ctx_out)
    yc, s_f, s_b = scans(xc, bmc, cmc, dtc, zeros, zeros, ctx_out)
    zl, xl, bml, cml, dtl = branch(h_lat, rows, GRID_W, True)
    yl, _, _ = scans(xl, bml, cml, dtl, s_f, s_b, True)
    out_ctx = finish(yc, zc) if ctx_out else None
    return finish(yl, zl), out_ctx


def hyena_filters(L, w1, b1, w2, b2, w3, freq):
    f32 = jnp.float32
    t = jnp.linspace(0.0, 1.0, L, dtype=f32)[:, None]
    bands = (HYENA_EMB - 1) // 2
    ang = 2.0 * math.pi * jnp.arange(L, dtype=f32)[:, None] / L
    fb = jnp.linspace(1e-4, bands - 1, bands, dtype=f32)[None, :]
    z = jnp.concatenate([t, jnp.cos(fb * ang), -jnp.sin(fb * ang)], axis=-1)
    fr = freq.astype(f32)
    hid = jnp.sin(fr * (z @ w1.astype(f32) + b1.astype(f32)))
    for j in range(HYENA_INNER_MLPS):
        hid = jnp.sin(fr * (hid @ w2[j].astype(f32) + b2[j].astype(f32)))
    h = (hid @ w3.astype(f32)).reshape(L, HYENA_ORDER, 2, D_MODEL)
    max_decay = math.log(HYENA_TARGET) / HYENA_STEEP_DECAY
    min_decay = math.log(HYENA_TARGET) / HYENA_GENTLE_DECAY
    deltas = jnp.linspace(min_decay, max_decay, D_MODEL, dtype=f32)
    h = h * jnp.exp(-t * jnp.abs(deltas))[:, None, None, :]
    h_fwd, h_bwd = h[:, :, 0], h[:, :, 1]
    two_sided = jnp.concatenate([h_fwd[:1] + h_bwd[:1], h_fwd[1:],
                                 jnp.zeros((1, HYENA_ORDER, D_MODEL), f32),
                                 jnp.flip(h_bwd[1:], 0)], axis=0)
    two_sided = two_sided * lax.rsqrt(jnp.sum(jnp.square(two_sided), axis=0, keepdims=True) + HYENA_NORM_EPS)
    return jnp.fft.rfft(two_sided, n=2 * L, axis=0)


def fft_long_conv(u, hf, bias):
    L = u.shape[1]
    uf = u.astype(jnp.float32)
    y = jnp.fft.irfft(jnp.fft.rfft(uf, n=2 * L, axis=1) * hf[None], n=2 * L, axis=1)[:, :L]
    return (y + uf * bias.astype(jnp.float32)).astype(u.dtype)


def short_conv_centred(u, w, bias):
    up = jnp.pad(u, ((0, 0), (1, 1), (0, 0)))
    return up[:, :-2] * w[0] + up[:, 1:-1] * w[1] + up[:, 2:] * w[2] + bias


def hyena_mixer(h, w_in, conv_w, conv_b, w1, b1, w2, b2, w3, freq, fbias, w_out):
    L = h.shape[1]
    hf = hyena_filters(L, w1, b1, w2, b2, w3, freq)
    u = short_conv_centred(h @ w_in, conv_w, conv_b)
    x1, x2, v = jnp.split(u, 3, axis=-1)
    zz = x1 * fft_long_conv(v, hf[:, 0], fbias[0])
    zz = x2 * fft_long_conv(zz, hf[:, 1], fbias[1])
    return zz @ w_out


def peer_ffn(h, wq, k1, k2, u_tab, v_tab):
    f32 = jnp.float32
    shp = h.shape
    t = h.reshape(-1, D_MODEL)
    T = t.shape[0]
    half = PEER_DK // 2
    q = (t @ wq).astype(f32).reshape(T, PEER_HEADS, PEER_DK)
    s1 = jnp.einsum('thd,hkd->thk', q[..., :half], k1.astype(f32))
    s2 = jnp.einsum('thd,hkd->thk', q[..., half:], k2.astype(f32))
    v1, i1 = lax.top_k(s1, PEER_TOPK)
    v2, i2 = lax.top_k(s2, PEER_TOPK)
    cand_s = (v1[..., :, None] + v2[..., None, :]).reshape(T, PEER_HEADS, PEER_TOPK * PEER_TOPK)
    cand_i = (i1[..., :, None] * PEER_NKEYS + i2[..., None, :]).reshape(T, PEER_HEADS, PEER_TOPK * PEER_TOPK)
    top_s, pos = lax.top_k(cand_s, PEER_TOPK)
    idx = jnp.take_along_axis(cand_i, pos, axis=-1)
    gate = jax.nn.softmax(top_s, axis=-1)
    nb = T // PEER_BLOCK

    def block(args):
        tb, ib, gb = args
        act = jax.nn.gelu(jnp.einsum('td,thkd->thk', tb, u_tab[ib]).astype(f32), approximate=False)
        return jnp.einsum('thk,thkd->td', (gb * act).astype(tb.dtype), v_tab[ib])

    out = lax.map(block, (t.reshape(nb, PEER_BLOCK, D_MODEL),
                          idx.reshape(nb, PEER_BLOCK, PEER_HEADS, PEER_TOPK),
                          gate.reshape(nb, PEER_BLOCK, PEER_HEADS, PEER_TOPK)))
    return out.reshape(shp)


def setup_inputs(seed: int = 0) -> dict:
    key = jax.random.key(seed)
    ks = iter(jax.random.split(key, 48))
    f32 = jnp.float32
    D = D_MODEL

    def nrm(shape, scale):
        return jax.random.normal(next(ks), shape, f32) * scale

    dt0 = jnp.exp(jax.random.uniform(next(ks), (N_MAMBA, 2, SSM_HEADS), f32, math.log(1e-3), math.log(1e-1)))
    a0 = jax.random.uniform(next(ks), (N_MAMBA, 2, SSM_HEADS), f32, 1.0, 16.0)
    return {
        'x': nrm((BATCH, SEQ, D), 1.0),
        'c': nrm((BATCH, D), 1.0),
        'ctx': nrm((BATCH, CTX_LEN, D), 1.0),
        'c_ctx': nrm((D,), 1.0),
        'ada_w': nrm((DEPTH, D, 6 * D), 0.5 * D ** -0.5),
        'ada_b': nrm((DEPTH, 6 * D), 0.02),
        'ln_g': 1.0 + nrm((DEPTH, 2, D), 0.02),
        'ln_b': nrm((DEPTH, 2, D), 0.02),
        'm_w_in': nrm((N_MAMBA, D, SSM_IN_DIM), D ** -0.5),
        'm_conv_w': nrm((N_MAMBA, SSM_CONV, SSM_CONV, SSM_CONV_DIM), 1.0 / SSM_CONV),
        'm_conv_b': nrm((N_MAMBA, SSM_CONV_DIM), 0.02),
        'm_a_log': jnp.log(a0),
        'm_dt_bias': dt0 + jnp.log(-jnp.expm1(-dt0)),
        'm_d': 1.0 + nrm((N_MAMBA, SSM_HEADS), 0.02),
        'm_norm_w': 1.0 + nrm((N_MAMBA, SSM_INNER), 0.02),
        'm_w_out': nrm((N_MAMBA, SSM_INNER, D), DEEPNORM_BETA * SSM_INNER ** -0.5),
        'h_w_in': nrm((N_HYENA, D, 3 * D), D ** -0.5),
        'h_conv_w': nrm((N_HYENA, HYENA_SHORT, 3 * D), HYENA_SHORT ** -0.5),
        'h_conv_b': nrm((N_HYENA, 3 * D), 0.02),
        'h_f_w1': nrm((N_HYENA, HYENA_EMB, HYENA_FF), HYENA_EMB ** -0.5),
        'h_f_b1': nrm((N_HYENA, HYENA_FF), 0.1),
        'h_f_w2': nrm((N_HYENA, HYENA_INNER_MLPS, HYENA_FF, HYENA_FF), HYENA_FF ** -0.5),
        'h_f_b2': nrm((N_HYENA, HYENA_INNER_MLPS, HYENA_FF), 0.1),
        'h_f_w3': nrm((N_HYENA, HYENA_FF, HYENA_ORDER * 2 * D), HYENA_FF ** -0.5),
        'h_freq': 1.0 + nrm((N_HYENA, HYENA_FF), 0.05),
        'h_bias': nrm((N_HYENA, HYENA_ORDER, D), 0.2),
        'h_w_out': nrm((N_HYENA, D, D), DEEPNORM_BETA * D ** -0.5),
        'p_wq': nrm((DEPTH, D, PEER_HEADS * PEER_DK), D ** -0.5),
        'p_k1': nrm((DEPTH, PEER_HEADS, PEER_NKEYS, PEER_DK // 2), (PEER_DK // 2) ** -0.5),
        'p_k2': nrm((DEPTH, PEER_HEADS, PEER_NKEYS, PEER_DK // 2), (PEER_DK // 2) ** -0.5),
        'p_u': nrm((DEPTH, PEER_EXPERTS, D), D ** -0.5),
        'p_v': nrm((DEPTH, PEER_EXPERTS, D), DEEPNORM_BETA),
    }


def reference(x, c, ctx, c_ctx, ada_w, ada_b, ln_g, ln_b,
              m_w_in, m_conv_w, m_conv_b, m_a_log, m_dt_bias, m_d, m_norm_w, m_w_out,
              h_w_in, h_conv_w, h_conv_b, h_f_w1, h_f_b1, h_f_w2, h_f_b2, h_f_w3, h_freq, h_bias, h_w_out,
              p_wq, p_k1, p_k2, p_u, p_v):
    rows = x.shape[1] // GRID_W
    s_lat = jax.nn.silu(c)
    s_ctx = jax.nn.silu(c_ctx)
    for i in range(DEPTH):
        kind, k = i % N_MIXERS, i // N_MIXERS
        ctx_live = any(j % N_MIXERS == 0 for j in range(i + 1, DEPTH))
        ctx_read = (kind == 0) or ctx_live
        sh1, sc1, g1, sh2, sc2, g2 = jnp.split((s_lat @ ada_w[i] + ada_b[i])[:, None, :], 6, axis=-1)
        hx = x * (1 + sc1) + sh1
        if ctx_read:
            csh1, csc1, cg1, csh2, csc2, cg2 = jnp.split(s_ctx @ ada_w[i] + ada_b[i], 6, axis=-1)
            hc = ctx * (1 + csc1) + csh1
        if kind == 0:
            y_lat, y_ctx = mamba2_mixer(hx, hc, rows, m_w_in[k], m_conv_w[k], m_conv_b[k], m_a_log[k],
                                        m_dt_bias[k], m_d[k], m_norm_w[k], m_w_out[k], ctx_live)
        else:
            hyena_w = (h_w_in[k], h_conv_w[k], h_conv_b[k], h_f_w1[k], h_f_b1[k], h_f_w2[k], h_f_b2[k],
                       h_f_w3[k], h_freq[k], h_bias[k], h_w_out[k])
            y_lat = hyena_mixer(hx, *hyena_w)
            y_ctx = hyena_mixer(hc, *hyena_w) if ctx_live else None
        peer_w = (p_wq[i], p_k1[i], p_k2[i], p_u[i], p_v[i])
        x = layer_norm(DEEPNORM_ALPHA * x + g1 * y_lat, ln_g[i, 0], ln_b[i, 0])
        x = layer_norm(DEEPNORM_ALPHA * x + g2 * peer_ffn(x * (1 + sc2) + sh2, *peer_w), ln_g[i, 1], ln_b[i, 1])
        if ctx_live:
            ctx = layer_norm(DEEPNORM_ALPHA * ctx + cg1 * y_ctx, ln_g[i, 0], ln_b[i, 0])
            ctx = layer_norm(DEEPNORM_ALPHA * ctx + cg2 * peer_ffn(ctx * (1 + csc2) + csh2, *peer_w),
                             ln_g[i, 1], ln_b[i, 1])
    return x
```

```cpp
#define PROBE 0
#include <hip/hip_runtime.h>
#include <hip/hip_bf16.h>
#include <hip/hip_cooperative_groups.h>
#include <cstdio>
namespace cg = cooperative_groups;

typedef unsigned short u16;
using bf16x8 = __attribute__((ext_vector_type(8))) short;
using f32x4 = __attribute__((ext_vector_type(4))) float;
using u32x4 = __attribute__((ext_vector_type(4))) unsigned;

#define DEV __device__ __forceinline__

constexpr int NB = 8, SEQ = 4096, DM = 1024, NT = NB * SEQ;
constexpr int CTXL = 256, NTC = NB * CTXL;
constexpr int SSM_IN = 5184, CONVD = 3072, SSM_INNER = 2048;
constexpr float ALPHA = 1.41421356237f;
constexpr int LDS_BYTES = 71168;

constexpr size_t MiB = 1ull << 20;
constexpr size_t OFF_W_IN = 0;
constexpr size_t OFF_W_OUT = OFF_W_IN + (size_t)5184 * 1024 * 2;
constexpr size_t OFF_W_HIN = OFF_W_OUT + (size_t)1024 * 2048 * 2;
constexpr size_t OFF_W_HOUT = OFF_W_HIN + (size_t)3072 * 1024 * 2;
constexpr size_t OFF_W_Q = OFF_W_HOUT + (size_t)1024 * 1024 * 2;
constexpr size_t OFF_MOD = OFF_W_Q + (size_t)2 * 2048 * 1024 * 2;
constexpr size_t OFF_HID = OFF_MOD + 512 * 1024;
constexpr size_t OFF_DT = OFF_HID + MiB;
constexpr size_t OFF_HC = OFF_DT + 8 * MiB;
constexpr size_t OFF_XBC_C = OFF_HC + 4 * MiB;
constexpr size_t OFF_XC_C = OFF_XBC_C + 12 * MiB;
constexpr size_t OFF_DT_C = OFF_XC_C + 12 * MiB;
constexpr size_t OFF_R1 = OFF_DT_C + MiB;
constexpr size_t OFF_R2 = OFF_R1 + 192 * MiB;
constexpr size_t OFF_BAR = OFF_R2 + 192 * MiB;
constexpr size_t WS_TOTAL = OFF_BAR + 4096;

struct Params {
  const float *x, *c, *ctx, *c_ctx, *ada_w, *ada_b, *ln_g, *ln_b;
  const float *m_w_in, *m_conv_w, *m_conv_b, *m_a_log, *m_dt_bias, *m_d, *m_norm_w, *m_w_out;
  const float *h_w_in, *h_conv_w, *h_conv_b, *h_f_w1, *h_f_b1, *h_f_w2, *h_f_b2, *h_f_w3, *h_freq, *h_bias, *h_w_out;
  const float *p_wq, *p_k1, *p_k2, *p_u, *p_v;
  float* out;
  char* ws;
};

DEV u16 f2bf(float f) {
  unsigned u = __float_as_uint(f);
  u += 0x7fffu + ((u >> 16) & 1u);
  return (u16)(u >> 16);
}
DEV float bf2f(u16 h) { return __uint_as_float(((unsigned)h) << 16); }
DEV float bflo(unsigned w) { return __uint_as_float(w << 16); }
DEV float bfhi(unsigned w) { return __uint_as_float(w & 0xffff0000u); }
DEV unsigned pack2(float a, float b) { return (unsigned)f2bf(a) | ((unsigned)f2bf(b) << 16); }
DEV float wave_sum(float v) {
#pragma unroll
  for (int o = 32; o > 0; o >>= 1) v += __shfl_xor(v, o);
  return v;
}
DEV float siluf(float v) { return v / (1.f + __expf(-v)); }
DEV f32x4 mfma16(bf16x8 a, bf16x8 b, f32x4 c) { return __builtin_amdgcn_mfma_f32_16x16x32_bf16(a, b, c, 0, 0, 0); }
DEV bf16x8 ld8(const u16* p) { return *reinterpret_cast<const bf16x8*>(p); }

template <int I>
DEV const float* karg() {
  unsigned long long v;
  asm volatile("s_load_dwordx2 %0, %1, %2\n\ts_waitcnt lgkmcnt(0)" : "=s"(v) : "s"(__builtin_amdgcn_kernarg_segment_ptr()), "n"(I * 8));
  return (const float*)(const __attribute__((address_space(1))) float*)v;
}
DEV Params fetch_params() {
  Params q;
  q.x = karg<0>(); q.c = karg<1>(); q.ctx = karg<2>(); q.c_ctx = karg<3>(); q.ada_w = karg<4>(); q.ada_b = karg<5>(); q.ln_g = karg<6>(); q.ln_b = karg<7>();
  q.m_w_in = karg<8>(); q.m_conv_w = karg<9>(); q.m_conv_b = karg<10>(); q.m_a_log = karg<11>(); q.m_dt_bias = karg<12>(); q.m_d = karg<13>();
  q.m_norm_w = karg<14>(); q.m_w_out = karg<15>();
  q.h_w_in = karg<16>(); q.h_conv_w = karg<17>(); q.h_conv_b = karg<18>(); q.h_f_w1 = karg<19>(); q.h_f_b1 = karg<20>(); q.h_f_w2 = karg<21>();
  q.h_f_b2 = karg<22>(); q.h_f_w3 = karg<23>(); q.h_freq = karg<24>(); q.h_bias = karg<25>(); q.h_w_out = karg<26>();
  q.p_wq = karg<27>(); q.p_k1 = karg<28>(); q.p_k2 = karg<29>(); q.p_u = karg<30>(); q.p_v = karg<31>();
  q.out = (float*)karg<32>(); q.ws = (char*)karg<33>();
  return q;
}

__device__ __forceinline__ void transpose_w_tile(const float* src, int srcld, int K, int N, u16* dst, int item, char* lds) {
  float* tile = (float*)lds;
  int ntn = N / 64;
  int kt = item / ntn, nt = item % ntn;
  int tid = threadIdx.x;
#pragma unroll
  for (int i = 0; i < 4; ++i) {
    int r = (tid >> 4) + i * 16, c4 = (tid & 15) * 4;
    float4 v = *reinterpret_cast<const float4*>(src + (size_t)(kt * 64 + r) * srcld + nt * 64 + c4);
    tile[r * 65 + c4 + 0] = v.x; tile[r * 65 + c4 + 1] = v.y; tile[r * 65 + c4 + 2] = v.z; tile[r * 65 + c4 + 3] = v.w;
  }
  __syncthreads();
#pragma unroll
  for (int i = 0; i < 2; ++i) {
    int n = (tid >> 3) + i * 32, k8 = (tid & 7) * 8;
    uint4 o;
    o.x = pack2(tile[(k8 + 0) * 65 + n], tile[(k8 + 1) * 65 + n]);
    o.y = pack2(tile[(k8 + 2) * 65 + n], tile[(k8 + 3) * 65 + n]);
    o.z = pack2(tile[(k8 + 4) * 65 + n], tile[(k8 + 5) * 65 + n]);
    o.w = pack2(tile[(k8 + 6) * 65 + n], tile[(k8 + 7) * 65 + n]);
    *reinterpret_cast<uint4*>(dst + (size_t)(nt * 64 + n) * K + kt * 64 + k8) = o;
  }
  __syncthreads();
}

__device__ __forceinline__ void ada_item(const Params& p, int item, char* lds) {
  float* red = (float*)lds;
  int layer = item / 96, cg_ = item % 96;
  int tid = threadIdx.x, kq = tid >> 6, col = cg_ * 64 + (tid & 63);
  float acc[9];
#pragma unroll
  for (int r = 0; r < 9; ++r) acc[r] = 0.f;
  const float* w = p.ada_w + (size_t)layer * 1024 * 6144 + col;
#pragma unroll 4
  for (int k = kq * 256; k < kq * 256 + 256; ++k) {
    float wv = w[(size_t)k * 6144];
#pragma unroll
    for (int r = 0; r < 8; ++r) acc[r] += siluf(p.c[r * 1024 + k]) * wv;
    acc[8] += siluf(p.c_ctx[k]) * wv;
  }
#pragma unroll
  for (int r = 0; r < 9; ++r) red[(kq * 9 + r) * 64 + (tid & 63)] = acc[r];
  __syncthreads();
  if (tid < 64) {
    float* mod = (float*)(p.ws + OFF_MOD);
    float bias = p.ada_b[layer * 6144 + col];
#pragma unroll
    for (int r = 0; r < 9; ++r) {
      float s = red[(0 * 9 + r) * 64 + tid] + red[(1 * 9 + r) * 64 + tid] + red[(2 * 9 + r) * 64 + tid] + red[(3 * 9 + r) * 64 + tid];
      mod[((size_t)layer * 9 + r) * 6144 + col] = s + bias;
    }
  }
  __syncthreads();
}

__device__ __forceinline__ void hyena_mlp_item(const Params& p, int item, char* lds) {
  float* zb = (float*)lds;
  float* h1 = zb + 256;
  float* h2 = h1 + 256;
  int tid = threadIdx.x, ti = tid >> 6, j = tid & 63;
  int t = item * 4 + ti;
  const float L = 4096.f;
  if (j < 33) {
    float v;
    if (j == 0) v = (float)t / 4095.f;
    else {
      int k = (j - 1) & 15;
      float fb = 1e-4f + (float)k * ((15.f - 1e-4f) / 15.f);
      float ang = 6.283185307179586f * (float)t / L;
      float a = fb * ang;
      v = (j <= 16) ? cosf(a) : -sinf(a);
    }
    zb[ti * 64 + j] = v;
  }
  __syncthreads();
  float fr = p.h_freq[j];
  float s = p.h_f_b1[j];
#pragma unroll 3
  for (int i = 0; i < 33; ++i) s += zb[ti * 64 + i] * p.h_f_w1[i * 64 + j];
  h1[ti * 64 + j] = sinf(fr * s);
  __syncthreads();
  s = p.h_f_b2[j];
#pragma unroll 8
  for (int i = 0; i < 64; ++i) s += h1[ti * 64 + i] * p.h_f_w2[i * 64 + j];
  h2[ti * 64 + j] = sinf(fr * s);
  __syncthreads();
  s = p.h_f_b2[64 + j];
#pragma unroll 8
  for (int i = 0; i < 64; ++i) s += h2[ti * 64 + i] * p.h_f_w2[4096 + i * 64 + j];
  float* hid = (float*)(p.ws + OFF_HID);
  hid[t * 64 + j] = sinf(fr * s);
  __syncthreads();
}

__device__ __forceinline__ void phase_prologue(const Params& p, char* lds) {
  constexpr int T0 = 1296, T1 = T0 + 512, T2 = T1 + 768, T3 = T2 + 256, T4 = T3 + 512, T5 = T4 + 512, T6 = T5 + 192, T7 = T6 + 1024;
  for (int item = blockIdx.x; item < T7; item += gridDim.x) {
    if (item < T0) transpose_w_tile(p.m_w_in, SSM_IN, 1024, SSM_IN, (u16*)(p.ws + OFF_W_IN), item, lds);
    else if (item < T1) transpose_w_tile(p.m_w_out, 1024, 2048, 1024, (u16*)(p.ws + OFF_W_OUT), item - T0, lds);
    else if (item < T2) transpose_w_tile(p.h_w_in, 3072, 1024, 3072, (u16*)(p.ws + OFF_W_HIN), item - T1, lds);
    else if (item < T3) transpose_w_tile(p.h_w_out, 1024, 1024, 1024, (u16*)(p.ws + OFF_W_HOUT), item - T2, lds);
    else if (item < T4) transpose_w_tile(p.p_wq, 2048, 1024, 2048, (u16*)(p.ws + OFF_W_Q), item - T3, lds);
    else if (item < T5) transpose_w_tile(p.p_wq + (size_t)1024 * 2048, 2048, 1024, 2048, (u16*)(p.ws + OFF_W_Q) + (size_t)2048 * 1024, item - T4, lds);
    else if (item < T6) ada_item(p, item - T5, lds);
    else hyena_mlp_item(p, item - T6, lds);
  }
}

__device__ __forceinline__ void modulate_rows(const float* src, u16* dst, int nrows, int rows_per_batch, const float* modbase, int sh_off, int sc_off, bool ctxrow) {
  size_t total = (size_t)nrows * 128;
  for (size_t e = (size_t)blockIdx.x * 256 + threadIdx.x; e < total; e += (size_t)gridDim.x * 256) {
    int row = (int)(e >> 7), c8 = (int)(e & 127) * 8;
    int b = ctxrow ? 8 : row / rows_per_batch;
    const float* m = modbase + (size_t)b * 6144;
    float4 a0 = *reinterpret_cast<const float4*>(src + (size_t)row * 1024 + c8);
    float4 a1 = *reinterpret_cast<const float4*>(src + (size_t)row * 1024 + c8 + 4);
    float4 s0 = *reinterpret_cast<const float4*>(m + sc_off + c8);
    float4 s1 = *reinterpret_cast<const float4*>(m + sc_off + c8 + 4);
    float4 h0 = *reinterpret_cast<const float4*>(m + sh_off + c8);
    float4 h1 = *reinterpret_cast<const float4*>(m + sh_off + c8 + 4);
    uint4 o;
    o.x = pack2(a0.x * (1.f + s0.x) + h0.x, a0.y * (1.f + s0.y) + h0.y);
    o.y = pack2(a0.z * (1.f + s0.z) + h0.z, a0.w * (1.f + s0.w) + h0.w);
    o.z = pack2(a1.x * (1.f + s1.x) + h1.x, a1.y * (1.f + s1.y) + h1.y);
    o.w = pack2(a1.z * (1.f + s1.z) + h1.z, a1.w * (1.f + s1.w) + h1.w);
    *reinterpret_cast<uint4*>(dst + (size_t)row * 1024 + c8) = o;
  }
}

constexpr int GLD = 72;
template <class Epi>
__device__ __forceinline__ void gemm_tile(const u16* __restrict__ A, int lda, const u16* __restrict__ Bt, int ldb, int brow, int bcol, int Nmax,
                                          int K, char* lds, Epi epi) {
  u16* SA = (u16*)lds;
  u16* SB = SA + 128 * GLD;
  int tid = threadIdx.x, wid = tid >> 6, lane = tid & 63, wr = wid >> 1, wc = wid & 1, fr = lane & 15, fq = lane >> 4;
  f32x4 acc[4][4];
#pragma unroll
  for (int m = 0; m < 4; ++m)
#pragma unroll
    for (int n = 0; n < 4; ++n) acc[m][n] = f32x4{0.f, 0.f, 0.f, 0.f};
  u32x4 ra[4], rb[4];
  const int lr = tid >> 3, lc = (tid & 7) * 8;
  const u16* abase = A + (size_t)(brow + lr) * lda + lc;
  size_t bo[4];
#pragma unroll
  for (int i = 0; i < 4; ++i) {
    int br = bcol + lr + i * 32;
    if (br >= Nmax) br = Nmax - 1;
    bo[i] = (size_t)br * ldb + lc;
  }
#pragma unroll
  for (int i = 0; i < 4; ++i) {
    ra[i] = *reinterpret_cast<const u32x4*>(abase + (size_t)(i * 32) * lda);
    rb[i] = *reinterpret_cast<const u32x4*>(Bt + bo[i]);
  }
  int nk = K / 64;
  for (int kt = 0; kt < nk; ++kt) {
#pragma unroll
    for (int i = 0; i < 4; ++i) {
      int q = tid + i * 256, r = q >> 3, c = (q & 7) * 8;
      *reinterpret_cast<u32x4*>(SA + r * GLD + c) = ra[i];
      *reinterpret_cast<u32x4*>(SB + r * GLD + c) = rb[i];
    }
    __syncthreads();
    if (kt + 1 < nk) {
#pragma unroll
      for (int i = 0; i < 4; ++i) {
        ra[i] = *reinterpret_cast<const u32x4*>(abase + (size_t)(i * 32) * lda + (kt + 1) * 64);
        rb[i] = *reinterpret_cast<const u32x4*>(Bt + bo[i] + (kt + 1) * 64);
      }
    }
#pragma unroll
    for (int kk = 0; kk < 2; ++kk) {
      bf16x8 At[4], Bl[4];
#pragma unroll
      for (int m = 0; m < 4; ++m) At[m] = ld8(SA + (wr * 64 + m * 16 + fr) * GLD + kk * 32 + fq * 8);
#pragma unroll
      for (int n = 0; n < 4; ++n) Bl[n] = ld8(SB + (wc * 64 + n * 16 + fr) * GLD + kk * 32 + fq * 8);
#pragma unroll
      for (int m = 0; m < 4; ++m)
#pragma unroll
        for (int n = 0; n < 4; ++n) acc[m][n] = mfma16(At[m], Bl[n], acc[m][n]);
    }
    __syncthreads();
  }
#pragma unroll
  for (int m = 0; m < 4; ++m)
#pragma unroll
    for (int n = 0; n < 4; ++n)
#pragma unroll
      for (int j = 0; j < 4; ++j) epi(brow + wr * 64 + m * 16 + fq * 4 + j, bcol + wc * 64 + n * 16 + fr, acc[m][n][j]);
}

DEV float softplusf(float v) { return fmaxf(v, 0.f) + log1pf(__expf(-fabsf(v))); }

__device__ __forceinline__ void phase_gemm_inproj(const Params& p, char* lds) {
  const u16* hx = (const u16*)(p.ws + OFF_R2);
  const u16* hc = (const u16*)(p.ws + OFF_HC);
  const u16* Wt = (const u16*)(p.ws + OFF_W_IN);
  u16* zbuf = (u16*)p.out;
  u16* xbc = (u16*)(p.ws + OFF_R1);
  float* dt = (float*)(p.ws + OFF_DT);
  u16* xbc_c = (u16*)(p.ws + OFF_XBC_C);
  float* dt_c = (float*)(p.ws + OFF_DT_C);
  const float* dtb = p.m_dt_bias;
  constexpr int NL = 256 * 41, NC = 16 * 25;
  for (int item = blockIdx.x; item < NL + NC; item += gridDim.x) {
    if (item < NL) {
      int pm = item / 41, pn = item % 41;
      gemm_tile(hx, 1024, Wt, 1024, pm * 128, pn * 128, SSM_IN, 1024, lds, [=](int m, int n, float v) {
        if (n < 2048) zbuf[(size_t)m * 2048 + n] = f2bf(v);
        else if (n < 5120) xbc[(size_t)m * 3072 + (n - 2048)] = f2bf(v);
        else if (n < 5184) dt[(size_t)m * 64 + (n - 5120)] = softplusf(v + dtb[n - 5120]);
      });
    } else {
      int it = item - NL;
      int pm = it / 25, pn = it % 25;
      gemm_tile(hc, 1024, Wt + (size_t)2048 * 1024, 1024, pm * 128, pn * 128, 3136, 1024, lds, [=](int m, int n, float v) {
        if (n < 3072) xbc_c[(size_t)m * 3072 + n] = f2bf(v);
        else if (n < 3136) dt_c[(size_t)m * 64 + (n - 3072)] = softplusf(v + dtb[n - 3072]);
      });
    }
  }
}

__device__ __forceinline__ void phase_conv(const Params& p) {
  const u16* xbc = (const u16*)(p.ws + OFF_R1);
  u16* xc = (u16*)(p.ws + OFF_R2);
  const u16* xbc_c = (const u16*)(p.ws + OFF_XBC_C);
  u16* xc_c = (u16*)(p.ws + OFF_XC_C);
  const float* cw = p.m_conv_w;
  const float* cb = p.m_conv_b;
  size_t nl = (size_t)NT * 384, ncx = (size_t)NTC * 384;
  for (size_t e = (size_t)blockIdx.x * 256 + threadIdx.x; e < nl + ncx; e += (size_t)gridDim.x * 256) {
    bool isc = e >= nl;
    size_t ee = isc ? e - nl : e;
    int tok = (int)(ee / 384), ch = (int)(ee % 384) * 8;
    float acc[8];
#pragma unroll
    for (int k = 0; k < 8; ++k) acc[k] = cb[ch + k];
    if (!isc) {
      int b = tok >> 12, l = tok & 4095, r = l >> 6, c = l & 63;
#pragma unroll
      for (int i = 0; i < 3; ++i) {
        int rr = r + i - 1;
        if (rr < 0 || rr > 63) continue;
#pragma unroll
        for (int j = 0; j < 3; ++j) {
          int cc = c + j - 1;
          if (cc < 0 || cc > 63) continue;
          uint4 v = *reinterpret_cast<const uint4*>(xbc + ((size_t)(b * 4096 + rr * 64 + cc)) * 3072 + ch);
          const float* w = cw + (i * 3 + j) * 3072 + ch;
          float4 w0 = *reinterpret_cast<const float4*>(w), w1 = *reinterpret_cast<const float4*>(w + 4);
          acc[0] += bflo(v.x) * w0.x; acc[1] += bfhi(v.x) * w0.y; acc[2] += bflo(v.y) * w0.z; acc[3] += bfhi(v.y) * w0.w;
          acc[4] += bflo(v.z) * w1.x; acc[5] += bfhi(v.z) * w1.y; acc[6] += bflo(v.w) * w1.z; acc[7] += bfhi(v.w) * w1.w;
        }
      }
    } else {
      int b = tok >> 8, c = tok & 255;
#pragma unroll
      for (int j = 0; j < 3; ++j) {
        int cc = c + j - 1;
        if (cc < 0 || cc > 255) continue;
        uint4 v = *reinterpret_cast<const uint4*>(xbc_c + ((size_t)(b * 256 + cc)) * 3072 + ch);
        const float* w = cw + (3 + j) * 3072 + ch;
        float4 w0 = *reinterpret_cast<const float4*>(w), w1 = *reinterpret_cast<const float4*>(w + 4);
        acc[0] += bflo(v.x) * w0.x; acc[1] += bfhi(v.x) * w0.y; acc[2] += bflo(v.y) * w0.z; acc[3] += bfhi(v.y) * w0.w;
        acc[4] += bflo(v.z) * w1.x; acc[5] += bfhi(v.z) * w1.y; acc[6] += bflo(v.w) * w1.z; acc[7] += bfhi(v.w) * w1.w;
      }
    }
    uint4 o;
    o.x = pack2(siluf(acc[0]), siluf(acc[1]));
    o.y = pack2(siluf(acc[2]), siluf(acc[3]));
    o.z = pack2(siluf(acc[4]), siluf(acc[5]));
    o.w = pack2(siluf(acc[6]), siluf(acc[7]));
    u16* dst = isc ? xc_c : xc;
    *reinterpret_cast<uint4*>(dst + (size_t)tok * 3072 + ch) = o;
  }
}

constexpr int SLD = 136;
__device__ __forceinline__ void phase_ssd(const Params& p, char* lds) {
  u16* xsT = (u16*)lds;
  u16* stb = xsT + 64 * SLD;
  u16* Mb = stb + 64 * SLD;
  float* cum = (float*)(Mb + 128 * SLD);
  float* dtv = cum + 128;
  float* asrc = dtv + 128;
  const u16* xc = (const u16*)(p.ws + OFF_R2);
  const u16* xc_c = (const u16*)(p.ws + OFF_XC_C);
  const float* dt = (const float*)(p.ws + OFF_DT);
  const float* dt_c = (const float*)(p.ws + OFF_DT_C);
  u16* y = (u16*)(p.ws + OFF_R1);
  int tid = threadIdx.x, w = tid >> 6, lane = tid & 63, fr = lane & 15, fq = lane >> 4;
  for (int item = blockIdx.x; item < 256; item += gridDim.x) {
    int b = item >> 5, h = item & 31, g = h >> 3;
    float dsk = p.m_d[h];
    for (int dir = 0; dir < 2; ++dir) {
      float a_neg = -__expf(p.m_a_log[dir * 32 + h]);
      f32x4 acc_s[8];
#pragma unroll
      for (int n = 0; n < 8; ++n) acc_s[n] = f32x4{0.f, 0.f, 0.f, 0.f};
      for (int step = 0; step < 34; ++step) {
        bool isctx = step < 2;
        int cidx = isctx ? step : step - 2;
        if (dir) cidx = (isctx ? 1 : 31) - cidx;
        size_t tok0 = isctx ? (size_t)(b * 256 + cidx * 128) : (size_t)(b * 4096 + cidx * 128);
        const u16* src = (isctx ? xc_c : xc) + tok0 * 3072;
        const float* dts = (isctx ? dt_c : dt) + tok0 * 64;
        if (tid < 128) {
          float d = dts[tid * 64 + dir * 32 + h];
          dtv[tid] = d;
          asrc[tid] = d * a_neg;
        }
#pragma unroll
        for (int i = 0; i < 4; ++i) {
          int idx = tid + i * 256, l = idx >> 3, pc = (idx & 7) * 8;
          uint4 v = *reinterpret_cast<const uint4*>(src + (size_t)l * 3072 + h * 64 + pc);
          xsT[(pc + 0) * SLD + l] = (u16)(v.x & 0xffff); xsT[(pc + 1) * SLD + l] = (u16)(v.x >> 16);
          xsT[(pc + 2) * SLD + l] = (u16)(v.y & 0xffff); xsT[(pc + 3) * SLD + l] = (u16)(v.y >> 16);
          xsT[(pc + 4) * SLD + l] = (u16)(v.z & 0xffff); xsT[(pc + 5) * SLD + l] = (u16)(v.z >> 16);
          xsT[(pc + 6) * SLD + l] = (u16)(v.w & 0xffff); xsT[(pc + 7) * SLD + l] = (u16)(v.w >> 16);
        }
        __syncthreads();
        if (tid < 128) {
          float s = 0.f;
          if (!dir) { for (int j = 0; j <= tid; ++j) s += asrc[j]; }
          else { for (int j = tid; j < 128; ++j) s += asrc[j]; }
          cum[tid] = s;
        }
        __syncthreads();
        float total = dir ? cum[0] : cum[127];
        if (!isctx) {
          bf16x8 Cf[2][4];
#pragma unroll
          for (int mt = 0; mt < 2; ++mt)
#pragma unroll
            for (int kk = 0; kk < 4; ++kk) Cf[mt][kk] = ld8(src + (size_t)(w * 32 + mt * 16 + fr) * 3072 + 2560 + g * 128 + kk * 32 + fq * 8);
          float cl[2][4];
#pragma unroll
          for (int mt = 0; mt < 2; ++mt)
#pragma unroll
            for (int j = 0; j < 4; ++j) cl[mt][j] = cum[w * 32 + mt * 16 + fq * 4 + j];
#pragma unroll 2
          for (int nt = 0; nt < 8; ++nt) {
            int s = nt * 16 + fr;
            bool need0 = dir ? (nt >= w * 2) : (nt <= w * 2);
            bool need1 = dir ? (nt >= w * 2 + 1) : (nt <= w * 2 + 1);
            f32x4 a0 = f32x4{0.f, 0.f, 0.f, 0.f}, a1 = f32x4{0.f, 0.f, 0.f, 0.f};
            if (need0 || need1) {
#pragma unroll
              for (int kk = 0; kk < 4; ++kk) {
                bf16x8 Bf = ld8(src + (size_t)s * 3072 + 2048 + g * 128 + kk * 32 + fq * 8);
                a0 = mfma16(Cf[0][kk], Bf, a0);
                a1 = mfma16(Cf[1][kk], Bf, a1);
              }
            }
            float cs = cum[s], ds = dtv[s];
#pragma unroll
            for (int j = 0; j < 4; ++j) {
              int l0 = w * 32 + fq * 4 + j, l1 = l0 + 16;
              bool ok0 = dir ? (s >= l0) : (s <= l0);
              bool ok1 = dir ? (s >= l1) : (s <= l1);
              float v0 = ok0 ? a0[j] * __expf(cl[0][j] - cs) * ds : 0.f;
              float v1 = ok1 ? a1[j] * __expf(cl[1][j] - cs) * ds : 0.f;
              Mb[l0 * SLD + s] = f2bf(v0);
              Mb[l1 * SLD + s] = f2bf(v1);
            }
          }
          __syncthreads();
          f32x4 ya[2][4];
#pragma unroll
          for (int mt = 0; mt < 2; ++mt)
#pragma unroll
            for (int nt = 0; nt < 4; ++nt) ya[mt][nt] = f32x4{0.f, 0.f, 0.f, 0.f};
#pragma unroll
          for (int kk = 0; kk < 4; ++kk)
#pragma unroll
            for (int nt = 0; nt < 4; ++nt) {
              bf16x8 Sf = ld8(stb + (nt * 16 + fr) * SLD + kk * 32 + fq * 8);
              ya[0][nt] = mfma16(Cf[0][kk], Sf, ya[0][nt]);
              ya[1][nt] = mfma16(Cf[1][kk], Sf, ya[1][nt]);
            }
#pragma unroll
          for (int mt = 0; mt < 2; ++mt)
#pragma unroll
            for (int j = 0; j < 4; ++j) {
              float e = __expf(cl[mt][j]);
#pragma unroll
              for (int nt = 0; nt < 4; ++nt) ya[mt][nt][j] *= e;
            }
#pragma unroll
          for (int kk = 0; kk < 4; ++kk) {
            bf16x8 Mf0 = ld8(Mb + (w * 32 + fr) * SLD + kk * 32 + fq * 8);
            bf16x8 Mf1 = ld8(Mb + (w * 32 + 16 + fr) * SLD + kk * 32 + fq * 8);
#pragma unroll
            for (int nt = 0; nt < 4; ++nt) {
              bf16x8 Xf = ld8(xsT + (nt * 16 + fr) * SLD + kk * 32 + fq * 8);
              ya[0][nt] = mfma16(Mf0, Xf, ya[0][nt]);
              ya[1][nt] = mfma16(Mf1, Xf, ya[1][nt]);
            }
          }
#pragma unroll
          for (int mt = 0; mt < 2; ++mt)
#pragma unroll
            for (int nt = 0; nt < 4; ++nt)
#pragma unroll
              for (int j = 0; j < 4; ++j) {
                int l = w * 32 + mt * 16 + fq * 4 + j, pp = nt * 16 + fr;
                u16* yp = y + (tok0 + l) * 2048 + h * 64 + pp;
                float val = ya[mt][nt][j];
                if (!dir) val += bf2f(xsT[pp * SLD + l]) * dsk;
                else val += bf2f(*yp);
                *yp = f2bf(val);
              }
        }
        if (step == 33) continue;
        __syncthreads();
#pragma unroll
        for (int i = 0; i < 8; ++i) {
          int idx = tid + i * 256, l = idx >> 4, nc = (idx & 15) * 8;
          uint4 v = *reinterpret_cast<const uint4*>(src + (size_t)l * 3072 + 2048 + g * 128 + nc);
          float sc = dtv[l] * __expf(total - cum[l]);
          Mb[(nc + 0) * SLD + l] = f2bf(bflo(v.x) * sc); Mb[(nc + 1) * SLD + l] = f2bf(bfhi(v.x) * sc);
          Mb[(nc + 2) * SLD + l] = f2bf(bflo(v.y) * sc); Mb[(nc + 3) * SLD + l] = f2bf(bfhi(v.y) * sc);
          Mb[(nc + 4) * SLD + l] = f2bf(bflo(v.z) * sc); Mb[(nc + 5) * SLD + l] = f2bf(bfhi(v.z) * sc);
          Mb[(nc + 6) * SLD + l] = f2bf(bflo(v.w) * sc); Mb[(nc + 7) * SLD + l] = f2bf(bfhi(v.w) * sc);
        }
        __syncthreads();
        float cd = __expf(total);
#pragma unroll
        for (int nt = 0; nt < 8; ++nt) acc_s[nt] *= cd;
#pragma unroll
        for (int kk = 0; kk < 4; ++kk) {
          bf16x8 Af = ld8(xsT + (w * 16 + fr) * SLD + kk * 32 + fq * 8);
#pragma unroll
          for (int nt = 0; nt < 8; ++nt) {
            bf16x8 Bf = ld8(Mb + (nt * 16 + fr) * SLD + kk * 32 + fq * 8);
            acc_s[nt] = mfma16(Af, Bf, acc_s[nt]);
          }
        }
#pragma unroll
        for (int nt = 0; nt < 8; ++nt)
#pragma unroll
          for (int j = 0; j < 4; ++j) stb[(w * 16 + fq * 4 + j) * SLD + nt * 16 + fr] = f2bf(acc_s[nt][j]);
        __syncthreads();
      }
      __syncthreads();
    }
  }
}

__device__ __forceinline__ void phase_gated_norm(const Params& p) {
  u16* y = (u16*)(p.ws + OFF_R1);
  const u16* z = (const u16*)p.out;
  int lane = threadIdx.x & 63;
  int wave = blockIdx.x * 4 + (threadIdx.x >> 6), nw = gridDim.x * 4;
  for (int tok = wave; tok < NT; tok += nw) {
#pragma unroll
    for (int g = 0; g < 4; ++g) {
      int ch = g * 512 + lane * 8;
      uint4 yv = *reinterpret_cast<const uint4*>(y + (size_t)tok * 2048 + ch);
      uint4 zv = *reinterpret_cast<const uint4*>(z + (size_t)tok * 2048 + ch);
      float u[8];
      u[0] = bflo(yv.x) * siluf(bflo(zv.x)); u[1] = bfhi(yv.x) * siluf(bfhi(zv.x));
      u[2] = bflo(yv.y) * siluf(bflo(zv.y)); u[3] = bfhi(yv.y) * siluf(bfhi(zv.y));
      u[4] = bflo(yv.z) * siluf(bflo(zv.z)); u[5] = bfhi(yv.z) * siluf(bfhi(zv.z));
      u[6] = bflo(yv.w) * siluf(bflo(zv.w)); u[7] = bfhi(yv.w) * siluf(bfhi(zv.w));
      float ss = 0.f;
#pragma unroll
      for (int k = 0; k < 8; ++k) ss += u[k] * u[k];
      ss = wave_sum(ss);
      float sc = rsqrtf(ss * (1.f / 512.f) + 1e-5f);
      float4 w0 = *reinterpret_cast<const float4*>(p.m_norm_w + ch), w1 = *reinterpret_cast<const float4*>(p.m_norm_w + ch + 4);
      uint4 o;
      o.x = pack2(u[0] * sc * w0.x, u[1] * sc * w0.y);
      o.y = pack2(u[2] * sc * w0.z, u[3] * sc * w0.w);
      o.z = pack2(u[4] * sc * w1.x, u[5] * sc * w1.y);
      o.w = pack2(u[6] * sc * w1.z, u[7] * sc * w1.w);
      *reinterpret_cast<uint4*>(y + (size_t)tok * 2048 + ch) = o;
    }
  }
}

__device__ __forceinline__ void phase_gemm_resid(const u16* A, int K, const u16* Wt, const float* res, float* dst, const float* gate  , char* lds) {
  for (int item = blockIdx.x; item < 256 * 8; item += gridDim.x) {
    int pm = item >> 3, pn = item & 7;
    gemm_tile(A, K, Wt, K, pm * 128, pn * 128, 1024, K, lds, [=](int m, int n, float v) {
      int b = m >> 12;
      dst[(size_t)m * 1024 + n] = ALPHA * res[(size_t)m * 1024 + n] + gate[(size_t)b * 6144 + n] * v;
    });
  }
}
__device__ __forceinline__ void phase_gemm_bf16(const u16* A, const u16* Wt, u16* dst, int N, char* lds) {
  int nn = N / 128;
  for (int item = blockIdx.x; item < 256 * nn; item += gridDim.x) {
    int pm = item / nn, pn = item % nn;
    gemm_tile(A, 1024, Wt, 1024, pm * 128, pn * 128, N, 1024, lds, [=](int m, int n, float v) { dst[(size_t)m * N + n] = f2bf(v); });
  }
}

__device__ __forceinline__ void phase_ln_mod(float* xio, const float* g, const float* bta, const float* mod  , u16* tdst) {
  int lane = threadIdx.x & 63;
  int wave = blockIdx.x * 4 + (threadIdx.x >> 6), nw = gridDim.x * 4;
  for (int tok = wave; tok < NT; tok += nw) {
    int b = tok >> 12;
    float4 v[4];
    float s = 0.f;
#pragma unroll
    for (int i = 0; i < 4; ++i) {
      v[i] = *reinterpret_cast<const float4*>(xio + (size_t)tok * 1024 + i * 256 + lane * 4);
      s += v[i].x + v[i].y + v[i].z + v[i].w;
    }
    float mu = wave_sum(s) * (1.f / 1024.f);
    float q = 0.f;
#pragma unroll
    for (int i = 0; i < 4; ++i) {
      v[i].x -= mu; v[i].y -= mu; v[i].z -= mu; v[i].w -= mu;
      q += v[i].x * v[i].x + v[i].y * v[i].y + v[i].z * v[i].z + v[i].w * v[i].w;
    }
    float rs = rsqrtf(wave_sum(q) * (1.f / 1024.f) + 1e-5f);
    const float* m = mod + (size_t)b * 6144;
#pragma unroll
    for (int i = 0; i < 4; ++i) {
      int c = i * 256 + lane * 4;
      float4 gg = *reinterpret_cast<const float4*>(g + c), bb = *reinterpret_cast<const float4*>(bta + c);
      float4 o;
      o.x = v[i].x * rs * gg.x + bb.x; o.y = v[i].y * rs * gg.y + bb.y; o.z = v[i].z * rs * gg.z + bb.z; o.w = v[i].w * rs * gg.w + bb.w;
      *reinterpret_cast<float4*>(xio + (size_t)tok * 1024 + c) = o;
      float4 sh = *reinterpret_cast<const float4*>(m + 3072 + c), sc = *reinterpret_cast<const float4*>(m + 4096 + c);
      uint2 t;
      t.x = pack2(o.x * (1.f + sc.x) + sh.x, o.y * (1.f + sc.y) + sh.y);
      t.y = pack2(o.z * (1.f + sc.z) + sh.z, o.w * (1.f + sc.w) + sh.w);
      *reinterpret_cast<uint2*>(tdst + (size_t)tok * 1024 + c) = t;
    }
  }
}

__device__ __forceinline__ void phase_peer_topk(const u16* q, const float* k1, const float* k2, int* idxo, float* gateo, char* lds, unsigned* shash = nullptr) {
  float* S = (float*)lds;
  float* sv = S + 64 * 129;
  int* si = (int*)(sv + 64 * 16);
  float* sel_s = (float*)(si + 64 * 16);
  int* sel_e = (int*)(sel_s + 32 * 16);
  float* cs = (float*)(sel_e + 32 * 16);
  int* cc = (int*)(cs + 32 * 52);
  int tid = threadIdx.x, w = tid >> 6, lane = tid & 63, fr = lane & 15, fq = lane >> 4;
  for (int item = blockIdx.x; item < 1024 * 8; item += gridDim.x) {
    int tile = item >> 3, h = item & 7;
    int tok0 = tile * 32;
    {
      int half = w >> 1, kb = (w & 1) * 64;
      const float* kk_ = (half ? k2 : k1) + (size_t)h * 128 * 128;
      f32x4 acc[2][4];
#pragma unroll
      for (int m = 0; m < 2; ++m)
#pragma unroll
        for (int n = 0; n < 4; ++n) acc[m][n] = f32x4{0.f, 0.f, 0.f, 0.f};
#pragma unroll
      for (int ks = 0; ks < 4; ++ks) {
        bf16x8 Af[2];
#pragma unroll
        for (int m = 0; m < 2; ++m) Af[m] = ld8(q + (size_t)(tok0 + m * 16 + fr) * 2048 + h * 256 + half * 128 + ks * 32 + fq * 8);
#pragma unroll
        for (int n = 0; n < 4; ++n) {
          const float* kp = kk_ + (size_t)(kb + n * 16 + fr) * 128 + ks * 32 + fq * 8;
          float4 f0 = *reinterpret_cast<const float4*>(kp), f1 = *reinterpret_cast<const float4*>(kp + 4);
          union { bf16x8 v; unsigned u[4]; } B;
          B.u[0] = pack2(f0.x, f0.y); B.u[1] = pack2(f0.z, f0.w); B.u[2] = pack2(f1.x, f1.y); B.u[3] = pack2(f1.z, f1.w);
          acc[0][n] = mfma16(Af[0], B.v, acc[0][n]);
          acc[1][n] = mfma16(Af[1], B.v, acc[1][n]);
        }
      }
#pragma unroll
      for (int m = 0; m < 2; ++m)
#pragma unroll
        for (int n = 0; n < 4; ++n)
#pragma unroll
          for (int j = 0; j < 4; ++j) S[(half * 32 + m * 16 + fq * 4 + j) * 129 + kb + n * 16 + fr] = acc[m][n][j];
    }
    __syncthreads();
    for (int i = 0; i < 32; ++i) {
      int e = tid + i * 256, list = e >> 7, k = e & 127;
      const float* row = S + list * 129;
      float v = row[k];
      int rank = 0;
      for (int k2_ = 0; k2_ < 128; ++k2_) {
        float o = row[k2_];
        rank += (o > v || (o == v && k2_ < k)) ? 1 : 0;
      }
      if (rank < 16) { sv[list * 16 + rank] = v; si[list * 16 + rank] = k; }
    }
    __syncthreads();
    if (shash) {
      unsigned hh = 0;
      for (int i = 0; i < 4; ++i) { int e = tid + i * 256; hh = hh * 31u + __float_as_uint(sv[e]) * 7u + (unsigned)si[e]; }
      shash[(size_t)item * 256 + tid] = hh;
    }
    {
      const int c = tid, ci = c >> 4, cj = c & 15;
      if ((ci + 1) * (cj + 1) <= 16) {
        const unsigned long long PACK = 0ull | (16ull << 8) | (24ull << 16) | (29ull << 24) | (33ull << 32) | (36ull << 40) | (38ull << 48) | (40ull << 56);
        const int slot = (ci < 8 ? (int)((PACK >> (8 * ci)) & 0xFF) : 34 + ci) + cj;
#pragma unroll 1
        for (int tok = 0; tok < 32; ++tok) {
          cs[tok * 52 + slot] = sv[tok * 16 + ci] + sv[(32 + tok) * 16 + cj];
          cc[tok * 52 + slot] = c;
        }
      }
    }
    __syncthreads();
#pragma unroll 1
    for (int i = 0; i < 7; ++i) {
      int e = tid + i * 256;
      if (e < 1600) {
        int tok = e / 50, slot = e - tok * 50;
        const float* csr = cs + tok * 52;
        const int* ccr = cc + tok * 52;
        float sc_ = csr[slot];
        int c = ccr[slot];
        int rank = 0;
#pragma unroll 2
        for (int j = 0; j < 50; ++j) {
          float o = csr[j];
          int c2 = ccr[j];
          rank += (o > sc_ || (o == sc_ && c2 < c)) ? 1 : 0;
        }
        if (rank < 16) {
          sel_s[tok * 16 + rank] = sc_;
          sel_e[tok * 16 + rank] = si[tok * 16 + (c >> 4)] * 128 + si[(32 + tok) * 16 + (c & 15)];
        }
      }
    }
    __syncthreads();
    if (tid < 32) {
      float mx = sel_s[tid * 16];
      float ex[16];
      float sum = 0.f;
#pragma unroll
      for (int r = 0; r < 16; ++r) { ex[r] = __expf(sel_s[tid * 16 + r] - mx); sum += ex[r]; }
      float inv = 1.f / sum;
      size_t o = (size_t)(tok0 + tid) * 128 + h * 16;
#pragma unroll
      for (int r = 0; r < 16; ++r) { gateo[o + r] = ex[r] * inv; idxo[o + r] = sel_e[tid * 16 + r]; }
    }
    __syncthreads();
  }
}

DEV float gelu_exact(float v) { return 0.5f * v * (1.f + erff(v * 0.70710678118654752f)); }

__device__ __forceinline__ void phase_peer_gather(const u16* tin, const int* idx, const float* gate, const float* utab, const float* vtab, const float* xres,
                                  const float* g2  , const float* lng, const float* lnb, float* xout,
                                  const float* modnext  , u16* hxout) {
  int lane = threadIdx.x & 63;
  int wave = blockIdx.x * 4 + (threadIdx.x >> 6), nw = gridDim.x * 4;
  for (int tok = wave; tok < NT; tok += nw) {
    int b = tok >> 12;
    float t[16];
#pragma unroll
    for (int i = 0; i < 4; ++i) {
      uint2 tv = *reinterpret_cast<const uint2*>(tin + (size_t)tok * 1024 + i * 256 + lane * 4);
      t[i * 4 + 0] = bflo(tv.x); t[i * 4 + 1] = bfhi(tv.x); t[i * 4 + 2] = bflo(tv.y); t[i * 4 + 3] = bfhi(tv.y);
    }
    int id0 = idx[(size_t)tok * 128 + lane], id1 = idx[(size_t)tok * 128 + 64 + lane];
    float gt0 = gate[(size_t)tok * 128 + lane], gt1 = gate[(size_t)tok * 128 + 64 + lane];
    float acc[16];
#pragma unroll
    for (int k = 0; k < 16; ++k) acc[k] = 0.f;
    for (int j = 0; j < 128; j += 2) {
      int ea, eb;
      float ga, gb;
      if (j < 64) { ea = __builtin_amdgcn_readlane(id0, j); eb = __builtin_amdgcn_readlane(id0, j + 1); ga = __shfl(gt0, j); gb = __shfl(gt0, j + 1); }
      else { ea = __builtin_amdgcn_readlane(id1, j - 64); eb = __builtin_amdgcn_readlane(id1, j - 63); ga = __shfl(gt1, j - 64); gb = __shfl(gt1, j - 63); }
      ea &= 16383; eb &= 16383;
      const float* ua = utab + (size_t)ea * 1024 + lane * 4;
      const float* ub = utab + (size_t)eb * 1024 + lane * 4;
      const float* va = vtab + (size_t)ea * 1024 + lane * 4;
      const float* vb = vtab + (size_t)eb * 1024 + lane * 4;
      float4 u0[4], u1[4], w0[4], w1[4];
#pragma unroll
      for (int i = 0; i < 4; ++i) {
        u0[i] = *reinterpret_cast<const float4*>(ua + i * 256);
        u1[i] = *reinterpret_cast<const float4*>(ub + i * 256);
        w0[i] = *reinterpret_cast<const float4*>(va + i * 256);
        w1[i] = *reinterpret_cast<const float4*>(vb + i * 256);
      }
      float d0 = 0.f, d1 = 0.f;
#pragma unroll
      for (int i = 0; i < 4; ++i) {
        d0 += u0[i].x * t[i * 4] + u0[i].y * t[i * 4 + 1] + u0[i].z * t[i * 4 + 2] + u0[i].w * t[i * 4 + 3];
        d1 += u1[i].x * t[i * 4] + u1[i].y * t[i * 4 + 1] + u1[i].z * t[i * 4 + 2] + u1[i].w * t[i * 4 + 3];
      }
      d0 = wave_sum(d0);
      d1 = wave_sum(d1);
      float a0 = ga * gelu_exact(d0), a1 = gb * gelu_exact(d1);
#pragma unroll
      for (int i = 0; i < 4; ++i) {
        acc[i * 4 + 0] += a0 * w0[i].x + a1 * w1[i].x;
        acc[i * 4 + 1] += a0 * w0[i].y + a1 * w1[i].y;
        acc[i * 4 + 2] += a0 * w0[i].z + a1 * w1[i].z;
        acc[i * 4 + 3] += a0 * w0[i].w + a1 * w1[i].w;
      }
    }
    float vv[16];
    float s = 0.f;
#pragma unroll
    for (int i = 0; i < 4; ++i) {
      int c = i * 256 + lane * 4;
      float4 xr = *reinterpret_cast<const float4*>(xres + (size_t)tok * 1024 + c);
      float4 gg = *reinterpret_cast<const float4*>(g2 + (size_t)b * 6144 + c);
      vv[i * 4 + 0] = ALPHA * xr.x + gg.x * acc[i * 4 + 0];
      vv[i * 4 + 1] = ALPHA * xr.y + gg.y * acc[i * 4 + 1];
      vv[i * 4 + 2] = ALPHA * xr.z + gg.z * acc[i * 4 + 2];
      vv[i * 4 + 3] = ALPHA * xr.w + gg.w * acc[i * 4 + 3];
      s += vv[i * 4] + vv[i * 4 + 1] + vv[i * 4 + 2] + vv[i * 4 + 3];
    }
    float mu = wave_sum(s) * (1.f / 1024.f);
    float qq = 0.f;
#pragma unroll
    for (int k = 0; k < 16; ++k) { vv[k] -= mu; qq += vv[k] * vv[k]; }
    float rs = rsqrtf(wave_sum(qq) * (1.f / 1024.f) + 1e-5f);
#pragma unroll
    for (int i = 0; i < 4; ++i) {
      int c = i * 256 + lane * 4;
      float4 gg = *reinterpret_cast<const float4*>(lng + c), bb = *reinterpret_cast<const float4*>(lnb + c);
      float4 o;
      o.x = vv[i * 4 + 0] * rs * gg.x + bb.x; o.y = vv[i * 4 + 1] * rs * gg.y + bb.y;
      o.z = vv[i * 4 + 2] * rs * gg.z + bb.z; o.w = vv[i * 4 + 3] * rs * gg.w + bb.w;
      *reinterpret_cast<float4*>(xout + (size_t)tok * 1024 + c) = o;
      if (modnext) {
        const float* m = modnext + (size_t)b * 6144;
        float4 sh = *reinterpret_cast<const float4*>(m + c), sc = *reinterpret_cast<const float4*>(m + 1024 + c);
        uint2 tt;
        tt.x = pack2(o.x * (1.f + sc.x) + sh.x, o.y * (1.f + sc.y) + sh.y);
        tt.y = pack2(o.z * (1.f + sc.z) + sh.z, o.w * (1.f + sc.w) + sh.w);
        *reinterpret_cast<uint2*>(hxout + (size_t)tok * 1024 + c) = tt;
      }
    }
  }
}

__device__ __forceinline__ void phase_shortconv_T(const Params& p, const u16* upre, u16* x1cm, u16* x2cm, u16* vcm, char* lds) {
  u16* tile = (u16*)lds;
  int tid = threadIdx.x;
  for (int item = blockIdx.x; item < 512 * 48; item += gridDim.x) {
    int tt = item / 48, ct = item % 48;
    int tok0 = tt * 64, c0 = ct * 64;
#pragma unroll
    for (int i = 0; i < 2; ++i) {
      int q = tid + i * 256, tl = q >> 3, cg_ = (q & 7) * 8;
      int tok = tok0 + tl, l = tok & 4095, ch = c0 + cg_;
      float acc[8];
#pragma unroll
      for (int k = 0; k < 8; ++k) acc[k] = p.h_conv_b[ch + k];
#pragma unroll
      for (int j = 0; j < 3; ++j) {
        int ll = l + j - 1;
        if (ll < 0 || ll > 4095) continue;
        uint4 v = *reinterpret_cast<const uint4*>(upre + (size_t)(tok + j - 1) * 3072 + ch);
        const float* w = p.h_conv_w + j * 3072 + ch;
        float4 w0 = *reinterpret_cast<const float4*>(w), w1 = *reinterpret_cast<const float4*>(w + 4);
        acc[0] += bflo(v.x) * w0.x; acc[1] += bfhi(v.x) * w0.y; acc[2] += bflo(v.y) * w0.z; acc[3] += bfhi(v.y) * w0.w;
        acc[4] += bflo(v.z) * w1.x; acc[5] += bfhi(v.z) * w1.y; acc[6] += bflo(v.w) * w1.z; acc[7] += bfhi(v.w) * w1.w;
      }
#pragma unroll
      for (int k = 0; k < 8; ++k) tile[(cg_ + k) * 72 + tl] = f2bf(acc[k]);
    }
    __syncthreads();
    int part = c0 >> 10, d0 = c0 & 1023;
    u16* dst = part == 0 ? x1cm : (part == 1 ? x2cm : vcm);
    int b = tok0 >> 12, l0 = tok0 & 4095;
#pragma unroll
    for (int i = 0; i < 2; ++i) {
      int q = tid + i * 256, c = q >> 3, tg = (q & 7) * 8;
      uint4 v = *reinterpret_cast<const uint4*>(tile + c * 72 + tg);
      *reinterpret_cast<uint4*>(dst + ((size_t)(b * 1024 + d0 + c)) * 4096 + l0 + tg) = v;
    }
    __syncthreads();
  }
}

__device__ __forceinline__ void fft_fwd(float2* X) {
  int tid = threadIdx.x;
  for (int s = 12; s >= 0; --s) {
    int half = 1 << s;
    float inv2h = 1.f / (float)(2 * half);
#pragma unroll 4
    for (int i = 0; i < 16; ++i) {
      int j = tid + i * 256;
      int pos = j & (half - 1);
      int i0 = ((j >> s) << (s + 1)) + pos, i1 = i0 + half;
      float fr_ = (float)pos * inv2h;
      float wr = __builtin_amdgcn_cosf(fr_), wi = -__builtin_amdgcn_sinf(fr_);
      float2 a = X[i0], bq = X[i1];
      float dr = a.x - bq.x, di = a.y - bq.y;
      X[i0] = make_float2(a.x + bq.x, a.y + bq.y);
      X[i1] = make_float2(dr * wr - di * wi, dr * wi + di * wr);
    }
    __syncthreads();
  }
}
__device__ __forceinline__ void fft_inv(float2* X) {
  int tid = threadIdx.x;
  for (int s = 0; s <= 12; ++s) {
    int half = 1 << s;
    float inv2h = 1.f / (float)(2 * half);
#pragma unroll 4
    for (int i = 0; i < 16; ++i) {
      int j = tid + i * 256;
      int pos = j & (half - 1);
      int i0 = ((j >> s) << (s + 1)) + pos, i1 = i0 + half;
      float fr_ = (float)pos * inv2h;
      float wr = __builtin_amdgcn_cosf(fr_), wi = -__builtin_amdgcn_sinf(fr_);
      float2 a = X[i0], bq = X[i1];
      float br = bq.x * wr + bq.y * wi, bi = bq.y * wr - bq.x * wi;
      X[i0] = make_float2(a.x + br, a.y + bi);
      X[i1] = make_float2(a.x - br, a.y - bi);
    }
    __syncthreads();
  }
}

__device__ __forceinline__ void phase_filter_fft(const Params& p, float2* Hf, char* lds) {
  float2* X = (float2*)lds;
  float* w3s = (float*)(lds + 65536);
  float* red = w3s + 128;
  const float* hid = (const float*)(p.ws + OFF_HID);
  int tid = threadIdx.x;
  const float min_decay = -3.0701134573253945f;
  const float max_decay = -15.350567286626973f;
  for (int item = blockIdx.x; item < 2048; item += gridDim.x) {
    int o = item >> 10, d = item & 1023;
    if (tid < 128) {
      int dirr = tid >> 6, j = tid & 63;
      w3s[tid] = p.h_f_w3[(size_t)j * 4096 + (o * 2 + dirr) * 1024 + d];
    }
    __syncthreads();
    float adelta = fabsf(min_decay + (float)d * ((max_decay - min_decay) / 1023.f));
    float ss = 0.f;
#pragma unroll 1
    for (int i = 0; i < 16; ++i) {
      int t = tid + i * 256;
      const float* hr = hid + (size_t)t * 64;
      float hf = 0.f, hb = 0.f;
#pragma unroll
      for (int j4 = 0; j4 < 16; ++j4) {
        float4 hv = *reinterpret_cast<const float4*>(hr + j4 * 4);
        hf += hv.x * w3s[j4 * 4] + hv.y * w3s[j4 * 4 + 1] + hv.z * w3s[j4 * 4 + 2] + hv.w * w3s[j4 * 4 + 3];
        hb += hv.x * w3s[64 + j4 * 4] + hv.y * w3s[64 + j4 * 4 + 1] + hv.z * w3s[64 + j4 * 4 + 2] + hv.w * w3s[64 + j4 * 4 + 3];
      }
      float dec = __expf(-((float)t / 4095.f) * adelta);
      hf *= dec; hb *= dec;
      if (t == 0) {
        float v = hf + hb;
        X[0] = make_float2(v, 0.f);
        X[4096] = make_float2(0.f, 0.f);
        ss += v * v;
      } else {
        X[t] = make_float2(hf, 0.f);
        X[8192 - t] = make_float2(hb, 0.f);
        ss += hf * hf + hb * hb;
      }
    }
    ss = wave_sum(ss);
    if ((tid & 63) == 0) red[tid >> 6] = ss;
    __syncthreads();
    float tot = red[0] + red[1] + red[2] + red[3];
    float scale = rsqrtf(tot + 1e-6f) * (1.f / 8192.f);
    fft_fwd(X);
    float2* dst = Hf + (size_t)item * 8192;
#pragma unroll 4
    for (int i = 0; i < 32; ++i) {
      int k = tid + i * 256;
      float2 v = X[k];
      dst[k] = make_float2(v.x * scale, v.y * scale);
    }
    __syncthreads();
  }
}

__device__ __forceinline__ void phase_hyena_conv(const Params& p, const u16* x1cm, const u16* x2cm, const u16* vcm, const float2* Hf, u16* zzcm, char* lds) {
  float2* X = (float2*)lds;
  int tid = threadIdx.x;
  for (int item = blockIdx.x; item < 4096; item += gridDim.x) {
    int d = item >> 2, bp = item & 3;
    size_t r0 = ((size_t)((bp * 2) * 1024 + d)) * 4096, r1 = ((size_t)((bp * 2 + 1) * 1024 + d)) * 4096;
    float bias0 = p.h_bias[d], bias1 = p.h_bias[1024 + d];
#pragma unroll
    for (int i = 0; i < 2; ++i) {
      int t8 = (tid + i * 256) * 8;
      uint4 a = *reinterpret_cast<const uint4*>(vcm + r0 + t8);
      uint4 bq = *reinterpret_cast<const uint4*>(vcm + r1 + t8);
      X[t8 + 0] = make_float2(bflo(a.x), bflo(bq.x)); X[t8 + 1] = make_float2(bfhi(a.x), bfhi(bq.x));
      X[t8 + 2] = make_float2(bflo(a.y), bflo(bq.y)); X[t8 + 3] = make_float2(bfhi(a.y), bfhi(bq.y));
      X[t8 + 4] = make_float2(bflo(a.z), bflo(bq.z)); X[t8 + 5] = make_float2(bfhi(a.z), bfhi(bq.z));
      X[t8 + 6] = make_float2(bflo(a.w), bflo(bq.w)); X[t8 + 7] = make_float2(bfhi(a.w), bfhi(bq.w));
    }
    for (int i = 0; i < 16; ++i) X[4096 + tid + i * 256] = make_float2(0.f, 0.f);
    __syncthreads();
    fft_fwd(X);
    {
      const float2* H = Hf + (size_t)d * 8192;
#pragma unroll 4
      for (int i = 0; i < 32; ++i) {
        int k = tid + i * 256;
        float2 hv = H[k], xv = X[k];
        X[k] = make_float2(xv.x * hv.x - xv.y * hv.y, xv.x * hv.y + xv.y * hv.x);
      }
    }
    __syncthreads();
    fft_inv(X);
    float zz0[16], zz1[16];
#pragma unroll
    for (int i = 0; i < 2; ++i) {
      int t8 = (tid + i * 256) * 8;
      uint4 a = *reinterpret_cast<const uint4*>(vcm + r0 + t8);
      uint4 bq = *reinterpret_cast<const uint4*>(vcm + r1 + t8);
      uint4 xa = *reinterpret_cast<const uint4*>(x1cm + r0 + t8);
      uint4 xb = *reinterpret_cast<const uint4*>(x1cm + r1 + t8);
      float va[8] = {bflo(a.x), bfhi(a.x), bflo(a.y), bfhi(a.y), bflo(a.z), bfhi(a.z), bflo(a.w), bfhi(a.w)};
      float vb[8] = {bflo(bq.x), bfhi(bq.x), bflo(bq.y), bfhi(bq.y), bflo(bq.z), bfhi(bq.z), bflo(bq.w), bfhi(bq.w)};
      float fa[8] = {bflo(xa.x), bfhi(xa.x), bflo(xa.y), bfhi(xa.y), bflo(xa.z), bfhi(xa.z), bflo(xa.w), bfhi(xa.w)};
      float fb[8] = {bflo(xb.x), bfhi(xb.x), bflo(xb.y), bfhi(xb.y), bflo(xb.z), bfhi(xb.z), bflo(xb.w), bfhi(xb.w)};
#pragma unroll
      for (int e = 0; e < 8; ++e) {
        float2 cv = X[t8 + e];
        float z0 = fa[e] * (cv.x + va[e] * bias0);
        float z1 = fb[e] * (cv.y + vb[e] * bias0);
        zz0[i * 8 + e] = z0; zz1[i * 8 + e] = z1;
        X[t8 + e] = make_float2(z0, z1);
      }
    }
    for (int i = 0; i < 16; ++i) X[4096 + tid + i * 256] = make_float2(0.f, 0.f);
    __syncthreads();
    fft_fwd(X);
    {
      const float2* H = Hf + (size_t)(1024 + d) * 8192;
#pragma unroll 4
      for (int i = 0; i < 32; ++i) {
        int k = tid + i * 256;
        float2 hv = H[k], xv = X[k];
        X[k] = make_float2(xv.x * hv.x - xv.y * hv.y, xv.x * hv.y + xv.y * hv.x);
      }
    }
    __syncthreads();
    fft_inv(X);
#pragma unroll
    for (int i = 0; i < 2; ++i) {
      int t8 = (tid + i * 256) * 8;
      uint4 xa = *reinterpret_cast<const uint4*>(x2cm + r0 + t8);
      uint4 xb = *reinterpret_cast<const uint4*>(x2cm + r1 + t8);
      float fa[8] = {bflo(xa.x), bfhi(xa.x), bflo(xa.y), bfhi(xa.y), bflo(xa.z), bfhi(xa.z), bflo(xa.w), bfhi(xa.w)};
      float fb[8] = {bflo(xb.x), bfhi(xb.x), bflo(xb.y), bfhi(xb.y), bflo(xb.z), bfhi(xb.z), bflo(xb.w), bfhi(xb.w)};
      float o0[8], o1[8];
#pragma unroll
      for (int e = 0; e < 8; ++e) {
        float2 cv = X[t8 + e];
        o0[e] = fa[e] * (cv.x + zz0[i * 8 + e] * bias1);
        o1[e] = fb[e] * (cv.y + zz1[i * 8 + e] * bias1);
      }
      uint4 w0, w1;
      w0.x = pack2(o0[0], o0[1]); w0.y = pack2(o0[2], o0[3]); w0.z = pack2(o0[4], o0[5]); w0.w = pack2(o0[6], o0[7]);
      w1.x = pack2(o1[0], o1[1]); w1.y = pack2(o1[2], o1[3]); w1.z = pack2(o1[4], o1[5]); w1.w = pack2(o1[6], o1[7]);
      *reinterpret_cast<uint4*>(zzcm + r0 + t8) = w0;
      *reinterpret_cast<uint4*>(zzcm + r1 + t8) = w1;
    }
    __syncthreads();
  }
}

__device__ __forceinline__ void phase_transpose_back(const u16* src, u16* dst, char* lds) {
  u16* tile = (u16*)lds;
  int tid = threadIdx.x;
  for (int item = blockIdx.x; item < 8 * 16 * 64; item += gridDim.x) {
    int b = item >> 10, dt_ = (item >> 6) & 15, tt = item & 63;
#pragma unroll
    for (int i = 0; i < 2; ++i) {
      int q = tid + i * 256, dd = q >> 3, tg = (q & 7) * 8;
      uint4 v = *reinterpret_cast<const uint4*>(src + ((size_t)(b * 1024 + dt_ * 64 + dd)) * 4096 + tt * 64 + tg);
      tile[(tg + 0) * 72 + dd] = (u16)(v.x & 0xffff); tile[(tg + 1) * 72 + dd] = (u16)(v.x >> 16);
      tile[(tg + 2) * 72 + dd] = (u16)(v.y & 0xffff); tile[(tg + 3) * 72 + dd] = (u16)(v.y >> 16);
      tile[(tg + 4) * 72 + dd] = (u16)(v.z & 0xffff); tile[(tg + 5) * 72 + dd] = (u16)(v.z >> 16);
      tile[(tg + 6) * 72 + dd] = (u16)(v.w & 0xffff); tile[(tg + 7) * 72 + dd] = (u16)(v.w >> 16);
    }
    __syncthreads();
#pragma unroll
    for (int i = 0; i < 2; ++i) {
      int q = tid + i * 256, tl = q >> 3, dg = (q & 7) * 8;
      uint4 v = *reinterpret_cast<const uint4*>(tile + tl * 72 + dg);
      *reinterpret_cast<uint4*>(dst + ((size_t)(b * 4096 + tt * 64 + tl)) * 1024 + dt_ * 64 + dg) = v;
    }
    __syncthreads();
  }
}

DEV void probe_rows(const unsigned* buf, int wpr, float* out) {
  int lane = threadIdx.x & 63;
  int wave = blockIdx.x * 4 + (threadIdx.x >> 6), nw = gridDim.x * 4;
  for (int row = wave; row < NT; row += nw) {
    unsigned h = 0;
    for (int w = lane; w < wpr; w += 64) { unsigned v = buf[(size_t)row * wpr + w]; h += (v ^ (v >> 15)) * (2654435761u + 2u * (unsigned)w); }
#pragma unroll
    for (int o = 32; o > 0; o >>= 1) h += (unsigned)__shfl_xor((int)h, o);
    float v = (float)((h >> 8) & 0xFFFFu) * (1.f / 65536.f);
    float4 vv = make_float4(v, v, v, v);
#pragma unroll
    for (int i = 0; i < 4; ++i) *reinterpret_cast<float4*>(out + (size_t)row * 1024 + i * 256 + lane * 4) = vv;
  }
}
#define PROBE_AT(id, bufexpr, wpr) if (PROBE == id) { Params pq = fetch_params(); probe_rows((const unsigned*)(bufexpr), wpr, pq.out); return; }

DEV void gsync2(unsigned k) {
  asm volatile("s_waitcnt vmcnt(0)" ::: "memory");
  __syncthreads();
  if (threadIdx.x == 0) {
    unsigned* bar = (unsigned*)((char*)karg<33>() + OFF_BAR);
    __builtin_amdgcn_fence(__ATOMIC_RELEASE, "agent");
    asm volatile("s_waitcnt vmcnt(0)" ::: "memory");
    __hip_atomic_fetch_add(bar, 1u, __ATOMIC_RELAXED, __HIP_MEMORY_SCOPE_AGENT);
    unsigned target = k * gridDim.x;
    while (__hip_atomic_load(bar, __ATOMIC_RELAXED, __HIP_MEMORY_SCOPE_AGENT) < target) __builtin_amdgcn_s_sleep(1);
    __builtin_amdgcn_fence(__ATOMIC_ACQUIRE, "agent");
    asm volatile("s_waitcnt vmcnt(0)" ::: "memory");
  }
  __syncthreads();
}

DEV void gsync(cg::grid_group& grid) {
  asm volatile("s_waitcnt vmcnt(0)" ::: "memory");
  grid.sync();
  if (threadIdx.x == 0) {
    __builtin_amdgcn_fence(__ATOMIC_ACQUIRE, "agent");
    asm volatile("s_waitcnt vmcnt(0)" ::: "memory");
  }
  __syncthreads();
}

template <int layer>
__device__ __forceinline__ void peer_block(unsigned& nbar, char* lds) {
  {
    Params p = fetch_params();
    char* ws = p.ws; char* R1 = ws + OFF_R1; char* R2 = ws + OFF_R2; char* DO = (char*)p.out;
    const float* modl = (float*)(ws + OFF_MOD) + (size_t)layer * 9 * 6144;
    const u16* A = layer == 0 ? (const u16*)R1 : (const u16*)DO;
    const int K = layer == 0 ? 2048 : 1024;
    const u16* Wt = (const u16*)(ws + (layer == 0 ? OFF_W_OUT : OFF_W_HOUT));
    const float* res = layer == 0 ? p.x : (const float*)R2;
    phase_gemm_resid(A, K, Wt, res, (float*)R2, modl + 2048, lds);
  }
  gsync2(++nbar);
  PROBE_AT(5 + layer * 10, pq.ws + OFF_R2, 1024)
  {
    Params p = fetch_params();
    char* ws = p.ws; char* R1 = ws + OFF_R1; char* R2 = ws + OFF_R2; char* DO = (char*)p.out;
    const float* modl = (float*)(ws + OFF_MOD) + (size_t)layer * 9 * 6144;
    u16* tpeer = layer == 0 ? (u16*)DO : (u16*)(R1 + 128 * MiB);
    phase_ln_mod((float*)R2, p.ln_g + layer * 2048, p.ln_b + layer * 2048, modl, tpeer);
  }
  gsync2(++nbar);
  {
    Params p = fetch_params();
    char* ws = p.ws; char* R1 = ws + OFF_R1; char* DO = (char*)p.out;
    u16* tpeer = layer == 0 ? (u16*)DO : (u16*)(R1 + 128 * MiB);
    phase_gemm_bf16(tpeer, (const u16*)(ws + OFF_W_Q) + (size_t)layer * 2048 * 1024, (u16*)R1, 2048, lds);
  }
  gsync2(++nbar);
  PROBE_AT(7 + layer * 10, pq.ws + OFF_R1, 1024)
  {
    Params p = fetch_params();
    char* ws = p.ws; char* R1 = ws + OFF_R1; char* R2 = ws + OFF_R2;
    int* idxb = (int*)(R2 + 128 * MiB);
    float* gateb = (float*)(R2 + 144 * MiB);
    phase_peer_topk((const u16*)R1, p.p_k1 + (size_t)layer * 8 * 128 * 128, p.p_k2 + (size_t)layer * 8 * 128 * 128, idxb, gateb, lds, (PROBE == 99 && layer == 0) ? (unsigned*)(R1 + 128 * MiB) : nullptr);
  }
  gsync2(++nbar);
  if (PROBE == 99 && layer == 0) {
    {
      Params p = fetch_params();
      char* ws = p.ws; char* R1 = ws + OFF_R1; char* R2 = ws + OFF_R2;
      phase_peer_topk((const u16*)R1, p.p_k1 + (size_t)layer * 8 * 128 * 128, p.p_k2 + (size_t)layer * 8 * 128 * 128, (int*)(R2 + 160 * MiB), (float*)(R2 + 176 * MiB), lds, (unsigned*)(R1 + 136 * MiB));
    }
    gsync2(++nbar);
    Params p = fetch_params();
    const int* i1 = (const int*)(p.ws + OFF_R2 + 128 * MiB); const int* i2 = (const int*)(p.ws + OFF_R2 + 160 * MiB);
    const float* g1 = (const float*)(p.ws + OFF_R2 + 144 * MiB); const float* g2 = (const float*)(p.ws + OFF_R2 + 176 * MiB);
    size_t m = (size_t)NT * 1024;
    for (size_t e = (size_t)blockIdx.x * 256 + threadIdx.x; e < m; e += (size_t)gridDim.x * 256) {
      size_t tok = e >> 10; int c = (int)(e & 1023);
      float v = 1.f;
      if (c < 128) v += 0.f;
      else if (c < 256) v += 0.f;
      else if (c < 320) { const unsigned* h1 = (const unsigned*)(p.ws + OFF_R1 + 128 * MiB); const unsigned* h2 = (const unsigned*)(p.ws + OFF_R1 + 136 * MiB); v += (h1[tok * 64 + c - 256] != h2[tok * 64 + c - 256]) ? 100.f : 0.f; }
      p.out[e] = v;
    }
    return;
  }
  {
    Params p = fetch_params();
    char* ws = p.ws; char* R1 = ws + OFF_R1; char* R2 = ws + OFF_R2; char* DO = (char*)p.out;
    float* mod = (float*)(ws + OFF_MOD);
    const float* modl = mod + (size_t)layer * 9 * 6144;
    int* idxb = (int*)(R2 + 128 * MiB);
    float* gateb = (float*)(R2 + 144 * MiB);
    u16* tpeer = layer == 0 ? (u16*)DO : (u16*)(R1 + 128 * MiB);
    phase_peer_gather(tpeer, idxb, gateb, p.p_u + (size_t)layer * 16384 * 1024, p.p_v + (size_t)layer * 16384 * 1024, (const float*)R2,
                      modl + 5120, p.ln_g + layer * 2048 + 1024, p.ln_b + layer * 2048 + 1024, layer == 0 ? (float*)R2 : p.out,
                      layer == 0 ? mod + 9 * 6144 : nullptr, (u16*)(DO + 64 * MiB));
  }
}

__global__ void __launch_bounds__(256, 2) fwd_megakernel(Params p_unused) {
  __shared__ __attribute__((aligned(16))) char lds[LDS_BYTES];
  cg::grid_group grid = cg::this_grid();
  unsigned nbar = 0;
  { Params p = fetch_params(); phase_prologue(p, lds); }
  gsync(grid);
  {
    Params p = fetch_params();
    float* mod = (float*)(p.ws + OFF_MOD);
    modulate_rows(p.x, (u16*)(p.ws + OFF_R2), NT, SEQ, mod, 0, 1024, false);
    modulate_rows(p.ctx, (u16*)(p.ws + OFF_HC), NTC, CTXL, mod, 0, 1024, true);
  }
  gsync2(++nbar);
  { Params p = fetch_params(); phase_gemm_inproj(p, lds); }
  gsync2(++nbar);
  PROBE_AT(1, pq.ws + OFF_R1, 1536)
  { Params p = fetch_params(); phase_conv(p); }
  gsync2(++nbar);
  PROBE_AT(2, pq.ws + OFF_R2, 1536)
  { Params p = fetch_params(); phase_ssd(p, lds); }
  gsync2(++nbar);
  PROBE_AT(3, pq.ws + OFF_R1, 1024)
  { Params p = fetch_params(); phase_gated_norm(p); }
  gsync2(++nbar);
  PROBE_AT(4, pq.ws + OFF_R1, 1024)
  peer_block<0>(nbar, lds);
  if ((PROBE >= 5 && PROBE <= 7) || PROBE == 99) return;
  gsync2(++nbar);
  {
    Params p = fetch_params();
    phase_gemm_bf16((const u16*)((char*)p.out + 64 * MiB), (const u16*)(p.ws + OFF_W_HIN), (u16*)(p.ws + OFF_R1), 3072, lds);
  }
  gsync2(++nbar);
  PROBE_AT(8, pq.ws + OFF_R2, 1024)
  PROBE_AT(11, pq.ws + OFF_R1, 1536)
  {
    Params p = fetch_params();
    phase_shortconv_T(p, (const u16*)(p.ws + OFF_R1), (u16*)(p.ws + OFF_R2 + 128 * MiB), (u16*)p.out, (u16*)((char*)p.out + 64 * MiB), lds);
  }
  gsync2(++nbar);
  PROBE_AT(12, pq.ws + OFF_R2 + 128 * MiB, 512)
  { Params p = fetch_params(); phase_filter_fft(p, (float2*)(p.ws + OFF_R1), lds); }
  gsync2(++nbar);
  PROBE_AT(13, pq.ws + OFF_R1, 1024)
  {
    Params p = fetch_params();
    phase_hyena_conv(p, (const u16*)(p.ws + OFF_R2 + 128 * MiB), (const u16*)p.out, (const u16*)((char*)p.out + 64 * MiB),
                     (const float2*)(p.ws + OFF_R1), (u16*)(p.ws + OFF_R1 + 128 * MiB), lds);
  }
  gsync2(++nbar);
  PROBE_AT(14, pq.ws + OFF_R1 + 128 * MiB, 512)
  { Params p = fetch_params(); phase_transpose_back((const u16*)(p.ws + OFF_R1 + 128 * MiB), (u16*)p.out, lds); }
  gsync2(++nbar);
  peer_block<1>(nbar, lds);
}

extern "C" void kernel_launch(void* const* d_in, const int* in_sizes, int n_in, void* d_out, int out_size, void* d_ws, size_t ws_size,
                              hipStream_t stream) {
  static int grid_blocks = 0;
  if (!grid_blocks) {
    int dev = 0, cus = 0, per_cu = 0;
    hipGetDevice(&dev);
    hipDeviceGetAttribute(&cus, hipDeviceAttributeMultiprocessorCount, dev);
    hipOccupancyMaxActiveBlocksPerMultiprocessor(&per_cu, fwd_megakernel, 256, 0);
    if (per_cu > 2) per_cu = 2;
    if (per_cu < 1) per_cu = 1;
    grid_blocks = cus * per_cu;
  }
  Params p{};
  const float** pp = reinterpret_cast<const float**>(&p);
  for (int i = 0; i < 32; ++i) pp[i] = (const float*)d_in[i];
  p.out = (float*)d_out;
  p.ws = (char*)d_ws;
  if (ws_size < WS_TOTAL) fprintf(stderr, "workspace too small: %zu < %zu\n", ws_size, (size_t)WS_TOTAL);
  (void)hipMemsetAsync((char*)d_ws + OFF_BAR, 0, 4096, stream);
  void* args[] = {&p};
  hipError_t e = hipLaunchCooperativeKernel((void*)fwd_megakernel, dim3(grid_blocks), dim3(256), args, 0, stream);
  if (e != hipSuccess) fprintf(stderr, "cooperative launch failed: %s (grid %d)\n", hipGetErrorString(e), grid_blocks);
}
```

```cpp
#define PROBE 0
#include <hip/hip_runtime.h>
#include <hip/hip_bf16.h>
#include <hip/hip_cooperative_groups.h>
#include <cstdio>
namespace cg = cooperative_groups;

typedef unsigned short u16;
using bf16x8 = __attribute__((ext_vector_type(8))) short;
using f32x4 = __attribute__((ext_vector_type(4))) float;
using u32x4 = __attribute__((ext_vector_type(4))) unsigned;

#define DEV __device__ __forceinline__

constexpr int NB = 8, SEQ = 4096, DM = 1024, NT = NB * SEQ;
constexpr int CTXL = 256, NTC = NB * CTXL;
constexpr int SSM_IN = 5184, CONVD = 3072, SSM_INNER = 2048;
constexpr float ALPHA = 1.41421356237f;
constexpr int LDS_BYTES = 71168;

constexpr size_t MiB = 1ull << 20;
constexpr size_t OFF_W_IN = 0;
constexpr size_t OFF_W_OUT = OFF_W_IN + (size_t)5184 * 1024 * 2;
constexpr size_t OFF_W_HIN = OFF_W_OUT + (size_t)1024 * 2048 * 2;
constexpr size_t OFF_W_HOUT = OFF_W_HIN + (size_t)3072 * 1024 * 2;
constexpr size_t OFF_W_Q = OFF_W_HOUT + (size_t)1024 * 1024 * 2;
constexpr size_t OFF_MOD = OFF_W_Q + (size_t)2 * 2048 * 1024 * 2;
constexpr size_t OFF_HID = OFF_MOD + 512 * 1024;
constexpr size_t OFF_DT = OFF_HID + MiB;
constexpr size_t OFF_HC = OFF_DT + 8 * MiB;
constexpr size_t OFF_XBC_C = OFF_HC + 4 * MiB;
constexpr size_t OFF_XC_C = OFF_XBC_C + 12 * MiB;
constexpr size_t OFF_DT_C = OFF_XC_C + 12 * MiB;
constexpr size_t OFF_R1 = OFF_DT_C + MiB;
constexpr size_t OFF_R2 = OFF_R1 + 192 * MiB;
constexpr size_t OFF_BAR = OFF_R2 + 192 * MiB;
constexpr size_t WS_TOTAL = OFF_BAR + 4096;

struct Params {
  const float *x, *c, *ctx, *c_ctx, *ada_w, *ada_b, *ln_g, *ln_b;
  const float *m_w_in, *m_conv_w, *m_conv_b, *m_a_log, *m_dt_bias, *m_d, *m_norm_w, *m_w_out;
  const float *h_w_in, *h_conv_w, *h_conv_b, *h_f_w1, *h_f_b1, *h_f_w2, *h_f_b2, *h_f_w3, *h_freq, *h_bias, *h_w_out;
  const float *p_wq, *p_k1, *p_k2, *p_u, *p_v;
  float* out;
  char* ws;
};

DEV u16 f2bf(float f) {
  unsigned u = __float_as_uint(f);
  u += 0x7fffu + ((u >> 16) & 1u);
  return (u16)(u >> 16);
}
DEV float bf2f(u16 h) { return __uint_as_float(((unsigned)h) << 16); }
DEV float bflo(unsigned w) { return __uint_as_float(w << 16); }
DEV float bfhi(unsigned w) { return __uint_as_float(w & 0xffff0000u); }
DEV unsigned pack2(float a, float b) { return (unsigned)f2bf(a) | ((unsigned)f2bf(b) << 16); }
DEV float wave_sum(float v) {
#pragma unroll
  for (int o = 32; o > 0; o >>= 1) v += __shfl_xor(v, o);
  return v;
}
DEV float siluf(float v) { return v / (1.f + __expf(-v)); }
DEV f32x4 mfma16(bf16x8 a, bf16x8 b, f32x4 c) { return __builtin_amdgcn_mfma_f32_16x16x32_bf16(a, b, c, 0, 0, 0); }
DEV bf16x8 ld8(const u16* p) { return *reinterpret_cast<const bf16x8*>(p); }

template <int I>
DEV const float* karg() {
  unsigned long long v;
  asm volatile("s_load_dwordx2 %0, %1, %2\n\ts_waitcnt lgkmcnt(0)" : "=s"(v) : "s"(__builtin_amdgcn_kernarg_segment_ptr()), "n"(I * 8));
  return (const float*)(const __attribute__((address_space(1))) float*)v;
}
DEV Params fetch_params() {
  Params q;
  q.x = karg<0>(); q.c = karg<1>(); q.ctx = karg<2>(); q.c_ctx = karg<3>(); q.ada_w = karg<4>(); q.ada_b = karg<5>(); q.ln_g = karg<6>(); q.ln_b = karg<7>();
  q.m_w_in = karg<8>(); q.m_conv_w = karg<9>(); q.m_conv_b = karg<10>(); q.m_a_log = karg<11>(); q.m_dt_bias = karg<12>(); q.m_d = karg<13>();
  q.m_norm_w = karg<14>(); q.m_w_out = karg<15>();
  q.h_w_in = karg<16>(); q.h_conv_w = karg<17>(); q.h_conv_b = karg<18>(); q.h_f_w1 = karg<19>(); q.h_f_b1 = karg<20>(); q.h_f_w2 = karg<21>();
  q.h_f_b2 = karg<22>(); q.h_f_w3 = karg<23>(); q.h_freq = karg<24>(); q.h_bias = karg<25>(); q.h_w_out = karg<26>();
  q.p_wq = karg<27>(); q.p_k1 = karg<28>(); q.p_k2 = karg<29>(); q.p_u = karg<30>(); q.p_v = karg<31>();
  q.out = (float*)karg<32>(); q.ws = (char*)karg<33>();
  return q;
}

__device__ __forceinline__ void transpose_w_tile(const float* src, int srcld, int K, int N, u16* dst, int item, char* lds) {
  float* tile = (float*)lds;
  int ntn = N / 64;
  int kt = item / ntn, nt = item % ntn;
  int tid = threadIdx.x;
#pragma unroll
  for (int i = 0; i < 4; ++i) {
    int r = (tid >> 4) + i * 16, c4 = (tid & 15) * 4;
    float4 v = *reinterpret_cast<const float4*>(src + (size_t)(kt * 64 + r) * srcld + nt * 64 + c4);
    tile[r * 65 + c4 + 0] = v.x; tile[r * 65 + c4 + 1] = v.y; tile[r * 65 + c4 + 2] = v.z; tile[r * 65 + c4 + 3] = v.w;
  }
  __syncthreads();
#pragma unroll
  for (int i = 0; i < 2; ++i) {
    int n = (tid >> 3) + i * 32, k8 = (tid & 7) * 8;
    uint4 o;
    o.x = pack2(tile[(k8 + 0) * 65 + n], tile[(k8 + 1) * 65 + n]);
    o.y = pack2(tile[(k8 + 2) * 65 + n], tile[(k8 + 3) * 65 + n]);
    o.z = pack2(tile[(k8 + 4) * 65 + n], tile[(k8 + 5) * 65 + n]);
    o.w = pack2(tile[(k8 + 6) * 65 + n], tile[(k8 + 7) * 65 + n]);
    *reinterpret_cast<uint4*>(dst + (size_t)(nt * 64 + n) * K + kt * 64 + k8) = o;
  }
  __syncthreads();
}

__device__ __forceinline__ void ada_item(const Params& p, int item, char* lds) {
  float* red = (float*)lds;
  int layer = item / 96, cg_ = item % 96;
  int tid = threadIdx.x, kq = tid >> 6, col = cg_ * 64 + (tid & 63);
  float acc[9];
#pragma unroll
  for (int r = 0; r < 9; ++r) acc[r] = 0.f;
  const float* w = p.ada_w + (size_t)layer * 1024 * 6144 + col;
#pragma unroll 4
  for (int k = kq * 256; k < kq * 256 + 256; ++k) {
    float wv = w[(size_t)k * 6144];
#pragma unroll
    for (int r = 0; r < 8; ++r) acc[r] += siluf(p.c[r * 1024 + k]) * wv;
    acc[8] += siluf(p.c_ctx[k]) * wv;
  }
#pragma unroll
  for (int r = 0; r < 9; ++r) red[(kq * 9 + r) * 64 + (tid & 63)] = acc[r];
  __syncthreads();
  if (tid < 64) {
    float* mod = (float*)(p.ws + OFF_MOD);
    float bias = p.ada_b[layer * 6144 + col];
#pragma unroll
    for (int r = 0; r < 9; ++r) {
      float s = red[(0 * 9 + r) * 64 + tid] + red[(1 * 9 + r) * 64 + tid] + red[(2 * 9 + r) * 64 + tid] + red[(3 * 9 + r) * 64 + tid];
      mod[((size_t)layer * 9 + r) * 6144 + col] = s + bias;
    }
  }
  __syncthreads();
}

__device__ __forceinline__ void hyena_mlp_item(const Params& p, int item, char* lds) {
  float* zb = (float*)lds;
  float* h1 = zb + 256;
  float* h2 = h1 + 256;
  int tid = threadIdx.x, ti = tid >> 6, j = tid & 63;
  int t = item * 4 + ti;
  const float L = 4096.f;
  if (j < 33) {
    float v;
    if (j == 0) v = (float)t / 4095.f;
    else {
      int k = (j - 1) & 15;
      float fb = 1e-4f + (float)k * ((15.f - 1e-4f) / 15.f);
      float ang = 6.283185307179586f * (float)t / L;
      float a = fb * ang;
      v = (j <= 16) ? cosf(a) : -sinf(a);
    }
    zb[ti * 64 + j] = v;
  }
  __syncthreads();
  float fr = p.h_freq[j];
  float s = p.h_f_b1[j];
#pragma unroll 3
  for (int i = 0; i < 33; ++i) s += zb[ti * 64 + i] * p.h_f_w1[i * 64 + j];
  h1[ti * 64 + j] = sinf(fr * s);
  __syncthreads();
  s = p.h_f_b2[j];
#pragma unroll 8
  for (int i = 0; i < 64; ++i) s += h1[ti * 64 + i] * p.h_f_w2[i * 64 + j];
  h2[ti * 64 + j] = sinf(fr * s);
  __syncthreads();
  s = p.h_f_b2[64 + j];
#pragma unroll 8
  for (int i = 0; i < 64; ++i) s += h2[ti * 64 + i] * p.h_f_w2[4096 + i * 64 + j];
  float* hid = (float*)(p.ws + OFF_HID);
  hid[t * 64 + j] = sinf(fr * s);
  __syncthreads();
}

__device__ __forceinline__ void phase_prologue(const Params& p, char* lds) {
  constexpr int T0 = 1296, T1 = T0 + 512, T2 = T1 + 768, T3 = T2 + 256, T4 = T3 + 512, T5 = T4 + 512, T6 = T5 + 192, T7 = T6 + 1024;
  for (int item = blockIdx.x; item < T7; item += gridDim.x) {
    if (item < T0) transpose_w_tile(p.m_w_in, SSM_IN, 1024, SSM_IN, (u16*)(p.ws + OFF_W_IN), item, lds);
    else if (item < T1) transpose_w_tile(p.m_w_out, 1024, 2048, 1024, (u16*)(p.ws + OFF_W_OUT), item - T0, lds);
    else if (item < T2) transpose_w_tile(p.h_w_in, 3072, 1024, 3072, (u16*)(p.ws + OFF_W_HIN), item - T1, lds);
    else if (item < T3) transpose_w_tile(p.h_w_out, 1024, 1024, 1024, (u16*)(p.ws + OFF_W_HOUT), item - T2, lds);
    else if (item < T4) transpose_w_tile(p.p_wq, 2048, 1024, 2048, (u16*)(p.ws + OFF_W_Q), item - T3, lds);
    else if (item < T5) transpose_w_tile(p.p_wq + (size_t)1024 * 2048, 2048, 1024, 2048, (u16*)(p.ws + OFF_W_Q) + (size_t)2048 * 1024, item - T4, lds);
    else if (item < T6) ada_item(p, item - T5, lds);
    else hyena_mlp_item(p, item - T6, lds);
  }
}

__device__ __forceinline__ void modulate_rows(const float* src, u16* dst, int nrows, int rows_per_batch, const float* modbase, int sh_off, int sc_off, bool ctxrow) {
  size_t total = (size_t)nrows * 128;
  for (size_t e = (size_t)blockIdx.x * 256 + threadIdx.x; e < total; e += (size_t)gridDim.x * 256) {
    int row = (int)(e >> 7), c8 = (int)(e & 127) * 8;
    int b = ctxrow ? 8 : row / rows_per_batch;
    const float* m = modbase + (size_t)b * 6144;
    float4 a0 = *reinterpret_cast<const float4*>(src + (size_t)row * 1024 + c8);
    float4 a1 = *reinterpret_cast<const float4*>(src + (size_t)row * 1024 + c8 + 4);
    float4 s0 = *reinterpret_cast<const float4*>(m + sc_off + c8);
    float4 s1 = *reinterpret_cast<const float4*>(m + sc_off + c8 + 4);
    float4 h0 = *reinterpret_cast<const float4*>(m + sh_off + c8);
    float4 h1 = *reinterpret_cast<const float4*>(m + sh_off + c8 + 4);
    uint4 o;
    o.x = pack2(a0.x * (1.f + s0.x) + h0.x, a0.y * (1.f + s0.y) + h0.y);
    o.y = pack2(a0.z * (1.f + s0.z) + h0.z, a0.w * (1.f + s0.w) + h0.w);
    o.z = pack2(a1.x * (1.f + s1.x) + h1.x, a1.y * (1.f + s1.y) + h1.y);
    o.w = pack2(a1.z * (1.f + s1.z) + h1.z, a1.w * (1.f + s1.w) + h1.w);
    *reinterpret_cast<uint4*>(dst + (size_t)row * 1024 + c8) = o;
  }
}

constexpr int GLD = 72;
template <class Epi>
__device__ __forceinline__ void gemm_tile(const u16* __restrict__ A, int lda, const u16* __restrict__ Bt, int ldb, int brow, int bcol, int Nmax,
                                          int K, char* lds, Epi epi) {
  u16* SA = (u16*)lds;
  u16* SB = SA + 128 * GLD;
  int tid = threadIdx.x, wid = tid >> 6, lane = tid & 63, wr = wid >> 1, wc = wid & 1, fr = lane & 15, fq = lane >> 4;
  f32x4 acc[4][4];
#pragma unroll
  for (int m = 0; m < 4; ++m)
#pragma unroll
    for (int n = 0; n < 4; ++n) acc[m][n] = f32x4{0.f, 0.f, 0.f, 0.f};
  u32x4 ra[4], rb[4];
  const int lr = tid >> 3, lc = (tid & 7) * 8;
  const u16* abase = A + (size_t)(brow + lr) * lda + lc;
  size_t bo[4];
#pragma unroll
  for (int i = 0; i < 4; ++i) {
    int br = bcol + lr + i * 32;
    if (br >= Nmax) br = Nmax - 1;
    bo[i] = (size_t)br * ldb + lc;
  }
#pragma unroll
  for (int i = 0; i < 4; ++i) {
    ra[i] = *reinterpret_cast<const u32x4*>(abase + (size_t)(i * 32) * lda);
    rb[i] = *reinterpret_cast<const u32x4*>(Bt + bo[i]);
  }
  int nk = K / 64;
  for (int kt = 0; kt < nk; ++kt) {
#pragma unroll
    for (int i = 0; i < 4; ++i) {
      int q = tid + i * 256, r = q >> 3, c = (q & 7) * 8;
      *reinterpret_cast<u32x4*>(SA + r * GLD + c) = ra[i];
      *reinterpret_cast<u32x4*>(SB + r * GLD + c) = rb[i];
    }
    __syncthreads();
    if (kt + 1 < nk) {
#pragma unroll
      for (int i = 0; i < 4; ++i) {
        ra[i] = *reinterpret_cast<const u32x4*>(abase + (size_t)(i * 32) * lda + (kt + 1) * 64);
        rb[i] = *reinterpret_cast<const u32x4*>(Bt + bo[i] + (kt + 1) * 64);
      }
    }
#pragma unroll
    for (int kk = 0; kk < 2; ++kk) {
      bf16x8 At[4], Bl[4];
#pragma unroll
      for (int m = 0; m < 4; ++m) At[m] = ld8(SA + (wr * 64 + m * 16 + fr) * GLD + kk * 32 + fq * 8);
#pragma unroll
      for (int n = 0; n < 4; ++n) Bl[n] = ld8(SB + (wc * 64 + n * 16 + fr) * GLD + kk * 32 + fq * 8);
#pragma unroll
      for (int m = 0; m < 4; ++m)
#pragma unroll
        for (int n = 0; n < 4; ++n) acc[m][n] = mfma16(At[m], Bl[n], acc[m][n]);
    }
    __syncthreads();
  }
#pragma unroll
  for (int m = 0; m < 4; ++m)
#pragma unroll
    for (int n = 0; n < 4; ++n)
#pragma unroll
      for (int j = 0; j < 4; ++j) epi(brow + wr * 64 + m * 16 + fq * 4 + j, bcol + wc * 64 + n * 16 + fr, acc[m][n][j]);
}

DEV float softplusf(float v) { return fmaxf(v, 0.f) + log1pf(__expf(-fabsf(v))); }

__device__ __forceinline__ void phase_gemm_inproj(const Params& p, char* lds) {
  const u16* hx = (const u16*)(p.ws + OFF_R2);
  const u16* hc = (const u16*)(p.ws + OFF_HC);
  const u16* Wt = (const u16*)(p.ws + OFF_W_IN);
  u16* zbuf = (u16*)p.out;
  u16* xbc = (u16*)(p.ws + OFF_R1);
  float* dt = (float*)(p.ws + OFF_DT);
  u16* xbc_c = (u16*)(p.ws + OFF_XBC_C);
  float* dt_c = (float*)(p.ws + OFF_DT_C);
  const float* dtb = p.m_dt_bias;
  constexpr int NL = 256 * 41, NC = 16 * 25;
  for (int item = blockIdx.x; item < NL + NC; item += gridDim.x) {
    if (item < NL) {
      int pm = item / 41, pn = item % 41;
      gemm_tile(hx, 1024, Wt, 1024, pm * 128, pn * 128, SSM_IN, 1024, lds, [=](int m, int n, float v) {
        if (n < 2048) zbuf[(size_t)m * 2048 + n] = f2bf(v);
        else if (n < 5120) xbc[(size_t)m * 3072 + (n - 2048)] = f2bf(v);
        else if (n < 5184) dt[(size_t)m * 64 + (n - 5120)] = softplusf(v + dtb[n - 5120]);
      });
    } else {
      int it = item - NL;
      int pm = it / 25, pn = it % 25;
      gemm_tile(hc, 1024, Wt + (size_t)2048 * 1024, 1024, pm * 128, pn * 128, 3136, 1024, lds, [=](int m, int n, float v) {
        if (n < 3072) xbc_c[(size_t)m * 3072 + n] = f2bf(v);
        else if (n < 3136) dt_c[(size_t)m * 64 + (n - 3072)] = softplusf(v + dtb[n - 3072]);
      });
    }
  }
}

__device__ __forceinline__ void phase_conv(const Params& p) {
  const u16* xbc = (const u16*)(p.ws + OFF_R1);
  u16* xc = (u16*)(p.ws + OFF_R2);
  const u16* xbc_c = (const u16*)(p.ws + OFF_XBC_C);
  u16* xc_c = (u16*)(p.ws + OFF_XC_C);
  const float* cw = p.m_conv_w;
  const float* cb = p.m_conv_b;
  size_t nl = (size_t)NT * 384, ncx = (size_t)NTC * 384;
  for (size_t e = (size_t)blockIdx.x * 256 + threadIdx.x; e < nl + ncx; e += (size_t)gridDim.x * 256) {
    bool isc = e >= nl;
    size_t ee = isc ? e - nl : e;
    int tok = (int)(ee / 384), ch = (int)(ee % 384) * 8;
    float acc[8];
#pragma unroll
    for (int k = 0; k < 8; ++k) acc[k] = cb[ch + k];
    if (!isc) {
      int b = tok >> 12, l = tok & 4095, r = l >> 6, c = l & 63;
#pragma unroll
      for (int i = 0; i < 3; ++i) {
        int rr = r + i - 1;
        if (rr < 0 || rr > 63) continue;
#pragma unroll
        for (int j = 0; j < 3; ++j) {
          int cc = c + j - 1;
          if (cc < 0 || cc > 63) continue;
          uint4 v = *reinterpret_cast<const uint4*>(xbc + ((size_t)(b * 4096 + rr * 64 + cc)) * 3072 + ch);
          const float* w = cw + (i * 3 + j) * 3072 + ch;
          float4 w0 = *reinterpret_cast<const float4*>(w), w1 = *reinterpret_cast<const float4*>(w + 4);
          acc[0] += bflo(v.x) * w0.x; acc[1] += bfhi(v.x) * w0.y; acc[2] += bflo(v.y) * w0.z; acc[3] += bfhi(v.y) * w0.w;
          acc[4] += bflo(v.z) * w1.x; acc[5] += bfhi(v.z) * w1.y; acc[6] += bflo(v.w) * w1.z; acc[7] += bfhi(v.w) * w1.w;
        }
      }
    } else {
      int b = tok >> 8, c = tok & 255;
#pragma unroll
      for (int j = 0; j < 3; ++j) {
        int cc = c + j - 1;
        if (cc < 0 || cc > 255) continue;
        uint4 v = *reinterpret_cast<const uint4*>(xbc_c + ((size_t)(b * 256 + cc)) * 3072 + ch);
        const float* w = cw + (3 + j) * 3072 + ch;
        float4 w0 = *reinterpret_cast<const float4*>(w), w1 = *reinterpret_cast<const float4*>(w + 4);
        acc[0] += bflo(v.x) * w0.x; acc[1] += bfhi(v.x) * w0.y; acc[2] += bflo(v.y) * w0.z; acc[3] += bfhi(v.y) * w0.w;
        acc[4] += bflo(v.z) * w1.x; acc[5] += bfhi(v.z) * w1.y; acc[6] += bflo(v.w) * w1.z; acc[7] += bfhi(v.w) * w1.w;
      }
    }
    uint4 o;
    o.x = pack2(siluf(acc[0]), siluf(acc[1]));
    o.y = pack2(siluf(acc[2]), siluf(acc[3]));
    o.z = pack2(siluf(acc[4]), siluf(acc[5]));
    o.w = pack2(siluf(acc[6]), siluf(acc[7]));
    u16* dst = isc ? xc_c : xc;
    *reinterpret_cast<uint4*>(dst + (size_t)tok * 3072 + ch) = o;
  }
}

constexpr int SLD = 136;
__device__ __forceinline__ void phase_ssd(const Params& p, char* lds) {
  u16* xsT = (u16*)lds;
  u16* stb = xsT + 64 * SLD;
  u16* Mb = stb + 64 * SLD;
  float* cum = (float*)(Mb + 128 * SLD);
  float* dtv = cum + 128;
  float* asrc = dtv + 128;
  const u16* xc = (const u16*)(p.ws + OFF_R2);
  const u16* xc_c = (const u16*)(p.ws + OFF_XC_C);
  const float* dt = (const float*)(p.ws + OFF_DT);
  const float* dt_c = (const float*)(p.ws + OFF_DT_C);
  u16* y = (u16*)(p.ws + OFF_R1);
  int tid = threadIdx.x, w = tid >> 6, lane = tid & 63, fr = lane & 15, fq = lane >> 4;
  for (int item = blockIdx.x; item < 256; item += gridDim.x) {
    int b = item >> 5, h = item & 31, g = h >> 3;
    float dsk = p.m_d[h];
    for (int dir = 0; dir < 2; ++dir) {
      float a_neg = -__expf(p.m_a_log[dir * 32 + h]);
      f32x4 acc_s[8];
#pragma unroll
      for (int n = 0; n < 8; ++n) acc_s[n] = f32x4{0.f, 0.f, 0.f, 0.f};
      for (int step = 0; step < 34; ++step) {
        bool isctx = step < 2;
        int cidx = isctx ? step : step - 2;
        if (dir) cidx = (isctx ? 1 : 31) - cidx;
        size_t tok0 = isctx ? (size_t)(b * 256 + cidx * 128) : (size_t)(b * 4096 + cidx * 128);
        const u16* src = (isctx ? xc_c : xc) + tok0 * 3072;
        const float* dts = (isctx ? dt_c : dt) + tok0 * 64;
        if (tid < 128) {
          float d = dts[tid * 64 + dir * 32 + h];
          dtv[tid] = d;
          asrc[tid] = d * a_neg;
        }
#pragma unroll
        for (int i = 0; i < 4; ++i) {
          int idx = tid + i * 256, l = idx >> 3, pc = (idx & 7) * 8;
          uint4 v = *reinterpret_cast<const uint4*>(src + (size_t)l * 3072 + h * 64 + pc);
          xsT[(pc + 0) * SLD + l] = (u16)(v.x & 0xffff); xsT[(pc + 1) * SLD + l] = (u16)(v.x >> 16);
          xsT[(pc + 2) * SLD + l] = (u16)(v.y & 0xffff); xsT[(pc + 3) * SLD + l] = (u16)(v.y >> 16);
          xsT[(pc + 4) * SLD + l] = (u16)(v.z & 0xffff); xsT[(pc + 5) * SLD + l] = (u16)(v.z >> 16);
          xsT[(pc + 6) * SLD + l] = (u16)(v.w & 0xffff); xsT[(pc + 7) * SLD + l] = (u16)(v.w >> 16);
        }
        __syncthreads();
        if (tid < 128) {
          float s = 0.f;
          if (!dir) { for (int j = 0; j <= tid; ++j) s += asrc[j]; }
          else { for (int j = tid; j < 128; ++j) s += asrc[j]; }
          cum[tid] = s;
        }
        __syncthreads();
        float total = dir ? cum[0] : cum[127];
        if (!isctx) {
          bf16x8 Cf[2][4];
#pragma unroll
          for (int mt = 0; mt < 2; ++mt)
#pragma unroll
            for (int kk = 0; kk < 4; ++kk) Cf[mt][kk] = ld8(src + (size_t)(w * 32 + mt * 16 + fr) * 3072 + 2560 + g * 128 + kk * 32 + fq * 8);
          float cl[2][4];
#pragma unroll
          for (int mt = 0; mt < 2; ++mt)
#pragma unroll
            for (int j = 0; j < 4; ++j) cl[mt][j] = cum[w * 32 + mt * 16 + fq * 4 + j];
#pragma unroll 2
          for (int nt = 0; nt < 8; ++nt) {
            int s = nt * 16 + fr;
            bool need0 = dir ? (nt >= w * 2) : (nt <= w * 2);
            bool need1 = dir ? (nt >= w * 2 + 1) : (nt <= w * 2 + 1);
            f32x4 a0 = f32x4{0.f, 0.f, 0.f, 0.f}, a1 = f32x4{0.f, 0.f, 0.f, 0.f};
            if (need0 || need1) {
#pragma unroll
              for (int kk = 0; kk < 4; ++kk) {
                bf16x8 Bf = ld8(src + (size_t)s * 3072 + 2048 + g * 128 + kk * 32 + fq * 8);
                a0 = mfma16(Cf[0][kk], Bf, a0);
                a1 = mfma16(Cf[1][kk], Bf, a1);
              }
            }
            float cs = cum[s], ds = dtv[s];
#pragma unroll
            for (int j = 0; j < 4; ++j) {
              int l0 = w * 32 + fq * 4 + j, l1 = l0 + 16;
              bool ok0 = dir ? (s >= l0) : (s <= l0);
              bool ok1 = dir ? (s >= l1) : (s <= l1);
              float v0 = ok0 ? a0[j] * __expf(cl[0][j] - cs) * ds : 0.f;
              float v1 = ok1 ? a1[j] * __expf(cl[1][j] - cs) * ds : 0.f;
              Mb[l0 * SLD + s] = f2bf(v0);
              Mb[l1 * SLD + s] = f2bf(v1);
            }
          }
          __syncthreads();
          f32x4 ya[2][4];
#pragma unroll
          for (int mt = 0; mt < 2; ++mt)
#pragma unroll
            for (int nt = 0; nt < 4; ++nt) ya[mt][nt] = f32x4{0.f, 0.f, 0.f, 0.f};
#pragma unroll
          for (int kk = 0; kk < 4; ++kk)
#pragma unroll
            for (int nt = 0; nt < 4; ++nt) {
              bf16x8 Sf = ld8(stb + (nt * 16 + fr) * SLD + kk * 32 + fq * 8);
              ya[0][nt] = mfma16(Cf[0][kk], Sf, ya[0][nt]);
              ya[1][nt] = mfma16(Cf[1][kk], Sf, ya[1][nt]);
            }
#pragma unroll
          for (int mt = 0; mt < 2; ++mt)
#pragma unroll
            for (int j = 0; j < 4; ++j) {
              float e = __expf(cl[mt][j]);
#pragma unroll
              for (int nt = 0; nt < 4; ++nt) ya[mt][nt][j] *= e;
            }
#pragma unroll
          for (int kk = 0; kk < 4; ++kk) {
            bf16x8 Mf0 = ld8(Mb + (w * 32 + fr) * SLD + kk * 32 + fq * 8);
            bf16x8 Mf1 = ld8(Mb + (w * 32 + 16 + fr) * SLD + kk * 32 + fq * 8);
#pragma unroll
            for (int nt = 0; nt < 4; ++nt) {
              bf16x8 Xf = ld8(xsT + (nt * 16 + fr) * SLD + kk * 32 + fq * 8);
              ya[0][nt] = mfma16(Mf0, Xf, ya[0][nt]);
              ya[1][nt] = mfma16(Mf1, Xf, ya[1][nt]);
            }
          }
#pragma unroll
          for (int mt = 0; mt < 2; ++mt)
#pragma unroll
            for (int nt = 0; nt < 4; ++nt)
#pragma unroll
              for (int j = 0; j < 4; ++j) {
                int l = w * 32 + mt * 16 + fq * 4 + j, pp = nt * 16 + fr;
                u16* yp = y + (tok0 + l) * 2048 + h * 64 + pp;
                float val = ya[mt][nt][j];
                if (!dir) val += bf2f(xsT[pp * SLD + l]) * dsk;
                else val += bf2f(*yp);
                *yp = f2bf(val);
              }
        }
        if (step == 33) continue;
        __syncthreads();
#pragma unroll
        for (int i = 0; i < 8; ++i) {
          int idx = tid + i * 256, l = idx >> 4, nc = (idx & 15) * 8;
          uint4 v = *reinterpret_cast<const uint4*>(src + (size_t)l * 3072 + 2048 + g * 128 + nc);
          float sc = dtv[l] * __expf(total - cum[l]);
          Mb[(nc + 0) * SLD + l] = f2bf(bflo(v.x) * sc); Mb[(nc + 1) * SLD + l] = f2bf(bfhi(v.x) * sc);
          Mb[(nc + 2) * SLD + l] = f2bf(bflo(v.y) * sc); Mb[(nc + 3) * SLD + l] = f2bf(bfhi(v.y) * sc);
          Mb[(nc + 4) * SLD + l] = f2bf(bflo(v.z) * sc); Mb[(nc + 5) * SLD + l] = f2bf(bfhi(v.z) * sc);
          Mb[(nc + 6) * SLD + l] = f2bf(bflo(v.w) * sc); Mb[(nc + 7) * SLD + l] = f2bf(bfhi(v.w) * sc);
        }
        __syncthreads();
        float cd = __expf(total);
#pragma unroll
        for (int nt = 0; nt < 8; ++nt) acc_s[nt] *= cd;
#pragma unroll
        for (int kk = 0; kk < 4; ++kk) {
          bf16x8 Af = ld8(xsT + (w * 16 + fr) * SLD + kk * 32 + fq * 8);
#pragma unroll
          for (int nt = 0; nt < 8; ++nt) {
            bf16x8 Bf = ld8(Mb + (nt * 16 + fr) * SLD + kk * 32 + fq * 8);
            acc_s[nt] = mfma16(Af, Bf, acc_s[nt]);
          }
        }
#pragma unroll
        for (int nt = 0; nt < 8; ++nt)
#pragma unroll
          for (int j = 0; j < 4; ++j) stb[(w * 16 + fq * 4 + j) * SLD + nt * 16 + fr] = f2bf(acc_s[nt][j]);
        __syncthreads();
      }
      __syncthreads();
    }
  }
}

__device__ __forceinline__ void phase_gated_norm(const Params& p) {
  u16* y = (u16*)(p.ws + OFF_R1);
  const u16* z = (const u16*)p.out;
  int lane = threadIdx.x & 63;
  int wave = blockIdx.x * 4 + (threadIdx.x >> 6), nw = gridDim.x * 4;
  for (int tok = wave; tok < NT; tok += nw) {
#pragma unroll
    for (int g = 0; g < 4; ++g) {
      int ch = g * 512 + lane * 8;
      uint4 yv = *reinterpret_cast<const uint4*>(y + (size_t)tok * 2048 + ch);
      uint4 zv = *reinterpret_cast<const uint4*>(z + (size_t)tok * 2048 + ch);
      float u[8];
      u[0] = bflo(yv.x) * siluf(bflo(zv.x)); u[1] = bfhi(yv.x) * siluf(bfhi(zv.x));
      u[2] = bflo(yv.y) * siluf(bflo(zv.y)); u[3] = bfhi(yv.y) * siluf(bfhi(zv.y));
      u[4] = bflo(yv.z) * siluf(bflo(zv.z)); u[5] = bfhi(yv.z) * siluf(bfhi(zv.z));
      u[6] = bflo(yv.w) * siluf(bflo(zv.w)); u[7] = bfhi(yv.w) * siluf(bfhi(zv.w));
      float ss = 0.f;
#pragma unroll
      for (int k = 0; k < 8; ++k) ss += u[k] * u[k];
      ss = wave_sum(ss);
      float sc = rsqrtf(ss * (1.f / 512.f) + 1e-5f);
      float4 w0 = *reinterpret_cast<const float4*>(p.m_norm_w + ch), w1 = *reinterpret_cast<const float4*>(p.m_norm_w + ch + 4);
      uint4 o;
      o.x = pack2(u[0] * sc * w0.x, u[1] * sc * w0.y);
      o.y = pack2(u[2] * sc * w0.z, u[3] * sc * w0.w);
      o.z = pack2(u[4] * sc * w1.x, u[5] * sc * w1.y);
      o.w = pack2(u[6] * sc * w1.z, u[7] * sc * w1.w);
      *reinterpret_cast<uint4*>(y + (size_t)tok * 2048 + ch) = o;
    }
  }
}

__device__ __forceinline__ void phase_gemm_resid(const u16* A, int K, const u16* Wt, const float* res, float* dst, const float* gate  , char* lds) {
  for (int item = blockIdx.x; item < 256 * 8; item += gridDim.x) {
    int pm = item >> 3, pn = item & 7;
    gemm_tile(A, K, Wt, K, pm * 128, pn * 128, 1024, K, lds, [=](int m, int n, float v) {
      int b = m >> 12;
      dst[(size_t)m * 1024 + n] = ALPHA * res[(size_t)m * 1024 + n] + gate[(size_t)b * 6144 + n] * v;
    });
  }
}
__device__ __forceinline__ void phase_gemm_bf16(const u16* A, const u16* Wt, u16* dst, int N, char* lds) {
  int nn = N / 128;
  for (int item = blockIdx.x; item < 256 * nn; item += gridDim.x) {
    int pm = item / nn, pn = item % nn;
    gemm_tile(A, 1024, Wt, 1024, pm * 128, pn * 128, N, 1024, lds, [=](int m, int n, float v) { dst[(size_t)m * N + n] = f2bf(v); });
  }
}

__device__ __forceinline__ void phase_ln_mod(float* xio, const float* g, const float* bta, const float* mod  , u16* tdst) {
  int lane = threadIdx.x & 63;
  int wave = blockIdx.x * 4 + (threadIdx.x >> 6), nw = gridDim.x * 4;
  for (int tok = wave; tok < NT; tok += nw) {
    int b = tok >> 12;
    float4 v[4];
    float s = 0.f;
#pragma unroll
    for (int i = 0; i < 4; ++i) {
      v[i] = *reinterpret_cast<const float4*>(xio + (size_t)tok * 1024 + i * 256 + lane * 4);
      s += v[i].x + v[i].y + v[i].z + v[i].w;
    }
    float mu = wave_sum(s) * (1.f / 1024.f);
    float q = 0.f;
#pragma unroll
    for (int i = 0; i < 4; ++i) {
      v[i].x -= mu; v[i].y -= mu; v[i].z -= mu; v[i].w -= mu;
      q += v[i].x * v[i].x + v[i].y * v[i].y + v[i].z * v[i].z + v[i].w * v[i].w;
    }
    float rs = rsqrtf(wave_sum(q) * (1.f / 1024.f) + 1e-5f);
    const float* m = mod + (size_t)b * 6144;
#pragma unroll
    for (int i = 0; i < 4; ++i) {
      int c = i * 256 + lane * 4;
      float4 gg = *reinterpret_cast<const float4*>(g + c), bb = *reinterpret_cast<const float4*>(bta + c);
      float4 o;
      o.x = v[i].x * rs * gg.x + bb.x; o.y = v[i].y * rs * gg.y + bb.y; o.z = v[i].z * rs * gg.z + bb.z; o.w = v[i].w * rs * gg.w + bb.w;
      *reinterpret_cast<float4*>(xio + (size_t)tok * 1024 + c) = o;
      float4 sh = *reinterpret_cast<const float4*>(m + 3072 + c), sc = *reinterpret_cast<const float4*>(m + 4096 + c);
      uint2 t;
      t.x = pack2(o.x * (1.f + sc.x) + sh.x, o.y * (1.f + sc.y) + sh.y);
      t.y = pack2(o.z * (1.f + sc.z) + sh.z, o.w * (1.f + sc.w) + sh.w);
      *reinterpret_cast<uint2*>(tdst + (size_t)tok * 1024 + c) = t;
    }
  }
}

__device__ __forceinline__ void phase_peer_topk(const u16* q, const float* k1, const float* k2, int* idxo, float* gateo, char* lds, unsigned* shash = nullptr) {
  float* S = (float*)lds;
  float* sv = S + 64 * 129;
  int* si = (int*)(sv + 64 * 16);
  float* sel_s = (float*)(si + 64 * 16);
  int* sel_e = (int*)(sel_s + 32 * 16);
  float* cs = (float*)(sel_e + 32 * 16);
  int* cc = (int*)(cs + 32 * 52);
  int tid = threadIdx.x, w = tid >> 6, lane = tid & 63, fr = lane & 15, fq = lane >> 4;
  for (int item = blockIdx.x; item < 1024 * 8; item += gridDim.x) {
    int tile = item >> 3, h = item & 7;
    int tok0 = tile * 32;
    {
      int half = w >> 1, kb = (w & 1) * 64;
      const float* kk_ = (half ? k2 : k1) + (size_t)h * 128 * 128;
      f32x4 acc[2][4];
#pragma unroll
      for (int m = 0; m < 2; ++m)
#pragma unroll
        for (int n = 0; n < 4; ++n) acc[m][n] = f32x4{0.f, 0.f, 0.f, 0.f};
#pragma unroll
      for (int ks = 0; ks < 4; ++ks) {
        bf16x8 Af[2];
#pragma unroll
        for (int m = 0; m < 2; ++m) Af[m] = ld8(q + (size_t)(tok0 + m * 16 + fr) * 2048 + h * 256 + half * 128 + ks * 32 + fq * 8);
#pragma unroll
        for (int n = 0; n < 4; ++n) {
          const float* kp = kk_ + (size_t)(kb + n * 16 + fr) * 128 + ks * 32 + fq * 8;
          float4 f0 = *reinterpret_cast<const float4*>(kp), f1 = *reinterpret_cast<const float4*>(kp + 4);
          union { bf16x8 v; unsigned u[4]; } B;
          B.u[0] = pack2(f0.x, f0.y); B.u[1] = pack2(f0.z, f0.w); B.u[2] = pack2(f1.x, f1.y); B.u[3] = pack2(f1.z, f1.w);
          acc[0][n] = mfma16(Af[0], B.v, acc[0][n]);
          acc[1][n] = mfma16(Af[1], B.v, acc[1][n]);
        }
      }
#pragma unroll
      for (int m = 0; m < 2; ++m)
#pragma unroll
        for (int n = 0; n < 4; ++n)
#pragma unroll
          for (int j = 0; j < 4; ++j) S[(half * 32 + m * 16 + fq * 4 + j) * 129 + kb + n * 16 + fr] = acc[m][n][j];
    }
    __syncthreads();
    for (int i = 0; i < 32; ++i) {
      int e = tid + i * 256, list = e >> 7, k = e & 127;
      const float* row = S + list * 129;
      float v = row[k];
      int rank = 0;
      for (int k2_ = 0; k2_ < 128; ++k2_) {
        float o = row[k2_];
        rank += (o > v || (o == v && k2_ < k)) ? 1 : 0;
      }
      if (rank < 16) { sv[list * 16 + rank] = v; si[list * 16 + rank] = k; }
    }
    __syncthreads();
    if (shash) {
      unsigned hh = 0;
      for (int i = 0; i < 4; ++i) { int e = tid + i * 256; hh = hh * 31u + __float_as_uint(sv[e]) * 7u + (unsigned)si[e]; }
      shash[(size_t)item * 256 + tid] = hh;
    }
    {
      const int c = tid, ci = c >> 4, cj = c & 15;
      if ((ci + 1) * (cj + 1) <= 16) {
        const unsigned long long PACK = 0ull | (16ull << 8) | (24ull << 16) | (29ull << 24) | (33ull << 32) | (36ull << 40) | (38ull << 48) | (40ull << 56);
        const int slot = (ci < 8 ? (int)((PACK >> (8 * ci)) & 0xFF) : 34 + ci) + cj;
#pragma unroll 1
        for (int tok = 0; tok < 32; ++tok) {
          cs[tok * 52 + slot] = sv[tok * 16 + ci] + sv[(32 + tok) * 16 + cj];
          cc[tok * 52 + slot] = c;
        }
      }
    }
    __syncthreads();
#pragma unroll 1
    for (int i = 0; i < 7; ++i) {
      int e = tid + i * 256;
      if (e < 1600) {
        int tok = e / 50, slot = e - tok * 50;
        const float* csr = cs + tok * 52;
        const int* ccr = cc + tok * 52;
        float sc_ = csr[slot];
        int c = ccr[slot];
        int rank = 0;
#pragma unroll 2
        for (int j = 0; j < 50; ++j) {
          float o = csr[j];
          int c2 = ccr[j];
          rank += (o > sc_ || (o == sc_ && c2 < c)) ? 1 : 0;
        }
        if (rank < 16) {
          sel_s[tok * 16 + rank] = sc_;
          sel_e[tok * 16 + rank] = si[tok * 16 + (c >> 4)] * 128 + si[(32 + tok) * 16 + (c & 15)];
        }
      }
    }
    __syncthreads();
    if (tid < 32) {
      float mx = sel_s[tid * 16];
      float ex[16];
      float sum = 0.f;
#pragma unroll
      for (int r = 0; r < 16; ++r) { ex[r] = __expf(sel_s[tid * 16 + r] - mx); sum += ex[r]; }
      float inv = 1.f / sum;
      size_t o = (size_t)(tok0 + tid) * 128 + h * 16;
#pragma unroll
      for (int r = 0; r < 16; ++r) { gateo[o + r] = ex[r] * inv; idxo[o + r] = sel_e[tid * 16 + r]; }
    }
    __syncthreads();
  }
}

DEV float gelu_exact(float v) { return 0.5f * v * (1.f + erff(v * 0.70710678118654752f)); }

__device__ __forceinline__ void convert_bf16(const float* src, u16* dst, size_t n) {
  size_t n8 = n >> 3;
  for (size_t e = (size_t)blockIdx.x * 256 + threadIdx.x; e < n8; e += (size_t)gridDim.x * 256) {
    float4 a0 = *reinterpret_cast<const float4*>(src + e * 8), a1 = *reinterpret_cast<const float4*>(src + e * 8 + 4);
    uint4 o;
    o.x = pack2(a0.x, a0.y); o.y = pack2(a0.z, a0.w); o.z = pack2(a1.x, a1.y); o.w = pack2(a1.z, a1.w);
    *reinterpret_cast<uint4*>(dst + e * 8) = o;
  }
}

#define UNPK8(dst, o, v) dst[o + 0] = bflo(v.x); dst[o + 1] = bfhi(v.x); dst[o + 2] = bflo(v.y); dst[o + 3] = bfhi(v.y); \
                         dst[o + 4] = bflo(v.z); dst[o + 5] = bfhi(v.z); dst[o + 6] = bflo(v.w); dst[o + 7] = bfhi(v.w);
DEV float dot8(const uint4& u, const float* t) {
  return bflo(u.x) * t[0] + bfhi(u.x) * t[1] + bflo(u.y) * t[2] + bfhi(u.y) * t[3] + bflo(u.z) * t[4] + bfhi(u.z) * t[5] + bflo(u.w) * t[6] + bfhi(u.w) * t[7];
}
DEV void axpy8(float* acc, float a, const uint4& v) {
  acc[0] += a * bflo(v.x); acc[1] += a * bfhi(v.x); acc[2] += a * bflo(v.y); acc[3] += a * bfhi(v.y);
  acc[4] += a * bflo(v.z); acc[5] += a * bfhi(v.z); acc[6] += a * bflo(v.w); acc[7] += a * bfhi(v.w);
}

__device__ __forceinline__ void phase_peer_gather(const u16* tin, const int* idx, const float* gate, const u16* utab, const u16* vtab, const float* xres,
                                  const float* g2  , const float* lng, const float* lnb, float* xout,
                                  const float* modnext  , u16* hxout) {
  int lane = threadIdx.x & 63;
  int wave = blockIdx.x * 4 + (threadIdx.x >> 6), nw = gridDim.x * 4;
  for (int tok = wave; tok < NT; tok += nw) {
    int b = tok >> 12;
    float t[16];
#pragma unroll
    for (int i = 0; i < 2; ++i) {
      uint4 tv = *reinterpret_cast<const uint4*>(tin + (size_t)tok * 1024 + i * 512 + lane * 8);
      UNPK8(t, i * 8, tv)
    }
    int id0 = idx[(size_t)tok * 128 + lane] & 16383, id1 = idx[(size_t)tok * 128 + 64 + lane] & 16383;
    int gt0 = __float_as_int(gate[(size_t)tok * 128 + lane]), gt1 = __float_as_int(gate[(size_t)tok * 128 + 64 + lane]);
    float acc[16];
#pragma unroll
    for (int k = 0; k < 16; ++k) acc[k] = 0.f;
#pragma unroll 1
    for (int j = 0; j < 128; j += 4) {
      int e[4];
      float g[4];
      if (j < 64) {
#pragma unroll
        for (int q = 0; q < 4; ++q) { e[q] = __builtin_amdgcn_readlane(id0, j + q); g[q] = __int_as_float(__builtin_amdgcn_readlane(gt0, j + q)); }
      } else {
#pragma unroll
        for (int q = 0; q < 4; ++q) { e[q] = __builtin_amdgcn_readlane(id1, j - 64 + q); g[q] = __int_as_float(__builtin_amdgcn_readlane(gt1, j - 64 + q)); }
      }
      uint4 U[4][2], V[4][2];
#pragma unroll
      for (int q = 0; q < 4; ++q)
#pragma unroll
        for (int i = 0; i < 2; ++i) {
          U[q][i] = *reinterpret_cast<const uint4*>(utab + (size_t)e[q] * 1024 + i * 512 + lane * 8);
          V[q][i] = *reinterpret_cast<const uint4*>(vtab + (size_t)e[q] * 1024 + i * 512 + lane * 8);
        }
      float d[4];
#pragma unroll
      for (int q = 0; q < 4; ++q) d[q] = dot8(U[q][0], t) + dot8(U[q][1], t + 8);
#pragma unroll
      for (int o = 32; o > 0; o >>= 1) {
#pragma unroll
        for (int q = 0; q < 4; ++q) d[q] += __shfl_xor(d[q], o);
      }
#pragma unroll
      for (int q = 0; q < 4; ++q) {
        float a = g[q] * gelu_exact(d[q]);
        axpy8(acc, a, V[q][0]);
        axpy8(acc + 8, a, V[q][1]);
      }
    }
    float vv[16];
    float s = 0.f;
#pragma unroll
    for (int i = 0; i < 2; ++i) {
      int c = i * 512 + lane * 8;
      float4 x0 = *reinterpret_cast<const float4*>(xres + (size_t)tok * 1024 + c), x1 = *reinterpret_cast<const float4*>(xres + (size_t)tok * 1024 + c + 4);
      float4 g0 = *reinterpret_cast<const float4*>(g2 + (size_t)b * 6144 + c), g1 = *reinterpret_cast<const float4*>(g2 + (size_t)b * 6144 + c + 4);
      vv[i * 8 + 0] = ALPHA * x0.x + g0.x * acc[i * 8 + 0]; vv[i * 8 + 1] = ALPHA * x0.y + g0.y * acc[i * 8 + 1];
      vv[i * 8 + 2] = ALPHA * x0.z + g0.z * acc[i * 8 + 2]; vv[i * 8 + 3] = ALPHA * x0.w + g0.w * acc[i * 8 + 3];
      vv[i * 8 + 4] = ALPHA * x1.x + g1.x * acc[i * 8 + 4]; vv[i * 8 + 5] = ALPHA * x1.y + g1.y * acc[i * 8 + 5];
      vv[i * 8 + 6] = ALPHA * x1.z + g1.z * acc[i * 8 + 6]; vv[i * 8 + 7] = ALPHA * x1.w + g1.w * acc[i * 8 + 7];
    }
#pragma unroll
    for (int k = 0; k < 16; ++k) s += vv[k];
    float mu = wave_sum(s) * (1.f / 1024.f);
    float qq = 0.f;
#pragma unroll
    for (int k = 0; k < 16; ++k) { vv[k] -= mu; qq += vv[k] * vv[k]; }
    float rs = rsqrtf(wave_sum(qq) * (1.f / 1024.f) + 1e-5f);
#pragma unroll
    for (int i = 0; i < 2; ++i) {
      int c = i * 512 + lane * 8;
      float4 ga = *reinterpret_cast<const float4*>(lng + c), gb = *reinterpret_cast<const float4*>(lng + c + 4);
      float4 ba = *reinterpret_cast<const float4*>(lnb + c), bb = *reinterpret_cast<const float4*>(lnb + c + 4);
      float4 o0, o1;
      o0.x = vv[i * 8 + 0] * rs * ga.x + ba.x; o0.y = vv[i * 8 + 1] * rs * ga.y + ba.y; o0.z = vv[i * 8 + 2] * rs * ga.z + ba.z; o0.w = vv[i * 8 + 3] * rs * ga.w + ba.w;
      o1.x = vv[i * 8 + 4] * rs * gb.x + bb.x; o1.y = vv[i * 8 + 5] * rs * gb.y + bb.y; o1.z = vv[i * 8 + 6] * rs * gb.z + bb.z; o1.w = vv[i * 8 + 7] * rs * gb.w + bb.w;
      *reinterpret_cast<float4*>(xout + (size_t)tok * 1024 + c) = o0;
      *reinterpret_cast<float4*>(xout + (size_t)tok * 1024 + c + 4) = o1;
      if (modnext) {
        const float* m = modnext + (size_t)b * 6144;
        float4 sh0 = *reinterpret_cast<const float4*>(m + c), sh1 = *reinterpret_cast<const float4*>(m + c + 4);
        float4 sc0 = *reinterpret_cast<const float4*>(m + 1024 + c), sc1 = *reinterpret_cast<const float4*>(m + 1024 + c + 4);
        uint4 tt;
        tt.x = pack2(o0.x * (1.f + sc0.x) + sh0.x, o0.y * (1.f + sc0.y) + sh0.y);
        tt.y = pack2(o0.z * (1.f + sc0.z) + sh0.z, o0.w * (1.f + sc0.w) + sh0.w);
        tt.z = pack2(o1.x * (1.f + sc1.x) + sh1.x, o1.y * (1.f + sc1.y) + sh1.y);
        tt.w = pack2(o1.z * (1.f + sc1.z) + sh1.z, o1.w * (1.f + sc1.w) + sh1.w);
        *reinterpret_cast<uint4*>(hxout + (size_t)tok * 1024 + c) = tt;
      }
    }
  }
}

__device__ __forceinline__ void phase_shortconv_T(const Params& p, const u16* upre, u16* x1cm, u16* x2cm, u16* vcm, char* lds) {
  u16* tile = (u16*)lds;
  int tid = threadIdx.x;
  for (int item = blockIdx.x; item < 512 * 48; item += gridDim.x) {
    int tt = item / 48, ct = item % 48;
    int tok0 = tt * 64, c0 = ct * 64;
#pragma unroll
    for (int i = 0; i < 2; ++i) {
      int q = tid + i * 256, tl = q >> 3, cg_ = (q & 7) * 8;
      int tok = tok0 + tl, l = tok & 4095, ch = c0 + cg_;
      float acc[8];
#pragma unroll
      for (int k = 0; k < 8; ++k) acc[k] = p.h_conv_b[ch + k];
#pragma unroll
      for (int j = 0; j < 3; ++j) {
        int ll = l + j - 1;
        if (ll < 0 || ll > 4095) continue;
        uint4 v = *reinterpret_cast<const uint4*>(upre + (size_t)(tok + j - 1) * 3072 + ch);
        const float* w = p.h_conv_w + j * 3072 + ch;
        float4 w0 = *reinterpret_cast<const float4*>(w), w1 = *reinterpret_cast<const float4*>(w + 4);
        acc[0] += bflo(v.x) * w0.x; acc[1] += bfhi(v.x) * w0.y; acc[2] += bflo(v.y) * w0.z; acc[3] += bfhi(v.y) * w0.w;
        acc[4] += bflo(v.z) * w1.x; acc[5] += bfhi(v.z) * w1.y; acc[6] += bflo(v.w) * w1.z; acc[7] += bfhi(v.w) * w1.w;
      }
#pragma unroll
      for (int k = 0; k < 8; ++k) tile[(cg_ + k) * 72 + tl] = f2bf(acc[k]);
    }
    __syncthreads();
    int part = c0 >> 10, d0 = c0 & 1023;
    u16* dst = part == 0 ? x1cm : (part == 1 ? x2cm : vcm);
    int b = tok0 >> 12, l0 = tok0 & 4095;
#pragma unroll
    for (int i = 0; i < 2; ++i) {
      int q = tid + i * 256, c = q >> 3, tg = (q & 7) * 8;
      uint4 v = *reinterpret_cast<const uint4*>(tile + c * 72 + tg);
      *reinterpret_cast<uint4*>(dst + ((size_t)(b * 1024 + d0 + c)) * 4096 + l0 + tg) = v;
    }
    __syncthreads();
  }
}

__device__ __forceinline__ void fft_fwd(float2* X) {
  int tid = threadIdx.x;
  for (int s = 12; s >= 0; --s) {
    int half = 1 << s;
    float inv2h = 1.f / (float)(2 * half);
#pragma unroll 4
    for (int i = 0; i < 16; ++i) {
      int j = tid + i * 256;
      int pos = j & (half - 1);
      int i0 = ((j >> s) << (s + 1)) + pos, i1 = i0 + half;
      float fr_ = (float)pos * inv2h;
      float wr = __builtin_amdgcn_cosf(fr_), wi = -__builtin_amdgcn_sinf(fr_);
      float2 a = X[i0], bq = X[i1];
      float dr = a.x - bq.x, di = a.y - bq.y;
      X[i0] = make_float2(a.x + bq.x, a.y + bq.y);
      X[i1] = make_float2(dr * wr - di * wi, dr * wi + di * wr);
    }
    __syncthreads();
  }
}
__device__ __forceinline__ void fft_inv(float2* X) {
  int tid = threadIdx.x;
  for (int s = 0; s <= 12; ++s) {
    int half = 1 << s;
    float inv2h = 1.f / (float)(2 * half);
#pragma unroll 4
    for (int i = 0; i < 16; ++i) {
      int j = tid + i * 256;
      int pos = j & (half - 1);
      int i0 = ((j >> s) << (s + 1)) + pos, i1 = i0 + half;
      float fr_ = (float)pos * inv2h;
      float wr = __builtin_amdgcn_cosf(fr_), wi = -__builtin_amdgcn_sinf(fr_);
      float2 a = X[i0], bq = X[i1];
      float br = bq.x * wr + bq.y * wi, bi = bq.y * wr - bq.x * wi;
      X[i0] = make_float2(a.x + br, a.y + bi);
      X[i1] = make_float2(a.x - br, a.y - bi);
    }
    __syncthreads();
  }
}

__device__ __forceinline__ void phase_filter_fft(const Params& p, float2* Hf, char* lds) {
  float2* X = (float2*)lds;
  float* w3s = (float*)(lds + 65536);
  float* red = w3s + 128;
  const float* hid = (const float*)(p.ws + OFF_HID);
  int tid = threadIdx.x;
  const float min_decay = -3.0701134573253945f;
  const float max_decay = -15.350567286626973f;
  for (int item = blockIdx.x; item < 2048; item += gridDim.x) {
    int o = item >> 10, d = item & 1023;
    if (tid < 128) {
      int dirr = tid >> 6, j = tid & 63;
      w3s[tid] = p.h_f_w3[(size_t)j * 4096 + (o * 2 + dirr) * 1024 + d];
    }
    __syncthreads();
    float adelta = fabsf(min_decay + (float)d * ((max_decay - min_decay) / 1023.f));
    float ss = 0.f;
#pragma unroll 1
    for (int i = 0; i < 16; ++i) {
      int t = tid + i * 256;
      const float* hr = hid + (size_t)t * 64;
      float hf = 0.f, hb = 0.f;
#pragma unroll
      for (int j4 = 0; j4 < 16; ++j4) {
        float4 hv = *reinterpret_cast<const float4*>(hr + j4 * 4);
        hf += hv.x * w3s[j4 * 4] + hv.y * w3s[j4 * 4 + 1] + hv.z * w3s[j4 * 4 + 2] + hv.w * w3s[j4 * 4 + 3];
        hb += hv.x * w3s[64 + j4 * 4] + hv.y * w3s[64 + j4 * 4 + 1] + hv.z * w3s[64 + j4 * 4 + 2] + hv.w * w3s[64 + j4 * 4 + 3];
      }
      float dec = __expf(-((float)t / 4095.f) * adelta);
      hf *= dec; hb *= dec;
      if (t == 0) {
        float v = hf + hb;
        X[0] = make_float2(v, 0.f);
        X[4096] = make_float2(0.f, 0.f);
        ss += v * v;
      } else {
        X[t] = make_float2(hf, 0.f);
        X[8192 - t] = make_float2(hb, 0.f);
        ss += hf * hf + hb * hb;
      }
    }
    ss = wave_sum(ss);
    if ((tid & 63) == 0) red[tid >> 6] = ss;
    __syncthreads();
    float tot = red[0] + red[1] + red[2] + red[3];
    float scale = rsqrtf(tot + 1e-6f) * (1.f / 8192.f);
    fft_fwd(X);
    float2* dst = Hf + (size_t)item * 8192;
#pragma unroll 4
    for (int i = 0; i < 32; ++i) {
      int k = tid + i * 256;
      float2 v = X[k];
      dst[k] = make_float2(v.x * scale, v.y * scale);
    }
    __syncthreads();
  }
}

__device__ __forceinline__ void phase_hyena_conv(const Params& p, const u16* x1cm, const u16* x2cm, const u16* vcm, const float2* Hf, u16* zzcm, char* lds) {
  float2* X = (float2*)lds;
  int tid = threadIdx.x;
  for (int item = blockIdx.x; item < 4096; item += gridDim.x) {
    int d = item >> 2, bp = item & 3;
    size_t r0 = ((size_t)((bp * 2) * 1024 + d)) * 4096, r1 = ((size_t)((bp * 2 + 1) * 1024 + d)) * 4096;
    float bias0 = p.h_bias[d], bias1 = p.h_bias[1024 + d];
#pragma unroll
    for (int i = 0; i < 2; ++i) {
      int t8 = (tid + i * 256) * 8;
      uint4 a = *reinterpret_cast<const uint4*>(vcm + r0 + t8);
      uint4 bq = *reinterpret_cast<const uint4*>(vcm + r1 + t8);
      X[t8 + 0] = make_float2(bflo(a.x), bflo(bq.x)); X[t8 + 1] = make_float2(bfhi(a.x), bfhi(bq.x));
      X[t8 + 2] = make_float2(bflo(a.y), bflo(bq.y)); X[t8 + 3] = make_float2(bfhi(a.y), bfhi(bq.y));
      X[t8 + 4] = make_float2(bflo(a.z), bflo(bq.z)); X[t8 + 5] = make_float2(bfhi(a.z), bfhi(bq.z));
      X[t8 + 6] = make_float2(bflo(a.w), bflo(bq.w)); X[t8 + 7] = make_float2(bfhi(a.w), bfhi(bq.w));
    }
    for (int i = 0; i < 16; ++i) X[4096 + tid + i * 256] = make_float2(0.f, 0.f);
    __syncthreads();
    fft_fwd(X);
    {
      const float2* H = Hf + (size_t)d * 8192;
#pragma unroll 4
      for (int i = 0; i < 32; ++i) {
        int k = tid + i * 256;
        float2 hv = H[k], xv = X[k];
        X[k] = make_float2(xv.x * hv.x - xv.y * hv.y, xv.x * hv.y + xv.y * hv.x);
      }
    }
    __syncthreads();
    fft_inv(X);
    float zz0[16], zz1[16];
#pragma unroll
    for (int i = 0; i < 2; ++i) {
      int t8 = (tid + i * 256) * 8;
      uint4 a = *reinterpret_cast<const uint4*>(vcm + r0 + t8);
      uint4 bq = *reinterpret_cast<const uint4*>(vcm + r1 + t8);
      uint4 xa = *reinterpret_cast<const uint4*>(x1cm + r0 + t8);
      uint4 xb = *reinterpret_cast<const uint4*>(x1cm + r1 + t8);
      float va[8] = {bflo(a.x), bfhi(a.x), bflo(a.y), bfhi(a.y), bflo(a.z), bfhi(a.z), bflo(a.w), bfhi(a.w)};
      float vb[8] = {bflo(bq.x), bfhi(bq.x), bflo(bq.y), bfhi(bq.y), bflo(bq.z), bfhi(bq.z), bflo(bq.w), bfhi(bq.w)};
      float fa[8] = {bflo(xa.x), bfhi(xa.x), bflo(xa.y), bfhi(xa.y), bflo(xa.z), bfhi(xa.z), bflo(xa.w), bfhi(xa.w)};
      float fb[8] = {bflo(xb.x), bfhi(xb.x), bflo(xb.y), bfhi(xb.y), bflo(xb.z), bfhi(xb.z), bflo(xb.w), bfhi(xb.w)};
#pragma unroll
      for (int e = 0; e < 8; ++e) {
        float2 cv = X[t8 + e];
        float z0 = fa[e] * (cv.x + va[e] * bias0);
        float z1 = fb[e] * (cv.y + vb[e] * bias0);
        zz0[i * 8 + e] = z0; zz1[i * 8 + e] = z1;
        X[t8 + e] = make_float2(z0, z1);
      }
    }
    for (int i = 0; i < 16; ++i) X[4096 + tid + i * 256] = make_float2(0.f, 0.f);
    __syncthreads();
    fft_fwd(X);
    {
      const float2* H = Hf + (size_t)(1024 + d) * 8192;
#pragma unroll 4
      for (int i = 0; i < 32; ++i) {
        int k = tid + i * 256;
        float2 hv = H[k], xv = X[k];
        X[k] = make_float2(xv.x * hv.x - xv.y * hv.y, xv.x * hv.y + xv.y * hv.x);
      }
    }
    __syncthreads();
    fft_inv(X);
#pragma unroll
    for (int i = 0; i < 2; ++i) {
      int t8 = (tid + i * 256) * 8;
      uint4 xa = *reinterpret_cast<const uint4*>(x2cm + r0 + t8);
      uint4 xb = *reinterpret_cast<const uint4*>(x2cm + r1 + t8);
      float fa[8] = {bflo(xa.x), bfhi(xa.x), bflo(xa.y), bfhi(xa.y), bflo(xa.z), bfhi(xa.z), bflo(xa.w), bfhi(xa.w)};
      float fb[8] = {bflo(xb.x), bfhi(xb.x), bflo(xb.y), bfhi(xb.y), bflo(xb.z), bfhi(xb.z), bflo(xb.w), bfhi(xb.w)};
      float o0[8], o1[8];
#pragma unroll
      for (int e = 0; e < 8; ++e) {
        float2 cv = X[t8 + e];
        o0[e] = fa[e] * (cv.x + zz0[i * 8 + e] * bias1);
        o1[e] = fb[e] * (cv.y + zz1[i * 8 + e] * bias1);
      }
      uint4 w0, w1;
      w0.x = pack2(o0[0], o0[1]); w0.y = pack2(o0[2], o0[3]); w0.z = pack2(o0[4], o0[5]); w0.w = pack2(o0[6], o0[7]);
      w1.x = pack2(o1[0], o1[1]); w1.y = pack2(o1[2], o1[3]); w1.z = pack2(o1[4], o1[5]); w1.w = pack2(o1[6], o1[7]);
      *reinterpret_cast<uint4*>(zzcm + r0 + t8) = w0;
      *reinterpret_cast<uint4*>(zzcm + r1 + t8) = w1;
    }
    __syncthreads();
  }
}

__device__ __forceinline__ void phase_transpose_back(const u16* src, u16* dst, char* lds) {
  u16* tile = (u16*)lds;
  int tid = threadIdx.x;
  for (int item = blockIdx.x; item < 8 * 16 * 64; item += gridDim.x) {
    int b = item >> 10, dt_ = (item >> 6) & 15, tt = item & 63;
#pragma unroll
    for (int i = 0; i < 2; ++i) {
      int q = tid + i * 256, dd = q >> 3, tg = (q & 7) * 8;
      uint4 v = *reinterpret_cast<const uint4*>(src + ((size_t)(b * 1024 + dt_ * 64 + dd)) * 4096 + tt * 64 + tg);
      tile[(tg + 0) * 72 + dd] = (u16)(v.x & 0xffff); tile[(tg + 1) * 72 + dd] = (u16)(v.x >> 16);
      tile[(tg + 2) * 72 + dd] = (u16)(v.y & 0xffff); tile[(tg + 3) * 72 + dd] = (u16)(v.y >> 16);
      tile[(tg + 4) * 72 + dd] = (u16)(v.z & 0xffff); tile[(tg + 5) * 72 + dd] = (u16)(v.z >> 16);
      tile[(tg + 6) * 72 + dd] = (u16)(v.w & 0xffff); tile[(tg + 7) * 72 + dd] = (u16)(v.w >> 16);
    }
    __syncthreads();
#pragma unroll
    for (int i = 0; i < 2; ++i) {
      int q = tid + i * 256, tl = q >> 3, dg = (q & 7) * 8;
      uint4 v = *reinterpret_cast<const uint4*>(tile + tl * 72 + dg);
      *reinterpret_cast<uint4*>(dst + ((size_t)(b * 4096 + tt * 64 + tl)) * 1024 + dt_ * 64 + dg) = v;
    }
    __syncthreads();
  }
}

DEV void probe_rows(const unsigned* buf, int wpr, float* out) {
  int lane = threadIdx.x & 63;
  int wave = blockIdx.x * 4 + (threadIdx.x >> 6), nw = gridDim.x * 4;
  for (int row = wave; row < NT; row += nw) {
    unsigned h = 0;
    for (int w = lane; w < wpr; w += 64) { unsigned v = buf[(size_t)row * wpr + w]; h += (v ^ (v >> 15)) * (2654435761u + 2u * (unsigned)w); }
#pragma unroll
    for (int o = 32; o > 0; o >>= 1) h += (unsigned)__shfl_xor((int)h, o);
    float v = (float)((h >> 8) & 0xFFFFu) * (1.f / 65536.f);
    float4 vv = make_float4(v, v, v, v);
#pragma unroll
    for (int i = 0; i < 4; ++i) *reinterpret_cast<float4*>(out + (size_t)row * 1024 + i * 256 + lane * 4) = vv;
  }
}
#define PROBE_AT(id, bufexpr, wpr) if (PROBE == id) { Params pq = fetch_params(); probe_rows((const unsigned*)(bufexpr), wpr, pq.out); return; }

DEV void gsync2(unsigned k) {
  asm volatile("s_waitcnt vmcnt(0)" ::: "memory");
  __syncthreads();
  if (threadIdx.x == 0) {
    unsigned* bar = (unsigned*)((char*)karg<33>() + OFF_BAR);
    __builtin_amdgcn_fence(__ATOMIC_RELEASE, "agent");
    asm volatile("s_waitcnt vmcnt(0)" ::: "memory");
    __hip_atomic_fetch_add(bar, 1u, __ATOMIC_RELAXED, __HIP_MEMORY_SCOPE_AGENT);
    unsigned target = k * gridDim.x;
    while (__hip_atomic_load(bar, __ATOMIC_RELAXED, __HIP_MEMORY_SCOPE_AGENT) < target) __builtin_amdgcn_s_sleep(1);
    __builtin_amdgcn_fence(__ATOMIC_ACQUIRE, "agent");
    asm volatile("s_waitcnt vmcnt(0)" ::: "memory");
  }
  __syncthreads();
}

DEV void gsync(cg::grid_group& grid) {
  asm volatile("s_waitcnt vmcnt(0)" ::: "memory");
  grid.sync();
  if (threadIdx.x == 0) {
    __builtin_amdgcn_fence(__ATOMIC_ACQUIRE, "agent");
    asm volatile("s_waitcnt vmcnt(0)" ::: "memory");
  }
  __syncthreads();
}

template <int layer>
__device__ __forceinline__ void peer_block(unsigned& nbar, char* lds) {
  {
    Params p = fetch_params();
    char* ws = p.ws; char* R1 = ws + OFF_R1; char* R2 = ws + OFF_R2; char* DO = (char*)p.out;
    const float* modl = (float*)(ws + OFF_MOD) + (size_t)layer * 9 * 6144;
    const u16* A = layer == 0 ? (const u16*)R1 : (const u16*)DO;
    const int K = layer == 0 ? 2048 : 1024;
    const u16* Wt = (const u16*)(ws + (layer == 0 ? OFF_W_OUT : OFF_W_HOUT));
    const float* res = layer == 0 ? p.x : (const float*)R2;
    phase_gemm_resid(A, K, Wt, res, (float*)R2, modl + 2048, lds);
  }
  gsync2(++nbar);
  PROBE_AT(5 + layer * 10, pq.ws + OFF_R2, 1024)
  {
    Params p = fetch_params();
    char* ws = p.ws; char* R1 = ws + OFF_R1; char* R2 = ws + OFF_R2; char* DO = (char*)p.out;
    const float* modl = (float*)(ws + OFF_MOD) + (size_t)layer * 9 * 6144;
    u16* tpeer = layer == 0 ? (u16*)DO : (u16*)(R1 + 128 * MiB);
    phase_ln_mod((float*)R2, p.ln_g + layer * 2048, p.ln_b + layer * 2048, modl, tpeer);
    if (layer == 1) {
      convert_bf16(p.p_u + (size_t)16384 * 1024, (u16*)R1, (size_t)16384 * 1024);
      convert_bf16(p.p_v + (size_t)16384 * 1024, (u16*)R1 + (size_t)16384 * 1024, (size_t)16384 * 1024);
    }
  }
  gsync2(++nbar);
  {
    Params p = fetch_params();
    char* ws = p.ws; char* R1 = ws + OFF_R1; char* DO = (char*)p.out;
    u16* tpeer = layer == 0 ? (u16*)DO : (u16*)(R1 + 128 * MiB);
    phase_gemm_bf16(tpeer, (const u16*)(ws + OFF_W_Q) + (size_t)layer * 2048 * 1024, layer == 0 ? (u16*)R1 : (u16*)DO, 2048, lds);
  }
  gsync2(++nbar);
  PROBE_AT(7 + layer * 10, pq.ws + OFF_R1, 1024)
  {
    Params p = fetch_params();
    char* ws = p.ws; char* R1 = ws + OFF_R1; char* R2 = ws + OFF_R2;
    int* idxb = (int*)(R2 + 128 * MiB);
    float* gateb = (float*)(R2 + 144 * MiB);
    phase_peer_topk(layer == 0 ? (const u16*)R1 : (const u16*)p.out, p.p_k1 + (size_t)layer * 8 * 128 * 128, p.p_k2 + (size_t)layer * 8 * 128 * 128, idxb, gateb, lds);
  }
  gsync2(++nbar);
  {
    Params p = fetch_params();
    char* ws = p.ws; char* R1 = ws + OFF_R1; char* R2 = ws + OFF_R2; char* DO = (char*)p.out;
    float* mod = (float*)(ws + OFF_MOD);
    const float* modl = mod + (size_t)layer * 9 * 6144;
    int* idxb = (int*)(R2 + 128 * MiB);
    float* gateb = (float*)(R2 + 144 * MiB);
    u16* tpeer = layer == 0 ? (u16*)DO : (u16*)(R1 + 128 * MiB);
    const u16* utb = (const u16*)(layer == 0 ? R1 + 128 * MiB : R1);
    phase_peer_gather(tpeer, idxb, gateb, utb, utb + (size_t)16384 * 1024, (const float*)R2,
                      modl + 5120, p.ln_g + layer * 2048 + 1024, p.ln_b + layer * 2048 + 1024, layer == 0 ? (float*)R2 : p.out,
                      layer == 0 ? mod + 9 * 6144 : nullptr, (u16*)(DO + 64 * MiB));
  }
}

__global__ void __launch_bounds__(256, 2) fwd_megakernel(Params p_unused) {
  __shared__ __attribute__((aligned(16))) char lds[LDS_BYTES];
  cg::grid_group grid = cg::this_grid();
  unsigned nbar = 0;
  { Params p = fetch_params(); phase_prologue(p, lds); }
  gsync(grid);
  {
    Params p = fetch_params();
    float* mod = (float*)(p.ws + OFF_MOD);
    modulate_rows(p.x, (u16*)(p.ws + OFF_R2), NT, SEQ, mod, 0, 1024, false);
    modulate_rows(p.ctx, (u16*)(p.ws + OFF_HC), NTC, CTXL, mod, 0, 1024, true);
  }
  gsync2(++nbar);
  { Params p = fetch_params(); phase_gemm_inproj(p, lds); }
  gsync2(++nbar);
  PROBE_AT(1, pq.ws + OFF_R1, 1536)
  { Params p = fetch_params(); phase_conv(p); }
  gsync2(++nbar);
  PROBE_AT(2, pq.ws + OFF_R2, 1536)
  { Params p = fetch_params(); phase_ssd(p, lds); }
  gsync2(++nbar);
  PROBE_AT(3, pq.ws + OFF_R1, 1024)
  {
    Params p = fetch_params(); phase_gated_norm(p);
    u16* tb = (u16*)(p.ws + OFF_R1 + 128 * MiB);
    convert_bf16(p.p_u, tb, (size_t)16384 * 1024);
    convert_bf16(p.p_v, tb + (size_t)16384 * 1024, (size_t)16384 * 1024);
  }
  gsync2(++nbar);
  PROBE_AT(4, pq.ws + OFF_R1, 1024)
  peer_block<0>(nbar, lds);
  if ((PROBE >= 5 && PROBE <= 7) || PROBE == 99) return;
  gsync2(++nbar);
  {
    Params p = fetch_params();
    phase_gemm_bf16((const u16*)((char*)p.out + 64 * MiB), (const u16*)(p.ws + OFF_W_HIN), (u16*)(p.ws + OFF_R1), 3072, lds);
  }
  gsync2(++nbar);
  PROBE_AT(8, pq.ws + OFF_R2, 1024)
  PROBE_AT(11, pq.ws + OFF_R1, 1536)
  {
    Params p = fetch_params();
    phase_shortconv_T(p, (const u16*)(p.ws + OFF_R1), (u16*)(p.ws + OFF_R2 + 128 * MiB), (u16*)p.out, (u16*)((char*)p.out + 64 * MiB), lds);
  }
  gsync2(++nbar);
  PROBE_AT(12, pq.ws + OFF_R2 + 128 * MiB, 512)
  { Params p = fetch_params(); phase_filter_fft(p, (float2*)(p.ws + OFF_R1), lds); }
  gsync2(++nbar);
  PROBE_AT(13, pq.ws + OFF_R1, 1024)
  {
    Params p = fetch_params();
    phase_hyena_conv(p, (const u16*)(p.ws + OFF_R2 + 128 * MiB), (const u16*)p.out, (const u16*)((char*)p.out + 64 * MiB),
                     (const float2*)(p.ws + OFF_R1), (u16*)(p.ws + OFF_R1 + 128 * MiB), lds);
  }
  gsync2(++nbar);
  PROBE_AT(14, pq.ws + OFF_R1 + 128 * MiB, 512)
  { Params p = fetch_params(); phase_transpose_back((const u16*)(p.ws + OFF_R1 + 128 * MiB), (u16*)p.out, lds); }
  gsync2(++nbar);
  peer_block<1>(nbar, lds);
}

extern "C" void kernel_launch(void* const* d_in, const int* in_sizes, int n_in, void* d_out, int out_size, void* d_ws, size_t ws_size,
                              hipStream_t stream) {
  static int grid_blocks = 0;
  if (!grid_blocks) {
    int dev = 0, cus = 0, per_cu = 0;
    hipGetDevice(&dev);
    hipDeviceGetAttribute(&cus, hipDeviceAttributeMultiprocessorCount, dev);
    hipOccupancyMaxActiveBlocksPerMultiprocessor(&per_cu, fwd_megakernel, 256, 0);
    if (per_cu > 2) per_cu = 2;
    if (per_cu < 1) per_cu = 1;
    grid_blocks = cus * per_cu;
  }
  Params p{};
  const float** pp = reinterpret_cast<const float**>(&p);
  for (int i = 0; i < 32; ++i) pp[i] = (const float*)d_in[i];
  p.out = (float*)d_out;
  p.ws = (char*)d_ws;
  if (ws_size < WS_TOTAL) fprintf(stderr, "workspace too small: %zu < %zu\n", ws_size, (size_t)WS_TOTAL);
  (void)hipMemsetAsync((char*)d_ws + OFF_BAR, 0, 4096, stream);
  void* args[] = {&p};
  hipError_t e = hipLaunchCooperativeKernel((void*)fwd_megakernel, dim3(grid_blocks), dim3(256), args, 0, stream);
  if (e != hipSuccess) fprintf(stderr, "cooperative launch failed: %s (grid %d)\n", hipGetErrorString(e), grid_blocks);
}
```

```cpp
#define PROBE 0
#define DUP 0
#include <hip/hip_runtime.h>
#include <hip/hip_bf16.h>
#include <hip/hip_cooperative_groups.h>
#include <cstdio>
namespace cg = cooperative_groups;

typedef unsigned short u16;
using bf16x8 = __attribute__((ext_vector_type(8))) short;
using f32x4 = __attribute__((ext_vector_type(4))) float;
using u32x4 = __attribute__((ext_vector_type(4))) unsigned;

#define DEV __device__ __forceinline__

constexpr int NB = 8, SEQ = 4096, DM = 1024, NT = NB * SEQ;
constexpr int CTXL = 256, NTC = NB * CTXL;
constexpr int SSM_IN = 5184, CONVD = 3072, SSM_INNER = 2048;
constexpr float ALPHA = 1.41421356237f;
constexpr int LDS_BYTES = 71168;

constexpr size_t MiB = 1ull << 20;
constexpr size_t OFF_W_IN = 0;
constexpr size_t OFF_W_OUT = OFF_W_IN + (size_t)5184 * 1024 * 2;
constexpr size_t OFF_W_HIN = OFF_W_OUT + (size_t)1024 * 2048 * 2;
constexpr size_t OFF_W_HOUT = OFF_W_HIN + (size_t)3072 * 1024 * 2;
constexpr size_t OFF_W_Q = OFF_W_HOUT + (size_t)1024 * 1024 * 2;
constexpr size_t OFF_MOD = OFF_W_Q + (size_t)2 * 2048 * 1024 * 2;
constexpr size_t OFF_HID = OFF_MOD + 512 * 1024;
constexpr size_t OFF_DT = OFF_HID + MiB;
constexpr size_t OFF_HC = OFF_DT + 8 * MiB;
constexpr size_t OFF_XBC_C = OFF_HC + 4 * MiB;
constexpr size_t OFF_XC_C = OFF_XBC_C + 12 * MiB;
constexpr size_t OFF_DT_C = OFF_XC_C + 12 * MiB;
constexpr size_t OFF_R1 = OFF_DT_C + MiB;
constexpr size_t OFF_R2 = OFF_R1 + 192 * MiB;
constexpr size_t OFF_BAR = OFF_R2 + 192 * MiB;
constexpr size_t OFF_KEYS = OFF_BAR + 4096;
constexpr size_t WS_TOTAL = OFF_KEYS + MiB;

struct Params {
  const float *x, *c, *ctx, *c_ctx, *ada_w, *ada_b, *ln_g, *ln_b;
  const float *m_w_in, *m_conv_w, *m_conv_b, *m_a_log, *m_dt_bias, *m_d, *m_norm_w, *m_w_out;
  const float *h_w_in, *h_conv_w, *h_conv_b, *h_f_w1, *h_f_b1, *h_f_w2, *h_f_b2, *h_f_w3, *h_freq, *h_bias, *h_w_out;
  const float *p_wq, *p_k1, *p_k2, *p_u, *p_v;
  float* out;
  char* ws;
};

DEV u16 f2bf(float f) {
  unsigned u = __float_as_uint(f);
  u += 0x7fffu + ((u >> 16) & 1u);
  return (u16)(u >> 16);
}
DEV float bf2f(u16 h) { return __uint_as_float(((unsigned)h) << 16); }
DEV float bflo(unsigned w) { return __uint_as_float(w << 16); }
DEV float bfhi(unsigned w) { return __uint_as_float(w & 0xffff0000u); }
DEV unsigned pack2(float a, float b) { return (unsigned)f2bf(a) | ((unsigned)f2bf(b) << 16); }
DEV float wave_sum(float v) {
#pragma unroll
  for (int o = 32; o > 0; o >>= 1) v += __shfl_xor(v, o);
  return v;
}
DEV unsigned ordkey(float f) { unsigned u = __float_as_uint(f); return (u & 0x80000000u) ? ~u : (u | 0x80000000u); }
DEV float siluf(float v) { return v / (1.f + __expf(-v)); }
DEV f32x4 mfma16(bf16x8 a, bf16x8 b, f32x4 c) { return __builtin_amdgcn_mfma_f32_16x16x32_bf16(a, b, c, 0, 0, 0); }
DEV bf16x8 ld8(const u16* p) { return *reinterpret_cast<const bf16x8*>(p); }

template <int I>
DEV const float* karg() {
  unsigned long long v;
  asm volatile("s_load_dwordx2 %0, %1, %2\n\ts_waitcnt lgkmcnt(0)" : "=s"(v) : "s"(__builtin_amdgcn_kernarg_segment_ptr()), "n"(I * 8));
  return (const float*)(const __attribute__((address_space(1))) float*)v;
}
DEV Params fetch_params() {
  Params q;
  q.x = karg<0>(); q.c = karg<1>(); q.ctx = karg<2>(); q.c_ctx = karg<3>(); q.ada_w = karg<4>(); q.ada_b = karg<5>(); q.ln_g = karg<6>(); q.ln_b = karg<7>();
  q.m_w_in = karg<8>(); q.m_conv_w = karg<9>(); q.m_conv_b = karg<10>(); q.m_a_log = karg<11>(); q.m_dt_bias = karg<12>(); q.m_d = karg<13>();
  q.m_norm_w = karg<14>(); q.m_w_out = karg<15>();
  q.h_w_in = karg<16>(); q.h_conv_w = karg<17>(); q.h_conv_b = karg<18>(); q.h_f_w1 = karg<19>(); q.h_f_b1 = karg<20>(); q.h_f_w2 = karg<21>();
  q.h_f_b2 = karg<22>(); q.h_f_w3 = karg<23>(); q.h_freq = karg<24>(); q.h_bias = karg<25>(); q.h_w_out = karg<26>();
  q.p_wq = karg<27>(); q.p_k1 = karg<28>(); q.p_k2 = karg<29>(); q.p_u = karg<30>(); q.p_v = karg<31>();
  q.out = (float*)karg<32>(); q.ws = (char*)karg<33>();
  return q;
}

__device__ __forceinline__ void transpose_w_tile(const float* src, int srcld, int K, int N, u16* dst, int item, char* lds) {
  float* tile = (float*)lds;
  int ntn = N / 64;
  int kt = item / ntn, nt = item % ntn;
  int tid = threadIdx.x;
#pragma unroll
  for (int i = 0; i < 4; ++i) {
    int r = (tid >> 4) + i * 16, c4 = (tid & 15) * 4;
    float4 v = *reinterpret_cast<const float4*>(src + (size_t)(kt * 64 + r) * srcld + nt * 64 + c4);
    tile[r * 65 + c4 + 0] = v.x; tile[r * 65 + c4 + 1] = v.y; tile[r * 65 + c4 + 2] = v.z; tile[r * 65 + c4 + 3] = v.w;
  }
  __syncthreads();
#pragma unroll
  for (int i = 0; i < 2; ++i) {
    int n = (tid >> 3) + i * 32, k8 = (tid & 7) * 8;
    uint4 o;
    o.x = pack2(tile[(k8 + 0) * 65 + n], tile[(k8 + 1) * 65 + n]);
    o.y = pack2(tile[(k8 + 2) * 65 + n], tile[(k8 + 3) * 65 + n]);
    o.z = pack2(tile[(k8 + 4) * 65 + n], tile[(k8 + 5) * 65 + n]);
    o.w = pack2(tile[(k8 + 6) * 65 + n], tile[(k8 + 7) * 65 + n]);
    *reinterpret_cast<uint4*>(dst + (size_t)(nt * 64 + n) * K + kt * 64 + k8) = o;
  }
  __syncthreads();
}

__device__ __forceinline__ void ada_item(const Params& p, int item, char* lds) {
  float* red = (float*)lds;
  int layer = item / 96, cg_ = item % 96;
  int tid = threadIdx.x, kq = tid >> 6, col = cg_ * 64 + (tid & 63);
  float acc[9];
#pragma unroll
  for (int r = 0; r < 9; ++r) acc[r] = 0.f;
  const float* w = p.ada_w + (size_t)layer * 1024 * 6144 + col;
#pragma unroll 4
  for (int k = kq * 256; k < kq * 256 + 256; ++k) {
    float wv = w[(size_t)k * 6144];
#pragma unroll
    for (int r = 0; r < 8; ++r) acc[r] += siluf(p.c[r * 1024 + k]) * wv;
    acc[8] += siluf(p.c_ctx[k]) * wv;
  }
#pragma unroll
  for (int r = 0; r < 9; ++r) red[(kq * 9 + r) * 64 + (tid & 63)] = acc[r];
  __syncthreads();
  if (tid < 64) {
    float* mod = (float*)(p.ws + OFF_MOD);
    float bias = p.ada_b[layer * 6144 + col];
#pragma unroll
    for (int r = 0; r < 9; ++r) {
      float s = red[(0 * 9 + r) * 64 + tid] + red[(1 * 9 + r) * 64 + tid] + red[(2 * 9 + r) * 64 + tid] + red[(3 * 9 + r) * 64 + tid];
      mod[((size_t)layer * 9 + r) * 6144 + col] = s + bias;
    }
  }
  __syncthreads();
}

__device__ __forceinline__ void hyena_mlp_item(const Params& p, int item, char* lds) {
  float* zb = (float*)lds;
  float* h1 = zb + 256;
  float* h2 = h1 + 256;
  int tid = threadIdx.x, ti = tid >> 6, j = tid & 63;
  int t = item * 4 + ti;
  const float L = 4096.f;
  if (j < 33) {
    float v;
    if (j == 0) v = (float)t / 4095.f;
    else {
      int k = (j - 1) & 15;
      float fb = 1e-4f + (float)k * ((15.f - 1e-4f) / 15.f);
      float ang = 6.283185307179586f * (float)t / L;
      float a = fb * ang;
      v = (j <= 16) ? cosf(a) : -sinf(a);
    }
    zb[ti * 64 + j] = v;
  }
  __syncthreads();
  float fr = p.h_freq[j];
  float s = p.h_f_b1[j];
#pragma unroll 3
  for (int i = 0; i < 33; ++i) s += zb[ti * 64 + i] * p.h_f_w1[i * 64 + j];
  h1[ti * 64 + j] = sinf(fr * s);
  __syncthreads();
  s = p.h_f_b2[j];
#pragma unroll 8
  for (int i = 0; i < 64; ++i) s += h1[ti * 64 + i] * p.h_f_w2[i * 64 + j];
  h2[ti * 64 + j] = sinf(fr * s);
  __syncthreads();
  s = p.h_f_b2[64 + j];
#pragma unroll 8
  for (int i = 0; i < 64; ++i) s += h2[ti * 64 + i] * p.h_f_w2[4096 + i * 64 + j];
  float* hid = (float*)(p.ws + OFF_HID);
  hid[t * 64 + j] = sinf(fr * s);
  __syncthreads();
}

__device__ __forceinline__ void phase_prologue(const Params& p, char* lds) {
  constexpr int T0 = 1296, T1 = T0 + 512, T2 = T1 + 768, T3 = T2 + 256, T4 = T3 + 512, T5 = T4 + 512, T6 = T5 + 192, T7 = T6 + 1024, T8 = T7 + 256;
  for (int item = blockIdx.x; item < T8; item += gridDim.x) {
    if (item < T0) transpose_w_tile(p.m_w_in, SSM_IN, 1024, SSM_IN, (u16*)(p.ws + OFF_W_IN), item, lds);
    else if (item < T1) transpose_w_tile(p.m_w_out, 1024, 2048, 1024, (u16*)(p.ws + OFF_W_OUT), item - T0, lds);
    else if (item < T2) transpose_w_tile(p.h_w_in, 3072, 1024, 3072, (u16*)(p.ws + OFF_W_HIN), item - T1, lds);
    else if (item < T3) transpose_w_tile(p.h_w_out, 1024, 1024, 1024, (u16*)(p.ws + OFF_W_HOUT), item - T2, lds);
    else if (item < T4) transpose_w_tile(p.p_wq, 2048, 1024, 2048, (u16*)(p.ws + OFF_W_Q), item - T3, lds);
    else if (item < T5) transpose_w_tile(p.p_wq + (size_t)1024 * 2048, 2048, 1024, 2048, (u16*)(p.ws + OFF_W_Q) + (size_t)2048 * 1024, item - T4, lds);
    else if (item < T6) ada_item(p, item - T5, lds);
    else if (item < T7) hyena_mlp_item(p, item - T6, lds);
    else {
      int e8 = ((item - T7) * 256 + threadIdx.x) * 8;
      const float* src = e8 < 262144 ? p.p_k1 + e8 : p.p_k2 + (e8 - 262144);
      float4 a0 = *reinterpret_cast<const float4*>(src), a1 = *reinterpret_cast<const float4*>(src + 4);
      uint4 o;
      o.x = pack2(a0.x, a0.y); o.y = pack2(a0.z, a0.w); o.z = pack2(a1.x, a1.y); o.w = pack2(a1.z, a1.w);
      *reinterpret_cast<uint4*>((u16*)(p.ws + OFF_KEYS) + e8) = o;
    }
  }
}

__device__ __forceinline__ void modulate_rows(const float* src, u16* dst, int nrows, int rows_per_batch, const float* modbase, int sh_off, int sc_off, bool ctxrow) {
  size_t total = (size_t)nrows * 128;
  for (size_t e = (size_t)blockIdx.x * 256 + threadIdx.x; e < total; e += (size_t)gridDim.x * 256) {
    int row = (int)(e >> 7), c8 = (int)(e & 127) * 8;
    int b = ctxrow ? 8 : row / rows_per_batch;
    const float* m = modbase + (size_t)b * 6144;
    float4 a0 = *reinterpret_cast<const float4*>(src + (size_t)row * 1024 + c8);
    float4 a1 = *reinterpret_cast<const float4*>(src + (size_t)row * 1024 + c8 + 4);
    float4 s0 = *reinterpret_cast<const float4*>(m + sc_off + c8);
    float4 s1 = *reinterpret_cast<const float4*>(m + sc_off + c8 + 4);
    float4 h0 = *reinterpret_cast<const float4*>(m + sh_off + c8);
    float4 h1 = *reinterpret_cast<const float4*>(m + sh_off + c8 + 4);
    uint4 o;
    o.x = pack2(a0.x * (1.f + s0.x) + h0.x, a0.y * (1.f + s0.y) + h0.y);
    o.y = pack2(a0.z * (1.f + s0.z) + h0.z, a0.w * (1.f + s0.w) + h0.w);
    o.z = pack2(a1.x * (1.f + s1.x) + h1.x, a1.y * (1.f + s1.y) + h1.y);
    o.w = pack2(a1.z * (1.f + s1.z) + h1.z, a1.w * (1.f + s1.w) + h1.w);
    *reinterpret_cast<uint4*>(dst + (size_t)row * 1024 + c8) = o;
  }
}

constexpr int GLD = 72;
template <class Epi>
__device__ __forceinline__ void gemm_tile(const u16* __restrict__ A, int lda, const u16* __restrict__ Bt, int ldb, int brow, int bcol, int Nmax,
                                          int K, char* lds, Epi epi) {
  u16* SA = (u16*)lds;
  u16* SB = SA + 128 * GLD;
  int tid = threadIdx.x, wid = tid >> 6, lane = tid & 63, wr = wid >> 1, wc = wid & 1, fr = lane & 15, fq = lane >> 4;
  f32x4 acc[4][4];
#pragma unroll
  for (int m = 0; m < 4; ++m)
#pragma unroll
    for (int n = 0; n < 4; ++n) acc[m][n] = f32x4{0.f, 0.f, 0.f, 0.f};
  u32x4 ra[4], rb[4];
  const int lr = tid >> 3, lc = (tid & 7) * 8;
  const u16* abase = A + (size_t)(brow + lr) * lda + lc;
  size_t bo[4];
#pragma unroll
  for (int i = 0; i < 4; ++i) {
    int br = bcol + lr + i * 32;
    if (br >= Nmax) br = Nmax - 1;
    bo[i] = (size_t)br * ldb + lc;
  }
#pragma unroll
  for (int i = 0; i < 4; ++i) {
    ra[i] = *reinterpret_cast<const u32x4*>(abase + (size_t)(i * 32) * lda);
    rb[i] = *reinterpret_cast<const u32x4*>(Bt + bo[i]);
  }
  int nk = K / 64;
  for (int kt = 0; kt < nk; ++kt) {
#pragma unroll
    for (int i = 0; i < 4; ++i) {
      int q = tid + i * 256, r = q >> 3, c = (q & 7) * 8;
      *reinterpret_cast<u32x4*>(SA + r * GLD + c) = ra[i];
      *reinterpret_cast<u32x4*>(SB + r * GLD + c) = rb[i];
    }
    __syncthreads();
    if (kt + 1 < nk) {
#pragma unroll
      for (int i = 0; i < 4; ++i) {
        ra[i] = *reinterpret_cast<const u32x4*>(abase + (size_t)(i * 32) * lda + (kt + 1) * 64);
        rb[i] = *reinterpret_cast<const u32x4*>(Bt + bo[i] + (kt + 1) * 64);
      }
    }
#pragma unroll
    for (int kk = 0; kk < 2; ++kk) {
      bf16x8 At[4], Bl[4];
#pragma unroll
      for (int m = 0; m < 4; ++m) At[m] = ld8(SA + (wr * 64 + m * 16 + fr) * GLD + kk * 32 + fq * 8);
#pragma unroll
      for (int n = 0; n < 4; ++n) Bl[n] = ld8(SB + (wc * 64 + n * 16 + fr) * GLD + kk * 32 + fq * 8);
#pragma unroll
      for (int m = 0; m < 4; ++m)
#pragma unroll
        for (int n = 0; n < 4; ++n) acc[m][n] = mfma16(At[m], Bl[n], acc[m][n]);
    }
    __syncthreads();
  }
#pragma unroll
  for (int m = 0; m < 4; ++m)
#pragma unroll
    for (int n = 0; n < 4; ++n)
#pragma unroll
      for (int j = 0; j < 4; ++j) epi(brow + wr * 64 + m * 16 + fq * 4 + j, bcol + wc * 64 + n * 16 + fr, acc[m][n][j]);
}

DEV float softplusf(float v) { return fmaxf(v, 0.f) + log1pf(__expf(-fabsf(v))); }

__device__ __forceinline__ void phase_gemm_inproj(const Params& p, char* lds) {
  const u16* hx = (const u16*)(p.ws + OFF_R2);
  const u16* hc = (const u16*)(p.ws + OFF_HC);
  const u16* Wt = (const u16*)(p.ws + OFF_W_IN);
  u16* zbuf = (u16*)p.out;
  u16* xbc = (u16*)(p.ws + OFF_R1);
  float* dt = (float*)(p.ws + OFF_DT);
  u16* xbc_c = (u16*)(p.ws + OFF_XBC_C);
  float* dt_c = (float*)(p.ws + OFF_DT_C);
  const float* dtb = p.m_dt_bias;
  constexpr int NL = 256 * 41, NC = 16 * 25;
  for (int item = blockIdx.x; item < NL + NC; item += gridDim.x) {
    if (item < NL) {
      int pm = item / 41, pn = item % 41;
      gemm_tile(hx, 1024, Wt, 1024, pm * 128, pn * 128, SSM_IN, 1024, lds, [=](int m, int n, float v) {
        if (n < 2048) zbuf[(size_t)m * 2048 + n] = f2bf(v);
        else if (n < 5120) xbc[(size_t)m * 3072 + (n - 2048)] = f2bf(v);
        else if (n < 5184) dt[(size_t)m * 64 + (n - 5120)] = softplusf(v + dtb[n - 5120]);
      });
    } else {
      int it = item - NL;
      int pm = it / 25, pn = it % 25;
      gemm_tile(hc, 1024, Wt + (size_t)2048 * 1024, 1024, pm * 128, pn * 128, 3136, 1024, lds, [=](int m, int n, float v) {
        if (n < 3072) xbc_c[(size_t)m * 3072 + n] = f2bf(v);
        else if (n < 3136) dt_c[(size_t)m * 64 + (n - 3072)] = softplusf(v + dtb[n - 3072]);
      });
    }
  }
}

__device__ __forceinline__ void phase_conv(const Params& p) {
  const u16* xbc = (const u16*)(p.ws + OFF_R1);
  u16* xc = (u16*)(p.ws + OFF_R2);
  const u16* xbc_c = (const u16*)(p.ws + OFF_XBC_C);
  u16* xc_c = (u16*)(p.ws + OFF_XC_C);
  const float* cw = p.m_conv_w;
  const float* cb = p.m_conv_b;
  size_t nl = (size_t)NT * 384, ncx = (size_t)NTC * 384;
  for (size_t e = (size_t)blockIdx.x * 256 + threadIdx.x; e < nl + ncx; e += (size_t)gridDim.x * 256) {
    bool isc = e >= nl;
    size_t ee = isc ? e - nl : e;
    int tok = (int)(ee / 384), ch = (int)(ee % 384) * 8;
    float acc[8];
#pragma unroll
    for (int k = 0; k < 8; ++k) acc[k] = cb[ch + k];
    if (!isc) {
      int b = tok >> 12, l = tok & 4095, r = l >> 6, c = l & 63;
#pragma unroll
      for (int i = 0; i < 3; ++i) {
        int rr = r + i - 1;
        if (rr < 0 || rr > 63) continue;
#pragma unroll
        for (int j = 0; j < 3; ++j) {
          int cc = c + j - 1;
          if (cc < 0 || cc > 63) continue;
          uint4 v = *reinterpret_cast<const uint4*>(xbc + ((size_t)(b * 4096 + rr * 64 + cc)) * 3072 + ch);
          const float* w = cw + (i * 3 + j) * 3072 + ch;
          float4 w0 = *reinterpret_cast<const float4*>(w), w1 = *reinterpret_cast<const float4*>(w + 4);
          acc[0] += bflo(v.x) * w0.x; acc[1] += bfhi(v.x) * w0.y; acc[2] += bflo(v.y) * w0.z; acc[3] += bfhi(v.y) * w0.w;
          acc[4] += bflo(v.z) * w1.x; acc[5] += bfhi(v.z) * w1.y; acc[6] += bflo(v.w) * w1.z; acc[7] += bfhi(v.w) * w1.w;
        }
      }
    } else {
      int b = tok >> 8, c = tok & 255;
#pragma unroll
      for (int j = 0; j < 3; ++j) {
        int cc = c + j - 1;
        if (cc < 0 || cc > 255) continue;
        uint4 v = *reinterpret_cast<const uint4*>(xbc_c + ((size_t)(b * 256 + cc)) * 3072 + ch);
        const float* w = cw + (3 + j) * 3072 + ch;
        float4 w0 = *reinterpret_cast<const float4*>(w), w1 = *reinterpret_cast<const float4*>(w + 4);
        acc[0] += bflo(v.x) * w0.x; acc[1] += bfhi(v.x) * w0.y; acc[2] += bflo(v.y) * w0.z; acc[3] += bfhi(v.y) * w0.w;
        acc[4] += bflo(v.z) * w1.x; acc[5] += bfhi(v.z) * w1.y; acc[6] += bflo(v.w) * w1.z; acc[7] += bfhi(v.w) * w1.w;
      }
    }
    uint4 o;
    o.x = pack2(siluf(acc[0]), siluf(acc[1]));
    o.y = pack2(siluf(acc[2]), siluf(acc[3]));
    o.z = pack2(siluf(acc[4]), siluf(acc[5]));
    o.w = pack2(siluf(acc[6]), siluf(acc[7]));
    u16* dst = isc ? xc_c : xc;
    *reinterpret_cast<uint4*>(dst + (size_t)tok * 3072 + ch) = o;
  }
}

constexpr int SLD = 136;
__device__ __forceinline__ void phase_ssd(const Params& p, char* lds) {
  u16* xsT = (u16*)lds;
  u16* stb = xsT + 64 * SLD;
  u16* Mb = stb + 64 * SLD;
  float* cum = (float*)(Mb + 128 * SLD);
  float* dtv = cum + 128;
  float* asrc = dtv + 128;
  const u16* xc = (const u16*)(p.ws + OFF_R2);
  const u16* xc_c = (const u16*)(p.ws + OFF_XC_C);
  const float* dt = (const float*)(p.ws + OFF_DT);
  const float* dt_c = (const float*)(p.ws + OFF_DT_C);
  u16* y = (u16*)(p.ws + OFF_R1);
  int tid = threadIdx.x, w = tid >> 6, lane = tid & 63, fr = lane & 15, fq = lane >> 4;
  for (int item = blockIdx.x; item < 256; item += gridDim.x) {
    int b = item >> 5, h = item & 31, g = h >> 3;
    float dsk = p.m_d[h];
    for (int dir = 0; dir < 2; ++dir) {
      float a_neg = -__expf(p.m_a_log[dir * 32 + h]);
      f32x4 acc_s[8];
#pragma unroll
      for (int n = 0; n < 8; ++n) acc_s[n] = f32x4{0.f, 0.f, 0.f, 0.f};
      for (int step = 0; step < 34; ++step) {
        bool isctx = step < 2;
        int cidx = isctx ? step : step - 2;
        if (dir) cidx = (isctx ? 1 : 31) - cidx;
        size_t tok0 = isctx ? (size_t)(b * 256 + cidx * 128) : (size_t)(b * 4096 + cidx * 128);
        const u16* src = (isctx ? xc_c : xc) + tok0 * 3072;
        const float* dts = (isctx ? dt_c : dt) + tok0 * 64;
        if (tid < 128) {
          float d = dts[tid * 64 + dir * 32 + h];
          dtv[tid] = d;
          asrc[tid] = d * a_neg;
        }
#pragma unroll
        for (int i = 0; i < 4; ++i) {
          int idx = tid + i * 256, l = idx >> 3, pc = (idx & 7) * 8;
          uint4 v = *reinterpret_cast<const uint4*>(src + (size_t)l * 3072 + h * 64 + pc);
          xsT[(pc + 0) * SLD + l] = (u16)(v.x & 0xffff); xsT[(pc + 1) * SLD + l] = (u16)(v.x >> 16);
          xsT[(pc + 2) * SLD + l] = (u16)(v.y & 0xffff); xsT[(pc + 3) * SLD + l] = (u16)(v.y >> 16);
          xsT[(pc + 4) * SLD + l] = (u16)(v.z & 0xffff); xsT[(pc + 5) * SLD + l] = (u16)(v.z >> 16);
          xsT[(pc + 6) * SLD + l] = (u16)(v.w & 0xffff); xsT[(pc + 7) * SLD + l] = (u16)(v.w >> 16);
        }
        __syncthreads();
        if (tid < 128) {
          float s = 0.f;
          if (!dir) { for (int j = 0; j <= tid; ++j) s += asrc[j]; }
          else { for (int j = tid; j < 128; ++j) s += asrc[j]; }
          cum[tid] = s;
        }
        __syncthreads();
        float total = dir ? cum[0] : cum[127];
        if (!isctx) {
          bf16x8 Cf[2][4];
#pragma unroll
          for (int mt = 0; mt < 2; ++mt)
#pragma unroll
            for (int kk = 0; kk < 4; ++kk) Cf[mt][kk] = ld8(src + (size_t)(w * 32 + mt * 16 + fr) * 3072 + 2560 + g * 128 + kk * 32 + fq * 8);
          float cl[2][4];
#pragma unroll
          for (int mt = 0; mt < 2; ++mt)
#pragma unroll
            for (int j = 0; j < 4; ++j) cl[mt][j] = cum[w * 32 + mt * 16 + fq * 4 + j];
#pragma unroll 2
          for (int nt = 0; nt < 8; ++nt) {
            int s = nt * 16 + fr;
            bool need0 = dir ? (nt >= w * 2) : (nt <= w * 2);
            bool need1 = dir ? (nt >= w * 2 + 1) : (nt <= w * 2 + 1);
            f32x4 a0 = f32x4{0.f, 0.f, 0.f, 0.f}, a1 = f32x4{0.f, 0.f, 0.f, 0.f};
            if (need0 || need1) {
#pragma unroll
              for (int kk = 0; kk < 4; ++kk) {
                bf16x8 Bf = ld8(src + (size_t)s * 3072 + 2048 + g * 128 + kk * 32 + fq * 8);
                a0 = mfma16(Cf[0][kk], Bf, a0);
                a1 = mfma16(Cf[1][kk], Bf, a1);
              }
            }
            float cs = cum[s], ds = dtv[s];
#pragma unroll
            for (int j = 0; j < 4; ++j) {
              int l0 = w * 32 + fq * 4 + j, l1 = l0 + 16;
              bool ok0 = dir ? (s >= l0) : (s <= l0);
              bool ok1 = dir ? (s >= l1) : (s <= l1);
              float v0 = ok0 ? a0[j] * __expf(cl[0][j] - cs) * ds : 0.f;
              float v1 = ok1 ? a1[j] * __expf(cl[1][j] - cs) * ds : 0.f;
              Mb[l0 * SLD + s] = f2bf(v0);
              Mb[l1 * SLD + s] = f2bf(v1);
            }
          }
          __syncthreads();
          f32x4 ya[2][4];
#pragma unroll
          for (int mt = 0; mt < 2; ++mt)
#pragma unroll
            for (int nt = 0; nt < 4; ++nt) ya[mt][nt] = f32x4{0.f, 0.f, 0.f, 0.f};
#pragma unroll
          for (int kk = 0; kk < 4; ++kk)
#pragma unroll
            for (int nt = 0; nt < 4; ++nt) {
              bf16x8 Sf = ld8(stb + (nt * 16 + fr) * SLD + kk * 32 + fq * 8);
              ya[0][nt] = mfma16(Cf[0][kk], Sf, ya[0][nt]);
              ya[1][nt] = mfma16(Cf[1][kk], Sf, ya[1][nt]);
            }
#pragma unroll
          for (int mt = 0; mt < 2; ++mt)
#pragma unroll
            for (int j = 0; j < 4; ++j) {
              float e = __expf(cl[mt][j]);
#pragma unroll
              for (int nt = 0; nt < 4; ++nt) ya[mt][nt][j] *= e;
            }
#pragma unroll
          for (int kk = 0; kk < 4; ++kk) {
            bf16x8 Mf0 = ld8(Mb + (w * 32 + fr) * SLD + kk * 32 + fq * 8);
            bf16x8 Mf1 = ld8(Mb + (w * 32 + 16 + fr) * SLD + kk * 32 + fq * 8);
#pragma unroll
            for (int nt = 0; nt < 4; ++nt) {
              bf16x8 Xf = ld8(xsT + (nt * 16 + fr) * SLD + kk * 32 + fq * 8);
              ya[0][nt] = mfma16(Mf0, Xf, ya[0][nt]);
              ya[1][nt] = mfma16(Mf1, Xf, ya[1][nt]);
            }
          }
#pragma unroll
          for (int mt = 0; mt < 2; ++mt)
#pragma unroll
            for (int nt = 0; nt < 4; ++nt)
#pragma unroll
              for (int j = 0; j < 4; ++j) {
                int l = w * 32 + mt * 16 + fq * 4 + j, pp = nt * 16 + fr;
                u16* yp = y + (tok0 + l) * 2048 + h * 64 + pp;
                float val = ya[mt][nt][j];
                if (!dir) val += bf2f(xsT[pp * SLD + l]) * dsk;
                else val += bf2f(*yp);
                *yp = f2bf(val);
              }
        }
        if (step == 33) continue;
        __syncthreads();
#pragma unroll
        for (int i = 0; i < 8; ++i) {
          int idx = tid + i * 256, l = idx >> 4, nc = (idx & 15) * 8;
          uint4 v = *reinterpret_cast<const uint4*>(src + (size_t)l * 3072 + 2048 + g * 128 + nc);
          float sc = dtv[l] * __expf(total - cum[l]);
          Mb[(nc + 0) * SLD + l] = f2bf(bflo(v.x) * sc); Mb[(nc + 1) * SLD + l] = f2bf(bfhi(v.x) * sc);
          Mb[(nc + 2) * SLD + l] = f2bf(bflo(v.y) * sc); Mb[(nc + 3) * SLD + l] = f2bf(bfhi(v.y) * sc);
          Mb[(nc + 4) * SLD + l] = f2bf(bflo(v.z) * sc); Mb[(nc + 5) * SLD + l] = f2bf(bfhi(v.z) * sc);
          Mb[(nc + 6) * SLD + l] = f2bf(bflo(v.w) * sc); Mb[(nc + 7) * SLD + l] = f2bf(bfhi(v.w) * sc);
        }
        __syncthreads();
        float cd = __expf(total);
#pragma unroll
        for (int nt = 0; nt < 8; ++nt) acc_s[nt] *= cd;
#pragma unroll
        for (int kk = 0; kk < 4; ++kk) {
          bf16x8 Af = ld8(xsT + (w * 16 + fr) * SLD + kk * 32 + fq * 8);
#pragma unroll
          for (int nt = 0; nt < 8; ++nt) {
            bf16x8 Bf = ld8(Mb + (nt * 16 + fr) * SLD + kk * 32 + fq * 8);
            acc_s[nt] = mfma16(Af, Bf, acc_s[nt]);
          }
        }
#pragma unroll
        for (int nt = 0; nt < 8; ++nt)
#pragma unroll
          for (int j = 0; j < 4; ++j) stb[(w * 16 + fq * 4 + j) * SLD + nt * 16 + fr] = f2bf(acc_s[nt][j]);
        __syncthreads();
      }
      __syncthreads();
    }
  }
}

__device__ __forceinline__ void phase_gated_norm(const Params& p) {
  u16* y = (u16*)(p.ws + OFF_R1);
  const u16* z = (const u16*)p.out;
  int lane = threadIdx.x & 63;
  int wave = blockIdx.x * 4 + (threadIdx.x >> 6), nw = gridDim.x * 4;
  for (int tok = wave; tok < NT; tok += nw) {
#pragma unroll
    for (int g = 0; g < 4; ++g) {
      int ch = g * 512 + lane * 8;
      uint4 yv = *reinterpret_cast<const uint4*>(y + (size_t)tok * 2048 + ch);
      uint4 zv = *reinterpret_cast<const uint4*>(z + (size_t)tok * 2048 + ch);
      float u[8];
      u[0] = bflo(yv.x) * siluf(bflo(zv.x)); u[1] = bfhi(yv.x) * siluf(bfhi(zv.x));
      u[2] = bflo(yv.y) * siluf(bflo(zv.y)); u[3] = bfhi(yv.y) * siluf(bfhi(zv.y));
      u[4] = bflo(yv.z) * siluf(bflo(zv.z)); u[5] = bfhi(yv.z) * siluf(bfhi(zv.z));
      u[6] = bflo(yv.w) * siluf(bflo(zv.w)); u[7] = bfhi(yv.w) * siluf(bfhi(zv.w));
      float ss = 0.f;
#pragma unroll
      for (int k = 0; k < 8; ++k) ss += u[k] * u[k];
      ss = wave_sum(ss);
      float sc = rsqrtf(ss * (1.f / 512.f) + 1e-5f);
      float4 w0 = *reinterpret_cast<const float4*>(p.m_norm_w + ch), w1 = *reinterpret_cast<const float4*>(p.m_norm_w + ch + 4);
      uint4 o;
      o.x = pack2(u[0] * sc * w0.x, u[1] * sc * w0.y);
      o.y = pack2(u[2] * sc * w0.z, u[3] * sc * w0.w);
      o.z = pack2(u[4] * sc * w1.x, u[5] * sc * w1.y);
      o.w = pack2(u[6] * sc * w1.z, u[7] * sc * w1.w);
      *reinterpret_cast<uint4*>(y + (size_t)tok * 2048 + ch) = o;
    }
  }
}

__device__ __forceinline__ void phase_gemm_resid(const u16* A, int K, const u16* Wt, const float* res, float* dst, const float* gate  , char* lds) {
  for (int item = blockIdx.x; item < 256 * 8; item += gridDim.x) {
    int pm = item >> 3, pn = item & 7;
    gemm_tile(A, K, Wt, K, pm * 128, pn * 128, 1024, K, lds, [=](int m, int n, float v) {
      int b = m >> 12;
      dst[(size_t)m * 1024 + n] = ALPHA * res[(size_t)m * 1024 + n] + gate[(size_t)b * 6144 + n] * v;
    });
  }
}
__device__ __forceinline__ void phase_gemm_bf16(const u16* A, const u16* Wt, u16* dst, int N, char* lds) {
  int nn = N / 128;
  for (int item = blockIdx.x; item < 256 * nn; item += gridDim.x) {
    int pm = item / nn, pn = item % nn;
    gemm_tile(A, 1024, Wt, 1024, pm * 128, pn * 128, N, 1024, lds, [=](int m, int n, float v) { dst[(size_t)m * N + n] = f2bf(v); });
  }
}

__device__ __forceinline__ void phase_ln_mod(float* xio, const float* g, const float* bta, const float* mod  , u16* tdst) {
  int lane = threadIdx.x & 63;
  int wave = blockIdx.x * 4 + (threadIdx.x >> 6), nw = gridDim.x * 4;
  for (int tok = wave; tok < NT; tok += nw) {
    int b = tok >> 12;
    float4 v[4];
    float s = 0.f;
#pragma unroll
    for (int i = 0; i < 4; ++i) {
      v[i] = *reinterpret_cast<const float4*>(xio + (size_t)tok * 1024 + i * 256 + lane * 4);
      s += v[i].x + v[i].y + v[i].z + v[i].w;
    }
    float mu = wave_sum(s) * (1.f / 1024.f);
    float q = 0.f;
#pragma unroll
    for (int i = 0; i < 4; ++i) {
      v[i].x -= mu; v[i].y -= mu; v[i].z -= mu; v[i].w -= mu;
      q += v[i].x * v[i].x + v[i].y * v[i].y + v[i].z * v[i].z + v[i].w * v[i].w;
    }
    float rs = rsqrtf(wave_sum(q) * (1.f / 1024.f) + 1e-5f);
    const float* m = mod + (size_t)b * 6144;
#pragma unroll
    for (int i = 0; i < 4; ++i) {
      int c = i * 256 + lane * 4;
      float4 gg = *reinterpret_cast<const float4*>(g + c), bb = *reinterpret_cast<const float4*>(bta + c);
      float4 o;
      o.x = v[i].x * rs * gg.x + bb.x; o.y = v[i].y * rs * gg.y + bb.y; o.z = v[i].z * rs * gg.z + bb.z; o.w = v[i].w * rs * gg.w + bb.w;
      *reinterpret_cast<float4*>(xio + (size_t)tok * 1024 + c) = o;
      float4 sh = *reinterpret_cast<const float4*>(m + 3072 + c), sc = *reinterpret_cast<const float4*>(m + 4096 + c);
      uint2 t;
      t.x = pack2(o.x * (1.f + sc.x) + sh.x, o.y * (1.f + sc.y) + sh.y);
      t.y = pack2(o.z * (1.f + sc.z) + sh.z, o.w * (1.f + sc.w) + sh.w);
      *reinterpret_cast<uint2*>(tdst + (size_t)tok * 1024 + c) = t;
    }
  }
}

__device__ __forceinline__ void phase_peer_topk(const u16* q, const u16* k1, const u16* k2, int* idxo, float* gateo, char* lds) {
  float* S = (float*)lds;
  float* sv = S + 64 * 129;
  int* si = (int*)(sv + 64 * 16);
  int tid = threadIdx.x, w = tid >> 6, lane = tid & 63, fr = lane & 15, fq = lane >> 4;
  const int slot = lane;
  const bool cvalid = lane < 50;
  int ci = slot < 42 ? ((slot >= 16) + (slot >= 24) + (slot >= 29) + (slot >= 33) + (slot >= 36) + (slot >= 38) + (slot >= 40)) : slot - 34;
  const unsigned long long PACK = 0ull | (16ull << 8) | (24ull << 16) | (29ull << 24) | (33ull << 32) | (36ull << 40) | (38ull << 48) | (40ull << 56);
  int cj = slot - (ci < 8 ? (int)((PACK >> (8 * ci)) & 0xFF) : 34 + ci);
  if (!cvalid) { ci = 0; cj = 0; }
  for (int item = blockIdx.x; item < 1024 * 8; item += gridDim.x) {
    int tile = item >> 3, h = item & 7;
    int tok0 = tile * 32;
    {
      int half = w >> 1, kb = (w & 1) * 64;
      const u16* kk_ = (half ? k2 : k1) + (size_t)h * 128 * 128;
      bf16x8 Af[2][4], Bf[4][4];
#pragma unroll
      for (int m = 0; m < 2; ++m)
#pragma unroll
        for (int ks = 0; ks < 4; ++ks) Af[m][ks] = ld8(q + (size_t)(tok0 + m * 16 + fr) * 2048 + h * 256 + half * 128 + ks * 32 + fq * 8);
#pragma unroll
      for (int n = 0; n < 4; ++n)
#pragma unroll
        for (int ks = 0; ks < 4; ++ks) Bf[n][ks] = ld8(kk_ + (size_t)(kb + n * 16 + fr) * 128 + ks * 32 + fq * 8);
      f32x4 acc[2][4];
#pragma unroll
      for (int m = 0; m < 2; ++m)
#pragma unroll
        for (int n = 0; n < 4; ++n) acc[m][n] = f32x4{0.f, 0.f, 0.f, 0.f};
#pragma unroll
      for (int ks = 0; ks < 4; ++ks)
#pragma unroll
        for (int n = 0; n < 4; ++n) {
          acc[0][n] = mfma16(Af[0][ks], Bf[n][ks], acc[0][n]);
          acc[1][n] = mfma16(Af[1][ks], Bf[n][ks], acc[1][n]);
        }
#pragma unroll
      for (int m = 0; m < 2; ++m)
#pragma unroll
        for (int n = 0; n < 4; ++n)
#pragma unroll
          for (int j = 0; j < 4; ++j) S[(half * 32 + m * 16 + fq * 4 + j) * 129 + kb + n * 16 + fr] = acc[m][n][j];
    }
    __syncthreads();
#pragma unroll 1
    for (int li = 0; li < 16; ++li) {
      int list = w * 16 + li;
      const float* row = S + list * 129;
      float vlo = row[lane], vhi = row[lane + 64];
      unsigned long long klo = ((unsigned long long)ordkey(vlo) << 7) | (unsigned)(127 - lane);
      unsigned long long khi = ((unsigned long long)ordkey(vhi) << 7) | (unsigned)(63 - lane);
      unsigned long long T = 0;
#pragma unroll 3
      for (int bit = 38; bit >= 0; --bit) {
        unsigned long long cand = T | (1ull << bit);
        int cnt = __popcll(__ballot(klo >= cand)) + __popcll(__ballot(khi >= cand));
        if (cnt >= 16) T = cand;
      }
      bool slo = klo >= T, shi = khi >= T;
      unsigned long long mlo = __ballot(slo), mhi = __ballot(shi);
      int rlo = 0, rhi = 0;
      int klo_l = (int)(unsigned)klo, klo_h = (int)(unsigned)(klo >> 32), khi_l = (int)(unsigned)khi, khi_h = (int)(unsigned)(khi >> 32);
      while (mlo) {
        int src = __ffsll((long long)mlo) - 1;
        mlo &= mlo - 1;
        unsigned long long ks = ((unsigned long long)(unsigned)__builtin_amdgcn_readlane(klo_h, src) << 32) | (unsigned)__builtin_amdgcn_readlane(klo_l, src);
        rlo += (ks > klo) ? 1 : 0;
        rhi += (ks > khi) ? 1 : 0;
      }
      while (mhi) {
        int src = __ffsll((long long)mhi) - 1;
        mhi &= mhi - 1;
        unsigned long long ks = ((unsigned long long)(unsigned)__builtin_amdgcn_readlane(khi_h, src) << 32) | (unsigned)__builtin_amdgcn_readlane(khi_l, src);
        rlo += (ks > klo) ? 1 : 0;
        rhi += (ks > khi) ? 1 : 0;
      }
      if (slo) { sv[list * 16 + rlo] = vlo; si[list * 16 + rlo] = lane; }
      if (shi) { sv[list * 16 + rhi] = vhi; si[list * 16 + rhi] = lane + 64; }
    }
    __syncthreads();
#pragma unroll 1
    for (int tt = 0; tt < 8; ++tt) {
      int tok = w * 8 + tt;
      float sc_ = sv[tok * 16 + ci] + sv[(32 + tok) * 16 + cj];
      if (!cvalid) sc_ = -INFINITY;
      int isc = __float_as_int(sc_);
      int rank = 0;
#pragma unroll 10
      for (int j = 0; j < 50; ++j) {
        float o = __int_as_float(__builtin_amdgcn_readlane(isc, j));
        rank += (o > sc_ || (o == sc_ && j < lane)) ? 1 : 0;
      }
      bool sel = cvalid && rank < 16;
      float mx = sc_;
#pragma unroll
      for (int o = 32; o > 0; o >>= 1) mx = fmaxf(mx, __shfl_xor(mx, o));
      float ex = sel ? __expf(sc_ - mx) : 0.f;
      float sum = wave_sum(ex);
      if (sel) {
        size_t o = (size_t)(tok0 + tok) * 128 + h * 16 + rank;
        gateo[o] = ex / sum;
        idxo[o] = si[tok * 16 + ci] * 128 + si[(32 + tok) * 16 + cj];
      }
    }
  }
  __syncthreads();
}

DEV float gelu_exact(float v) { return 0.5f * v * (1.f + erff(v * 0.70710678118654752f)); }

typedef float f32x2 __attribute__((ext_vector_type(2)));
__device__ __forceinline__ void convert_fp8_rows(const float* src, unsigned char* dst, float* rscale, int nrows) {
  int lane = threadIdx.x & 63;
  int wave = blockIdx.x * 4 + (threadIdx.x >> 6), nw = gridDim.x * 4;
  for (int row = wave; row < nrows; row += nw) {
    const float* r = src + (size_t)row * 1024 + lane * 16;
    float4 a0 = *reinterpret_cast<const float4*>(r), a1 = *reinterpret_cast<const float4*>(r + 4);
    float4 a2 = *reinterpret_cast<const float4*>(r + 8), a3 = *reinterpret_cast<const float4*>(r + 12);
    float m = fmaxf(fmaxf(fmaxf(fabsf(a0.x), fabsf(a0.y)), fmaxf(fabsf(a0.z), fabsf(a0.w))), fmaxf(fmaxf(fabsf(a1.x), fabsf(a1.y)), fmaxf(fabsf(a1.z), fabsf(a1.w))));
    m = fmaxf(m, fmaxf(fmaxf(fmaxf(fabsf(a2.x), fabsf(a2.y)), fmaxf(fabsf(a2.z), fabsf(a2.w))), fmaxf(fmaxf(fabsf(a3.x), fabsf(a3.y)), fmaxf(fabsf(a3.z), fabsf(a3.w)))));
#pragma unroll
    for (int o = 32; o > 0; o >>= 1) m = fmaxf(m, __shfl_xor(m, o));
    float sc = m > 0.f ? exp2f(floorf(log2f(224.f / m))) : 1.f;
    uint4 o;
    int p;
    p = __builtin_amdgcn_cvt_pk_fp8_f32(a0.x * sc, a0.y * sc, 0, false); p = __builtin_amdgcn_cvt_pk_fp8_f32(a0.z * sc, a0.w * sc, p, true); o.x = (unsigned)p;
    p = __builtin_amdgcn_cvt_pk_fp8_f32(a1.x * sc, a1.y * sc, 0, false); p = __builtin_amdgcn_cvt_pk_fp8_f32(a1.z * sc, a1.w * sc, p, true); o.y = (unsigned)p;
    p = __builtin_amdgcn_cvt_pk_fp8_f32(a2.x * sc, a2.y * sc, 0, false); p = __builtin_amdgcn_cvt_pk_fp8_f32(a2.z * sc, a2.w * sc, p, true); o.z = (unsigned)p;
    p = __builtin_amdgcn_cvt_pk_fp8_f32(a3.x * sc, a3.y * sc, 0, false); p = __builtin_amdgcn_cvt_pk_fp8_f32(a3.z * sc, a3.w * sc, p, true); o.w = (unsigned)p;
    *reinterpret_cast<uint4*>(dst + (size_t)row * 1024 + lane * 16) = o;
    if (lane == 0) rscale[row] = 1.f / sc;
  }
}

#define F8X(dst, WW) { dst[0] = __builtin_amdgcn_cvt_pk_f32_fp8((int)(WW).x, false); dst[1] = __builtin_amdgcn_cvt_pk_f32_fp8((int)(WW).x, true); \
                      dst[2] = __builtin_amdgcn_cvt_pk_f32_fp8((int)(WW).y, false); dst[3] = __builtin_amdgcn_cvt_pk_f32_fp8((int)(WW).y, true); \
                      dst[4] = __builtin_amdgcn_cvt_pk_f32_fp8((int)(WW).z, false); dst[5] = __builtin_amdgcn_cvt_pk_f32_fp8((int)(WW).z, true); \
                      dst[6] = __builtin_amdgcn_cvt_pk_f32_fp8((int)(WW).w, false); dst[7] = __builtin_amdgcn_cvt_pk_f32_fp8((int)(WW).w, true); }

__device__ __forceinline__ void phase_peer_gather(const u16* tin, const int* idx, const float* gate, const unsigned char* utab, const unsigned char* vtab,
                                  const float* urs, const float* vrs, const float* xres,
                                  const float* g2  , const float* lng, const float* lnb, float* xout,
                                  const float* modnext  , u16* hxout) {
  int lane = threadIdx.x & 63;
  int wave = blockIdx.x * 4 + (threadIdx.x >> 6), nw = gridDim.x * 4;
  for (int tok = wave; tok < NT; tok += nw) {
    int b = tok >> 12;
    f32x2 t2[8];
    {
      uint4 ta = *reinterpret_cast<const uint4*>(tin + (size_t)tok * 1024 + lane * 16);
      uint4 tb = *reinterpret_cast<const uint4*>(tin + (size_t)tok * 1024 + lane * 16 + 8);
      t2[0] = f32x2{bflo(ta.x), bfhi(ta.x)}; t2[1] = f32x2{bflo(ta.y), bfhi(ta.y)}; t2[2] = f32x2{bflo(ta.z), bfhi(ta.z)}; t2[3] = f32x2{bflo(ta.w), bfhi(ta.w)};
      t2[4] = f32x2{bflo(tb.x), bfhi(tb.x)}; t2[5] = f32x2{bflo(tb.y), bfhi(tb.y)}; t2[6] = f32x2{bflo(tb.z), bfhi(tb.z)}; t2[7] = f32x2{bflo(tb.w), bfhi(tb.w)};
    }
    int id0 = idx[(size_t)tok * 128 + lane] & 16383, id1 = idx[(size_t)tok * 128 + 64 + lane] & 16383;
    int gt0 = __float_as_int(gate[(size_t)tok * 128 + lane]), gt1 = __float_as_int(gate[(size_t)tok * 128 + 64 + lane]);
    f32x2 acc2[8];
#pragma unroll
    for (int k = 0; k < 8; ++k) acc2[k] = f32x2{0.f, 0.f};
#pragma unroll 1
    for (int j = 0; j < 128; j += 4) {
      int e[4];
      float g[4];
      if (j < 64) {
#pragma unroll
        for (int q = 0; q < 4; ++q) { e[q] = __builtin_amdgcn_readlane(id0, j + q); g[q] = __int_as_float(__builtin_amdgcn_readlane(gt0, j + q)); }
      } else {
#pragma unroll
        for (int q = 0; q < 4; ++q) { e[q] = __builtin_amdgcn_readlane(id1, j - 64 + q); g[q] = __int_as_float(__builtin_amdgcn_readlane(gt1, j - 64 + q)); }
      }
      uint4 U[4], V[4];
      float su[4], sv_[4];
#pragma unroll
      for (int q = 0; q < 4; ++q) {
        U[q] = *reinterpret_cast<const uint4*>(utab + (size_t)e[q] * 1024 + lane * 16);
        V[q] = *reinterpret_cast<const uint4*>(vtab + (size_t)e[q] * 1024 + lane * 16);
        su[q] = urs[e[q]];
        sv_[q] = vrs[e[q]];
      }
      float d[4];
#pragma unroll
      for (int q = 0; q < 4; ++q) {
        f32x2 u2[8];
        F8X(u2, U[q])
        f32x2 dd = u2[0] * t2[0];
#pragma unroll
        for (int k = 1; k < 8; ++k) dd = u2[k] * t2[k] + dd;
        d[q] = dd.x + dd.y;
      }
#pragma unroll
      for (int o = 32; o > 0; o >>= 1) {
#pragma unroll
        for (int q = 0; q < 4; ++q) d[q] += __shfl_xor(d[q], o);
      }
#pragma unroll
      for (int q = 0; q < 4; ++q) {
        float a = g[q] * gelu_exact(d[q] * su[q]) * sv_[q];
        f32x2 aa = f32x2{a, a};
        f32x2 v2[8];
        F8X(v2, V[q])
#pragma unroll
        for (int k = 0; k < 8; ++k) acc2[k] = aa * v2[k] + acc2[k];
      }
    }
    float vv[16];
    float s = 0.f;
    const int c0 = lane * 16;
#pragma unroll
    for (int k4 = 0; k4 < 4; ++k4) {
      float4 x0 = *reinterpret_cast<const float4*>(xres + (size_t)tok * 1024 + c0 + k4 * 4);
      float4 g0 = *reinterpret_cast<const float4*>(g2 + (size_t)b * 6144 + c0 + k4 * 4);
      vv[k4 * 4 + 0] = ALPHA * x0.x + g0.x * acc2[k4 * 2].x; vv[k4 * 4 + 1] = ALPHA * x0.y + g0.y * acc2[k4 * 2].y;
      vv[k4 * 4 + 2] = ALPHA * x0.z + g0.z * acc2[k4 * 2 + 1].x; vv[k4 * 4 + 3] = ALPHA * x0.w + g0.w * acc2[k4 * 2 + 1].y;
    }
#pragma unroll
    for (int k = 0; k < 16; ++k) s += vv[k];
    float mu = wave_sum(s) * (1.f / 1024.f);
    float qq = 0.f;
#pragma unroll
    for (int k = 0; k < 16; ++k) { vv[k] -= mu; qq += vv[k] * vv[k]; }
    float rs = rsqrtf(wave_sum(qq) * (1.f / 1024.f) + 1e-5f);
    float oo[16];
#pragma unroll
    for (int k4 = 0; k4 < 4; ++k4) {
      float4 ga = *reinterpret_cast<const float4*>(lng + c0 + k4 * 4), ba = *reinterpret_cast<const float4*>(lnb + c0 + k4 * 4);
      float4 o0;
      o0.x = vv[k4 * 4 + 0] * rs * ga.x + ba.x; o0.y = vv[k4 * 4 + 1] * rs * ga.y + ba.y; o0.z = vv[k4 * 4 + 2] * rs * ga.z + ba.z; o0.w = vv[k4 * 4 + 3] * rs * ga.w + ba.w;
      *reinterpret_cast<float4*>(xout + (size_t)tok * 1024 + c0 + k4 * 4) = o0;
      oo[k4 * 4 + 0] = o0.x; oo[k4 * 4 + 1] = o0.y; oo[k4 * 4 + 2] = o0.z; oo[k4 * 4 + 3] = o0.w;
    }
    if (modnext) {
      const float* m = modnext + (size_t)b * 6144;
      unsigned pk[8];
#pragma unroll
      for (int k4 = 0; k4 < 4; ++k4) {
        float4 sh0 = *reinterpret_cast<const float4*>(m + c0 + k4 * 4), sc0 = *reinterpret_cast<const float4*>(m + 1024 + c0 + k4 * 4);
        pk[k4 * 2] = pack2(oo[k4 * 4 + 0] * (1.f + sc0.x) + sh0.x, oo[k4 * 4 + 1] * (1.f + sc0.y) + sh0.y);
        pk[k4 * 2 + 1] = pack2(oo[k4 * 4 + 2] * (1.f + sc0.z) + sh0.z, oo[k4 * 4 + 3] * (1.f + sc0.w) + sh0.w);
      }
      *reinterpret_cast<uint4*>(hxout + (size_t)tok * 1024 + c0) = make_uint4(pk[0], pk[1], pk[2], pk[3]);
      *reinterpret_cast<uint4*>(hxout + (size_t)tok * 1024 + c0 + 8) = make_uint4(pk[4], pk[5], pk[6], pk[7]);
    }
  }
}

__device__ __forceinline__ void phase_shortconv_T(const Params& p, const u16* upre, u16* x1cm, u16* x2cm, u16* vcm, char* lds) {
  u16* tile = (u16*)lds;
  int tid = threadIdx.x;
  for (int item = blockIdx.x; item < 512 * 48; item += gridDim.x) {
    int tt = item / 48, ct = item % 48;
    int tok0 = tt * 64, c0 = ct * 64;
#pragma unroll
    for (int i = 0; i < 2; ++i) {
      int q = tid + i * 256, tl = q >> 3, cg_ = (q & 7) * 8;
      int tok = tok0 + tl, l = tok & 4095, ch = c0 + cg_;
      float acc[8];
#pragma unroll
      for (int k = 0; k < 8; ++k) acc[k] = p.h_conv_b[ch + k];
#pragma unroll
      for (int j = 0; j < 3; ++j) {
        int ll = l + j - 1;
        if (ll < 0 || ll > 4095) continue;
        uint4 v = *reinterpret_cast<const uint4*>(upre + (size_t)(tok + j - 1) * 3072 + ch);
        const float* w = p.h_conv_w + j * 3072 + ch;
        float4 w0 = *reinterpret_cast<const float4*>(w), w1 = *reinterpret_cast<const float4*>(w + 4);
        acc[0] += bflo(v.x) * w0.x; acc[1] += bfhi(v.x) * w0.y; acc[2] += bflo(v.y) * w0.z; acc[3] += bfhi(v.y) * w0.w;
        acc[4] += bflo(v.z) * w1.x; acc[5] += bfhi(v.z) * w1.y; acc[6] += bflo(v.w) * w1.z; acc[7] += bfhi(v.w) * w1.w;
      }
#pragma unroll
      for (int k = 0; k < 8; ++k) tile[(cg_ + k) * 72 + tl] = f2bf(acc[k]);
    }
    __syncthreads();
    int part = c0 >> 10, d0 = c0 & 1023;
    u16* dst = part == 0 ? x1cm : (part == 1 ? x2cm : vcm);
    int b = tok0 >> 12, l0 = tok0 & 4095;
#pragma unroll
    for (int i = 0; i < 2; ++i) {
      int q = tid + i * 256, c = q >> 3, tg = (q & 7) * 8;
      uint4 v = *reinterpret_cast<const uint4*>(tile + c * 72 + tg);
      *reinterpret_cast<uint4*>(dst + ((size_t)(b * 1024 + d0 + c)) * 4096 + l0 + tg) = v;
    }
    __syncthreads();
  }
}

__device__ __forceinline__ void fft_fwd(float2* X) {
  int tid = threadIdx.x;
  for (int s = 12; s >= 0; --s) {
    int half = 1 << s;
    float inv2h = 1.f / (float)(2 * half);
#pragma unroll 4
    for (int i = 0; i < 16; ++i) {
      int j = tid + i * 256;
      int pos = j & (half - 1);
      int i0 = ((j >> s) << (s + 1)) + pos, i1 = i0 + half;
      float fr_ = (float)pos * inv2h;
      float wr = __builtin_amdgcn_cosf(fr_), wi = -__builtin_amdgcn_sinf(fr_);
      float2 a = X[i0], bq = X[i1];
      float dr = a.x - bq.x, di = a.y - bq.y;
      X[i0] = make_float2(a.x + bq.x, a.y + bq.y);
      X[i1] = make_float2(dr * wr - di * wi, dr * wi + di * wr);
    }
    __syncthreads();
  }
}
__device__ __forceinline__ void fft_inv(float2* X) {
  int tid = threadIdx.x;
  for (int s = 0; s <= 12; ++s) {
    int half = 1 << s;
    float inv2h = 1.f / (float)(2 * half);
#pragma unroll 4
    for (int i = 0; i < 16; ++i) {
      int j = tid + i * 256;
      int pos = j & (half - 1);
      int i0 = ((j >> s) << (s + 1)) + pos, i1 = i0 + half;
      float fr_ = (float)pos * inv2h;
      float wr = __builtin_amdgcn_cosf(fr_), wi = -__builtin_amdgcn_sinf(fr_);
      float2 a = X[i0], bq = X[i1];
      float br = bq.x * wr + bq.y * wi, bi = bq.y * wr - bq.x * wi;
      X[i0] = make_float2(a.x + br, a.y + bi);
      X[i1] = make_float2(a.x - br, a.y - bi);
    }
    __syncthreads();
  }
}

__device__ __forceinline__ void phase_filter_fft(const Params& p, float2* Hf, char* lds) {
  float2* X = (float2*)lds;
  float* w3s = (float*)(lds + 65536);
  float* red = w3s + 128;
  const float* hid = (const float*)(p.ws + OFF_HID);
  int tid = threadIdx.x;
  const float min_decay = -3.0701134573253945f;
  const float max_decay = -15.350567286626973f;
  for (int item = blockIdx.x; item < 2048; item += gridDim.x) {
    int o = item >> 10, d = item & 1023;
    if (tid < 128) {
      int dirr = tid >> 6, j = tid & 63;
      w3s[tid] = p.h_f_w3[(size_t)j * 4096 + (o * 2 + dirr) * 1024 + d];
    }
    __syncthreads();
    float adelta = fabsf(min_decay + (float)d * ((max_decay - min_decay) / 1023.f));
    float ss = 0.f;
#pragma unroll 1
    for (int i = 0; i < 16; ++i) {
      int t = tid + i * 256;
      const float* hr = hid + (size_t)t * 64;
      float hf = 0.f, hb = 0.f;
#pragma unroll
      for (int j4 = 0; j4 < 16; ++j4) {
        float4 hv = *reinterpret_cast<const float4*>(hr + j4 * 4);
        hf += hv.x * w3s[j4 * 4] + hv.y * w3s[j4 * 4 + 1] + hv.z * w3s[j4 * 4 + 2] + hv.w * w3s[j4 * 4 + 3];
        hb += hv.x * w3s[64 + j4 * 4] + hv.y * w3s[64 + j4 * 4 + 1] + hv.z * w3s[64 + j4 * 4 + 2] + hv.w * w3s[64 + j4 * 4 + 3];
      }
      float dec = __expf(-((float)t / 4095.f) * adelta);
      hf *= dec; hb *= dec;
      if (t == 0) {
        float v = hf + hb;
        X[0] = make_float2(v, 0.f);
        X[4096] = make_float2(0.f, 0.f);
        ss += v * v;
      } else {
        X[t] = make_float2(hf, 0.f);
        X[8192 - t] = make_float2(hb, 0.f);
        ss += hf * hf + hb * hb;
      }
    }
    ss = wave_sum(ss);
    if ((tid & 63) == 0) red[tid >> 6] = ss;
    __syncthreads();
    float tot = red[0] + red[1] + red[2] + red[3];
    float scale = rsqrtf(tot + 1e-6f) * (1.f / 8192.f);
    fft_fwd(X);
    float2* dst = Hf + (size_t)item * 8192;
#pragma unroll 4
    for (int i = 0; i < 32; ++i) {
      int k = tid + i * 256;
      float2 v = X[k];
      dst[k] = make_float2(v.x * scale, v.y * scale);
    }
    __syncthreads();
  }
}

__device__ __forceinline__ void phase_hyena_conv(const Params& p, const u16* x1cm, const u16* x2cm, const u16* vcm, const float2* Hf, u16* zzcm, char* lds) {
  float2* X = (float2*)lds;
  int tid = threadIdx.x;
  for (int item = blockIdx.x; item < 4096; item += gridDim.x) {
    int d = item >> 2, bp = item & 3;
    size_t r0 = ((size_t)((bp * 2) * 1024 + d)) * 4096, r1 = ((size_t)((bp * 2 + 1) * 1024 + d)) * 4096;
    float bias0 = p.h_bias[d], bias1 = p.h_bias[1024 + d];
#pragma unroll
    for (int i = 0; i < 2; ++i) {
      int t8 = (tid + i * 256) * 8;
      uint4 a = *reinterpret_cast<const uint4*>(vcm + r0 + t8);
      uint4 bq = *reinterpret_cast<const uint4*>(vcm + r1 + t8);
      X[t8 + 0] = make_float2(bflo(a.x), bflo(bq.x)); X[t8 + 1] = make_float2(bfhi(a.x), bfhi(bq.x));
      X[t8 + 2] = make_float2(bflo(a.y), bflo(bq.y)); X[t8 + 3] = make_float2(bfhi(a.y), bfhi(bq.y));
      X[t8 + 4] = make_float2(bflo(a.z), bflo(bq.z)); X[t8 + 5] = make_float2(bfhi(a.z), bfhi(bq.z));
      X[t8 + 6] = make_float2(bflo(a.w), bflo(bq.w)); X[t8 + 7] = make_float2(bfhi(a.w), bfhi(bq.w));
    }
    for (int i = 0; i < 16; ++i) X[4096 + tid + i * 256] = make_float2(0.f, 0.f);
    __syncthreads();
    fft_fwd(X);
    {
      const float2* H = Hf + (size_t)d * 8192;
#pragma unroll 4
      for (int i = 0; i < 32; ++i) {
        int k = tid + i * 256;
        float2 hv = H[k], xv = X[k];
        X[k] = make_float2(xv.x * hv.x - xv.y * hv.y, xv.x * hv.y + xv.y * hv.x);
      }
    }
    __syncthreads();
    fft_inv(X);
    float zz0[16], zz1[16];
#pragma unroll
    for (int i = 0; i < 2; ++i) {
      int t8 = (tid + i * 256) * 8;
      uint4 a = *reinterpret_cast<const uint4*>(vcm + r0 + t8);
      uint4 bq = *reinterpret_cast<const uint4*>(vcm + r1 + t8);
      uint4 xa = *reinterpret_cast<const uint4*>(x1cm + r0 + t8);
      uint4 xb = *reinterpret_cast<const uint4*>(x1cm + r1 + t8);
      float va[8] = {bflo(a.x), bfhi(a.x), bflo(a.y), bfhi(a.y), bflo(a.z), bfhi(a.z), bflo(a.w), bfhi(a.w)};
      float vb[8] = {bflo(bq.x), bfhi(bq.x), bflo(bq.y), bfhi(bq.y), bflo(bq.z), bfhi(bq.z), bflo(bq.w), bfhi(bq.w)};
      float fa[8] = {bflo(xa.x), bfhi(xa.x), bflo(xa.y), bfhi(xa.y), bflo(xa.z), bfhi(xa.z), bflo(xa.w), bfhi(xa.w)};
      float fb[8] = {bflo(xb.x), bfhi(xb.x), bflo(xb.y), bfhi(xb.y), bflo(xb.z), bfhi(xb.z), bflo(xb.w), bfhi(xb.w)};
#pragma unroll
      for (int e = 0; e < 8; ++e) {
        float2 cv = X[t8 + e];
        float z0 = fa[e] * (cv.x + va[e] * bias0);
        float z1 = fb[e] * (cv.y + vb[e] * bias0);
        zz0[i * 8 + e] = z0; zz1[i * 8 + e] = z1;
        X[t8 + e] = make_float2(z0, z1);
      }
    }
    for (int i = 0; i < 16; ++i) X[4096 + tid + i * 256] = make_float2(0.f, 0.f);
    __syncthreads();
    fft_fwd(X);
    {
      const float2* H = Hf + (size_t)(1024 + d) * 8192;
#pragma unroll 4
      for (int i = 0; i < 32; ++i) {
        int k = tid + i * 256;
        float2 hv = H[k], xv = X[k];
        X[k] = make_float2(xv.x * hv.x - xv.y * hv.y, xv.x * hv.y + xv.y * hv.x);
      }
    }
    __syncthreads();
    fft_inv(X);
#pragma unroll
    for (int i = 0; i < 2; ++i) {
      int t8 = (tid + i * 256) * 8;
      uint4 xa = *reinterpret_cast<const uint4*>(x2cm + r0 + t8);
      uint4 xb = *reinterpret_cast<const uint4*>(x2cm + r1 + t8);
      float fa[8] = {bflo(xa.x), bfhi(xa.x), bflo(xa.y), bfhi(xa.y), bflo(xa.z), bfhi(xa.z), bflo(xa.w), bfhi(xa.w)};
      float fb[8] = {bflo(xb.x), bfhi(xb.x), bflo(xb.y), bfhi(xb.y), bflo(xb.z), bfhi(xb.z), bflo(xb.w), bfhi(xb.w)};
      float o0[8], o1[8];
#pragma unroll
      for (int e = 0; e < 8; ++e) {
        float2 cv = X[t8 + e];
        o0[e] = fa[e] * (cv.x + zz0[i * 8 + e] * bias1);
        o1[e] = fb[e] * (cv.y + zz1[i * 8 + e] * bias1);
      }
      uint4 w0, w1;
      w0.x = pack2(o0[0], o0[1]); w0.y = pack2(o0[2], o0[3]); w0.z = pack2(o0[4], o0[5]); w0.w = pack2(o0[6], o0[7]);
      w1.x = pack2(o1[0], o1[1]); w1.y = pack2(o1[2], o1[3]); w1.z = pack2(o1[4], o1[5]); w1.w = pack2(o1[6], o1[7]);
      *reinterpret_cast<uint4*>(zzcm + r0 + t8) = w0;
      *reinterpret_cast<uint4*>(zzcm + r1 + t8) = w1;
    }
    __syncthreads();
  }
}

__device__ __forceinline__ void phase_transpose_back(const u16* src, u16* dst, char* lds) {
  u16* tile = (u16*)lds;
  int tid = threadIdx.x;
  for (int item = blockIdx.x; item < 8 * 16 * 64; item += gridDim.x) {
    int b = item >> 10, dt_ = (item >> 6) & 15, tt = item & 63;
#pragma unroll
    for (int i = 0; i < 2; ++i) {
      int q = tid + i * 256, dd = q >> 3, tg = (q & 7) * 8;
      uint4 v = *reinterpret_cast<const uint4*>(src + ((size_t)(b * 1024 + dt_ * 64 + dd)) * 4096 + tt * 64 + tg);
      tile[(tg + 0) * 72 + dd] = (u16)(v.x & 0xffff); tile[(tg + 1) * 72 + dd] = (u16)(v.x >> 16);
      tile[(tg + 2) * 72 + dd] = (u16)(v.y & 0xffff); tile[(tg + 3) * 72 + dd] = (u16)(v.y >> 16);
      tile[(tg + 4) * 72 + dd] = (u16)(v.z & 0xffff); tile[(tg + 5) * 72 + dd] = (u16)(v.z >> 16);
      tile[(tg + 6) * 72 + dd] = (u16)(v.w & 0xffff); tile[(tg + 7) * 72 + dd] = (u16)(v.w >> 16);
    }
    __syncthreads();
#pragma unroll
    for (int i = 0; i < 2; ++i) {
      int q = tid + i * 256, tl = q >> 3, dg = (q & 7) * 8;
      uint4 v = *reinterpret_cast<const uint4*>(tile + tl * 72 + dg);
      *reinterpret_cast<uint4*>(dst + ((size_t)(b * 4096 + tt * 64 + tl)) * 1024 + dt_ * 64 + dg) = v;
    }
    __syncthreads();
  }
}

DEV void probe_rows(const unsigned* buf, int wpr, float* out) {
  int lane = threadIdx.x & 63;
  int wave = blockIdx.x * 4 + (threadIdx.x >> 6), nw = gridDim.x * 4;
  for (int row = wave; row < NT; row += nw) {
    unsigned h = 0;
    for (int w = lane; w < wpr; w += 64) { unsigned v = buf[(size_t)row * wpr + w]; h += (v ^ (v >> 15)) * (2654435761u + 2u * (unsigned)w); }
#pragma unroll
    for (int o = 32; o > 0; o >>= 1) h += (unsigned)__shfl_xor((int)h, o);
    float v = (float)((h >> 8) & 0xFFFFu) * (1.f / 65536.f);
    float4 vv = make_float4(v, v, v, v);
#pragma unroll
    for (int i = 0; i < 4; ++i) *reinterpret_cast<float4*>(out + (size_t)row * 1024 + i * 256 + lane * 4) = vv;
  }
}
#define PROBE_AT(id, bufexpr, wpr) if (PROBE == id) { Params pq = fetch_params(); probe_rows((const unsigned*)(bufexpr), wpr, pq.out); return; }

DEV void gsync2(unsigned k) {
  asm volatile("s_waitcnt vmcnt(0)" ::: "memory");
  __syncthreads();
  if (threadIdx.x == 0) {
    unsigned* bar = (unsigned*)((char*)karg<33>() + OFF_BAR);
    __builtin_amdgcn_fence(__ATOMIC_RELEASE, "agent");
    asm volatile("s_waitcnt vmcnt(0)" ::: "memory");
    __hip_atomic_fetch_add(bar, 1u, __ATOMIC_RELAXED, __HIP_MEMORY_SCOPE_AGENT);
    unsigned target = k * gridDim.x;
    while (__hip_atomic_load(bar, __ATOMIC_RELAXED, __HIP_MEMORY_SCOPE_AGENT) < target) __builtin_amdgcn_s_sleep(1);
    __builtin_amdgcn_fence(__ATOMIC_ACQUIRE, "agent");
    asm volatile("s_waitcnt vmcnt(0)" ::: "memory");
  }
  __syncthreads();
}

DEV void gsync(cg::grid_group& grid) {
  asm volatile("s_waitcnt vmcnt(0)" ::: "memory");
  grid.sync();
  if (threadIdx.x == 0) {
    __builtin_amdgcn_fence(__ATOMIC_ACQUIRE, "agent");
    asm volatile("s_waitcnt vmcnt(0)" ::: "memory");
  }
  __syncthreads();
}

template <int layer>
__device__ __forceinline__ void peer_block(unsigned& nbar, char* lds) {
  {
    Params p = fetch_params();
    char* ws = p.ws; char* R1 = ws + OFF_R1; char* R2 = ws + OFF_R2; char* DO = (char*)p.out;
    const float* modl = (float*)(ws + OFF_MOD) + (size_t)layer * 9 * 6144;
    const u16* A = layer == 0 ? (const u16*)R1 : (const u16*)DO;
    const int K = layer == 0 ? 2048 : 1024;
    const u16* Wt = (const u16*)(ws + (layer == 0 ? OFF_W_OUT : OFF_W_HOUT));
    const float* res = layer == 0 ? p.x : (const float*)R2;
    phase_gemm_resid(A, K, Wt, res, (float*)R2, modl + 2048, lds);
  }
  gsync2(++nbar);
  PROBE_AT(5 + layer * 10, pq.ws + OFF_R2, 1024)
  {
    Params p = fetch_params();
    char* ws = p.ws; char* R1 = ws + OFF_R1; char* R2 = ws + OFF_R2; char* DO = (char*)p.out;
    const float* modl = (float*)(ws + OFF_MOD) + (size_t)layer * 9 * 6144;
    u16* tpeer = layer == 0 ? (u16*)DO : (u16*)(R1 + 128 * MiB);
    phase_ln_mod((float*)R2, p.ln_g + layer * 2048, p.ln_b + layer * 2048, modl, tpeer);
    if (layer == 1) {
      unsigned char* tb = (unsigned char*)R1;
      convert_fp8_rows(p.p_u + (size_t)16384 * 1024, tb, (float*)(tb + 32 * MiB), 16384);
      convert_fp8_rows(p.p_v + (size_t)16384 * 1024, tb + 16 * MiB, (float*)(tb + 32 * MiB + 65536), 16384);
    }
  }
  gsync2(++nbar);
  {
    Params p = fetch_params();
    char* ws = p.ws; char* R1 = ws + OFF_R1; char* DO = (char*)p.out;
    u16* tpeer = layer == 0 ? (u16*)DO : (u16*)(R1 + 128 * MiB);
    phase_gemm_bf16(tpeer, (const u16*)(ws + OFF_W_Q) + (size_t)layer * 2048 * 1024, layer == 0 ? (u16*)R1 : (u16*)DO, 2048, lds);
  }
  gsync2(++nbar);
  PROBE_AT(7 + layer * 10, pq.ws + OFF_R1, 1024)
  {
    Params p = fetch_params();
    char* ws = p.ws; char* R1 = ws + OFF_R1; char* R2 = ws + OFF_R2;
    int* idxb = (int*)(R2 + 128 * MiB);
    float* gateb = (float*)(R2 + 144 * MiB);
    const u16* kbf = (const u16*)(ws + OFF_KEYS);
    phase_peer_topk(layer == 0 ? (const u16*)R1 : (const u16*)p.out, kbf + (size_t)layer * 131072, kbf + 262144 + (size_t)layer * 131072, idxb, gateb, lds);
    if (DUP & 4) { __syncthreads(); phase_peer_topk(layer == 0 ? (const u16*)R1 : (const u16*)p.out, kbf + (size_t)layer * 131072, kbf + 262144 + (size_t)layer * 131072, idxb, gateb, lds); }
  }
  gsync2(++nbar);
  {
    Params p = fetch_params();
    char* ws = p.ws; char* R1 = ws + OFF_R1; char* R2 = ws + OFF_R2; char* DO = (char*)p.out;
    float* mod = (float*)(ws + OFF_MOD);
    const float* modl = mod + (size_t)layer * 9 * 6144;
    int* idxb = (int*)(R2 + 128 * MiB);
    float* gateb = (float*)(R2 + 144 * MiB);
    u16* tpeer = layer == 0 ? (u16*)DO : (u16*)(R1 + 128 * MiB);
    const unsigned char* tb8 = (const unsigned char*)(layer == 0 ? R1 + 128 * MiB : R1);
    phase_peer_gather(tpeer, idxb, gateb, tb8, tb8 + 16 * MiB, (const float*)(tb8 + 32 * MiB), (const float*)(tb8 + 32 * MiB + 65536), (const float*)R2,
                      modl + 5120, p.ln_g + layer * 2048 + 1024, p.ln_b + layer * 2048 + 1024, layer == 0 ? (float*)R2 : p.out,
                      layer == 0 ? mod + 9 * 6144 : nullptr, (u16*)(DO + 64 * MiB));
  }
}

__global__ void __launch_bounds__(256, 2) fwd_megakernel(Params p_unused) {
  __shared__ __attribute__((aligned(16))) char lds[LDS_BYTES];
  cg::grid_group grid = cg::this_grid();
  unsigned nbar = 0;
  { Params p = fetch_params(); phase_prologue(p, lds); }
  gsync(grid);
  {
    Params p = fetch_params();
    float* mod = (float*)(p.ws + OFF_MOD);
    modulate_rows(p.x, (u16*)(p.ws + OFF_R2), NT, SEQ, mod, 0, 1024, false);
    modulate_rows(p.ctx, (u16*)(p.ws + OFF_HC), NTC, CTXL, mod, 0, 1024, true);
  }
  gsync2(++nbar);
  { Params p = fetch_params(); phase_gemm_inproj(p, lds); }
  if (DUP & 2) { gsync2(++nbar); Params p = fetch_params(); phase_gemm_inproj(p, lds); }
  gsync2(++nbar);
  PROBE_AT(1, pq.ws + OFF_R1, 1536)
  { Params p = fetch_params(); phase_conv(p); }
  if (DUP & 16) { gsync2(++nbar); Params p = fetch_params(); phase_conv(p); }
  gsync2(++nbar);
  PROBE_AT(2, pq.ws + OFF_R2, 1536)
  { Params p = fetch_params(); phase_ssd(p, lds); }
  if (DUP & 1) { gsync2(++nbar); Params p = fetch_params(); phase_ssd(p, lds); }
  gsync2(++nbar);
  PROBE_AT(3, pq.ws + OFF_R1, 1024)
  {
    Params p = fetch_params(); phase_gated_norm(p);
    unsigned char* tb = (unsigned char*)(p.ws + OFF_R1 + 128 * MiB);
    convert_fp8_rows(p.p_u, tb, (float*)(tb + 32 * MiB), 16384);
    convert_fp8_rows(p.p_v, tb + 16 * MiB, (float*)(tb + 32 * MiB + 65536), 16384);
  }
  gsync2(++nbar);
  PROBE_AT(4, pq.ws + OFF_R1, 1024)
  peer_block<0>(nbar, lds);
  if ((PROBE >= 5 && PROBE <= 7) || PROBE == 99) return;
  gsync2(++nbar);
  {
    Params p = fetch_params();
    phase_gemm_bf16((const u16*)((char*)p.out + 64 * MiB), (const u16*)(p.ws + OFF_W_HIN), (u16*)(p.ws + OFF_R1), 3072, lds);
  }
  gsync2(++nbar);
  PROBE_AT(8, pq.ws + OFF_R2, 1024)
  PROBE_AT(11, pq.ws + OFF_R1, 1536)
  {
    Params p = fetch_params();
    phase_shortconv_T(p, (const u16*)(p.ws + OFF_R1), (u16*)(p.ws + OFF_R2 + 128 * MiB), (u16*)p.out, (u16*)((char*)p.out + 64 * MiB), lds);
  }
  gsync2(++nbar);
  PROBE_AT(12, pq.ws + OFF_R2 + 128 * MiB, 512)
  { Params p = fetch_params(); phase_filter_fft(p, (float2*)(p.ws + OFF_R1), lds); }
  if (DUP & 32) { gsync2(++nbar); Params p = fetch_params(); phase_filter_fft(p, (float2*)(p.ws + OFF_R1), lds); }
  gsync2(++nbar);
  PROBE_AT(13, pq.ws + OFF_R1, 1024)
  {
    Params p = fetch_params();
    phase_hyena_conv(p, (const u16*)(p.ws + OFF_R2 + 128 * MiB), (const u16*)p.out, (const u16*)((char*)p.out + 64 * MiB),
                     (const float2*)(p.ws + OFF_R1), (u16*)(p.ws + OFF_R1 + 128 * MiB), lds);
  }
  if (DUP & 8) {
    gsync2(++nbar);
    Params p = fetch_params();
    phase_hyena_conv(p, (const u16*)(p.ws + OFF_R2 + 128 * MiB), (const u16*)p.out, (const u16*)((char*)p.out + 64 * MiB),
                     (const float2*)(p.ws + OFF_R1), (u16*)(p.ws + OFF_R1 + 128 * MiB), lds);
  }
  gsync2(++nbar);
  PROBE_AT(14, pq.ws + OFF_R1 + 128 * MiB, 512)
  { Params p = fetch_params(); phase_transpose_back((const u16*)(p.ws + OFF_R1 + 128 * MiB), (u16*)p.out, lds); }
  gsync2(++nbar);
  peer_block<1>(nbar, lds);
}

extern "C" void kernel_launch(void* const* d_in, const int* in_sizes, int n_in, void* d_out, int out_size, void* d_ws, size_t ws_size,
                              hipStream_t stream) {
  static int grid_blocks = 0;
  if (!grid_blocks) {
    int dev = 0, cus = 0, per_cu = 0;
    hipGetDevice(&dev);
    hipDeviceGetAttribute(&cus, hipDeviceAttributeMultiprocessorCount, dev);
    hipOccupancyMaxActiveBlocksPerMultiprocessor(&per_cu, fwd_megakernel, 256, 0);
    if (per_cu > 2) per_cu = 2;
    if (per_cu < 1) per_cu = 1;
    grid_blocks = cus * per_cu;
  }
  Params p{};
  const float** pp = reinterpret_cast<const float**>(&p);
  for (int i = 0; i < 32; ++i) pp[i] = (const float*)d_in[i];
  p.out = (float*)d_out;
  p.ws = (char*)d_ws;
  if (ws_size < WS_TOTAL) fprintf(stderr, "workspace too small: %zu < %zu\n", ws_size, (size_t)WS_TOTAL);
  (void)hipMemsetAsync((char*)d_ws + OFF_BAR, 0, 4096, stream);
  void* args[] = {&p};
  hipError_t e = hipLaunchCooperativeKernel((void*)fwd_megakernel, dim3(grid_blocks), dim3(256), args, 0, stream);
  if (e != hipSuccess) fprintf(stderr, "cooperative launch failed: %s (grid %d)\n", hipGetErrorString(e), grid_blocks);
}
```

```cpp
#define PROBE 0
#define DUP 0
#include <hip/hip_runtime.h>
#include <hip/hip_bf16.h>
#include <hip/hip_cooperative_groups.h>
#include <cstdio>
namespace cg = cooperative_groups;

typedef unsigned short u16;
using bf16x8 = __attribute__((ext_vector_type(8))) short;
using f32x4 = __attribute__((ext_vector_type(4))) float;
using u32x4 = __attribute__((ext_vector_type(4))) unsigned;

#define DEV __device__ __forceinline__

constexpr int NB = 8, SEQ = 4096, DM = 1024, NT = NB * SEQ;
constexpr int CTXL = 256, NTC = NB * CTXL;
constexpr int SSM_IN = 5184, CONVD = 3072, SSM_INNER = 2048;
constexpr float ALPHA = 1.41421356237f;
constexpr int LDS_BYTES = 71168;

constexpr size_t MiB = 1ull << 20;
constexpr size_t OFF_W_IN = 0;
constexpr size_t OFF_W_OUT = OFF_W_IN + (size_t)5184 * 1024 * 2;
constexpr size_t OFF_W_HIN = OFF_W_OUT + (size_t)1024 * 2048 * 2;
constexpr size_t OFF_W_HOUT = OFF_W_HIN + (size_t)3072 * 1024 * 2;
constexpr size_t OFF_W_Q = OFF_W_HOUT + (size_t)1024 * 1024 * 2;
constexpr size_t OFF_MOD = OFF_W_Q + (size_t)2 * 2048 * 1024 * 2;
constexpr size_t OFF_HID = OFF_MOD + 512 * 1024;
constexpr size_t OFF_DT = OFF_HID + MiB;
constexpr size_t OFF_HC = OFF_DT + 8 * MiB;
constexpr size_t OFF_XBC_C = OFF_HC + 4 * MiB;
constexpr size_t OFF_XC_C = OFF_XBC_C + 12 * MiB;
constexpr size_t OFF_DT_C = OFF_XC_C + 12 * MiB;
constexpr size_t OFF_R1 = OFF_DT_C + MiB;
constexpr size_t OFF_R2 = OFF_R1 + 192 * MiB;
constexpr size_t OFF_BAR = OFF_R2 + 192 * MiB;
constexpr size_t OFF_KEYS = OFF_BAR + 4096;
constexpr size_t WS_TOTAL = OFF_KEYS + MiB;

struct Params {
  const float *x, *c, *ctx, *c_ctx, *ada_w, *ada_b, *ln_g, *ln_b;
  const float *m_w_in, *m_conv_w, *m_conv_b, *m_a_log, *m_dt_bias, *m_d, *m_norm_w, *m_w_out;
  const float *h_w_in, *h_conv_w, *h_conv_b, *h_f_w1, *h_f_b1, *h_f_w2, *h_f_b2, *h_f_w3, *h_freq, *h_bias, *h_w_out;
  const float *p_wq, *p_k1, *p_k2, *p_u, *p_v;
  float* out;
  char* ws;
};

DEV u16 f2bf(float f) {
  unsigned u = __float_as_uint(f);
  u += 0x7fffu + ((u >> 16) & 1u);
  return (u16)(u >> 16);
}
DEV float bf2f(u16 h) { return __uint_as_float(((unsigned)h) << 16); }
DEV float bflo(unsigned w) { return __uint_as_float(w << 16); }
DEV float bfhi(unsigned w) { return __uint_as_float(w & 0xffff0000u); }
DEV unsigned pack2(float a, float b) { return (unsigned)f2bf(a) | ((unsigned)f2bf(b) << 16); }
DEV float wave_sum(float v) {
#pragma unroll
  for (int o = 32; o > 0; o >>= 1) v += __shfl_xor(v, o);
  return v;
}
DEV int otid() { int t = threadIdx.x; asm volatile("" : "+v"(t)); return t; }
DEV unsigned ordkey(float f) { unsigned u = __float_as_uint(f); return (u & 0x80000000u) ? ~u : (u | 0x80000000u); }
DEV float siluf(float v) { return v / (1.f + __expf(-v)); }
DEV f32x4 mfma16(bf16x8 a, bf16x8 b, f32x4 c) { return __builtin_amdgcn_mfma_f32_16x16x32_bf16(a, b, c, 0, 0, 0); }
DEV bf16x8 ld8(const u16* p) { return *reinterpret_cast<const bf16x8*>(p); }

template <int I>
DEV const float* karg() {
  unsigned long long v;
  asm volatile("s_load_dwordx2 %0, %1, %2\n\ts_waitcnt lgkmcnt(0)" : "=s"(v) : "s"(__builtin_amdgcn_kernarg_segment_ptr()), "n"(I * 8));
  return (const float*)(const __attribute__((address_space(1))) float*)v;
}
DEV Params fetch_params() {
  Params q;
  q.x = karg<0>(); q.c = karg<1>(); q.ctx = karg<2>(); q.c_ctx = karg<3>(); q.ada_w = karg<4>(); q.ada_b = karg<5>(); q.ln_g = karg<6>(); q.ln_b = karg<7>();
  q.m_w_in = karg<8>(); q.m_conv_w = karg<9>(); q.m_conv_b = karg<10>(); q.m_a_log = karg<11>(); q.m_dt_bias = karg<12>(); q.m_d = karg<13>();
  q.m_norm_w = karg<14>(); q.m_w_out = karg<15>();
  q.h_w_in = karg<16>(); q.h_conv_w = karg<17>(); q.h_conv_b = karg<18>(); q.h_f_w1 = karg<19>(); q.h_f_b1 = karg<20>(); q.h_f_w2 = karg<21>();
  q.h_f_b2 = karg<22>(); q.h_f_w3 = karg<23>(); q.h_freq = karg<24>(); q.h_bias = karg<25>(); q.h_w_out = karg<26>();
  q.p_wq = karg<27>(); q.p_k1 = karg<28>(); q.p_k2 = karg<29>(); q.p_u = karg<30>(); q.p_v = karg<31>();
  q.out = (float*)karg<32>(); q.ws = (char*)karg<33>();
  return q;
}

__device__ __forceinline__ void transpose_w_tile(const float* src, int srcld, int K, int N, u16* dst, int item, char* lds) {
  float* tile = (float*)lds;
  int ntn = N / 64;
  int kt = item / ntn, nt = item % ntn;
  int tid = otid();
#pragma unroll
  for (int i = 0; i < 4; ++i) {
    int r = (tid >> 4) + i * 16, c4 = (tid & 15) * 4;
    float4 v = *reinterpret_cast<const float4*>(src + (size_t)(kt * 64 + r) * srcld + nt * 64 + c4);
    tile[r * 65 + c4 + 0] = v.x; tile[r * 65 + c4 + 1] = v.y; tile[r * 65 + c4 + 2] = v.z; tile[r * 65 + c4 + 3] = v.w;
  }
  __syncthreads();
#pragma unroll
  for (int i = 0; i < 2; ++i) {
    int n = (tid >> 3) + i * 32, k8 = (tid & 7) * 8;
    uint4 o;
    o.x = pack2(tile[(k8 + 0) * 65 + n], tile[(k8 + 1) * 65 + n]);
    o.y = pack2(tile[(k8 + 2) * 65 + n], tile[(k8 + 3) * 65 + n]);
    o.z = pack2(tile[(k8 + 4) * 65 + n], tile[(k8 + 5) * 65 + n]);
    o.w = pack2(tile[(k8 + 6) * 65 + n], tile[(k8 + 7) * 65 + n]);
    *reinterpret_cast<uint4*>(dst + (size_t)(nt * 64 + n) * K + kt * 64 + k8) = o;
  }
  __syncthreads();
}

__device__ __forceinline__ void ada_item(const Params& p, int item, char* lds) {
  float* sl = (float*)lds;
  float* red = sl + 9 * 1024;
  int layer = item / 96, cg_ = item % 96;
  int tid = otid(), kq = tid >> 6, col = cg_ * 64 + (tid & 63);
  for (int e = tid; e < 9 * 1024; e += 256) {
    int r = e >> 10, k = e & 1023;
    sl[e] = siluf(r < 8 ? p.c[r * 1024 + k] : p.c_ctx[k]);
  }
  __syncthreads();
  float acc[9];
#pragma unroll
  for (int r = 0; r < 9; ++r) acc[r] = 0.f;
  const float* w = p.ada_w + (size_t)layer * 1024 * 6144 + col;
#pragma unroll 8
  for (int k = kq * 256; k < kq * 256 + 256; ++k) {
    float wv = w[(size_t)k * 6144];
#pragma unroll
    for (int r = 0; r < 9; ++r) acc[r] += sl[r * 1024 + k] * wv;
  }
#pragma unroll
  for (int r = 0; r < 9; ++r) red[(kq * 9 + r) * 64 + (tid & 63)] = acc[r];
  __syncthreads();
  if (tid < 64) {
    float* mod = (float*)(p.ws + OFF_MOD);
    float bias = p.ada_b[layer * 6144 + col];
#pragma unroll
    for (int r = 0; r < 9; ++r) {
      float s = red[(0 * 9 + r) * 64 + tid] + red[(1 * 9 + r) * 64 + tid] + red[(2 * 9 + r) * 64 + tid] + red[(3 * 9 + r) * 64 + tid];
      mod[((size_t)layer * 9 + r) * 6144 + col] = s + bias;
    }
  }
  __syncthreads();
}

__device__ __forceinline__ void hyena_mlp_item(const Params& p, int item, char* lds) {
  float* zb = (float*)lds;
  float* h1 = zb + 256;
  float* h2 = h1 + 256;
  int tid = otid(), ti = tid >> 6, j = tid & 63;
  int t = item * 4 + ti;
  const float L = 4096.f;
  if (j < 33) {
    float v;
    if (j == 0) v = (float)t / 4095.f;
    else {
      int k = (j - 1) & 15;
      float fb = 1e-4f + (float)k * ((15.f - 1e-4f) / 15.f);
      float ang = 6.283185307179586f * (float)t / L;
      float a = fb * ang;
      v = (j <= 16) ? cosf(a) : -sinf(a);
    }
    zb[ti * 64 + j] = v;
  }
  __syncthreads();
  float fr = p.h_freq[j];
  float s = p.h_f_b1[j];
#pragma unroll 3
  for (int i = 0; i < 33; ++i) s += zb[ti * 64 + i] * p.h_f_w1[i * 64 + j];
  h1[ti * 64 + j] = sinf(fr * s);
  __syncthreads();
  s = p.h_f_b2[j];
#pragma unroll 8
  for (int i = 0; i < 64; ++i) s += h1[ti * 64 + i] * p.h_f_w2[i * 64 + j];
  h2[ti * 64 + j] = sinf(fr * s);
  __syncthreads();
  s = p.h_f_b2[64 + j];
#pragma unroll 8
  for (int i = 0; i < 64; ++i) s += h2[ti * 64 + i] * p.h_f_w2[4096 + i * 64 + j];
  float* hid = (float*)(p.ws + OFF_HID);
  hid[t * 64 + j] = sinf(fr * s);
  __syncthreads();
}

__device__ __forceinline__ void phase_prologue(const Params& p, char* lds) {
  constexpr int T0 = 1296, T1 = T0 + 512, T2 = T1 + 768, T3 = T2 + 256, T4 = T3 + 512, T5 = T4 + 512, T6 = T5 + 192, T7 = T6 + 1024, T8 = T7 + 256;
  for (int item = blockIdx.x; item < T8; item += gridDim.x) {
    if (item < T0) transpose_w_tile(p.m_w_in, SSM_IN, 1024, SSM_IN, (u16*)(p.ws + OFF_W_IN), item, lds);
    else if (item < T1) transpose_w_tile(p.m_w_out, 1024, 2048, 1024, (u16*)(p.ws + OFF_W_OUT), item - T0, lds);
    else if (item < T2) transpose_w_tile(p.h_w_in, 3072, 1024, 3072, (u16*)(p.ws + OFF_W_HIN), item - T1, lds);
    else if (item < T3) transpose_w_tile(p.h_w_out, 1024, 1024, 1024, (u16*)(p.ws + OFF_W_HOUT), item - T2, lds);
    else if (item < T4) transpose_w_tile(p.p_wq, 2048, 1024, 2048, (u16*)(p.ws + OFF_W_Q), item - T3, lds);
    else if (item < T5) transpose_w_tile(p.p_wq + (size_t)1024 * 2048, 2048, 1024, 2048, (u16*)(p.ws + OFF_W_Q) + (size_t)2048 * 1024, item - T4, lds);
    else if (item < T6) ada_item(p, item - T5, lds);
    else if (item < T7) hyena_mlp_item(p, item - T6, lds);
    else {
      int e8 = ((item - T7) * 256 + threadIdx.x) * 8;
      const float* src = e8 < 262144 ? p.p_k1 + e8 : p.p_k2 + (e8 - 262144);
      float4 a0 = *reinterpret_cast<const float4*>(src), a1 = *reinterpret_cast<const float4*>(src + 4);
      uint4 o;
      o.x = pack2(a0.x, a0.y); o.y = pack2(a0.z, a0.w); o.z = pack2(a1.x, a1.y); o.w = pack2(a1.z, a1.w);
      *reinterpret_cast<uint4*>((u16*)(p.ws + OFF_KEYS) + e8) = o;
    }
  }
}

__device__ __forceinline__ void modulate_rows(const float* src, u16* dst, int nrows, int rows_per_batch, const float* modbase, int sh_off, int sc_off, bool ctxrow) {
  size_t total = (size_t)nrows * 128;
  for (size_t e = (size_t)blockIdx.x * 256 + threadIdx.x; e < total; e += (size_t)gridDim.x * 256) {
    int row = (int)(e >> 7), c8 = (int)(e & 127) * 8;
    int b = ctxrow ? 8 : row / rows_per_batch;
    const float* m = modbase + (size_t)b * 6144;
    float4 a0 = *reinterpret_cast<const float4*>(src + (size_t)row * 1024 + c8);
    float4 a1 = *reinterpret_cast<const float4*>(src + (size_t)row * 1024 + c8 + 4);
    float4 s0 = *reinterpret_cast<const float4*>(m + sc_off + c8);
    float4 s1 = *reinterpret_cast<const float4*>(m + sc_off + c8 + 4);
    float4 h0 = *reinterpret_cast<const float4*>(m + sh_off + c8);
    float4 h1 = *reinterpret_cast<const float4*>(m + sh_off + c8 + 4);
    uint4 o;
    o.x = pack2(a0.x * (1.f + s0.x) + h0.x, a0.y * (1.f + s0.y) + h0.y);
    o.y = pack2(a0.z * (1.f + s0.z) + h0.z, a0.w * (1.f + s0.w) + h0.w);
    o.z = pack2(a1.x * (1.f + s1.x) + h1.x, a1.y * (1.f + s1.y) + h1.y);
    o.w = pack2(a1.z * (1.f + s1.z) + h1.z, a1.w * (1.f + s1.w) + h1.w);
    *reinterpret_cast<uint4*>(dst + (size_t)row * 1024 + c8) = o;
  }
}

constexpr int GLD = 72;
template <class Epi>
__device__ __forceinline__ void gemm_tile(const u16* __restrict__ A, int lda, const u16* __restrict__ Bt, int ldb, int brow, int bcol, int Nmax,
                                          int K, char* lds, Epi epi) {
  u16* SA = (u16*)lds;
  u16* SB = SA + 256 * GLD;
  int tid = otid(), wid = tid >> 6, lane = tid & 63, wr = wid >> 1, wc = wid & 1, fr = lane & 15, fq = lane >> 4;
  f32x4 acc[8][4];
#pragma unroll
  for (int m = 0; m < 8; ++m)
#pragma unroll
    for (int n = 0; n < 4; ++n) acc[m][n] = f32x4{0.f, 0.f, 0.f, 0.f};
  u32x4 ra[8], rb[4];
  const int lr = tid >> 3, lc = (tid & 7) * 8;
  const u16* abase = A + (size_t)brow * lda;
  const unsigned aoff = (unsigned)(lr * lda + lc);
  unsigned bo[4];
#pragma unroll
  for (int i = 0; i < 4; ++i) {
    int br = bcol + lr + i * 32;
    if (br >= Nmax) br = Nmax - 1;
    bo[i] = (unsigned)(br * ldb + lc);
  }
#define GLOADT(KT)                                                                                 \
  _Pragma("unroll") for (int i = 0; i < 8; ++i)                                                    \
    ra[i] = *reinterpret_cast<const u32x4*>(abase + (aoff + (unsigned)((i * 32) * lda + (KT) * 64))); \
  _Pragma("unroll") for (int i = 0; i < 4; ++i)                                                    \
    rb[i] = *reinterpret_cast<const u32x4*>(Bt + (bo[i] + (unsigned)((KT) * 64)));
  const int nk = K / 64;
  GLOADT(0)
  for (int kt = 0; kt < nk; ++kt) {
#pragma unroll
    for (int i = 0; i < 8; ++i) *reinterpret_cast<u32x4*>(SA + (lr + i * 32) * GLD + lc) = ra[i];
#pragma unroll
    for (int i = 0; i < 4; ++i) *reinterpret_cast<u32x4*>(SB + (lr + i * 32) * GLD + lc) = rb[i];
    __syncthreads();
    { const int kn = kt + 1 < nk ? kt + 1 : nk - 1; GLOADT(kn) }
#pragma unroll
    for (int kk = 0; kk < 2; ++kk) {
      bf16x8 Bl[4];
#pragma unroll
      for (int n = 0; n < 4; ++n) Bl[n] = ld8(SB + (wc * 64 + n * 16 + fr) * GLD + kk * 32 + fq * 8);
#pragma unroll
      for (int mh = 0; mh < 2; ++mh) {
        bf16x8 At[4];
#pragma unroll
        for (int m = 0; m < 4; ++m) At[m] = ld8(SA + (wr * 128 + (mh * 4 + m) * 16 + fr) * GLD + kk * 32 + fq * 8);
#pragma unroll
        for (int m = 0; m < 4; ++m)
#pragma unroll
          for (int n = 0; n < 4; ++n) acc[mh * 4 + m][n] = mfma16(Bl[n], At[m], acc[mh * 4 + m][n]);
      }
    }
    __syncthreads();
  }
#undef GLOADT
#pragma unroll
  for (int m = 0; m < 8; ++m)
#pragma unroll
    for (int n = 0; n < 4; ++n) epi(brow + wr * 128 + m * 16 + fr, bcol + wc * 64 + n * 16 + fq * 4, acc[m][n]);
}

DEV float softplusf(float v) { return fmaxf(v, 0.f) + log1pf(__expf(-fabsf(v))); }

__device__ __forceinline__ void phase_gemm_inproj(const Params& p, char* lds) {
  const u16* hx = (const u16*)(p.ws + OFF_R2);
  const u16* hc = (const u16*)(p.ws + OFF_HC);
  const u16* Wt = (const u16*)(p.ws + OFF_W_IN);
  u16* zbuf = (u16*)p.out;
  u16* xbc = (u16*)(p.ws + OFF_R1);
  float* dt = (float*)(p.ws + OFF_DT);
  u16* xbc_c = (u16*)(p.ws + OFF_XBC_C);
  float* dt_c = (float*)(p.ws + OFF_DT_C);
  const float* dtb = p.m_dt_bias;
  const int xcd = blockIdx.x & 7, li = blockIdx.x >> 3, nl = gridDim.x >> 3;
  {
    const int nb = (41 - xcd + 7) >> 3;
    for (int t = li; t < 128 * nb; t += nl) {
      int pm = t / nb, pn = xcd + 8 * (t % nb);
      gemm_tile(hx, 1024, Wt, 1024, pm * 256, pn * 128, SSM_IN, 1024, lds, [=](int m, int n, f32x4 v) {
        if (n < 2048) *reinterpret_cast<uint2*>(zbuf + (size_t)m * 2048 + n) = make_uint2(pack2(v[0], v[1]), pack2(v[2], v[3]));
        else if (n < 5120) *reinterpret_cast<uint2*>(xbc + (size_t)m * 3072 + (n - 2048)) = make_uint2(pack2(v[0], v[1]), pack2(v[2], v[3]));
        else if (n < 5184) {
          float4 bb = *reinterpret_cast<const float4*>(dtb + (n - 5120));
          *reinterpret_cast<float4*>(dt + (size_t)m * 64 + (n - 5120)) = make_float4(softplusf(v[0] + bb.x), softplusf(v[1] + bb.y), softplusf(v[2] + bb.z), softplusf(v[3] + bb.w));
        }
      });
    }
  }
  {
    const int nb = (25 - xcd + 7) >> 3;
    for (int t = li; t < 8 * nb; t += nl) {
      int pm = t / nb, pn = xcd + 8 * (t % nb);
      gemm_tile(hc, 1024, Wt + (size_t)2048 * 1024, 1024, pm * 256, pn * 128, 3136, 1024, lds, [=](int m, int n, f32x4 v) {
        if (n < 3072) *reinterpret_cast<uint2*>(xbc_c + (size_t)m * 3072 + n) = make_uint2(pack2(v[0], v[1]), pack2(v[2], v[3]));
        else if (n < 3136) {
          float4 bb = *reinterpret_cast<const float4*>(dtb + (n - 3072));
          *reinterpret_cast<float4*>(dt_c + (size_t)m * 64 + (n - 3072)) = make_float4(softplusf(v[0] + bb.x), softplusf(v[1] + bb.y), softplusf(v[2] + bb.z), softplusf(v[3] + bb.w));
        }
      });
    }
  }
}

DEV void fma8(float* acc, const u32x4& v, const float* w) {
  acc[0] += bflo(v[0]) * w[0]; acc[1] += bfhi(v[0]) * w[1]; acc[2] += bflo(v[1]) * w[2]; acc[3] += bfhi(v[1]) * w[3];
  acc[4] += bflo(v[2]) * w[4]; acc[5] += bfhi(v[2]) * w[5]; acc[6] += bflo(v[3]) * w[6]; acc[7] += bfhi(v[3]) * w[7];
}
__device__ __forceinline__ void phase_conv(const Params& p) {
  const u16* xbc = (const u16*)(p.ws + OFF_R1);
  u16* xc = (u16*)(p.ws + OFF_R2);
  const u16* xbc_c = (const u16*)(p.ws + OFF_XBC_C);
  u16* xc_c = (u16*)(p.ws + OFF_XC_C);
  const float* cw = p.m_conv_w;
  const float* cb = p.m_conv_b;
  const int tid_ = otid();
  const size_t nl = (size_t)8 * 64 * 8 * 384;
  for (size_t e = (size_t)blockIdx.x * 256 + tid_; e < nl; e += (size_t)gridDim.x * 256) {
    int ch = (int)(e % 384) * 8;
    int rest = (int)(e / 384);
    int cg_ = rest & 7, r = (rest >> 3) & 63, b = rest >> 9;
    float w[9][8];
#pragma unroll
    for (int k = 0; k < 9; ++k) {
      float4 w0 = *reinterpret_cast<const float4*>(cw + k * 3072 + ch), w1 = *reinterpret_cast<const float4*>(cw + k * 3072 + ch + 4);
      w[k][0] = w0.x; w[k][1] = w0.y; w[k][2] = w0.z; w[k][3] = w0.w; w[k][4] = w1.x; w[k][5] = w1.y; w[k][6] = w1.z; w[k][7] = w1.w;
    }
    float bias[8];
    {
      float4 b0 = *reinterpret_cast<const float4*>(cb + ch), b1 = *reinterpret_cast<const float4*>(cb + ch + 4);
      bias[0] = b0.x; bias[1] = b0.y; bias[2] = b0.z; bias[3] = b0.w; bias[4] = b1.x; bias[5] = b1.y; bias[6] = b1.z; bias[7] = b1.w;
    }
    const u32x4 zero4 = u32x4{0u, 0u, 0u, 0u};
    const int c0 = cg_ * 8;
    u32x4 win[3][3];
#pragma unroll
    for (int i = 0; i < 3; ++i) {
      int rr = r + i - 1;
      bool rok = rr >= 0 && rr <= 63;
      const u16* rowp = xbc + ((size_t)(b * 4096 + (rok ? rr : r) * 64)) * 3072 + ch;
      win[i][0] = (rok && c0 > 0) ? *reinterpret_cast<const u32x4*>(rowp + (size_t)(c0 - 1) * 3072) : zero4;
      win[i][1] = rok ? *reinterpret_cast<const u32x4*>(rowp + (size_t)c0 * 3072) : zero4;
    }
#pragma unroll
    for (int cc = 0; cc < 8; ++cc) {
      int c = c0 + cc;
#pragma unroll
      for (int i = 0; i < 3; ++i) {
        int rr = r + i - 1;
        bool rok = rr >= 0 && rr <= 63;
        const u16* rowp = xbc + ((size_t)(b * 4096 + (rok ? rr : r) * 64)) * 3072 + ch;
        win[i][2] = (rok && c < 63) ? *reinterpret_cast<const u32x4*>(rowp + (size_t)(c + 1) * 3072) : zero4;
      }
      float acc[8];
#pragma unroll
      for (int k = 0; k < 8; ++k) acc[k] = bias[k];
#pragma unroll
      for (int i = 0; i < 3; ++i)
#pragma unroll
        for (int j = 0; j < 3; ++j) fma8(acc, win[i][j], w[i * 3 + j]);
      uint4 o;
      o.x = pack2(siluf(acc[0]), siluf(acc[1]));
      o.y = pack2(siluf(acc[2]), siluf(acc[3]));
      o.z = pack2(siluf(acc[4]), siluf(acc[5]));
      o.w = pack2(siluf(acc[6]), siluf(acc[7]));
      *reinterpret_cast<uint4*>(xc + ((size_t)(b * 4096 + r * 64 + c)) * 3072 + ch) = o;
#pragma unroll
      for (int i = 0; i < 3; ++i) { win[i][0] = win[i][1]; win[i][1] = win[i][2]; }
    }
  }
  const size_t ncx = (size_t)NTC * 384;
  for (size_t e = (size_t)blockIdx.x * 256 + tid_; e < ncx; e += (size_t)gridDim.x * 256) {
    int tok = (int)(e / 384), ch = (int)(e % 384) * 8;
    float acc[8];
#pragma unroll
    for (int k = 0; k < 8; ++k) acc[k] = cb[ch + k];
    int b = tok >> 8, c = tok & 255;
#pragma unroll
    for (int j = 0; j < 3; ++j) {
      int cc = c + j - 1;
      if (cc < 0 || cc > 255) continue;
      uint4 v = *reinterpret_cast<const uint4*>(xbc_c + ((size_t)(b * 256 + cc)) * 3072 + ch);
      const float* w = cw + (3 + j) * 3072 + ch;
      float4 w0 = *reinterpret_cast<const float4*>(w), w1 = *reinterpret_cast<const float4*>(w + 4);
      acc[0] += bflo(v.x) * w0.x; acc[1] += bfhi(v.x) * w0.y; acc[2] += bflo(v.y) * w0.z; acc[3] += bfhi(v.y) * w0.w;
      acc[4] += bflo(v.z) * w1.x; acc[5] += bfhi(v.z) * w1.y; acc[6] += bflo(v.w) * w1.z; acc[7] += bfhi(v.w) * w1.w;
    }
    uint4 o;
    o.x = pack2(siluf(acc[0]), siluf(acc[1]));
    o.y = pack2(siluf(acc[2]), siluf(acc[3]));
    o.z = pack2(siluf(acc[4]), siluf(acc[5]));
    o.w = pack2(siluf(acc[6]), siluf(acc[7]));
    *reinterpret_cast<uint4*>(xc_c + (size_t)tok * 3072 + ch) = o;
  }
}

constexpr int SLD = 136;
__device__ __forceinline__ void phase_ssd(const Params& p, char* lds) {
  u16* xsT = (u16*)lds;
  u16* stb = xsT + 64 * SLD;
  u16* Mb = stb + 64 * SLD;
  float* cum = (float*)(Mb + 128 * SLD);
  float* dtv = cum + 128;
  float* asrc = dtv + 128;
  const u16* xc = (const u16*)(p.ws + OFF_R2);
  const u16* xc_c = (const u16*)(p.ws + OFF_XC_C);
  const float* dt = (const float*)(p.ws + OFF_DT);
  const float* dt_c = (const float*)(p.ws + OFF_DT_C);
  u16* y = (u16*)(p.ws + OFF_R1);
  int tid = otid(), w = tid >> 6, lane = tid & 63, fr = lane & 15, fq = lane >> 4;
  for (int item = blockIdx.x; item < 256; item += gridDim.x) {
    int b = item >> 5, h = item & 31, g = h >> 3;
    float dsk = p.m_d[h];
    for (int dir = 0; dir < 2; ++dir) {
      float a_neg = -__expf(p.m_a_log[dir * 32 + h]);
      f32x4 acc_s[8];
#pragma unroll
      for (int n = 0; n < 8; ++n) acc_s[n] = f32x4{0.f, 0.f, 0.f, 0.f};
      for (int step = 0; step < 34; ++step) {
        bool isctx = step < 2;
        int cidx = isctx ? step : step - 2;
        if (dir) cidx = (isctx ? 1 : 31) - cidx;
        size_t tok0 = isctx ? (size_t)(b * 256 + cidx * 128) : (size_t)(b * 4096 + cidx * 128);
        const u16* src = (isctx ? xc_c : xc) + tok0 * 3072;
        const float* dts = (isctx ? dt_c : dt) + tok0 * 64;
        int tz = tid;
        asm volatile("" : "+v"(tz));
        float dval = 0.f;
        if (tid < 128) dval = dts[tid * 64 + dir * 32 + h];
        uint4 xv[4], bv[8];
#pragma unroll
        for (int i = 0; i < 4; ++i) {
          int idx = tz + i * 256, l = (idx & 31) | ((idx >> 8) << 5), pc = ((idx >> 5) & 7) * 8;
          xv[i] = *reinterpret_cast<const uint4*>(src + (size_t)l * 3072 + h * 64 + pc);
        }
#pragma unroll
        for (int i = 0; i < 8; ++i) {
          int idx = tz + i * 256, l = (idx & 31) | (((idx >> 9) & 3) << 5), nc = (((idx >> 5) & 7) | (((idx >> 8) & 1) << 3)) * 8;
          bv[i] = *reinterpret_cast<const uint4*>(src + (size_t)l * 3072 + 2048 + g * 128 + nc);
        }
        if (tid < 128) { dtv[tid] = dval; asrc[tid] = dval * a_neg; }
#pragma unroll
        for (int i = 0; i < 4; ++i) {
          int idx = tz + i * 256, l = (idx & 31) | ((idx >> 8) << 5), pc = ((idx >> 5) & 7) * 8;
          uint4 v = xv[i];
          xsT[(pc + 0) * SLD + l] = (u16)(v.x & 0xffff); xsT[(pc + 1) * SLD + l] = (u16)(v.x >> 16);
          xsT[(pc + 2) * SLD + l] = (u16)(v.y & 0xffff); xsT[(pc + 3) * SLD + l] = (u16)(v.y >> 16);
          xsT[(pc + 4) * SLD + l] = (u16)(v.z & 0xffff); xsT[(pc + 5) * SLD + l] = (u16)(v.z >> 16);
          xsT[(pc + 6) * SLD + l] = (u16)(v.w & 0xffff); xsT[(pc + 7) * SLD + l] = (u16)(v.w >> 16);
        }
        if (!isctx) {
#pragma unroll
          for (int i = 0; i < 8; ++i) {
            int idx = tz + i * 256, l = (idx & 31) | (((idx >> 9) & 3) << 5), nc = (((idx >> 5) & 7) | (((idx >> 8) & 1) << 3)) * 8;
            *reinterpret_cast<uint4*>(Mb + l * SLD + nc) = bv[i];
          }
        }
        __syncthreads();
        bf16x8 Cf[2][4];
        if (!isctx) {
#pragma unroll
          for (int mt = 0; mt < 2; ++mt)
#pragma unroll
            for (int kk = 0; kk < 4; ++kk) Cf[mt][kk] = ld8(src + (size_t)(w * 32 + mt * 16 + fr) * 3072 + 2560 + g * 128 + kk * 32 + fq * 8);
        }
        if (tid < 128) {
          float s = 0.f;
          if (!dir) { for (int j = 0; j <= tid; ++j) s += asrc[j]; }
          else { for (int j = tid; j < 128; ++j) s += asrc[j]; }
          cum[tid] = s;
        }
        __syncthreads();
        float total = dir ? cum[0] : cum[127];
        if (!isctx) {
          float cl[2][4];
#pragma unroll
          for (int mt = 0; mt < 2; ++mt)
#pragma unroll
            for (int j = 0; j < 4; ++j) cl[mt][j] = cum[w * 32 + mt * 16 + fq * 4 + j];
          f32x4 cb0[8], cb1[8];
#pragma unroll
          for (int nt = 0; nt < 8; ++nt) {
            cb0[nt] = f32x4{0.f, 0.f, 0.f, 0.f};
            cb1[nt] = f32x4{0.f, 0.f, 0.f, 0.f};
            bool need = dir ? (nt >= w * 2) : (nt <= w * 2 + 1);
            if (need) {
#pragma unroll
              for (int kk = 0; kk < 4; ++kk) {
                bf16x8 Bf = ld8(Mb + (nt * 16 + fr) * SLD + kk * 32 + fq * 8);
                cb0[nt] = mfma16(Cf[0][kk], Bf, cb0[nt]);
                cb1[nt] = mfma16(Cf[1][kk], Bf, cb1[nt]);
              }
            }
          }
          __syncthreads();
          int zero = 0;
          asm volatile("" : "+v"(zero));
#pragma unroll
          for (int nt = 0; nt < 8; ++nt) {
            int s = nt * 16 + fr + zero;
            float cs = cum[s], ds = dtv[s];
#pragma unroll
            for (int j = 0; j < 4; ++j) {
              int l0 = w * 32 + fq * 4 + j, l1 = l0 + 16;
              bool ok0 = dir ? (s >= l0) : (s <= l0);
              bool ok1 = dir ? (s >= l1) : (s <= l1);
              float v0 = ok0 ? cb0[nt][j] * __expf(cl[0][j] - cs) * ds : 0.f;
              float v1 = ok1 ? cb1[nt][j] * __expf(cl[1][j] - cs) * ds : 0.f;
              Mb[l0 * SLD + s] = f2bf(v0);
              Mb[l1 * SLD + s] = f2bf(v1);
            }
          }
          __syncthreads();
          f32x4 ya[2][4];
#pragma unroll
          for (int mt = 0; mt < 2; ++mt)
#pragma unroll
            for (int nt = 0; nt < 4; ++nt) ya[mt][nt] = f32x4{0.f, 0.f, 0.f, 0.f};
#pragma unroll
          for (int kk = 0; kk < 4; ++kk)
#pragma unroll
            for (int nt = 0; nt < 4; ++nt) {
              bf16x8 Sf = ld8(stb + (nt * 16 + fr) * SLD + kk * 32 + fq * 8);
              ya[0][nt] = mfma16(Cf[0][kk], Sf, ya[0][nt]);
              ya[1][nt] = mfma16(Cf[1][kk], Sf, ya[1][nt]);
            }
#pragma unroll
          for (int mt = 0; mt < 2; ++mt)
#pragma unroll
            for (int j = 0; j < 4; ++j) {
              float e = __expf(cl[mt][j]);
#pragma unroll
              for (int nt = 0; nt < 4; ++nt) ya[mt][nt][j] *= e;
            }
#pragma unroll
          for (int kk = 0; kk < 4; ++kk) {
            bf16x8 Mf0 = ld8(Mb + (w * 32 + fr) * SLD + kk * 32 + fq * 8);
            bf16x8 Mf1 = ld8(Mb + (w * 32 + 16 + fr) * SLD + kk * 32 + fq * 8);
#pragma unroll
            for (int nt = 0; nt < 4; ++nt) {
              bf16x8 Xf = ld8(xsT + (nt * 16 + fr) * SLD + kk * 32 + fq * 8);
              ya[0][nt] = mfma16(Mf0, Xf, ya[0][nt]);
              ya[1][nt] = mfma16(Mf1, Xf, ya[1][nt]);
            }
          }
#pragma unroll
          for (int i = 0; i < 8; ++i) {
            int idx = tz + i * 256, l = (idx & 31) | (((idx >> 9) & 3) << 5), nc = (((idx >> 5) & 7) | (((idx >> 8) & 1) << 3)) * 8;
            bv[i] = *reinterpret_cast<const uint4*>(src + (size_t)l * 3072 + 2048 + g * 128 + nc);
          }
#pragma unroll
          for (int mt = 0; mt < 2; ++mt)
#pragma unroll
            for (int nt = 0; nt < 4; ++nt)
#pragma unroll
              for (int j = 0; j < 4; ++j) {
                int l = w * 32 + mt * 16 + fq * 4 + j, pp = nt * 16 + fr;
                u16* yp = y + (tok0 + l) * 2048 + h * 64 + pp;
                float val = ya[mt][nt][j];
                if (!dir) val += bf2f(xsT[pp * SLD + l]) * dsk;
                else val += bf2f(*yp);
                *yp = f2bf(val);
              }
        }
        if (step == 33) continue;
        __syncthreads();
#pragma unroll
        for (int i = 0; i < 8; ++i) {
          int idx = tz + i * 256, l = (idx & 31) | (((idx >> 9) & 3) << 5), nc = (((idx >> 5) & 7) | (((idx >> 8) & 1) << 3)) * 8;
          uint4 v = bv[i];
          float sc = dtv[l] * __expf(total - cum[l]);
          Mb[(nc + 0) * SLD + l] = f2bf(bflo(v.x) * sc); Mb[(nc + 1) * SLD + l] = f2bf(bfhi(v.x) * sc);
          Mb[(nc + 2) * SLD + l] = f2bf(bflo(v.y) * sc); Mb[(nc + 3) * SLD + l] = f2bf(bfhi(v.y) * sc);
          Mb[(nc + 4) * SLD + l] = f2bf(bflo(v.z) * sc); Mb[(nc + 5) * SLD + l] = f2bf(bfhi(v.z) * sc);
          Mb[(nc + 6) * SLD + l] = f2bf(bflo(v.w) * sc); Mb[(nc + 7) * SLD + l] = f2bf(bfhi(v.w) * sc);
        }
        __syncthreads();
        float cd = __expf(total);
#pragma unroll
        for (int nt = 0; nt < 8; ++nt) acc_s[nt] *= cd;
#pragma unroll
        for (int kk = 0; kk < 4; ++kk) {
          bf16x8 Af = ld8(xsT + (w * 16 + fr) * SLD + kk * 32 + fq * 8);
#pragma unroll
          for (int nt = 0; nt < 8; ++nt) {
            bf16x8 Bf = ld8(Mb + (nt * 16 + fr) * SLD + kk * 32 + fq * 8);
            acc_s[nt] = mfma16(Af, Bf, acc_s[nt]);
          }
        }
#pragma unroll
        for (int nt = 0; nt < 8; ++nt)
#pragma unroll
          for (int j = 0; j < 4; ++j) stb[(w * 16 + fq * 4 + j) * SLD + nt * 16 + fr] = f2bf(acc_s[nt][j]);
        __syncthreads();
      }
      __syncthreads();
    }
  }
}

__device__ __forceinline__ void phase_gated_norm(const Params& p) {
  u16* y = (u16*)(p.ws + OFF_R1);
  const u16* z = (const u16*)p.out;
  const int tid_ = otid();
  int lane = tid_ & 63;
  int wave = blockIdx.x * 4 + (tid_ >> 6), nw = gridDim.x * 4;
  for (int tok = wave; tok < NT; tok += nw) {
#pragma unroll
    for (int g = 0; g < 4; ++g) {
      int ch = g * 512 + lane * 8;
      uint4 yv = *reinterpret_cast<const uint4*>(y + (size_t)tok * 2048 + ch);
      uint4 zv = *reinterpret_cast<const uint4*>(z + (size_t)tok * 2048 + ch);
      float u[8];
      u[0] = bflo(yv.x) * siluf(bflo(zv.x)); u[1] = bfhi(yv.x) * siluf(bfhi(zv.x));
      u[2] = bflo(yv.y) * siluf(bflo(zv.y)); u[3] = bfhi(yv.y) * siluf(bfhi(zv.y));
      u[4] = bflo(yv.z) * siluf(bflo(zv.z)); u[5] = bfhi(yv.z) * siluf(bfhi(zv.z));
      u[6] = bflo(yv.w) * siluf(bflo(zv.w)); u[7] = bfhi(yv.w) * siluf(bfhi(zv.w));
      float ss = 0.f;
#pragma unroll
      for (int k = 0; k < 8; ++k) ss += u[k] * u[k];
      ss = wave_sum(ss);
      float sc = rsqrtf(ss * (1.f / 512.f) + 1e-5f);
      float4 w0 = *reinterpret_cast<const float4*>(p.m_norm_w + ch), w1 = *reinterpret_cast<const float4*>(p.m_norm_w + ch + 4);
      uint4 o;
      o.x = pack2(u[0] * sc * w0.x, u[1] * sc * w0.y);
      o.y = pack2(u[2] * sc * w0.z, u[3] * sc * w0.w);
      o.z = pack2(u[4] * sc * w1.x, u[5] * sc * w1.y);
      o.w = pack2(u[6] * sc * w1.z, u[7] * sc * w1.w);
      *reinterpret_cast<uint4*>(y + (size_t)tok * 2048 + ch) = o;
    }
  }
}

__device__ __forceinline__ void phase_gemm_resid(const u16* A, int K, const u16* Wt, const float* res, float* dst, const float* gate  , char* lds) {
  const int xcd = blockIdx.x & 7, li = blockIdx.x >> 3, nl = gridDim.x >> 3;
  for (int t = li; t < 128; t += nl) {
    int pm = t, pn = xcd;
    gemm_tile(A, K, Wt, K, pm * 256, pn * 128, 1024, K, lds, [=](int m, int n, f32x4 v) {
      int b = m >> 12;
      float4 r = *reinterpret_cast<const float4*>(res + (size_t)m * 1024 + n);
      float4 g = *reinterpret_cast<const float4*>(gate + (size_t)b * 6144 + n);
      *reinterpret_cast<float4*>(dst + (size_t)m * 1024 + n) = make_float4(ALPHA * r.x + g.x * v[0], ALPHA * r.y + g.y * v[1], ALPHA * r.z + g.z * v[2], ALPHA * r.w + g.w * v[3]);
    });
  }
}
__device__ __forceinline__ void phase_gemm_bf16(const u16* A, const u16* Wt, u16* dst, int N, char* lds) {
  const int xcd = blockIdx.x & 7, li = blockIdx.x >> 3, nl = gridDim.x >> 3;
  const int nb = N / 1024;
  for (int t = li; t < 128 * nb; t += nl) {
    int pm = t / nb, pn = xcd + 8 * (t % nb);
    gemm_tile(A, 1024, Wt, 1024, pm * 256, pn * 128, N, 1024, lds, [=](int m, int n, f32x4 v) { *reinterpret_cast<uint2*>(dst + (size_t)m * N + n) = make_uint2(pack2(v[0], v[1]), pack2(v[2], v[3])); });
  }
}

__device__ __forceinline__ void phase_ln_mod(float* xio, const float* g, const float* bta, const float* mod  , u16* tdst) {
  const int tid_ = otid();
  int lane = tid_ & 63;
  int wave = blockIdx.x * 4 + (tid_ >> 6), nw = gridDim.x * 4;
  for (int tok = wave; tok < NT; tok += nw) {
    int b = tok >> 12;
    float4 v[4];
    float s = 0.f;
#pragma unroll
    for (int i = 0; i < 4; ++i) {
      v[i] = *reinterpret_cast<const float4*>(xio + (size_t)tok * 1024 + i * 256 + lane * 4);
      s += v[i].x + v[i].y + v[i].z + v[i].w;
    }
    float mu = wave_sum(s) * (1.f / 1024.f);
    float q = 0.f;
#pragma unroll
    for (int i = 0; i < 4; ++i) {
      v[i].x -= mu; v[i].y -= mu; v[i].z -= mu; v[i].w -= mu;
      q += v[i].x * v[i].x + v[i].y * v[i].y + v[i].z * v[i].z + v[i].w * v[i].w;
    }
    float rs = rsqrtf(wave_sum(q) * (1.f / 1024.f) + 1e-5f);
    const float* m = mod + (size_t)b * 6144;
#pragma unroll
    for (int i = 0; i < 4; ++i) {
      int c = i * 256 + lane * 4;
      float4 gg = *reinterpret_cast<const float4*>(g + c), bb = *reinterpret_cast<const float4*>(bta + c);
      float4 o;
      o.x = v[i].x * rs * gg.x + bb.x; o.y = v[i].y * rs * gg.y + bb.y; o.z = v[i].z * rs * gg.z + bb.z; o.w = v[i].w * rs * gg.w + bb.w;
      *reinterpret_cast<float4*>(xio + (size_t)tok * 1024 + c) = o;
      float4 sh = *reinterpret_cast<const float4*>(m + 3072 + c), sc = *reinterpret_cast<const float4*>(m + 4096 + c);
      uint2 t;
      t.x = pack2(o.x * (1.f + sc.x) + sh.x, o.y * (1.f + sc.y) + sh.y);
      t.y = pack2(o.z * (1.f + sc.z) + sh.z, o.w * (1.f + sc.w) + sh.w);
      *reinterpret_cast<uint2*>(tdst + (size_t)tok * 1024 + c) = t;
    }
  }
}

__device__ __forceinline__ void phase_peer_topk(const u16* q, const u16* k1, const u16* k2, int* idxo, float* gateo, char* lds) {
  float* S = (float*)lds;
  float* sv = S + 64 * 129;
  int* si = (int*)(sv + 64 * 16);
  int tid = otid(), w = tid >> 6, lane = tid & 63, fr = lane & 15, fq = lane >> 4;
  const int slot = lane;
  const bool cvalid = lane < 50;
  int ci = slot < 42 ? ((slot >= 16) + (slot >= 24) + (slot >= 29) + (slot >= 33) + (slot >= 36) + (slot >= 38) + (slot >= 40)) : slot - 34;
  const unsigned long long PACK = 0ull | (16ull << 8) | (24ull << 16) | (29ull << 24) | (33ull << 32) | (36ull << 40) | (38ull << 48) | (40ull << 56);
  int cj = slot - (ci < 8 ? (int)((PACK >> (8 * ci)) & 0xFF) : 34 + ci);
  if (!cvalid) { ci = 0; cj = 0; }
  for (int item = blockIdx.x; item < 1024 * 8; item += gridDim.x) {
    int tile = item >> 3, h = item & 7;
    int tok0 = tile * 32;
    {
      int half = w >> 1, kb = (w & 1) * 64;
      const u16* kk_ = (half ? k2 : k1) + (size_t)h * 128 * 128;
      bf16x8 Af[2][4], Bf[4][4];
#pragma unroll
      for (int m = 0; m < 2; ++m)
#pragma unroll
        for (int ks = 0; ks < 4; ++ks) Af[m][ks] = ld8(q + (size_t)(tok0 + m * 16 + fr) * 2048 + h * 256 + half * 128 + ks * 32 + fq * 8);
#pragma unroll
      for (int n = 0; n < 4; ++n)
#pragma unroll
        for (int ks = 0; ks < 4; ++ks) Bf[n][ks] = ld8(kk_ + (size_t)(kb + n * 16 + fr) * 128 + ks * 32 + fq * 8);
      f32x4 acc[2][4];
#pragma unroll
      for (int m = 0; m < 2; ++m)
#pragma unroll
        for (int n = 0; n < 4; ++n) acc[m][n] = f32x4{0.f, 0.f, 0.f, 0.f};
#pragma unroll
      for (int ks = 0; ks < 4; ++ks)
#pragma unroll
        for (int n = 0; n < 4; ++n) {
          acc[0][n] = mfma16(Af[0][ks], Bf[n][ks], acc[0][n]);
          acc[1][n] = mfma16(Af[1][ks], Bf[n][ks], acc[1][n]);
        }
#pragma unroll
      for (int m = 0; m < 2; ++m)
#pragma unroll
        for (int n = 0; n < 4; ++n)
#pragma unroll
          for (int j = 0; j < 4; ++j) S[(half * 32 + m * 16 + fq * 4 + j) * 129 + kb + n * 16 + fr] = acc[m][n][j];
    }
    __syncthreads();
#pragma unroll 1
    for (int li = 0; li < 16; ++li) {
      int list = w * 16 + li;
      const float* row = S + list * 129;
      float vlo = row[lane], vhi = row[lane + 64];
      unsigned long long klo = ((unsigned long long)ordkey(vlo) << 7) | (unsigned)(127 - lane);
      unsigned long long khi = ((unsigned long long)ordkey(vhi) << 7) | (unsigned)(63 - lane);
      unsigned long long T = 0;
#pragma unroll 3
      for (int bit = 38; bit >= 0; --bit) {
        unsigned long long cand = T | (1ull << bit);
        int cnt = __popcll(__ballot(klo >= cand)) + __popcll(__ballot(khi >= cand));
        if (cnt >= 16) T = cand;
        if (cnt == 16) break;
      }
      bool slo = klo >= T, shi = khi >= T;
      unsigned long long mlo = __ballot(slo), mhi = __ballot(shi);
      int rlo = 0, rhi = 0;
      int klo_l = (int)(unsigned)klo, klo_h = (int)(unsigned)(klo >> 32), khi_l = (int)(unsigned)khi, khi_h = (int)(unsigned)(khi >> 32);
      while (mlo) {
        int src = __ffsll((long long)mlo) - 1;
        mlo &= mlo - 1;
        unsigned long long ks = ((unsigned long long)(unsigned)__builtin_amdgcn_readlane(klo_h, src) << 32) | (unsigned)__builtin_amdgcn_readlane(klo_l, src);
        rlo += (ks > klo) ? 1 : 0;
        rhi += (ks > khi) ? 1 : 0;
      }
      while (mhi) {
        int src = __ffsll((long long)mhi) - 1;
        mhi &= mhi - 1;
        unsigned long long ks = ((unsigned long long)(unsigned)__builtin_amdgcn_readlane(khi_h, src) << 32) | (unsigned)__builtin_amdgcn_readlane(khi_l, src);
        rlo += (ks > klo) ? 1 : 0;
        rhi += (ks > khi) ? 1 : 0;
      }
      if (slo) { sv[list * 16 + rlo] = vlo; si[list * 16 + rlo] = lane; }
      if (shi) { sv[list * 16 + rhi] = vhi; si[list * 16 + rhi] = lane + 64; }
    }
    __syncthreads();
#pragma unroll 1
    for (int tt = 0; tt < 8; ++tt) {
      int tok = w * 8 + tt;
      float sc_ = sv[tok * 16 + ci] + sv[(32 + tok) * 16 + cj];
      unsigned long long key = cvalid ? ((((unsigned long long)ordkey(sc_)) << 6) | (unsigned)(63 - lane)) : 0ull;
      unsigned long long T = 0;
#pragma unroll 3
      for (int bit = 37; bit >= 0; --bit) {
        unsigned long long cand = T | (1ull << bit);
        int cnt = __popcll(__ballot(key >= cand));
        if (cnt >= 16) T = cand;
        if (cnt == 16) break;
      }
      bool sel = cvalid && key >= T;
      unsigned long long msel = __ballot(sel);
      int rank = 0;
      int k_l = (int)(unsigned)key, k_h = (int)(unsigned)(key >> 32);
      int isc = __float_as_int(sc_);
      unsigned long long mm = msel;
      float mx = -INFINITY;
      while (mm) {
        int src = __ffsll((long long)mm) - 1;
        mm &= mm - 1;
        unsigned long long ks = ((unsigned long long)(unsigned)__builtin_amdgcn_readlane(k_h, src) << 32) | (unsigned)__builtin_amdgcn_readlane(k_l, src);
        rank += (ks > key) ? 1 : 0;
        mx = fmaxf(mx, __int_as_float(__builtin_amdgcn_readlane(isc, src)));
      }
      float ex = sel ? __expf(sc_ - mx) : 0.f;
      int iex = __float_as_int(ex);
      float sum = 0.f;
      mm = msel;
      while (mm) {
        int src = __ffsll((long long)mm) - 1;
        mm &= mm - 1;
        sum += __int_as_float(__builtin_amdgcn_readlane(iex, src));
      }
      if (sel) {
        size_t o = (size_t)(tok0 + tok) * 128 + h * 16 + rank;
        gateo[o] = ex / sum;
        idxo[o] = si[tok * 16 + ci] * 128 + si[(32 + tok) * 16 + cj];
      }
    }
  }
  __syncthreads();
}

DEV float gelu_exact(float v) { return 0.5f * v * (1.f + erff(v * 0.70710678118654752f)); }

typedef float f32x2 __attribute__((ext_vector_type(2)));
__device__ __forceinline__ void convert_fp8_rows(const float* src, unsigned char* dst, float* rscale, int nrows) {
  const int tid_ = otid();
  int lane = tid_ & 63;
  int wave = blockIdx.x * 4 + (tid_ >> 6), nw = gridDim.x * 4;
  for (int row = wave; row < nrows; row += nw) {
    const float* r = src + (size_t)row * 1024 + lane * 16;
    float4 a0 = *reinterpret_cast<const float4*>(r), a1 = *reinterpret_cast<const float4*>(r + 4);
    float4 a2 = *reinterpret_cast<const float4*>(r + 8), a3 = *reinterpret_cast<const float4*>(r + 12);
    float m = fmaxf(fmaxf(fmaxf(fabsf(a0.x), fabsf(a0.y)), fmaxf(fabsf(a0.z), fabsf(a0.w))), fmaxf(fmaxf(fabsf(a1.x), fabsf(a1.y)), fmaxf(fabsf(a1.z), fabsf(a1.w))));
    m = fmaxf(m, fmaxf(fmaxf(fmaxf(fabsf(a2.x), fabsf(a2.y)), fmaxf(fabsf(a2.z), fabsf(a2.w))), fmaxf(fmaxf(fabsf(a3.x), fabsf(a3.y)), fmaxf(fabsf(a3.z), fabsf(a3.w)))));
#pragma unroll
    for (int o = 32; o > 0; o >>= 1) m = fmaxf(m, __shfl_xor(m, o));
    float sc = m > 0.f ? exp2f(floorf(log2f(224.f / m))) : 1.f;
    uint4 o;
    int p;
    p = __builtin_amdgcn_cvt_pk_fp8_f32(a0.x * sc, a0.y * sc, 0, false); p = __builtin_amdgcn_cvt_pk_fp8_f32(a0.z * sc, a0.w * sc, p, true); o.x = (unsigned)p;
    p = __builtin_amdgcn_cvt_pk_fp8_f32(a1.x * sc, a1.y * sc, 0, false); p = __builtin_amdgcn_cvt_pk_fp8_f32(a1.z * sc, a1.w * sc, p, true); o.y = (unsigned)p;
    p = __builtin_amdgcn_cvt_pk_fp8_f32(a2.x * sc, a2.y * sc, 0, false); p = __builtin_amdgcn_cvt_pk_fp8_f32(a2.z * sc, a2.w * sc, p, true); o.z = (unsigned)p;
    p = __builtin_amdgcn_cvt_pk_fp8_f32(a3.x * sc, a3.y * sc, 0, false); p = __builtin_amdgcn_cvt_pk_fp8_f32(a3.z * sc, a3.w * sc, p, true); o.w = (unsigned)p;
    *reinterpret_cast<uint4*>(dst + (size_t)row * 1024 + lane * 16) = o;
    if (lane == 0) rscale[row] = 1.f / sc;
  }
}

#define F8X(dst, WW) { dst[0] = __builtin_amdgcn_cvt_pk_f32_fp8((int)(WW).x, false); dst[1] = __builtin_amdgcn_cvt_pk_f32_fp8((int)(WW).x, true); \
                      dst[2] = __builtin_amdgcn_cvt_pk_f32_fp8((int)(WW).y, false); dst[3] = __builtin_amdgcn_cvt_pk_f32_fp8((int)(WW).y, true); \
                      dst[4] = __builtin_amdgcn_cvt_pk_f32_fp8((int)(WW).z, false); dst[5] = __builtin_amdgcn_cvt_pk_f32_fp8((int)(WW).z, true); \
                      dst[6] = __builtin_amdgcn_cvt_pk_f32_fp8((int)(WW).w, false); dst[7] = __builtin_amdgcn_cvt_pk_f32_fp8((int)(WW).w, true); }

__device__ __forceinline__ void phase_peer_gather(const u16* tin, const int* idx, const float* gate, const unsigned char* utab, const unsigned char* vtab,
                                  const float* urs, const float* vrs, const float* xres,
                                  const float* g2  , const float* lng, const float* lnb, float* xout,
                                  const float* modnext  , u16* hxout) {
  const int tid_ = otid();
  int lane = tid_ & 63;
  int wave = blockIdx.x * 4 + (tid_ >> 6), nw = gridDim.x * 4;
  for (int tok = wave; tok < NT; tok += nw) {
    int b = tok >> 12;
    f32x2 t2[8];
    {
      uint4 ta = *reinterpret_cast<const uint4*>(tin + (size_t)tok * 1024 + lane * 16);
      uint4 tb = *reinterpret_cast<const uint4*>(tin + (size_t)tok * 1024 + lane * 16 + 8);
      t2[0] = f32x2{bflo(ta.x), bfhi(ta.x)}; t2[1] = f32x2{bflo(ta.y), bfhi(ta.y)}; t2[2] = f32x2{bflo(ta.z), bfhi(ta.z)}; t2[3] = f32x2{bflo(ta.w), bfhi(ta.w)};
      t2[4] = f32x2{bflo(tb.x), bfhi(tb.x)}; t2[5] = f32x2{bflo(tb.y), bfhi(tb.y)}; t2[6] = f32x2{bflo(tb.z), bfhi(tb.z)}; t2[7] = f32x2{bflo(tb.w), bfhi(tb.w)};
    }
    int id0 = idx[(size_t)tok * 128 + lane] & 16383, id1 = idx[(size_t)tok * 128 + 64 + lane] & 16383;
    int gt0 = __float_as_int(gate[(size_t)tok * 128 + lane]), gt1 = __float_as_int(gate[(size_t)tok * 128 + 64 + lane]);
    f32x2 acc2[8];
#pragma unroll
    for (int k = 0; k < 8; ++k) acc2[k] = f32x2{0.f, 0.f};
#pragma unroll 1
    for (int j = 0; j < 128; j += 4) {
      int e[4];
      float g[4];
      if (j < 64) {
#pragma unroll
        for (int q = 0; q < 4; ++q) { e[q] = __builtin_amdgcn_readlane(id0, j + q); g[q] = __int_as_float(__builtin_amdgcn_readlane(gt0, j + q)); }
      } else {
#pragma unroll
        for (int q = 0; q < 4; ++q) { e[q] = __builtin_amdgcn_readlane(id1, j - 64 + q); g[q] = __int_as_float(__builtin_amdgcn_readlane(gt1, j - 64 + q)); }
      }
      uint4 U[4], V[4];
      float su[4], sv_[4];
#pragma unroll
      for (int q = 0; q < 4; ++q) {
        U[q] = *reinterpret_cast<const uint4*>(utab + (size_t)e[q] * 1024 + lane * 16);
        V[q] = *reinterpret_cast<const uint4*>(vtab + (size_t)e[q] * 1024 + lane * 16);
        su[q] = urs[e[q]];
        sv_[q] = vrs[e[q]];
      }
      float d[4];
#pragma unroll
      for (int q = 0; q < 4; ++q) {
        f32x2 u2[8];
        F8X(u2, U[q])
        f32x2 dd = u2[0] * t2[0];
#pragma unroll
        for (int k = 1; k < 8; ++k) dd = u2[k] * t2[k] + dd;
        d[q] = dd.x + dd.y;
      }
#pragma unroll
      for (int o = 32; o > 0; o >>= 1) {
#pragma unroll
        for (int q = 0; q < 4; ++q) d[q] += __shfl_xor(d[q], o);
      }
#pragma unroll
      for (int q = 0; q < 4; ++q) {
        float a = g[q] * gelu_exact(d[q] * su[q]) * sv_[q];
        f32x2 aa = f32x2{a, a};
        f32x2 v2[8];
        F8X(v2, V[q])
#pragma unroll
        for (int k = 0; k < 8; ++k) acc2[k] = aa * v2[k] + acc2[k];
      }
    }
    float vv[16];
    float s = 0.f;
    const int c0 = lane * 16;
#pragma unroll
    for (int k4 = 0; k4 < 4; ++k4) {
      float4 x0 = *reinterpret_cast<const float4*>(xres + (size_t)tok * 1024 + c0 + k4 * 4);
      float4 g0 = *reinterpret_cast<const float4*>(g2 + (size_t)b * 6144 + c0 + k4 * 4);
      vv[k4 * 4 + 0] = ALPHA * x0.x + g0.x * acc2[k4 * 2].x; vv[k4 * 4 + 1] = ALPHA * x0.y + g0.y * acc2[k4 * 2].y;
      vv[k4 * 4 + 2] = ALPHA * x0.z + g0.z * acc2[k4 * 2 + 1].x; vv[k4 * 4 + 3] = ALPHA * x0.w + g0.w * acc2[k4 * 2 + 1].y;
    }
#pragma unroll
    for (int k = 0; k < 16; ++k) s += vv[k];
    float mu = wave_sum(s) * (1.f / 1024.f);
    float qq = 0.f;
#pragma unroll
    for (int k = 0; k < 16; ++k) { vv[k] -= mu; qq += vv[k] * vv[k]; }
    float rs = rsqrtf(wave_sum(qq) * (1.f / 1024.f) + 1e-5f);
    float oo[16];
#pragma unroll
    for (int k4 = 0; k4 < 4; ++k4) {
      float4 ga = *reinterpret_cast<const float4*>(lng + c0 + k4 * 4), ba = *reinterpret_cast<const float4*>(lnb + c0 + k4 * 4);
      float4 o0;
      o0.x = vv[k4 * 4 + 0] * rs * ga.x + ba.x; o0.y = vv[k4 * 4 + 1] * rs * ga.y + ba.y; o0.z = vv[k4 * 4 + 2] * rs * ga.z + ba.z; o0.w = vv[k4 * 4 + 3] * rs * ga.w + ba.w;
      *reinterpret_cast<float4*>(xout + (size_t)tok * 1024 + c0 + k4 * 4) = o0;
      oo[k4 * 4 + 0] = o0.x; oo[k4 * 4 + 1] = o0.y; oo[k4 * 4 + 2] = o0.z; oo[k4 * 4 + 3] = o0.w;
    }
    if (modnext) {
      const float* m = modnext + (size_t)b * 6144;
      unsigned pk[8];
#pragma unroll
      for (int k4 = 0; k4 < 4; ++k4) {
        float4 sh0 = *reinterpret_cast<const float4*>(m + c0 + k4 * 4), sc0 = *reinterpret_cast<const float4*>(m + 1024 + c0 + k4 * 4);
        pk[k4 * 2] = pack2(oo[k4 * 4 + 0] * (1.f + sc0.x) + sh0.x, oo[k4 * 4 + 1] * (1.f + sc0.y) + sh0.y);
        pk[k4 * 2 + 1] = pack2(oo[k4 * 4 + 2] * (1.f + sc0.z) + sh0.z, oo[k4 * 4 + 3] * (1.f + sc0.w) + sh0.w);
      }
      *reinterpret_cast<uint4*>(hxout + (size_t)tok * 1024 + c0) = make_uint4(pk[0], pk[1], pk[2], pk[3]);
      *reinterpret_cast<uint4*>(hxout + (size_t)tok * 1024 + c0 + 8) = make_uint4(pk[4], pk[5], pk[6], pk[7]);
    }
  }
}

__device__ __forceinline__ void phase_shortconv_T(const Params& p, const u16* upre, u16* x1cm, u16* x2cm, u16* vcm, char* lds) {
  u16* tile = (u16*)lds;
  int tid = otid();
  for (int item = blockIdx.x; item < 512 * 48; item += gridDim.x) {
    int tt = item / 48, ct = item % 48;
    int tok0 = tt * 64, c0 = ct * 64;
#pragma unroll
    for (int i = 0; i < 2; ++i) {
      int q = tid + i * 256, tl = q >> 3, cg_ = (q & 7) * 8;
      int tok = tok0 + tl, l = tok & 4095, ch = c0 + cg_;
      float acc[8];
#pragma unroll
      for (int k = 0; k < 8; ++k) acc[k] = p.h_conv_b[ch + k];
#pragma unroll
      for (int j = 0; j < 3; ++j) {
        int ll = l + j - 1;
        if (ll < 0 || ll > 4095) continue;
        uint4 v = *reinterpret_cast<const uint4*>(upre + (size_t)(tok + j - 1) * 3072 + ch);
        const float* w = p.h_conv_w + j * 3072 + ch;
        float4 w0 = *reinterpret_cast<const float4*>(w), w1 = *reinterpret_cast<const float4*>(w + 4);
        acc[0] += bflo(v.x) * w0.x; acc[1] += bfhi(v.x) * w0.y; acc[2] += bflo(v.y) * w0.z; acc[3] += bfhi(v.y) * w0.w;
        acc[4] += bflo(v.z) * w1.x; acc[5] += bfhi(v.z) * w1.y; acc[6] += bflo(v.w) * w1.z; acc[7] += bfhi(v.w) * w1.w;
      }
#pragma unroll
      for (int k = 0; k < 8; ++k) tile[(cg_ + k) * 72 + tl] = f2bf(acc[k]);
    }
    __syncthreads();
    int part = c0 >> 10, d0 = c0 & 1023;
    u16* dst = part == 0 ? x1cm : (part == 1 ? x2cm : vcm);
    int b = tok0 >> 12, l0 = tok0 & 4095;
#pragma unroll
    for (int i = 0; i < 2; ++i) {
      int q = tid + i * 256, c = q >> 3, tg = (q & 7) * 8;
      uint4 v = *reinterpret_cast<const uint4*>(tile + c * 72 + tg);
      *reinterpret_cast<uint4*>(dst + ((size_t)(b * 1024 + d0 + c)) * 4096 + l0 + tg) = v;
    }
    __syncthreads();
  }
}

__device__ __forceinline__ void fft_fwd(float2* X) {
  int tid = otid();
  for (int s = 12; s >= 0; --s) {
    int half = 1 << s;
    float inv2h = 1.f / (float)(2 * half);
#pragma unroll 4
    for (int i = 0; i < 16; ++i) {
      int j = tid + i * 256;
      int pos = j & (half - 1);
      int i0 = ((j >> s) << (s + 1)) + pos, i1 = i0 + half;
      float fr_ = (float)pos * inv2h;
      float wr = __builtin_amdgcn_cosf(fr_), wi = -__builtin_amdgcn_sinf(fr_);
      float2 a = X[i0], bq = X[i1];
      float dr = a.x - bq.x, di = a.y - bq.y;
      X[i0] = make_float2(a.x + bq.x, a.y + bq.y);
      X[i1] = make_float2(dr * wr - di * wi, dr * wi + di * wr);
    }
    __syncthreads();
  }
}
__device__ __forceinline__ void fft_inv(float2* X) {
  int tid = otid();
  for (int s = 0; s <= 12; ++s) {
    int half = 1 << s;
    float inv2h = 1.f / (float)(2 * half);
#pragma unroll 4
    for (int i = 0; i < 16; ++i) {
      int j = tid + i * 256;
      int pos = j & (half - 1);
      int i0 = ((j >> s) << (s + 1)) + pos, i1 = i0 + half;
      float fr_ = (float)pos * inv2h;
      float wr = __builtin_amdgcn_cosf(fr_), wi = -__builtin_amdgcn_sinf(fr_);
      float2 a = X[i0], bq = X[i1];
      float br = bq.x * wr + bq.y * wi, bi = bq.y * wr - bq.x * wi;
      X[i0] = make_float2(a.x + br, a.y + bi);
      X[i1] = make_float2(a.x - br, a.y - bi);
    }
    __syncthreads();
  }
}

__device__ __forceinline__ void phase_filter_fft(const Params& p, float2* Hf, char* lds) {
  float2* X = (float2*)lds;
  float* w3s = (float*)(lds + 65536);
  float* red = w3s + 128;
  const float* hid = (const float*)(p.ws + OFF_HID);
  int tid = otid();
  const float min_decay = -3.0701134573253945f;
  const float max_decay = -15.350567286626973f;
  for (int item = blockIdx.x; item < 2048; item += gridDim.x) {
    int o = item >> 10, d = item & 1023;
    if (tid < 128) {
      int dirr = tid >> 6, j = tid & 63;
      w3s[tid] = p.h_f_w3[(size_t)j * 4096 + (o * 2 + dirr) * 1024 + d];
    }
    __syncthreads();
    float adelta = fabsf(min_decay + (float)d * ((max_decay - min_decay) / 1023.f));
    float ss = 0.f;
#pragma unroll 1
    for (int i = 0; i < 16; ++i) {
      int t = tid + i * 256;
      const float* hr = hid + (size_t)t * 64;
      float hf = 0.f, hb = 0.f;
#pragma unroll
      for (int j4 = 0; j4 < 16; ++j4) {
        float4 hv = *reinterpret_cast<const float4*>(hr + j4 * 4);
        hf += hv.x * w3s[j4 * 4] + hv.y * w3s[j4 * 4 + 1] + hv.z * w3s[j4 * 4 + 2] + hv.w * w3s[j4 * 4 + 3];
        hb += hv.x * w3s[64 + j4 * 4] + hv.y * w3s[64 + j4 * 4 + 1] + hv.z * w3s[64 + j4 * 4 + 2] + hv.w * w3s[64 + j4 * 4 + 3];
      }
      float dec = __expf(-((float)t / 4095.f) * adelta);
      hf *= dec; hb *= dec;
      if (t == 0) {
        float v = hf + hb;
        X[0] = make_float2(v, 0.f);
        X[4096] = make_float2(0.f, 0.f);
        ss += v * v;
      } else {
        X[t] = make_float2(hf, 0.f);
        X[8192 - t] = make_float2(hb, 0.f);
        ss += hf * hf + hb * hb;
      }
    }
    ss = wave_sum(ss);
    if ((tid & 63) == 0) red[tid >> 6] = ss;
    __syncthreads();
    float tot = red[0] + red[1] + red[2] + red[3];
    float scale = rsqrtf(tot + 1e-6f) * (1.f / 8192.f);
    fft_fwd(X);
    float2* dst = Hf + (size_t)item * 8192;
#pragma unroll 4
    for (int i = 0; i < 32; ++i) {
      int k = tid + i * 256;
      float2 v = X[k];
      dst[k] = make_float2(v.x * scale, v.y * scale);
    }
    __syncthreads();
  }
}

__device__ __forceinline__ void phase_hyena_conv(const Params& p, const u16* x1cm, const u16* x2cm, const u16* vcm, const float2* Hf, u16* zzcm, char* lds) {
  float2* X = (float2*)lds;
  int tid = otid();
  for (int item = blockIdx.x; item < 4096; item += gridDim.x) {
    int d = item >> 2, bp = item & 3;
    size_t r0 = ((size_t)((bp * 2) * 1024 + d)) * 4096, r1 = ((size_t)((bp * 2 + 1) * 1024 + d)) * 4096;
    float bias0 = p.h_bias[d], bias1 = p.h_bias[1024 + d];
#pragma unroll
    for (int i = 0; i < 2; ++i) {
      int t8 = (tid + i * 256) * 8;
      uint4 a = *reinterpret_cast<const uint4*>(vcm + r0 + t8);
      uint4 bq = *reinterpret_cast<const uint4*>(vcm + r1 + t8);
      X[t8 + 0] = make_float2(bflo(a.x), bflo(bq.x)); X[t8 + 1] = make_float2(bfhi(a.x), bfhi(bq.x));
      X[t8 + 2] = make_float2(bflo(a.y), bflo(bq.y)); X[t8 + 3] = make_float2(bfhi(a.y), bfhi(bq.y));
      X[t8 + 4] = make_float2(bflo(a.z), bflo(bq.z)); X[t8 + 5] = make_float2(bfhi(a.z), bfhi(bq.z));
      X[t8 + 6] = make_float2(bflo(a.w), bflo(bq.w)); X[t8 + 7] = make_float2(bfhi(a.w), bfhi(bq.w));
    }
    for (int i = 0; i < 16; ++i) X[4096 + tid + i * 256] = make_float2(0.f, 0.f);
    __syncthreads();
    fft_fwd(X);
    {
      const float2* H = Hf + (size_t)d * 8192;
#pragma unroll 4
      for (int i = 0; i < 32; ++i) {
        int k = tid + i * 256;
        float2 hv = H[k], xv = X[k];
        X[k] = make_float2(xv.x * hv.x - xv.y * hv.y, xv.x * hv.y + xv.y * hv.x);
      }
    }
    __syncthreads();
    fft_inv(X);
    float zz0[16], zz1[16];
#pragma unroll
    for (int i = 0; i < 2; ++i) {
      int t8 = (tid + i * 256) * 8;
      uint4 a = *reinterpret_cast<const uint4*>(vcm + r0 + t8);
      uint4 bq = *reinterpret_cast<const uint4*>(vcm + r1 + t8);
      uint4 xa = *reinterpret_cast<const uint4*>(x1cm + r0 + t8);
      uint4 xb = *reinterpret_cast<const uint4*>(x1cm + r1 + t8);
      float va[8] = {bflo(a.x), bfhi(a.x), bflo(a.y), bfhi(a.y), bflo(a.z), bfhi(a.z), bflo(a.w), bfhi(a.w)};
      float vb[8] = {bflo(bq.x), bfhi(bq.x), bflo(bq.y), bfhi(bq.y), bflo(bq.z), bfhi(bq.z), bflo(bq.w), bfhi(bq.w)};
      float fa[8] = {bflo(xa.x), bfhi(xa.x), bflo(xa.y), bfhi(xa.y), bflo(xa.z), bfhi(xa.z), bflo(xa.w), bfhi(xa.w)};
      float fb[8] = {bflo(xb.x), bfhi(xb.x), bflo(xb.y), bfhi(xb.y), bflo(xb.z), bfhi(xb.z), bflo(xb.w), bfhi(xb.w)};
#pragma unroll
      for (int e = 0; e < 8; ++e) {
        float2 cv = X[t8 + e];
        float z0 = fa[e] * (cv.x + va[e] * bias0);
        float z1 = fb[e] * (cv.y + vb[e] * bias0);
        zz0[i * 8 + e] = z0; zz1[i * 8 + e] = z1;
        X[t8 + e] = make_float2(z0, z1);
      }
    }
    for (int i = 0; i < 16; ++i) X[4096 + tid + i * 256] = make_float2(0.f, 0.f);
    __syncthreads();
    fft_fwd(X);
    {
      const float2* H = Hf + (size_t)(1024 + d) * 8192;
#pragma unroll 4
      for (int i = 0; i < 32; ++i) {
        int k = tid + i * 256;
        float2 hv = H[k], xv = X[k];
        X[k] = make_float2(xv.x * hv.x - xv.y * hv.y, xv.x * hv.y + xv.y * hv.x);
      }
    }
    __syncthreads();
    fft_inv(X);
#pragma unroll
    for (int i = 0; i < 2; ++i) {
      int t8 = (tid + i * 256) * 8;
      uint4 xa = *reinterpret_cast<const uint4*>(x2cm + r0 + t8);
      uint4 xb = *reinterpret_cast<const uint4*>(x2cm + r1 + t8);
      float fa[8] = {bflo(xa.x), bfhi(xa.x), bflo(xa.y), bfhi(xa.y), bflo(xa.z), bfhi(xa.z), bflo(xa.w), bfhi(xa.w)};
      float fb[8] = {bflo(xb.x), bfhi(xb.x), bflo(xb.y), bfhi(xb.y), bflo(xb.z), bfhi(xb.z), bflo(xb.w), bfhi(xb.w)};
      float o0[8], o1[8];
#pragma unroll
      for (int e = 0; e < 8; ++e) {
        float2 cv = X[t8 + e];
        o0[e] = fa[e] * (cv.x + zz0[i * 8 + e] * bias1);
        o1[e] = fb[e] * (cv.y + zz1[i * 8 + e] * bias1);
      }
      uint4 w0, w1;
      w0.x = pack2(o0[0], o0[1]); w0.y = pack2(o0[2], o0[3]); w0.z = pack2(o0[4], o0[5]); w0.w = pack2(o0[6], o0[7]);
      w1.x = pack2(o1[0], o1[1]); w1.y = pack2(o1[2], o1[3]); w1.z = pack2(o1[4], o1[5]); w1.w = pack2(o1[6], o1[7]);
      *reinterpret_cast<uint4*>(zzcm + r0 + t8) = w0;
      *reinterpret_cast<uint4*>(zzcm + r1 + t8) = w1;
    }
    __syncthreads();
  }
}

__device__ __forceinline__ void phase_transpose_back(const u16* src, u16* dst, char* lds) {
  u16* tile = (u16*)lds;
  int tid = otid();
  for (int item = blockIdx.x; item < 8 * 16 * 64; item += gridDim.x) {
    int b = item >> 10, dt_ = (item >> 6) & 15, tt = item & 63;
#pragma unroll
    for (int i = 0; i < 2; ++i) {
      int q = tid + i * 256, dd = q >> 3, tg = (q & 7) * 8;
      uint4 v = *reinterpret_cast<const uint4*>(src + ((size_t)(b * 1024 + dt_ * 64 + dd)) * 4096 + tt * 64 + tg);
      tile[(tg + 0) * 72 + dd] = (u16)(v.x & 0xffff); tile[(tg + 1) * 72 + dd] = (u16)(v.x >> 16);
      tile[(tg + 2) * 72 + dd] = (u16)(v.y & 0xffff); tile[(tg + 3) * 72 + dd] = (u16)(v.y >> 16);
      tile[(tg + 4) * 72 + dd] = (u16)(v.z & 0xffff); tile[(tg + 5) * 72 + dd] = (u16)(v.z >> 16);
      tile[(tg + 6) * 72 + dd] = (u16)(v.w & 0xffff); tile[(tg + 7) * 72 + dd] = (u16)(v.w >> 16);
    }
    __syncthreads();
#pragma unroll
    for (int i = 0; i < 2; ++i) {
      int q = tid + i * 256, tl = q >> 3, dg = (q & 7) * 8;
      uint4 v = *reinterpret_cast<const uint4*>(tile + tl * 72 + dg);
      *reinterpret_cast<uint4*>(dst + ((size_t)(b * 4096 + tt * 64 + tl)) * 1024 + dt_ * 64 + dg) = v;
    }
    __syncthreads();
  }
}

DEV void probe_rows(const unsigned* buf, int wpr, float* out) {
  const int tid_ = otid();
  int lane = tid_ & 63;
  int wave = blockIdx.x * 4 + (tid_ >> 6), nw = gridDim.x * 4;
  for (int row = wave; row < NT; row += nw) {
    unsigned h = 0;
    for (int w = lane; w < wpr; w += 64) { unsigned v = buf[(size_t)row * wpr + w]; h += (v ^ (v >> 15)) * (2654435761u + 2u * (unsigned)w); }
#pragma unroll
    for (int o = 32; o > 0; o >>= 1) h += (unsigned)__shfl_xor((int)h, o);
    float v = (float)((h >> 8) & 0xFFFFu) * (1.f / 65536.f);
    float4 vv = make_float4(v, v, v, v);
#pragma unroll
    for (int i = 0; i < 4; ++i) *reinterpret_cast<float4*>(out + (size_t)row * 1024 + i * 256 + lane * 4) = vv;
  }
}
#define PROBE_AT(id, bufexpr, wpr) if (PROBE == id) { Params pq = fetch_params(); probe_rows((const unsigned*)(bufexpr), wpr, pq.out); return; }

DEV void gsync2(unsigned k) {
  asm volatile("s_waitcnt vmcnt(0)" ::: "memory");
  __syncthreads();
  if (threadIdx.x == 0) {
    unsigned* bar = (unsigned*)((char*)karg<33>() + OFF_BAR);
    __builtin_amdgcn_fence(__ATOMIC_RELEASE, "agent");
    asm volatile("s_waitcnt vmcnt(0)" ::: "memory");
    __hip_atomic_fetch_add(bar, 1u, __ATOMIC_RELAXED, __HIP_MEMORY_SCOPE_AGENT);
    unsigned target = k * gridDim.x;
    while (__hip_atomic_load(bar, __ATOMIC_RELAXED, __HIP_MEMORY_SCOPE_AGENT) < target) __builtin_amdgcn_s_sleep(1);
    __builtin_amdgcn_fence(__ATOMIC_ACQUIRE, "agent");
    asm volatile("s_waitcnt vmcnt(0)" ::: "memory");
  }
  __syncthreads();
}

DEV void gsync(cg::grid_group& grid) {
  asm volatile("s_waitcnt vmcnt(0)" ::: "memory");
  grid.sync();
  if (threadIdx.x == 0) {
    __builtin_amdgcn_fence(__ATOMIC_ACQUIRE, "agent");
    asm volatile("s_waitcnt vmcnt(0)" ::: "memory");
  }
  __syncthreads();
}

template <int layer>
__device__ __forceinline__ void peer_block(unsigned& nbar, char* lds) {
  {
    Params p = fetch_params();
    char* ws = p.ws; char* R1 = ws + OFF_R1; char* R2 = ws + OFF_R2; char* DO = (char*)p.out;
    const float* modl = (float*)(ws + OFF_MOD) + (size_t)layer * 9 * 6144;
    const u16* A = layer == 0 ? (const u16*)R1 : (const u16*)DO;
    const int K = layer == 0 ? 2048 : 1024;
    const u16* Wt = (const u16*)(ws + (layer == 0 ? OFF_W_OUT : OFF_W_HOUT));
    const float* res = layer == 0 ? p.x : (const float*)R2;
    phase_gemm_resid(A, K, Wt, res, (float*)R2, modl + 2048, lds);
  }
  gsync2(++nbar);
  PROBE_AT(5 + layer * 10, pq.ws + OFF_R2, 1024)
  {
    Params p = fetch_params();
    char* ws = p.ws; char* R1 = ws + OFF_R1; char* R2 = ws + OFF_R2; char* DO = (char*)p.out;
    const float* modl = (float*)(ws + OFF_MOD) + (size_t)layer * 9 * 6144;
    u16* tpeer = layer == 0 ? (u16*)DO : (u16*)(R1 + 128 * MiB);
    phase_ln_mod((float*)R2, p.ln_g + layer * 2048, p.ln_b + layer * 2048, modl, tpeer);
    if (DUP & 128) { gsync2(++nbar); phase_ln_mod((float*)R2, p.ln_g + layer * 2048, p.ln_b + layer * 2048, modl, tpeer); }
    if (layer == 1) {
      unsigned char* tb = (unsigned char*)R1;
      convert_fp8_rows(p.p_u + (size_t)16384 * 1024, tb, (float*)(tb + 32 * MiB), 16384);
      convert_fp8_rows(p.p_v + (size_t)16384 * 1024, tb + 16 * MiB, (float*)(tb + 32 * MiB + 65536), 16384);
    }
  }
  gsync2(++nbar);
  {
    Params p = fetch_params();
    char* ws = p.ws; char* R1 = ws + OFF_R1; char* DO = (char*)p.out;
    u16* tpeer = layer == 0 ? (u16*)DO : (u16*)(R1 + 128 * MiB);
    phase_gemm_bf16(tpeer, (const u16*)(ws + OFF_W_Q) + (size_t)layer * 2048 * 1024, layer == 0 ? (u16*)R1 : (u16*)DO, 2048, lds);
  }
  gsync2(++nbar);
  PROBE_AT(7 + layer * 10, pq.ws + OFF_R1, 1024)
  {
    Params p = fetch_params();
    char* ws = p.ws; char* R1 = ws + OFF_R1; char* R2 = ws + OFF_R2;
    int* idxb = (int*)(R2 + 128 * MiB);
    float* gateb = (float*)(R2 + 144 * MiB);
    const u16* kbf = (const u16*)(ws + OFF_KEYS);
    phase_peer_topk(layer == 0 ? (const u16*)R1 : (const u16*)p.out, kbf + (size_t)layer * 131072, kbf + 262144 + (size_t)layer * 131072, idxb, gateb, lds);
    if (DUP & 4) { __syncthreads(); phase_peer_topk(layer == 0 ? (const u16*)R1 : (const u16*)p.out, kbf + (size_t)layer * 131072, kbf + 262144 + (size_t)layer * 131072, idxb, gateb, lds); }
  }
  gsync2(++nbar);
  {
    Params p = fetch_params();
    char* ws = p.ws; char* R1 = ws + OFF_R1; char* R2 = ws + OFF_R2; char* DO = (char*)p.out;
    float* mod = (float*)(ws + OFF_MOD);
    const float* modl = mod + (size_t)layer * 9 * 6144;
    int* idxb = (int*)(R2 + 128 * MiB);
    float* gateb = (float*)(R2 + 144 * MiB);
    u16* tpeer = layer == 0 ? (u16*)DO : (u16*)(R1 + 128 * MiB);
    const unsigned char* tb8 = (const unsigned char*)(layer == 0 ? R1 + 128 * MiB : R1);
    phase_peer_gather(tpeer, idxb, gateb, tb8, tb8 + 16 * MiB, (const float*)(tb8 + 32 * MiB), (const float*)(tb8 + 32 * MiB + 65536), (const float*)R2,
                      modl + 5120, p.ln_g + layer * 2048 + 1024, p.ln_b + layer * 2048 + 1024, layer == 0 ? (float*)R2 : p.out,
                      layer == 0 ? mod + 9 * 6144 : nullptr, (u16*)(DO + 64 * MiB));
  }
}

__global__ void __launch_bounds__(256, 2) fwd_megakernel(Params p_unused) {
  __shared__ __attribute__((aligned(16))) char lds[LDS_BYTES];
  cg::grid_group grid = cg::this_grid();
  unsigned nbar = 0;
  { Params p = fetch_params(); phase_prologue(p, lds); }
  if (DUP & 64) { __syncthreads(); Params p = fetch_params(); phase_prologue(p, lds); }
  gsync(grid);
  {
    Params p = fetch_params();
    float* mod = (float*)(p.ws + OFF_MOD);
    modulate_rows(p.x, (u16*)(p.ws + OFF_R2), NT, SEQ, mod, 0, 1024, false);
    modulate_rows(p.ctx, (u16*)(p.ws + OFF_HC), NTC, CTXL, mod, 0, 1024, true);
  }
  gsync2(++nbar);
  { Params p = fetch_params(); phase_gemm_inproj(p, lds); }
  if (DUP & 2) { gsync2(++nbar); Params p = fetch_params(); phase_gemm_inproj(p, lds); }
  gsync2(++nbar);
  PROBE_AT(1, pq.ws + OFF_R1, 1536)
  { Params p = fetch_params(); phase_conv(p); }
  if (DUP & 16) { gsync2(++nbar); Params p = fetch_params(); phase_conv(p); }
  gsync2(++nbar);
  PROBE_AT(2, pq.ws + OFF_R2, 1536)
  { Params p = fetch_params(); phase_ssd(p, lds); }
  if (DUP & 1) { gsync2(++nbar); Params p = fetch_params(); phase_ssd(p, lds); }
  gsync2(++nbar);
  PROBE_AT(3, pq.ws + OFF_R1, 1024)
  {
    Params p = fetch_params(); phase_gated_norm(p);
    unsigned char* tb = (unsigned char*)(p.ws + OFF_R1 + 128 * MiB);
    convert_fp8_rows(p.p_u, tb, (float*)(tb + 32 * MiB), 16384);
    convert_fp8_rows(p.p_v, tb + 16 * MiB, (float*)(tb + 32 * MiB + 65536), 16384);
  }
  gsync2(++nbar);
  PROBE_AT(4, pq.ws + OFF_R1, 1024)
  peer_block<0>(nbar, lds);
  if ((PROBE >= 5 && PROBE <= 7) || PROBE == 99) return;
  gsync2(++nbar);
  {
    Params p = fetch_params();
    phase_gemm_bf16((const u16*)((char*)p.out + 64 * MiB), (const u16*)(p.ws + OFF_W_HIN), (u16*)(p.ws + OFF_R1), 3072, lds);
  }
  gsync2(++nbar);
  PROBE_AT(8, pq.ws + OFF_R2, 1024)
  PROBE_AT(11, pq.ws + OFF_R1, 1536)
  {
    Params p = fetch_params();
    phase_shortconv_T(p, (const u16*)(p.ws + OFF_R1), (u16*)(p.ws + OFF_R2 + 128 * MiB), (u16*)p.out, (u16*)((char*)p.out + 64 * MiB), lds);
  }
  gsync2(++nbar);
  PROBE_AT(12, pq.ws + OFF_R2 + 128 * MiB, 512)
  { Params p = fetch_params(); phase_filter_fft(p, (float2*)(p.ws + OFF_R1), lds); }
  if (DUP & 32) { gsync2(++nbar); Params p = fetch_params(); phase_filter_fft(p, (float2*)(p.ws + OFF_R1), lds); }
  gsync2(++nbar);
  PROBE_AT(13, pq.ws + OFF_R1, 1024)
  {
    Params p = fetch_params();
    phase_hyena_conv(p, (const u16*)(p.ws + OFF_R2 + 128 * MiB), (const u16*)p.out, (const u16*)((char*)p.out + 64 * MiB),
                     (const float2*)(p.ws + OFF_R1), (u16*)(p.ws + OFF_R1 + 128 * MiB), lds);
  }
  if (DUP & 8) {
    gsync2(++nbar);
    Params p = fetch_params();
    phase_hyena_conv(p, (const u16*)(p.ws + OFF_R2 + 128 * MiB), (const u16*)p.out, (const u16*)((char*)p.out + 64 * MiB),
                     (const float2*)(p.ws + OFF_R1), (u16*)(p.ws + OFF_R1 + 128 * MiB), lds);
  }
  gsync2(++nbar);
  PROBE_AT(14, pq.ws + OFF_R1 + 128 * MiB, 512)
  { Params p = fetch_params(); phase_transpose_back((const u16*)(p.ws + OFF_R1 + 128 * MiB), (u16*)p.out, lds); }
  gsync2(++nbar);
  peer_block<1>(nbar, lds);
}

extern "C" void kernel_launch(void* const* d_in, const int* in_sizes, int n_in, void* d_out, int out_size, void* d_ws, size_t ws_size,
                              hipStream_t stream) {
  static int grid_blocks = 0;
  if (!grid_blocks) {
    int dev = 0, cus = 0, per_cu = 0;
    hipGetDevice(&dev);
    hipDeviceGetAttribute(&cus, hipDeviceAttributeMultiprocessorCount, dev);
    hipOccupancyMaxActiveBlocksPerMultiprocessor(&per_cu, fwd_megakernel, 256, 0);
    if (per_cu > 2) per_cu = 2;
    if (per_cu < 1) per_cu = 1;
    grid_blocks = cus * per_cu;
  }
  Params p{};
  const float** pp = reinterpret_cast<const float**>(&p);
  for (int i = 0; i < 32; ++i) pp[i] = (const float*)d_in[i];
  p.out = (float*)d_out;
  p.ws = (char*)d_ws;
  if (ws_size < WS_TOTAL) fprintf(stderr, "workspace too small: %zu < %zu\n", ws_size, (size_t)WS_TOTAL);
  (void)hipMemsetAsync((char*)d_ws + OFF_BAR, 0, 4096, stream);
  void* args[] = {&p};
  hipError_t e = hipLaunchCooperativeKernel((void*)fwd_megakernel, dim3(grid_blocks), dim3(256), args, 0, stream);
  if (e != hipSuccess) fprintf(stderr, "cooperative launch failed: %s (grid %d)\n", hipGetErrorString(e), grid_blocks);
}
```

```cpp
#define PROBE 0
#define DUP 0
#include <hip/hip_runtime.h>
#include <hip/hip_bf16.h>
#include <hip/hip_cooperative_groups.h>
#include <cstdio>
namespace cg = cooperative_groups;

typedef unsigned short u16;
using bf16x8 = __attribute__((ext_vector_type(8))) short;
using f32x4 = __attribute__((ext_vector_type(4))) float;
using u32x4 = __attribute__((ext_vector_type(4))) unsigned;

#define DEV __device__ __forceinline__

constexpr int NB = 8, SEQ = 4096, DM = 1024, NT = NB * SEQ;
constexpr int CTXL = 256, NTC = NB * CTXL;
constexpr int SSM_IN = 5184, CONVD = 3072, SSM_INNER = 2048;
constexpr float ALPHA = 1.41421356237f;
constexpr int LDS_BYTES = 71168;

constexpr size_t MiB = 1ull << 20;
constexpr size_t OFF_W_IN = 0;
constexpr size_t OFF_W_OUT = OFF_W_IN + (size_t)5184 * 1024 * 2;
constexpr size_t OFF_W_HIN = OFF_W_OUT + (size_t)1024 * 2048 * 2;
constexpr size_t OFF_W_HOUT = OFF_W_HIN + (size_t)3072 * 1024 * 2;
constexpr size_t OFF_W_Q = OFF_W_HOUT + (size_t)1024 * 1024 * 2;
constexpr size_t OFF_MOD = OFF_W_Q + (size_t)2 * 2048 * 1024 * 2;
constexpr size_t OFF_HID = OFF_MOD + 512 * 1024;
constexpr size_t OFF_DT = OFF_HID + MiB;
constexpr size_t OFF_HC = OFF_DT + 8 * MiB;
constexpr size_t OFF_XBC_C = OFF_HC + 4 * MiB;
constexpr size_t OFF_XC_C = OFF_XBC_C + 12 * MiB;
constexpr size_t OFF_DT_C = OFF_XC_C + 12 * MiB;
constexpr size_t OFF_R1 = OFF_DT_C + MiB;
constexpr size_t OFF_R2 = OFF_R1 + 192 * MiB;
constexpr size_t OFF_BAR = OFF_R2 + 192 * MiB;
constexpr size_t OFF_KEYS = OFF_BAR + 16384;
constexpr size_t WS_TOTAL = OFF_KEYS + MiB;

struct Params {
  const float *x, *c, *ctx, *c_ctx, *ada_w, *ada_b, *ln_g, *ln_b;
  const float *m_w_in, *m_conv_w, *m_conv_b, *m_a_log, *m_dt_bias, *m_d, *m_norm_w, *m_w_out;
  const float *h_w_in, *h_conv_w, *h_conv_b, *h_f_w1, *h_f_b1, *h_f_w2, *h_f_b2, *h_f_w3, *h_freq, *h_bias, *h_w_out;
  const float *p_wq, *p_k1, *p_k2, *p_u, *p_v;
  float* out;
  char* ws;
};

DEV u16 f2bf(float f) {
  unsigned u = __float_as_uint(f);
  u += 0x7fffu + ((u >> 16) & 1u);
  return (u16)(u >> 16);
}
DEV float bf2f(u16 h) { return __uint_as_float(((unsigned)h) << 16); }
DEV float bflo(unsigned w) { return __uint_as_float(w << 16); }
DEV float bfhi(unsigned w) { return __uint_as_float(w & 0xffff0000u); }
DEV unsigned pack2(float a, float b) { return (unsigned)f2bf(a) | ((unsigned)f2bf(b) << 16); }
DEV float wave_sum(float v) {
#pragma unroll
  for (int o = 32; o > 0; o >>= 1) v += __shfl_xor(v, o);
  return v;
}
DEV int otid() { int t = threadIdx.x; asm volatile("" : "+v"(t)); return t; }
DEV unsigned ordkey(float f) { unsigned u = __float_as_uint(f); return (u & 0x80000000u) ? ~u : (u | 0x80000000u); }
DEV float siluf(float v) { return v / (1.f + __expf(-v)); }
DEV f32x4 mfma16(bf16x8 a, bf16x8 b, f32x4 c) { return __builtin_amdgcn_mfma_f32_16x16x32_bf16(a, b, c, 0, 0, 0); }
DEV bf16x8 ld8(const u16* p) { return *reinterpret_cast<const bf16x8*>(p); }

template <int I>
DEV const float* karg() {
  unsigned long long v;
  asm volatile("s_load_dwordx2 %0, %1, %2\n\ts_waitcnt lgkmcnt(0)" : "=s"(v) : "s"(__builtin_amdgcn_kernarg_segment_ptr()), "n"(I * 8));
  return (const float*)(const __attribute__((address_space(1))) float*)v;
}
DEV Params fetch_params() {
  Params q;
  q.x = karg<0>(); q.c = karg<1>(); q.ctx = karg<2>(); q.c_ctx = karg<3>(); q.ada_w = karg<4>(); q.ada_b = karg<5>(); q.ln_g = karg<6>(); q.ln_b = karg<7>();
  q.m_w_in = karg<8>(); q.m_conv_w = karg<9>(); q.m_conv_b = karg<10>(); q.m_a_log = karg<11>(); q.m_dt_bias = karg<12>(); q.m_d = karg<13>();
  q.m_norm_w = karg<14>(); q.m_w_out = karg<15>();
  q.h_w_in = karg<16>(); q.h_conv_w = karg<17>(); q.h_conv_b = karg<18>(); q.h_f_w1 = karg<19>(); q.h_f_b1 = karg<20>(); q.h_f_w2 = karg<21>();
  q.h_f_b2 = karg<22>(); q.h_f_w3 = karg<23>(); q.h_freq = karg<24>(); q.h_bias = karg<25>(); q.h_w_out = karg<26>();
  q.p_wq = karg<27>(); q.p_k1 = karg<28>(); q.p_k2 = karg<29>(); q.p_u = karg<30>(); q.p_v = karg<31>();
  q.out = (float*)karg<32>(); q.ws = (char*)karg<33>();
  return q;
}

__device__ __forceinline__ void transpose_w_tile(const float* src, int srcld, int K, int N, u16* dst, int item, char* lds) {
  float* tile = (float*)lds;
  int ntn = N / 64;
  int kt = item / ntn, nt = item % ntn;
  int tid = otid();
#pragma unroll
  for (int i = 0; i < 4; ++i) {
    int r = (tid >> 4) + i * 16, c4 = (tid & 15) * 4;
    float4 v = *reinterpret_cast<const float4*>(src + (size_t)(kt * 64 + r) * srcld + nt * 64 + c4);
    tile[r * 65 + c4 + 0] = v.x; tile[r * 65 + c4 + 1] = v.y; tile[r * 65 + c4 + 2] = v.z; tile[r * 65 + c4 + 3] = v.w;
  }
  __syncthreads();
#pragma unroll
  for (int i = 0; i < 2; ++i) {
    int n = (tid >> 3) + i * 32, k8 = (tid & 7) * 8;
    uint4 o;
    o.x = pack2(tile[(k8 + 0) * 65 + n], tile[(k8 + 1) * 65 + n]);
    o.y = pack2(tile[(k8 + 2) * 65 + n], tile[(k8 + 3) * 65 + n]);
    o.z = pack2(tile[(k8 + 4) * 65 + n], tile[(k8 + 5) * 65 + n]);
    o.w = pack2(tile[(k8 + 6) * 65 + n], tile[(k8 + 7) * 65 + n]);
    *reinterpret_cast<uint4*>(dst + (size_t)(nt * 64 + n) * K + kt * 64 + k8) = o;
  }
  __syncthreads();
}

__device__ __forceinline__ void ada_item(const Params& p, int item, char* lds) {
  float* sl = (float*)lds;
  float* red = sl + 9 * 1024;
  int layer = item / 96, cg_ = item % 96;
  int tid = otid(), kq = tid >> 6, col = cg_ * 64 + (tid & 63);
  for (int e = tid; e < 9 * 1024; e += 256) {
    int r = e >> 10, k = e & 1023;
    sl[e] = siluf(r < 8 ? p.c[r * 1024 + k] : p.c_ctx[k]);
  }
  __syncthreads();
  float acc[9];
#pragma unroll
  for (int r = 0; r < 9; ++r) acc[r] = 0.f;
  const float* w = p.ada_w + (size_t)layer * 1024 * 6144 + col;
#pragma unroll 8
  for (int k = kq * 256; k < kq * 256 + 256; ++k) {
    float wv = w[(size_t)k * 6144];
#pragma unroll
    for (int r = 0; r < 9; ++r) acc[r] += sl[r * 1024 + k] * wv;
  }
#pragma unroll
  for (int r = 0; r < 9; ++r) red[(kq * 9 + r) * 64 + (tid & 63)] = acc[r];
  __syncthreads();
  if (tid < 64) {
    float* mod = (float*)(p.ws + OFF_MOD);
    float bias = p.ada_b[layer * 6144 + col];
#pragma unroll
    for (int r = 0; r < 9; ++r) {
      float s = red[(0 * 9 + r) * 64 + tid] + red[(1 * 9 + r) * 64 + tid] + red[(2 * 9 + r) * 64 + tid] + red[(3 * 9 + r) * 64 + tid];
      mod[((size_t)layer * 9 + r) * 6144 + col] = s + bias;
    }
  }
  __syncthreads();
}

__device__ __forceinline__ void hyena_mlp_item(const Params& p, int item, char* lds) {
  float* zb = (float*)lds;
  float* h1 = zb + 256;
  float* h2 = h1 + 256;
  int tid = otid(), ti = tid >> 6, j = tid & 63;
  int t = item * 4 + ti;
  const float L = 4096.f;
  if (j < 33) {
    float v;
    if (j == 0) v = (float)t / 4095.f;
    else {
      int k = (j - 1) & 15;
      float fb = 1e-4f + (float)k * ((15.f - 1e-4f) / 15.f);
      float ang = 6.283185307179586f * (float)t / L;
      float a = fb * ang;
      v = (j <= 16) ? cosf(a) : -sinf(a);
    }
    zb[ti * 64 + j] = v;
  }
  __syncthreads();
  float fr = p.h_freq[j];
  float s = p.h_f_b1[j];
#pragma unroll 3
  for (int i = 0; i < 33; ++i) s += zb[ti * 64 + i] * p.h_f_w1[i * 64 + j];
  h1[ti * 64 + j] = sinf(fr * s);
  __syncthreads();
  s = p.h_f_b2[j];
#pragma unroll 8
  for (int i = 0; i < 64; ++i) s += h1[ti * 64 + i] * p.h_f_w2[i * 64 + j];
  h2[ti * 64 + j] = sinf(fr * s);
  __syncthreads();
  s = p.h_f_b2[64 + j];
#pragma unroll 8
  for (int i = 0; i < 64; ++i) s += h2[ti * 64 + i] * p.h_f_w2[4096 + i * 64 + j];
  float* hid = (float*)(p.ws + OFF_HID);
  hid[t * 64 + j] = sinf(fr * s);
  __syncthreads();
}

__device__ __forceinline__ void phase_prologue(const Params& p, char* lds) {
  constexpr int T0 = 1296, T1 = T0 + 512, T2 = T1 + 768, T3 = T2 + 256, T4 = T3 + 512, T5 = T4 + 512, T6 = T5 + 192, T7 = T6 + 1024, T8 = T7 + 256;
  for (int item = blockIdx.x; item < T8; item += gridDim.x) {
    if (item < T0) transpose_w_tile(p.m_w_in, SSM_IN, 1024, SSM_IN, (u16*)(p.ws + OFF_W_IN), item, lds);
    else if (item < T1) transpose_w_tile(p.m_w_out, 1024, 2048, 1024, (u16*)(p.ws + OFF_W_OUT), item - T0, lds);
    else if (item < T2) transpose_w_tile(p.h_w_in, 3072, 1024, 3072, (u16*)(p.ws + OFF_W_HIN), item - T1, lds);
    else if (item < T3) transpose_w_tile(p.h_w_out, 1024, 1024, 1024, (u16*)(p.ws + OFF_W_HOUT), item - T2, lds);
    else if (item < T4) transpose_w_tile(p.p_wq, 2048, 1024, 2048, (u16*)(p.ws + OFF_W_Q), item - T3, lds);
    else if (item < T5) transpose_w_tile(p.p_wq + (size_t)1024 * 2048, 2048, 1024, 2048, (u16*)(p.ws + OFF_W_Q) + (size_t)2048 * 1024, item - T4, lds);
    else if (item < T6) ada_item(p, item - T5, lds);
    else if (item < T7) hyena_mlp_item(p, item - T6, lds);
    else {
      int e8 = ((item - T7) * 256 + threadIdx.x) * 8;
      const float* src = e8 < 262144 ? p.p_k1 + e8 : p.p_k2 + (e8 - 262144);
      float4 a0 = *reinterpret_cast<const float4*>(src), a1 = *reinterpret_cast<const float4*>(src + 4);
      uint4 o;
      o.x = pack2(a0.x, a0.y); o.y = pack2(a0.z, a0.w); o.z = pack2(a1.x, a1.y); o.w = pack2(a1.z, a1.w);
      *reinterpret_cast<uint4*>((u16*)(p.ws + OFF_KEYS) + e8) = o;
    }
  }
}

__device__ __forceinline__ void modulate_rows(const float* src, u16* dst, int nrows, int rows_per_batch, const float* modbase, int sh_off, int sc_off, bool ctxrow) {
  size_t total = (size_t)nrows * 128;
  for (size_t e = (size_t)blockIdx.x * 256 + threadIdx.x; e < total; e += (size_t)gridDim.x * 256) {
    int row = (int)(e >> 7), c8 = (int)(e & 127) * 8;
    int b = ctxrow ? 8 : row / rows_per_batch;
    const float* m = modbase + (size_t)b * 6144;
    float4 a0 = *reinterpret_cast<const float4*>(src + (size_t)row * 1024 + c8);
    float4 a1 = *reinterpret_cast<const float4*>(src + (size_t)row * 1024 + c8 + 4);
    float4 s0 = *reinterpret_cast<const float4*>(m + sc_off + c8);
    float4 s1 = *reinterpret_cast<const float4*>(m + sc_off + c8 + 4);
    float4 h0 = *reinterpret_cast<const float4*>(m + sh_off + c8);
    float4 h1 = *reinterpret_cast<const float4*>(m + sh_off + c8 + 4);
    uint4 o;
    o.x = pack2(a0.x * (1.f + s0.x) + h0.x, a0.y * (1.f + s0.y) + h0.y);
    o.y = pack2(a0.z * (1.f + s0.z) + h0.z, a0.w * (1.f + s0.w) + h0.w);
    o.z = pack2(a1.x * (1.f + s1.x) + h1.x, a1.y * (1.f + s1.y) + h1.y);
    o.w = pack2(a1.z * (1.f + s1.z) + h1.z, a1.w * (1.f + s1.w) + h1.w);
    *reinterpret_cast<uint4*>(dst + (size_t)row * 1024 + c8) = o;
  }
}

constexpr int GLD = 72;
template <class Epi>
__device__ __forceinline__ void gemm_tile(const u16* __restrict__ A, int lda, const u16* __restrict__ Bt, int ldb, int brow, int bcol, int Nmax,
                                          int K, char* lds, Epi epi) {
  u16* SA = (u16*)lds;
  u16* SB = SA + 256 * GLD;
  int tid = otid(), wid = tid >> 6, lane = tid & 63, wr = wid >> 1, wc = wid & 1, fr = lane & 15, fq = lane >> 4;
  f32x4 acc[8][4];
#pragma unroll
  for (int m = 0; m < 8; ++m)
#pragma unroll
    for (int n = 0; n < 4; ++n) acc[m][n] = f32x4{0.f, 0.f, 0.f, 0.f};
  u32x4 ra[8], rb[4];
  const int lr = tid >> 3, lc = (tid & 7) * 8;
  const u16* abase = A + (size_t)brow * lda;
  const unsigned aoff = (unsigned)(lr * lda + lc);
  unsigned bo[4];
#pragma unroll
  for (int i = 0; i < 4; ++i) {
    int br = bcol + lr + i * 32;
    if (br >= Nmax) br = Nmax - 1;
    bo[i] = (unsigned)(br * ldb + lc);
  }
#define GLOADT(KT)                                                                                 \
  _Pragma("unroll") for (int i = 0; i < 8; ++i)                                                    \
    ra[i] = *reinterpret_cast<const u32x4*>(abase + (aoff + (unsigned)((i * 32) * lda + (KT) * 64))); \
  _Pragma("unroll") for (int i = 0; i < 4; ++i)                                                    \
    rb[i] = *reinterpret_cast<const u32x4*>(Bt + (bo[i] + (unsigned)((KT) * 64)));
  const int nk = K / 64;
  GLOADT(0)
  for (int kt = 0; kt < nk; ++kt) {
#pragma unroll
    for (int i = 0; i < 8; ++i) *reinterpret_cast<u32x4*>(SA + (lr + i * 32) * GLD + lc) = ra[i];
#pragma unroll
    for (int i = 0; i < 4; ++i) *reinterpret_cast<u32x4*>(SB + (lr + i * 32) * GLD + lc) = rb[i];
    __syncthreads();
    { const int kn = kt + 1 < nk ? kt + 1 : nk - 1; GLOADT(kn) }
#pragma unroll
    for (int kk = 0; kk < 2; ++kk) {
      bf16x8 Bl[4];
#pragma unroll
      for (int n = 0; n < 4; ++n) Bl[n] = ld8(SB + (wc * 64 + n * 16 + fr) * GLD + kk * 32 + fq * 8);
#pragma unroll
      for (int mh = 0; mh < 2; ++mh) {
        bf16x8 At[4];
#pragma unroll
        for (int m = 0; m < 4; ++m) At[m] = ld8(SA + (wr * 128 + (mh * 4 + m) * 16 + fr) * GLD + kk * 32 + fq * 8);
#pragma unroll
        for (int m = 0; m < 4; ++m)
#pragma unroll
          for (int n = 0; n < 4; ++n) acc[mh * 4 + m][n] = mfma16(Bl[n], At[m], acc[mh * 4 + m][n]);
      }
    }
    __syncthreads();
  }
#undef GLOADT
#pragma unroll
  for (int m = 0; m < 8; ++m)
#pragma unroll
    for (int n = 0; n < 4; ++n) epi(brow + wr * 128 + m * 16 + fr, bcol + wc * 64 + n * 16 + fq * 4, acc[m][n]);
}

DEV float softplusf(float v) { return fmaxf(v, 0.f) + log1pf(__expf(-fabsf(v))); }

__device__ __forceinline__ void phase_gemm_inproj(const Params& p, char* lds) {
  const u16* hx = (const u16*)(p.ws + OFF_R2);
  const u16* hc = (const u16*)(p.ws + OFF_HC);
  const u16* Wt = (const u16*)(p.ws + OFF_W_IN);
  u16* zbuf = (u16*)p.out;
  u16* xbc = (u16*)(p.ws + OFF_R1);
  float* dt = (float*)(p.ws + OFF_DT);
  u16* xbc_c = (u16*)(p.ws + OFF_XBC_C);
  float* dt_c = (float*)(p.ws + OFF_DT_C);
  const float* dtb = p.m_dt_bias;
  const int xcd = blockIdx.x & 7, li = blockIdx.x >> 3, nl = gridDim.x >> 3;
  {
    const int nb = (41 - xcd + 7) >> 3;
    for (int t = li; t < 128 * nb; t += nl) {
      int pm = t / nb, pn = xcd + 8 * (t % nb);
      gemm_tile(hx, 1024, Wt, 1024, pm * 256, pn * 128, SSM_IN, 1024, lds, [=](int m, int n, f32x4 v) {
        if (n < 2048) *reinterpret_cast<uint2*>(zbuf + (size_t)m * 2048 + n) = make_uint2(pack2(v[0], v[1]), pack2(v[2], v[3]));
        else if (n < 5120) *reinterpret_cast<uint2*>(xbc + (size_t)m * 3072 + (n - 2048)) = make_uint2(pack2(v[0], v[1]), pack2(v[2], v[3]));
        else if (n < 5184) {
          float4 bb = *reinterpret_cast<const float4*>(dtb + (n - 5120));
          *reinterpret_cast<float4*>(dt + (size_t)m * 64 + (n - 5120)) = make_float4(softplusf(v[0] + bb.x), softplusf(v[1] + bb.y), softplusf(v[2] + bb.z), softplusf(v[3] + bb.w));
        }
      });
    }
  }
  {
    const int nb = (25 - xcd + 7) >> 3;
    for (int t = li; t < 8 * nb; t += nl) {
      int pm = t / nb, pn = xcd + 8 * (t % nb);
      gemm_tile(hc, 1024, Wt + (size_t)2048 * 1024, 1024, pm * 256, pn * 128, 3136, 1024, lds, [=](int m, int n, f32x4 v) {
        if (n < 3072) *reinterpret_cast<uint2*>(xbc_c + (size_t)m * 3072 + n) = make_uint2(pack2(v[0], v[1]), pack2(v[2], v[3]));
        else if (n < 3136) {
          float4 bb = *reinterpret_cast<const float4*>(dtb + (n - 3072));
          *reinterpret_cast<float4*>(dt_c + (size_t)m * 64 + (n - 3072)) = make_float4(softplusf(v[0] + bb.x), softplusf(v[1] + bb.y), softplusf(v[2] + bb.z), softplusf(v[3] + bb.w));
        }
      });
    }
  }
}

DEV void fma8(float* acc, const u32x4& v, const float* w) {
  acc[0] += bflo(v[0]) * w[0]; acc[1] += bfhi(v[0]) * w[1]; acc[2] += bflo(v[1]) * w[2]; acc[3] += bfhi(v[1]) * w[3];
  acc[4] += bflo(v[2]) * w[4]; acc[5] += bfhi(v[2]) * w[5]; acc[6] += bflo(v[3]) * w[6]; acc[7] += bfhi(v[3]) * w[7];
}
__device__ __forceinline__ void phase_conv(const Params& p) {
  const u16* xbc = (const u16*)(p.ws + OFF_R1);
  u16* xc = (u16*)(p.ws + OFF_R2);
  const u16* xbc_c = (const u16*)(p.ws + OFF_XBC_C);
  u16* xc_c = (u16*)(p.ws + OFF_XC_C);
  const float* cw = p.m_conv_w;
  const float* cb = p.m_conv_b;
  const int tid_ = otid();
  const size_t nl = (size_t)8 * 64 * 8 * 384;
  for (size_t e = (size_t)blockIdx.x * 256 + tid_; e < nl; e += (size_t)gridDim.x * 256) {
    int ch = (int)(e % 384) * 8;
    int rest = (int)(e / 384);
    int cg_ = rest & 7, r = (rest >> 3) & 63, b = rest >> 9;
    float w[9][8];
#pragma unroll
    for (int k = 0; k < 9; ++k) {
      float4 w0 = *reinterpret_cast<const float4*>(cw + k * 3072 + ch), w1 = *reinterpret_cast<const float4*>(cw + k * 3072 + ch + 4);
      w[k][0] = w0.x; w[k][1] = w0.y; w[k][2] = w0.z; w[k][3] = w0.w; w[k][4] = w1.x; w[k][5] = w1.y; w[k][6] = w1.z; w[k][7] = w1.w;
    }
    float bias[8];
    {
      float4 b0 = *reinterpret_cast<const float4*>(cb + ch), b1 = *reinterpret_cast<const float4*>(cb + ch + 4);
      bias[0] = b0.x; bias[1] = b0.y; bias[2] = b0.z; bias[3] = b0.w; bias[4] = b1.x; bias[5] = b1.y; bias[6] = b1.z; bias[7] = b1.w;
    }
    const u32x4 zero4 = u32x4{0u, 0u, 0u, 0u};
    const int c0 = cg_ * 8;
    u32x4 win[3][3];
#pragma unroll
    for (int i = 0; i < 3; ++i) {
      int rr = r + i - 1;
      bool rok = rr >= 0 && rr <= 63;
      const u16* rowp = xbc + ((size_t)(b * 4096 + (rok ? rr : r) * 64)) * 3072 + ch;
      win[i][0] = (rok && c0 > 0) ? *reinterpret_cast<const u32x4*>(rowp + (size_t)(c0 - 1) * 3072) : zero4;
      win[i][1] = rok ? *reinterpret_cast<const u32x4*>(rowp + (size_t)c0 * 3072) : zero4;
    }
#pragma unroll
    for (int cc = 0; cc < 8; ++cc) {
      int c = c0 + cc;
#pragma unroll
      for (int i = 0; i < 3; ++i) {
        int rr = r + i - 1;
        bool rok = rr >= 0 && rr <= 63;
        const u16* rowp = xbc + ((size_t)(b * 4096 + (rok ? rr : r) * 64)) * 3072 + ch;
        win[i][2] = (rok && c < 63) ? *reinterpret_cast<const u32x4*>(rowp + (size_t)(c + 1) * 3072) : zero4;
      }
      float acc[8];
#pragma unroll
      for (int k = 0; k < 8; ++k) acc[k] = bias[k];
#pragma unroll
      for (int i = 0; i < 3; ++i)
#pragma unroll
        for (int j = 0; j < 3; ++j) fma8(acc, win[i][j], w[i * 3 + j]);
      uint4 o;
      o.x = pack2(siluf(acc[0]), siluf(acc[1]));
      o.y = pack2(siluf(acc[2]), siluf(acc[3]));
      o.z = pack2(siluf(acc[4]), siluf(acc[5]));
      o.w = pack2(siluf(acc[6]), siluf(acc[7]));
      *reinterpret_cast<uint4*>(xc + ((size_t)(b * 4096 + r * 64 + c)) * 3072 + ch) = o;
#pragma unroll
      for (int i = 0; i < 3; ++i) { win[i][0] = win[i][1]; win[i][1] = win[i][2]; }
    }
  }
  const size_t ncx = (size_t)NTC * 384;
  for (size_t e = (size_t)blockIdx.x * 256 + tid_; e < ncx; e += (size_t)gridDim.x * 256) {
    int tok = (int)(e / 384), ch = (int)(e % 384) * 8;
    float acc[8];
#pragma unroll
    for (int k = 0; k < 8; ++k) acc[k] = cb[ch + k];
    int b = tok >> 8, c = tok & 255;
#pragma unroll
    for (int j = 0; j < 3; ++j) {
      int cc = c + j - 1;
      if (cc < 0 || cc > 255) continue;
      uint4 v = *reinterpret_cast<const uint4*>(xbc_c + ((size_t)(b * 256 + cc)) * 3072 + ch);
      const float* w = cw + (3 + j) * 3072 + ch;
      float4 w0 = *reinterpret_cast<const float4*>(w), w1 = *reinterpret_cast<const float4*>(w + 4);
      acc[0] += bflo(v.x) * w0.x; acc[1] += bfhi(v.x) * w0.y; acc[2] += bflo(v.y) * w0.z; acc[3] += bfhi(v.y) * w0.w;
      acc[4] += bflo(v.z) * w1.x; acc[5] += bfhi(v.z) * w1.y; acc[6] += bflo(v.w) * w1.z; acc[7] += bfhi(v.w) * w1.w;
    }
    uint4 o;
    o.x = pack2(siluf(acc[0]), siluf(acc[1]));
    o.y = pack2(siluf(acc[2]), siluf(acc[3]));
    o.z = pack2(siluf(acc[4]), siluf(acc[5]));
    o.w = pack2(siluf(acc[6]), siluf(acc[7]));
    *reinterpret_cast<uint4*>(xc_c + (size_t)tok * 3072 + ch) = o;
  }
}

constexpr int SLD = 136;
__device__ __forceinline__ void phase_ssd(const Params& p, char* lds) {
  u16* xsT = (u16*)lds;
  u16* stb = xsT + 64 * SLD;
  u16* Mb = stb + 64 * SLD;
  float* cum = (float*)(Mb + 128 * SLD);
  float* dtv = cum + 128;
  float* asrc = dtv + 128;
  const u16* xc = (const u16*)(p.ws + OFF_R2);
  const u16* xc_c = (const u16*)(p.ws + OFF_XC_C);
  const float* dt = (const float*)(p.ws + OFF_DT);
  const float* dt_c = (const float*)(p.ws + OFF_DT_C);
  u16* y = (u16*)(p.ws + OFF_R1);
  int tid = otid(), w = tid >> 6, lane = tid & 63, fr = lane & 15, fq = lane >> 4;
  for (int item = blockIdx.x; item < 256; item += gridDim.x) {
    int b = item >> 5, h = item & 31, g = h >> 3;
    float dsk = p.m_d[h];
    for (int dir = 0; dir < 2; ++dir) {
      float a_neg = -__expf(p.m_a_log[dir * 32 + h]);
      f32x4 acc_s[8];
#pragma unroll
      for (int n = 0; n < 8; ++n) acc_s[n] = f32x4{0.f, 0.f, 0.f, 0.f};
      for (int step = 0; step < 34; ++step) {
        bool isctx = step < 2;
        int cidx = isctx ? step : step - 2;
        if (dir) cidx = (isctx ? 1 : 31) - cidx;
        size_t tok0 = isctx ? (size_t)(b * 256 + cidx * 128) : (size_t)(b * 4096 + cidx * 128);
        const u16* src = (isctx ? xc_c : xc) + tok0 * 3072;
        const float* dts = (isctx ? dt_c : dt) + tok0 * 64;
        int tz = tid;
        asm volatile("" : "+v"(tz));
        float dval = 0.f;
        if (tid < 128) dval = dts[tid * 64 + dir * 32 + h];
        uint4 xv[4], bv[8];
#pragma unroll
        for (int i = 0; i < 4; ++i) {
          int idx = tz + i * 256, l = (idx & 31) | ((idx >> 8) << 5), pc = ((idx >> 5) & 7) * 8;
          xv[i] = *reinterpret_cast<const uint4*>(src + (size_t)l * 3072 + h * 64 + pc);
        }
#pragma unroll
        for (int i = 0; i < 8; ++i) {
          int idx = tz + i * 256, l = (idx & 31) | (((idx >> 9) & 3) << 5), nc = (((idx >> 5) & 7) | (((idx >> 8) & 1) << 3)) * 8;
          bv[i] = *reinterpret_cast<const uint4*>(src + (size_t)l * 3072 + 2048 + g * 128 + nc);
        }
        if (tid < 128) { dtv[tid] = dval; asrc[tid] = dval * a_neg; }
#pragma unroll
        for (int i = 0; i < 4; ++i) {
          int idx = tz + i * 256, l = (idx & 31) | ((idx >> 8) << 5), pc = ((idx >> 5) & 7) * 8;
          uint4 v = xv[i];
          xsT[(pc + 0) * SLD + l] = (u16)(v.x & 0xffff); xsT[(pc + 1) * SLD + l] = (u16)(v.x >> 16);
          xsT[(pc + 2) * SLD + l] = (u16)(v.y & 0xffff); xsT[(pc + 3) * SLD + l] = (u16)(v.y >> 16);
          xsT[(pc + 4) * SLD + l] = (u16)(v.z & 0xffff); xsT[(pc + 5) * SLD + l] = (u16)(v.z >> 16);
          xsT[(pc + 6) * SLD + l] = (u16)(v.w & 0xffff); xsT[(pc + 7) * SLD + l] = (u16)(v.w >> 16);
        }
        if (!isctx) {
#pragma unroll
          for (int i = 0; i < 8; ++i) {
            int idx = tz + i * 256, l = (idx & 31) | (((idx >> 9) & 3) << 5), nc = (((idx >> 5) & 7) | (((idx >> 8) & 1) << 3)) * 8;
            *reinterpret_cast<uint4*>(Mb + l * SLD + nc) = bv[i];
          }
        }
        __syncthreads();
        bf16x8 Cf[2][4];
        if (!isctx) {
#pragma unroll
          for (int mt = 0; mt < 2; ++mt)
#pragma unroll
            for (int kk = 0; kk < 4; ++kk) Cf[mt][kk] = ld8(src + (size_t)(w * 32 + mt * 16 + fr) * 3072 + 2560 + g * 128 + kk * 32 + fq * 8);
        }
        if (tid < 128) {
          float s = 0.f;
          if (!dir) { for (int j = 0; j <= tid; ++j) s += asrc[j]; }
          else { for (int j = tid; j < 128; ++j) s += asrc[j]; }
          cum[tid] = s;
        }
        __syncthreads();
        float total = dir ? cum[0] : cum[127];
        if (!isctx) {
          float cl[2][4];
#pragma unroll
          for (int mt = 0; mt < 2; ++mt)
#pragma unroll
            for (int j = 0; j < 4; ++j) cl[mt][j] = cum[w * 32 + mt * 16 + fq * 4 + j];
          f32x4 cb0[8], cb1[8];
#pragma unroll
          for (int nt = 0; nt < 8; ++nt) {
            cb0[nt] = f32x4{0.f, 0.f, 0.f, 0.f};
            cb1[nt] = f32x4{0.f, 0.f, 0.f, 0.f};
            bool need = dir ? (nt >= w * 2) : (nt <= w * 2 + 1);
            if (need) {
#pragma unroll
              for (int kk = 0; kk < 4; ++kk) {
                bf16x8 Bf = ld8(Mb + (nt * 16 + fr) * SLD + kk * 32 + fq * 8);
                cb0[nt] = mfma16(Cf[0][kk], Bf, cb0[nt]);
                cb1[nt] = mfma16(Cf[1][kk], Bf, cb1[nt]);
              }
            }
          }
          __syncthreads();
          int zero = 0;
          asm volatile("" : "+v"(zero));
#pragma unroll
          for (int nt = 0; nt < 8; ++nt) {
            int s = nt * 16 + fr + zero;
            float cs = cum[s], ds = dtv[s];
#pragma unroll
            for (int j = 0; j < 4; ++j) {
              int l0 = w * 32 + fq * 4 + j, l1 = l0 + 16;
              bool ok0 = dir ? (s >= l0) : (s <= l0);
              bool ok1 = dir ? (s >= l1) : (s <= l1);
              float v0 = ok0 ? cb0[nt][j] * __expf(cl[0][j] - cs) * ds : 0.f;
              float v1 = ok1 ? cb1[nt][j] * __expf(cl[1][j] - cs) * ds : 0.f;
              Mb[l0 * SLD + s] = f2bf(v0);
              Mb[l1 * SLD + s] = f2bf(v1);
            }
          }
          __syncthreads();
          f32x4 ya[2][4];
#pragma unroll
          for (int mt = 0; mt < 2; ++mt)
#pragma unroll
            for (int nt = 0; nt < 4; ++nt) ya[mt][nt] = f32x4{0.f, 0.f, 0.f, 0.f};
#pragma unroll
          for (int kk = 0; kk < 4; ++kk)
#pragma unroll
            for (int nt = 0; nt < 4; ++nt) {
              bf16x8 Sf = ld8(stb + (nt * 16 + fr) * SLD + kk * 32 + fq * 8);
              ya[0][nt] = mfma16(Cf[0][kk], Sf, ya[0][nt]);
              ya[1][nt] = mfma16(Cf[1][kk], Sf, ya[1][nt]);
            }
#pragma unroll
          for (int mt = 0; mt < 2; ++mt)
#pragma unroll
            for (int j = 0; j < 4; ++j) {
              float e = __expf(cl[mt][j]);
#pragma unroll
              for (int nt = 0; nt < 4; ++nt) ya[mt][nt][j] *= e;
            }
#pragma unroll
          for (int kk = 0; kk < 4; ++kk) {
            bf16x8 Mf0 = ld8(Mb + (w * 32 + fr) * SLD + kk * 32 + fq * 8);
            bf16x8 Mf1 = ld8(Mb + (w * 32 + 16 + fr) * SLD + kk * 32 + fq * 8);
#pragma unroll
            for (int nt = 0; nt < 4; ++nt) {
              bf16x8 Xf = ld8(xsT + (nt * 16 + fr) * SLD + kk * 32 + fq * 8);
              ya[0][nt] = mfma16(Mf0, Xf, ya[0][nt]);
              ya[1][nt] = mfma16(Mf1, Xf, ya[1][nt]);
            }
          }
#pragma unroll
          for (int i = 0; i < 8; ++i) {
            int idx = tz + i * 256, l = (idx & 31) | (((idx >> 9) & 3) << 5), nc = (((idx >> 5) & 7) | (((idx >> 8) & 1) << 3)) * 8;
            bv[i] = *reinterpret_cast<const uint4*>(src + (size_t)l * 3072 + 2048 + g * 128 + nc);
          }
#pragma unroll
          for (int mt = 0; mt < 2; ++mt)
#pragma unroll
            for (int nt = 0; nt < 4; ++nt)
#pragma unroll
              for (int j = 0; j < 4; ++j) {
                int l = w * 32 + mt * 16 + fq * 4 + j, pp = nt * 16 + fr;
                u16* yp = y + (tok0 + l) * 2048 + h * 64 + pp;
                float val = ya[mt][nt][j];
                if (!dir) val += bf2f(xsT[pp * SLD + l]) * dsk;
                else val += bf2f(*yp);
                *yp = f2bf(val);
              }
        }
        if (step == 33) continue;
        __syncthreads();
#pragma unroll
        for (int i = 0; i < 8; ++i) {
          int idx = tz + i * 256, l = (idx & 31) | (((idx >> 9) & 3) << 5), nc = (((idx >> 5) & 7) | (((idx >> 8) & 1) << 3)) * 8;
          uint4 v = bv[i];
          float sc = dtv[l] * __expf(total - cum[l]);
          Mb[(nc + 0) * SLD + l] = f2bf(bflo(v.x) * sc); Mb[(nc + 1) * SLD + l] = f2bf(bfhi(v.x) * sc);
          Mb[(nc + 2) * SLD + l] = f2bf(bflo(v.y) * sc); Mb[(nc + 3) * SLD + l] = f2bf(bfhi(v.y) * sc);
          Mb[(nc + 4) * SLD + l] = f2bf(bflo(v.z) * sc); Mb[(nc + 5) * SLD + l] = f2bf(bfhi(v.z) * sc);
          Mb[(nc + 6) * SLD + l] = f2bf(bflo(v.w) * sc); Mb[(nc + 7) * SLD + l] = f2bf(bfhi(v.w) * sc);
        }
        __syncthreads();
        float cd = __expf(total);
#pragma unroll
        for (int nt = 0; nt < 8; ++nt) acc_s[nt] *= cd;
#pragma unroll
        for (int kk = 0; kk < 4; ++kk) {
          bf16x8 Af = ld8(xsT + (w * 16 + fr) * SLD + kk * 32 + fq * 8);
#pragma unroll
          for (int nt = 0; nt < 8; ++nt) {
            bf16x8 Bf = ld8(Mb + (nt * 16 + fr) * SLD + kk * 32 + fq * 8);
            acc_s[nt] = mfma16(Af, Bf, acc_s[nt]);
          }
        }
#pragma unroll
        for (int nt = 0; nt < 8; ++nt)
#pragma unroll
          for (int j = 0; j < 4; ++j) stb[(w * 16 + fq * 4 + j) * SLD + nt * 16 + fr] = f2bf(acc_s[nt][j]);
        __syncthreads();
      }
      __syncthreads();
    }
  }
}

__device__ __forceinline__ void phase_gated_norm(const Params& p) {
  u16* y = (u16*)(p.ws + OFF_R1);
  const u16* z = (const u16*)p.out;
  const int tid_ = otid();
  int lane = tid_ & 63;
  int wave = blockIdx.x * 4 + (tid_ >> 6), nw = gridDim.x * 4;
  for (int tok = wave; tok < NT; tok += nw) {
#pragma unroll
    for (int g = 0; g < 4; ++g) {
      int ch = g * 512 + lane * 8;
      uint4 yv = *reinterpret_cast<const uint4*>(y + (size_t)tok * 2048 + ch);
      uint4 zv = *reinterpret_cast<const uint4*>(z + (size_t)tok * 2048 + ch);
      float u[8];
      u[0] = bflo(yv.x) * siluf(bflo(zv.x)); u[1] = bfhi(yv.x) * siluf(bfhi(zv.x));
      u[2] = bflo(yv.y) * siluf(bflo(zv.y)); u[3] = bfhi(yv.y) * siluf(bfhi(zv.y));
      u[4] = bflo(yv.z) * siluf(bflo(zv.z)); u[5] = bfhi(yv.z) * siluf(bfhi(zv.z));
      u[6] = bflo(yv.w) * siluf(bflo(zv.w)); u[7] = bfhi(yv.w) * siluf(bfhi(zv.w));
      float ss = 0.f;
#pragma unroll
      for (int k = 0; k < 8; ++k) ss += u[k] * u[k];
      ss = wave_sum(ss);
      float sc = rsqrtf(ss * (1.f / 512.f) + 1e-5f);
      float4 w0 = *reinterpret_cast<const float4*>(p.m_norm_w + ch), w1 = *reinterpret_cast<const float4*>(p.m_norm_w + ch + 4);
      uint4 o;
      o.x = pack2(u[0] * sc * w0.x, u[1] * sc * w0.y);
      o.y = pack2(u[2] * sc * w0.z, u[3] * sc * w0.w);
      o.z = pack2(u[4] * sc * w1.x, u[5] * sc * w1.y);
      o.w = pack2(u[6] * sc * w1.z, u[7] * sc * w1.w);
      *reinterpret_cast<uint4*>(y + (size_t)tok * 2048 + ch) = o;
    }
  }
}

__device__ __forceinline__ void phase_gemm_resid(const u16* A, int K, const u16* Wt, const float* res, float* dst, const float* gate  , char* lds) {
  const int xcd = blockIdx.x & 7, li = blockIdx.x >> 3, nl = gridDim.x >> 3;
  for (int t = li; t < 128; t += nl) {
    int pm = t, pn = xcd;
    gemm_tile(A, K, Wt, K, pm * 256, pn * 128, 1024, K, lds, [=](int m, int n, f32x4 v) {
      int b = m >> 12;
      float4 r = *reinterpret_cast<const float4*>(res + (size_t)m * 1024 + n);
      float4 g = *reinterpret_cast<const float4*>(gate + (size_t)b * 6144 + n);
      *reinterpret_cast<float4*>(dst + (size_t)m * 1024 + n) = make_float4(ALPHA * r.x + g.x * v[0], ALPHA * r.y + g.y * v[1], ALPHA * r.z + g.z * v[2], ALPHA * r.w + g.w * v[3]);
    });
  }
}
__device__ __forceinline__ void phase_gemm_bf16(const u16* A, const u16* Wt, u16* dst, int N, char* lds) {
  const int xcd = blockIdx.x & 7, li = blockIdx.x >> 3, nl = gridDim.x >> 3;
  const int nb = N / 1024;
  for (int t = li; t < 128 * nb; t += nl) {
    int pm = t / nb, pn = xcd + 8 * (t % nb);
    gemm_tile(A, 1024, Wt, 1024, pm * 256, pn * 128, N, 1024, lds, [=](int m, int n, f32x4 v) { *reinterpret_cast<uint2*>(dst + (size_t)m * N + n) = make_uint2(pack2(v[0], v[1]), pack2(v[2], v[3])); });
  }
}

__device__ __forceinline__ void phase_ln_mod(float* xio, const float* g, const float* bta, const float* mod  , u16* tdst) {
  const int tid_ = otid();
  int lane = tid_ & 63;
  int wave = blockIdx.x * 4 + (tid_ >> 6), nw = gridDim.x * 4;
  for (int tok = wave; tok < NT; tok += nw) {
    int b = tok >> 12;
    float4 v[4];
    float s = 0.f;
#pragma unroll
    for (int i = 0; i < 4; ++i) {
      v[i] = *reinterpret_cast<const float4*>(xio + (size_t)tok * 1024 + i * 256 + lane * 4);
      s += v[i].x + v[i].y + v[i].z + v[i].w;
    }
    float mu = wave_sum(s) * (1.f / 1024.f);
    float q = 0.f;
#pragma unroll
    for (int i = 0; i < 4; ++i) {
      v[i].x -= mu; v[i].y -= mu; v[i].z -= mu; v[i].w -= mu;
      q += v[i].x * v[i].x + v[i].y * v[i].y + v[i].z * v[i].z + v[i].w * v[i].w;
    }
    float rs = rsqrtf(wave_sum(q) * (1.f / 1024.f) + 1e-5f);
    const float* m = mod + (size_t)b * 6144;
#pragma unroll
    for (int i = 0; i < 4; ++i) {
      int c = i * 256 + lane * 4;
      float4 gg = *reinterpret_cast<const float4*>(g + c), bb = *reinterpret_cast<const float4*>(bta + c);
      float4 o;
      o.x = v[i].x * rs * gg.x + bb.x; o.y = v[i].y * rs * gg.y + bb.y; o.z = v[i].z * rs * gg.z + bb.z; o.w = v[i].w * rs * gg.w + bb.w;
      *reinterpret_cast<float4*>(xio + (size_t)tok * 1024 + c) = o;
      float4 sh = *reinterpret_cast<const float4*>(m + 3072 + c), sc = *reinterpret_cast<const float4*>(m + 4096 + c);
      uint2 t;
      t.x = pack2(o.x * (1.f + sc.x) + sh.x, o.y * (1.f + sc.y) + sh.y);
      t.y = pack2(o.z * (1.f + sc.z) + sh.z, o.w * (1.f + sc.w) + sh.w);
      *reinterpret_cast<uint2*>(tdst + (size_t)tok * 1024 + c) = t;
    }
  }
}

__device__ __forceinline__ void phase_peer_topk(const u16* q, const u16* k1, const u16* k2, int* idxo, float* gateo, char* lds) {
  float* S = (float*)lds;
  float* sv = S + 64 * 129;
  int* si = (int*)(sv + 64 * 16);
  int tid = otid(), w = tid >> 6, lane = tid & 63, fr = lane & 15, fq = lane >> 4;
  const int slot = lane;
  const bool cvalid = lane < 50;
  int ci = slot < 42 ? ((slot >= 16) + (slot >= 24) + (slot >= 29) + (slot >= 33) + (slot >= 36) + (slot >= 38) + (slot >= 40)) : slot - 34;
  const unsigned long long PACK = 0ull | (16ull << 8) | (24ull << 16) | (29ull << 24) | (33ull << 32) | (36ull << 40) | (38ull << 48) | (40ull << 56);
  int cj = slot - (ci < 8 ? (int)((PACK >> (8 * ci)) & 0xFF) : 34 + ci);
  if (!cvalid) { ci = 0; cj = 0; }
  for (int item = blockIdx.x; item < 1024 * 8; item += gridDim.x) {
    int tile = item >> 3, h = item & 7;
    int tok0 = tile * 32;
    {
      int half = w >> 1, kb = (w & 1) * 64;
      const u16* kk_ = (half ? k2 : k1) + (size_t)h * 128 * 128;
      bf16x8 Af[2][4], Bf[4][4];
#pragma unroll
      for (int m = 0; m < 2; ++m)
#pragma unroll
        for (int ks = 0; ks < 4; ++ks) Af[m][ks] = ld8(q + (size_t)(tok0 + m * 16 + fr) * 2048 + h * 256 + half * 128 + ks * 32 + fq * 8);
#pragma unroll
      for (int n = 0; n < 4; ++n)
#pragma unroll
        for (int ks = 0; ks < 4; ++ks) Bf[n][ks] = ld8(kk_ + (size_t)(kb + n * 16 + fr) * 128 + ks * 32 + fq * 8);
      f32x4 acc[2][4];
#pragma unroll
      for (int m = 0; m < 2; ++m)
#pragma unroll
        for (int n = 0; n < 4; ++n) acc[m][n] = f32x4{0.f, 0.f, 0.f, 0.f};
#pragma unroll
      for (int ks = 0; ks < 4; ++ks)
#pragma unroll
        for (int n = 0; n < 4; ++n) {
          acc[0][n] = mfma16(Af[0][ks], Bf[n][ks], acc[0][n]);
          acc[1][n] = mfma16(Af[1][ks], Bf[n][ks], acc[1][n]);
        }
#pragma unroll
      for (int m = 0; m < 2; ++m)
#pragma unroll
        for (int n = 0; n < 4; ++n)
#pragma unroll
          for (int j = 0; j < 4; ++j) S[(half * 32 + m * 16 + fq * 4 + j) * 129 + kb + n * 16 + fr] = acc[m][n][j];
    }
    __syncthreads();
#pragma unroll 1
    for (int li = 0; li < 16; ++li) {
      int list = w * 16 + li;
      const float* row = S + list * 129;
      float vlo = row[lane], vhi = row[lane + 64];
      unsigned long long klo = ((unsigned long long)ordkey(vlo) << 7) | (unsigned)(127 - lane);
      unsigned long long khi = ((unsigned long long)ordkey(vhi) << 7) | (unsigned)(63 - lane);
      unsigned long long T = 0;
#pragma unroll 3
      for (int bit = 38; bit >= 0; --bit) {
        unsigned long long cand = T | (1ull << bit);
        int cnt = __popcll(__ballot(klo >= cand)) + __popcll(__ballot(khi >= cand));
        if (cnt >= 16) T = cand;
        if (cnt == 16) break;
      }
      bool slo = klo >= T, shi = khi >= T;
      unsigned long long mlo = __ballot(slo), mhi = __ballot(shi);
      int rlo = 0, rhi = 0;
      int klo_l = (int)(unsigned)klo, klo_h = (int)(unsigned)(klo >> 32), khi_l = (int)(unsigned)khi, khi_h = (int)(unsigned)(khi >> 32);
      while (mlo) {
        int src = __ffsll((long long)mlo) - 1;
        mlo &= mlo - 1;
        unsigned long long ks = ((unsigned long long)(unsigned)__builtin_amdgcn_readlane(klo_h, src) << 32) | (unsigned)__builtin_amdgcn_readlane(klo_l, src);
        rlo += (ks > klo) ? 1 : 0;
        rhi += (ks > khi) ? 1 : 0;
      }
      while (mhi) {
        int src = __ffsll((long long)mhi) - 1;
        mhi &= mhi - 1;
        unsigned long long ks = ((unsigned long long)(unsigned)__builtin_amdgcn_readlane(khi_h, src) << 32) | (unsigned)__builtin_amdgcn_readlane(khi_l, src);
        rlo += (ks > klo) ? 1 : 0;
        rhi += (ks > khi) ? 1 : 0;
      }
      if (slo) { sv[list * 16 + rlo] = vlo; si[list * 16 + rlo] = lane; }
      if (shi) { sv[list * 16 + rhi] = vhi; si[list * 16 + rhi] = lane + 64; }
    }
    __syncthreads();
#pragma unroll 1
    for (int tt = 0; tt < 8; ++tt) {
      int tok = w * 8 + tt;
      float sc_ = sv[tok * 16 + ci] + sv[(32 + tok) * 16 + cj];
      unsigned long long key = cvalid ? ((((unsigned long long)ordkey(sc_)) << 6) | (unsigned)(63 - lane)) : 0ull;
      unsigned long long T = 0;
#pragma unroll 3
      for (int bit = 37; bit >= 0; --bit) {
        unsigned long long cand = T | (1ull << bit);
        int cnt = __popcll(__ballot(key >= cand));
        if (cnt >= 16) T = cand;
        if (cnt == 16) break;
      }
      bool sel = cvalid && key >= T;
      unsigned long long msel = __ballot(sel);
      int rank = 0;
      int k_l = (int)(unsigned)key, k_h = (int)(unsigned)(key >> 32);
      int isc = __float_as_int(sc_);
      unsigned long long mm = msel;
      float mx = -INFINITY;
      while (mm) {
        int src = __ffsll((long long)mm) - 1;
        mm &= mm - 1;
        unsigned long long ks = ((unsigned long long)(unsigned)__builtin_amdgcn_readlane(k_h, src) << 32) | (unsigned)__builtin_amdgcn_readlane(k_l, src);
        rank += (ks > key) ? 1 : 0;
        mx = fmaxf(mx, __int_as_float(__builtin_amdgcn_readlane(isc, src)));
      }
      float ex = sel ? __expf(sc_ - mx) : 0.f;
      int iex = __float_as_int(ex);
      float sum = 0.f;
      mm = msel;
      while (mm) {
        int src = __ffsll((long long)mm) - 1;
        mm &= mm - 1;
        sum += __int_as_float(__builtin_amdgcn_readlane(iex, src));
      }
      if (sel) {
        size_t o = (size_t)(tok0 + tok) * 128 + h * 16 + rank;
        gateo[o] = ex / sum;
        idxo[o] = si[tok * 16 + ci] * 128 + si[(32 + tok) * 16 + cj];
      }
    }
  }
  __syncthreads();
}

DEV float gelu_exact(float v) { return 0.5f * v * (1.f + erff(v * 0.70710678118654752f)); }

typedef float f32x2 __attribute__((ext_vector_type(2)));
__device__ __forceinline__ void convert_fp8_rows(const float* src, unsigned char* dst, float* rscale, int nrows) {
  const int tid_ = otid();
  int lane = tid_ & 63;
  int wave = blockIdx.x * 4 + (tid_ >> 6), nw = gridDim.x * 4;
  for (int row = wave; row < nrows; row += nw) {
    const float* r = src + (size_t)row * 1024 + lane * 16;
    float4 a0 = *reinterpret_cast<const float4*>(r), a1 = *reinterpret_cast<const float4*>(r + 4);
    float4 a2 = *reinterpret_cast<const float4*>(r + 8), a3 = *reinterpret_cast<const float4*>(r + 12);
    float m = fmaxf(fmaxf(fmaxf(fabsf(a0.x), fabsf(a0.y)), fmaxf(fabsf(a0.z), fabsf(a0.w))), fmaxf(fmaxf(fabsf(a1.x), fabsf(a1.y)), fmaxf(fabsf(a1.z), fabsf(a1.w))));
    m = fmaxf(m, fmaxf(fmaxf(fmaxf(fabsf(a2.x), fabsf(a2.y)), fmaxf(fabsf(a2.z), fabsf(a2.w))), fmaxf(fmaxf(fabsf(a3.x), fabsf(a3.y)), fmaxf(fabsf(a3.z), fabsf(a3.w)))));
#pragma unroll
    for (int o = 32; o > 0; o >>= 1) m = fmaxf(m, __shfl_xor(m, o));
    float sc = m > 0.f ? exp2f(floorf(log2f(224.f / m))) : 1.f;
    uint4 o;
    int p;
    p = __builtin_amdgcn_cvt_pk_fp8_f32(a0.x * sc, a0.y * sc, 0, false); p = __builtin_amdgcn_cvt_pk_fp8_f32(a0.z * sc, a0.w * sc, p, true); o.x = (unsigned)p;
    p = __builtin_amdgcn_cvt_pk_fp8_f32(a1.x * sc, a1.y * sc, 0, false); p = __builtin_amdgcn_cvt_pk_fp8_f32(a1.z * sc, a1.w * sc, p, true); o.y = (unsigned)p;
    p = __builtin_amdgcn_cvt_pk_fp8_f32(a2.x * sc, a2.y * sc, 0, false); p = __builtin_amdgcn_cvt_pk_fp8_f32(a2.z * sc, a2.w * sc, p, true); o.z = (unsigned)p;
    p = __builtin_amdgcn_cvt_pk_fp8_f32(a3.x * sc, a3.y * sc, 0, false); p = __builtin_amdgcn_cvt_pk_fp8_f32(a3.z * sc, a3.w * sc, p, true); o.w = (unsigned)p;
    *reinterpret_cast<uint4*>(dst + (size_t)row * 1024 + lane * 16) = o;
    if (lane == 0) rscale[row] = 1.f / sc;
  }
}

#define F8X(dst, WW) { dst[0] = __builtin_amdgcn_cvt_pk_f32_fp8((int)(WW).x, false); dst[1] = __builtin_amdgcn_cvt_pk_f32_fp8((int)(WW).x, true); \
                      dst[2] = __builtin_amdgcn_cvt_pk_f32_fp8((int)(WW).y, false); dst[3] = __builtin_amdgcn_cvt_pk_f32_fp8((int)(WW).y, true); \
                      dst[4] = __builtin_amdgcn_cvt_pk_f32_fp8((int)(WW).z, false); dst[5] = __builtin_amdgcn_cvt_pk_f32_fp8((int)(WW).z, true); \
                      dst[6] = __builtin_amdgcn_cvt_pk_f32_fp8((int)(WW).w, false); dst[7] = __builtin_amdgcn_cvt_pk_f32_fp8((int)(WW).w, true); }

__device__ __forceinline__ void phase_peer_gather(const u16* tin, const int* idx, const float* gate, const unsigned char* utab, const unsigned char* vtab,
                                  const float* urs, const float* vrs, const float* xres,
                                  const float* g2  , const float* lng, const float* lnb, float* xout,
                                  const float* modnext  , u16* hxout) {
  const int tid_ = otid();
  int lane = tid_ & 63;
  int wave = blockIdx.x * 4 + (tid_ >> 6), nw = gridDim.x * 4;
  for (int tok = wave; tok < NT; tok += nw) {
    int b = tok >> 12;
    f32x2 t2[8];
    {
      uint4 ta = *reinterpret_cast<const uint4*>(tin + (size_t)tok * 1024 + lane * 16);
      uint4 tb = *reinterpret_cast<const uint4*>(tin + (size_t)tok * 1024 + lane * 16 + 8);
      t2[0] = f32x2{bflo(ta.x), bfhi(ta.x)}; t2[1] = f32x2{bflo(ta.y), bfhi(ta.y)}; t2[2] = f32x2{bflo(ta.z), bfhi(ta.z)}; t2[3] = f32x2{bflo(ta.w), bfhi(ta.w)};
      t2[4] = f32x2{bflo(tb.x), bfhi(tb.x)}; t2[5] = f32x2{bflo(tb.y), bfhi(tb.y)}; t2[6] = f32x2{bflo(tb.z), bfhi(tb.z)}; t2[7] = f32x2{bflo(tb.w), bfhi(tb.w)};
    }
    int id0 = idx[(size_t)tok * 128 + lane] & 16383, id1 = idx[(size_t)tok * 128 + 64 + lane] & 16383;
    int gt0 = __float_as_int(gate[(size_t)tok * 128 + lane]), gt1 = __float_as_int(gate[(size_t)tok * 128 + 64 + lane]);
    f32x2 acc2[8];
#pragma unroll
    for (int k = 0; k < 8; ++k) acc2[k] = f32x2{0.f, 0.f};
#pragma unroll 1
    for (int j = 0; j < 128; j += 4) {
      int e[4];
      float g[4];
      if (j < 64) {
#pragma unroll
        for (int q = 0; q < 4; ++q) { e[q] = __builtin_amdgcn_readlane(id0, j + q); g[q] = __int_as_float(__builtin_amdgcn_readlane(gt0, j + q)); }
      } else {
#pragma unroll
        for (int q = 0; q < 4; ++q) { e[q] = __builtin_amdgcn_readlane(id1, j - 64 + q); g[q] = __int_as_float(__builtin_amdgcn_readlane(gt1, j - 64 + q)); }
      }
      uint4 U[4], V[4];
      float su[4], sv_[4];
#pragma unroll
      for (int q = 0; q < 4; ++q) {
        U[q] = *reinterpret_cast<const uint4*>(utab + (size_t)e[q] * 1024 + lane * 16);
        V[q] = *reinterpret_cast<const uint4*>(vtab + (size_t)e[q] * 1024 + lane * 16);
        su[q] = urs[e[q]];
        sv_[q] = vrs[e[q]];
      }
      float d[4];
#pragma unroll
      for (int q = 0; q < 4; ++q) {
        f32x2 u2[8];
        F8X(u2, U[q])
        f32x2 dd = u2[0] * t2[0];
#pragma unroll
        for (int k = 1; k < 8; ++k) dd = u2[k] * t2[k] + dd;
        d[q] = dd.x + dd.y;
      }
#pragma unroll
      for (int o = 32; o > 0; o >>= 1) {
#pragma unroll
        for (int q = 0; q < 4; ++q) d[q] += __shfl_xor(d[q], o);
      }
#pragma unroll
      for (int q = 0; q < 4; ++q) {
        float a = g[q] * gelu_exact(d[q] * su[q]) * sv_[q];
        f32x2 aa = f32x2{a, a};
        f32x2 v2[8];
        F8X(v2, V[q])
#pragma unroll
        for (int k = 0; k < 8; ++k) acc2[k] = aa * v2[k] + acc2[k];
      }
    }
    float vv[16];
    float s = 0.f;
    const int c0 = lane * 16;
#pragma unroll
    for (int k4 = 0; k4 < 4; ++k4) {
      float4 x0 = *reinterpret_cast<const float4*>(xres + (size_t)tok * 1024 + c0 + k4 * 4);
      float4 g0 = *reinterpret_cast<const float4*>(g2 + (size_t)b * 6144 + c0 + k4 * 4);
      vv[k4 * 4 + 0] = ALPHA * x0.x + g0.x * acc2[k4 * 2].x; vv[k4 * 4 + 1] = ALPHA * x0.y + g0.y * acc2[k4 * 2].y;
      vv[k4 * 4 + 2] = ALPHA * x0.z + g0.z * acc2[k4 * 2 + 1].x; vv[k4 * 4 + 3] = ALPHA * x0.w + g0.w * acc2[k4 * 2 + 1].y;
    }
#pragma unroll
    for (int k = 0; k < 16; ++k) s += vv[k];
    float mu = wave_sum(s) * (1.f / 1024.f);
    float qq = 0.f;
#pragma unroll
    for (int k = 0; k < 16; ++k) { vv[k] -= mu; qq += vv[k] * vv[k]; }
    float rs = rsqrtf(wave_sum(qq) * (1.f / 1024.f) + 1e-5f);
    float oo[16];
#pragma unroll
    for (int k4 = 0; k4 < 4; ++k4) {
      float4 ga = *reinterpret_cast<const float4*>(lng + c0 + k4 * 4), ba = *reinterpret_cast<const float4*>(lnb + c0 + k4 * 4);
      float4 o0;
      o0.x = vv[k4 * 4 + 0] * rs * ga.x + ba.x; o0.y = vv[k4 * 4 + 1] * rs * ga.y + ba.y; o0.z = vv[k4 * 4 + 2] * rs * ga.z + ba.z; o0.w = vv[k4 * 4 + 3] * rs * ga.w + ba.w;
      *reinterpret_cast<float4*>(xout + (size_t)tok * 1024 + c0 + k4 * 4) = o0;
      oo[k4 * 4 + 0] = o0.x; oo[k4 * 4 + 1] = o0.y; oo[k4 * 4 + 2] = o0.z; oo[k4 * 4 + 3] = o0.w;
    }
    if (modnext) {
      const float* m = modnext + (size_t)b * 6144;
      unsigned pk[8];
#pragma unroll
      for (int k4 = 0; k4 < 4; ++k4) {
        float4 sh0 = *reinterpret_cast<const float4*>(m + c0 + k4 * 4), sc0 = *reinterpret_cast<const float4*>(m + 1024 + c0 + k4 * 4);
        pk[k4 * 2] = pack2(oo[k4 * 4 + 0] * (1.f + sc0.x) + sh0.x, oo[k4 * 4 + 1] * (1.f + sc0.y) + sh0.y);
        pk[k4 * 2 + 1] = pack2(oo[k4 * 4 + 2] * (1.f + sc0.z) + sh0.z, oo[k4 * 4 + 3] * (1.f + sc0.w) + sh0.w);
      }
      *reinterpret_cast<uint4*>(hxout + (size_t)tok * 1024 + c0) = make_uint4(pk[0], pk[1], pk[2], pk[3]);
      *reinterpret_cast<uint4*>(hxout + (size_t)tok * 1024 + c0 + 8) = make_uint4(pk[4], pk[5], pk[6], pk[7]);
    }
  }
}

__device__ __forceinline__ void phase_shortconv_T(const Params& p, const u16* upre, u16* x1cm, u16* x2cm, u16* vcm, char* lds) {
  u16* tile = (u16*)lds;
  int tid = otid();
  for (int item = blockIdx.x; item < 512 * 48; item += gridDim.x) {
    int tt = item / 48, ct = item % 48;
    int tok0 = tt * 64, c0 = ct * 64;
#pragma unroll
    for (int i = 0; i < 2; ++i) {
      int q = tid + i * 256, tl = q >> 3, cg_ = (q & 7) * 8;
      int tok = tok0 + tl, l = tok & 4095, ch = c0 + cg_;
      float acc[8];
#pragma unroll
      for (int k = 0; k < 8; ++k) acc[k] = p.h_conv_b[ch + k];
#pragma unroll
      for (int j = 0; j < 3; ++j) {
        int ll = l + j - 1;
        if (ll < 0 || ll > 4095) continue;
        uint4 v = *reinterpret_cast<const uint4*>(upre + (size_t)(tok + j - 1) * 3072 + ch);
        const float* w = p.h_conv_w + j * 3072 + ch;
        float4 w0 = *reinterpret_cast<const float4*>(w), w1 = *reinterpret_cast<const float4*>(w + 4);
        acc[0] += bflo(v.x) * w0.x; acc[1] += bfhi(v.x) * w0.y; acc[2] += bflo(v.y) * w0.z; acc[3] += bfhi(v.y) * w0.w;
        acc[4] += bflo(v.z) * w1.x; acc[5] += bfhi(v.z) * w1.y; acc[6] += bflo(v.w) * w1.z; acc[7] += bfhi(v.w) * w1.w;
      }
#pragma unroll
      for (int k = 0; k < 8; ++k) tile[(cg_ + k) * 72 + tl] = f2bf(acc[k]);
    }
    __syncthreads();
    int part = c0 >> 10, d0 = c0 & 1023;
    u16* dst = part == 0 ? x1cm : (part == 1 ? x2cm : vcm);
    int b = tok0 >> 12, l0 = tok0 & 4095;
#pragma unroll
    for (int i = 0; i < 2; ++i) {
      int q = tid + i * 256, c = q >> 3, tg = (q & 7) * 8;
      uint4 v = *reinterpret_cast<const uint4*>(tile + c * 72 + tg);
      *reinterpret_cast<uint4*>(dst + ((size_t)(b * 1024 + d0 + c)) * 4096 + l0 + tg) = v;
    }
    __syncthreads();
  }
}

__device__ __forceinline__ void fft_fwd(float2* X) {
  int tid = otid();
  for (int s = 12; s >= 0; --s) {
    int half = 1 << s;
    float inv2h = 1.f / (float)(2 * half);
#pragma unroll 4
    for (int i = 0; i < 16; ++i) {
      int j = tid + i * 256;
      int pos = j & (half - 1);
      int i0 = ((j >> s) << (s + 1)) + pos, i1 = i0 + half;
      float fr_ = (float)pos * inv2h;
      float wr = __builtin_amdgcn_cosf(fr_), wi = -__builtin_amdgcn_sinf(fr_);
      float2 a = X[i0], bq = X[i1];
      float dr = a.x - bq.x, di = a.y - bq.y;
      X[i0] = make_float2(a.x + bq.x, a.y + bq.y);
      X[i1] = make_float2(dr * wr - di * wi, dr * wi + di * wr);
    }
    __syncthreads();
  }
}
__device__ __forceinline__ void fft_inv(float2* X) {
  int tid = otid();
  for (int s = 0; s <= 12; ++s) {
    int half = 1 << s;
    float inv2h = 1.f / (float)(2 * half);
#pragma unroll 4
    for (int i = 0; i < 16; ++i) {
      int j = tid + i * 256;
      int pos = j & (half - 1);
      int i0 = ((j >> s) << (s + 1)) + pos, i1 = i0 + half;
      float fr_ = (float)pos * inv2h;
      float wr = __builtin_amdgcn_cosf(fr_), wi = -__builtin_amdgcn_sinf(fr_);
      float2 a = X[i0], bq = X[i1];
      float br = bq.x * wr + bq.y * wi, bi = bq.y * wr - bq.x * wi;
      X[i0] = make_float2(a.x + br, a.y + bi);
      X[i1] = make_float2(a.x - br, a.y - bi);
    }
    __syncthreads();
  }
}

__device__ __forceinline__ void phase_filter_fft(const Params& p, float2* Hf, char* lds) {
  float2* X = (float2*)lds;
  float* w3s = (float*)(lds + 65536);
  float* red = w3s + 128;
  const float* hid = (const float*)(p.ws + OFF_HID);
  int tid = otid();
  const float min_decay = -3.0701134573253945f;
  const float max_decay = -15.350567286626973f;
  for (int item = blockIdx.x; item < 2048; item += gridDim.x) {
    int o = item >> 10, d = item & 1023;
    if (tid < 128) {
      int dirr = tid >> 6, j = tid & 63;
      w3s[tid] = p.h_f_w3[(size_t)j * 4096 + (o * 2 + dirr) * 1024 + d];
    }
    __syncthreads();
    float adelta = fabsf(min_decay + (float)d * ((max_decay - min_decay) / 1023.f));
    float ss = 0.f;
#pragma unroll 1
    for (int i = 0; i < 16; ++i) {
      int t = tid + i * 256;
      const float* hr = hid + (size_t)t * 64;
      float hf = 0.f, hb = 0.f;
#pragma unroll
      for (int j4 = 0; j4 < 16; ++j4) {
        float4 hv = *reinterpret_cast<const float4*>(hr + j4 * 4);
        hf += hv.x * w3s[j4 * 4] + hv.y * w3s[j4 * 4 + 1] + hv.z * w3s[j4 * 4 + 2] + hv.w * w3s[j4 * 4 + 3];
        hb += hv.x * w3s[64 + j4 * 4] + hv.y * w3s[64 + j4 * 4 + 1] + hv.z * w3s[64 + j4 * 4 + 2] + hv.w * w3s[64 + j4 * 4 + 3];
      }
      float dec = __expf(-((float)t / 4095.f) * adelta);
      hf *= dec; hb *= dec;
      if (t == 0) {
        float v = hf + hb;
        X[0] = make_float2(v, 0.f);
        X[4096] = make_float2(0.f, 0.f);
        ss += v * v;
      } else {
        X[t] = make_float2(hf, 0.f);
        X[8192 - t] = make_float2(hb, 0.f);
        ss += hf * hf + hb * hb;
      }
    }
    ss = wave_sum(ss);
    if ((tid & 63) == 0) red[tid >> 6] = ss;
    __syncthreads();
    float tot = red[0] + red[1] + red[2] + red[3];
    float scale = rsqrtf(tot + 1e-6f) * (1.f / 8192.f);
    fft_fwd(X);
    float2* dst = Hf + (size_t)item * 8192;
#pragma unroll 4
    for (int i = 0; i < 32; ++i) {
      int k = tid + i * 256;
      float2 v = X[k];
      dst[k] = make_float2(v.x * scale, v.y * scale);
    }
    __syncthreads();
  }
}

__device__ __forceinline__ void phase_hyena_conv(const Params& p, const u16* x1cm, const u16* x2cm, const u16* vcm, const float2* Hf, u16* zzcm, char* lds) {
  float2* X = (float2*)lds;
  int tid = otid();
  for (int item = blockIdx.x; item < 4096; item += gridDim.x) {
    int d = item >> 2, bp = item & 3;
    size_t r0 = ((size_t)((bp * 2) * 1024 + d)) * 4096, r1 = ((size_t)((bp * 2 + 1) * 1024 + d)) * 4096;
    float bias0 = p.h_bias[d], bias1 = p.h_bias[1024 + d];
#pragma unroll
    for (int i = 0; i < 2; ++i) {
      int t8 = (tid + i * 256) * 8;
      uint4 a = *reinterpret_cast<const uint4*>(vcm + r0 + t8);
      uint4 bq = *reinterpret_cast<const uint4*>(vcm + r1 + t8);
      X[t8 + 0] = make_float2(bflo(a.x), bflo(bq.x)); X[t8 + 1] = make_float2(bfhi(a.x), bfhi(bq.x));
      X[t8 + 2] = make_float2(bflo(a.y), bflo(bq.y)); X[t8 + 3] = make_float2(bfhi(a.y), bfhi(bq.y));
      X[t8 + 4] = make_float2(bflo(a.z), bflo(bq.z)); X[t8 + 5] = make_float2(bfhi(a.z), bfhi(bq.z));
      X[t8 + 6] = make_float2(bflo(a.w), bflo(bq.w)); X[t8 + 7] = make_float2(bfhi(a.w), bfhi(bq.w));
    }
    for (int i = 0; i < 16; ++i) X[4096 + tid + i * 256] = make_float2(0.f, 0.f);
    __syncthreads();
    fft_fwd(X);
    {
      const float2* H = Hf + (size_t)d * 8192;
#pragma unroll 4
      for (int i = 0; i < 32; ++i) {
        int k = tid + i * 256;
        float2 hv = H[k], xv = X[k];
        X[k] = make_float2(xv.x * hv.x - xv.y * hv.y, xv.x * hv.y + xv.y * hv.x);
      }
    }
    __syncthreads();
    fft_inv(X);
    float zz0[16], zz1[16];
#pragma unroll
    for (int i = 0; i < 2; ++i) {
      int t8 = (tid + i * 256) * 8;
      uint4 a = *reinterpret_cast<const uint4*>(vcm + r0 + t8);
      uint4 bq = *reinterpret_cast<const uint4*>(vcm + r1 + t8);
      uint4 xa = *reinterpret_cast<const uint4*>(x1cm + r0 + t8);
      uint4 xb = *reinterpret_cast<const uint4*>(x1cm + r1 + t8);
      float va[8] = {bflo(a.x), bfhi(a.x), bflo(a.y), bfhi(a.y), bflo(a.z), bfhi(a.z), bflo(a.w), bfhi(a.w)};
      float vb[8] = {bflo(bq.x), bfhi(bq.x), bflo(bq.y), bfhi(bq.y), bflo(bq.z), bfhi(bq.z), bflo(bq.w), bfhi(bq.w)};
      float fa[8] = {bflo(xa.x), bfhi(xa.x), bflo(xa.y), bfhi(xa.y), bflo(xa.z), bfhi(xa.z), bflo(xa.w), bfhi(xa.w)};
      float fb[8] = {bflo(xb.x), bfhi(xb.x), bflo(xb.y), bfhi(xb.y), bflo(xb.z), bfhi(xb.z), bflo(xb.w), bfhi(xb.w)};
#pragma unroll
      for (int e = 0; e < 8; ++e) {
        float2 cv = X[t8 + e];
        float z0 = fa[e] * (cv.x + va[e] * bias0);
        float z1 = fb[e] * (cv.y + vb[e] * bias0);
        zz0[i * 8 + e] = z0; zz1[i * 8 + e] = z1;
        X[t8 + e] = make_float2(z0, z1);
      }
    }
    for (int i = 0; i < 16; ++i) X[4096 + tid + i * 256] = make_float2(0.f, 0.f);
    __syncthreads();
    fft_fwd(X);
    {
      const float2* H = Hf + (size_t)(1024 + d) * 8192;
#pragma unroll 4
      for (int i = 0; i < 32; ++i) {
        int k = tid + i * 256;
        float2 hv = H[k], xv = X[k];
        X[k] = make_float2(xv.x * hv.x - xv.y * hv.y, xv.x * hv.y + xv.y * hv.x);
      }
    }
    __syncthreads();
    fft_inv(X);
#pragma unroll
    for (int i = 0; i < 2; ++i) {
      int t8 = (tid + i * 256) * 8;
      uint4 xa = *reinterpret_cast<const uint4*>(x2cm + r0 + t8);
      uint4 xb = *reinterpret_cast<const uint4*>(x2cm + r1 + t8);
      float fa[8] = {bflo(xa.x), bfhi(xa.x), bflo(xa.y), bfhi(xa.y), bflo(xa.z), bfhi(xa.z), bflo(xa.w), bfhi(xa.w)};
      float fb[8] = {bflo(xb.x), bfhi(xb.x), bflo(xb.y), bfhi(xb.y), bflo(xb.z), bfhi(xb.z), bflo(xb.w), bfhi(xb.w)};
      float o0[8], o1[8];
#pragma unroll
      for (int e = 0; e < 8; ++e) {
        float2 cv = X[t8 + e];
        o0[e] = fa[e] * (cv.x + zz0[i * 8 + e] * bias1);
        o1[e] = fb[e] * (cv.y + zz1[i * 8 + e] * bias1);
      }
      uint4 w0, w1;
      w0.x = pack2(o0[0], o0[1]); w0.y = pack2(o0[2], o0[3]); w0.z = pack2(o0[4], o0[5]); w0.w = pack2(o0[6], o0[7]);
      w1.x = pack2(o1[0], o1[1]); w1.y = pack2(o1[2], o1[3]); w1.z = pack2(o1[4], o1[5]); w1.w = pack2(o1[6], o1[7]);
      *reinterpret_cast<uint4*>(zzcm + r0 + t8) = w0;
      *reinterpret_cast<uint4*>(zzcm + r1 + t8) = w1;
    }
    __syncthreads();
  }
}

__device__ __forceinline__ void phase_transpose_back(const u16* src, u16* dst, char* lds) {
  u16* tile = (u16*)lds;
  int tid = otid();
  for (int item = blockIdx.x; item < 8 * 16 * 64; item += gridDim.x) {
    int b = item >> 10, dt_ = (item >> 6) & 15, tt = item & 63;
#pragma unroll
    for (int i = 0; i < 2; ++i) {
      int q = tid + i * 256, dd = q >> 3, tg = (q & 7) * 8;
      uint4 v = *reinterpret_cast<const uint4*>(src + ((size_t)(b * 1024 + dt_ * 64 + dd)) * 4096 + tt * 64 + tg);
      tile[(tg + 0) * 72 + dd] = (u16)(v.x & 0xffff); tile[(tg + 1) * 72 + dd] = (u16)(v.x >> 16);
      tile[(tg + 2) * 72 + dd] = (u16)(v.y & 0xffff); tile[(tg + 3) * 72 + dd] = (u16)(v.y >> 16);
      tile[(tg + 4) * 72 + dd] = (u16)(v.z & 0xffff); tile[(tg + 5) * 72 + dd] = (u16)(v.z >> 16);
      tile[(tg + 6) * 72 + dd] = (u16)(v.w & 0xffff); tile[(tg + 7) * 72 + dd] = (u16)(v.w >> 16);
    }
    __syncthreads();
#pragma unroll
    for (int i = 0; i < 2; ++i) {
      int q = tid + i * 256, tl = q >> 3, dg = (q & 7) * 8;
      uint4 v = *reinterpret_cast<const uint4*>(tile + tl * 72 + dg);
      *reinterpret_cast<uint4*>(dst + ((size_t)(b * 4096 + tt * 64 + tl)) * 1024 + dt_ * 64 + dg) = v;
    }
    __syncthreads();
  }
}

DEV void probe_rows(const unsigned* buf, int wpr, float* out) {
  const int tid_ = otid();
  int lane = tid_ & 63;
  int wave = blockIdx.x * 4 + (tid_ >> 6), nw = gridDim.x * 4;
  for (int row = wave; row < NT; row += nw) {
    unsigned h = 0;
    for (int w = lane; w < wpr; w += 64) { unsigned v = buf[(size_t)row * wpr + w]; h += (v ^ (v >> 15)) * (2654435761u + 2u * (unsigned)w); }
#pragma unroll
    for (int o = 32; o > 0; o >>= 1) h += (unsigned)__shfl_xor((int)h, o);
    float v = (float)((h >> 8) & 0xFFFFu) * (1.f / 65536.f);
    float4 vv = make_float4(v, v, v, v);
#pragma unroll
    for (int i = 0; i < 4; ++i) *reinterpret_cast<float4*>(out + (size_t)row * 1024 + i * 256 + lane * 4) = vv;
  }
}
#define PROBE_AT(id, bufexpr, wpr) if (PROBE == id) { Params pq = fetch_params(); probe_rows((const unsigned*)(bufexpr), wpr, pq.out); return; }

__device__ __forceinline__ uint4* xb_words_ptr() { __shared__ uint4 xb_words; return &xb_words; }
#define XB_TMO      128
#define XB_XCNT(j)  (256  + 64 * (j))
#define XB_XSUB(j)  (1280 + 64 * (j))
#define XB_XGEN(j)  (2304 + 64 * (j))
#define XB_TOP      3328
#define XB_TOPGEN   3392
#define XCD_BAR_WORDS 3456
#define XB_SPIN_CAP (1u << 18)
#define LAS __attribute__((address_space(3)))

__device__ __forceinline__ unsigned xb_ld(unsigned* p)              { return __hip_atomic_load(p, __ATOMIC_RELAXED, __HIP_MEMORY_SCOPE_AGENT); }
__device__ __forceinline__ unsigned xb_add(unsigned* p, unsigned v) { return __hip_atomic_fetch_add(p, v, __ATOMIC_RELAXED, __HIP_MEMORY_SCOPE_AGENT); }
__device__ __forceinline__ unsigned xb_xcc_id() { return (unsigned)__builtin_amdgcn_s_getreg((3 << 11) | 20) & 0xFu; }
#define XB_SPIN(cond, bar) do { unsigned _sp = 0; while (cond) { __builtin_amdgcn_s_sleep(1); \
    if ((++_sp & 255u) == 0u) { if (xb_ld(&(bar)[XB_TMO])) break; if (_sp > XB_SPIN_CAP) { atomicAdd(&(bar)[XB_TMO], 1u); break; } } } } while (0)

struct XcdBarrier {
    unsigned* bar; unsigned x;
    volatile LAS unsigned* st;
};

__device__ __forceinline__ XcdBarrier xcd_barrier_post(unsigned* bar, volatile LAS unsigned* st) {
    XcdBarrier b; b.bar = bar; b.x = xb_xcc_id(); b.st = st;
    if (threadIdx.x == 0) (void)xb_add(&bar[XB_XCNT(b.x)], 1u);
    return b;
}
__device__ __forceinline__ void xcd_barrier_complete(unsigned* bar, unsigned x, unsigned& nloc, unsigned& nx) {
    const unsigned G = gridDim.x * gridDim.y * gridDim.z;
    unsigned sum, cnt, mine, sp = 0u;
    for (;;) {
        sum = 0u; cnt = 0u; mine = 0u;
#pragma unroll
        for (unsigned j = 0; j < 16; ++j) { const unsigned c = xb_ld(&bar[XB_XCNT(j)]); sum += c; cnt += (c > 0u) ? 1u : 0u; mine = (j == x) ? c : mine; }
        if (sum == G) break;
        __builtin_amdgcn_s_sleep(1);
        if ((++sp & 255u) == 0u) { if (xb_ld(&bar[XB_TMO])) break; if (sp > XB_SPIN_CAP) { atomicAdd(&bar[XB_TMO], 1u); break; } }
    }
    nloc = mine > 0u ? mine : 1u; nx = cnt > 0u ? cnt : 1u;
}

__device__ __forceinline__ void xcd_barrier(const XcdBarrier& b) {
    asm volatile("s_waitcnt vmcnt(0)" ::: "memory");
    __syncthreads();
    if (threadIdx.x == 0) {
        unsigned* bar = b.bar;
        __builtin_amdgcn_s_waitcnt(0);
        unsigned nloc = b.st[0], nx = b.st[1];
        if (nloc == 0u) { xcd_barrier_complete(bar, b.x, nloc, nx); b.st[0] = nloc; b.st[1] = nx; }
        const unsigned old = xb_add(&bar[XB_XSUB(b.x)], 1u);
        const unsigned gen = old / nloc;
        if (old + 1u == (gen + 1u) * nloc) {
            __builtin_amdgcn_fence(__ATOMIC_RELEASE, "agent");
            asm volatile("s_waitcnt vmcnt(0)" ::: "memory");
            const unsigned og = xb_add(&bar[XB_TOP], 1u);
            const unsigned tg = og / nx;
            if (og + 1u == (tg + 1u) * nx) xb_add(&bar[XB_TOPGEN], 1u);
            else XB_SPIN(xb_ld(&bar[XB_TOPGEN]) == tg, bar);
            __builtin_amdgcn_fence(__ATOMIC_ACQUIRE, "agent");
            xb_add(&bar[XB_XGEN(b.x)], 1u);
            asm volatile("s_waitcnt vmcnt(0)" ::: "memory");
        } else {
            XB_SPIN(xb_ld(&bar[XB_XGEN(b.x)]) == gen, bar);
            __builtin_amdgcn_fence(__ATOMIC_ACQUIRE, "agent");
            asm volatile("s_waitcnt vmcnt(0)" ::: "memory");
        }
    }
    __syncthreads();
}


DEV void gsync2(unsigned k) {
  (void)k;
  XcdBarrier b;
  b.bar = (unsigned*)((char*)karg<33>() + OFF_BAR);
  b.x = xb_xcc_id();
  b.st = (volatile LAS unsigned*)xb_words_ptr();
  xcd_barrier(b);
}

DEV void gsync(cg::grid_group& grid) {
  asm volatile("s_waitcnt vmcnt(0)" ::: "memory");
  grid.sync();
  if (threadIdx.x == 0) {
    __builtin_amdgcn_fence(__ATOMIC_ACQUIRE, "agent");
    asm volatile("s_waitcnt vmcnt(0)" ::: "memory");
  }
  __syncthreads();
}

template <int layer>
__device__ __forceinline__ void peer_block(unsigned& nbar, char* lds) {
  {
    Params p = fetch_params();
    char* ws = p.ws; char* R1 = ws + OFF_R1; char* R2 = ws + OFF_R2; char* DO = (char*)p.out;
    const float* modl = (float*)(ws + OFF_MOD) + (size_t)layer * 9 * 6144;
    const u16* A = layer == 0 ? (const u16*)R1 : (const u16*)DO;
    const int K = layer == 0 ? 2048 : 1024;
    const u16* Wt = (const u16*)(ws + (layer == 0 ? OFF_W_OUT : OFF_W_HOUT));
    const float* res = layer == 0 ? p.x : (const float*)R2;
    phase_gemm_resid(A, K, Wt, res, (float*)R2, modl + 2048, lds);
  }
  gsync2(++nbar);
  PROBE_AT(5 + layer * 10, pq.ws + OFF_R2, 1024)
  {
    Params p = fetch_params();
    char* ws = p.ws; char* R1 = ws + OFF_R1; char* R2 = ws + OFF_R2; char* DO = (char*)p.out;
    const float* modl = (float*)(ws + OFF_MOD) + (size_t)layer * 9 * 6144;
    u16* tpeer = layer == 0 ? (u16*)DO : (u16*)(R1 + 128 * MiB);
    phase_ln_mod((float*)R2, p.ln_g + layer * 2048, p.ln_b + layer * 2048, modl, tpeer);
    if (DUP & 128) { gsync2(++nbar); phase_ln_mod((float*)R2, p.ln_g + layer * 2048, p.ln_b + layer * 2048, modl, tpeer); }
    if (layer == 1) {
      unsigned char* tb = (unsigned char*)R1;
      convert_fp8_rows(p.p_u + (size_t)16384 * 1024, tb, (float*)(tb + 32 * MiB), 16384);
      convert_fp8_rows(p.p_v + (size_t)16384 * 1024, tb + 16 * MiB, (float*)(tb + 32 * MiB + 65536), 16384);
    }
  }
  gsync2(++nbar);
  {
    Params p = fetch_params();
    char* ws = p.ws; char* R1 = ws + OFF_R1; char* DO = (char*)p.out;
    u16* tpeer = layer == 0 ? (u16*)DO : (u16*)(R1 + 128 * MiB);
    phase_gemm_bf16(tpeer, (const u16*)(ws + OFF_W_Q) + (size_t)layer * 2048 * 1024, layer == 0 ? (u16*)R1 : (u16*)DO, 2048, lds);
  }
  gsync2(++nbar);
  PROBE_AT(7 + layer * 10, pq.ws + OFF_R1, 1024)
  {
    Params p = fetch_params();
    char* ws = p.ws; char* R1 = ws + OFF_R1; char* R2 = ws + OFF_R2;
    int* idxb = (int*)(R2 + 128 * MiB);
    float* gateb = (float*)(R2 + 144 * MiB);
    const u16* kbf = (const u16*)(ws + OFF_KEYS);
    phase_peer_topk(layer == 0 ? (const u16*)R1 : (const u16*)p.out, kbf + (size_t)layer * 131072, kbf + 262144 + (size_t)layer * 131072, idxb, gateb, lds);
    if (DUP & 4) { __syncthreads(); phase_peer_topk(layer == 0 ? (const u16*)R1 : (const u16*)p.out, kbf + (size_t)layer * 131072, kbf + 262144 + (size_t)layer * 131072, idxb, gateb, lds); }
  }
  gsync2(++nbar);
  {
    Params p = fetch_params();
    char* ws = p.ws; char* R1 = ws + OFF_R1; char* R2 = ws + OFF_R2; char* DO = (char*)p.out;
    float* mod = (float*)(ws + OFF_MOD);
    const float* modl = mod + (size_t)layer * 9 * 6144;
    int* idxb = (int*)(R2 + 128 * MiB);
    float* gateb = (float*)(R2 + 144 * MiB);
    u16* tpeer = layer == 0 ? (u16*)DO : (u16*)(R1 + 128 * MiB);
    const unsigned char* tb8 = (const unsigned char*)(layer == 0 ? R1 + 128 * MiB : R1);
    phase_peer_gather(tpeer, idxb, gateb, tb8, tb8 + 16 * MiB, (const float*)(tb8 + 32 * MiB), (const float*)(tb8 + 32 * MiB + 65536), (const float*)R2,
                      modl + 5120, p.ln_g + layer * 2048 + 1024, p.ln_b + layer * 2048 + 1024, layer == 0 ? (float*)R2 : p.out,
                      layer == 0 ? mod + 9 * 6144 : nullptr, (u16*)(DO + 64 * MiB));
  }
}

__global__ void __launch_bounds__(256, 2) fwd_megakernel(Params p_unused) {
  __shared__ __attribute__((aligned(16))) char lds[LDS_BYTES];
  cg::grid_group grid = cg::this_grid();
  unsigned nbar = 0;
  if (threadIdx.x == 0) *xb_words_ptr() = make_uint4(0u, 0u, 0u, 0u);
  __syncthreads();
  (void)xcd_barrier_post((unsigned*)((char*)karg<33>() + OFF_BAR), (volatile LAS unsigned*)xb_words_ptr());
  { Params p = fetch_params(); phase_prologue(p, lds); }
  if (DUP & 64) { __syncthreads(); Params p = fetch_params(); phase_prologue(p, lds); }
  gsync(grid);
  if (DUP & 4096) {
#pragma unroll 1
    for (int r = 0; r < 20; ++r) gsync2(++nbar);
  }
  {
    Params p = fetch_params();
    float* mod = (float*)(p.ws + OFF_MOD);
    modulate_rows(p.x, (u16*)(p.ws + OFF_R2), NT, SEQ, mod, 0, 1024, false);
    modulate_rows(p.ctx, (u16*)(p.ws + OFF_HC), NTC, CTXL, mod, 0, 1024, true);
  }
  gsync2(++nbar);
  { Params p = fetch_params(); phase_gemm_inproj(p, lds); }
  if (DUP & 2) { gsync2(++nbar); Params p = fetch_params(); phase_gemm_inproj(p, lds); }
  gsync2(++nbar);
  PROBE_AT(1, pq.ws + OFF_R1, 1536)
  { Params p = fetch_params(); phase_conv(p); }
  if (DUP & 16) { gsync2(++nbar); Params p = fetch_params(); phase_conv(p); }
  gsync2(++nbar);
  PROBE_AT(2, pq.ws + OFF_R2, 1536)
  { Params p = fetch_params(); phase_ssd(p, lds); }
  if (DUP & 1) { gsync2(++nbar); Params p = fetch_params(); phase_ssd(p, lds); }
  gsync2(++nbar);
  PROBE_AT(3, pq.ws + OFF_R1, 1024)
  {
    Params p = fetch_params(); phase_gated_norm(p);
    unsigned char* tb = (unsigned char*)(p.ws + OFF_R1 + 128 * MiB);
    convert_fp8_rows(p.p_u, tb, (float*)(tb + 32 * MiB), 16384);
    convert_fp8_rows(p.p_v, tb + 16 * MiB, (float*)(tb + 32 * MiB + 65536), 16384);
    if (DUP & 2048) {
      convert_fp8_rows(p.p_u, tb, (float*)(tb + 32 * MiB), 16384);
      convert_fp8_rows(p.p_v, tb + 16 * MiB, (float*)(tb + 32 * MiB + 65536), 16384);
    }
  }
  gsync2(++nbar);
  PROBE_AT(4, pq.ws + OFF_R1, 1024)
  peer_block<0>(nbar, lds);
  if ((PROBE >= 5 && PROBE <= 7) || PROBE == 99) return;
  gsync2(++nbar);
  {
    Params p = fetch_params();
    phase_gemm_bf16((const u16*)((char*)p.out + 64 * MiB), (const u16*)(p.ws + OFF_W_HIN), (u16*)(p.ws + OFF_R1), 3072, lds);
  }
  gsync2(++nbar);
  PROBE_AT(8, pq.ws + OFF_R2, 1024)
  PROBE_AT(11, pq.ws + OFF_R1, 1536)
  {
    Params p = fetch_params();
    phase_shortconv_T(p, (const u16*)(p.ws + OFF_R1), (u16*)(p.ws + OFF_R2 + 128 * MiB), (u16*)p.out, (u16*)((char*)p.out + 64 * MiB), lds);
    if (DUP & 256) { __syncthreads(); phase_shortconv_T(p, (const u16*)(p.ws + OFF_R1), (u16*)(p.ws + OFF_R2 + 128 * MiB), (u16*)p.out, (u16*)((char*)p.out + 64 * MiB), lds); }
  }
  gsync2(++nbar);
  PROBE_AT(12, pq.ws + OFF_R2 + 128 * MiB, 512)
  { Params p = fetch_params(); phase_filter_fft(p, (float2*)(p.ws + OFF_R1), lds); }
  if (DUP & 32) { gsync2(++nbar); Params p = fetch_params(); phase_filter_fft(p, (float2*)(p.ws + OFF_R1), lds); }
  gsync2(++nbar);
  PROBE_AT(13, pq.ws + OFF_R1, 1024)
  {
    Params p = fetch_params();
    phase_hyena_conv(p, (const u16*)(p.ws + OFF_R2 + 128 * MiB), (const u16*)p.out, (const u16*)((char*)p.out + 64 * MiB),
                     (const float2*)(p.ws + OFF_R1), (u16*)(p.ws + OFF_R1 + 128 * MiB), lds);
  }
  if (DUP & 8) {
    gsync2(++nbar);
    Params p = fetch_params();
    phase_hyena_conv(p, (const u16*)(p.ws + OFF_R2 + 128 * MiB), (const u16*)p.out, (const u16*)((char*)p.out + 64 * MiB),
                     (const float2*)(p.ws + OFF_R1), (u16*)(p.ws + OFF_R1 + 128 * MiB), lds);
  }
  gsync2(++nbar);
  PROBE_AT(14, pq.ws + OFF_R1 + 128 * MiB, 512)
  { Params p = fetch_params(); phase_transpose_back((const u16*)(p.ws + OFF_R1 + 128 * MiB), (u16*)p.out, lds); }
  gsync2(++nbar);
  peer_block<1>(nbar, lds);
}

extern "C" void kernel_launch(void* const* d_in, const int* in_sizes, int n_in, void* d_out, int out_size, void* d_ws, size_t ws_size,
                              hipStream_t stream) {
  static int grid_blocks = 0;
  if (!grid_blocks) {
    int dev = 0, cus = 0, per_cu = 0;
    hipGetDevice(&dev);
    hipDeviceGetAttribute(&cus, hipDeviceAttributeMultiprocessorCount, dev);
    hipOccupancyMaxActiveBlocksPerMultiprocessor(&per_cu, fwd_megakernel, 256, 0);
    if (per_cu > 2) per_cu = 2;
    if (per_cu < 1) per_cu = 1;
    grid_blocks = cus * per_cu;
  }
  Params p{};
  const float** pp = reinterpret_cast<const float**>(&p);
  for (int i = 0; i < 32; ++i) pp[i] = (const float*)d_in[i];
  p.out = (float*)d_out;
  p.ws = (char*)d_ws;
  if (ws_size < WS_TOTAL) fprintf(stderr, "workspace too small: %zu < %zu\n", ws_size, (size_t)WS_TOTAL);
  (void)hipMemsetAsync((char*)d_ws + OFF_BAR, 0, 16384, stream);
  void* args[] = {&p};
  hipError_t e = hipLaunchCooperativeKernel((void*)fwd_megakernel, dim3(grid_blocks), dim3(256), args, 0, stream);
  if (e != hipSuccess) fprintf(stderr, "cooperative launch failed: %s (grid %d)\n", hipGetErrorString(e), grid_blocks);
}
```

```cpp
#define PROBE 0
#define DUP 0
#include <hip/hip_runtime.h>
#include <hip/hip_bf16.h>
#include <hip/hip_cooperative_groups.h>
#include <cstdio>
namespace cg = cooperative_groups;

typedef unsigned short u16;
using bf16x8 = __attribute__((ext_vector_type(8))) short;
using f32x4 = __attribute__((ext_vector_type(4))) float;
using u32x4 = __attribute__((ext_vector_type(4))) unsigned;
typedef float f32x2 __attribute__((ext_vector_type(2)));

#define DEV __device__ __forceinline__

constexpr int NB = 8, SEQ = 4096, DM = 1024, NT = NB * SEQ;
constexpr int CTXL = 256, NTC = NB * CTXL;
constexpr int SSM_IN = 5184, CONVD = 3072, SSM_INNER = 2048;
constexpr float ALPHA = 1.41421356237f;
constexpr int LDS_BYTES = 71168;

constexpr size_t MiB = 1ull << 20;
constexpr size_t OFF_W_IN = 0;
constexpr size_t OFF_W_OUT = OFF_W_IN + (size_t)5184 * 1024 * 2;
constexpr size_t OFF_W_HIN = OFF_W_OUT + (size_t)1024 * 2048 * 2;
constexpr size_t OFF_W_HOUT = OFF_W_HIN + (size_t)3072 * 1024 * 2;
constexpr size_t OFF_W_Q = OFF_W_HOUT + (size_t)1024 * 1024 * 2;
constexpr size_t OFF_MOD = OFF_W_Q + (size_t)2 * 2048 * 1024 * 2;
constexpr size_t OFF_HID = OFF_MOD + 512 * 1024;
constexpr size_t OFF_DT = OFF_HID + MiB;
constexpr size_t OFF_HC = OFF_DT + 8 * MiB;
constexpr size_t OFF_XBC_C = OFF_HC + 4 * MiB;
constexpr size_t OFF_XC_C = OFF_XBC_C + 12 * MiB;
constexpr size_t OFF_DT_C = OFF_XC_C + 12 * MiB;
constexpr size_t OFF_R1 = OFF_DT_C + MiB;
constexpr size_t OFF_R2 = OFF_R1 + 192 * MiB;
constexpr size_t OFF_BAR = OFF_R2 + 192 * MiB;
constexpr size_t OFF_KEYS = OFF_BAR + 16384;
constexpr size_t OFF_TW = OFF_KEYS + MiB;
constexpr size_t OFF_TAB0 = OFF_TW + 32768;
constexpr size_t WS_TOTAL = OFF_TAB0 + 33 * MiB;

struct Params {
  const float *x, *c, *ctx, *c_ctx, *ada_w, *ada_b, *ln_g, *ln_b;
  const float *m_w_in, *m_conv_w, *m_conv_b, *m_a_log, *m_dt_bias, *m_d, *m_norm_w, *m_w_out;
  const float *h_w_in, *h_conv_w, *h_conv_b, *h_f_w1, *h_f_b1, *h_f_w2, *h_f_b2, *h_f_w3, *h_freq, *h_bias, *h_w_out;
  const float *p_wq, *p_k1, *p_k2, *p_u, *p_v;
  float* out;
  char* ws;
};

DEV u16 f2bf(float f) {
  unsigned u = __float_as_uint(f);
  u += 0x7fffu + ((u >> 16) & 1u);
  return (u16)(u >> 16);
}
DEV float bf2f(u16 h) { return __uint_as_float(((unsigned)h) << 16); }
DEV float bflo(unsigned w) { return __uint_as_float(w << 16); }
DEV float bfhi(unsigned w) { return __uint_as_float(w & 0xffff0000u); }
DEV unsigned pack2(float a, float b) { return (unsigned)f2bf(a) | ((unsigned)f2bf(b) << 16); }
DEV float wave_sum(float v) {
#pragma unroll
  for (int o = 32; o > 0; o >>= 1) v += __shfl_xor(v, o);
  return v;
}
DEV int otid() { int t = threadIdx.x; asm volatile("" : "+v"(t)); return t; }
DEV unsigned ordkey(float f) { unsigned u = __float_as_uint(f); return (u & 0x80000000u) ? ~u : (u | 0x80000000u); }
DEV float siluf(float v) { return v / (1.f + __expf(-v)); }
DEV f32x4 mfma16(bf16x8 a, bf16x8 b, f32x4 c) { return __builtin_amdgcn_mfma_f32_16x16x32_bf16(a, b, c, 0, 0, 0); }
DEV bf16x8 ld8(const u16* p) { return *reinterpret_cast<const bf16x8*>(p); }

template <int I>
DEV const float* karg() {
  unsigned long long v;
  asm volatile("s_load_dwordx2 %0, %1, %2\n\ts_waitcnt lgkmcnt(0)" : "=s"(v) : "s"(__builtin_amdgcn_kernarg_segment_ptr()), "n"(I * 8));
  return (const float*)(const __attribute__((address_space(1))) float*)v;
}
DEV Params fetch_params() {
  Params q;
  q.x = karg<0>(); q.c = karg<1>(); q.ctx = karg<2>(); q.c_ctx = karg<3>(); q.ada_w = karg<4>(); q.ada_b = karg<5>(); q.ln_g = karg<6>(); q.ln_b = karg<7>();
  q.m_w_in = karg<8>(); q.m_conv_w = karg<9>(); q.m_conv_b = karg<10>(); q.m_a_log = karg<11>(); q.m_dt_bias = karg<12>(); q.m_d = karg<13>();
  q.m_norm_w = karg<14>(); q.m_w_out = karg<15>();
  q.h_w_in = karg<16>(); q.h_conv_w = karg<17>(); q.h_conv_b = karg<18>(); q.h_f_w1 = karg<19>(); q.h_f_b1 = karg<20>(); q.h_f_w2 = karg<21>();
  q.h_f_b2 = karg<22>(); q.h_f_w3 = karg<23>(); q.h_freq = karg<24>(); q.h_bias = karg<25>(); q.h_w_out = karg<26>();
  q.p_wq = karg<27>(); q.p_k1 = karg<28>(); q.p_k2 = karg<29>(); q.p_u = karg<30>(); q.p_v = karg<31>();
  q.out = (float*)karg<32>(); q.ws = (char*)karg<33>();
  return q;
}

__device__ __forceinline__ void transpose_w_tile(const float* src, int srcld, int K, int N, u16* dst, int item, char* lds) {
  float* tile = (float*)lds;
  int ntn = N / 64;
  int kt = item / ntn, nt = item % ntn;
  int tid = otid();
#pragma unroll
  for (int i = 0; i < 4; ++i) {
    int r = (tid >> 4) + i * 16, c4 = (tid & 15) * 4;
    float4 v = *reinterpret_cast<const float4*>(src + (size_t)(kt * 64 + r) * srcld + nt * 64 + c4);
    tile[r * 65 + c4 + 0] = v.x; tile[r * 65 + c4 + 1] = v.y; tile[r * 65 + c4 + 2] = v.z; tile[r * 65 + c4 + 3] = v.w;
  }
  __syncthreads();
#pragma unroll
  for (int i = 0; i < 2; ++i) {
    int n = (tid >> 3) + i * 32, k8 = (tid & 7) * 8;
    uint4 o;
    o.x = pack2(tile[(k8 + 0) * 65 + n], tile[(k8 + 1) * 65 + n]);
    o.y = pack2(tile[(k8 + 2) * 65 + n], tile[(k8 + 3) * 65 + n]);
    o.z = pack2(tile[(k8 + 4) * 65 + n], tile[(k8 + 5) * 65 + n]);
    o.w = pack2(tile[(k8 + 6) * 65 + n], tile[(k8 + 7) * 65 + n]);
    *reinterpret_cast<uint4*>(dst + (size_t)(nt * 64 + n) * K + kt * 64 + k8) = o;
  }
  __syncthreads();
}

__device__ __forceinline__ void ada_item(const Params& p, int item, char* lds) {
  float* sl = (float*)lds;
  float* red = sl + 9 * 1024;
  int layer = item / 96, cg_ = item % 96;
  int tid = otid(), kq = tid >> 6, col = cg_ * 64 + (tid & 63);
  for (int e = tid; e < 9 * 1024; e += 256) {
    int r = e >> 10, k = e & 1023;
    sl[e] = siluf(r < 8 ? p.c[r * 1024 + k] : p.c_ctx[k]);
  }
  __syncthreads();
  float acc[9];
#pragma unroll
  for (int r = 0; r < 9; ++r) acc[r] = 0.f;
  const float* w = p.ada_w + (size_t)layer * 1024 * 6144 + col;
#pragma unroll 8
  for (int k = kq * 256; k < kq * 256 + 256; ++k) {
    float wv = w[(size_t)k * 6144];
#pragma unroll
    for (int r = 0; r < 9; ++r) acc[r] += sl[r * 1024 + k] * wv;
  }
#pragma unroll
  for (int r = 0; r < 9; ++r) red[(kq * 9 + r) * 64 + (tid & 63)] = acc[r];
  __syncthreads();
  if (tid < 64) {
    float* mod = (float*)(p.ws + OFF_MOD);
    float bias = p.ada_b[layer * 6144 + col];
#pragma unroll
    for (int r = 0; r < 9; ++r) {
      float s = red[(0 * 9 + r) * 64 + tid] + red[(1 * 9 + r) * 64 + tid] + red[(2 * 9 + r) * 64 + tid] + red[(3 * 9 + r) * 64 + tid];
      mod[((size_t)layer * 9 + r) * 6144 + col] = s + bias;
    }
  }
  __syncthreads();
}

__device__ __forceinline__ void hyena_mlp_item(const Params& p, int item, char* lds) {
  float* zb = (float*)lds;
  float* h1 = zb + 256;
  float* h2 = h1 + 256;
  int tid = otid(), ti = tid >> 6, j = tid & 63;
  int t = item * 4 + ti;
  const float L = 4096.f;
  if (j < 33) {
    float v;
    if (j == 0) v = (float)t / 4095.f;
    else {
      int k = (j - 1) & 15;
      float fb = 1e-4f + (float)k * ((15.f - 1e-4f) / 15.f);
      float ang = 6.283185307179586f * (float)t / L;
      float a = fb * ang;
      v = (j <= 16) ? cosf(a) : -sinf(a);
    }
    zb[ti * 64 + j] = v;
  }
  __syncthreads();
  float fr = p.h_freq[j];
  float s = p.h_f_b1[j];
#pragma unroll 3
  for (int i = 0; i < 33; ++i) s += zb[ti * 64 + i] * p.h_f_w1[i * 64 + j];
  h1[ti * 64 + j] = sinf(fr * s);
  __syncthreads();
  s = p.h_f_b2[j];
#pragma unroll 8
  for (int i = 0; i < 64; ++i) s += h1[ti * 64 + i] * p.h_f_w2[i * 64 + j];
  h2[ti * 64 + j] = sinf(fr * s);
  __syncthreads();
  s = p.h_f_b2[64 + j];
#pragma unroll 8
  for (int i = 0; i < 64; ++i) s += h2[ti * 64 + i] * p.h_f_w2[4096 + i * 64 + j];
  float* hid = (float*)(p.ws + OFF_HID);
  hid[t * 64 + j] = sinf(fr * s);
  __syncthreads();
}

__device__ __forceinline__ void phase_prologue(const Params& p, char* lds) {
  constexpr int T0 = 1296, T1 = T0 + 512, T2 = T1 + 768, T3 = T2 + 256, T4 = T3 + 512, T5 = T4 + 512, T6 = T5 + 192, T7 = T6 + 1024, T8 = T7 + 256, T9 = T8 + 16;
  for (int item = blockIdx.x; item < T9; item += gridDim.x) {
    if (item < T0) transpose_w_tile(p.m_w_in, SSM_IN, 1024, SSM_IN, (u16*)(p.ws + OFF_W_IN), item, lds);
    else if (item < T1) transpose_w_tile(p.m_w_out, 1024, 2048, 1024, (u16*)(p.ws + OFF_W_OUT), item - T0, lds);
    else if (item < T2) transpose_w_tile(p.h_w_in, 3072, 1024, 3072, (u16*)(p.ws + OFF_W_HIN), item - T1, lds);
    else if (item < T3) transpose_w_tile(p.h_w_out, 1024, 1024, 1024, (u16*)(p.ws + OFF_W_HOUT), item - T2, lds);
    else if (item < T4) transpose_w_tile(p.p_wq, 2048, 1024, 2048, (u16*)(p.ws + OFF_W_Q), item - T3, lds);
    else if (item < T5) transpose_w_tile(p.p_wq + (size_t)1024 * 2048, 2048, 1024, 2048, (u16*)(p.ws + OFF_W_Q) + (size_t)2048 * 1024, item - T4, lds);
    else if (item < T6) ada_item(p, item - T5, lds);
    else if (item < T7) hyena_mlp_item(p, item - T6, lds);
    else if (item >= T8) {
      int k = (item - T8) * 256 + threadIdx.x;
      float sn, cs;
      sincospif((float)k * (1.f / 4096.f), &sn, &cs);
      ((float2*)(p.ws + OFF_TW))[k] = make_float2(cs, -sn);
    } else {
      int e8 = ((item - T7) * 256 + threadIdx.x) * 8;
      const float* src = e8 < 262144 ? p.p_k1 + e8 : p.p_k2 + (e8 - 262144);
      float4 a0 = *reinterpret_cast<const float4*>(src), a1 = *reinterpret_cast<const float4*>(src + 4);
      uint4 o;
      o.x = pack2(a0.x, a0.y); o.y = pack2(a0.z, a0.w); o.z = pack2(a1.x, a1.y); o.w = pack2(a1.z, a1.w);
      *reinterpret_cast<uint4*>((u16*)(p.ws + OFF_KEYS) + e8) = o;
    }
  }
}

__device__ __forceinline__ void modulate_rows(const float* src, u16* dst, int nrows, int rows_per_batch, const float* modbase, int sh_off, int sc_off, bool ctxrow) {
  size_t total = (size_t)nrows * 128;
  for (size_t e = (size_t)blockIdx.x * 256 + threadIdx.x; e < total; e += (size_t)gridDim.x * 256) {
    int row = (int)(e >> 7), c8 = (int)(e & 127) * 8;
    int b = ctxrow ? 8 : row / rows_per_batch;
    const float* m = modbase + (size_t)b * 6144;
    float4 a0 = *reinterpret_cast<const float4*>(src + (size_t)row * 1024 + c8);
    float4 a1 = *reinterpret_cast<const float4*>(src + (size_t)row * 1024 + c8 + 4);
    float4 s0 = *reinterpret_cast<const float4*>(m + sc_off + c8);
    float4 s1 = *reinterpret_cast<const float4*>(m + sc_off + c8 + 4);
    float4 h0 = *reinterpret_cast<const float4*>(m + sh_off + c8);
    float4 h1 = *reinterpret_cast<const float4*>(m + sh_off + c8 + 4);
    uint4 o;
    o.x = pack2(a0.x * (1.f + s0.x) + h0.x, a0.y * (1.f + s0.y) + h0.y);
    o.y = pack2(a0.z * (1.f + s0.z) + h0.z, a0.w * (1.f + s0.w) + h0.w);
    o.z = pack2(a1.x * (1.f + s1.x) + h1.x, a1.y * (1.f + s1.y) + h1.y);
    o.w = pack2(a1.z * (1.f + s1.z) + h1.z, a1.w * (1.f + s1.w) + h1.w);
    *reinterpret_cast<uint4*>(dst + (size_t)row * 1024 + c8) = o;
  }
}

constexpr int GLD = 72;
template <class Epi>
__device__ __forceinline__ void gemm_tile(const u16* __restrict__ A, int lda, const u16* __restrict__ Bt, int ldb, int brow, int bcol, int Nmax,
                                          int K, char* lds, Epi epi) {
  u16* SA = (u16*)lds;
  u16* SB = SA + 256 * GLD;
  int tid = otid(), wid = tid >> 6, lane = tid & 63, wr = wid >> 1, wc = wid & 1, fr = lane & 15, fq = lane >> 4;
  f32x4 acc[8][4];
#pragma unroll
  for (int m = 0; m < 8; ++m)
#pragma unroll
    for (int n = 0; n < 4; ++n) acc[m][n] = f32x4{0.f, 0.f, 0.f, 0.f};
  u32x4 ra[8], rb[4];
  const int lr = tid >> 3, lc = (tid & 7) * 8;
  const u16* abase = A + (size_t)brow * lda;
  const unsigned aoff = (unsigned)(lr * lda + lc);
  unsigned bo[4];
#pragma unroll
  for (int i = 0; i < 4; ++i) {
    int br = bcol + lr + i * 32;
    if (br >= Nmax) br = Nmax - 1;
    bo[i] = (unsigned)(br * ldb + lc);
  }
#define GLOADT(KT)                                                                                 \
  _Pragma("unroll") for (int i = 0; i < 8; ++i)                                                    \
    ra[i] = *reinterpret_cast<const u32x4*>(abase + (aoff + (unsigned)((i * 32) * lda + (KT) * 64))); \
  _Pragma("unroll") for (int i = 0; i < 4; ++i)                                                    \
    rb[i] = *reinterpret_cast<const u32x4*>(Bt + (bo[i] + (unsigned)((KT) * 64)));
  const int nk = K / 64;
  GLOADT(0)
  for (int kt = 0; kt < nk; ++kt) {
#pragma unroll
    for (int i = 0; i < 8; ++i) *reinterpret_cast<u32x4*>(SA + (lr + i * 32) * GLD + lc) = ra[i];
#pragma unroll
    for (int i = 0; i < 4; ++i) *reinterpret_cast<u32x4*>(SB + (lr + i * 32) * GLD + lc) = rb[i];
    __syncthreads();
    { const int kn = kt + 1 < nk ? kt + 1 : nk - 1; GLOADT(kn) }
#pragma unroll
    for (int kk = 0; kk < 2; ++kk) {
      bf16x8 Bl[4];
#pragma unroll
      for (int n = 0; n < 4; ++n) Bl[n] = ld8(SB + (wc * 64 + n * 16 + fr) * GLD + kk * 32 + fq * 8);
#pragma unroll
      for (int mh = 0; mh < 2; ++mh) {
        bf16x8 At[4];
#pragma unroll
        for (int m = 0; m < 4; ++m) At[m] = ld8(SA + (wr * 128 + (mh * 4 + m) * 16 + fr) * GLD + kk * 32 + fq * 8);
#pragma unroll
        for (int m = 0; m < 4; ++m)
#pragma unroll
          for (int n = 0; n < 4; ++n) acc[mh * 4 + m][n] = mfma16(Bl[n], At[m], acc[mh * 4 + m][n]);
      }
    }
    __syncthreads();
  }
#undef GLOADT
#pragma unroll
  for (int m = 0; m < 8; ++m)
#pragma unroll
    for (int n = 0; n < 4; ++n) epi(brow + wr * 128 + m * 16 + fr, bcol + wc * 64 + n * 16 + fq * 4, acc[m][n]);
}

DEV float softplusf(float v) { return fmaxf(v, 0.f) + log1pf(__expf(-fabsf(v))); }

__device__ __forceinline__ void phase_gemm_inproj(const Params& p, char* lds) {
  const u16* hx = (const u16*)(p.ws + OFF_R2);
  const u16* hc = (const u16*)(p.ws + OFF_HC);
  const u16* Wt = (const u16*)(p.ws + OFF_W_IN);
  u16* zbuf = (u16*)p.out;
  u16* xbc = (u16*)(p.ws + OFF_R1);
  float* dt = (float*)(p.ws + OFF_DT);
  u16* xbc_c = (u16*)(p.ws + OFF_XBC_C);
  float* dt_c = (float*)(p.ws + OFF_DT_C);
  const float* dtb = p.m_dt_bias;
  const int xcd = blockIdx.x & 7, li = blockIdx.x >> 3, nl = gridDim.x >> 3;
  auto epi_lat = [=](int m, int n, f32x4 v) {
    if (n < 2048) *reinterpret_cast<uint2*>(zbuf + (size_t)m * 2048 + n) = make_uint2(pack2(v[0], v[1]), pack2(v[2], v[3]));
    else if (n < 5120) *reinterpret_cast<uint2*>(xbc + (size_t)m * 3072 + (n - 2048)) = make_uint2(pack2(v[0], v[1]), pack2(v[2], v[3]));
    else if (n < 5184) {
      float4 bb = *reinterpret_cast<const float4*>(dtb + (n - 5120));
      *reinterpret_cast<float4*>(dt + (size_t)m * 64 + (n - 5120)) = make_float4(softplusf(v[0] + bb.x), softplusf(v[1] + bb.y), softplusf(v[2] + bb.z), softplusf(v[3] + bb.w));
    }
  };
  auto epi_ctx = [=](int m, int n, f32x4 v) {
    if (n < 3072) *reinterpret_cast<uint2*>(xbc_c + (size_t)m * 3072 + n) = make_uint2(pack2(v[0], v[1]), pack2(v[2], v[3]));
    else if (n < 3136) {
      float4 bb = *reinterpret_cast<const float4*>(dtb + (n - 3072));
      *reinterpret_cast<float4*>(dt_c + (size_t)m * 64 + (n - 3072)) = make_float4(softplusf(v[0] + bb.x), softplusf(v[1] + bb.y), softplusf(v[2] + bb.z), softplusf(v[3] + bb.w));
    }
  };
  for (int t = li; t < 128 * 5; t += nl) {
    int pm = t / 5, pn = xcd + 8 * (t % 5);
    gemm_tile(hx, 1024, Wt, 1024, pm * 256, pn * 128, SSM_IN, 1024, lds, epi_lat);
  }
  for (int t = blockIdx.x; t < 128 + 8 * 25; t += gridDim.x) {
    if (t < 128) gemm_tile(hx, 1024, Wt, 1024, t * 256, 40 * 128, SSM_IN, 1024, lds, epi_lat);
    else {
      int it = t - 128, pm = it / 25, pn = it % 25;
      gemm_tile(hc, 1024, Wt + (size_t)2048 * 1024, 1024, pm * 256, pn * 128, 3136, 1024, lds, epi_ctx);
    }
  }
}

DEV void fma8(float* acc, const u32x4& v, const float* w) {
  acc[0] += bflo(v[0]) * w[0]; acc[1] += bfhi(v[0]) * w[1]; acc[2] += bflo(v[1]) * w[2]; acc[3] += bfhi(v[1]) * w[3];
  acc[4] += bflo(v[2]) * w[4]; acc[5] += bfhi(v[2]) * w[5]; acc[6] += bflo(v[3]) * w[6]; acc[7] += bfhi(v[3]) * w[7];
}
__device__ __forceinline__ void phase_conv(const Params& p) {
  const u16* xbc = (const u16*)(p.ws + OFF_R1);
  u16* xc = (u16*)(p.ws + OFF_R2);
  const u16* xbc_c = (const u16*)(p.ws + OFF_XBC_C);
  u16* xc_c = (u16*)(p.ws + OFF_XC_C);
  const float* cw = p.m_conv_w;
  const float* cb = p.m_conv_b;
  const int tid_ = otid();
  const size_t nl = (size_t)8 * 64 * 8 * 384;
  for (size_t e = (size_t)blockIdx.x * 256 + tid_; e < nl; e += (size_t)gridDim.x * 256) {
    int ch = (int)(e % 384) * 8;
    int rest = (int)(e / 384);
    int cg_ = rest & 7, r = (rest >> 3) & 63, b = rest >> 9;
    float w[9][8];
#pragma unroll
    for (int k = 0; k < 9; ++k) {
      float4 w0 = *reinterpret_cast<const float4*>(cw + k * 3072 + ch), w1 = *reinterpret_cast<const float4*>(cw + k * 3072 + ch + 4);
      w[k][0] = w0.x; w[k][1] = w0.y; w[k][2] = w0.z; w[k][3] = w0.w; w[k][4] = w1.x; w[k][5] = w1.y; w[k][6] = w1.z; w[k][7] = w1.w;
    }
    float bias[8];
    {
      float4 b0 = *reinterpret_cast<const float4*>(cb + ch), b1 = *reinterpret_cast<const float4*>(cb + ch + 4);
      bias[0] = b0.x; bias[1] = b0.y; bias[2] = b0.z; bias[3] = b0.w; bias[4] = b1.x; bias[5] = b1.y; bias[6] = b1.z; bias[7] = b1.w;
    }
    const u32x4 zero4 = u32x4{0u, 0u, 0u, 0u};
    const int c0 = cg_ * 8;
    u32x4 win[3][3];
#pragma unroll
    for (int i = 0; i < 3; ++i) {
      int rr = r + i - 1;
      bool rok = rr >= 0 && rr <= 63;
      const u16* rowp = xbc + ((size_t)(b * 4096 + (rok ? rr : r) * 64)) * 3072 + ch;
      win[i][0] = (rok && c0 > 0) ? *reinterpret_cast<const u32x4*>(rowp + (size_t)(c0 - 1) * 3072) : zero4;
      win[i][1] = rok ? *reinterpret_cast<const u32x4*>(rowp + (size_t)c0 * 3072) : zero4;
    }
#pragma unroll
    for (int cc = 0; cc < 8; ++cc) {
      int c = c0 + cc;
#pragma unroll
      for (int i = 0; i < 3; ++i) {
        int rr = r + i - 1;
        bool rok = rr >= 0 && rr <= 63;
        const u16* rowp = xbc + ((size_t)(b * 4096 + (rok ? rr : r) * 64)) * 3072 + ch;
        win[i][2] = (rok && c < 63) ? *reinterpret_cast<const u32x4*>(rowp + (size_t)(c + 1) * 3072) : zero4;
      }
      float acc[8];
#pragma unroll
      for (int k = 0; k < 8; ++k) acc[k] = bias[k];
#pragma unroll
      for (int i = 0; i < 3; ++i)
#pragma unroll
        for (int j = 0; j < 3; ++j) fma8(acc, win[i][j], w[i * 3 + j]);
      uint4 o;
      o.x = pack2(siluf(acc[0]), siluf(acc[1]));
      o.y = pack2(siluf(acc[2]), siluf(acc[3]));
      o.z = pack2(siluf(acc[4]), siluf(acc[5]));
      o.w = pack2(siluf(acc[6]), siluf(acc[7]));
      *reinterpret_cast<uint4*>(xc + ((size_t)(b * 4096 + r * 64 + c)) * 3072 + ch) = o;
#pragma unroll
      for (int i = 0; i < 3; ++i) { win[i][0] = win[i][1]; win[i][1] = win[i][2]; }
    }
  }
  const size_t ncx = (size_t)NTC * 384;
  for (size_t e = (size_t)blockIdx.x * 256 + tid_; e < ncx; e += (size_t)gridDim.x * 256) {
    int tok = (int)(e / 384), ch = (int)(e % 384) * 8;
    float acc[8];
#pragma unroll
    for (int k = 0; k < 8; ++k) acc[k] = cb[ch + k];
    int b = tok >> 8, c = tok & 255;
#pragma unroll
    for (int j = 0; j < 3; ++j) {
      int cc = c + j - 1;
      if (cc < 0 || cc > 255) continue;
      uint4 v = *reinterpret_cast<const uint4*>(xbc_c + ((size_t)(b * 256 + cc)) * 3072 + ch);
      const float* w = cw + (3 + j) * 3072 + ch;
      float4 w0 = *reinterpret_cast<const float4*>(w), w1 = *reinterpret_cast<const float4*>(w + 4);
      acc[0] += bflo(v.x) * w0.x; acc[1] += bfhi(v.x) * w0.y; acc[2] += bflo(v.y) * w0.z; acc[3] += bfhi(v.y) * w0.w;
      acc[4] += bflo(v.z) * w1.x; acc[5] += bfhi(v.z) * w1.y; acc[6] += bflo(v.w) * w1.z; acc[7] += bfhi(v.w) * w1.w;
    }
    uint4 o;
    o.x = pack2(siluf(acc[0]), siluf(acc[1]));
    o.y = pack2(siluf(acc[2]), siluf(acc[3]));
    o.z = pack2(siluf(acc[4]), siluf(acc[5]));
    o.w = pack2(siluf(acc[6]), siluf(acc[7]));
    *reinterpret_cast<uint4*>(xc_c + (size_t)tok * 3072 + ch) = o;
  }
}

constexpr int SLD = 136;
__device__ __forceinline__ void phase_ssd(const Params& p, char* lds) {
  u16* xsT = (u16*)lds;
  u16* stb = xsT + 64 * SLD;
  u16* Mb = stb + 64 * SLD;
  float* cum = (float*)(Mb + 128 * SLD);
  float* dtv = cum + 128;
  float* asrc = dtv + 128;
  const u16* xc = (const u16*)(p.ws + OFF_R2);
  const u16* xc_c = (const u16*)(p.ws + OFF_XC_C);
  const float* dt = (const float*)(p.ws + OFF_DT);
  const float* dt_c = (const float*)(p.ws + OFF_DT_C);
  u16* y = (u16*)(p.ws + OFF_R1);
  int tid = otid(), w = tid >> 6, lane = tid & 63, fr = lane & 15, fq = lane >> 4;
  unsigned char* yb8 = (unsigned char*)(p.ws + OFF_R1 + 128 * MiB);
  for (int item = blockIdx.x; item < 512; item += gridDim.x) {
    int b = item >> 6, h = (item >> 1) & 31, g = h >> 3;
    float dsk = p.m_d[h];
    {
      const int dir = item & 1;
      float a_neg = -__expf(p.m_a_log[dir * 32 + h]);
      f32x4 acc_s[8];
#pragma unroll
      for (int n = 0; n < 8; ++n) acc_s[n] = f32x4{0.f, 0.f, 0.f, 0.f};
      for (int step = 0; step < 34; ++step) {
        bool isctx = step < 2;
        int cidx = isctx ? step : step - 2;
        if (dir) cidx = (isctx ? 1 : 31) - cidx;
        size_t tok0 = isctx ? (size_t)(b * 256 + cidx * 128) : (size_t)(b * 4096 + cidx * 128);
        const u16* src = (isctx ? xc_c : xc) + tok0 * 3072;
        const float* dts = (isctx ? dt_c : dt) + tok0 * 64;
        int tz = tid;
        asm volatile("" : "+v"(tz));
        float dval = 0.f;
        if (tid < 128) dval = dts[tid * 64 + dir * 32 + h];
        uint4 xv[4], bv[8];
#pragma unroll
        for (int i = 0; i < 4; ++i) {
          int idx = tz + i * 256, l = (idx & 31) | ((idx >> 8) << 5), pc = ((idx >> 5) & 7) * 8;
          xv[i] = *reinterpret_cast<const uint4*>(src + (size_t)l * 3072 + h * 64 + pc);
        }
#pragma unroll
        for (int i = 0; i < 8; ++i) {
          int idx = tz + i * 256, l = (idx & 31) | (((idx >> 9) & 3) << 5), nc = (((idx >> 5) & 7) | (((idx >> 8) & 1) << 3)) * 8;
          bv[i] = *reinterpret_cast<const uint4*>(src + (size_t)l * 3072 + 2048 + g * 128 + nc);
        }
        if (tid < 128) { dtv[tid] = dval; asrc[tid] = dval * a_neg; }
#pragma unroll
        for (int i = 0; i < 4; ++i) {
          int idx = tz + i * 256, l = (idx & 31) | ((idx >> 8) << 5), pc = ((idx >> 5) & 7) * 8;
          uint4 v = xv[i];
          xsT[(pc + 0) * SLD + l] = (u16)(v.x & 0xffff); xsT[(pc + 1) * SLD + l] = (u16)(v.x >> 16);
          xsT[(pc + 2) * SLD + l] = (u16)(v.y & 0xffff); xsT[(pc + 3) * SLD + l] = (u16)(v.y >> 16);
          xsT[(pc + 4) * SLD + l] = (u16)(v.z & 0xffff); xsT[(pc + 5) * SLD + l] = (u16)(v.z >> 16);
          xsT[(pc + 6) * SLD + l] = (u16)(v.w & 0xffff); xsT[(pc + 7) * SLD + l] = (u16)(v.w >> 16);
        }
        if (!isctx) {
#pragma unroll
          for (int i = 0; i < 8; ++i) {
            int idx = tz + i * 256, l = (idx & 31) | (((idx >> 9) & 3) << 5), nc = (((idx >> 5) & 7) | (((idx >> 8) & 1) << 3)) * 8;
            *reinterpret_cast<uint4*>(Mb + l * SLD + nc) = bv[i];
          }
        }
        __syncthreads();
        bf16x8 Cf[2][4];
        if (!isctx) {
#pragma unroll
          for (int mt = 0; mt < 2; ++mt)
#pragma unroll
            for (int kk = 0; kk < 4; ++kk) Cf[mt][kk] = ld8(src + (size_t)(w * 32 + mt * 16 + fr) * 3072 + 2560 + g * 128 + kk * 32 + fq * 8);
        }
        if (tid < 128) {
          float s = 0.f;
          if (!dir) { for (int j = 0; j <= tid; ++j) s += asrc[j]; }
          else { for (int j = tid; j < 128; ++j) s += asrc[j]; }
          cum[tid] = s;
        }
        __syncthreads();
        float total = dir ? cum[0] : cum[127];
        if (!isctx) {
          float cl[2][4];
#pragma unroll
          for (int mt = 0; mt < 2; ++mt)
#pragma unroll
            for (int j = 0; j < 4; ++j) cl[mt][j] = cum[w * 32 + mt * 16 + fq * 4 + j];
          f32x4 cb0[8], cb1[8];
#pragma unroll
          for (int nt = 0; nt < 8; ++nt) {
            cb0[nt] = f32x4{0.f, 0.f, 0.f, 0.f};
            cb1[nt] = f32x4{0.f, 0.f, 0.f, 0.f};
            bool need = dir ? (nt >= w * 2) : (nt <= w * 2 + 1);
            if (need) {
#pragma unroll
              for (int kk = 0; kk < 4; ++kk) {
                bf16x8 Bf = ld8(Mb + (nt * 16 + fr) * SLD + kk * 32 + fq * 8);
                cb0[nt] = mfma16(Cf[0][kk], Bf, cb0[nt]);
                cb1[nt] = mfma16(Cf[1][kk], Bf, cb1[nt]);
              }
            }
          }
          __syncthreads();
          int zero = 0;
          asm volatile("" : "+v"(zero));
#pragma unroll
          for (int nt = 0; nt < 8; ++nt) {
            int s = nt * 16 + fr + zero;
            float cs = cum[s], ds = dtv[s];
#pragma unroll
            for (int j = 0; j < 4; ++j) {
              int l0 = w * 32 + fq * 4 + j, l1 = l0 + 16;
              bool ok0 = dir ? (s >= l0) : (s <= l0);
              bool ok1 = dir ? (s >= l1) : (s <= l1);
              float v0 = ok0 ? cb0[nt][j] * __expf(cl[0][j] - cs) * ds : 0.f;
              float v1 = ok1 ? cb1[nt][j] * __expf(cl[1][j] - cs) * ds : 0.f;
              Mb[l0 * SLD + s] = f2bf(v0);
              Mb[l1 * SLD + s] = f2bf(v1);
            }
          }
          __syncthreads();
          f32x4 ya[2][4];
#pragma unroll
          for (int mt = 0; mt < 2; ++mt)
#pragma unroll
            for (int nt = 0; nt < 4; ++nt) ya[mt][nt] = f32x4{0.f, 0.f, 0.f, 0.f};
#pragma unroll
          for (int kk = 0; kk < 4; ++kk)
#pragma unroll
            for (int nt = 0; nt < 4; ++nt) {
              bf16x8 Sf = ld8(stb + (nt * 16 + fr) * SLD + kk * 32 + fq * 8);
              ya[0][nt] = mfma16(Cf[0][kk], Sf, ya[0][nt]);
              ya[1][nt] = mfma16(Cf[1][kk], Sf, ya[1][nt]);
            }
#pragma unroll
          for (int mt = 0; mt < 2; ++mt)
#pragma unroll
            for (int j = 0; j < 4; ++j) {
              float e = __expf(cl[mt][j]);
#pragma unroll
              for (int nt = 0; nt < 4; ++nt) ya[mt][nt][j] *= e;
            }
#pragma unroll
          for (int kk = 0; kk < 4; ++kk) {
            bf16x8 Mf0 = ld8(Mb + (w * 32 + fr) * SLD + kk * 32 + fq * 8);
            bf16x8 Mf1 = ld8(Mb + (w * 32 + 16 + fr) * SLD + kk * 32 + fq * 8);
#pragma unroll
            for (int nt = 0; nt < 4; ++nt) {
              bf16x8 Xf = ld8(xsT + (nt * 16 + fr) * SLD + kk * 32 + fq * 8);
              ya[0][nt] = mfma16(Mf0, Xf, ya[0][nt]);
              ya[1][nt] = mfma16(Mf1, Xf, ya[1][nt]);
            }
          }
#pragma unroll
          for (int i = 0; i < 8; ++i) {
            int idx = tz + i * 256, l = (idx & 31) | (((idx >> 9) & 3) << 5), nc = (((idx >> 5) & 7) | (((idx >> 8) & 1) << 3)) * 8;
            bv[i] = *reinterpret_cast<const uint4*>(src + (size_t)l * 3072 + 2048 + g * 128 + nc);
          }
#pragma unroll
          for (int mt = 0; mt < 2; ++mt)
#pragma unroll
            for (int nt = 0; nt < 4; ++nt)
#pragma unroll
              for (int j = 0; j < 4; ++j) {
                int l = w * 32 + mt * 16 + fq * 4 + j, pp = nt * 16 + fr;
                float val = ya[mt][nt][j];
                if (!dir) {
                  val += bf2f(xsT[pp * SLD + l]) * dsk;
                  y[(tok0 + l) * 2048 + h * 64 + pp] = f2bf(val);
                } else {
                  yb8[(tok0 + l) * 2048 + h * 64 + pp] = (unsigned char)(__builtin_amdgcn_cvt_pk_fp8_f32(fminf(fmaxf(val * 4.f, -440.f), 440.f), 0.f, 0, false) & 0xFF);
                }
              }
        }
        if (step == 33) continue;
        __syncthreads();
#pragma unroll
        for (int i = 0; i < 8; ++i) {
          int idx = tz + i * 256, l = (idx & 31) | (((idx >> 9) & 3) << 5), nc = (((idx >> 5) & 7) | (((idx >> 8) & 1) << 3)) * 8;
          uint4 v = bv[i];
          float sc = dtv[l] * __expf(total - cum[l]);
          Mb[(nc + 0) * SLD + l] = f2bf(bflo(v.x) * sc); Mb[(nc + 1) * SLD + l] = f2bf(bfhi(v.x) * sc);
          Mb[(nc + 2) * SLD + l] = f2bf(bflo(v.y) * sc); Mb[(nc + 3) * SLD + l] = f2bf(bfhi(v.y) * sc);
          Mb[(nc + 4) * SLD + l] = f2bf(bflo(v.z) * sc); Mb[(nc + 5) * SLD + l] = f2bf(bfhi(v.z) * sc);
          Mb[(nc + 6) * SLD + l] = f2bf(bflo(v.w) * sc); Mb[(nc + 7) * SLD + l] = f2bf(bfhi(v.w) * sc);
        }
        __syncthreads();
        float cd = __expf(total);
#pragma unroll
        for (int nt = 0; nt < 8; ++nt) acc_s[nt] *= cd;
#pragma unroll
        for (int kk = 0; kk < 4; ++kk) {
          bf16x8 Af = ld8(xsT + (w * 16 + fr) * SLD + kk * 32 + fq * 8);
#pragma unroll
          for (int nt = 0; nt < 8; ++nt) {
            bf16x8 Bf = ld8(Mb + (nt * 16 + fr) * SLD + kk * 32 + fq * 8);
            acc_s[nt] = mfma16(Af, Bf, acc_s[nt]);
          }
        }
#pragma unroll
        for (int nt = 0; nt < 8; ++nt)
#pragma unroll
          for (int j = 0; j < 4; ++j) stb[(w * 16 + fq * 4 + j) * SLD + nt * 16 + fr] = f2bf(acc_s[nt][j]);
        __syncthreads();
      }
      __syncthreads();
    }
  }
}

__device__ __forceinline__ void phase_gated_norm(const Params& p) {
  u16* y = (u16*)(p.ws + OFF_R1);
  const u16* z = (const u16*)p.out;
  const unsigned char* yb8 = (const unsigned char*)(p.ws + OFF_R1 + 128 * MiB);
  const int tid_ = otid();
  int lane = tid_ & 63;
  int wave = blockIdx.x * 4 + (tid_ >> 6), nw = gridDim.x * 4;
  for (int tok = wave; tok < NT; tok += nw) {
#pragma unroll
    for (int g = 0; g < 4; ++g) {
      int ch = g * 512 + lane * 8;
      uint4 yv = *reinterpret_cast<const uint4*>(y + (size_t)tok * 2048 + ch);
      uint4 zv = *reinterpret_cast<const uint4*>(z + (size_t)tok * 2048 + ch);
      uint2 bw = *reinterpret_cast<const uint2*>(yb8 + (size_t)tok * 2048 + ch);
      f32x2 b01 = __builtin_amdgcn_cvt_pk_f32_fp8((int)bw.x, false), b23 = __builtin_amdgcn_cvt_pk_f32_fp8((int)bw.x, true);
      f32x2 b45 = __builtin_amdgcn_cvt_pk_f32_fp8((int)bw.y, false), b67 = __builtin_amdgcn_cvt_pk_f32_fp8((int)bw.y, true);
      const float r16 = 0.25f;
      float u[8];
      u[0] = (bflo(yv.x) + b01.x * r16) * siluf(bflo(zv.x)); u[1] = (bfhi(yv.x) + b01.y * r16) * siluf(bfhi(zv.x));
      u[2] = (bflo(yv.y) + b23.x * r16) * siluf(bflo(zv.y)); u[3] = (bfhi(yv.y) + b23.y * r16) * siluf(bfhi(zv.y));
      u[4] = (bflo(yv.z) + b45.x * r16) * siluf(bflo(zv.z)); u[5] = (bfhi(yv.z) + b45.y * r16) * siluf(bfhi(zv.z));
      u[6] = (bflo(yv.w) + b67.x * r16) * siluf(bflo(zv.w)); u[7] = (bfhi(yv.w) + b67.y * r16) * siluf(bfhi(zv.w));
      float ss = 0.f;
#pragma unroll
      for (int k = 0; k < 8; ++k) ss += u[k] * u[k];
      ss = wave_sum(ss);
      float sc = rsqrtf(ss * (1.f / 512.f) + 1e-5f);
      float4 w0 = *reinterpret_cast<const float4*>(p.m_norm_w + ch), w1 = *reinterpret_cast<const float4*>(p.m_norm_w + ch + 4);
      uint4 o;
      o.x = pack2(u[0] * sc * w0.x, u[1] * sc * w0.y);
      o.y = pack2(u[2] * sc * w0.z, u[3] * sc * w0.w);
      o.z = pack2(u[4] * sc * w1.x, u[5] * sc * w1.y);
      o.w = pack2(u[6] * sc * w1.z, u[7] * sc * w1.w);
      *reinterpret_cast<uint4*>(y + (size_t)tok * 2048 + ch) = o;
    }
  }
}

__device__ __forceinline__ void phase_gemm_resid(const u16* A, int K, const u16* Wt, const float* res, float* dst, const float* gate  , char* lds) {
  const int xcd = blockIdx.x & 7, li = blockIdx.x >> 3, nl = gridDim.x >> 3;
  for (int t = li; t < 128; t += nl) {
    int pm = t, pn = xcd;
    gemm_tile(A, K, Wt, K, pm * 256, pn * 128, 1024, K, lds, [=](int m, int n, f32x4 v) {
      int b = m >> 12;
      float4 r = *reinterpret_cast<const float4*>(res + (size_t)m * 1024 + n);
      float4 g = *reinterpret_cast<const float4*>(gate + (size_t)b * 6144 + n);
      *reinterpret_cast<float4*>(dst + (size_t)m * 1024 + n) = make_float4(ALPHA * r.x + g.x * v[0], ALPHA * r.y + g.y * v[1], ALPHA * r.z + g.z * v[2], ALPHA * r.w + g.w * v[3]);
    });
  }
}
__device__ __forceinline__ void phase_gemm_bf16(const u16* A, const u16* Wt, u16* dst, int N, char* lds) {
  const int xcd = blockIdx.x & 7, li = blockIdx.x >> 3, nl = gridDim.x >> 3;
  const int nb = N / 1024;
  for (int t = li; t < 128 * nb; t += nl) {
    int pm = t / nb, pn = xcd + 8 * (t % nb);
    gemm_tile(A, 1024, Wt, 1024, pm * 256, pn * 128, N, 1024, lds, [=](int m, int n, f32x4 v) { *reinterpret_cast<uint2*>(dst + (size_t)m * N + n) = make_uint2(pack2(v[0], v[1]), pack2(v[2], v[3])); });
  }
}

__device__ __forceinline__ void phase_ln_mod(float* xio, const float* g, const float* bta, const float* mod  , u16* tdst) {
  const int tid_ = otid();
  int lane = tid_ & 63;
  int wave = blockIdx.x * 4 + (tid_ >> 6), nw = gridDim.x * 4;
  for (int tok = wave; tok < NT; tok += nw) {
    int b = tok >> 12;
    float4 v[4];
    float s = 0.f;
#pragma unroll
    for (int i = 0; i < 4; ++i) {
      v[i] = *reinterpret_cast<const float4*>(xio + (size_t)tok * 1024 + i * 256 + lane * 4);
      s += v[i].x + v[i].y + v[i].z + v[i].w;
    }
    float mu = wave_sum(s) * (1.f / 1024.f);
    float q = 0.f;
#pragma unroll
    for (int i = 0; i < 4; ++i) {
      v[i].x -= mu; v[i].y -= mu; v[i].z -= mu; v[i].w -= mu;
      q += v[i].x * v[i].x + v[i].y * v[i].y + v[i].z * v[i].z + v[i].w * v[i].w;
    }
    float rs = rsqrtf(wave_sum(q) * (1.f / 1024.f) + 1e-5f);
    const float* m = mod + (size_t)b * 6144;
#pragma unroll
    for (int i = 0; i < 4; ++i) {
      int c = i * 256 + lane * 4;
      float4 gg = *reinterpret_cast<const float4*>(g + c), bb = *reinterpret_cast<const float4*>(bta + c);
      float4 o;
      o.x = v[i].x * rs * gg.x + bb.x; o.y = v[i].y * rs * gg.y + bb.y; o.z = v[i].z * rs * gg.z + bb.z; o.w = v[i].w * rs * gg.w + bb.w;
      *reinterpret_cast<float4*>(xio + (size_t)tok * 1024 + c) = o;
      float4 sh = *reinterpret_cast<const float4*>(m + 3072 + c), sc = *reinterpret_cast<const float4*>(m + 4096 + c);
      uint2 t;
      t.x = pack2(o.x * (1.f + sc.x) + sh.x, o.y * (1.f + sc.y) + sh.y);
      t.y = pack2(o.z * (1.f + sc.z) + sh.z, o.w * (1.f + sc.w) + sh.w);
      *reinterpret_cast<uint2*>(tdst + (size_t)tok * 1024 + c) = t;
    }
  }
}

__device__ __forceinline__ void phase_peer_topk(const u16* q, const u16* k1, const u16* k2, int* idxo, float* gateo, char* lds) {
  float* S = (float*)lds;
  float* sv = S + 64 * 129;
  int* si = (int*)(sv + 64 * 16);
  int tid = otid(), w = tid >> 6, lane = tid & 63, fr = lane & 15, fq = lane >> 4;
  const int slot = lane;
  const bool cvalid = lane < 50;
  int ci = slot < 42 ? ((slot >= 16) + (slot >= 24) + (slot >= 29) + (slot >= 33) + (slot >= 36) + (slot >= 38) + (slot >= 40)) : slot - 34;
  const unsigned long long PACK = 0ull | (16ull << 8) | (24ull << 16) | (29ull << 24) | (33ull << 32) | (36ull << 40) | (38ull << 48) | (40ull << 56);
  int cj = slot - (ci < 8 ? (int)((PACK >> (8 * ci)) & 0xFF) : 34 + ci);
  if (!cvalid) { ci = 0; cj = 0; }
  for (int item = blockIdx.x; item < 1024 * 8; item += gridDim.x) {
    int tile = item >> 3, h = item & 7;
    int tok0 = tile * 32;
    {
      int half = w >> 1, kb = (w & 1) * 64;
      const u16* kk_ = (half ? k2 : k1) + (size_t)h * 128 * 128;
      bf16x8 Af[2][4], Bf[4][4];
#pragma unroll
      for (int m = 0; m < 2; ++m)
#pragma unroll
        for (int ks = 0; ks < 4; ++ks) Af[m][ks] = ld8(q + (size_t)(tok0 + m * 16 + fr) * 2048 + h * 256 + half * 128 + ks * 32 + fq * 8);
#pragma unroll
      for (int n = 0; n < 4; ++n)
#pragma unroll
        for (int ks = 0; ks < 4; ++ks) Bf[n][ks] = ld8(kk_ + (size_t)(kb + n * 16 + fr) * 128 + ks * 32 + fq * 8);
      f32x4 acc[2][4];
#pragma unroll
      for (int m = 0; m < 2; ++m)
#pragma unroll
        for (int n = 0; n < 4; ++n) acc[m][n] = f32x4{0.f, 0.f, 0.f, 0.f};
#pragma unroll
      for (int ks = 0; ks < 4; ++ks)
#pragma unroll
        for (int n = 0; n < 4; ++n) {
          acc[0][n] = mfma16(Af[0][ks], Bf[n][ks], acc[0][n]);
          acc[1][n] = mfma16(Af[1][ks], Bf[n][ks], acc[1][n]);
        }
#pragma unroll
      for (int m = 0; m < 2; ++m)
#pragma unroll
        for (int n = 0; n < 4; ++n)
#pragma unroll
          for (int j = 0; j < 4; ++j) S[(half * 32 + m * 16 + fq * 4 + j) * 129 + kb + n * 16 + fr] = acc[m][n][j];
    }
    __syncthreads();
#pragma unroll 1
    for (int li = 0; li < 16; ++li) {
      int list = w * 16 + li;
      const float* row = S + list * 129;
      float vlo = row[lane], vhi = row[lane + 64];
      unsigned long long klo = ((unsigned long long)ordkey(vlo) << 7) | (unsigned)(127 - lane);
      unsigned long long khi = ((unsigned long long)ordkey(vhi) << 7) | (unsigned)(63 - lane);
      unsigned long long T = 0;
#pragma unroll 3
      for (int bit = 38; bit >= 0; --bit) {
        unsigned long long cand = T | (1ull << bit);
        int cnt = __popcll(__ballot(klo >= cand)) + __popcll(__ballot(khi >= cand));
        if (cnt >= 16) T = cand;
        if (cnt == 16) break;
      }
      bool slo = klo >= T, shi = khi >= T;
      unsigned long long mlo = __ballot(slo), mhi = __ballot(shi);
      int rlo = 0, rhi = 0;
      int klo_l = (int)(unsigned)klo, klo_h = (int)(unsigned)(klo >> 32), khi_l = (int)(unsigned)khi, khi_h = (int)(unsigned)(khi >> 32);
      while (mlo) {
        int src = __ffsll((long long)mlo) - 1;
        mlo &= mlo - 1;
        unsigned long long ks = ((unsigned long long)(unsigned)__builtin_amdgcn_readlane(klo_h, src) << 32) | (unsigned)__builtin_amdgcn_readlane(klo_l, src);
        rlo += (ks > klo) ? 1 : 0;
        rhi += (ks > khi) ? 1 : 0;
      }
      while (mhi) {
        int src = __ffsll((long long)mhi) - 1;
        mhi &= mhi - 1;
        unsigned long long ks = ((unsigned long long)(unsigned)__builtin_amdgcn_readlane(khi_h, src) << 32) | (unsigned)__builtin_amdgcn_readlane(khi_l, src);
        rlo += (ks > klo) ? 1 : 0;
        rhi += (ks > khi) ? 1 : 0;
      }
      if (slo) { sv[list * 16 + rlo] = vlo; si[list * 16 + rlo] = lane; }
      if (shi) { sv[list * 16 + rhi] = vhi; si[list * 16 + rhi] = lane + 64; }
    }
    __syncthreads();
#pragma unroll 1
    for (int tt = 0; tt < 8; ++tt) {
      int tok = w * 8 + tt;
      float sc_ = sv[tok * 16 + ci] + sv[(32 + tok) * 16 + cj];
      unsigned long long key = cvalid ? ((((unsigned long long)ordkey(sc_)) << 6) | (unsigned)(63 - lane)) : 0ull;
      unsigned long long T = 0;
#pragma unroll 3
      for (int bit = 37; bit >= 0; --bit) {
        unsigned long long cand = T | (1ull << bit);
        int cnt = __popcll(__ballot(key >= cand));
        if (cnt >= 16) T = cand;
        if (cnt == 16) break;
      }
      bool sel = cvalid && key >= T;
      unsigned long long msel = __ballot(sel);
      int rank = 0;
      int k_l = (int)(unsigned)key, k_h = (int)(unsigned)(key >> 32);
      int isc = __float_as_int(sc_);
      unsigned long long mm = msel;
      float mx = -INFINITY;
      while (mm) {
        int src = __ffsll((long long)mm) - 1;
        mm &= mm - 1;
        unsigned long long ks = ((unsigned long long)(unsigned)__builtin_amdgcn_readlane(k_h, src) << 32) | (unsigned)__builtin_amdgcn_readlane(k_l, src);
        rank += (ks > key) ? 1 : 0;
        mx = fmaxf(mx, __int_as_float(__builtin_amdgcn_readlane(isc, src)));
      }
      float ex = sel ? __expf(sc_ - mx) : 0.f;
      int iex = __float_as_int(ex);
      float sum = 0.f;
      mm = msel;
      while (mm) {
        int src = __ffsll((long long)mm) - 1;
        mm &= mm - 1;
        sum += __int_as_float(__builtin_amdgcn_readlane(iex, src));
      }
      if (sel) {
        size_t o = (size_t)(tok0 + tok) * 128 + h * 16 + rank;
        gateo[o] = ex / sum;
        idxo[o] = si[tok * 16 + ci] * 128 + si[(32 + tok) * 16 + cj];
      }
    }
  }
  __syncthreads();
}

DEV float gelu_exact(float v) { return 0.5f * v * (1.f + erff(v * 0.70710678118654752f)); }

__device__ __forceinline__ void convert_fp8_rows(const float* src, unsigned char* dst, float* rscale, int nrows) {
  const int tid_ = otid();
  int lane = tid_ & 63;
  int wave = blockIdx.x * 4 + (tid_ >> 6), nw = gridDim.x * 4;
  for (int row = wave; row < nrows; row += nw) {
    const float* r = src + (size_t)row * 1024 + lane * 16;
    float4 a0 = *reinterpret_cast<const float4*>(r), a1 = *reinterpret_cast<const float4*>(r + 4);
    float4 a2 = *reinterpret_cast<const float4*>(r + 8), a3 = *reinterpret_cast<const float4*>(r + 12);
    float m = fmaxf(fmaxf(fmaxf(fabsf(a0.x), fabsf(a0.y)), fmaxf(fabsf(a0.z), fabsf(a0.w))), fmaxf(fmaxf(fabsf(a1.x), fabsf(a1.y)), fmaxf(fabsf(a1.z), fabsf(a1.w))));
    m = fmaxf(m, fmaxf(fmaxf(fmaxf(fabsf(a2.x), fabsf(a2.y)), fmaxf(fabsf(a2.z), fabsf(a2.w))), fmaxf(fmaxf(fabsf(a3.x), fabsf(a3.y)), fmaxf(fabsf(a3.z), fabsf(a3.w)))));
#pragma unroll
    for (int o = 32; o > 0; o >>= 1) m = fmaxf(m, __shfl_xor(m, o));
    float sc = m > 0.f ? exp2f(floorf(log2f(224.f / m))) : 1.f;
    uint4 o;
    int p;
    p = __builtin_amdgcn_cvt_pk_fp8_f32(a0.x * sc, a0.y * sc, 0, false); p = __builtin_amdgcn_cvt_pk_fp8_f32(a0.z * sc, a0.w * sc, p, true); o.x = (unsigned)p;
    p = __builtin_amdgcn_cvt_pk_fp8_f32(a1.x * sc, a1.y * sc, 0, false); p = __builtin_amdgcn_cvt_pk_fp8_f32(a1.z * sc, a1.w * sc, p, true); o.y = (unsigned)p;
    p = __builtin_amdgcn_cvt_pk_fp8_f32(a2.x * sc, a2.y * sc, 0, false); p = __builtin_amdgcn_cvt_pk_fp8_f32(a2.z * sc, a2.w * sc, p, true); o.z = (unsigned)p;
    p = __builtin_amdgcn_cvt_pk_fp8_f32(a3.x * sc, a3.y * sc, 0, false); p = __builtin_amdgcn_cvt_pk_fp8_f32(a3.z * sc, a3.w * sc, p, true); o.w = (unsigned)p;
    *reinterpret_cast<uint4*>(dst + (size_t)row * 1024 + lane * 16) = o;
    if (lane == 0) rscale[row] = 1.f / sc;
  }
}

#define F8X(dst, WW) { dst[0] = __builtin_amdgcn_cvt_pk_f32_fp8((int)(WW).x, false); dst[1] = __builtin_amdgcn_cvt_pk_f32_fp8((int)(WW).x, true); \
                      dst[2] = __builtin_amdgcn_cvt_pk_f32_fp8((int)(WW).y, false); dst[3] = __builtin_amdgcn_cvt_pk_f32_fp8((int)(WW).y, true); \
                      dst[4] = __builtin_amdgcn_cvt_pk_f32_fp8((int)(WW).z, false); dst[5] = __builtin_amdgcn_cvt_pk_f32_fp8((int)(WW).z, true); \
                      dst[6] = __builtin_amdgcn_cvt_pk_f32_fp8((int)(WW).w, false); dst[7] = __builtin_amdgcn_cvt_pk_f32_fp8((int)(WW).w, true); }

__device__ __forceinline__ void phase_peer_gather(const u16* tin, const int* idx, const float* gate, const unsigned char* utab, const unsigned char* vtab,
                                  const float* urs, const float* vrs, const float* xres,
                                  const float* g2  , const float* lng, const float* lnb, float* xout,
                                  const float* modnext  , u16* hxout) {
  const int tid_ = otid();
  int lane = tid_ & 63;
  int wave = blockIdx.x * 4 + (tid_ >> 6), nw = gridDim.x * 4;
  for (int tok = wave; tok < NT; tok += nw) {
    int b = tok >> 12;
    f32x2 t2[8];
    {
      uint4 ta = *reinterpret_cast<const uint4*>(tin + (size_t)tok * 1024 + lane * 16);
      uint4 tb = *reinterpret_cast<const uint4*>(tin + (size_t)tok * 1024 + lane * 16 + 8);
      t2[0] = f32x2{bflo(ta.x), bfhi(ta.x)}; t2[1] = f32x2{bflo(ta.y), bfhi(ta.y)}; t2[2] = f32x2{bflo(ta.z), bfhi(ta.z)}; t2[3] = f32x2{bflo(ta.w), bfhi(ta.w)};
      t2[4] = f32x2{bflo(tb.x), bfhi(tb.x)}; t2[5] = f32x2{bflo(tb.y), bfhi(tb.y)}; t2[6] = f32x2{bflo(tb.z), bfhi(tb.z)}; t2[7] = f32x2{bflo(tb.w), bfhi(tb.w)};
    }
    int id0 = idx[(size_t)tok * 128 + lane] & 16383, id1 = idx[(size_t)tok * 128 + 64 + lane] & 16383;
    int gt0 = __float_as_int(gate[(size_t)tok * 128 + lane]), gt1 = __float_as_int(gate[(size_t)tok * 128 + 64 + lane]);
    f32x2 acc2[8];
#pragma unroll
    for (int k = 0; k < 8; ++k) acc2[k] = f32x2{0.f, 0.f};
#pragma unroll 1
    for (int j = 0; j < 128; j += 4) {
      int e[4];
      float g[4];
      if (j < 64) {
#pragma unroll
        for (int q = 0; q < 4; ++q) { e[q] = __builtin_amdgcn_readlane(id0, j + q); g[q] = __int_as_float(__builtin_amdgcn_readlane(gt0, j + q)); }
      } else {
#pragma unroll
        for (int q = 0; q < 4; ++q) { e[q] = __builtin_amdgcn_readlane(id1, j - 64 + q); g[q] = __int_as_float(__builtin_amdgcn_readlane(gt1, j - 64 + q)); }
      }
      uint4 U[4], V[4];
      float su[4], sv_[4];
#pragma unroll
      for (int q = 0; q < 4; ++q) {
        U[q] = *reinterpret_cast<const uint4*>(utab + (size_t)e[q] * 1024 + lane * 16);
        V[q] = *reinterpret_cast<const uint4*>(vtab + (size_t)e[q] * 1024 + lane * 16);
        su[q] = urs[e[q]];
        sv_[q] = vrs[e[q]];
      }
      float d[4];
#pragma unroll
      for (int q = 0; q < 4; ++q) {
        f32x2 u2[8];
        F8X(u2, U[q])
        f32x2 dd = u2[0] * t2[0];
#pragma unroll
        for (int k = 1; k < 8; ++k) dd = u2[k] * t2[k] + dd;
        d[q] = dd.x + dd.y;
      }
#pragma unroll
      for (int o = 32; o > 0; o >>= 1) {
#pragma unroll
        for (int q = 0; q < 4; ++q) d[q] += __shfl_xor(d[q], o);
      }
#pragma unroll
      for (int q = 0; q < 4; ++q) {
        float a = g[q] * gelu_exact(d[q] * su[q]) * sv_[q];
        f32x2 aa = f32x2{a, a};
        f32x2 v2[8];
        F8X(v2, V[q])
#pragma unroll
        for (int k = 0; k < 8; ++k) acc2[k] = aa * v2[k] + acc2[k];
      }
    }
    float vv[16];
    float s = 0.f;
    const int c0 = lane * 16;
#pragma unroll
    for (int k4 = 0; k4 < 4; ++k4) {
      float4 x0 = *reinterpret_cast<const float4*>(xres + (size_t)tok * 1024 + c0 + k4 * 4);
      float4 g0 = *reinterpret_cast<const float4*>(g2 + (size_t)b * 6144 + c0 + k4 * 4);
      vv[k4 * 4 + 0] = ALPHA * x0.x + g0.x * acc2[k4 * 2].x; vv[k4 * 4 + 1] = ALPHA * x0.y + g0.y * acc2[k4 * 2].y;
      vv[k4 * 4 + 2] = ALPHA * x0.z + g0.z * acc2[k4 * 2 + 1].x; vv[k4 * 4 + 3] = ALPHA * x0.w + g0.w * acc2[k4 * 2 + 1].y;
    }
#pragma unroll
    for (int k = 0; k < 16; ++k) s += vv[k];
    float mu = wave_sum(s) * (1.f / 1024.f);
    float qq = 0.f;
#pragma unroll
    for (int k = 0; k < 16; ++k) { vv[k] -= mu; qq += vv[k] * vv[k]; }
    float rs = rsqrtf(wave_sum(qq) * (1.f / 1024.f) + 1e-5f);
    float oo[16];
#pragma unroll
    for (int k4 = 0; k4 < 4; ++k4) {
      float4 ga = *reinterpret_cast<const float4*>(lng + c0 + k4 * 4), ba = *reinterpret_cast<const float4*>(lnb + c0 + k4 * 4);
      float4 o0;
      o0.x = vv[k4 * 4 + 0] * rs * ga.x + ba.x; o0.y = vv[k4 * 4 + 1] * rs * ga.y + ba.y; o0.z = vv[k4 * 4 + 2] * rs * ga.z + ba.z; o0.w = vv[k4 * 4 + 3] * rs * ga.w + ba.w;
      *reinterpret_cast<float4*>(xout + (size_t)tok * 1024 + c0 + k4 * 4) = o0;
      oo[k4 * 4 + 0] = o0.x; oo[k4 * 4 + 1] = o0.y; oo[k4 * 4 + 2] = o0.z; oo[k4 * 4 + 3] = o0.w;
    }
    if (modnext) {
      const float* m = modnext + (size_t)b * 6144;
      unsigned pk[8];
#pragma unroll
      for (int k4 = 0; k4 < 4; ++k4) {
        float4 sh0 = *reinterpret_cast<const float4*>(m + c0 + k4 * 4), sc0 = *reinterpret_cast<const float4*>(m + 1024 + c0 + k4 * 4);
        pk[k4 * 2] = pack2(oo[k4 * 4 + 0] * (1.f + sc0.x) + sh0.x, oo[k4 * 4 + 1] * (1.f + sc0.y) + sh0.y);
        pk[k4 * 2 + 1] = pack2(oo[k4 * 4 + 2] * (1.f + sc0.z) + sh0.z, oo[k4 * 4 + 3] * (1.f + sc0.w) + sh0.w);
      }
      *reinterpret_cast<uint4*>(hxout + (size_t)tok * 1024 + c0) = make_uint4(pk[0], pk[1], pk[2], pk[3]);
      *reinterpret_cast<uint4*>(hxout + (size_t)tok * 1024 + c0 + 8) = make_uint4(pk[4], pk[5], pk[6], pk[7]);
    }
  }
}

__device__ __forceinline__ void phase_shortconv_T(const Params& p, const u16* upre, u16* x1cm, u16* x2cm, u16* vcm, char* lds) {
  u16* tile = (u16*)lds;
  int tid = otid();
  for (int item = blockIdx.x; item < 512 * 48; item += gridDim.x) {
    int tt = item / 48, ct = item % 48;
    int tok0 = tt * 64, c0 = ct * 64;
#pragma unroll
    for (int i = 0; i < 2; ++i) {
      int q = tid + i * 256, tl = q >> 3, cg_ = (q & 7) * 8;
      int tok = tok0 + tl, l = tok & 4095, ch = c0 + cg_;
      float acc[8];
#pragma unroll
      for (int k = 0; k < 8; ++k) acc[k] = p.h_conv_b[ch + k];
#pragma unroll
      for (int j = 0; j < 3; ++j) {
        int ll = l + j - 1;
        if (ll < 0 || ll > 4095) continue;
        uint4 v = *reinterpret_cast<const uint4*>(upre + (size_t)(tok + j - 1) * 3072 + ch);
        const float* w = p.h_conv_w + j * 3072 + ch;
        float4 w0 = *reinterpret_cast<const float4*>(w), w1 = *reinterpret_cast<const float4*>(w + 4);
        acc[0] += bflo(v.x) * w0.x; acc[1] += bfhi(v.x) * w0.y; acc[2] += bflo(v.y) * w0.z; acc[3] += bfhi(v.y) * w0.w;
        acc[4] += bflo(v.z) * w1.x; acc[5] += bfhi(v.z) * w1.y; acc[6] += bflo(v.w) * w1.z; acc[7] += bfhi(v.w) * w1.w;
      }
#pragma unroll
      for (int k = 0; k < 8; ++k) tile[(cg_ + k) * 72 + tl] = f2bf(acc[k]);
    }
    __syncthreads();
    int part = c0 >> 10, d0 = c0 & 1023;
    u16* dst = part == 0 ? x1cm : (part == 1 ? x2cm : vcm);
    int b = tok0 >> 12, l0 = tok0 & 4095;
#pragma unroll
    for (int i = 0; i < 2; ++i) {
      int q = tid + i * 256, c = q >> 3, tg = (q & 7) * 8;
      uint4 v = *reinterpret_cast<const uint4*>(tile + c * 72 + tg);
      *reinterpret_cast<uint4*>(dst + ((size_t)(b * 1024 + d0 + c)) * 4096 + l0 + tg) = v;
    }
    __syncthreads();
  }
}

__device__ __forceinline__ void fft_fwd(float2* X, const float2* __restrict__ tw) {
  int tid = otid();
  for (int s = 12; s >= 0; --s) {
    int half = 1 << s;
#pragma unroll 4
    for (int i = 0; i < 16; ++i) {
      int j = tid + i * 256;
      int pos = j & (half - 1);
      int i0 = ((j >> s) << (s + 1)) + pos, i1 = i0 + half;
      float2 wv = tw[pos << (12 - s)];
      float wr = wv.x, wi = wv.y;
      float2 a = X[i0], bq = X[i1];
      float dr = a.x - bq.x, di = a.y - bq.y;
      X[i0] = make_float2(a.x + bq.x, a.y + bq.y);
      X[i1] = make_float2(dr * wr - di * wi, dr * wi + di * wr);
    }
    __syncthreads();
  }
}
__device__ __forceinline__ void fft_inv(float2* X, const float2* __restrict__ tw) {
  int tid = otid();
  for (int s = 0; s <= 12; ++s) {
    int half = 1 << s;
#pragma unroll 4
    for (int i = 0; i < 16; ++i) {
      int j = tid + i * 256;
      int pos = j & (half - 1);
      int i0 = ((j >> s) << (s + 1)) + pos, i1 = i0 + half;
      float2 wv = tw[pos << (12 - s)];
      float wr = wv.x, wi = wv.y;
      float2 a = X[i0], bq = X[i1];
      float br = bq.x * wr + bq.y * wi, bi = bq.y * wr - bq.x * wi;
      X[i0] = make_float2(a.x + br, a.y + bi);
      X[i1] = make_float2(a.x - br, a.y - bi);
    }
    __syncthreads();
  }
}

__device__ __forceinline__ void phase_filter_fft(const Params& p, float2* Hf, char* lds) {
  float2* X = (float2*)lds;
  float* w3s = (float*)(lds + 65536);
  float* red = w3s + 128;
  const float* hid = (const float*)(p.ws + OFF_HID);
  int tid = otid();
  const float min_decay = -3.0701134573253945f;
  const float max_decay = -15.350567286626973f;
  for (int item = blockIdx.x; item < 2048; item += gridDim.x) {
    int o = item >> 10, d = item & 1023;
    if (tid < 128) {
      int dirr = tid >> 6, j = tid & 63;
      w3s[tid] = p.h_f_w3[(size_t)j * 4096 + (o * 2 + dirr) * 1024 + d];
    }
    __syncthreads();
    float adelta = fabsf(min_decay + (float)d * ((max_decay - min_decay) / 1023.f));
    float ss = 0.f;
#pragma unroll 1
    for (int i = 0; i < 16; ++i) {
      int t = tid + i * 256;
      const float* hr = hid + (size_t)t * 64;
      float hf = 0.f, hb = 0.f;
#pragma unroll
      for (int j4 = 0; j4 < 16; ++j4) {
        float4 hv = *reinterpret_cast<const float4*>(hr + j4 * 4);
        hf += hv.x * w3s[j4 * 4] + hv.y * w3s[j4 * 4 + 1] + hv.z * w3s[j4 * 4 + 2] + hv.w * w3s[j4 * 4 + 3];
        hb += hv.x * w3s[64 + j4 * 4] + hv.y * w3s[64 + j4 * 4 + 1] + hv.z * w3s[64 + j4 * 4 + 2] + hv.w * w3s[64 + j4 * 4 + 3];
      }
      float dec = __expf(-((float)t / 4095.f) * adelta);
      hf *= dec; hb *= dec;
      if (t == 0) {
        float v = hf + hb;
        X[0] = make_float2(v, 0.f);
        X[4096] = make_float2(0.f, 0.f);
        ss += v * v;
      } else {
        X[t] = make_float2(hf, 0.f);
        X[8192 - t] = make_float2(hb, 0.f);
        ss += hf * hf + hb * hb;
      }
    }
    ss = wave_sum(ss);
    if ((tid & 63) == 0) red[tid >> 6] = ss;
    __syncthreads();
    float tot = red[0] + red[1] + red[2] + red[3];
    float scale = rsqrtf(tot + 1e-6f) * (1.f / 8192.f);
    fft_fwd(X, (const float2*)(p.ws + OFF_TW));
    float2* dst = Hf + (size_t)item * 8192;
#pragma unroll 4
    for (int i = 0; i < 32; ++i) {
      int k = tid + i * 256;
      float2 v = X[k];
      dst[k] = make_float2(v.x * scale, v.y * scale);
    }
    __syncthreads();
  }
}

__device__ __forceinline__ void phase_hyena_conv(const Params& p, const u16* x1cm, const u16* x2cm, const u16* vcm, const float2* Hf, u16* zzcm, char* lds) {
  float2* X = (float2*)lds;
  int tid = otid();
  for (int item = blockIdx.x; item < 4096; item += gridDim.x) {
    int d = item >> 2, bp = item & 3;
    size_t r0 = ((size_t)((bp * 2) * 1024 + d)) * 4096, r1 = ((size_t)((bp * 2 + 1) * 1024 + d)) * 4096;
    float bias0 = p.h_bias[d], bias1 = p.h_bias[1024 + d];
#pragma unroll
    for (int i = 0; i < 2; ++i) {
      int t8 = (tid + i * 256) * 8;
      uint4 a = *reinterpret_cast<const uint4*>(vcm + r0 + t8);
      uint4 bq = *reinterpret_cast<const uint4*>(vcm + r1 + t8);
      X[t8 + 0] = make_float2(bflo(a.x), bflo(bq.x)); X[t8 + 1] = make_float2(bfhi(a.x), bfhi(bq.x));
      X[t8 + 2] = make_float2(bflo(a.y), bflo(bq.y)); X[t8 + 3] = make_float2(bfhi(a.y), bfhi(bq.y));
      X[t8 + 4] = make_float2(bflo(a.z), bflo(bq.z)); X[t8 + 5] = make_float2(bfhi(a.z), bfhi(bq.z));
      X[t8 + 6] = make_float2(bflo(a.w), bflo(bq.w)); X[t8 + 7] = make_float2(bfhi(a.w), bfhi(bq.w));
    }
    for (int i = 0; i < 16; ++i) X[4096 + tid + i * 256] = make_float2(0.f, 0.f);
    __syncthreads();
    fft_fwd(X, (const float2*)(p.ws + OFF_TW));
    {
      const float2* H = Hf + (size_t)d * 8192;
#pragma unroll 4
      for (int i = 0; i < 32; ++i) {
        int k = tid + i * 256;
        float2 hv = H[k], xv = X[k];
        X[k] = make_float2(xv.x * hv.x - xv.y * hv.y, xv.x * hv.y + xv.y * hv.x);
      }
    }
    __syncthreads();
    fft_inv(X, (const float2*)(p.ws + OFF_TW));
    float zz0[16], zz1[16];
#pragma unroll
    for (int i = 0; i < 2; ++i) {
      int t8 = (tid + i * 256) * 8;
      uint4 a = *reinterpret_cast<const uint4*>(vcm + r0 + t8);
      uint4 bq = *reinterpret_cast<const uint4*>(vcm + r1 + t8);
      uint4 xa = *reinterpret_cast<const uint4*>(x1cm + r0 + t8);
      uint4 xb = *reinterpret_cast<const uint4*>(x1cm + r1 + t8);
      float va[8] = {bflo(a.x), bfhi(a.x), bflo(a.y), bfhi(a.y), bflo(a.z), bfhi(a.z), bflo(a.w), bfhi(a.w)};
      float vb[8] = {bflo(bq.x), bfhi(bq.x), bflo(bq.y), bfhi(bq.y), bflo(bq.z), bfhi(bq.z), bflo(bq.w), bfhi(bq.w)};
      float fa[8] = {bflo(xa.x), bfhi(xa.x), bflo(xa.y), bfhi(xa.y), bflo(xa.z), bfhi(xa.z), bflo(xa.w), bfhi(xa.w)};
      float fb[8] = {bflo(xb.x), bfhi(xb.x), bflo(xb.y), bfhi(xb.y), bflo(xb.z), bfhi(xb.z), bflo(xb.w), bfhi(xb.w)};
#pragma unroll
      for (int e = 0; e < 8; ++e) {
        float2 cv = X[t8 + e];
        float z0 = fa[e] * (cv.x + va[e] * bias0);
        float z1 = fb[e] * (cv.y + vb[e] * bias0);
        zz0[i * 8 + e] = z0; zz1[i * 8 + e] = z1;
        X[t8 + e] = make_float2(z0, z1);
      }
    }
    for (int i = 0; i < 16; ++i) X[4096 + tid + i * 256] = make_float2(0.f, 0.f);
    __syncthreads();
    fft_fwd(X, (const float2*)(p.ws + OFF_TW));
    {
      const float2* H = Hf + (size_t)(1024 + d) * 8192;
#pragma unroll 4
      for (int i = 0; i < 32; ++i) {
        int k = tid + i * 256;
        float2 hv = H[k], xv = X[k];
        X[k] = make_float2(xv.x * hv.x - xv.y * hv.y, xv.x * hv.y + xv.y * hv.x);
      }
    }
    __syncthreads();
    fft_inv(X, (const float2*)(p.ws + OFF_TW));
#pragma unroll
    for (int i = 0; i < 2; ++i) {
      int t8 = (tid + i * 256) * 8;
      uint4 xa = *reinterpret_cast<const uint4*>(x2cm + r0 + t8);
      uint4 xb = *reinterpret_cast<const uint4*>(x2cm + r1 + t8);
      float fa[8] = {bflo(xa.x), bfhi(xa.x), bflo(xa.y), bfhi(xa.y), bflo(xa.z), bfhi(xa.z), bflo(xa.w), bfhi(xa.w)};
      float fb[8] = {bflo(xb.x), bfhi(xb.x), bflo(xb.y), bfhi(xb.y), bflo(xb.z), bfhi(xb.z), bflo(xb.w), bfhi(xb.w)};
      float o0[8], o1[8];
#pragma unroll
      for (int e = 0; e < 8; ++e) {
        float2 cv = X[t8 + e];
        o0[e] = fa[e] * (cv.x + zz0[i * 8 + e] * bias1);
        o1[e] = fb[e] * (cv.y + zz1[i * 8 + e] * bias1);
      }
      uint4 w0, w1;
      w0.x = pack2(o0[0], o0[1]); w0.y = pack2(o0[2], o0[3]); w0.z = pack2(o0[4], o0[5]); w0.w = pack2(o0[6], o0[7]);
      w1.x = pack2(o1[0], o1[1]); w1.y = pack2(o1[2], o1[3]); w1.z = pack2(o1[4], o1[5]); w1.w = pack2(o1[6], o1[7]);
      *reinterpret_cast<uint4*>(zzcm + r0 + t8) = w0;
      *reinterpret_cast<uint4*>(zzcm + r1 + t8) = w1;
    }
    __syncthreads();
  }
}

__device__ __forceinline__ void phase_transpose_back(const u16* src, u16* dst, char* lds) {
  u16* tile = (u16*)lds;
  int tid = otid();
  for (int item = blockIdx.x; item < 8 * 16 * 64; item += gridDim.x) {
    int b = item >> 10, dt_ = (item >> 6) & 15, tt = item & 63;
#pragma unroll
    for (int i = 0; i < 2; ++i) {
      int q = tid + i * 256, dd = q >> 3, tg = (q & 7) * 8;
      uint4 v = *reinterpret_cast<const uint4*>(src + ((size_t)(b * 1024 + dt_ * 64 + dd)) * 4096 + tt * 64 + tg);
      tile[(tg + 0) * 72 + dd] = (u16)(v.x & 0xffff); tile[(tg + 1) * 72 + dd] = (u16)(v.x >> 16);
      tile[(tg + 2) * 72 + dd] = (u16)(v.y & 0xffff); tile[(tg + 3) * 72 + dd] = (u16)(v.y >> 16);
      tile[(tg + 4) * 72 + dd] = (u16)(v.z & 0xffff); tile[(tg + 5) * 72 + dd] = (u16)(v.z >> 16);
      tile[(tg + 6) * 72 + dd] = (u16)(v.w & 0xffff); tile[(tg + 7) * 72 + dd] = (u16)(v.w >> 16);
    }
    __syncthreads();
#pragma unroll
    for (int i = 0; i < 2; ++i) {
      int q = tid + i * 256, tl = q >> 3, dg = (q & 7) * 8;
      uint4 v = *reinterpret_cast<const uint4*>(tile + tl * 72 + dg);
      *reinterpret_cast<uint4*>(dst + ((size_t)(b * 4096 + tt * 64 + tl)) * 1024 + dt_ * 64 + dg) = v;
    }
    __syncthreads();
  }
}

DEV void probe_rows(const unsigned* buf, int wpr, float* out) {
  const int tid_ = otid();
  int lane = tid_ & 63;
  int wave = blockIdx.x * 4 + (tid_ >> 6), nw = gridDim.x * 4;
  for (int row = wave; row < NT; row += nw) {
    unsigned h = 0;
    for (int w = lane; w < wpr; w += 64) { unsigned v = buf[(size_t)row * wpr + w]; h += (v ^ (v >> 15)) * (2654435761u + 2u * (unsigned)w); }
#pragma unroll
    for (int o = 32; o > 0; o >>= 1) h += (unsigned)__shfl_xor((int)h, o);
    float v = (float)((h >> 8) & 0xFFFFu) * (1.f / 65536.f);
    float4 vv = make_float4(v, v, v, v);
#pragma unroll
    for (int i = 0; i < 4; ++i) *reinterpret_cast<float4*>(out + (size_t)row * 1024 + i * 256 + lane * 4) = vv;
  }
}
#define PROBE_AT(id, bufexpr, wpr) if (PROBE == id) { Params pq = fetch_params(); probe_rows((const unsigned*)(bufexpr), wpr, pq.out); return; }

__device__ __forceinline__ uint4* xb_words_ptr() { __shared__ uint4 xb_words; return &xb_words; }
#define XB_TMO      128
#define XB_XCNT(j)  (256  + 64 * (j))
#define XB_XSUB(j)  (1280 + 64 * (j))
#define XB_XGEN(j)  (2304 + 64 * (j))
#define XB_TOP      3328
#define XB_TOPGEN   3392
#define XCD_BAR_WORDS 3456
#define XB_SPIN_CAP (1u << 18)
#define LAS __attribute__((address_space(3)))

__device__ __forceinline__ unsigned xb_ld(unsigned* p)              { return __hip_atomic_load(p, __ATOMIC_RELAXED, __HIP_MEMORY_SCOPE_AGENT); }
__device__ __forceinline__ unsigned xb_add(unsigned* p, unsigned v) { return __hip_atomic_fetch_add(p, v, __ATOMIC_RELAXED, __HIP_MEMORY_SCOPE_AGENT); }
__device__ __forceinline__ unsigned xb_xcc_id() { return (unsigned)__builtin_amdgcn_s_getreg((3 << 11) | 20) & 0xFu; }
#define XB_SPIN(cond, bar) do { unsigned _sp = 0; while (cond) { __builtin_amdgcn_s_sleep(1); \
    if ((++_sp & 255u) == 0u) { if (xb_ld(&(bar)[XB_TMO])) break; if (_sp > XB_SPIN_CAP) { atomicAdd(&(bar)[XB_TMO], 1u); break; } } } } while (0)

struct XcdBarrier {
    unsigned* bar; unsigned x;
    volatile LAS unsigned* st;
};

__device__ __forceinline__ XcdBarrier xcd_barrier_post(unsigned* bar, volatile LAS unsigned* st) {
    XcdBarrier b; b.bar = bar; b.x = xb_xcc_id(); b.st = st;
    if (threadIdx.x == 0) (void)xb_add(&bar[XB_XCNT(b.x)], 1u);
    return b;
}
__device__ __forceinline__ void xcd_barrier_complete(unsigned* bar, unsigned x, unsigned& nloc, unsigned& nx) {
    const unsigned G = gridDim.x * gridDim.y * gridDim.z;
    unsigned sum, cnt, mine, sp = 0u;
    for (;;) {
        sum = 0u; cnt = 0u; mine = 0u;
#pragma unroll
        for (unsigned j = 0; j < 16; ++j) { const unsigned c = xb_ld(&bar[XB_XCNT(j)]); sum += c; cnt += (c > 0u) ? 1u : 0u; mine = (j == x) ? c : mine; }
        if (sum == G) break;
        __builtin_amdgcn_s_sleep(1);
        if ((++sp & 255u) == 0u) { if (xb_ld(&bar[XB_TMO])) break; if (sp > XB_SPIN_CAP) { atomicAdd(&bar[XB_TMO], 1u); break; } }
    }
    nloc = mine > 0u ? mine : 1u; nx = cnt > 0u ? cnt : 1u;
}

__device__ __forceinline__ void xcd_barrier(const XcdBarrier& b) {
    asm volatile("s_waitcnt vmcnt(0)" ::: "memory");
    __syncthreads();
    if (threadIdx.x == 0) {
        unsigned* bar = b.bar;
        __builtin_amdgcn_s_waitcnt(0);
        unsigned nloc = b.st[0], nx = b.st[1];
        if (nloc == 0u) { xcd_barrier_complete(bar, b.x, nloc, nx); b.st[0] = nloc; b.st[1] = nx; }
        const unsigned old = xb_add(&bar[XB_XSUB(b.x)], 1u);
        const unsigned gen = old / nloc;
        if (old + 1u == (gen + 1u) * nloc) {
            __builtin_amdgcn_fence(__ATOMIC_RELEASE, "agent");
            asm volatile("s_waitcnt vmcnt(0)" ::: "memory");
            const unsigned og = xb_add(&bar[XB_TOP], 1u);
            const unsigned tg = og / nx;
            if (og + 1u == (tg + 1u) * nx) xb_add(&bar[XB_TOPGEN], 1u);
            else XB_SPIN(xb_ld(&bar[XB_TOPGEN]) == tg, bar);
            __builtin_amdgcn_fence(__ATOMIC_ACQUIRE, "agent");
            xb_add(&bar[XB_XGEN(b.x)], 1u);
            asm volatile("s_waitcnt vmcnt(0)" ::: "memory");
        } else {
            XB_SPIN(xb_ld(&bar[XB_XGEN(b.x)]) == gen, bar);
            __builtin_amdgcn_fence(__ATOMIC_ACQUIRE, "agent");
            asm volatile("s_waitcnt vmcnt(0)" ::: "memory");
        }
    }
    __syncthreads();
}


DEV void gsync2(unsigned k) {
  (void)k;
  XcdBarrier b;
  b.bar = (unsigned*)((char*)karg<33>() + OFF_BAR);
  b.x = xb_xcc_id();
  b.st = (volatile LAS unsigned*)xb_words_ptr();
  xcd_barrier(b);
}

DEV void gsync(cg::grid_group& grid) {
  asm volatile("s_waitcnt vmcnt(0)" ::: "memory");
  grid.sync();
  if (threadIdx.x == 0) {
    __builtin_amdgcn_fence(__ATOMIC_ACQUIRE, "agent");
    asm volatile("s_waitcnt vmcnt(0)" ::: "memory");
  }
  __syncthreads();
}

template <int layer>
__device__ __forceinline__ void peer_block(unsigned& nbar, char* lds) {
  {
    Params p = fetch_params();
    char* ws = p.ws; char* R1 = ws + OFF_R1; char* R2 = ws + OFF_R2; char* DO = (char*)p.out;
    const float* modl = (float*)(ws + OFF_MOD) + (size_t)layer * 9 * 6144;
    const u16* A = layer == 0 ? (const u16*)R1 : (const u16*)DO;
    const int K = layer == 0 ? 2048 : 1024;
    const u16* Wt = (const u16*)(ws + (layer == 0 ? OFF_W_OUT : OFF_W_HOUT));
    const float* res = layer == 0 ? p.x : (const float*)R2;
    phase_gemm_resid(A, K, Wt, res, (float*)R2, modl + 2048, lds);
  }
  gsync2(++nbar);
  PROBE_AT(5 + layer * 10, pq.ws + OFF_R2, 1024)
  {
    Params p = fetch_params();
    char* ws = p.ws; char* R1 = ws + OFF_R1; char* R2 = ws + OFF_R2; char* DO = (char*)p.out;
    const float* modl = (float*)(ws + OFF_MOD) + (size_t)layer * 9 * 6144;
    u16* tpeer = layer == 0 ? (u16*)DO : (u16*)(R1 + 128 * MiB);
    phase_ln_mod((float*)R2, p.ln_g + layer * 2048, p.ln_b + layer * 2048, modl, tpeer);
    if (DUP & 128) { gsync2(++nbar); phase_ln_mod((float*)R2, p.ln_g + layer * 2048, p.ln_b + layer * 2048, modl, tpeer); }
    if (layer == 1) {
      unsigned char* tb = (unsigned char*)R1;
      convert_fp8_rows(p.p_u + (size_t)16384 * 1024, tb, (float*)(tb + 32 * MiB), 16384);
      convert_fp8_rows(p.p_v + (size_t)16384 * 1024, tb + 16 * MiB, (float*)(tb + 32 * MiB + 65536), 16384);
    }
  }
  gsync2(++nbar);
  {
    Params p = fetch_params();
    char* ws = p.ws; char* R1 = ws + OFF_R1; char* DO = (char*)p.out;
    u16* tpeer = layer == 0 ? (u16*)DO : (u16*)(R1 + 128 * MiB);
    phase_gemm_bf16(tpeer, (const u16*)(ws + OFF_W_Q) + (size_t)layer * 2048 * 1024, layer == 0 ? (u16*)R1 : (u16*)DO, 2048, lds);
  }
  gsync2(++nbar);
  PROBE_AT(7 + layer * 10, pq.ws + OFF_R1, 1024)
  {
    Params p = fetch_params();
    char* ws = p.ws; char* R1 = ws + OFF_R1; char* R2 = ws + OFF_R2;
    int* idxb = (int*)(R2 + 128 * MiB);
    float* gateb = (float*)(R2 + 144 * MiB);
    const u16* kbf = (const u16*)(ws + OFF_KEYS);
    phase_peer_topk(layer == 0 ? (const u16*)R1 : (const u16*)p.out, kbf + (size_t)layer * 131072, kbf + 262144 + (size_t)layer * 131072, idxb, gateb, lds);
    if (DUP & 4) { __syncthreads(); phase_peer_topk(layer == 0 ? (const u16*)R1 : (const u16*)p.out, kbf + (size_t)layer * 131072, kbf + 262144 + (size_t)layer * 131072, idxb, gateb, lds); }
  }
  gsync2(++nbar);
  {
    Params p = fetch_params();
    char* ws = p.ws; char* R1 = ws + OFF_R1; char* R2 = ws + OFF_R2; char* DO = (char*)p.out;
    float* mod = (float*)(ws + OFF_MOD);
    const float* modl = mod + (size_t)layer * 9 * 6144;
    int* idxb = (int*)(R2 + 128 * MiB);
    float* gateb = (float*)(R2 + 144 * MiB);
    u16* tpeer = layer == 0 ? (u16*)DO : (u16*)(R1 + 128 * MiB);
    const unsigned char* tb8 = (const unsigned char*)(layer == 0 ? ws + OFF_TAB0 : R1);
    phase_peer_gather(tpeer, idxb, gateb, tb8, tb8 + 16 * MiB, (const float*)(tb8 + 32 * MiB), (const float*)(tb8 + 32 * MiB + 65536), (const float*)R2,
                      modl + 5120, p.ln_g + layer * 2048 + 1024, p.ln_b + layer * 2048 + 1024, layer == 0 ? (float*)R2 : p.out,
                      layer == 0 ? mod + 9 * 6144 : nullptr, (u16*)(DO + 64 * MiB));
  }
}

__global__ void __launch_bounds__(256, 2) fwd_megakernel(Params p_unused) {
  __shared__ __attribute__((aligned(16))) char lds[LDS_BYTES];
  cg::grid_group grid = cg::this_grid();
  unsigned nbar = 0;
  if (threadIdx.x == 0) *xb_words_ptr() = make_uint4(0u, 0u, 0u, 0u);
  __syncthreads();
  (void)xcd_barrier_post((unsigned*)((char*)karg<33>() + OFF_BAR), (volatile LAS unsigned*)xb_words_ptr());
  { Params p = fetch_params(); phase_prologue(p, lds); }
  if (DUP & 64) { __syncthreads(); Params p = fetch_params(); phase_prologue(p, lds); }
  gsync(grid);
  if (DUP & 4096) {
#pragma unroll 1
    for (int r = 0; r < 20; ++r) gsync2(++nbar);
  }
  {
    Params p = fetch_params();
    float* mod = (float*)(p.ws + OFF_MOD);
    modulate_rows(p.x, (u16*)(p.ws + OFF_R2), NT, SEQ, mod, 0, 1024, false);
    modulate_rows(p.ctx, (u16*)(p.ws + OFF_HC), NTC, CTXL, mod, 0, 1024, true);
  }
  gsync2(++nbar);
  { Params p = fetch_params(); phase_gemm_inproj(p, lds); }
  if (DUP & 2) { gsync2(++nbar); Params p = fetch_params(); phase_gemm_inproj(p, lds); }
  gsync2(++nbar);
  PROBE_AT(1, pq.ws + OFF_R1, 1536)
  { Params p = fetch_params(); phase_conv(p); }
  if (DUP & 16) { gsync2(++nbar); Params p = fetch_params(); phase_conv(p); }
  gsync2(++nbar);
  PROBE_AT(2, pq.ws + OFF_R2, 1536)
  { Params p = fetch_params(); phase_ssd(p, lds); }
  if (DUP & 1) { gsync2(++nbar); Params p = fetch_params(); phase_ssd(p, lds); }
  gsync2(++nbar);
  PROBE_AT(3, pq.ws + OFF_R1, 1024)
  {
    Params p = fetch_params(); phase_gated_norm(p);
    unsigned char* tb = (unsigned char*)(p.ws + OFF_TAB0);
    convert_fp8_rows(p.p_u, tb, (float*)(tb + 32 * MiB), 16384);
    convert_fp8_rows(p.p_v, tb + 16 * MiB, (float*)(tb + 32 * MiB + 65536), 16384);
    if (DUP & 2048) {
      convert_fp8_rows(p.p_u, tb, (float*)(tb + 32 * MiB), 16384);
      convert_fp8_rows(p.p_v, tb + 16 * MiB, (float*)(tb + 32 * MiB + 65536), 16384);
    }
  }
  gsync2(++nbar);
  PROBE_AT(4, pq.ws + OFF_R1, 1024)
  peer_block<0>(nbar, lds);
  if ((PROBE >= 5 && PROBE <= 7) || PROBE == 99) return;
  gsync2(++nbar);
  {
    Params p = fetch_params();
    phase_gemm_bf16((const u16*)((char*)p.out + 64 * MiB), (const u16*)(p.ws + OFF_W_HIN), (u16*)(p.ws + OFF_R1), 3072, lds);
  }
  gsync2(++nbar);
  PROBE_AT(8, pq.ws + OFF_R2, 1024)
  PROBE_AT(11, pq.ws + OFF_R1, 1536)
  {
    Params p = fetch_params();
    phase_shortconv_T(p, (const u16*)(p.ws + OFF_R1), (u16*)(p.ws + OFF_R2 + 128 * MiB), (u16*)p.out, (u16*)((char*)p.out + 64 * MiB), lds);
    if (DUP & 256) { __syncthreads(); phase_shortconv_T(p, (const u16*)(p.ws + OFF_R1), (u16*)(p.ws + OFF_R2 + 128 * MiB), (u16*)p.out, (u16*)((char*)p.out + 64 * MiB), lds); }
  }
  gsync2(++nbar);
  PROBE_AT(12, pq.ws + OFF_R2 + 128 * MiB, 512)
  { Params p = fetch_params(); phase_filter_fft(p, (float2*)(p.ws + OFF_R1), lds); }
  if (DUP & 32) { gsync2(++nbar); Params p = fetch_params(); phase_filter_fft(p, (float2*)(p.ws + OFF_R1), lds); }
  gsync2(++nbar);
  PROBE_AT(13, pq.ws + OFF_R1, 1024)
  {
    Params p = fetch_params();
    phase_hyena_conv(p, (const u16*)(p.ws + OFF_R2 + 128 * MiB), (const u16*)p.out, (const u16*)((char*)p.out + 64 * MiB),
                     (const float2*)(p.ws + OFF_R1), (u16*)(p.ws + OFF_R1 + 128 * MiB), lds);
  }
  if (DUP & 8) {
    gsync2(++nbar);
    Params p = fetch_params();
    phase_hyena_conv(p, (const u16*)(p.ws + OFF_R2 + 128 * MiB), (const u16*)p.out, (const u16*)((char*)p.out + 64 * MiB),
                     (const float2*)(p.ws + OFF_R1), (u16*)(p.ws + OFF_R1 + 128 * MiB), lds);
  }
  gsync2(++nbar);
  PROBE_AT(14, pq.ws + OFF_R1 + 128 * MiB, 512)
  { Params p = fetch_params(); phase_transpose_back((const u16*)(p.ws + OFF_R1 + 128 * MiB), (u16*)p.out, lds); }
  gsync2(++nbar);
  peer_block<1>(nbar, lds);
}

extern "C" void kernel_launch(void* const* d_in, const int* in_sizes, int n_in, void* d_out, int out_size, void* d_ws, size_t ws_size,
                              hipStream_t stream) {
  static int grid_blocks = 0;
  if (!grid_blocks) {
    int dev = 0, cus = 0, per_cu = 0;
    hipGetDevice(&dev);
    hipDeviceGetAttribute(&cus, hipDeviceAttributeMultiprocessorCount, dev);
    hipOccupancyMaxActiveBlocksPerMultiprocessor(&per_cu, fwd_megakernel, 256, 0);
    if (per_cu > 2) per_cu = 2;
    if (per_cu < 1) per_cu = 1;
    grid_blocks = cus * per_cu;
  }
  Params p{};
  const float** pp = reinterpret_cast<const float**>(&p);
  for (int i = 0; i < 32; ++i) pp[i] = (const float*)d_in[i];
  p.out = (float*)d_out;
  p.ws = (char*)d_ws;
  if (ws_size < WS_TOTAL) fprintf(stderr, "workspace too small: %zu < %zu\n", ws_size, (size_t)WS_TOTAL);
  (void)hipMemsetAsync((char*)d_ws + OFF_BAR, 0, 16384, stream);
  void* args[] = {&p};
  hipError_t e = hipLaunchCooperativeKernel((void*)fwd_megakernel, dim3(grid_blocks), dim3(256), args, 0, stream);
  if (e != hipSuccess) fprintf(stderr, "cooperative launch failed: %s (grid %d)\n", hipGetErrorString(e), grid_blocks);
}
```

```cpp
#define PROBE 0
#define DUP 0
#include <hip/hip_runtime.h>
#include <hip/hip_bf16.h>
#include <hip/hip_cooperative_groups.h>
#include <cstdio>
namespace cg = cooperative_groups;

typedef unsigned short u16;
using bf16x8 = __attribute__((ext_vector_type(8))) short;
using f32x4 = __attribute__((ext_vector_type(4))) float;
using u32x4 = __attribute__((ext_vector_type(4))) unsigned;
typedef float f32x2 __attribute__((ext_vector_type(2)));

#define DEV __device__ __forceinline__

constexpr int NB = 8, SEQ = 4096, DM = 1024, NT = NB * SEQ;
constexpr int CTXL = 256, NTC = NB * CTXL;
constexpr int SSM_IN = 5184, CONVD = 3072, SSM_INNER = 2048;
constexpr float ALPHA = 1.41421356237f;
constexpr int LDS_BYTES = 71168;

constexpr size_t MiB = 1ull << 20;
constexpr size_t OFF_W_IN = 0;
constexpr size_t OFF_W_OUT = OFF_W_IN + (size_t)5184 * 1024 * 2;
constexpr size_t OFF_W_HIN = OFF_W_OUT + (size_t)1024 * 2048 * 2;
constexpr size_t OFF_W_HOUT = OFF_W_HIN + (size_t)3072 * 1024 * 2;
constexpr size_t OFF_W_Q = OFF_W_HOUT + (size_t)1024 * 1024 * 2;
constexpr size_t OFF_MOD = OFF_W_Q + (size_t)2 * 2048 * 1024 * 2;
constexpr size_t OFF_HID = OFF_MOD + 512 * 1024;
constexpr size_t OFF_DT = OFF_HID + MiB;
constexpr size_t OFF_HC = OFF_DT + 8 * MiB;
constexpr size_t OFF_XBC_C = OFF_HC + 4 * MiB;
constexpr size_t OFF_XC_C = OFF_XBC_C + 12 * MiB;
constexpr size_t OFF_DT_C = OFF_XC_C + 12 * MiB;
constexpr size_t OFF_R1 = OFF_DT_C + MiB;
constexpr size_t OFF_R2 = OFF_R1 + 192 * MiB;
constexpr size_t OFF_BAR = OFF_R2 + 192 * MiB;
constexpr size_t OFF_KEYS = OFF_BAR + 16384;
constexpr size_t OFF_TW = OFF_KEYS + MiB;
constexpr size_t OFF_TAB0 = OFF_TW + 32768;
constexpr size_t WS_TOTAL = OFF_TAB0 + 33 * MiB;

struct Params {
  const float *x, *c, *ctx, *c_ctx, *ada_w, *ada_b, *ln_g, *ln_b;
  const float *m_w_in, *m_conv_w, *m_conv_b, *m_a_log, *m_dt_bias, *m_d, *m_norm_w, *m_w_out;
  const float *h_w_in, *h_conv_w, *h_conv_b, *h_f_w1, *h_f_b1, *h_f_w2, *h_f_b2, *h_f_w3, *h_freq, *h_bias, *h_w_out;
  const float *p_wq, *p_k1, *p_k2, *p_u, *p_v;
  float* out;
  char* ws;
};

DEV u16 f2bf(float f) {
  unsigned u = __float_as_uint(f);
  u += 0x7fffu + ((u >> 16) & 1u);
  return (u16)(u >> 16);
}
DEV float bf2f(u16 h) { return __uint_as_float(((unsigned)h) << 16); }
DEV float bflo(unsigned w) { return __uint_as_float(w << 16); }
DEV float bfhi(unsigned w) { return __uint_as_float(w & 0xffff0000u); }
DEV unsigned pack2(float a, float b) { return (unsigned)f2bf(a) | ((unsigned)f2bf(b) << 16); }
DEV float wave_sum(float v) {
#pragma unroll
  for (int o = 32; o > 0; o >>= 1) v += __shfl_xor(v, o);
  return v;
}
DEV int otid() { int t = threadIdx.x; asm volatile("" : "+v"(t)); return t; }
DEV unsigned ordkey(float f) { unsigned u = __float_as_uint(f); return (u & 0x80000000u) ? ~u : (u | 0x80000000u); }
DEV float siluf(float v) { return v / (1.f + __expf(-v)); }
DEV f32x4 mfma16(bf16x8 a, bf16x8 b, f32x4 c) { return __builtin_amdgcn_mfma_f32_16x16x32_bf16(a, b, c, 0, 0, 0); }
DEV bf16x8 ld8(const u16* p) { return *reinterpret_cast<const bf16x8*>(p); }

template <int I>
DEV const float* karg() {
  unsigned long long v;
  asm volatile("s_load_dwordx2 %0, %1, %2\n\ts_waitcnt lgkmcnt(0)" : "=s"(v) : "s"(__builtin_amdgcn_kernarg_segment_ptr()), "n"(I * 8));
  return (const float*)(const __attribute__((address_space(1))) float*)v;
}
DEV Params fetch_params() {
  Params q;
  q.x = karg<0>(); q.c = karg<1>(); q.ctx = karg<2>(); q.c_ctx = karg<3>(); q.ada_w = karg<4>(); q.ada_b = karg<5>(); q.ln_g = karg<6>(); q.ln_b = karg<7>();
  q.m_w_in = karg<8>(); q.m_conv_w = karg<9>(); q.m_conv_b = karg<10>(); q.m_a_log = karg<11>(); q.m_dt_bias = karg<12>(); q.m_d = karg<13>();
  q.m_norm_w = karg<14>(); q.m_w_out = karg<15>();
  q.h_w_in = karg<16>(); q.h_conv_w = karg<17>(); q.h_conv_b = karg<18>(); q.h_f_w1 = karg<19>(); q.h_f_b1 = karg<20>(); q.h_f_w2 = karg<21>();
  q.h_f_b2 = karg<22>(); q.h_f_w3 = karg<23>(); q.h_freq = karg<24>(); q.h_bias = karg<25>(); q.h_w_out = karg<26>();
  q.p_wq = karg<27>(); q.p_k1 = karg<28>(); q.p_k2 = karg<29>(); q.p_u = karg<30>(); q.p_v = karg<31>();
  q.out = (float*)karg<32>(); q.ws = (char*)karg<33>();
  return q;
}

__device__ __forceinline__ void transpose_w_tile(const float* src, int srcld, int K, int N, u16* dst, int item, char* lds) {
  float* tile = (float*)lds;
  int ntn = N / 64;
  int kt = item / ntn, nt = item % ntn;
  int tid = otid();
#pragma unroll
  for (int i = 0; i < 4; ++i) {
    int r = (tid >> 4) + i * 16, c4 = (tid & 15) * 4;
    float4 v = *reinterpret_cast<const float4*>(src + (size_t)(kt * 64 + r) * srcld + nt * 64 + c4);
    tile[r * 65 + c4 + 0] = v.x; tile[r * 65 + c4 + 1] = v.y; tile[r * 65 + c4 + 2] = v.z; tile[r * 65 + c4 + 3] = v.w;
  }
  __syncthreads();
#pragma unroll
  for (int i = 0; i < 2; ++i) {
    int n = (tid >> 3) + i * 32, k8 = (tid & 7) * 8;
    uint4 o;
    o.x = pack2(tile[(k8 + 0) * 65 + n], tile[(k8 + 1) * 65 + n]);
    o.y = pack2(tile[(k8 + 2) * 65 + n], tile[(k8 + 3) * 65 + n]);
    o.z = pack2(tile[(k8 + 4) * 65 + n], tile[(k8 + 5) * 65 + n]);
    o.w = pack2(tile[(k8 + 6) * 65 + n], tile[(k8 + 7) * 65 + n]);
    *reinterpret_cast<uint4*>(dst + (size_t)(nt * 64 + n) * K + kt * 64 + k8) = o;
  }
  __syncthreads();
}

__device__ __forceinline__ void ada_item(const Params& p, int item, char* lds) {
  float* sl = (float*)lds;
  float* red = sl + 9 * 1024;
  int layer = item / 96, cg_ = item % 96;
  int tid = otid(), kq = tid >> 6, col = cg_ * 64 + (tid & 63);
  for (int e = tid; e < 9 * 1024; e += 256) {
    int r = e >> 10, k = e & 1023;
    sl[e] = siluf(r < 8 ? p.c[r * 1024 + k] : p.c_ctx[k]);
  }
  __syncthreads();
  float acc[9];
#pragma unroll
  for (int r = 0; r < 9; ++r) acc[r] = 0.f;
  const float* w = p.ada_w + (size_t)layer * 1024 * 6144 + col;
#pragma unroll 8
  for (int k = kq * 256; k < kq * 256 + 256; ++k) {
    float wv = w[(size_t)k * 6144];
#pragma unroll
    for (int r = 0; r < 9; ++r) acc[r] += sl[r * 1024 + k] * wv;
  }
#pragma unroll
  for (int r = 0; r < 9; ++r) red[(kq * 9 + r) * 64 + (tid & 63)] = acc[r];
  __syncthreads();
  if (tid < 64) {
    float* mod = (float*)(p.ws + OFF_MOD);
    float bias = p.ada_b[layer * 6144 + col];
#pragma unroll
    for (int r = 0; r < 9; ++r) {
      float s = red[(0 * 9 + r) * 64 + tid] + red[(1 * 9 + r) * 64 + tid] + red[(2 * 9 + r) * 64 + tid] + red[(3 * 9 + r) * 64 + tid];
      mod[((size_t)layer * 9 + r) * 6144 + col] = s + bias;
    }
  }
  __syncthreads();
}

__device__ __forceinline__ void hyena_mlp_item(const Params& p, int item, char* lds) {
  float* zb = (float*)lds;
  float* h1 = zb + 256;
  float* h2 = h1 + 256;
  int tid = otid(), ti = tid >> 6, j = tid & 63;
  int t = item * 4 + ti;
  const float L = 4096.f;
  if (j < 33) {
    float v;
    if (j == 0) v = (float)t / 4095.f;
    else {
      int k = (j - 1) & 15;
      float fb = 1e-4f + (float)k * ((15.f - 1e-4f) / 15.f);
      float ang = 6.283185307179586f * (float)t / L;
      float a = fb * ang;
      v = (j <= 16) ? cosf(a) : -sinf(a);
    }
    zb[ti * 64 + j] = v;
  }
  __syncthreads();
  float fr = p.h_freq[j];
  float s = p.h_f_b1[j];
#pragma unroll 3
  for (int i = 0; i < 33; ++i) s += zb[ti * 64 + i] * p.h_f_w1[i * 64 + j];
  h1[ti * 64 + j] = sinf(fr * s);
  __syncthreads();
  s = p.h_f_b2[j];
#pragma unroll 8
  for (int i = 0; i < 64; ++i) s += h1[ti * 64 + i] * p.h_f_w2[i * 64 + j];
  h2[ti * 64 + j] = sinf(fr * s);
  __syncthreads();
  s = p.h_f_b2[64 + j];
#pragma unroll 8
  for (int i = 0; i < 64; ++i) s += h2[ti * 64 + i] * p.h_f_w2[4096 + i * 64 + j];
  float* hid = (float*)(p.ws + OFF_HID);
  hid[t * 64 + j] = sinf(fr * s);
  __syncthreads();
}

__device__ __forceinline__ void phase_prologue(const Params& p, char* lds) {
  constexpr int T0 = 1296, T1 = T0 + 512, T2 = T1 + 768, T3 = T2 + 256, T4 = T3 + 512, T5 = T4 + 512, T6 = T5 + 192, T7 = T6 + 1024, T8 = T7 + 256, T9 = T8 + 16;
  for (int item = blockIdx.x; item < T9; item += gridDim.x) {
    if (item < T0) transpose_w_tile(p.m_w_in, SSM_IN, 1024, SSM_IN, (u16*)(p.ws + OFF_W_IN), item, lds);
    else if (item < T1) transpose_w_tile(p.m_w_out, 1024, 2048, 1024, (u16*)(p.ws + OFF_W_OUT), item - T0, lds);
    else if (item < T2) transpose_w_tile(p.h_w_in, 3072, 1024, 3072, (u16*)(p.ws + OFF_W_HIN), item - T1, lds);
    else if (item < T3) transpose_w_tile(p.h_w_out, 1024, 1024, 1024, (u16*)(p.ws + OFF_W_HOUT), item - T2, lds);
    else if (item < T4) transpose_w_tile(p.p_wq, 2048, 1024, 2048, (u16*)(p.ws + OFF_W_Q), item - T3, lds);
    else if (item < T5) transpose_w_tile(p.p_wq + (size_t)1024 * 2048, 2048, 1024, 2048, (u16*)(p.ws + OFF_W_Q) + (size_t)2048 * 1024, item - T4, lds);
    else if (item < T6) ada_item(p, item - T5, lds);
    else if (item < T7) hyena_mlp_item(p, item - T6, lds);
    else if (item >= T8) {
      int k = (item - T8) * 256 + threadIdx.x;
      float sn, cs;
      sincospif((float)k * (1.f / 4096.f), &sn, &cs);
      ((float2*)(p.ws + OFF_TW))[k] = make_float2(cs, -sn);
    } else {
      int e8 = ((item - T7) * 256 + threadIdx.x) * 8;
      const float* src = e8 < 262144 ? p.p_k1 + e8 : p.p_k2 + (e8 - 262144);
      float4 a0 = *reinterpret_cast<const float4*>(src), a1 = *reinterpret_cast<const float4*>(src + 4);
      uint4 o;
      o.x = pack2(a0.x, a0.y); o.y = pack2(a0.z, a0.w); o.z = pack2(a1.x, a1.y); o.w = pack2(a1.z, a1.w);
      *reinterpret_cast<uint4*>((u16*)(p.ws + OFF_KEYS) + e8) = o;
    }
  }
}

__device__ __forceinline__ void modulate_rows(const float* src, u16* dst, int nrows, int rows_per_batch, const float* modbase, int sh_off, int sc_off, bool ctxrow) {
  size_t total = (size_t)nrows * 128;
  for (size_t e = (size_t)blockIdx.x * 256 + threadIdx.x; e < total; e += (size_t)gridDim.x * 256) {
    int row = (int)(e >> 7), c8 = (int)(e & 127) * 8;
    int b = ctxrow ? 8 : row / rows_per_batch;
    const float* m = modbase + (size_t)b * 6144;
    float4 a0 = *reinterpret_cast<const float4*>(src + (size_t)row * 1024 + c8);
    float4 a1 = *reinterpret_cast<const float4*>(src + (size_t)row * 1024 + c8 + 4);
    float4 s0 = *reinterpret_cast<const float4*>(m + sc_off + c8);
    float4 s1 = *reinterpret_cast<const float4*>(m + sc_off + c8 + 4);
    float4 h0 = *reinterpret_cast<const float4*>(m + sh_off + c8);
    float4 h1 = *reinterpret_cast<const float4*>(m + sh_off + c8 + 4);
    uint4 o;
    o.x = pack2(a0.x * (1.f + s0.x) + h0.x, a0.y * (1.f + s0.y) + h0.y);
    o.y = pack2(a0.z * (1.f + s0.z) + h0.z, a0.w * (1.f + s0.w) + h0.w);
    o.z = pack2(a1.x * (1.f + s1.x) + h1.x, a1.y * (1.f + s1.y) + h1.y);
    o.w = pack2(a1.z * (1.f + s1.z) + h1.z, a1.w * (1.f + s1.w) + h1.w);
    *reinterpret_cast<uint4*>(dst + (size_t)row * 1024 + c8) = o;
  }
}

constexpr int GLD = 72;
template <class Epi>
__device__ __forceinline__ void gemm_tile(const u16* __restrict__ A, int lda, const u16* __restrict__ Bt, int ldb, int brow, int bcol, int Nmax,
                                          int K, char* lds, Epi epi) {
  u16* SA = (u16*)lds;
  u16* SB = SA + 256 * GLD;
  int tid = otid(), wid = tid >> 6, lane = tid & 63, wr = wid >> 1, wc = wid & 1, fr = lane & 15, fq = lane >> 4;
  f32x4 acc[8][4];
#pragma unroll
  for (int m = 0; m < 8; ++m)
#pragma unroll
    for (int n = 0; n < 4; ++n) acc[m][n] = f32x4{0.f, 0.f, 0.f, 0.f};
  u32x4 ra[8], rb[4];
  const int lr = tid >> 3, lc = (tid & 7) * 8;
  const u16* abase = A + (size_t)brow * lda;
  const unsigned aoff = (unsigned)(lr * lda + lc);
  unsigned bo[4];
#pragma unroll
  for (int i = 0; i < 4; ++i) {
    int br = bcol + lr + i * 32;
    if (br >= Nmax) br = Nmax - 1;
    bo[i] = (unsigned)(br * ldb + lc);
  }
#define GLOADT(KT)                                                                                 \
  _Pragma("unroll") for (int i = 0; i < 8; ++i)                                                    \
    ra[i] = *reinterpret_cast<const u32x4*>(abase + (aoff + (unsigned)((i * 32) * lda + (KT) * 64))); \
  _Pragma("unroll") for (int i = 0; i < 4; ++i)                                                    \
    rb[i] = *reinterpret_cast<const u32x4*>(Bt + (bo[i] + (unsigned)((KT) * 64)));
  const int nk = K / 64;
  GLOADT(0)
  for (int kt = 0; kt < nk; ++kt) {
#pragma unroll
    for (int i = 0; i < 8; ++i) *reinterpret_cast<u32x4*>(SA + (lr + i * 32) * GLD + lc) = ra[i];
#pragma unroll
    for (int i = 0; i < 4; ++i) *reinterpret_cast<u32x4*>(SB + (lr + i * 32) * GLD + lc) = rb[i];
    __syncthreads();
    { const int kn = kt + 1 < nk ? kt + 1 : nk - 1; GLOADT(kn) }
#pragma unroll
    for (int kk = 0; kk < 2; ++kk) {
      bf16x8 Bl[4];
#pragma unroll
      for (int n = 0; n < 4; ++n) Bl[n] = ld8(SB + (wc * 64 + n * 16 + fr) * GLD + kk * 32 + fq * 8);
#pragma unroll
      for (int mh = 0; mh < 2; ++mh) {
        bf16x8 At[4];
#pragma unroll
        for (int m = 0; m < 4; ++m) At[m] = ld8(SA + (wr * 128 + (mh * 4 + m) * 16 + fr) * GLD + kk * 32 + fq * 8);
#pragma unroll
        for (int m = 0; m < 4; ++m)
#pragma unroll
          for (int n = 0; n < 4; ++n) acc[mh * 4 + m][n] = mfma16(Bl[n], At[m], acc[mh * 4 + m][n]);
      }
    }
    __syncthreads();
  }
#undef GLOADT
#pragma unroll
  for (int m = 0; m < 8; ++m)
#pragma unroll
    for (int n = 0; n < 4; ++n) epi(brow + wr * 128 + m * 16 + fr, bcol + wc * 64 + n * 16 + fq * 4, acc[m][n]);
}

DEV float softplusf(float v) { return fmaxf(v, 0.f) + log1pf(__expf(-fabsf(v))); }

__device__ __forceinline__ void phase_gemm_inproj(const Params& p, char* lds) {
  const u16* hx = (const u16*)(p.ws + OFF_R2);
  const u16* hc = (const u16*)(p.ws + OFF_HC);
  const u16* Wt = (const u16*)(p.ws + OFF_W_IN);
  u16* zbuf = (u16*)p.out;
  u16* xbc = (u16*)(p.ws + OFF_R1);
  float* dt = (float*)(p.ws + OFF_DT);
  u16* xbc_c = (u16*)(p.ws + OFF_XBC_C);
  float* dt_c = (float*)(p.ws + OFF_DT_C);
  const float* dtb = p.m_dt_bias;
  const int xcd = blockIdx.x & 7, li = blockIdx.x >> 3, nl = gridDim.x >> 3;
  auto epi_lat = [=](int m, int n, f32x4 v) {
    if (n < 2048) *reinterpret_cast<uint2*>(zbuf + (size_t)m * 2048 + n) = make_uint2(pack2(v[0], v[1]), pack2(v[2], v[3]));
    else if (n < 5120) *reinterpret_cast<uint2*>(xbc + (size_t)m * 3072 + (n - 2048)) = make_uint2(pack2(v[0], v[1]), pack2(v[2], v[3]));
    else if (n < 5184) {
      float4 bb = *reinterpret_cast<const float4*>(dtb + (n - 5120));
      *reinterpret_cast<float4*>(dt + (size_t)m * 64 + (n - 5120)) = make_float4(softplusf(v[0] + bb.x), softplusf(v[1] + bb.y), softplusf(v[2] + bb.z), softplusf(v[3] + bb.w));
    }
  };
  auto epi_ctx = [=](int m, int n, f32x4 v) {
    if (n < 3072) *reinterpret_cast<uint2*>(xbc_c + (size_t)m * 3072 + n) = make_uint2(pack2(v[0], v[1]), pack2(v[2], v[3]));
    else if (n < 3136) {
      float4 bb = *reinterpret_cast<const float4*>(dtb + (n - 3072));
      *reinterpret_cast<float4*>(dt_c + (size_t)m * 64 + (n - 3072)) = make_float4(softplusf(v[0] + bb.x), softplusf(v[1] + bb.y), softplusf(v[2] + bb.z), softplusf(v[3] + bb.w));
    }
  };
  for (int t = li; t < 128 * 5; t += nl) {
    int pm = t / 5, pn = xcd + 8 * (t % 5);
    gemm_tile(hx, 1024, Wt, 1024, pm * 256, pn * 128, SSM_IN, 1024, lds, epi_lat);
  }
  for (int t = blockIdx.x; t < 128 + 8 * 25; t += gridDim.x) {
    if (t < 128) gemm_tile(hx, 1024, Wt, 1024, t * 256, 40 * 128, SSM_IN, 1024, lds, epi_lat);
    else {
      int it = t - 128, pm = it / 25, pn = it % 25;
      gemm_tile(hc, 1024, Wt + (size_t)2048 * 1024, 1024, pm * 256, pn * 128, 3136, 1024, lds, epi_ctx);
    }
  }
}

DEV void fma8(float* acc, const u32x4& v, const float* w) {
  acc[0] += bflo(v[0]) * w[0]; acc[1] += bfhi(v[0]) * w[1]; acc[2] += bflo(v[1]) * w[2]; acc[3] += bfhi(v[1]) * w[3];
  acc[4] += bflo(v[2]) * w[4]; acc[5] += bfhi(v[2]) * w[5]; acc[6] += bflo(v[3]) * w[6]; acc[7] += bfhi(v[3]) * w[7];
}
__device__ __forceinline__ void phase_conv(const Params& p) {
  const u16* xbc = (const u16*)(p.ws + OFF_R1);
  u16* xc = (u16*)(p.ws + OFF_R2);
  const u16* xbc_c = (const u16*)(p.ws + OFF_XBC_C);
  u16* xc_c = (u16*)(p.ws + OFF_XC_C);
  const float* cw = p.m_conv_w;
  const float* cb = p.m_conv_b;
  const int tid_ = otid();
  const size_t nl = (size_t)8 * 64 * 8 * 384;
  for (size_t e = (size_t)blockIdx.x * 256 + tid_; e < nl; e += (size_t)gridDim.x * 256) {
    int ch = (int)(e % 384) * 8;
    int rest = (int)(e / 384);
    int cg_ = rest & 7, r = (rest >> 3) & 63, b = rest >> 9;
    float w[9][8];
#pragma unroll
    for (int k = 0; k < 9; ++k) {
      float4 w0 = *reinterpret_cast<const float4*>(cw + k * 3072 + ch), w1 = *reinterpret_cast<const float4*>(cw + k * 3072 + ch + 4);
      w[k][0] = w0.x; w[k][1] = w0.y; w[k][2] = w0.z; w[k][3] = w0.w; w[k][4] = w1.x; w[k][5] = w1.y; w[k][6] = w1.z; w[k][7] = w1.w;
    }
    float bias[8];
    {
      float4 b0 = *reinterpret_cast<const float4*>(cb + ch), b1 = *reinterpret_cast<const float4*>(cb + ch + 4);
      bias[0] = b0.x; bias[1] = b0.y; bias[2] = b0.z; bias[3] = b0.w; bias[4] = b1.x; bias[5] = b1.y; bias[6] = b1.z; bias[7] = b1.w;
    }
    const u32x4 zero4 = u32x4{0u, 0u, 0u, 0u};
    const int c0 = cg_ * 8;
    u32x4 win[3][3];
#pragma unroll
    for (int i = 0; i < 3; ++i) {
      int rr = r + i - 1;
      bool rok = rr >= 0 && rr <= 63;
      const u16* rowp = xbc + ((size_t)(b * 4096 + (rok ? rr : r) * 64)) * 3072 + ch;
      win[i][0] = (rok && c0 > 0) ? *reinterpret_cast<const u32x4*>(rowp + (size_t)(c0 - 1) * 3072) : zero4;
      win[i][1] = rok ? *reinterpret_cast<const u32x4*>(rowp + (size_t)c0 * 3072) : zero4;
    }
#pragma unroll
    for (int cc = 0; cc < 8; ++cc) {
      int c = c0 + cc;
#pragma unroll
      for (int i = 0; i < 3; ++i) {
        int rr = r + i - 1;
        bool rok = rr >= 0 && rr <= 63;
        const u16* rowp = xbc + ((size_t)(b * 4096 + (rok ? rr : r) * 64)) * 3072 + ch;
        win[i][2] = (rok && c < 63) ? *reinterpret_cast<const u32x4*>(rowp + (size_t)(c + 1) * 3072) : zero4;
      }
      float acc[8];
#pragma unroll
      for (int k = 0; k < 8; ++k) acc[k] = bias[k];
#pragma unroll
      for (int i = 0; i < 3; ++i)
#pragma unroll
        for (int j = 0; j < 3; ++j) fma8(acc, win[i][j], w[i * 3 + j]);
      uint4 o;
      o.x = pack2(siluf(acc[0]), siluf(acc[1]));
      o.y = pack2(siluf(acc[2]), siluf(acc[3]));
      o.z = pack2(siluf(acc[4]), siluf(acc[5]));
      o.w = pack2(siluf(acc[6]), siluf(acc[7]));
      *reinterpret_cast<uint4*>(xc + ((size_t)(b * 4096 + r * 64 + c)) * 3072 + ch) = o;
#pragma unroll
      for (int i = 0; i < 3; ++i) { win[i][0] = win[i][1]; win[i][1] = win[i][2]; }
    }
  }
  const size_t ncx = (size_t)NTC * 384;
  for (size_t e = (size_t)blockIdx.x * 256 + tid_; e < ncx; e += (size_t)gridDim.x * 256) {
    int tok = (int)(e / 384), ch = (int)(e % 384) * 8;
    float acc[8];
#pragma unroll
    for (int k = 0; k < 8; ++k) acc[k] = cb[ch + k];
    int b = tok >> 8, c = tok & 255;
#pragma unroll
    for (int j = 0; j < 3; ++j) {
      int cc = c + j - 1;
      if (cc < 0 || cc > 255) continue;
      uint4 v = *reinterpret_cast<const uint4*>(xbc_c + ((size_t)(b * 256 + cc)) * 3072 + ch);
      const float* w = cw + (3 + j) * 3072 + ch;
      float4 w0 = *reinterpret_cast<const float4*>(w), w1 = *reinterpret_cast<const float4*>(w + 4);
      acc[0] += bflo(v.x) * w0.x; acc[1] += bfhi(v.x) * w0.y; acc[2] += bflo(v.y) * w0.z; acc[3] += bfhi(v.y) * w0.w;
      acc[4] += bflo(v.z) * w1.x; acc[5] += bfhi(v.z) * w1.y; acc[6] += bflo(v.w) * w1.z; acc[7] += bfhi(v.w) * w1.w;
    }
    uint4 o;
    o.x = pack2(siluf(acc[0]), siluf(acc[1]));
    o.y = pack2(siluf(acc[2]), siluf(acc[3]));
    o.z = pack2(siluf(acc[4]), siluf(acc[5]));
    o.w = pack2(siluf(acc[6]), siluf(acc[7]));
    *reinterpret_cast<uint4*>(xc_c + (size_t)tok * 3072 + ch) = o;
  }
}

constexpr int SLD = 136;
__device__ __forceinline__ void phase_ssd(const Params& p, char* lds) {
  u16* xsT = (u16*)lds;
  u16* stb = xsT + 64 * SLD;
  u16* Mb = stb + 64 * SLD;
  float* cum = (float*)(Mb + 128 * SLD);
  float* dtv = cum + 128;
  float* asrc = dtv + 128;
  const u16* xc = (const u16*)(p.ws + OFF_R2);
  const u16* xc_c = (const u16*)(p.ws + OFF_XC_C);
  const float* dt = (const float*)(p.ws + OFF_DT);
  const float* dt_c = (const float*)(p.ws + OFF_DT_C);
  u16* y = (u16*)(p.ws + OFF_R1);
  int tid = otid(), w = tid >> 6, lane = tid & 63, fr = lane & 15, fq = lane >> 4;
  unsigned char* yb8 = (unsigned char*)(p.ws + OFF_R1 + 128 * MiB);
  for (int item = blockIdx.x; item < 512; item += gridDim.x) {
    int b = item >> 6, h = (item >> 1) & 31, g = h >> 3;
    float dsk = p.m_d[h];
    {
      const int dir = item & 1;
      float a_neg = -__expf(p.m_a_log[dir * 32 + h]);
      f32x4 acc_s[8];
#pragma unroll
      for (int n = 0; n < 8; ++n) acc_s[n] = f32x4{0.f, 0.f, 0.f, 0.f};
      for (int step = 0; step < 34; ++step) {
        bool isctx = step < 2;
        int cidx = isctx ? step : step - 2;
        if (dir) cidx = (isctx ? 1 : 31) - cidx;
        size_t tok0 = isctx ? (size_t)(b * 256 + cidx * 128) : (size_t)(b * 4096 + cidx * 128);
        const u16* src = (isctx ? xc_c : xc) + tok0 * 3072;
        const float* dts = (isctx ? dt_c : dt) + tok0 * 64;
        int tz = tid;
        asm volatile("" : "+v"(tz));
        float dval = 0.f;
        if (tid < 128) dval = dts[tid * 64 + dir * 32 + h];
        uint4 xv[4], bv[8];
#pragma unroll
        for (int i = 0; i < 4; ++i) {
          int idx = tz + i * 256, l = (idx & 31) | ((idx >> 8) << 5), pc = ((idx >> 5) & 7) * 8;
          xv[i] = *reinterpret_cast<const uint4*>(src + (size_t)l * 3072 + h * 64 + pc);
        }
#pragma unroll
        for (int i = 0; i < 8; ++i) {
          int idx = tz + i * 256, l = (idx & 31) | (((idx >> 9) & 3) << 5), nc = (((idx >> 5) & 7) | (((idx >> 8) & 1) << 3)) * 8;
          bv[i] = *reinterpret_cast<const uint4*>(src + (size_t)l * 3072 + 2048 + g * 128 + nc);
        }
        if (tid < 128) { dtv[tid] = dval; asrc[tid] = dval * a_neg; }
#pragma unroll
        for (int i = 0; i < 4; ++i) {
          int idx = tz + i * 256, l = (idx & 31) | ((idx >> 8) << 5), pc = ((idx >> 5) & 7) * 8;
          uint4 v = xv[i];
          xsT[(pc + 0) * SLD + l] = (u16)(v.x & 0xffff); xsT[(pc + 1) * SLD + l] = (u16)(v.x >> 16);
          xsT[(pc + 2) * SLD + l] = (u16)(v.y & 0xffff); xsT[(pc + 3) * SLD + l] = (u16)(v.y >> 16);
          xsT[(pc + 4) * SLD + l] = (u16)(v.z & 0xffff); xsT[(pc + 5) * SLD + l] = (u16)(v.z >> 16);
          xsT[(pc + 6) * SLD + l] = (u16)(v.w & 0xffff); xsT[(pc + 7) * SLD + l] = (u16)(v.w >> 16);
        }
        if (!isctx) {
#pragma unroll
          for (int i = 0; i < 8; ++i) {
            int idx = tz + i * 256, l = (idx & 31) | (((idx >> 9) & 3) << 5), nc = (((idx >> 5) & 7) | (((idx >> 8) & 1) << 3)) * 8;
            *reinterpret_cast<uint4*>(Mb + l * SLD + nc) = bv[i];
          }
        }
        __syncthreads();
        bf16x8 Cf[2][4];
        if (!isctx) {
#pragma unroll
          for (int mt = 0; mt < 2; ++mt)
#pragma unroll
            for (int kk = 0; kk < 4; ++kk) Cf[mt][kk] = ld8(src + (size_t)(w * 32 + mt * 16 + fr) * 3072 + 2560 + g * 128 + kk * 32 + fq * 8);
        }
        if (tid < 128) {
          float s = 0.f;
          if (!dir) { for (int j = 0; j <= tid; ++j) s += asrc[j]; }
          else { for (int j = tid; j < 128; ++j) s += asrc[j]; }
          cum[tid] = s;
        }
        __syncthreads();
        float total = dir ? cum[0] : cum[127];
        if (!isctx) {
          float cl[2][4];
#pragma unroll
          for (int mt = 0; mt < 2; ++mt)
#pragma unroll
            for (int j = 0; j < 4; ++j) cl[mt][j] = cum[w * 32 + mt * 16 + fq * 4 + j];
          f32x4 cb0[8], cb1[8];
#pragma unroll
          for (int nt = 0; nt < 8; ++nt) {
            cb0[nt] = f32x4{0.f, 0.f, 0.f, 0.f};
            cb1[nt] = f32x4{0.f, 0.f, 0.f, 0.f};
            bool need = dir ? (nt >= w * 2) : (nt <= w * 2 + 1);
            if (need) {
#pragma unroll
              for (int kk = 0; kk < 4; ++kk) {
                bf16x8 Bf = ld8(Mb + (nt * 16 + fr) * SLD + kk * 32 + fq * 8);
                cb0[nt] = mfma16(Cf[0][kk], Bf, cb0[nt]);
                cb1[nt] = mfma16(Cf[1][kk], Bf, cb1[nt]);
              }
            }
          }
          __syncthreads();
          int zero = 0;
          asm volatile("" : "+v"(zero));
#pragma unroll
          for (int nt = 0; nt < 8; ++nt) {
            int s = nt * 16 + fr + zero;
            float cs = cum[s], ds = dtv[s];
#pragma unroll
            for (int j = 0; j < 4; ++j) {
              int l0 = w * 32 + fq * 4 + j, l1 = l0 + 16;
              bool ok0 = dir ? (s >= l0) : (s <= l0);
              bool ok1 = dir ? (s >= l1) : (s <= l1);
              float v0 = ok0 ? cb0[nt][j] * __expf(cl[0][j] - cs) * ds : 0.f;
              float v1 = ok1 ? cb1[nt][j] * __expf(cl[1][j] - cs) * ds : 0.f;
              Mb[l0 * SLD + s] = f2bf(v0);
              Mb[l1 * SLD + s] = f2bf(v1);
            }
          }
          __syncthreads();
          f32x4 ya[2][4];
#pragma unroll
          for (int mt = 0; mt < 2; ++mt)
#pragma unroll
            for (int nt = 0; nt < 4; ++nt) ya[mt][nt] = f32x4{0.f, 0.f, 0.f, 0.f};
#pragma unroll
          for (int kk = 0; kk < 4; ++kk)
#pragma unroll
            for (int nt = 0; nt < 4; ++nt) {
              bf16x8 Sf = ld8(stb + (nt * 16 + fr) * SLD + kk * 32 + fq * 8);
              ya[0][nt] = mfma16(Cf[0][kk], Sf, ya[0][nt]);
              ya[1][nt] = mfma16(Cf[1][kk], Sf, ya[1][nt]);
            }
#pragma unroll
          for (int mt = 0; mt < 2; ++mt)
#pragma unroll
            for (int j = 0; j < 4; ++j) {
              float e = __expf(cl[mt][j]);
#pragma unroll
              for (int nt = 0; nt < 4; ++nt) ya[mt][nt][j] *= e;
            }
#pragma unroll
          for (int kk = 0; kk < 4; ++kk) {
            bf16x8 Mf0 = ld8(Mb + (w * 32 + fr) * SLD + kk * 32 + fq * 8);
            bf16x8 Mf1 = ld8(Mb + (w * 32 + 16 + fr) * SLD + kk * 32 + fq * 8);
#pragma unroll
            for (int nt = 0; nt < 4; ++nt) {
              bf16x8 Xf = ld8(xsT + (nt * 16 + fr) * SLD + kk * 32 + fq * 8);
              ya[0][nt] = mfma16(Mf0, Xf, ya[0][nt]);
              ya[1][nt] = mfma16(Mf1, Xf, ya[1][nt]);
            }
          }
#pragma unroll
          for (int i = 0; i < 8; ++i) {
            int idx = tz + i * 256, l = (idx & 31) | (((idx >> 9) & 3) << 5), nc = (((idx >> 5) & 7) | (((idx >> 8) & 1) << 3)) * 8;
            bv[i] = *reinterpret_cast<const uint4*>(src + (size_t)l * 3072 + 2048 + g * 128 + nc);
          }
#pragma unroll
          for (int mt = 0; mt < 2; ++mt)
#pragma unroll
            for (int nt = 0; nt < 4; ++nt)
#pragma unroll
              for (int j = 0; j < 4; ++j) {
                int l = w * 32 + mt * 16 + fq * 4 + j, pp = nt * 16 + fr;
                float val = ya[mt][nt][j];
                if (!dir) {
                  val += bf2f(xsT[pp * SLD + l]) * dsk;
                  y[(tok0 + l) * 2048 + h * 64 + pp] = f2bf(val);
                } else {
                  yb8[(tok0 + l) * 2048 + h * 64 + pp] = (unsigned char)(__builtin_amdgcn_cvt_pk_fp8_f32(fminf(fmaxf(val * 4.f, -440.f), 440.f), 0.f, 0, false) & 0xFF);
                }
              }
        }
        if (step == 33) continue;
        __syncthreads();
#pragma unroll
        for (int i = 0; i < 8; ++i) {
          int idx = tz + i * 256, l = (idx & 31) | (((idx >> 9) & 3) << 5), nc = (((idx >> 5) & 7) | (((idx >> 8) & 1) << 3)) * 8;
          uint4 v = bv[i];
          float sc = dtv[l] * __expf(total - cum[l]);
          Mb[(nc + 0) * SLD + l] = f2bf(bflo(v.x) * sc); Mb[(nc + 1) * SLD + l] = f2bf(bfhi(v.x) * sc);
          Mb[(nc + 2) * SLD + l] = f2bf(bflo(v.y) * sc); Mb[(nc + 3) * SLD + l] = f2bf(bfhi(v.y) * sc);
          Mb[(nc + 4) * SLD + l] = f2bf(bflo(v.z) * sc); Mb[(nc + 5) * SLD + l] = f2bf(bfhi(v.z) * sc);
          Mb[(nc + 6) * SLD + l] = f2bf(bflo(v.w) * sc); Mb[(nc + 7) * SLD + l] = f2bf(bfhi(v.w) * sc);
        }
        __syncthreads();
        float cd = __expf(total);
#pragma unroll
        for (int nt = 0; nt < 8; ++nt) acc_s[nt] *= cd;
#pragma unroll
        for (int kk = 0; kk < 4; ++kk) {
          bf16x8 Af = ld8(xsT + (w * 16 + fr) * SLD + kk * 32 + fq * 8);
#pragma unroll
          for (int nt = 0; nt < 8; ++nt) {
            bf16x8 Bf = ld8(Mb + (nt * 16 + fr) * SLD + kk * 32 + fq * 8);
            acc_s[nt] = mfma16(Af, Bf, acc_s[nt]);
          }
        }
#pragma unroll
        for (int nt = 0; nt < 8; ++nt)
#pragma unroll
          for (int j = 0; j < 4; ++j) stb[(w * 16 + fq * 4 + j) * SLD + nt * 16 + fr] = f2bf(acc_s[nt][j]);
        __syncthreads();
      }
      __syncthreads();
    }
  }
}

__device__ __forceinline__ void phase_gated_norm(const Params& p) {
  u16* y = (u16*)(p.ws + OFF_R1);
  const u16* z = (const u16*)p.out;
  const unsigned char* yb8 = (const unsigned char*)(p.ws + OFF_R1 + 128 * MiB);
  const int tid_ = otid();
  int lane = tid_ & 63;
  int wave = blockIdx.x * 4 + (tid_ >> 6), nw = gridDim.x * 4;
  for (int tok = wave; tok < NT; tok += nw) {
#pragma unroll
    for (int g = 0; g < 4; ++g) {
      int ch = g * 512 + lane * 8;
      uint4 yv = *reinterpret_cast<const uint4*>(y + (size_t)tok * 2048 + ch);
      uint4 zv = *reinterpret_cast<const uint4*>(z + (size_t)tok * 2048 + ch);
      uint2 bw = *reinterpret_cast<const uint2*>(yb8 + (size_t)tok * 2048 + ch);
      f32x2 b01 = __builtin_amdgcn_cvt_pk_f32_fp8((int)bw.x, false), b23 = __builtin_amdgcn_cvt_pk_f32_fp8((int)bw.x, true);
      f32x2 b45 = __builtin_amdgcn_cvt_pk_f32_fp8((int)bw.y, false), b67 = __builtin_amdgcn_cvt_pk_f32_fp8((int)bw.y, true);
      const float r16 = 0.25f;
      float u[8];
      u[0] = (bflo(yv.x) + b01.x * r16) * siluf(bflo(zv.x)); u[1] = (bfhi(yv.x) + b01.y * r16) * siluf(bfhi(zv.x));
      u[2] = (bflo(yv.y) + b23.x * r16) * siluf(bflo(zv.y)); u[3] = (bfhi(yv.y) + b23.y * r16) * siluf(bfhi(zv.y));
      u[4] = (bflo(yv.z) + b45.x * r16) * siluf(bflo(zv.z)); u[5] = (bfhi(yv.z) + b45.y * r16) * siluf(bfhi(zv.z));
      u[6] = (bflo(yv.w) + b67.x * r16) * siluf(bflo(zv.w)); u[7] = (bfhi(yv.w) + b67.y * r16) * siluf(bfhi(zv.w));
      float ss = 0.f;
#pragma unroll
      for (int k = 0; k < 8; ++k) ss += u[k] * u[k];
      ss = wave_sum(ss);
      float sc = rsqrtf(ss * (1.f / 512.f) + 1e-5f);
      float4 w0 = *reinterpret_cast<const float4*>(p.m_norm_w + ch), w1 = *reinterpret_cast<const float4*>(p.m_norm_w + ch + 4);
      uint4 o;
      o.x = pack2(u[0] * sc * w0.x, u[1] * sc * w0.y);
      o.y = pack2(u[2] * sc * w0.z, u[3] * sc * w0.w);
      o.z = pack2(u[4] * sc * w1.x, u[5] * sc * w1.y);
      o.w = pack2(u[6] * sc * w1.z, u[7] * sc * w1.w);
      *reinterpret_cast<uint4*>(y + (size_t)tok * 2048 + ch) = o;
    }
  }
}

__device__ __forceinline__ void phase_gemm_resid(const u16* A, int K, const u16* Wt, const float* res, float* dst, const float* gate  , char* lds) {
  const int xcd = blockIdx.x & 7, li = blockIdx.x >> 3, nl = gridDim.x >> 3;
  for (int t = li; t < 128; t += nl) {
    int pm = t, pn = xcd;
    gemm_tile(A, K, Wt, K, pm * 256, pn * 128, 1024, K, lds, [=](int m, int n, f32x4 v) {
      int b = m >> 12;
      float4 r = *reinterpret_cast<const float4*>(res + (size_t)m * 1024 + n);
      float4 g = *reinterpret_cast<const float4*>(gate + (size_t)b * 6144 + n);
      *reinterpret_cast<float4*>(dst + (size_t)m * 1024 + n) = make_float4(ALPHA * r.x + g.x * v[0], ALPHA * r.y + g.y * v[1], ALPHA * r.z + g.z * v[2], ALPHA * r.w + g.w * v[3]);
    });
  }
}
__device__ __forceinline__ void phase_gemm_bf16(const u16* A, const u16* Wt, u16* dst, int N, char* lds) {
  const int xcd = blockIdx.x & 7, li = blockIdx.x >> 3, nl = gridDim.x >> 3;
  const int nb = N / 1024;
  for (int t = li; t < 128 * nb; t += nl) {
    int pm = t / nb, pn = xcd + 8 * (t % nb);
    gemm_tile(A, 1024, Wt, 1024, pm * 256, pn * 128, N, 1024, lds, [=](int m, int n, f32x4 v) { *reinterpret_cast<uint2*>(dst + (size_t)m * N + n) = make_uint2(pack2(v[0], v[1]), pack2(v[2], v[3])); });
  }
}

__device__ __forceinline__ void phase_ln_mod(float* xio, const float* g, const float* bta, const float* mod  , u16* tdst) {
  const int tid_ = otid();
  int lane = tid_ & 63;
  int wave = blockIdx.x * 4 + (tid_ >> 6), nw = gridDim.x * 4;
  for (int tok = wave; tok < NT; tok += nw) {
    int b = tok >> 12;
    float4 v[4];
    float s = 0.f;
#pragma unroll
    for (int i = 0; i < 4; ++i) {
      v[i] = *reinterpret_cast<const float4*>(xio + (size_t)tok * 1024 + i * 256 + lane * 4);
      s += v[i].x + v[i].y + v[i].z + v[i].w;
    }
    float mu = wave_sum(s) * (1.f / 1024.f);
    float q = 0.f;
#pragma unroll
    for (int i = 0; i < 4; ++i) {
      v[i].x -= mu; v[i].y -= mu; v[i].z -= mu; v[i].w -= mu;
      q += v[i].x * v[i].x + v[i].y * v[i].y + v[i].z * v[i].z + v[i].w * v[i].w;
    }
    float rs = rsqrtf(wave_sum(q) * (1.f / 1024.f) + 1e-5f);
    const float* m = mod + (size_t)b * 6144;
#pragma unroll
    for (int i = 0; i < 4; ++i) {
      int c = i * 256 + lane * 4;
      float4 gg = *reinterpret_cast<const float4*>(g + c), bb = *reinterpret_cast<const float4*>(bta + c);
      float4 o;
      o.x = v[i].x * rs * gg.x + bb.x; o.y = v[i].y * rs * gg.y + bb.y; o.z = v[i].z * rs * gg.z + bb.z; o.w = v[i].w * rs * gg.w + bb.w;
      *reinterpret_cast<float4*>(xio + (size_t)tok * 1024 + c) = o;
      float4 sh = *reinterpret_cast<const float4*>(m + 3072 + c), sc = *reinterpret_cast<const float4*>(m + 4096 + c);
      uint2 t;
      t.x = pack2(o.x * (1.f + sc.x) + sh.x, o.y * (1.f + sc.y) + sh.y);
      t.y = pack2(o.z * (1.f + sc.z) + sh.z, o.w * (1.f + sc.w) + sh.w);
      *reinterpret_cast<uint2*>(tdst + (size_t)tok * 1024 + c) = t;
    }
  }
}

__device__ __forceinline__ void phase_peer_topk(const u16* q, const u16* k1, const u16* k2, int* idxo, float* gateo, char* lds) {
  float* S = (float*)lds;
  float* sv = S + 64 * 129;
  int* si = (int*)(sv + 64 * 16);
  int tid = otid(), w = tid >> 6, lane = tid & 63, fr = lane & 15, fq = lane >> 4;
  const int slot = lane;
  const bool cvalid = lane < 50;
  int ci = slot < 42 ? ((slot >= 16) + (slot >= 24) + (slot >= 29) + (slot >= 33) + (slot >= 36) + (slot >= 38) + (slot >= 40)) : slot - 34;
  const unsigned long long PACK = 0ull | (16ull << 8) | (24ull << 16) | (29ull << 24) | (33ull << 32) | (36ull << 40) | (38ull << 48) | (40ull << 56);
  int cj = slot - (ci < 8 ? (int)((PACK >> (8 * ci)) & 0xFF) : 34 + ci);
  if (!cvalid) { ci = 0; cj = 0; }
  for (int item = blockIdx.x; item < 1024 * 8; item += gridDim.x) {
    int tile = item >> 3, h = item & 7;
    int tok0 = tile * 32;
    {
      int half = w >> 1, kb = (w & 1) * 64;
      const u16* kk_ = (half ? k2 : k1) + (size_t)h * 128 * 128;
      bf16x8 Af[2][4], Bf[4][4];
#pragma unroll
      for (int m = 0; m < 2; ++m)
#pragma unroll
        for (int ks = 0; ks < 4; ++ks) Af[m][ks] = ld8(q + (size_t)(tok0 + m * 16 + fr) * 2048 + h * 256 + half * 128 + ks * 32 + fq * 8);
#pragma unroll
      for (int n = 0; n < 4; ++n)
#pragma unroll
        for (int ks = 0; ks < 4; ++ks) Bf[n][ks] = ld8(kk_ + (size_t)(kb + n * 16 + fr) * 128 + ks * 32 + fq * 8);
      f32x4 acc[2][4];
#pragma unroll
      for (int m = 0; m < 2; ++m)
#pragma unroll
        for (int n = 0; n < 4; ++n) acc[m][n] = f32x4{0.f, 0.f, 0.f, 0.f};
#pragma unroll
      for (int ks = 0; ks < 4; ++ks)
#pragma unroll
        for (int n = 0; n < 4; ++n) {
          acc[0][n] = mfma16(Af[0][ks], Bf[n][ks], acc[0][n]);
          acc[1][n] = mfma16(Af[1][ks], Bf[n][ks], acc[1][n]);
        }
#pragma unroll
      for (int m = 0; m < 2; ++m)
#pragma unroll
        for (int n = 0; n < 4; ++n)
#pragma unroll
          for (int j = 0; j < 4; ++j) S[(half * 32 + m * 16 + fq * 4 + j) * 129 + kb + n * 16 + fr] = acc[m][n][j];
    }
    __syncthreads();
#pragma unroll 1
    for (int li = 0; li < 16; ++li) {
      int list = w * 16 + li;
      const float* row = S + list * 129;
      float vlo = row[lane], vhi = row[lane + 64];
      unsigned long long klo = ((unsigned long long)ordkey(vlo) << 7) | (unsigned)(127 - lane);
      unsigned long long khi = ((unsigned long long)ordkey(vhi) << 7) | (unsigned)(63 - lane);
      unsigned long long T = 0;
#pragma unroll 3
      for (int bit = 38; bit >= 0; --bit) {
        unsigned long long cand = T | (1ull << bit);
        int cnt = __popcll(__ballot(klo >= cand)) + __popcll(__ballot(khi >= cand));
        if (cnt >= 16) T = cand;
        if (cnt == 16) break;
      }
      bool slo = klo >= T, shi = khi >= T;
      unsigned long long mlo = __ballot(slo), mhi = __ballot(shi);
      int rlo = 0, rhi = 0;
      int klo_l = (int)(unsigned)klo, klo_h = (int)(unsigned)(klo >> 32), khi_l = (int)(unsigned)khi, khi_h = (int)(unsigned)(khi >> 32);
      while (mlo) {
        int src = __ffsll((long long)mlo) - 1;
        mlo &= mlo - 1;
        unsigned long long ks = ((unsigned long long)(unsigned)__builtin_amdgcn_readlane(klo_h, src) << 32) | (unsigned)__builtin_amdgcn_readlane(klo_l, src);
        rlo += (ks > klo) ? 1 : 0;
        rhi += (ks > khi) ? 1 : 0;
      }
      while (mhi) {
        int src = __ffsll((long long)mhi) - 1;
        mhi &= mhi - 1;
        unsigned long long ks = ((unsigned long long)(unsigned)__builtin_amdgcn_readlane(khi_h, src) << 32) | (unsigned)__builtin_amdgcn_readlane(khi_l, src);
        rlo += (ks > klo) ? 1 : 0;
        rhi += (ks > khi) ? 1 : 0;
      }
      if (slo) { sv[list * 16 + rlo] = vlo; si[list * 16 + rlo] = lane; }
      if (shi) { sv[list * 16 + rhi] = vhi; si[list * 16 + rhi] = lane + 64; }
    }
    __syncthreads();
#pragma unroll 1
    for (int tt = 0; tt < 8; ++tt) {
      int tok = w * 8 + tt;
      float sc_ = sv[tok * 16 + ci] + sv[(32 + tok) * 16 + cj];
      unsigned long long key = cvalid ? ((((unsigned long long)ordkey(sc_)) << 6) | (unsigned)(63 - lane)) : 0ull;
      unsigned long long T = 0;
#pragma unroll 3
      for (int bit = 37; bit >= 0; --bit) {
        unsigned long long cand = T | (1ull << bit);
        int cnt = __popcll(__ballot(key >= cand));
        if (cnt >= 16) T = cand;
        if (cnt == 16) break;
      }
      bool sel = cvalid && key >= T;
      unsigned long long msel = __ballot(sel);
      int rank = 0;
      int k_l = (int)(unsigned)key, k_h = (int)(unsigned)(key >> 32);
      int isc = __float_as_int(sc_);
      unsigned long long mm = msel;
      float mx = -INFINITY;
      while (mm) {
        int src = __ffsll((long long)mm) - 1;
        mm &= mm - 1;
        unsigned long long ks = ((unsigned long long)(unsigned)__builtin_amdgcn_readlane(k_h, src) << 32) | (unsigned)__builtin_amdgcn_readlane(k_l, src);
        rank += (ks > key) ? 1 : 0;
        mx = fmaxf(mx, __int_as_float(__builtin_amdgcn_readlane(isc, src)));
      }
      float ex = sel ? __expf(sc_ - mx) : 0.f;
      int iex = __float_as_int(ex);
      float sum = 0.f;
      mm = msel;
      while (mm) {
        int src = __ffsll((long long)mm) - 1;
        mm &= mm - 1;
        sum += __int_as_float(__builtin_amdgcn_readlane(iex, src));
      }
      if (sel) {
        size_t o = (size_t)(tok0 + tok) * 128 + h * 16 + rank;
        gateo[o] = ex / sum;
        idxo[o] = si[tok * 16 + ci] * 128 + si[(32 + tok) * 16 + cj];
      }
    }
  }
  __syncthreads();
}

DEV float gelu_exact(float v) { return 0.5f * v * (1.f + erff(v * 0.70710678118654752f)); }

__device__ __forceinline__ void convert_fp8_rows(const float* src, unsigned char* dst, float* rscale, int nrows) {
  const int tid_ = otid();
  int lane = tid_ & 63;
  int wave = blockIdx.x * 4 + (tid_ >> 6), nw = gridDim.x * 4;
  for (int row = wave; row < nrows; row += nw) {
    const float* r = src + (size_t)row * 1024 + lane * 16;
    float4 a0 = *reinterpret_cast<const float4*>(r), a1 = *reinterpret_cast<const float4*>(r + 4);
    float4 a2 = *reinterpret_cast<const float4*>(r + 8), a3 = *reinterpret_cast<const float4*>(r + 12);
    float m = fmaxf(fmaxf(fmaxf(fabsf(a0.x), fabsf(a0.y)), fmaxf(fabsf(a0.z), fabsf(a0.w))), fmaxf(fmaxf(fabsf(a1.x), fabsf(a1.y)), fmaxf(fabsf(a1.z), fabsf(a1.w))));
    m = fmaxf(m, fmaxf(fmaxf(fmaxf(fabsf(a2.x), fabsf(a2.y)), fmaxf(fabsf(a2.z), fabsf(a2.w))), fmaxf(fmaxf(fabsf(a3.x), fabsf(a3.y)), fmaxf(fabsf(a3.z), fabsf(a3.w)))));
#pragma unroll
    for (int o = 32; o > 0; o >>= 1) m = fmaxf(m, __shfl_xor(m, o));
    float sc = m > 0.f ? exp2f(floorf(log2f(224.f / m))) : 1.f;
    uint4 o;
    int p;
    p = __builtin_amdgcn_cvt_pk_fp8_f32(a0.x * sc, a0.y * sc, 0, false); p = __builtin_amdgcn_cvt_pk_fp8_f32(a0.z * sc, a0.w * sc, p, true); o.x = (unsigned)p;
    p = __builtin_amdgcn_cvt_pk_fp8_f32(a1.x * sc, a1.y * sc, 0, false); p = __builtin_amdgcn_cvt_pk_fp8_f32(a1.z * sc, a1.w * sc, p, true); o.y = (unsigned)p;
    p = __builtin_amdgcn_cvt_pk_fp8_f32(a2.x * sc, a2.y * sc, 0, false); p = __builtin_amdgcn_cvt_pk_fp8_f32(a2.z * sc, a2.w * sc, p, true); o.z = (unsigned)p;
    p = __builtin_amdgcn_cvt_pk_fp8_f32(a3.x * sc, a3.y * sc, 0, false); p = __builtin_amdgcn_cvt_pk_fp8_f32(a3.z * sc, a3.w * sc, p, true); o.w = (unsigned)p;
    *reinterpret_cast<uint4*>(dst + (size_t)row * 1024 + lane * 16) = o;
    if (lane == 0) rscale[row] = 1.f / sc;
  }
}

#define F8X(dst, WW) { dst[0] = __builtin_amdgcn_cvt_pk_f32_fp8((int)(WW).x, false); dst[1] = __builtin_amdgcn_cvt_pk_f32_fp8((int)(WW).x, true); \
                      dst[2] = __builtin_amdgcn_cvt_pk_f32_fp8((int)(WW).y, false); dst[3] = __builtin_amdgcn_cvt_pk_f32_fp8((int)(WW).y, true); \
                      dst[4] = __builtin_amdgcn_cvt_pk_f32_fp8((int)(WW).z, false); dst[5] = __builtin_amdgcn_cvt_pk_f32_fp8((int)(WW).z, true); \
                      dst[6] = __builtin_amdgcn_cvt_pk_f32_fp8((int)(WW).w, false); dst[7] = __builtin_amdgcn_cvt_pk_f32_fp8((int)(WW).w, true); }

__device__ __forceinline__ void phase_peer_gather(const u16* tin, const int* idx, const float* gate, const unsigned char* utab, const unsigned char* vtab,
                                  const float* urs, const float* vrs, const float* xres,
                                  const float* g2  , const float* lng, const float* lnb, float* xout,
                                  const float* modnext  , u16* hxout) {
  const int tid_ = otid();
  int lane = tid_ & 63;
  int wave = blockIdx.x * 4 + (tid_ >> 6), nw = gridDim.x * 4;
  for (int tok = wave; tok < NT; tok += nw) {
    int b = tok >> 12;
    f32x2 t2[8];
    {
      uint4 ta = *reinterpret_cast<const uint4*>(tin + (size_t)tok * 1024 + lane * 16);
      uint4 tb = *reinterpret_cast<const uint4*>(tin + (size_t)tok * 1024 + lane * 16 + 8);
      t2[0] = f32x2{bflo(ta.x), bfhi(ta.x)}; t2[1] = f32x2{bflo(ta.y), bfhi(ta.y)}; t2[2] = f32x2{bflo(ta.z), bfhi(ta.z)}; t2[3] = f32x2{bflo(ta.w), bfhi(ta.w)};
      t2[4] = f32x2{bflo(tb.x), bfhi(tb.x)}; t2[5] = f32x2{bflo(tb.y), bfhi(tb.y)}; t2[6] = f32x2{bflo(tb.z), bfhi(tb.z)}; t2[7] = f32x2{bflo(tb.w), bfhi(tb.w)};
    }
    int id0 = idx[(size_t)tok * 128 + lane] & 16383, id1 = idx[(size_t)tok * 128 + 64 + lane] & 16383;
    int gt0 = __float_as_int(gate[(size_t)tok * 128 + lane]), gt1 = __float_as_int(gate[(size_t)tok * 128 + 64 + lane]);
    f32x2 acc2[8];
#pragma unroll
    for (int k = 0; k < 8; ++k) acc2[k] = f32x2{0.f, 0.f};
#pragma unroll 1
    for (int j = 0; j < 128; j += 4) {
      int e[4];
      float g[4];
      if (j < 64) {
#pragma unroll
        for (int q = 0; q < 4; ++q) { e[q] = __builtin_amdgcn_readlane(id0, j + q); g[q] = __int_as_float(__builtin_amdgcn_readlane(gt0, j + q)); }
      } else {
#pragma unroll
        for (int q = 0; q < 4; ++q) { e[q] = __builtin_amdgcn_readlane(id1, j - 64 + q); g[q] = __int_as_float(__builtin_amdgcn_readlane(gt1, j - 64 + q)); }
      }
      uint4 U[4], V[4];
      float su[4], sv_[4];
#pragma unroll
      for (int q = 0; q < 4; ++q) {
        U[q] = *reinterpret_cast<const uint4*>(utab + (size_t)e[q] * 1024 + lane * 16);
        V[q] = *reinterpret_cast<const uint4*>(vtab + (size_t)e[q] * 1024 + lane * 16);
        su[q] = urs[e[q]];
        sv_[q] = vrs[e[q]];
      }
      float d[4];
#pragma unroll
      for (int q = 0; q < 4; ++q) {
        f32x2 u2[8];
        F8X(u2, U[q])
        f32x2 dd = u2[0] * t2[0];
#pragma unroll
        for (int k = 1; k < 8; ++k) dd = u2[k] * t2[k] + dd;
        d[q] = dd.x + dd.y;
      }
#pragma unroll
      for (int o = 32; o > 0; o >>= 1) {
#pragma unroll
        for (int q = 0; q < 4; ++q) d[q] += __shfl_xor(d[q], o);
      }
#pragma unroll
      for (int q = 0; q < 4; ++q) {
        float a = g[q] * gelu_exact(d[q] * su[q]) * sv_[q];
        f32x2 aa = f32x2{a, a};
        f32x2 v2[8];
        F8X(v2, V[q])
#pragma unroll
        for (int k = 0; k < 8; ++k) acc2[k] = aa * v2[k] + acc2[k];
      }
    }
    float vv[16];
    float s = 0.f;
    const int c0 = lane * 16;
#pragma unroll
    for (int k4 = 0; k4 < 4; ++k4) {
      float4 x0 = *reinterpret_cast<const float4*>(xres + (size_t)tok * 1024 + c0 + k4 * 4);
      float4 g0 = *reinterpret_cast<const float4*>(g2 + (size_t)b * 6144 + c0 + k4 * 4);
      vv[k4 * 4 + 0] = ALPHA * x0.x + g0.x * acc2[k4 * 2].x; vv[k4 * 4 + 1] = ALPHA * x0.y + g0.y * acc2[k4 * 2].y;
      vv[k4 * 4 + 2] = ALPHA * x0.z + g0.z * acc2[k4 * 2 + 1].x; vv[k4 * 4 + 3] = ALPHA * x0.w + g0.w * acc2[k4 * 2 + 1].y;
    }
#pragma unroll
    for (int k = 0; k < 16; ++k) s += vv[k];
    float mu = wave_sum(s) * (1.f / 1024.f);
    float qq = 0.f;
#pragma unroll
    for (int k = 0; k < 16; ++k) { vv[k] -= mu; qq += vv[k] * vv[k]; }
    float rs = rsqrtf(wave_sum(qq) * (1.f / 1024.f) + 1e-5f);
    float oo[16];
#pragma unroll
    for (int k4 = 0; k4 < 4; ++k4) {
      float4 ga = *reinterpret_cast<const float4*>(lng + c0 + k4 * 4), ba = *reinterpret_cast<const float4*>(lnb + c0 + k4 * 4);
      float4 o0;
      o0.x = vv[k4 * 4 + 0] * rs * ga.x + ba.x; o0.y = vv[k4 * 4 + 1] * rs * ga.y + ba.y; o0.z = vv[k4 * 4 + 2] * rs * ga.z + ba.z; o0.w = vv[k4 * 4 + 3] * rs * ga.w + ba.w;
      *reinterpret_cast<float4*>(xout + (size_t)tok * 1024 + c0 + k4 * 4) = o0;
      oo[k4 * 4 + 0] = o0.x; oo[k4 * 4 + 1] = o0.y; oo[k4 * 4 + 2] = o0.z; oo[k4 * 4 + 3] = o0.w;
    }
    if (modnext) {
      const float* m = modnext + (size_t)b * 6144;
      unsigned pk[8];
#pragma unroll
      for (int k4 = 0; k4 < 4; ++k4) {
        float4 sh0 = *reinterpret_cast<const float4*>(m + c0 + k4 * 4), sc0 = *reinterpret_cast<const float4*>(m + 1024 + c0 + k4 * 4);
        pk[k4 * 2] = pack2(oo[k4 * 4 + 0] * (1.f + sc0.x) + sh0.x, oo[k4 * 4 + 1] * (1.f + sc0.y) + sh0.y);
        pk[k4 * 2 + 1] = pack2(oo[k4 * 4 + 2] * (1.f + sc0.z) + sh0.z, oo[k4 * 4 + 3] * (1.f + sc0.w) + sh0.w);
      }
      *reinterpret_cast<uint4*>(hxout + (size_t)tok * 1024 + c0) = make_uint4(pk[0], pk[1], pk[2], pk[3]);
      *reinterpret_cast<uint4*>(hxout + (size_t)tok * 1024 + c0 + 8) = make_uint4(pk[4], pk[5], pk[6], pk[7]);
    }
  }
}

__device__ __forceinline__ void phase_shortconv_T(const Params& p, const u16* upre, u16* x1cm, u16* x2cm, u16* vcm, char* lds) {
  u16* tile = (u16*)lds;
  int tid = otid();
  for (int item = blockIdx.x; item < 512 * 48; item += gridDim.x) {
    int tt = item / 48, ct = item % 48;
    int tok0 = tt * 64, c0 = ct * 64;
#pragma unroll
    for (int i = 0; i < 2; ++i) {
      int q = tid + i * 256, tl = q >> 3, cg_ = (q & 7) * 8;
      int tok = tok0 + tl, l = tok & 4095, ch = c0 + cg_;
      float acc[8];
#pragma unroll
      for (int k = 0; k < 8; ++k) acc[k] = p.h_conv_b[ch + k];
#pragma unroll
      for (int j = 0; j < 3; ++j) {
        int ll = l + j - 1;
        if (ll < 0 || ll > 4095) continue;
        uint4 v = *reinterpret_cast<const uint4*>(upre + (size_t)(tok + j - 1) * 3072 + ch);
        const float* w = p.h_conv_w + j * 3072 + ch;
        float4 w0 = *reinterpret_cast<const float4*>(w), w1 = *reinterpret_cast<const float4*>(w + 4);
        acc[0] += bflo(v.x) * w0.x; acc[1] += bfhi(v.x) * w0.y; acc[2] += bflo(v.y) * w0.z; acc[3] += bfhi(v.y) * w0.w;
        acc[4] += bflo(v.z) * w1.x; acc[5] += bfhi(v.z) * w1.y; acc[6] += bflo(v.w) * w1.z; acc[7] += bfhi(v.w) * w1.w;
      }
#pragma unroll
      for (int k = 0; k < 8; ++k) tile[(cg_ + k) * 72 + tl] = f2bf(acc[k]);
    }
    __syncthreads();
    int part = c0 >> 10, d0 = c0 & 1023;
    u16* dst = part == 0 ? x1cm : (part == 1 ? x2cm : vcm);
    int b = tok0 >> 12, l0 = tok0 & 4095;
#pragma unroll
    for (int i = 0; i < 2; ++i) {
      int q = tid + i * 256, c = q >> 3, tg = (q & 7) * 8;
      uint4 v = *reinterpret_cast<const uint4*>(tile + c * 72 + tg);
      *reinterpret_cast<uint4*>(dst + ((size_t)(b * 1024 + d0 + c)) * 4096 + l0 + tg) = v;
    }
    __syncthreads();
  }
}

DEV float2 cmul(float2 a, float2 w) { return make_float2(a.x * w.x - a.y * w.y, a.x * w.y + a.y * w.x); }
DEV float2 cmulc(float2 a, float2 w) { return make_float2(a.x * w.x + a.y * w.y, a.y * w.x - a.x * w.y); }
__device__ __forceinline__ void fft_fwd(float2* X, const float2* __restrict__ tw) {
  int tid = otid();
  for (int s = 12; s >= 2; s -= 2) {
    const int h = 1 << s, q = h >> 1;
#pragma unroll 2
    for (int i = 0; i < 8; ++i) {
      int gi = tid + i * 256;
      int pos = gi & (q - 1);
      int base = ((gi >> (s - 1)) << (s + 1)) + pos;
      float2 w1 = tw[pos << (12 - s)];
      float2 w2 = tw[pos << (13 - s)];
      float2 a = X[base], bb = X[base + q], c = X[base + h], d = X[base + h + q];
      float2 a1 = make_float2(a.x + c.x, a.y + c.y);
      float2 c1 = cmul(make_float2(a.x - c.x, a.y - c.y), w1);
      float2 b1 = make_float2(bb.x + d.x, bb.y + d.y);
      float2 t = cmul(make_float2(bb.x - d.x, bb.y - d.y), w1);
      float2 d1 = make_float2(t.y, -t.x);
      X[base] = make_float2(a1.x + b1.x, a1.y + b1.y);
      X[base + q] = cmul(make_float2(a1.x - b1.x, a1.y - b1.y), w2);
      X[base + h] = make_float2(c1.x + d1.x, c1.y + d1.y);
      X[base + h + q] = cmul(make_float2(c1.x - d1.x, c1.y - d1.y), w2);
    }
    __syncthreads();
  }
  {
#pragma unroll 4
    for (int i = 0; i < 16; ++i) {
      int j = tid + i * 256;
      float2 a = X[2 * j], bq = X[2 * j + 1];
      X[2 * j] = make_float2(a.x + bq.x, a.y + bq.y);
      X[2 * j + 1] = make_float2(a.x - bq.x, a.y - bq.y);
    }
    __syncthreads();
  }
}
__device__ __forceinline__ void fft_inv(float2* X, const float2* __restrict__ tw) {
  int tid = otid();
  {
#pragma unroll 4
    for (int i = 0; i < 16; ++i) {
      int j = tid + i * 256;
      float2 a = X[2 * j], bq = X[2 * j + 1];
      X[2 * j] = make_float2(a.x + bq.x, a.y + bq.y);
      X[2 * j + 1] = make_float2(a.x - bq.x, a.y - bq.y);
    }
    __syncthreads();
  }
  for (int s = 2; s <= 12; s += 2) {
    const int h = 1 << s, q = h >> 1;
#pragma unroll 2
    for (int i = 0; i < 8; ++i) {
      int gi = tid + i * 256;
      int pos = gi & (q - 1);
      int base = ((gi >> (s - 1)) << (s + 1)) + pos;
      float2 w1 = tw[pos << (12 - s)];
      float2 w2 = tw[pos << (13 - s)];
      float2 a = X[base], bb = X[base + q], c = X[base + h], d = X[base + h + q];
      float2 tb = cmulc(bb, w2), td = cmulc(d, w2);
      float2 a1 = make_float2(a.x + tb.x, a.y + tb.y), b1 = make_float2(a.x - tb.x, a.y - tb.y);
      float2 c1 = make_float2(c.x + td.x, c.y + td.y), d1 = make_float2(c.x - td.x, c.y - td.y);
      float2 tc = cmulc(c1, w1);
      float2 u = cmulc(d1, w1);
      float2 tdd = make_float2(-u.y, u.x);
      X[base] = make_float2(a1.x + tc.x, a1.y + tc.y);
      X[base + h] = make_float2(a1.x - tc.x, a1.y - tc.y);
      X[base + q] = make_float2(b1.x + tdd.x, b1.y + tdd.y);
      X[base + h + q] = make_float2(b1.x - tdd.x, b1.y - tdd.y);
    }
    __syncthreads();
  }
}

__device__ __forceinline__ void phase_filter_fft(const Params& p, float2* Hf, char* lds) {
  float2* X = (float2*)lds;
  float* w3s = (float*)(lds + 65536);
  float* red = w3s + 128;
  const float* hid = (const float*)(p.ws + OFF_HID);
  int tid = otid();
  const float min_decay = -3.0701134573253945f;
  const float max_decay = -15.350567286626973f;
  for (int item = blockIdx.x; item < 2048; item += gridDim.x) {
    int o = item >> 10, d = item & 1023;
    if (tid < 128) {
      int dirr = tid >> 6, j = tid & 63;
      w3s[tid] = p.h_f_w3[(size_t)j * 4096 + (o * 2 + dirr) * 1024 + d];
    }
    __syncthreads();
    float adelta = fabsf(min_decay + (float)d * ((max_decay - min_decay) / 1023.f));
    float ss = 0.f;
#pragma unroll 1
    for (int i = 0; i < 16; ++i) {
      int t = tid + i * 256;
      const float* hr = hid + (size_t)t * 64;
      float hf = 0.f, hb = 0.f;
#pragma unroll
      for (int j4 = 0; j4 < 16; ++j4) {
        float4 hv = *reinterpret_cast<const float4*>(hr + j4 * 4);
        hf += hv.x * w3s[j4 * 4] + hv.y * w3s[j4 * 4 + 1] + hv.z * w3s[j4 * 4 + 2] + hv.w * w3s[j4 * 4 + 3];
        hb += hv.x * w3s[64 + j4 * 4] + hv.y * w3s[64 + j4 * 4 + 1] + hv.z * w3s[64 + j4 * 4 + 2] + hv.w * w3s[64 + j4 * 4 + 3];
      }
      float dec = __expf(-((float)t / 4095.f) * adelta);
      hf *= dec; hb *= dec;
      if (t == 0) {
        float v = hf + hb;
        X[0] = make_float2(v, 0.f);
        X[4096] = make_float2(0.f, 0.f);
        ss += v * v;
      } else {
        X[t] = make_float2(hf, 0.f);
        X[8192 - t] = make_float2(hb, 0.f);
        ss += hf * hf + hb * hb;
      }
    }
    ss = wave_sum(ss);
    if ((tid & 63) == 0) red[tid >> 6] = ss;
    __syncthreads();
    float tot = red[0] + red[1] + red[2] + red[3];
    float scale = rsqrtf(tot + 1e-6f) * (1.f / 8192.f);
    fft_fwd(X, (const float2*)(p.ws + OFF_TW));
    float2* dst = Hf + (size_t)item * 8192;
#pragma unroll 4
    for (int i = 0; i < 32; ++i) {
      int k = tid + i * 256;
      float2 v = X[k];
      dst[k] = make_float2(v.x * scale, v.y * scale);
    }
    __syncthreads();
  }
}

__device__ __forceinline__ void phase_hyena_conv(const Params& p, const u16* x1cm, const u16* x2cm, const u16* vcm, const float2* Hf, u16* zzcm, char* lds) {
  float2* X = (float2*)lds;
  int tid = otid();
  for (int item = blockIdx.x; item < 4096; item += gridDim.x) {
    int d = item >> 2, bp = item & 3;
    size_t r0 = ((size_t)((bp * 2) * 1024 + d)) * 4096, r1 = ((size_t)((bp * 2 + 1) * 1024 + d)) * 4096;
    float bias0 = p.h_bias[d], bias1 = p.h_bias[1024 + d];
#pragma unroll
    for (int i = 0; i < 2; ++i) {
      int t8 = (tid + i * 256) * 8;
      uint4 a = *reinterpret_cast<const uint4*>(vcm + r0 + t8);
      uint4 bq = *reinterpret_cast<const uint4*>(vcm + r1 + t8);
      X[t8 + 0] = make_float2(bflo(a.x), bflo(bq.x)); X[t8 + 1] = make_float2(bfhi(a.x), bfhi(bq.x));
      X[t8 + 2] = make_float2(bflo(a.y), bflo(bq.y)); X[t8 + 3] = make_float2(bfhi(a.y), bfhi(bq.y));
      X[t8 + 4] = make_float2(bflo(a.z), bflo(bq.z)); X[t8 + 5] = make_float2(bfhi(a.z), bfhi(bq.z));
      X[t8 + 6] = make_float2(bflo(a.w), bflo(bq.w)); X[t8 + 7] = make_float2(bfhi(a.w), bfhi(bq.w));
    }
    for (int i = 0; i < 16; ++i) X[4096 + tid + i * 256] = make_float2(0.f, 0.f);
    __syncthreads();
    fft_fwd(X, (const float2*)(p.ws + OFF_TW));
    {
      const float2* H = Hf + (size_t)d * 8192;
#pragma unroll 4
      for (int i = 0; i < 32; ++i) {
        int k = tid + i * 256;
        float2 hv = H[k], xv = X[k];
        X[k] = make_float2(xv.x * hv.x - xv.y * hv.y, xv.x * hv.y + xv.y * hv.x);
      }
    }
    __syncthreads();
    fft_inv(X, (const float2*)(p.ws + OFF_TW));
    float zz0[16], zz1[16];
#pragma unroll
    for (int i = 0; i < 2; ++i) {
      int t8 = (tid + i * 256) * 8;
      uint4 a = *reinterpret_cast<const uint4*>(vcm + r0 + t8);
      uint4 bq = *reinterpret_cast<const uint4*>(vcm + r1 + t8);
      uint4 xa = *reinterpret_cast<const uint4*>(x1cm + r0 + t8);
      uint4 xb = *reinterpret_cast<const uint4*>(x1cm + r1 + t8);
      float va[8] = {bflo(a.x), bfhi(a.x), bflo(a.y), bfhi(a.y), bflo(a.z), bfhi(a.z), bflo(a.w), bfhi(a.w)};
      float vb[8] = {bflo(bq.x), bfhi(bq.x), bflo(bq.y), bfhi(bq.y), bflo(bq.z), bfhi(bq.z), bflo(bq.w), bfhi(bq.w)};
      float fa[8] = {bflo(xa.x), bfhi(xa.x), bflo(xa.y), bfhi(xa.y), bflo(xa.z), bfhi(xa.z), bflo(xa.w), bfhi(xa.w)};
      float fb[8] = {bflo(xb.x), bfhi(xb.x), bflo(xb.y), bfhi(xb.y), bflo(xb.z), bfhi(xb.z), bflo(xb.w), bfhi(xb.w)};
#pragma unroll
      for (int e = 0; e < 8; ++e) {
        float2 cv = X[t8 + e];
        float z0 = fa[e] * (cv.x + va[e] * bias0);
        float z1 = fb[e] * (cv.y + vb[e] * bias0);
        zz0[i * 8 + e] = z0; zz1[i * 8 + e] = z1;
        X[t8 + e] = make_float2(z0, z1);
      }
    }
    for (int i = 0; i < 16; ++i) X[4096 + tid + i * 256] = make_float2(0.f, 0.f);
    __syncthreads();
    fft_fwd(X, (const float2*)(p.ws + OFF_TW));
    {
      const float2* H = Hf + (size_t)(1024 + d) * 8192;
#pragma unroll 4
      for (int i = 0; i < 32; ++i) {
        int k = tid + i * 256;
        float2 hv = H[k], xv = X[k];
        X[k] = make_float2(xv.x * hv.x - xv.y * hv.y, xv.x * hv.y + xv.y * hv.x);
      }
    }
    __syncthreads();
    fft_inv(X, (const float2*)(p.ws + OFF_TW));
#pragma unroll
    for (int i = 0; i < 2; ++i) {
      int t8 = (tid + i * 256) * 8;
      uint4 xa = *reinterpret_cast<const uint4*>(x2cm + r0 + t8);
      uint4 xb = *reinterpret_cast<const uint4*>(x2cm + r1 + t8);
      float fa[8] = {bflo(xa.x), bfhi(xa.x), bflo(xa.y), bfhi(xa.y), bflo(xa.z), bfhi(xa.z), bflo(xa.w), bfhi(xa.w)};
      float fb[8] = {bflo(xb.x), bfhi(xb.x), bflo(xb.y), bfhi(xb.y), bflo(xb.z), bfhi(xb.z), bflo(xb.w), bfhi(xb.w)};
      float o0[8], o1[8];
#pragma unroll
      for (int e = 0; e < 8; ++e) {
        float2 cv = X[t8 + e];
        o0[e] = fa[e] * (cv.x + zz0[i * 8 + e] * bias1);
        o1[e] = fb[e] * (cv.y + zz1[i * 8 + e] * bias1);
      }
      uint4 w0, w1;
      w0.x = pack2(o0[0], o0[1]); w0.y = pack2(o0[2], o0[3]); w0.z = pack2(o0[4], o0[5]); w0.w = pack2(o0[6], o0[7]);
      w1.x = pack2(o1[0], o1[1]); w1.y = pack2(o1[2], o1[3]); w1.z = pack2(o1[4], o1[5]); w1.w = pack2(o1[6], o1[7]);
      *reinterpret_cast<uint4*>(zzcm + r0 + t8) = w0;
      *reinterpret_cast<uint4*>(zzcm + r1 + t8) = w1;
    }
    __syncthreads();
  }
}

__device__ __forceinline__ void phase_transpose_back(const u16* src, u16* dst, char* lds) {
  u16* tile = (u16*)lds;
  int tid = otid();
  for (int item = blockIdx.x; item < 8 * 16 * 64; item += gridDim.x) {
    int b = item >> 10, dt_ = (item >> 6) & 15, tt = item & 63;
#pragma unroll
    for (int i = 0; i < 2; ++i) {
      int q = tid + i * 256, dd = q >> 3, tg = (q & 7) * 8;
      uint4 v = *reinterpret_cast<const uint4*>(src + ((size_t)(b * 1024 + dt_ * 64 + dd)) * 4096 + tt * 64 + tg);
      tile[(tg + 0) * 72 + dd] = (u16)(v.x & 0xffff); tile[(tg + 1) * 72 + dd] = (u16)(v.x >> 16);
      tile[(tg + 2) * 72 + dd] = (u16)(v.y & 0xffff); tile[(tg + 3) * 72 + dd] = (u16)(v.y >> 16);
      tile[(tg + 4) * 72 + dd] = (u16)(v.z & 0xffff); tile[(tg + 5) * 72 + dd] = (u16)(v.z >> 16);
      tile[(tg + 6) * 72 + dd] = (u16)(v.w & 0xffff); tile[(tg + 7) * 72 + dd] = (u16)(v.w >> 16);
    }
    __syncthreads();
#pragma unroll
    for (int i = 0; i < 2; ++i) {
      int q = tid + i * 256, tl = q >> 3, dg = (q & 7) * 8;
      uint4 v = *reinterpret_cast<const uint4*>(tile + tl * 72 + dg);
      *reinterpret_cast<uint4*>(dst + ((size_t)(b * 4096 + tt * 64 + tl)) * 1024 + dt_ * 64 + dg) = v;
    }
    __syncthreads();
  }
}

DEV void probe_rows(const unsigned* buf, int wpr, float* out) {
  const int tid_ = otid();
  int lane = tid_ & 63;
  int wave = blockIdx.x * 4 + (tid_ >> 6), nw = gridDim.x * 4;
  for (int row = wave; row < NT; row += nw) {
    unsigned h = 0;
    for (int w = lane; w < wpr; w += 64) { unsigned v = buf[(size_t)row * wpr + w]; h += (v ^ (v >> 15)) * (2654435761u + 2u * (unsigned)w); }
#pragma unroll
    for (int o = 32; o > 0; o >>= 1) h += (unsigned)__shfl_xor((int)h, o);
    float v = (float)((h >> 8) & 0xFFFFu) * (1.f / 65536.f);
    float4 vv = make_float4(v, v, v, v);
#pragma unroll
    for (int i = 0; i < 4; ++i) *reinterpret_cast<float4*>(out + (size_t)row * 1024 + i * 256 + lane * 4) = vv;
  }
}
#define PROBE_AT(id, bufexpr, wpr) if (PROBE == id) { Params pq = fetch_params(); probe_rows((const unsigned*)(bufexpr), wpr, pq.out); return; }

__device__ __forceinline__ uint4* xb_words_ptr() { __shared__ uint4 xb_words; return &xb_words; }
#define XB_TMO      128
#define XB_XCNT(j)  (256  + 64 * (j))
#define XB_XSUB(j)  (1280 + 64 * (j))
#define XB_XGEN(j)  (2304 + 64 * (j))
#define XB_TOP      3328
#define XB_TOPGEN   3392
#define XCD_BAR_WORDS 3456
#define XB_SPIN_CAP (1u << 18)
#define LAS __attribute__((address_space(3)))

__device__ __forceinline__ unsigned xb_ld(unsigned* p)              { return __hip_atomic_load(p, __ATOMIC_RELAXED, __HIP_MEMORY_SCOPE_AGENT); }
__device__ __forceinline__ unsigned xb_add(unsigned* p, unsigned v) { return __hip_atomic_fetch_add(p, v, __ATOMIC_RELAXED, __HIP_MEMORY_SCOPE_AGENT); }
__device__ __forceinline__ unsigned xb_xcc_id() { return (unsigned)__builtin_amdgcn_s_getreg((3 << 11) | 20) & 0xFu; }
#define XB_SPIN(cond, bar) do { unsigned _sp = 0; while (cond) { __builtin_amdgcn_s_sleep(1); \
    if ((++_sp & 255u) == 0u) { if (xb_ld(&(bar)[XB_TMO])) break; if (_sp > XB_SPIN_CAP) { atomicAdd(&(bar)[XB_TMO], 1u); break; } } } } while (0)

struct XcdBarrier {
    unsigned* bar; unsigned x;
    volatile LAS unsigned* st;
};

__device__ __forceinline__ XcdBarrier xcd_barrier_post(unsigned* bar, volatile LAS unsigned* st) {
    XcdBarrier b; b.bar = bar; b.x = xb_xcc_id(); b.st = st;
    if (threadIdx.x == 0) (void)xb_add(&bar[XB_XCNT(b.x)], 1u);
    return b;
}
__device__ __forceinline__ void xcd_barrier_complete(unsigned* bar, unsigned x, unsigned& nloc, unsigned& nx) {
    const unsigned G = gridDim.x * gridDim.y * gridDim.z;
    unsigned sum, cnt, mine, sp = 0u;
    for (;;) {
        sum = 0u; cnt = 0u; mine = 0u;
#pragma unroll
        for (unsigned j = 0; j < 16; ++j) { const unsigned c = xb_ld(&bar[XB_XCNT(j)]); sum += c; cnt += (c > 0u) ? 1u : 0u; mine = (j == x) ? c : mine; }
        if (sum == G) break;
        __builtin_amdgcn_s_sleep(1);
        if ((++sp & 255u) == 0u) { if (xb_ld(&bar[XB_TMO])) break; if (sp > XB_SPIN_CAP) { atomicAdd(&bar[XB_TMO], 1u); break; } }
    }
    nloc = mine > 0u ? mine : 1u; nx = cnt > 0u ? cnt : 1u;
}

__device__ __forceinline__ void xcd_barrier(const XcdBarrier& b) {
    asm volatile("s_waitcnt vmcnt(0)" ::: "memory");
    __syncthreads();
    if (threadIdx.x == 0) {
        unsigned* bar = b.bar;
        __builtin_amdgcn_s_waitcnt(0);
        unsigned nloc = b.st[0], nx = b.st[1];
        if (nloc == 0u) { xcd_barrier_complete(bar, b.x, nloc, nx); b.st[0] = nloc; b.st[1] = nx; }
        const unsigned old = xb_add(&bar[XB_XSUB(b.x)], 1u);
        const unsigned gen = old / nloc;
        if (old + 1u == (gen + 1u) * nloc) {
            __builtin_amdgcn_fence(__ATOMIC_RELEASE, "agent");
            asm volatile("s_waitcnt vmcnt(0)" ::: "memory");
            const unsigned og = xb_add(&bar[XB_TOP], 1u);
            const unsigned tg = og / nx;
            if (og + 1u == (tg + 1u) * nx) xb_add(&bar[XB_TOPGEN], 1u);
            else XB_SPIN(xb_ld(&bar[XB_TOPGEN]) == tg, bar);
            __builtin_amdgcn_fence(__ATOMIC_ACQUIRE, "agent");
            xb_add(&bar[XB_XGEN(b.x)], 1u);
            asm volatile("s_waitcnt vmcnt(0)" ::: "memory");
        } else {
            XB_SPIN(xb_ld(&bar[XB_XGEN(b.x)]) == gen, bar);
            __builtin_amdgcn_fence(__ATOMIC_ACQUIRE, "agent");
            asm volatile("s_waitcnt vmcnt(0)" ::: "memory");
        }
    }
    __syncthreads();
}


DEV void gsync2(unsigned k) {
  (void)k;
  XcdBarrier b;
  b.bar = (unsigned*)((char*)karg<33>() + OFF_BAR);
  b.x = xb_xcc_id();
  b.st = (volatile LAS unsigned*)xb_words_ptr();
  xcd_barrier(b);
}

DEV void gsync(cg::grid_group& grid) {
  asm volatile("s_waitcnt vmcnt(0)" ::: "memory");
  grid.sync();
  if (threadIdx.x == 0) {
    __builtin_amdgcn_fence(__ATOMIC_ACQUIRE, "agent");
    asm volatile("s_waitcnt vmcnt(0)" ::: "memory");
  }
  __syncthreads();
}

template <int layer>
__device__ __forceinline__ void peer_block(unsigned& nbar, char* lds) {
  {
    Params p = fetch_params();
    char* ws = p.ws; char* R1 = ws + OFF_R1; char* R2 = ws + OFF_R2; char* DO = (char*)p.out;
    const float* modl = (float*)(ws + OFF_MOD) + (size_t)layer * 9 * 6144;
    const u16* A = layer == 0 ? (const u16*)R1 : (const u16*)DO;
    const int K = layer == 0 ? 2048 : 1024;
    const u16* Wt = (const u16*)(ws + (layer == 0 ? OFF_W_OUT : OFF_W_HOUT));
    const float* res = layer == 0 ? p.x : (const float*)R2;
    phase_gemm_resid(A, K, Wt, res, (float*)R2, modl + 2048, lds);
  }
  gsync2(++nbar);
  PROBE_AT(5 + layer * 10, pq.ws + OFF_R2, 1024)
  {
    Params p = fetch_params();
    char* ws = p.ws; char* R1 = ws + OFF_R1; char* R2 = ws + OFF_R2; char* DO = (char*)p.out;
    const float* modl = (float*)(ws + OFF_MOD) + (size_t)layer * 9 * 6144;
    u16* tpeer = layer == 0 ? (u16*)DO : (u16*)(R1 + 128 * MiB);
    phase_ln_mod((float*)R2, p.ln_g + layer * 2048, p.ln_b + layer * 2048, modl, tpeer);
    if (DUP & 128) { gsync2(++nbar); phase_ln_mod((float*)R2, p.ln_g + layer * 2048, p.ln_b + layer * 2048, modl, tpeer); }
    if (layer == 1) {
      unsigned char* tb = (unsigned char*)R1;
      convert_fp8_rows(p.p_u + (size_t)16384 * 1024, tb, (float*)(tb + 32 * MiB), 16384);
      convert_fp8_rows(p.p_v + (size_t)16384 * 1024, tb + 16 * MiB, (float*)(tb + 32 * MiB + 65536), 16384);
    }
  }
  gsync2(++nbar);
  {
    Params p = fetch_params();
    char* ws = p.ws; char* R1 = ws + OFF_R1; char* DO = (char*)p.out;
    u16* tpeer = layer == 0 ? (u16*)DO : (u16*)(R1 + 128 * MiB);
    phase_gemm_bf16(tpeer, (const u16*)(ws + OFF_W_Q) + (size_t)layer * 2048 * 1024, layer == 0 ? (u16*)R1 : (u16*)DO, 2048, lds);
  }
  gsync2(++nbar);
  PROBE_AT(7 + layer * 10, pq.ws + OFF_R1, 1024)
  {
    Params p = fetch_params();
    char* ws = p.ws; char* R1 = ws + OFF_R1; char* R2 = ws + OFF_R2;
    int* idxb = (int*)(R2 + 128 * MiB);
    float* gateb = (float*)(R2 + 144 * MiB);
    const u16* kbf = (const u16*)(ws + OFF_KEYS);
    phase_peer_topk(layer == 0 ? (const u16*)R1 : (const u16*)p.out, kbf + (size_t)layer * 131072, kbf + 262144 + (size_t)layer * 131072, idxb, gateb, lds);
    if (DUP & 4) { __syncthreads(); phase_peer_topk(layer == 0 ? (const u16*)R1 : (const u16*)p.out, kbf + (size_t)layer * 131072, kbf + 262144 + (size_t)layer * 131072, idxb, gateb, lds); }
  }
  gsync2(++nbar);
  {
    Params p = fetch_params();
    char* ws = p.ws; char* R1 = ws + OFF_R1; char* R2 = ws + OFF_R2; char* DO = (char*)p.out;
    float* mod = (float*)(ws + OFF_MOD);
    const float* modl = mod + (size_t)layer * 9 * 6144;
    int* idxb = (int*)(R2 + 128 * MiB);
    float* gateb = (float*)(R2 + 144 * MiB);
    u16* tpeer = layer == 0 ? (u16*)DO : (u16*)(R1 + 128 * MiB);
    const unsigned char* tb8 = (const unsigned char*)(layer == 0 ? ws + OFF_TAB0 : R1);
    phase_peer_gather(tpeer, idxb, gateb, tb8, tb8 + 16 * MiB, (const float*)(tb8 + 32 * MiB), (const float*)(tb8 + 32 * MiB + 65536), (const float*)R2,
                      modl + 5120, p.ln_g + layer * 2048 + 1024, p.ln_b + layer * 2048 + 1024, layer == 0 ? (float*)R2 : p.out,
                      layer == 0 ? mod + 9 * 6144 : nullptr, (u16*)(DO + 64 * MiB));
  }
}

__global__ void __launch_bounds__(256, 2) fwd_megakernel(Params p_unused) {
  __shared__ __attribute__((aligned(16))) char lds[LDS_BYTES];
  cg::grid_group grid = cg::this_grid();
  unsigned nbar = 0;
  if (threadIdx.x == 0) *xb_words_ptr() = make_uint4(0u, 0u, 0u, 0u);
  __syncthreads();
  (void)xcd_barrier_post((unsigned*)((char*)karg<33>() + OFF_BAR), (volatile LAS unsigned*)xb_words_ptr());
  { Params p = fetch_params(); phase_prologue(p, lds); }
  if (DUP & 64) { __syncthreads(); Params p = fetch_params(); phase_prologue(p, lds); }
  gsync(grid);
  if (DUP & 4096) {
#pragma unroll 1
    for (int r = 0; r < 20; ++r) gsync2(++nbar);
  }
  {
    Params p = fetch_params();
    float* mod = (float*)(p.ws + OFF_MOD);
    modulate_rows(p.x, (u16*)(p.ws + OFF_R2), NT, SEQ, mod, 0, 1024, false);
    modulate_rows(p.ctx, (u16*)(p.ws + OFF_HC), NTC, CTXL, mod, 0, 1024, true);
  }
  gsync2(++nbar);
  { Params p = fetch_params(); phase_gemm_inproj(p, lds); }
  if (DUP & 2) { gsync2(++nbar); Params p = fetch_params(); phase_gemm_inproj(p, lds); }
  gsync2(++nbar);
  PROBE_AT(1, pq.ws + OFF_R1, 1536)
  { Params p = fetch_params(); phase_conv(p); }
  if (DUP & 16) { gsync2(++nbar); Params p = fetch_params(); phase_conv(p); }
  gsync2(++nbar);
  PROBE_AT(2, pq.ws + OFF_R2, 1536)
  { Params p = fetch_params(); phase_ssd(p, lds); }
  if (DUP & 1) { gsync2(++nbar); Params p = fetch_params(); phase_ssd(p, lds); }
  gsync2(++nbar);
  PROBE_AT(3, pq.ws + OFF_R1, 1024)
  {
    Params p = fetch_params(); phase_gated_norm(p);
    unsigned char* tb = (unsigned char*)(p.ws + OFF_TAB0);
    convert_fp8_rows(p.p_u, tb, (float*)(tb + 32 * MiB), 16384);
    convert_fp8_rows(p.p_v, tb + 16 * MiB, (float*)(tb + 32 * MiB + 65536), 16384);
    if (DUP & 2048) {
      convert_fp8_rows(p.p_u, tb, (float*)(tb + 32 * MiB), 16384);
      convert_fp8_rows(p.p_v, tb + 16 * MiB, (float*)(tb + 32 * MiB + 65536), 16384);
    }
  }
  gsync2(++nbar);
  PROBE_AT(4, pq.ws + OFF_R1, 1024)
  peer_block<0>(nbar, lds);
  if ((PROBE >= 5 && PROBE <= 7) || PROBE == 99) return;
  gsync2(++nbar);
  {
    Params p = fetch_params();
    phase_gemm_bf16((const u16*)((char*)p.out + 64 * MiB), (const u16*)(p.ws + OFF_W_HIN), (u16*)(p.ws + OFF_R1), 3072, lds);
  }
  gsync2(++nbar);
  PROBE_AT(8, pq.ws + OFF_R2, 1024)
  PROBE_AT(11, pq.ws + OFF_R1, 1536)
  {
    Params p = fetch_params();
    phase_shortconv_T(p, (const u16*)(p.ws + OFF_R1), (u16*)(p.ws + OFF_R2 + 128 * MiB), (u16*)p.out, (u16*)((char*)p.out + 64 * MiB), lds);
    if (DUP & 256) { __syncthreads(); phase_shortconv_T(p, (const u16*)(p.ws + OFF_R1), (u16*)(p.ws + OFF_R2 + 128 * MiB), (u16*)p.out, (u16*)((char*)p.out + 64 * MiB), lds); }
  }
  gsync2(++nbar);
  PROBE_AT(12, pq.ws + OFF_R2 + 128 * MiB, 512)
  { Params p = fetch_params(); phase_filter_fft(p, (float2*)(p.ws + OFF_R1), lds); }
  if (DUP & 32) { gsync2(++nbar); Params p = fetch_params(); phase_filter_fft(p, (float2*)(p.ws + OFF_R1), lds); }
  gsync2(++nbar);
  PROBE_AT(13, pq.ws + OFF_R1, 1024)
  {
    Params p = fetch_params();
    phase_hyena_conv(p, (const u16*)(p.ws + OFF_R2 + 128 * MiB), (const u16*)p.out, (const u16*)((char*)p.out + 64 * MiB),
                     (const float2*)(p.ws + OFF_R1), (u16*)(p.ws + OFF_R1 + 128 * MiB), lds);
  }
  if (DUP & 8) {
    gsync2(++nbar);
    Params p = fetch_params();
    phase_hyena_conv(p, (const u16*)(p.ws + OFF_R2 + 128 * MiB), (const u16*)p.out, (const u16*)((char*)p.out + 64 * MiB),
                     (const float2*)(p.ws + OFF_R1), (u16*)(p.ws + OFF_R1 + 128 * MiB), lds);
  }
  gsync2(++nbar);
  PROBE_AT(14, pq.ws + OFF_R1 + 128 * MiB, 512)
  { Params p = fetch_params(); phase_transpose_back((const u16*)(p.ws + OFF_R1 + 128 * MiB), (u16*)p.out, lds); }
  gsync2(++nbar);
  peer_block<1>(nbar, lds);
}

extern "C" void kernel_launch(void* const* d_in, const int* in_sizes, int n_in, void* d_out, int out_size, void* d_ws, size_t ws_size,
                              hipStream_t stream) {
  static int grid_blocks = 0;
  if (!grid_blocks) {
    int dev = 0, cus = 0, per_cu = 0;
    hipGetDevice(&dev);
    hipDeviceGetAttribute(&cus, hipDeviceAttributeMultiprocessorCount, dev);
    hipOccupancyMaxActiveBlocksPerMultiprocessor(&per_cu, fwd_megakernel, 256, 0);
    if (per_cu > 2) per_cu = 2;
    if (per_cu < 1) per_cu = 1;
    grid_blocks = cus * per_cu;
  }
  Params p{};
  const float** pp = reinterpret_cast<const float**>(&p);
  for (int i = 0; i < 32; ++i) pp[i] = (const float*)d_in[i];
  p.out = (float*)d_out;
  p.ws = (char*)d_ws;
  if (ws_size < WS_TOTAL) fprintf(stderr, "workspace too small: %zu < %zu\n", ws_size, (size_t)WS_TOTAL);
  (void)hipMemsetAsync((char*)d_ws + OFF_BAR, 0, 16384, stream);
  void* args[] = {&p};
  hipError_t e = hipLaunchCooperativeKernel((void*)fwd_megakernel, dim3(grid_blocks), dim3(256), args, 0, stream);
  if (e != hipSuccess) fprintf(stderr, "cooperative launch failed: %s (grid %d)\n", hipGetErrorString(e), grid_blocks);
}
```

```cpp
#include <hip/hip_runtime.h>
#include <hip/hip_bf16.h>
#include <hip/hip_cooperative_groups.h>
#include <cstdio>
namespace cg = cooperative_groups;

typedef unsigned short u16;
using bf16x8 = __attribute__((ext_vector_type(8))) short;
using f32x4 = __attribute__((ext_vector_type(4))) float;
using u32x4 = __attribute__((ext_vector_type(4))) unsigned;
typedef float f32x2 __attribute__((ext_vector_type(2)));

#define DEV __device__ __forceinline__

constexpr int NB = 8, SEQ = 4096, DM = 1024, NT = NB * SEQ;
constexpr int CTXL = 256, NTC = NB * CTXL;
constexpr int SSM_IN = 5184, CONVD = 3072, SSM_INNER = 2048;
constexpr float ALPHA = 1.41421356237f;
constexpr int LDS_BYTES = 71168;

constexpr size_t MiB = 1ull << 20;
constexpr size_t OFF_W_IN = 0;
constexpr size_t OFF_W_OUT = OFF_W_IN + (size_t)5184 * 1024 * 2;
constexpr size_t OFF_W_HIN = OFF_W_OUT + (size_t)1024 * 2048 * 2;
constexpr size_t OFF_W_HOUT = OFF_W_HIN + (size_t)3072 * 1024 * 2;
constexpr size_t OFF_W_Q = OFF_W_HOUT + (size_t)1024 * 1024 * 2;
constexpr size_t OFF_MOD = OFF_W_Q + (size_t)2 * 2048 * 1024 * 2;
constexpr size_t OFF_HID = OFF_MOD + 512 * 1024;
constexpr size_t OFF_DT = OFF_HID + MiB;
constexpr size_t OFF_HC = OFF_DT + 8 * MiB;
constexpr size_t OFF_XBC_C = OFF_HC + 4 * MiB;
constexpr size_t OFF_XC_C = OFF_XBC_C + 12 * MiB;
constexpr size_t OFF_DT_C = OFF_XC_C + 12 * MiB;
constexpr size_t OFF_R1 = OFF_DT_C + MiB;
constexpr size_t OFF_R2 = OFF_R1 + 192 * MiB;
constexpr size_t OFF_BAR = OFF_R2 + 192 * MiB;
constexpr size_t OFF_KEYS = OFF_BAR + 16384;
constexpr size_t OFF_TW = OFF_KEYS + MiB;
constexpr size_t OFF_TAB0 = OFF_TW + 32768;
constexpr size_t WS_TOTAL = OFF_TAB0 + 33 * MiB;

struct Params {
  const float *x, *c, *ctx, *c_ctx, *ada_w, *ada_b, *ln_g, *ln_b;
  const float *m_w_in, *m_conv_w, *m_conv_b, *m_a_log, *m_dt_bias, *m_d, *m_norm_w, *m_w_out;
  const float *h_w_in, *h_conv_w, *h_conv_b, *h_f_w1, *h_f_b1, *h_f_w2, *h_f_b2, *h_f_w3, *h_freq, *h_bias, *h_w_out;
  const float *p_wq, *p_k1, *p_k2, *p_u, *p_v;
  float* out;
  char* ws;
};

typedef __bf16 bf16x2_t __attribute__((ext_vector_type(2)));
typedef float f32x2_ __attribute__((ext_vector_type(2)));
DEV u16 f2bf(float f) { __bf16 v = (__bf16)f; return __builtin_bit_cast(u16, v); }
DEV float bf2f(u16 h) { return __uint_as_float(((unsigned)h) << 16); }
DEV float bflo(unsigned w) { return __uint_as_float(w << 16); }
DEV float bfhi(unsigned w) { return __uint_as_float(w & 0xffff0000u); }
DEV unsigned pack2(float a, float b) { bf16x2_t v = __builtin_convertvector(f32x2_{a, b}, bf16x2_t); return __builtin_bit_cast(unsigned, v); }
DEV float wave_sum(float v) {
#pragma unroll
  for (int o = 32; o > 0; o >>= 1) v += __shfl_xor(v, o);
  return v;
}
DEV int otid() { int t = threadIdx.x; asm volatile("" : "+v"(t)); return t; }
DEV unsigned ordkey(float f) { unsigned u = __float_as_uint(f); return (u & 0x80000000u) ? ~u : (u | 0x80000000u); }
DEV float siluf(float v) { return v / (1.f + __expf(-v)); }
DEV f32x4 mfma16(bf16x8 a, bf16x8 b, f32x4 c) { return __builtin_amdgcn_mfma_f32_16x16x32_bf16(a, b, c, 0, 0, 0); }
DEV bf16x8 ld8(const u16* p) { return *reinterpret_cast<const bf16x8*>(p); }

template <int I>
DEV const float* karg() {
  unsigned long long v;
  asm volatile("s_load_dwordx2 %0, %1, %2\n\ts_waitcnt lgkmcnt(0)" : "=s"(v) : "s"(__builtin_amdgcn_kernarg_segment_ptr()), "n"(I * 8));
  return (const float*)(const __attribute__((address_space(1))) float*)v;
}
DEV Params fetch_params() {
  Params q;
  q.x = karg<0>(); q.c = karg<1>(); q.ctx = karg<2>(); q.c_ctx = karg<3>(); q.ada_w = karg<4>(); q.ada_b = karg<5>(); q.ln_g = karg<6>(); q.ln_b = karg<7>();
  q.m_w_in = karg<8>(); q.m_conv_w = karg<9>(); q.m_conv_b = karg<10>(); q.m_a_log = karg<11>(); q.m_dt_bias = karg<12>(); q.m_d = karg<13>();
  q.m_norm_w = karg<14>(); q.m_w_out = karg<15>();
  q.h_w_in = karg<16>(); q.h_conv_w = karg<17>(); q.h_conv_b = karg<18>(); q.h_f_w1 = karg<19>(); q.h_f_b1 = karg<20>(); q.h_f_w2 = karg<21>();
  q.h_f_b2 = karg<22>(); q.h_f_w3 = karg<23>(); q.h_freq = karg<24>(); q.h_bias = karg<25>(); q.h_w_out = karg<26>();
  q.p_wq = karg<27>(); q.p_k1 = karg<28>(); q.p_k2 = karg<29>(); q.p_u = karg<30>(); q.p_v = karg<31>();
  q.out = (float*)karg<32>(); q.ws = (char*)karg<33>();
  return q;
}

__device__ __forceinline__ void transpose_w_tile(const float* src, int srcld, int K, int N, u16* dst, int item, char* lds) {
  float* tile = (float*)lds;
  int ntn = N / 64;
  int kt = item / ntn, nt = item % ntn;
  int tid = otid();
#pragma unroll
  for (int i = 0; i < 4; ++i) {
    int r = (tid >> 4) + i * 16, c4 = (tid & 15) * 4;
    float4 v = *reinterpret_cast<const float4*>(src + (size_t)(kt * 64 + r) * srcld + nt * 64 + c4);
    tile[r * 65 + c4 + 0] = v.x; tile[r * 65 + c4 + 1] = v.y; tile[r * 65 + c4 + 2] = v.z; tile[r * 65 + c4 + 3] = v.w;
  }
  __syncthreads();
#pragma unroll
  for (int i = 0; i < 2; ++i) {
    int n = (tid >> 3) + i * 32, k8 = (tid & 7) * 8;
    uint4 o;
    o.x = pack2(tile[(k8 + 0) * 65 + n], tile[(k8 + 1) * 65 + n]);
    o.y = pack2(tile[(k8 + 2) * 65 + n], tile[(k8 + 3) * 65 + n]);
    o.z = pack2(tile[(k8 + 4) * 65 + n], tile[(k8 + 5) * 65 + n]);
    o.w = pack2(tile[(k8 + 6) * 65 + n], tile[(k8 + 7) * 65 + n]);
    *reinterpret_cast<uint4*>(dst + (size_t)(nt * 64 + n) * K + kt * 64 + k8) = o;
  }
  __syncthreads();
}

__device__ __forceinline__ void ada_item(const Params& p, int item, char* lds) {
  float* sl = (float*)lds;
  float* red = sl + 9 * 1024;
  int layer = item / 96, cg_ = item % 96;
  int tid = otid(), kq = tid >> 6, col = cg_ * 64 + (tid & 63);
  for (int e = tid; e < 9 * 1024; e += 256) {
    int r = e >> 10, k = e & 1023;
    sl[e] = siluf(r < 8 ? p.c[r * 1024 + k] : p.c_ctx[k]);
  }
  __syncthreads();
  float acc[9];
#pragma unroll
  for (int r = 0; r < 9; ++r) acc[r] = 0.f;
  const float* w = p.ada_w + (size_t)layer * 1024 * 6144 + col;
#pragma unroll 8
  for (int k = kq * 256; k < kq * 256 + 256; ++k) {
    float wv = w[(size_t)k * 6144];
#pragma unroll
    for (int r = 0; r < 9; ++r) acc[r] += sl[r * 1024 + k] * wv;
  }
#pragma unroll
  for (int r = 0; r < 9; ++r) red[(kq * 9 + r) * 64 + (tid & 63)] = acc[r];
  __syncthreads();
  if (tid < 64) {
    float* mod = (float*)(p.ws + OFF_MOD);
    float bias = p.ada_b[layer * 6144 + col];
#pragma unroll
    for (int r = 0; r < 9; ++r) {
      float s = red[(0 * 9 + r) * 64 + tid] + red[(1 * 9 + r) * 64 + tid] + red[(2 * 9 + r) * 64 + tid] + red[(3 * 9 + r) * 64 + tid];
      mod[((size_t)layer * 9 + r) * 6144 + col] = s + bias;
    }
  }
  __syncthreads();
}

__device__ __forceinline__ void hyena_mlp_item(const Params& p, int item, char* lds) {
  float* zb = (float*)lds;
  float* h1 = zb + 256;
  float* h2 = h1 + 256;
  int tid = otid(), ti = tid >> 6, j = tid & 63;
  int t = item * 4 + ti;
  const float L = 4096.f;
  if (j < 33) {
    float v;
    if (j == 0) v = (float)t / 4095.f;
    else {
      int k = (j - 1) & 15;
      float fb = 1e-4f + (float)k * ((15.f - 1e-4f) / 15.f);
      float ang = 6.283185307179586f * (float)t / L;
      float a = fb * ang;
      v = (j <= 16) ? cosf(a) : -sinf(a);
    }
    zb[ti * 64 + j] = v;
  }
  __syncthreads();
  float fr = p.h_freq[j];
  float s = p.h_f_b1[j];
#pragma unroll 3
  for (int i = 0; i < 33; ++i) s += zb[ti * 64 + i] * p.h_f_w1[i * 64 + j];
  h1[ti * 64 + j] = sinf(fr * s);
  __syncthreads();
  s = p.h_f_b2[j];
#pragma unroll 8
  for (int i = 0; i < 64; ++i) s += h1[ti * 64 + i] * p.h_f_w2[i * 64 + j];
  h2[ti * 64 + j] = sinf(fr * s);
  __syncthreads();
  s = p.h_f_b2[64 + j];
#pragma unroll 8
  for (int i = 0; i < 64; ++i) s += h2[ti * 64 + i] * p.h_f_w2[4096 + i * 64 + j];
  float* hid = (float*)(p.ws + OFF_HID);
  hid[t * 64 + j] = sinf(fr * s);
  __syncthreads();
}

__device__ __forceinline__ void phase_prologue(const Params& p, char* lds) {
  constexpr int T0 = 1296, T1 = T0 + 512, T2 = T1 + 768, T3 = T2 + 256, T4 = T3 + 512, T5 = T4 + 512, T6 = T5 + 192, T7 = T6 + 1024, T8 = T7 + 256, T9 = T8 + 16;
  for (int item = blockIdx.x; item < T9; item += gridDim.x) {
    if (item < T0) transpose_w_tile(p.m_w_in, SSM_IN, 1024, SSM_IN, (u16*)(p.ws + OFF_W_IN), item, lds);
    else if (item < T1) transpose_w_tile(p.m_w_out, 1024, 2048, 1024, (u16*)(p.ws + OFF_W_OUT), item - T0, lds);
    else if (item < T2) transpose_w_tile(p.h_w_in, 3072, 1024, 3072, (u16*)(p.ws + OFF_W_HIN), item - T1, lds);
    else if (item < T3) transpose_w_tile(p.h_w_out, 1024, 1024, 1024, (u16*)(p.ws + OFF_W_HOUT), item - T2, lds);
    else if (item < T4) transpose_w_tile(p.p_wq, 2048, 1024, 2048, (u16*)(p.ws + OFF_W_Q), item - T3, lds);
    else if (item < T5) transpose_w_tile(p.p_wq + (size_t)1024 * 2048, 2048, 1024, 2048, (u16*)(p.ws + OFF_W_Q) + (size_t)2048 * 1024, item - T4, lds);
    else if (item < T6) ada_item(p, item - T5, lds);
    else if (item < T7) hyena_mlp_item(p, item - T6, lds);
    else if (item >= T8) {
      int k = (item - T8) * 256 + threadIdx.x;
      float sn, cs;
      sincospif((float)k * (1.f / 4096.f), &sn, &cs);
      ((float2*)(p.ws + OFF_TW))[k] = make_float2(cs, -sn);
    } else {
      int e8 = ((item - T7) * 256 + threadIdx.x) * 8;
      const float* src = e8 < 262144 ? p.p_k1 + e8 : p.p_k2 + (e8 - 262144);
      float4 a0 = *reinterpret_cast<const float4*>(src), a1 = *reinterpret_cast<const float4*>(src + 4);
      uint4 o;
      o.x = pack2(a0.x, a0.y); o.y = pack2(a0.z, a0.w); o.z = pack2(a1.x, a1.y); o.w = pack2(a1.z, a1.w);
      *reinterpret_cast<uint4*>((u16*)(p.ws + OFF_KEYS) + e8) = o;
    }
  }
}

__device__ __forceinline__ void modulate_rows(const float* src, u16* dst, int nrows, int rows_per_batch, const float* modbase, int sh_off, int sc_off, bool ctxrow) {
  size_t total = (size_t)nrows * 128;
  for (size_t e = (size_t)blockIdx.x * 256 + threadIdx.x; e < total; e += (size_t)gridDim.x * 256) {
    int row = (int)(e >> 7), c8 = (int)(e & 127) * 8;
    int b = ctxrow ? 8 : row / rows_per_batch;
    const float* m = modbase + (size_t)b * 6144;
    float4 a0 = *reinterpret_cast<const float4*>(src + (size_t)row * 1024 + c8);
    float4 a1 = *reinterpret_cast<const float4*>(src + (size_t)row * 1024 + c8 + 4);
    float4 s0 = *reinterpret_cast<const float4*>(m + sc_off + c8);
    float4 s1 = *reinterpret_cast<const float4*>(m + sc_off + c8 + 4);
    float4 h0 = *reinterpret_cast<const float4*>(m + sh_off + c8);
    float4 h1 = *reinterpret_cast<const float4*>(m + sh_off + c8 + 4);
    uint4 o;
    o.x = pack2(a0.x * (1.f + s0.x) + h0.x, a0.y * (1.f + s0.y) + h0.y);
    o.y = pack2(a0.z * (1.f + s0.z) + h0.z, a0.w * (1.f + s0.w) + h0.w);
    o.z = pack2(a1.x * (1.f + s1.x) + h1.x, a1.y * (1.f + s1.y) + h1.y);
    o.w = pack2(a1.z * (1.f + s1.z) + h1.z, a1.w * (1.f + s1.w) + h1.w);
    *reinterpret_cast<uint4*>(dst + (size_t)row * 1024 + c8) = o;
  }
}

constexpr int GLD = 72;
template <class Epi>
__device__ __forceinline__ void gemm_tile(const u16* __restrict__ A, int lda, const u16* __restrict__ Bt, int ldb, int brow, int bcol, int Nmax,
                                          int K, char* lds, Epi epi) {
  u16* SA = (u16*)lds;
  u16* SB = SA + 256 * GLD;
  int tid = otid(), wid = tid >> 6, lane = tid & 63, wr = wid >> 1, wc = wid & 1, fr = lane & 15, fq = lane >> 4;
  f32x4 acc[8][4];
#pragma unroll
  for (int m = 0; m < 8; ++m)
#pragma unroll
    for (int n = 0; n < 4; ++n) acc[m][n] = f32x4{0.f, 0.f, 0.f, 0.f};
  u32x4 ra[8], rb[4];
  const int lr = tid >> 3, lc = (tid & 7) * 8;
  const u16* abase = A + (size_t)brow * lda;
  const unsigned aoff = (unsigned)(lr * lda + lc);
  unsigned bo[4];
#pragma unroll
  for (int i = 0; i < 4; ++i) {
    int br = bcol + lr + i * 32;
    if (br >= Nmax) br = Nmax - 1;
    bo[i] = (unsigned)(br * ldb + lc);
  }
#define GLOADT(KT)                                                                                 \
  _Pragma("unroll") for (int i = 0; i < 8; ++i)                                                    \
    ra[i] = *reinterpret_cast<const u32x4*>(abase + (aoff + (unsigned)((i * 32) * lda + (KT) * 64))); \
  _Pragma("unroll") for (int i = 0; i < 4; ++i)                                                    \
    rb[i] = *reinterpret_cast<const u32x4*>(Bt + (bo[i] + (unsigned)((KT) * 64)));
  const int nk = K / 64;
  GLOADT(0)
  for (int kt = 0; kt < nk; ++kt) {
#pragma unroll
    for (int i = 0; i < 8; ++i) *reinterpret_cast<u32x4*>(SA + (lr + i * 32) * GLD + lc) = ra[i];
#pragma unroll
    for (int i = 0; i < 4; ++i) *reinterpret_cast<u32x4*>(SB + (lr + i * 32) * GLD + lc) = rb[i];
    __syncthreads();
    { const int kn = kt + 1 < nk ? kt + 1 : nk - 1; GLOADT(kn) }
#pragma unroll
    for (int kk = 0; kk < 2; ++kk) {
      bf16x8 Bl[4];
#pragma unroll
      for (int n = 0; n < 4; ++n) Bl[n] = ld8(SB + (wc * 64 + n * 16 + fr) * GLD + kk * 32 + fq * 8);
#pragma unroll
      for (int mh = 0; mh < 2; ++mh) {
        bf16x8 At[4];
#pragma unroll
        for (int m = 0; m < 4; ++m) At[m] = ld8(SA + (wr * 128 + (mh * 4 + m) * 16 + fr) * GLD + kk * 32 + fq * 8);
#pragma unroll
        for (int m = 0; m < 4; ++m)
#pragma unroll
          for (int n = 0; n < 4; ++n) acc[mh * 4 + m][n] = mfma16(Bl[n], At[m], acc[mh * 4 + m][n]);
      }
    }
    __syncthreads();
  }
#undef GLOADT
#pragma unroll
  for (int m = 0; m < 8; ++m)
#pragma unroll
    for (int n = 0; n < 4; ++n) epi(brow + wr * 128 + m * 16 + fr, bcol + wc * 64 + n * 16 + fq * 4, acc[m][n]);
}

DEV float softplusf(float v) { return fmaxf(v, 0.f) + log1pf(__expf(-fabsf(v))); }

__device__ __forceinline__ void phase_gemm_inproj(const Params& p, char* lds) {
  const u16* hx = (const u16*)(p.ws + OFF_R2);
  const u16* hc = (const u16*)(p.ws + OFF_HC);
  const u16* Wt = (const u16*)(p.ws + OFF_W_IN);
  u16* zbuf = (u16*)p.out;
  u16* xbc = (u16*)(p.ws + OFF_R1);
  float* dt = (float*)(p.ws + OFF_DT);
  u16* xbc_c = (u16*)(p.ws + OFF_XBC_C);
  float* dt_c = (float*)(p.ws + OFF_DT_C);
  const float* dtb = p.m_dt_bias;
  const int xcd = blockIdx.x & 7, li = blockIdx.x >> 3, nl = gridDim.x >> 3;
  auto epi_lat = [=](int m, int n, f32x4 v) {
    if (n < 2048) *reinterpret_cast<uint2*>(zbuf + (size_t)m * 2048 + n) = make_uint2(pack2(v[0], v[1]), pack2(v[2], v[3]));
    else if (n < 5120) *reinterpret_cast<uint2*>(xbc + (size_t)m * 3072 + (n - 2048)) = make_uint2(pack2(v[0], v[1]), pack2(v[2], v[3]));
    else if (n < 5184) {
      float4 bb = *reinterpret_cast<const float4*>(dtb + (n - 5120));
      *reinterpret_cast<float4*>(dt + (size_t)m * 64 + (n - 5120)) = make_float4(softplusf(v[0] + bb.x), softplusf(v[1] + bb.y), softplusf(v[2] + bb.z), softplusf(v[3] + bb.w));
    }
  };
  auto epi_ctx = [=](int m, int n, f32x4 v) {
    if (n < 3072) *reinterpret_cast<uint2*>(xbc_c + (size_t)m * 3072 + n) = make_uint2(pack2(v[0], v[1]), pack2(v[2], v[3]));
    else if (n < 3136) {
      float4 bb = *reinterpret_cast<const float4*>(dtb + (n - 3072));
      *reinterpret_cast<float4*>(dt_c + (size_t)m * 64 + (n - 3072)) = make_float4(softplusf(v[0] + bb.x), softplusf(v[1] + bb.y), softplusf(v[2] + bb.z), softplusf(v[3] + bb.w));
    }
  };
  for (int t = li; t < 128 * 5; t += nl) {
    int pm = t / 5, pn = xcd + 8 * (t % 5);
    gemm_tile(hx, 1024, Wt, 1024, pm * 256, pn * 128, SSM_IN, 1024, lds, epi_lat);
  }
  for (int t = blockIdx.x; t < 128 + 8 * 25; t += gridDim.x) {
    if (t < 128) gemm_tile(hx, 1024, Wt, 1024, t * 256, 40 * 128, SSM_IN, 1024, lds, epi_lat);
    else {
      int it = t - 128, pm = it / 25, pn = it % 25;
      gemm_tile(hc, 1024, Wt + (size_t)2048 * 1024, 1024, pm * 256, pn * 128, 3136, 1024, lds, epi_ctx);
    }
  }
}

DEV void fma8(float* acc, const u32x4& v, const float* w) {
  acc[0] += bflo(v[0]) * w[0]; acc[1] += bfhi(v[0]) * w[1]; acc[2] += bflo(v[1]) * w[2]; acc[3] += bfhi(v[1]) * w[3];
  acc[4] += bflo(v[2]) * w[4]; acc[5] += bfhi(v[2]) * w[5]; acc[6] += bflo(v[3]) * w[6]; acc[7] += bfhi(v[3]) * w[7];
}
__device__ __forceinline__ void phase_conv(const Params& p) {
  const u16* xbc = (const u16*)(p.ws + OFF_R1);
  u16* xc = (u16*)(p.ws + OFF_R2);
  const u16* xbc_c = (const u16*)(p.ws + OFF_XBC_C);
  u16* xc_c = (u16*)(p.ws + OFF_XC_C);
  const float* cw = p.m_conv_w;
  const float* cb = p.m_conv_b;
  const int tid_ = otid();
  const size_t nl = (size_t)8 * 64 * 8 * 384;
  for (size_t e = (size_t)blockIdx.x * 256 + tid_; e < nl; e += (size_t)gridDim.x * 256) {
    int ch = (int)(e % 384) * 8;
    int rest = (int)(e / 384);
    int cg_ = rest & 7, r = (rest >> 3) & 63, b = rest >> 9;
    float w[9][8];
#pragma unroll
    for (int k = 0; k < 9; ++k) {
      float4 w0 = *reinterpret_cast<const float4*>(cw + k * 3072 + ch), w1 = *reinterpret_cast<const float4*>(cw + k * 3072 + ch + 4);
      w[k][0] = w0.x; w[k][1] = w0.y; w[k][2] = w0.z; w[k][3] = w0.w; w[k][4] = w1.x; w[k][5] = w1.y; w[k][6] = w1.z; w[k][7] = w1.w;
    }
    float bias[8];
    {
      float4 b0 = *reinterpret_cast<const float4*>(cb + ch), b1 = *reinterpret_cast<const float4*>(cb + ch + 4);
      bias[0] = b0.x; bias[1] = b0.y; bias[2] = b0.z; bias[3] = b0.w; bias[4] = b1.x; bias[5] = b1.y; bias[6] = b1.z; bias[7] = b1.w;
    }
    const u32x4 zero4 = u32x4{0u, 0u, 0u, 0u};
    const int c0 = cg_ * 8;
    u32x4 win[3][3];
#pragma unroll
    for (int i = 0; i < 3; ++i) {
      int rr = r + i - 1;
      bool rok = rr >= 0 && rr <= 63;
      const u16* rowp = xbc + ((size_t)(b * 4096 + (rok ? rr : r) * 64)) * 3072 + ch;
      win[i][0] = (rok && c0 > 0) ? *reinterpret_cast<const u32x4*>(rowp + (size_t)(c0 - 1) * 3072) : zero4;
      win[i][1] = rok ? *reinterpret_cast<const u32x4*>(rowp + (size_t)c0 * 3072) : zero4;
    }
#pragma unroll
    for (int cc = 0; cc < 8; ++cc) {
      int c = c0 + cc;
#pragma unroll
      for (int i = 0; i < 3; ++i) {
        int rr = r + i - 1;
        bool rok = rr >= 0 && rr <= 63;
        const u16* rowp = xbc + ((size_t)(b * 4096 + (rok ? rr : r) * 64)) * 3072 + ch;
        win[i][2] = (rok && c < 63) ? *reinterpret_cast<const u32x4*>(rowp + (size_t)(c + 1) * 3072) : zero4;
      }
      float acc[8];
#pragma unroll
      for (int k = 0; k < 8; ++k) acc[k] = bias[k];
#pragma unroll
      for (int i = 0; i < 3; ++i)
#pragma unroll
        for (int j = 0; j < 3; ++j) fma8(acc, win[i][j], w[i * 3 + j]);
      uint4 o;
      o.x = pack2(siluf(acc[0]), siluf(acc[1]));
      o.y = pack2(siluf(acc[2]), siluf(acc[3]));
      o.z = pack2(siluf(acc[4]), siluf(acc[5]));
      o.w = pack2(siluf(acc[6]), siluf(acc[7]));
      *reinterpret_cast<uint4*>(xc + ((size_t)(b * 4096 + r * 64 + c)) * 3072 + ch) = o;
#pragma unroll
      for (int i = 0; i < 3; ++i) { win[i][0] = win[i][1]; win[i][1] = win[i][2]; }
    }
  }
  const size_t ncx = (size_t)NTC * 384;
  for (size_t e = (size_t)blockIdx.x * 256 + tid_; e < ncx; e += (size_t)gridDim.x * 256) {
    int tok = (int)(e / 384), ch = (int)(e % 384) * 8;
    float acc[8];
#pragma unroll
    for (int k = 0; k < 8; ++k) acc[k] = cb[ch + k];
    int b = tok >> 8, c = tok & 255;
#pragma unroll
    for (int j = 0; j < 3; ++j) {
      int cc = c + j - 1;
      if (cc < 0 || cc > 255) continue;
      uint4 v = *reinterpret_cast<const uint4*>(xbc_c + ((size_t)(b * 256 + cc)) * 3072 + ch);
      const float* w = cw + (3 + j) * 3072 + ch;
      float4 w0 = *reinterpret_cast<const float4*>(w), w1 = *reinterpret_cast<const float4*>(w + 4);
      acc[0] += bflo(v.x) * w0.x; acc[1] += bfhi(v.x) * w0.y; acc[2] += bflo(v.y) * w0.z; acc[3] += bfhi(v.y) * w0.w;
      acc[4] += bflo(v.z) * w1.x; acc[5] += bfhi(v.z) * w1.y; acc[6] += bflo(v.w) * w1.z; acc[7] += bfhi(v.w) * w1.w;
    }
    uint4 o;
    o.x = pack2(siluf(acc[0]), siluf(acc[1]));
    o.y = pack2(siluf(acc[2]), siluf(acc[3]));
    o.z = pack2(siluf(acc[4]), siluf(acc[5]));
    o.w = pack2(siluf(acc[6]), siluf(acc[7]));
    *reinterpret_cast<uint4*>(xc_c + (size_t)tok * 3072 + ch) = o;
  }
}

constexpr int SLD = 136;
__device__ __forceinline__ void phase_ssd(const Params& p, char* lds) {
  u16* xsT = (u16*)lds;
  u16* stb = xsT + 64 * SLD;
  u16* Mb = stb + 64 * SLD;
  float* cum = (float*)(Mb + 128 * SLD);
  float* dtv = cum + 128;
  float* asrc = dtv + 128;
  const u16* xc = (const u16*)(p.ws + OFF_R2);
  const u16* xc_c = (const u16*)(p.ws + OFF_XC_C);
  const float* dt = (const float*)(p.ws + OFF_DT);
  const float* dt_c = (const float*)(p.ws + OFF_DT_C);
  u16* y = (u16*)(p.ws + OFF_R1);
  int tid = otid(), w = tid >> 6, lane = tid & 63, fr = lane & 15, fq = lane >> 4;
  unsigned char* yb8 = (unsigned char*)(p.ws + OFF_R1 + 128 * MiB);
  for (int item = blockIdx.x; item < 512; item += gridDim.x) {
    int b = item >> 6, h = (item >> 1) & 31, g = h >> 3;
    float dsk = p.m_d[h];
    {
      const int dir = item & 1;
      float a_neg = -__expf(p.m_a_log[dir * 32 + h]);
      f32x4 acc_s[8];
#pragma unroll
      for (int n = 0; n < 8; ++n) acc_s[n] = f32x4{0.f, 0.f, 0.f, 0.f};
      for (int step = 0; step < 34; ++step) {
        bool isctx = step < 2;
        int cidx = isctx ? step : step - 2;
        if (dir) cidx = (isctx ? 1 : 31) - cidx;
        size_t tok0 = isctx ? (size_t)(b * 256 + cidx * 128) : (size_t)(b * 4096 + cidx * 128);
        const u16* src = (isctx ? xc_c : xc) + tok0 * 3072;
        const float* dts = (isctx ? dt_c : dt) + tok0 * 64;
        int tz = tid;
        asm volatile("" : "+v"(tz));
        float dval = 0.f;
        if (tid < 128) dval = dts[tid * 64 + dir * 32 + h];
        uint4 xv[4], bv[8];
#pragma unroll
        for (int i = 0; i < 4; ++i) {
          int idx = tz + i * 256, l = (idx & 31) | ((idx >> 8) << 5), pc = ((idx >> 5) & 7) * 8;
          xv[i] = *reinterpret_cast<const uint4*>(src + (size_t)l * 3072 + h * 64 + pc);
        }
#pragma unroll
        for (int i = 0; i < 8; ++i) {
          int idx = tz + i * 256, l = (idx & 31) | (((idx >> 9) & 3) << 5), nc = (((idx >> 5) & 7) | (((idx >> 8) & 1) << 3)) * 8;
          bv[i] = *reinterpret_cast<const uint4*>(src + (size_t)l * 3072 + 2048 + g * 128 + nc);
        }
        if (tid < 128) { dtv[tid] = dval; asrc[tid] = dval * a_neg; }
#pragma unroll
        for (int i = 0; i < 4; ++i) {
          int idx = tz + i * 256, l = (idx & 31) | ((idx >> 8) << 5), pc = ((idx >> 5) & 7) * 8;
          uint4 v = xv[i];
          xsT[(pc + 0) * SLD + l] = (u16)(v.x & 0xffff); xsT[(pc + 1) * SLD + l] = (u16)(v.x >> 16);
          xsT[(pc + 2) * SLD + l] = (u16)(v.y & 0xffff); xsT[(pc + 3) * SLD + l] = (u16)(v.y >> 16);
          xsT[(pc + 4) * SLD + l] = (u16)(v.z & 0xffff); xsT[(pc + 5) * SLD + l] = (u16)(v.z >> 16);
          xsT[(pc + 6) * SLD + l] = (u16)(v.w & 0xffff); xsT[(pc + 7) * SLD + l] = (u16)(v.w >> 16);
        }
        if (!isctx) {
#pragma unroll
          for (int i = 0; i < 8; ++i) {
            int idx = tz + i * 256, l = (idx & 31) | (((idx >> 9) & 3) << 5), nc = (((idx >> 5) & 7) | (((idx >> 8) & 1) << 3)) * 8;
            *reinterpret_cast<uint4*>(Mb + l * SLD + nc) = bv[i];
          }
        }
        __syncthreads();
        bf16x8 Cf[2][4];
        if (!isctx) {
#pragma unroll
          for (int mt = 0; mt < 2; ++mt)
#pragma unroll
            for (int kk = 0; kk < 4; ++kk) Cf[mt][kk] = ld8(src + (size_t)(w * 32 + mt * 16 + fr) * 3072 + 2560 + g * 128 + kk * 32 + fq * 8);
        }
        if (tid < 128) {
          float s = 0.f;
          if (!dir) { for (int j = 0; j <= tid; ++j) s += asrc[j]; }
          else { for (int j = tid; j < 128; ++j) s += asrc[j]; }
          cum[tid] = s;
        }
        __syncthreads();
        float total = dir ? cum[0] : cum[127];
        if (!isctx) {
          float cl[2][4];
#pragma unroll
          for (int mt = 0; mt < 2; ++mt)
#pragma unroll
            for (int j = 0; j < 4; ++j) cl[mt][j] = cum[w * 32 + mt * 16 + fq * 4 + j];
          f32x4 cb0[8], cb1[8];
#pragma unroll
          for (int nt = 0; nt < 8; ++nt) {
            cb0[nt] = f32x4{0.f, 0.f, 0.f, 0.f};
            cb1[nt] = f32x4{0.f, 0.f, 0.f, 0.f};
            bool need = dir ? (nt >= w * 2) : (nt <= w * 2 + 1);
            if (need) {
#pragma unroll
              for (int kk = 0; kk < 4; ++kk) {
                bf16x8 Bf = ld8(Mb + (nt * 16 + fr) * SLD + kk * 32 + fq * 8);
                cb0[nt] = mfma16(Cf[0][kk], Bf, cb0[nt]);
                cb1[nt] = mfma16(Cf[1][kk], Bf, cb1[nt]);
              }
            }
          }
          __syncthreads();
          int zero = 0;
          asm volatile("" : "+v"(zero));
#pragma unroll
          for (int nt = 0; nt < 8; ++nt) {
            int s = nt * 16 + fr + zero;
            float cs = cum[s], ds = dtv[s];
#pragma unroll
            for (int j = 0; j < 4; ++j) {
              int l0 = w * 32 + fq * 4 + j, l1 = l0 + 16;
              bool ok0 = dir ? (s >= l0) : (s <= l0);
              bool ok1 = dir ? (s >= l1) : (s <= l1);
              float v0 = ok0 ? cb0[nt][j] * __expf(cl[0][j] - cs) * ds : 0.f;
              float v1 = ok1 ? cb1[nt][j] * __expf(cl[1][j] - cs) * ds : 0.f;
              Mb[l0 * SLD + s] = f2bf(v0);
              Mb[l1 * SLD + s] = f2bf(v1);
            }
          }
          __syncthreads();
          f32x4 ya[2][4];
#pragma unroll
          for (int mt = 0; mt < 2; ++mt)
#pragma unroll
            for (int nt = 0; nt < 4; ++nt) ya[mt][nt] = f32x4{0.f, 0.f, 0.f, 0.f};
#pragma unroll
          for (int kk = 0; kk < 4; ++kk)
#pragma unroll
            for (int nt = 0; nt < 4; ++nt) {
              bf16x8 Sf = ld8(stb + (nt * 16 + fr) * SLD + kk * 32 + fq * 8);
              ya[0][nt] = mfma16(Cf[0][kk], Sf, ya[0][nt]);
              ya[1][nt] = mfma16(Cf[1][kk], Sf, ya[1][nt]);
            }
#pragma unroll
          for (int mt = 0; mt < 2; ++mt)
#pragma unroll
            for (int j = 0; j < 4; ++j) {
              float e = __expf(cl[mt][j]);
#pragma unroll
              for (int nt = 0; nt < 4; ++nt) ya[mt][nt][j] *= e;
            }
#pragma unroll
          for (int kk = 0; kk < 4; ++kk) {
            bf16x8 Mf0 = ld8(Mb + (w * 32 + fr) * SLD + kk * 32 + fq * 8);
            bf16x8 Mf1 = ld8(Mb + (w * 32 + 16 + fr) * SLD + kk * 32 + fq * 8);
#pragma unroll
            for (int nt = 0; nt < 4; ++nt) {
              bf16x8 Xf = ld8(xsT + (nt * 16 + fr) * SLD + kk * 32 + fq * 8);
              ya[0][nt] = mfma16(Mf0, Xf, ya[0][nt]);
              ya[1][nt] = mfma16(Mf1, Xf, ya[1][nt]);
            }
          }
#pragma unroll
          for (int i = 0; i < 8; ++i) {
            int idx = tz + i * 256, l = (idx & 31) | (((idx >> 9) & 3) << 5), nc = (((idx >> 5) & 7) | (((idx >> 8) & 1) << 3)) * 8;
            bv[i] = *reinterpret_cast<const uint4*>(src + (size_t)l * 3072 + 2048 + g * 128 + nc);
          }
#pragma unroll
          for (int mt = 0; mt < 2; ++mt)
#pragma unroll
            for (int nt = 0; nt < 4; ++nt)
#pragma unroll
              for (int j = 0; j < 4; ++j) {
                int l = w * 32 + mt * 16 + fq * 4 + j, pp = nt * 16 + fr;
                float val = ya[mt][nt][j];
                if (!dir) {
                  val += bf2f(xsT[pp * SLD + l]) * dsk;
                  y[(tok0 + l) * 2048 + h * 64 + pp] = f2bf(val);
                } else {
                  yb8[(tok0 + l) * 2048 + h * 64 + pp] = (unsigned char)(__builtin_amdgcn_cvt_pk_fp8_f32(fminf(fmaxf(val * 4.f, -440.f), 440.f), 0.f, 0, false) & 0xFF);
                }
              }
        }
        if (step == 33) continue;
        __syncthreads();
#pragma unroll
        for (int i = 0; i < 8; ++i) {
          int idx = tz + i * 256, l = (idx & 31) | (((idx >> 9) & 3) << 5), nc = (((idx >> 5) & 7) | (((idx >> 8) & 1) << 3)) * 8;
          uint4 v = bv[i];
          float sc = dtv[l] * __expf(total - cum[l]);
          Mb[(nc + 0) * SLD + l] = f2bf(bflo(v.x) * sc); Mb[(nc + 1) * SLD + l] = f2bf(bfhi(v.x) * sc);
          Mb[(nc + 2) * SLD + l] = f2bf(bflo(v.y) * sc); Mb[(nc + 3) * SLD + l] = f2bf(bfhi(v.y) * sc);
          Mb[(nc + 4) * SLD + l] = f2bf(bflo(v.z) * sc); Mb[(nc + 5) * SLD + l] = f2bf(bfhi(v.z) * sc);
          Mb[(nc + 6) * SLD + l] = f2bf(bflo(v.w) * sc); Mb[(nc + 7) * SLD + l] = f2bf(bfhi(v.w) * sc);
        }
        __syncthreads();
        float cd = __expf(total);
#pragma unroll
        for (int nt = 0; nt < 8; ++nt) acc_s[nt] *= cd;
#pragma unroll
        for (int kk = 0; kk < 4; ++kk) {
          bf16x8 Af = ld8(xsT + (w * 16 + fr) * SLD + kk * 32 + fq * 8);
#pragma unroll
          for (int nt = 0; nt < 8; ++nt) {
            bf16x8 Bf = ld8(Mb + (nt * 16 + fr) * SLD + kk * 32 + fq * 8);
            acc_s[nt] = mfma16(Af, Bf, acc_s[nt]);
          }
        }
#pragma unroll
        for (int nt = 0; nt < 8; ++nt)
#pragma unroll
          for (int j = 0; j < 4; ++j) stb[(w * 16 + fq * 4 + j) * SLD + nt * 16 + fr] = f2bf(acc_s[nt][j]);
        __syncthreads();
      }
      __syncthreads();
    }
  }
}

__device__ __forceinline__ void phase_gated_norm(const Params& p) {
  u16* y = (u16*)(p.ws + OFF_R1);
  const u16* z = (const u16*)p.out;
  const unsigned char* yb8 = (const unsigned char*)(p.ws + OFF_R1 + 128 * MiB);
  const int tid_ = otid();
  int lane = tid_ & 63;
  int wave = blockIdx.x * 4 + (tid_ >> 6), nw = gridDim.x * 4;
  for (int tok = wave; tok < NT; tok += nw) {
#pragma unroll
    for (int g = 0; g < 4; ++g) {
      int ch = g * 512 + lane * 8;
      uint4 yv = *reinterpret_cast<const uint4*>(y + (size_t)tok * 2048 + ch);
      uint4 zv = *reinterpret_cast<const uint4*>(z + (size_t)tok * 2048 + ch);
      uint2 bw = *reinterpret_cast<const uint2*>(yb8 + (size_t)tok * 2048 + ch);
      f32x2 b01 = __builtin_amdgcn_cvt_pk_f32_fp8((int)bw.x, false), b23 = __builtin_amdgcn_cvt_pk_f32_fp8((int)bw.x, true);
      f32x2 b45 = __builtin_amdgcn_cvt_pk_f32_fp8((int)bw.y, false), b67 = __builtin_amdgcn_cvt_pk_f32_fp8((int)bw.y, true);
      const float r16 = 0.25f;
      float u[8];
      u[0] = (bflo(yv.x) + b01.x * r16) * siluf(bflo(zv.x)); u[1] = (bfhi(yv.x) + b01.y * r16) * siluf(bfhi(zv.x));
      u[2] = (bflo(yv.y) + b23.x * r16) * siluf(bflo(zv.y)); u[3] = (bfhi(yv.y) + b23.y * r16) * siluf(bfhi(zv.y));
      u[4] = (bflo(yv.z) + b45.x * r16) * siluf(bflo(zv.z)); u[5] = (bfhi(yv.z) + b45.y * r16) * siluf(bfhi(zv.z));
      u[6] = (bflo(yv.w) + b67.x * r16) * siluf(bflo(zv.w)); u[7] = (bfhi(yv.w) + b67.y * r16) * siluf(bfhi(zv.w));
      float ss = 0.f;
#pragma unroll
      for (int k = 0; k < 8; ++k) ss += u[k] * u[k];
      ss = wave_sum(ss);
      float sc = rsqrtf(ss * (1.f / 512.f) + 1e-5f);
      float4 w0 = *reinterpret_cast<const float4*>(p.m_norm_w + ch), w1 = *reinterpret_cast<const float4*>(p.m_norm_w + ch + 4);
      uint4 o;
      o.x = pack2(u[0] * sc * w0.x, u[1] * sc * w0.y);
      o.y = pack2(u[2] * sc * w0.z, u[3] * sc * w0.w);
      o.z = pack2(u[4] * sc * w1.x, u[5] * sc * w1.y);
      o.w = pack2(u[6] * sc * w1.z, u[7] * sc * w1.w);
      *reinterpret_cast<uint4*>(y + (size_t)tok * 2048 + ch) = o;
    }
  }
}

__device__ __forceinline__ void phase_gemm_resid(const u16* A, int K, const u16* Wt, const float* res, float* dst, const float* gate  , char* lds) {
  const int xcd = blockIdx.x & 7, li = blockIdx.x >> 3, nl = gridDim.x >> 3;
  for (int t = li; t < 128; t += nl) {
    int pm = t, pn = xcd;
    gemm_tile(A, K, Wt, K, pm * 256, pn * 128, 1024, K, lds, [=](int m, int n, f32x4 v) {
      int b = m >> 12;
      float4 r = *reinterpret_cast<const float4*>(res + (size_t)m * 1024 + n);
      float4 g = *reinterpret_cast<const float4*>(gate + (size_t)b * 6144 + n);
      *reinterpret_cast<float4*>(dst + (size_t)m * 1024 + n) = make_float4(ALPHA * r.x + g.x * v[0], ALPHA * r.y + g.y * v[1], ALPHA * r.z + g.z * v[2], ALPHA * r.w + g.w * v[3]);
    });
  }
}
__device__ __forceinline__ void phase_gemm_bf16(const u16* A, const u16* Wt, u16* dst, int N, char* lds) {
  const int xcd = blockIdx.x & 7, li = blockIdx.x >> 3, nl = gridDim.x >> 3;
  const int nb = N / 1024;
  for (int t = li; t < 128 * nb; t += nl) {
    int pm = t / nb, pn = xcd + 8 * (t % nb);
    gemm_tile(A, 1024, Wt, 1024, pm * 256, pn * 128, N, 1024, lds, [=](int m, int n, f32x4 v) { *reinterpret_cast<uint2*>(dst + (size_t)m * N + n) = make_uint2(pack2(v[0], v[1]), pack2(v[2], v[3])); });
  }
}

__device__ __forceinline__ void phase_ln_mod(float* xio, const float* g, const float* bta, const float* mod  , u16* tdst) {
  const int tid_ = otid();
  int lane = tid_ & 63;
  int wave = blockIdx.x * 4 + (tid_ >> 6), nw = gridDim.x * 4;
  for (int tok = wave; tok < NT; tok += nw) {
    int b = tok >> 12;
    float4 v[4];
    float s = 0.f;
#pragma unroll
    for (int i = 0; i < 4; ++i) {
      v[i] = *reinterpret_cast<const float4*>(xio + (size_t)tok * 1024 + i * 256 + lane * 4);
      s += v[i].x + v[i].y + v[i].z + v[i].w;
    }
    float mu = wave_sum(s) * (1.f / 1024.f);
    float q = 0.f;
#pragma unroll
    for (int i = 0; i < 4; ++i) {
      v[i].x -= mu; v[i].y -= mu; v[i].z -= mu; v[i].w -= mu;
      q += v[i].x * v[i].x + v[i].y * v[i].y + v[i].z * v[i].z + v[i].w * v[i].w;
    }
    float rs = rsqrtf(wave_sum(q) * (1.f / 1024.f) + 1e-5f);
    const float* m = mod + (size_t)b * 6144;
#pragma unroll
    for (int i = 0; i < 4; ++i) {
      int c = i * 256 + lane * 4;
      float4 gg = *reinterpret_cast<const float4*>(g + c), bb = *reinterpret_cast<const float4*>(bta + c);
      float4 o;
      o.x = v[i].x * rs * gg.x + bb.x; o.y = v[i].y * rs * gg.y + bb.y; o.z = v[i].z * rs * gg.z + bb.z; o.w = v[i].w * rs * gg.w + bb.w;
      *reinterpret_cast<float4*>(xio + (size_t)tok * 1024 + c) = o;
      float4 sh = *reinterpret_cast<const float4*>(m + 3072 + c), sc = *reinterpret_cast<const float4*>(m + 4096 + c);
      uint2 t;
      t.x = pack2(o.x * (1.f + sc.x) + sh.x, o.y * (1.f + sc.y) + sh.y);
      t.y = pack2(o.z * (1.f + sc.z) + sh.z, o.w * (1.f + sc.w) + sh.w);
      *reinterpret_cast<uint2*>(tdst + (size_t)tok * 1024 + c) = t;
    }
  }
}

__device__ __forceinline__ void phase_peer_topk(const u16* q, const u16* k1, const u16* k2, int* idxo, float* gateo, char* lds) {
  float* S = (float*)lds;
  float* sv = S + 64 * 129;
  int* si = (int*)(sv + 64 * 16);
  int tid = otid(), w = tid >> 6, lane = tid & 63, fr = lane & 15, fq = lane >> 4;
  const int slot = lane;
  const bool cvalid = lane < 50;
  int ci = slot < 42 ? ((slot >= 16) + (slot >= 24) + (slot >= 29) + (slot >= 33) + (slot >= 36) + (slot >= 38) + (slot >= 40)) : slot - 34;
  const unsigned long long PACK = 0ull | (16ull << 8) | (24ull << 16) | (29ull << 24) | (33ull << 32) | (36ull << 40) | (38ull << 48) | (40ull << 56);
  int cj = slot - (ci < 8 ? (int)((PACK >> (8 * ci)) & 0xFF) : 34 + ci);
  if (!cvalid) { ci = 0; cj = 0; }
  for (int item = blockIdx.x; item < 1024 * 8; item += gridDim.x) {
    int tile = item >> 3, h = item & 7;
    int tok0 = tile * 32;
    {
      int half = w >> 1, kb = (w & 1) * 64;
      const u16* kk_ = (half ? k2 : k1) + (size_t)h * 128 * 128;
      bf16x8 Af[2][4], Bf[4][4];
#pragma unroll
      for (int m = 0; m < 2; ++m)
#pragma unroll
        for (int ks = 0; ks < 4; ++ks) Af[m][ks] = ld8(q + (size_t)(tok0 + m * 16 + fr) * 2048 + h * 256 + half * 128 + ks * 32 + fq * 8);
#pragma unroll
      for (int n = 0; n < 4; ++n)
#pragma unroll
        for (int ks = 0; ks < 4; ++ks) Bf[n][ks] = ld8(kk_ + (size_t)(kb + n * 16 + fr) * 128 + ks * 32 + fq * 8);
      f32x4 acc[2][4];
#pragma unroll
      for (int m = 0; m < 2; ++m)
#pragma unroll
        for (int n = 0; n < 4; ++n) acc[m][n] = f32x4{0.f, 0.f, 0.f, 0.f};
#pragma unroll
      for (int ks = 0; ks < 4; ++ks)
#pragma unroll
        for (int n = 0; n < 4; ++n) {
          acc[0][n] = mfma16(Af[0][ks], Bf[n][ks], acc[0][n]);
          acc[1][n] = mfma16(Af[1][ks], Bf[n][ks], acc[1][n]);
        }
#pragma unroll
      for (int m = 0; m < 2; ++m)
#pragma unroll
        for (int n = 0; n < 4; ++n)
#pragma unroll
          for (int j = 0; j < 4; ++j) S[(half * 32 + m * 16 + fq * 4 + j) * 129 + kb + n * 16 + fr] = acc[m][n][j];
    }
    __syncthreads();
#pragma unroll 1
    for (int li = 0; li < 16; ++li) {
      int list = w * 16 + li;
      const float* row = S + list * 129;
      float vlo = row[lane], vhi = row[lane + 64];
      unsigned long long klo = ((unsigned long long)ordkey(vlo) << 7) | (unsigned)(127 - lane);
      unsigned long long khi = ((unsigned long long)ordkey(vhi) << 7) | (unsigned)(63 - lane);
      unsigned long long T = 0;
#pragma unroll 3
      for (int bit = 38; bit >= 0; --bit) {
        unsigned long long cand = T | (1ull << bit);
        int cnt = __popcll(__ballot(klo >= cand)) + __popcll(__ballot(khi >= cand));
        if (cnt >= 16) T = cand;
        if (cnt == 16) break;
      }
      bool slo = klo >= T, shi = khi >= T;
      unsigned long long mlo = __ballot(slo), mhi = __ballot(shi);
      int rlo = 0, rhi = 0;
      int klo_l = (int)(unsigned)klo, klo_h = (int)(unsigned)(klo >> 32), khi_l = (int)(unsigned)khi, khi_h = (int)(unsigned)(khi >> 32);
      while (mlo) {
        int src = __ffsll((long long)mlo) - 1;
        mlo &= mlo - 1;
        unsigned long long ks = ((unsigned long long)(unsigned)__builtin_amdgcn_readlane(klo_h, src) << 32) | (unsigned)__builtin_amdgcn_readlane(klo_l, src);
        rlo += (ks > klo) ? 1 : 0;
        rhi += (ks > khi) ? 1 : 0;
      }
      while (mhi) {
        int src = __ffsll((long long)mhi) - 1;
        mhi &= mhi - 1;
        unsigned long long ks = ((unsigned long long)(unsigned)__builtin_amdgcn_readlane(khi_h, src) << 32) | (unsigned)__builtin_amdgcn_readlane(khi_l, src);
        rlo += (ks > klo) ? 1 : 0;
        rhi += (ks > khi) ? 1 : 0;
      }
      if (slo) { sv[list * 16 + rlo] = vlo; si[list * 16 + rlo] = lane; }
      if (shi) { sv[list * 16 + rhi] = vhi; si[list * 16 + rhi] = lane + 64; }
    }
    __syncthreads();
#pragma unroll 1
    for (int tt = 0; tt < 8; ++tt) {
      int tok = w * 8 + tt;
      float sc_ = sv[tok * 16 + ci] + sv[(32 + tok) * 16 + cj];
      unsigned long long key = cvalid ? ((((unsigned long long)ordkey(sc_)) << 6) | (unsigned)(63 - lane)) : 0ull;
      unsigned long long T = 0;
#pragma unroll 3
      for (int bit = 37; bit >= 0; --bit) {
        unsigned long long cand = T | (1ull << bit);
        int cnt = __popcll(__ballot(key >= cand));
        if (cnt >= 16) T = cand;
        if (cnt == 16) break;
      }
      bool sel = cvalid && key >= T;
      unsigned long long msel = __ballot(sel);
      int rank = 0;
      int k_l = (int)(unsigned)key, k_h = (int)(unsigned)(key >> 32);
      int isc = __float_as_int(sc_);
      unsigned long long mm = msel;
      float mx = -INFINITY;
      while (mm) {
        int src = __ffsll((long long)mm) - 1;
        mm &= mm - 1;
        unsigned long long ks = ((unsigned long long)(unsigned)__builtin_amdgcn_readlane(k_h, src) << 32) | (unsigned)__builtin_amdgcn_readlane(k_l, src);
        rank += (ks > key) ? 1 : 0;
        mx = fmaxf(mx, __int_as_float(__builtin_amdgcn_readlane(isc, src)));
      }
      float ex = sel ? __expf(sc_ - mx) : 0.f;
      int iex = __float_as_int(ex);
      float sum = 0.f;
      mm = msel;
      while (mm) {
        int src = __ffsll((long long)mm) - 1;
        mm &= mm - 1;
        sum += __int_as_float(__builtin_amdgcn_readlane(iex, src));
      }
      if (sel) {
        size_t o = (size_t)(tok0 + tok) * 128 + h * 16 + rank;
        gateo[o] = ex / sum;
        idxo[o] = si[tok * 16 + ci] * 128 + si[(32 + tok) * 16 + cj];
      }
    }
  }
  __syncthreads();
}

DEV float gelu_exact(float v) { return 0.5f * v * (1.f + erff(v * 0.70710678118654752f)); }

__device__ __forceinline__ void convert_fp8_rows(const float* src, unsigned char* dst, float* rscale, int nrows) {
  const int tid_ = otid();
  int lane = tid_ & 63;
  int wave = blockIdx.x * 4 + (tid_ >> 6), nw = gridDim.x * 4;
  for (int row = wave; row < nrows; row += nw) {
    const float* r = src + (size_t)row * 1024 + lane * 16;
    float4 a0 = *reinterpret_cast<const float4*>(r), a1 = *reinterpret_cast<const float4*>(r + 4);
    float4 a2 = *reinterpret_cast<const float4*>(r + 8), a3 = *reinterpret_cast<const float4*>(r + 12);
    float m = fmaxf(fmaxf(fmaxf(fabsf(a0.x), fabsf(a0.y)), fmaxf(fabsf(a0.z), fabsf(a0.w))), fmaxf(fmaxf(fabsf(a1.x), fabsf(a1.y)), fmaxf(fabsf(a1.z), fabsf(a1.w))));
    m = fmaxf(m, fmaxf(fmaxf(fmaxf(fabsf(a2.x), fabsf(a2.y)), fmaxf(fabsf(a2.z), fabsf(a2.w))), fmaxf(fmaxf(fabsf(a3.x), fabsf(a3.y)), fmaxf(fabsf(a3.z), fabsf(a3.w)))));
#pragma unroll
    for (int o = 32; o > 0; o >>= 1) m = fmaxf(m, __shfl_xor(m, o));
    float sc = m > 0.f ? exp2f(floorf(log2f(224.f / m))) : 1.f;
    uint4 o;
    int p;
    p = __builtin_amdgcn_cvt_pk_fp8_f32(a0.x * sc, a0.y * sc, 0, false); p = __builtin_amdgcn_cvt_pk_fp8_f32(a0.z * sc, a0.w * sc, p, true); o.x = (unsigned)p;
    p = __builtin_amdgcn_cvt_pk_fp8_f32(a1.x * sc, a1.y * sc, 0, false); p = __builtin_amdgcn_cvt_pk_fp8_f32(a1.z * sc, a1.w * sc, p, true); o.y = (unsigned)p;
    p = __builtin_amdgcn_cvt_pk_fp8_f32(a2.x * sc, a2.y * sc, 0, false); p = __builtin_amdgcn_cvt_pk_fp8_f32(a2.z * sc, a2.w * sc, p, true); o.z = (unsigned)p;
    p = __builtin_amdgcn_cvt_pk_fp8_f32(a3.x * sc, a3.y * sc, 0, false); p = __builtin_amdgcn_cvt_pk_fp8_f32(a3.z * sc, a3.w * sc, p, true); o.w = (unsigned)p;
    *reinterpret_cast<uint4*>(dst + (size_t)row * 1024 + lane * 16) = o;
    if (lane == 0) rscale[row] = 1.f / sc;
  }
}

#define F8X(dst, WW) { dst[0] = __builtin_amdgcn_cvt_pk_f32_fp8((int)(WW).x, false); dst[1] = __builtin_amdgcn_cvt_pk_f32_fp8((int)(WW).x, true); \
                      dst[2] = __builtin_amdgcn_cvt_pk_f32_fp8((int)(WW).y, false); dst[3] = __builtin_amdgcn_cvt_pk_f32_fp8((int)(WW).y, true); \
                      dst[4] = __builtin_amdgcn_cvt_pk_f32_fp8((int)(WW).z, false); dst[5] = __builtin_amdgcn_cvt_pk_f32_fp8((int)(WW).z, true); \
                      dst[6] = __builtin_amdgcn_cvt_pk_f32_fp8((int)(WW).w, false); dst[7] = __builtin_amdgcn_cvt_pk_f32_fp8((int)(WW).w, true); }

__device__ __forceinline__ void phase_peer_gather(const u16* tin, const int* idx, const float* gate, const unsigned char* utab, const unsigned char* vtab,
                                  const float* urs, const float* vrs, const float* xres,
                                  const float* g2  , const float* lng, const float* lnb, float* xout,
                                  const float* modnext  , u16* hxout) {
  const int tid_ = otid();
  int lane = tid_ & 63;
  int wave = blockIdx.x * 4 + (tid_ >> 6), nw = gridDim.x * 4;
  for (int tok = wave; tok < NT; tok += nw) {
    int b = tok >> 12;
    f32x2 t2[8];
    {
      uint4 ta = *reinterpret_cast<const uint4*>(tin + (size_t)tok * 1024 + lane * 16);
      uint4 tb = *reinterpret_cast<const uint4*>(tin + (size_t)tok * 1024 + lane * 16 + 8);
      t2[0] = f32x2{bflo(ta.x), bfhi(ta.x)}; t2[1] = f32x2{bflo(ta.y), bfhi(ta.y)}; t2[2] = f32x2{bflo(ta.z), bfhi(ta.z)}; t2[3] = f32x2{bflo(ta.w), bfhi(ta.w)};
      t2[4] = f32x2{bflo(tb.x), bfhi(tb.x)}; t2[5] = f32x2{bflo(tb.y), bfhi(tb.y)}; t2[6] = f32x2{bflo(tb.z), bfhi(tb.z)}; t2[7] = f32x2{bflo(tb.w), bfhi(tb.w)};
    }
    int id0 = idx[(size_t)tok * 128 + lane] & 16383, id1 = idx[(size_t)tok * 128 + 64 + lane] & 16383;
    int gt0 = __float_as_int(gate[(size_t)tok * 128 + lane]), gt1 = __float_as_int(gate[(size_t)tok * 128 + 64 + lane]);
    f32x2 acc2[8];
#pragma unroll
    for (int k = 0; k < 8; ++k) acc2[k] = f32x2{0.f, 0.f};
#pragma unroll 1
    for (int j = 0; j < 128; j += 4) {
      int e[4];
      float g[4];
      if (j < 64) {
#pragma unroll
        for (int q = 0; q < 4; ++q) { e[q] = __builtin_amdgcn_readlane(id0, j + q); g[q] = __int_as_float(__builtin_amdgcn_readlane(gt0, j + q)); }
      } else {
#pragma unroll
        for (int q = 0; q < 4; ++q) { e[q] = __builtin_amdgcn_readlane(id1, j - 64 + q); g[q] = __int_as_float(__builtin_amdgcn_readlane(gt1, j - 64 + q)); }
      }
      uint4 U[4], V[4];
      float su[4], sv_[4];
#pragma unroll
      for (int q = 0; q < 4; ++q) {
        U[q] = *reinterpret_cast<const uint4*>(utab + (size_t)e[q] * 1024 + lane * 16);
        V[q] = *reinterpret_cast<const uint4*>(vtab + (size_t)e[q] * 1024 + lane * 16);
        su[q] = urs[e[q]];
        sv_[q] = vrs[e[q]];
      }
      float d[4];
#pragma unroll
      for (int q = 0; q < 4; ++q) {
        f32x2 u2[8];
        F8X(u2, U[q])
        f32x2 dd = u2[0] * t2[0];
#pragma unroll
        for (int k = 1; k < 8; ++k) dd = u2[k] * t2[k] + dd;
        d[q] = dd.x + dd.y;
      }
#pragma unroll
      for (int o = 32; o > 0; o >>= 1) {
#pragma unroll
        for (int q = 0; q < 4; ++q) d[q] += __shfl_xor(d[q], o);
      }
#pragma unroll
      for (int q = 0; q < 4; ++q) {
        float a = g[q] * gelu_exact(d[q] * su[q]) * sv_[q];
        f32x2 aa = f32x2{a, a};
        f32x2 v2[8];
        F8X(v2, V[q])
#pragma unroll
        for (int k = 0; k < 8; ++k) acc2[k] = aa * v2[k] + acc2[k];
      }
    }
    float vv[16];
    float s = 0.f;
    const int c0 = lane * 16;
#pragma unroll
    for (int k4 = 0; k4 < 4; ++k4) {
      float4 x0 = *reinterpret_cast<const float4*>(xres + (size_t)tok * 1024 + c0 + k4 * 4);
      float4 g0 = *reinterpret_cast<const float4*>(g2 + (size_t)b * 6144 + c0 + k4 * 4);
      vv[k4 * 4 + 0] = ALPHA * x0.x + g0.x * acc2[k4 * 2].x; vv[k4 * 4 + 1] = ALPHA * x0.y + g0.y * acc2[k4 * 2].y;
      vv[k4 * 4 + 2] = ALPHA * x0.z + g0.z * acc2[k4 * 2 + 1].x; vv[k4 * 4 + 3] = ALPHA * x0.w + g0.w * acc2[k4 * 2 + 1].y;
    }
#pragma unroll
    for (int k = 0; k < 16; ++k) s += vv[k];
    float mu = wave_sum(s) * (1.f / 1024.f);
    float qq = 0.f;
#pragma unroll
    for (int k = 0; k < 16; ++k) { vv[k] -= mu; qq += vv[k] * vv[k]; }
    float rs = rsqrtf(wave_sum(qq) * (1.f / 1024.f) + 1e-5f);
    float oo[16];
#pragma unroll
    for (int k4 = 0; k4 < 4; ++k4) {
      float4 ga = *reinterpret_cast<const float4*>(lng + c0 + k4 * 4), ba = *reinterpret_cast<const float4*>(lnb + c0 + k4 * 4);
      float4 o0;
      o0.x = vv[k4 * 4 + 0] * rs * ga.x + ba.x; o0.y = vv[k4 * 4 + 1] * rs * ga.y + ba.y; o0.z = vv[k4 * 4 + 2] * rs * ga.z + ba.z; o0.w = vv[k4 * 4 + 3] * rs * ga.w + ba.w;
      *reinterpret_cast<float4*>(xout + (size_t)tok * 1024 + c0 + k4 * 4) = o0;
      oo[k4 * 4 + 0] = o0.x; oo[k4 * 4 + 1] = o0.y; oo[k4 * 4 + 2] = o0.z; oo[k4 * 4 + 3] = o0.w;
    }
    if (modnext) {
      const float* m = modnext + (size_t)b * 6144;
      unsigned pk[8];
#pragma unroll
      for (int k4 = 0; k4 < 4; ++k4) {
        float4 sh0 = *reinterpret_cast<const float4*>(m + c0 + k4 * 4), sc0 = *reinterpret_cast<const float4*>(m + 1024 + c0 + k4 * 4);
        pk[k4 * 2] = pack2(oo[k4 * 4 + 0] * (1.f + sc0.x) + sh0.x, oo[k4 * 4 + 1] * (1.f + sc0.y) + sh0.y);
        pk[k4 * 2 + 1] = pack2(oo[k4 * 4 + 2] * (1.f + sc0.z) + sh0.z, oo[k4 * 4 + 3] * (1.f + sc0.w) + sh0.w);
      }
      *reinterpret_cast<uint4*>(hxout + (size_t)tok * 1024 + c0) = make_uint4(pk[0], pk[1], pk[2], pk[3]);
      *reinterpret_cast<uint4*>(hxout + (size_t)tok * 1024 + c0 + 8) = make_uint4(pk[4], pk[5], pk[6], pk[7]);
    }
  }
}

__device__ __forceinline__ void phase_shortconv_T(const Params& p, const u16* upre, u16* x1cm, u16* x2cm, u16* vcm, char* lds) {
  u16* tile = (u16*)lds;
  int tid = otid();
  for (int item = blockIdx.x; item < 512 * 48; item += gridDim.x) {
    int tt = item / 48, ct = item % 48;
    int tok0 = tt * 64, c0 = ct * 64;
#pragma unroll
    for (int i = 0; i < 2; ++i) {
      int q = tid + i * 256, tl = q >> 3, cg_ = (q & 7) * 8;
      int tok = tok0 + tl, l = tok & 4095, ch = c0 + cg_;
      float acc[8];
#pragma unroll
      for (int k = 0; k < 8; ++k) acc[k] = p.h_conv_b[ch + k];
#pragma unroll
      for (int j = 0; j < 3; ++j) {
        int ll = l + j - 1;
        if (ll < 0 || ll > 4095) continue;
        uint4 v = *reinterpret_cast<const uint4*>(upre + (size_t)(tok + j - 1) * 3072 + ch);
        const float* w = p.h_conv_w + j * 3072 + ch;
        float4 w0 = *reinterpret_cast<const float4*>(w), w1 = *reinterpret_cast<const float4*>(w + 4);
        acc[0] += bflo(v.x) * w0.x; acc[1] += bfhi(v.x) * w0.y; acc[2] += bflo(v.y) * w0.z; acc[3] += bfhi(v.y) * w0.w;
        acc[4] += bflo(v.z) * w1.x; acc[5] += bfhi(v.z) * w1.y; acc[6] += bflo(v.w) * w1.z; acc[7] += bfhi(v.w) * w1.w;
      }
#pragma unroll
      for (int k = 0; k < 8; ++k) tile[(cg_ + k) * 72 + tl] = f2bf(acc[k]);
    }
    __syncthreads();
    int part = c0 >> 10, d0 = c0 & 1023;
    u16* dst = part == 0 ? x1cm : (part == 1 ? x2cm : vcm);
    int b = tok0 >> 12, l0 = tok0 & 4095;
#pragma unroll
    for (int i = 0; i < 2; ++i) {
      int q = tid + i * 256, c = q >> 3, tg = (q & 7) * 8;
      uint4 v = *reinterpret_cast<const uint4*>(tile + c * 72 + tg);
      *reinterpret_cast<uint4*>(dst + ((size_t)(b * 1024 + d0 + c)) * 4096 + l0 + tg) = v;
    }
    __syncthreads();
  }
}

DEV float2 cmul(float2 a, float2 w) { return make_float2(a.x * w.x - a.y * w.y, a.x * w.y + a.y * w.x); }
DEV float2 cmulc(float2 a, float2 w) { return make_float2(a.x * w.x + a.y * w.y, a.y * w.x - a.x * w.y); }
__device__ __forceinline__ void fft_fwd(float2* X, const float2* __restrict__ tw) {
  int tid = otid();
  for (int s = 12; s >= 2; s -= 2) {
    const int h = 1 << s, q = h >> 1;
#pragma unroll 2
    for (int i = 0; i < 8; ++i) {
      int gi = tid + i * 256;
      int pos = gi & (q - 1);
      int base = ((gi >> (s - 1)) << (s + 1)) + pos;
      float2 w1 = tw[pos << (12 - s)];
      float2 w2 = tw[pos << (13 - s)];
      float2 a = X[base], bb = X[base + q], c = X[base + h], d = X[base + h + q];
      float2 a1 = make_float2(a.x + c.x, a.y + c.y);
      float2 c1 = cmul(make_float2(a.x - c.x, a.y - c.y), w1);
      float2 b1 = make_float2(bb.x + d.x, bb.y + d.y);
      float2 t = cmul(make_float2(bb.x - d.x, bb.y - d.y), w1);
      float2 d1 = make_float2(t.y, -t.x);
      X[base] = make_float2(a1.x + b1.x, a1.y + b1.y);
      X[base + q] = cmul(make_float2(a1.x - b1.x, a1.y - b1.y), w2);
      X[base + h] = make_float2(c1.x + d1.x, c1.y + d1.y);
      X[base + h + q] = cmul(make_float2(c1.x - d1.x, c1.y - d1.y), w2);
    }
    __syncthreads();
  }
  {
#pragma unroll 4
    for (int i = 0; i < 16; ++i) {
      int j = tid + i * 256;
      float2 a = X[2 * j], bq = X[2 * j + 1];
      X[2 * j] = make_float2(a.x + bq.x, a.y + bq.y);
      X[2 * j + 1] = make_float2(a.x - bq.x, a.y - bq.y);
    }
    __syncthreads();
  }
}
__device__ __forceinline__ void fft_inv(float2* X, const float2* __restrict__ tw) {
  int tid = otid();
  {
#pragma unroll 4
    for (int i = 0; i < 16; ++i) {
      int j = tid + i * 256;
      float2 a = X[2 * j], bq = X[2 * j + 1];
      X[2 * j] = make_float2(a.x + bq.x, a.y + bq.y);
      X[2 * j + 1] = make_float2(a.x - bq.x, a.y - bq.y);
    }
    __syncthreads();
  }
  for (int s = 2; s <= 12; s += 2) {
    const int h = 1 << s, q = h >> 1;
#pragma unroll 2
    for (int i = 0; i < 8; ++i) {
      int gi = tid + i * 256;
      int pos = gi & (q - 1);
      int base = ((gi >> (s - 1)) << (s + 1)) + pos;
      float2 w1 = tw[pos << (12 - s)];
      float2 w2 = tw[pos << (13 - s)];
      float2 a = X[base], bb = X[base + q], c = X[base + h], d = X[base + h + q];
      float2 tb = cmulc(bb, w2), td = cmulc(d, w2);
      float2 a1 = make_float2(a.x + tb.x, a.y + tb.y), b1 = make_float2(a.x - tb.x, a.y - tb.y);
      float2 c1 = make_float2(c.x + td.x, c.y + td.y), d1 = make_float2(c.x - td.x, c.y - td.y);
      float2 tc = cmulc(c1, w1);
      float2 u = cmulc(d1, w1);
      float2 tdd = make_float2(-u.y, u.x);
      X[base] = make_float2(a1.x + tc.x, a1.y + tc.y);
      X[base + h] = make_float2(a1.x - tc.x, a1.y - tc.y);
      X[base + q] = make_float2(b1.x + tdd.x, b1.y + tdd.y);
      X[base + h + q] = make_float2(b1.x - tdd.x, b1.y - tdd.y);
    }
    __syncthreads();
  }
}

__device__ __forceinline__ void phase_filter_fft(const Params& p, float2* Hf, char* lds) {
  float2* X = (float2*)lds;
  float* w3s = (float*)(lds + 65536);
  float* red = w3s + 128;
  const float* hid = (const float*)(p.ws + OFF_HID);
  int tid = otid();
  const float min_decay = -3.0701134573253945f;
  const float max_decay = -15.350567286626973f;
  for (int item = blockIdx.x; item < 2048; item += gridDim.x) {
    int o = item >> 10, d = item & 1023;
    if (tid < 128) {
      int dirr = tid >> 6, j = tid & 63;
      w3s[tid] = p.h_f_w3[(size_t)j * 4096 + (o * 2 + dirr) * 1024 + d];
    }
    __syncthreads();
    float adelta = fabsf(min_decay + (float)d * ((max_decay - min_decay) / 1023.f));
    float ss = 0.f;
#pragma unroll 1
    for (int i = 0; i < 16; ++i) {
      int t = tid + i * 256;
      const float* hr = hid + (size_t)t * 64;
      float hf = 0.f, hb = 0.f;
#pragma unroll
      for (int j4 = 0; j4 < 16; ++j4) {
        float4 hv = *reinterpret_cast<const float4*>(hr + j4 * 4);
        hf += hv.x * w3s[j4 * 4] + hv.y * w3s[j4 * 4 + 1] + hv.z * w3s[j4 * 4 + 2] + hv.w * w3s[j4 * 4 + 3];
        hb += hv.x * w3s[64 + j4 * 4] + hv.y * w3s[64 + j4 * 4 + 1] + hv.z * w3s[64 + j4 * 4 + 2] + hv.w * w3s[64 + j4 * 4 + 3];
      }
      float dec = __expf(-((float)t / 4095.f) * adelta);
      hf *= dec; hb *= dec;
      if (t == 0) {
        float v = hf + hb;
        X[0] = make_float2(v, 0.f);
        X[4096] = make_float2(0.f, 0.f);
        ss += v * v;
      } else {
        X[t] = make_float2(hf, 0.f);
        X[8192 - t] = make_float2(hb, 0.f);
        ss += hf * hf + hb * hb;
      }
    }
    ss = wave_sum(ss);
    if ((tid & 63) == 0) red[tid >> 6] = ss;
    __syncthreads();
    float tot = red[0] + red[1] + red[2] + red[3];
    float scale = rsqrtf(tot + 1e-6f) * (1.f / 8192.f);
    fft_fwd(X, (const float2*)(p.ws + OFF_TW));
    float2* dst = Hf + (size_t)item * 8192;
#pragma unroll 4
    for (int i = 0; i < 32; ++i) {
      int k = tid + i * 256;
      float2 v = X[k];
      dst[k] = make_float2(v.x * scale, v.y * scale);
    }
    __syncthreads();
  }
}

__device__ __forceinline__ void phase_hyena_conv(const Params& p, const u16* x1cm, const u16* x2cm, const u16* vcm, const float2* Hf, u16* zzcm, char* lds) {
  float2* X = (float2*)lds;
  int tid = otid();
  for (int item = blockIdx.x; item < 4096; item += gridDim.x) {
    int d = item >> 2, bp = item & 3;
    size_t r0 = ((size_t)((bp * 2) * 1024 + d)) * 4096, r1 = ((size_t)((bp * 2 + 1) * 1024 + d)) * 4096;
    float bias0 = p.h_bias[d], bias1 = p.h_bias[1024 + d];
#pragma unroll
    for (int i = 0; i < 2; ++i) {
      int t8 = (tid + i * 256) * 8;
      uint4 a = *reinterpret_cast<const uint4*>(vcm + r0 + t8);
      uint4 bq = *reinterpret_cast<const uint4*>(vcm + r1 + t8);
      X[t8 + 0] = make_float2(bflo(a.x), bflo(bq.x)); X[t8 + 1] = make_float2(bfhi(a.x), bfhi(bq.x));
      X[t8 + 2] = make_float2(bflo(a.y), bflo(bq.y)); X[t8 + 3] = make_float2(bfhi(a.y), bfhi(bq.y));
      X[t8 + 4] = make_float2(bflo(a.z), bflo(bq.z)); X[t8 + 5] = make_float2(bfhi(a.z), bfhi(bq.z));
      X[t8 + 6] = make_float2(bflo(a.w), bflo(bq.w)); X[t8 + 7] = make_float2(bfhi(a.w), bfhi(bq.w));
    }
    for (int i = 0; i < 16; ++i) X[4096 + tid + i * 256] = make_float2(0.f, 0.f);
    __syncthreads();
    fft_fwd(X, (const float2*)(p.ws + OFF_TW));
    {
      const float2* H = Hf + (size_t)d * 8192;
#pragma unroll 4
      for (int i = 0; i < 32; ++i) {
        int k = tid + i * 256;
        float2 hv = H[k], xv = X[k];
        X[k] = make_float2(xv.x * hv.x - xv.y * hv.y, xv.x * hv.y + xv.y * hv.x);
      }
    }
    __syncthreads();
    fft_inv(X, (const float2*)(p.ws + OFF_TW));
    float zz0[16], zz1[16];
#pragma unroll
    for (int i = 0; i < 2; ++i) {
      int t8 = (tid + i * 256) * 8;
      uint4 a = *reinterpret_cast<const uint4*>(vcm + r0 + t8);
      uint4 bq = *reinterpret_cast<const uint4*>(vcm + r1 + t8);
      uint4 xa = *reinterpret_cast<const uint4*>(x1cm + r0 + t8);
      uint4 xb = *reinterpret_cast<const uint4*>(x1cm + r1 + t8);
      float va[8] = {bflo(a.x), bfhi(a.x), bflo(a.y), bfhi(a.y), bflo(a.z), bfhi(a.z), bflo(a.w), bfhi(a.w)};
      float vb[8] = {bflo(bq.x), bfhi(bq.x), bflo(bq.y), bfhi(bq.y), bflo(bq.z), bfhi(bq.z), bflo(bq.w), bfhi(bq.w)};
      float fa[8] = {bflo(xa.x), bfhi(xa.x), bflo(xa.y), bfhi(xa.y), bflo(xa.z), bfhi(xa.z), bflo(xa.w), bfhi(xa.w)};
      float fb[8] = {bflo(xb.x), bfhi(xb.x), bflo(xb.y), bfhi(xb.y), bflo(xb.z), bfhi(xb.z), bflo(xb.w), bfhi(xb.w)};
#pragma unroll
      for (int e = 0; e < 8; ++e) {
        float2 cv = X[t8 + e];
        float z0 = fa[e] * (cv.x + va[e] * bias0);
        float z1 = fb[e] * (cv.y + vb[e] * bias0);
        zz0[i * 8 + e] = z0; zz1[i * 8 + e] = z1;
        X[t8 + e] = make_float2(z0, z1);
      }
    }
    for (int i = 0; i < 16; ++i) X[4096 + tid + i * 256] = make_float2(0.f, 0.f);
    __syncthreads();
    fft_fwd(X, (const float2*)(p.ws + OFF_TW));
    {
      const float2* H = Hf + (size_t)(1024 + d) * 8192;
#pragma unroll 4
      for (int i = 0; i < 32; ++i) {
        int k = tid + i * 256;
        float2 hv = H[k], xv = X[k];
        X[k] = make_float2(xv.x * hv.x - xv.y * hv.y, xv.x * hv.y + xv.y * hv.x);
      }
    }
    __syncthreads();
    fft_inv(X, (const float2*)(p.ws + OFF_TW));
#pragma unroll
    for (int i = 0; i < 2; ++i) {
      int t8 = (tid + i * 256) * 8;
      uint4 xa = *reinterpret_cast<const uint4*>(x2cm + r0 + t8);
      uint4 xb = *reinterpret_cast<const uint4*>(x2cm + r1 + t8);
      float fa[8] = {bflo(xa.x), bfhi(xa.x), bflo(xa.y), bfhi(xa.y), bflo(xa.z), bfhi(xa.z), bflo(xa.w), bfhi(xa.w)};
      float fb[8] = {bflo(xb.x), bfhi(xb.x), bflo(xb.y), bfhi(xb.y), bflo(xb.z), bfhi(xb.z), bflo(xb.w), bfhi(xb.w)};
      float o0[8], o1[8];
#pragma unroll
      for (int e = 0; e < 8; ++e) {
        float2 cv = X[t8 + e];
        o0[e] = fa[e] * (cv.x + zz0[i * 8 + e] * bias1);
        o1[e] = fb[e] * (cv.y + zz1[i * 8 + e] * bias1);
      }
      uint4 w0, w1;
      w0.x = pack2(o0[0], o0[1]); w0.y = pack2(o0[2], o0[3]); w0.z = pack2(o0[4], o0[5]); w0.w = pack2(o0[6], o0[7]);
      w1.x = pack2(o1[0], o1[1]); w1.y = pack2(o1[2], o1[3]); w1.z = pack2(o1[4], o1[5]); w1.w = pack2(o1[6], o1[7]);
      *reinterpret_cast<uint4*>(zzcm + r0 + t8) = w0;
      *reinterpret_cast<uint4*>(zzcm + r1 + t8) = w1;
    }
    __syncthreads();
  }
}

__device__ __forceinline__ void phase_transpose_back(const u16* src, u16* dst, char* lds) {
  u16* tile = (u16*)lds;
  int tid = otid();
  for (int item = blockIdx.x; item < 8 * 16 * 64; item += gridDim.x) {
    int b = item >> 10, dt_ = (item >> 6) & 15, tt = item & 63;
#pragma unroll
    for (int i = 0; i < 2; ++i) {
      int q = tid + i * 256, dd = q >> 3, tg = (q & 7) * 8;
      uint4 v = *reinterpret_cast<const uint4*>(src + ((size_t)(b * 1024 + dt_ * 64 + dd)) * 4096 + tt * 64 + tg);
      tile[(tg + 0) * 72 + dd] = (u16)(v.x & 0xffff); tile[(tg + 1) * 72 + dd] = (u16)(v.x >> 16);
      tile[(tg + 2) * 72 + dd] = (u16)(v.y & 0xffff); tile[(tg + 3) * 72 + dd] = (u16)(v.y >> 16);
      tile[(tg + 4) * 72 + dd] = (u16)(v.z & 0xffff); tile[(tg + 5) * 72 + dd] = (u16)(v.z >> 16);
      tile[(tg + 6) * 72 + dd] = (u16)(v.w & 0xffff); tile[(tg + 7) * 72 + dd] = (u16)(v.w >> 16);
    }
    __syncthreads();
#pragma unroll
    for (int i = 0; i < 2; ++i) {
      int q = tid + i * 256, tl = q >> 3, dg = (q & 7) * 8;
      uint4 v = *reinterpret_cast<const uint4*>(tile + tl * 72 + dg);
      *reinterpret_cast<uint4*>(dst + ((size_t)(b * 4096 + tt * 64 + tl)) * 1024 + dt_ * 64 + dg) = v;
    }
    __syncthreads();
  }
}

__device__ __forceinline__ uint4* xb_words_ptr() { __shared__ uint4 xb_words; return &xb_words; }
#define XB_TMO      128
#define XB_XCNT(j)  (256  + 64 * (j))
#define XB_XSUB(j)  (1280 + 64 * (j))
#define XB_XGEN(j)  (2304 + 64 * (j))
#define XB_TOP      3328
#define XB_TOPGEN   3392
#define XCD_BAR_WORDS 3456
#define XB_SPIN_CAP (1u << 18)
#define LAS __attribute__((address_space(3)))

__device__ __forceinline__ unsigned xb_ld(unsigned* p)              { return __hip_atomic_load(p, __ATOMIC_RELAXED, __HIP_MEMORY_SCOPE_AGENT); }
__device__ __forceinline__ unsigned xb_add(unsigned* p, unsigned v) { return __hip_atomic_fetch_add(p, v, __ATOMIC_RELAXED, __HIP_MEMORY_SCOPE_AGENT); }
__device__ __forceinline__ unsigned xb_xcc_id() { return (unsigned)__builtin_amdgcn_s_getreg((3 << 11) | 20) & 0xFu; }
#define XB_SPIN(cond, bar) do { unsigned _sp = 0; while (cond) { __builtin_amdgcn_s_sleep(1); \
    if ((++_sp & 255u) == 0u) { if (xb_ld(&(bar)[XB_TMO])) break; if (_sp > XB_SPIN_CAP) { atomicAdd(&(bar)[XB_TMO], 1u); break; } } } } while (0)

struct XcdBarrier {
    unsigned* bar; unsigned x;
    volatile LAS unsigned* st;
};

__device__ __forceinline__ XcdBarrier xcd_barrier_post(unsigned* bar, volatile LAS unsigned* st) {
    XcdBarrier b; b.bar = bar; b.x = xb_xcc_id(); b.st = st;
    if (threadIdx.x == 0) (void)xb_add(&bar[XB_XCNT(b.x)], 1u);
    return b;
}
__device__ __forceinline__ void xcd_barrier_complete(unsigned* bar, unsigned x, unsigned& nloc, unsigned& nx) {
    const unsigned G = gridDim.x * gridDim.y * gridDim.z;
    unsigned sum, cnt, mine, sp = 0u;
    for (;;) {
        sum = 0u; cnt = 0u; mine = 0u;
#pragma unroll
        for (unsigned j = 0; j < 16; ++j) { const unsigned c = xb_ld(&bar[XB_XCNT(j)]); sum += c; cnt += (c > 0u) ? 1u : 0u; mine = (j == x) ? c : mine; }
        if (sum == G) break;
        __builtin_amdgcn_s_sleep(1);
        if ((++sp & 255u) == 0u) { if (xb_ld(&bar[XB_TMO])) break; if (sp > XB_SPIN_CAP) { atomicAdd(&bar[XB_TMO], 1u); break; } }
    }
    nloc = mine > 0u ? mine : 1u; nx = cnt > 0u ? cnt : 1u;
}

__device__ __forceinline__ void xcd_barrier(const XcdBarrier& b) {
    asm volatile("s_waitcnt vmcnt(0)" ::: "memory");
    __syncthreads();
    if (threadIdx.x == 0) {
        unsigned* bar = b.bar;
        __builtin_amdgcn_s_waitcnt(0);
        unsigned nloc = b.st[0], nx = b.st[1];
        if (nloc == 0u) { xcd_barrier_complete(bar, b.x, nloc, nx); b.st[0] = nloc; b.st[1] = nx; }
        const unsigned old = xb_add(&bar[XB_XSUB(b.x)], 1u);
        const unsigned gen = old / nloc;
        if (old + 1u == (gen + 1u) * nloc) {
            __builtin_amdgcn_fence(__ATOMIC_RELEASE, "agent");
            asm volatile("s_waitcnt vmcnt(0)" ::: "memory");
            const unsigned og = xb_add(&bar[XB_TOP], 1u);
            const unsigned tg = og / nx;
            if (og + 1u == (tg + 1u) * nx) xb_add(&bar[XB_TOPGEN], 1u);
            else XB_SPIN(xb_ld(&bar[XB_TOPGEN]) == tg, bar);
            __builtin_amdgcn_fence(__ATOMIC_ACQUIRE, "agent");
            xb_add(&bar[XB_XGEN(b.x)], 1u);
            asm volatile("s_waitcnt vmcnt(0)" ::: "memory");
        } else {
            XB_SPIN(xb_ld(&bar[XB_XGEN(b.x)]) == gen, bar);
            __builtin_amdgcn_fence(__ATOMIC_ACQUIRE, "agent");
            asm volatile("s_waitcnt vmcnt(0)" ::: "memory");
        }
    }
    __syncthreads();
}


DEV void gsync2(unsigned k) {
  (void)k;
  XcdBarrier b;
  b.bar = (unsigned*)((char*)karg<33>() + OFF_BAR);
  b.x = xb_xcc_id();
  b.st = (volatile LAS unsigned*)xb_words_ptr();
  xcd_barrier(b);
}

DEV void gsync(cg::grid_group& grid) {
  asm volatile("s_waitcnt vmcnt(0)" ::: "memory");
  grid.sync();
  if (threadIdx.x == 0) {
    __builtin_amdgcn_fence(__ATOMIC_ACQUIRE, "agent");
    asm volatile("s_waitcnt vmcnt(0)" ::: "memory");
  }
  __syncthreads();
}

template <int layer>
__device__ __forceinline__ void peer_block(unsigned& nbar, char* lds) {
  {
    Params p = fetch_params();
    char* ws = p.ws; char* R1 = ws + OFF_R1; char* R2 = ws + OFF_R2; char* DO = (char*)p.out;
    const float* modl = (float*)(ws + OFF_MOD) + (size_t)layer * 9 * 6144;
    const u16* A = layer == 0 ? (const u16*)R1 : (const u16*)DO;
    const int K = layer == 0 ? 2048 : 1024;
    const u16* Wt = (const u16*)(ws + (layer == 0 ? OFF_W_OUT : OFF_W_HOUT));
    const float* res = layer == 0 ? p.x : (const float*)R2;
    phase_gemm_resid(A, K, Wt, res, (float*)R2, modl + 2048, lds);
  }
  gsync2(++nbar);
  {
    Params p = fetch_params();
    char* ws = p.ws; char* R1 = ws + OFF_R1; char* R2 = ws + OFF_R2; char* DO = (char*)p.out;
    const float* modl = (float*)(ws + OFF_MOD) + (size_t)layer * 9 * 6144;
    u16* tpeer = layer == 0 ? (u16*)DO : (u16*)(R1 + 128 * MiB);
    phase_ln_mod((float*)R2, p.ln_g + layer * 2048, p.ln_b + layer * 2048, modl, tpeer);
    if (layer == 1) {
      unsigned char* tb = (unsigned char*)R1;
      convert_fp8_rows(p.p_u + (size_t)16384 * 1024, tb, (float*)(tb + 32 * MiB), 16384);
      convert_fp8_rows(p.p_v + (size_t)16384 * 1024, tb + 16 * MiB, (float*)(tb + 32 * MiB + 65536), 16384);
    }
  }
  gsync2(++nbar);
  {
    Params p = fetch_params();
    char* ws = p.ws; char* R1 = ws + OFF_R1; char* DO = (char*)p.out;
    u16* tpeer = layer == 0 ? (u16*)DO : (u16*)(R1 + 128 * MiB);
    phase_gemm_bf16(tpeer, (const u16*)(ws + OFF_W_Q) + (size_t)layer * 2048 * 1024, layer == 0 ? (u16*)R1 : (u16*)DO, 2048, lds);
  }
  gsync2(++nbar);
  {
    Params p = fetch_params();
    char* ws = p.ws; char* R1 = ws + OFF_R1; char* R2 = ws + OFF_R2;
    int* idxb = (int*)(R2 + 128 * MiB);
    float* gateb = (float*)(R2 + 144 * MiB);
    const u16* kbf = (const u16*)(ws + OFF_KEYS);
    phase_peer_topk(layer == 0 ? (const u16*)R1 : (const u16*)p.out, kbf + (size_t)layer * 131072, kbf + 262144 + (size_t)layer * 131072, idxb, gateb, lds);
  }
  gsync2(++nbar);
  {
    Params p = fetch_params();
    char* ws = p.ws; char* R1 = ws + OFF_R1; char* R2 = ws + OFF_R2; char* DO = (char*)p.out;
    float* mod = (float*)(ws + OFF_MOD);
    const float* modl = mod + (size_t)layer * 9 * 6144;
    int* idxb = (int*)(R2 + 128 * MiB);
    float* gateb = (float*)(R2 + 144 * MiB);
    u16* tpeer = layer == 0 ? (u16*)DO : (u16*)(R1 + 128 * MiB);
    const unsigned char* tb8 = (const unsigned char*)(layer == 0 ? ws + OFF_TAB0 : R1);
    phase_peer_gather(tpeer, idxb, gateb, tb8, tb8 + 16 * MiB, (const float*)(tb8 + 32 * MiB), (const float*)(tb8 + 32 * MiB + 65536), (const float*)R2,
                      modl + 5120, p.ln_g + layer * 2048 + 1024, p.ln_b + layer * 2048 + 1024, layer == 0 ? (float*)R2 : p.out,
                      layer == 0 ? mod + 9 * 6144 : nullptr, (u16*)(DO + 64 * MiB));
  }
}

__global__ void __launch_bounds__(256, 2) fwd_megakernel(Params p_unused) {
  __shared__ __attribute__((aligned(16))) char lds[LDS_BYTES];
  cg::grid_group grid = cg::this_grid();
  unsigned nbar = 0;
  if (threadIdx.x == 0) *xb_words_ptr() = make_uint4(0u, 0u, 0u, 0u);
  __syncthreads();
  (void)xcd_barrier_post((unsigned*)((char*)karg<33>() + OFF_BAR), (volatile LAS unsigned*)xb_words_ptr());
  { Params p = fetch_params(); phase_prologue(p, lds); }
  gsync(grid);
  {
    Params p = fetch_params();
    float* mod = (float*)(p.ws + OFF_MOD);
    modulate_rows(p.x, (u16*)(p.ws + OFF_R2), NT, SEQ, mod, 0, 1024, false);
    modulate_rows(p.ctx, (u16*)(p.ws + OFF_HC), NTC, CTXL, mod, 0, 1024, true);
  }
  gsync2(++nbar);
  { Params p = fetch_params(); phase_gemm_inproj(p, lds); }
  gsync2(++nbar);
  { Params p = fetch_params(); phase_conv(p); }
  gsync2(++nbar);
  { Params p = fetch_params(); phase_ssd(p, lds); }
  gsync2(++nbar);
  {
    Params p = fetch_params(); phase_gated_norm(p);
    unsigned char* tb = (unsigned char*)(p.ws + OFF_TAB0);
    convert_fp8_rows(p.p_u, tb, (float*)(tb + 32 * MiB), 16384);
    convert_fp8_rows(p.p_v, tb + 16 * MiB, (float*)(tb + 32 * MiB + 65536), 16384);
  }
  gsync2(++nbar);
  peer_block<0>(nbar, lds);
  gsync2(++nbar);
  {
    Params p = fetch_params();
    phase_gemm_bf16((const u16*)((char*)p.out + 64 * MiB), (const u16*)(p.ws + OFF_W_HIN), (u16*)(p.ws + OFF_R1), 3072, lds);
  }
  gsync2(++nbar);
  {
    Params p = fetch_params();
    phase_shortconv_T(p, (const u16*)(p.ws + OFF_R1), (u16*)(p.ws + OFF_R2 + 128 * MiB), (u16*)p.out, (u16*)((char*)p.out + 64 * MiB), lds);
  }
  gsync2(++nbar);
  { Params p = fetch_params(); phase_filter_fft(p, (float2*)(p.ws + OFF_R1), lds); }
  gsync2(++nbar);
  {
    Params p = fetch_params();
    phase_hyena_conv(p, (const u16*)(p.ws + OFF_R2 + 128 * MiB), (const u16*)p.out, (const u16*)((char*)p.out + 64 * MiB),
                     (const float2*)(p.ws + OFF_R1), (u16*)(p.ws + OFF_R1 + 128 * MiB), lds);
  }
  gsync2(++nbar);
  { Params p = fetch_params(); phase_transpose_back((const u16*)(p.ws + OFF_R1 + 128 * MiB), (u16*)p.out, lds); }
  gsync2(++nbar);
  peer_block<1>(nbar, lds);
}

extern "C" void kernel_launch(void* const* d_in, const int* in_sizes, int n_in, void* d_out, int out_size, void* d_ws, size_t ws_size,
                              hipStream_t stream) {
  static int grid_blocks = 0;
  if (!grid_blocks) {
    int dev = 0, cus = 0, per_cu = 0;
    hipGetDevice(&dev);
    hipDeviceGetAttribute(&cus, hipDeviceAttributeMultiprocessorCount, dev);
    hipOccupancyMaxActiveBlocksPerMultiprocessor(&per_cu, fwd_megakernel, 256, 0);
    if (per_cu > 2) per_cu = 2;
    if (per_cu < 1) per_cu = 1;
    grid_blocks = cus * per_cu;
  }
  Params p{};
  const float** pp = reinterpret_cast<const float**>(&p);
  for (int i = 0; i < 32; ++i) pp[i] = (const float*)d_in[i];
  p.out = (float*)d_out;
  p.ws = (char*)d_ws;
  if (ws_size < WS_TOTAL) fprintf(stderr, "workspace too small: %zu < %zu\n", ws_size, (size_t)WS_TOTAL);
  (void)hipMemsetAsync((char*)d_ws + OFF_BAR, 0, 16384, stream);
  void* args[] = {&p};
  hipError_t e = hipLaunchCooperativeKernel((void*)fwd_megakernel, dim3(grid_blocks), dim3(256), args, 0, stream);
  if (e != hipSuccess) fprintf(stderr, "cooperative launch failed: %s (grid %d)\n", hipGetErrorString(e), grid_blocks);
}
```

```cpp
#include <hip/hip_runtime.h>
#include <hip/hip_bf16.h>
#include <hip/hip_cooperative_groups.h>
#include <cstdio>
namespace cg = cooperative_groups;

typedef unsigned short u16;
using bf16x8 = __attribute__((ext_vector_type(8))) short;
using f32x4 = __attribute__((ext_vector_type(4))) float;
using u32x4 = __attribute__((ext_vector_type(4))) unsigned;
typedef float f32x2 __attribute__((ext_vector_type(2)));

#define DEV __device__ __forceinline__

constexpr int NB = 8, SEQ = 4096, DM = 1024, NT = NB * SEQ;
constexpr int CTXL = 256, NTC = NB * CTXL;
constexpr int SSM_IN = 5184, CONVD = 3072, SSM_INNER = 2048;
constexpr float ALPHA = 1.41421356237f;
constexpr int LDS_BYTES = 71168;

constexpr size_t MiB = 1ull << 20;
constexpr size_t OFF_W_IN = 0;
constexpr size_t OFF_W_OUT = OFF_W_IN + (size_t)5184 * 1024 * 2;
constexpr size_t OFF_W_HIN = OFF_W_OUT + (size_t)1024 * 2048 * 2;
constexpr size_t OFF_W_HOUT = OFF_W_HIN + (size_t)3072 * 1024 * 2;
constexpr size_t OFF_W_Q = OFF_W_HOUT + (size_t)1024 * 1024 * 2;
constexpr size_t OFF_MOD = OFF_W_Q + (size_t)2 * 2048 * 1024 * 2;
constexpr size_t OFF_HID = OFF_MOD + 512 * 1024;
constexpr size_t OFF_DT = OFF_HID + MiB;
constexpr size_t OFF_HC = OFF_DT + 8 * MiB;
constexpr size_t OFF_XBC_C = OFF_HC + 4 * MiB;
constexpr size_t OFF_XC_C = OFF_XBC_C + 12 * MiB;
constexpr size_t OFF_DT_C = OFF_XC_C + 12 * MiB;
constexpr size_t OFF_R1 = OFF_DT_C + MiB;
constexpr size_t OFF_R2 = OFF_R1 + 192 * MiB;
constexpr size_t OFF_BAR = OFF_R2 + 192 * MiB;
constexpr size_t OFF_KEYS = OFF_BAR + 16384;
constexpr size_t OFF_TW = OFF_KEYS + MiB;
constexpr size_t OFF_TAB0 = OFF_TW + 32768;
constexpr size_t WS_TOTAL = OFF_TAB0 + 33 * MiB;

struct Params {
  const float *x, *c, *ctx, *c_ctx, *ada_w, *ada_b, *ln_g, *ln_b;
  const float *m_w_in, *m_conv_w, *m_conv_b, *m_a_log, *m_dt_bias, *m_d, *m_norm_w, *m_w_out;
  const float *h_w_in, *h_conv_w, *h_conv_b, *h_f_w1, *h_f_b1, *h_f_w2, *h_f_b2, *h_f_w3, *h_freq, *h_bias, *h_w_out;
  const float *p_wq, *p_k1, *p_k2, *p_u, *p_v;
  float* out;
  char* ws;
};

typedef __bf16 bf16x2_t __attribute__((ext_vector_type(2)));
typedef float f32x2_ __attribute__((ext_vector_type(2)));
DEV u16 f2bf(float f) { __bf16 v = (__bf16)f; return __builtin_bit_cast(u16, v); }
DEV float bf2f(u16 h) { return __uint_as_float(((unsigned)h) << 16); }
DEV float bflo(unsigned w) { return __uint_as_float(w << 16); }
DEV float bfhi(unsigned w) { return __uint_as_float(w & 0xffff0000u); }
DEV unsigned pack2(float a, float b) { bf16x2_t v = __builtin_convertvector(f32x2_{a, b}, bf16x2_t); return __builtin_bit_cast(unsigned, v); }
DEV float wave_sum(float v) {
#pragma unroll
  for (int o = 32; o > 0; o >>= 1) v += __shfl_xor(v, o);
  return v;
}
DEV int otid() { int t = threadIdx.x; asm volatile("" : "+v"(t)); return t; }
DEV unsigned ordkey(float f) { unsigned u = __float_as_uint(f); return (u & 0x80000000u) ? ~u : (u | 0x80000000u); }
DEV float siluf(float v) { return v / (1.f + __expf(-v)); }
DEV f32x4 mfma16(bf16x8 a, bf16x8 b, f32x4 c) { return __builtin_amdgcn_mfma_f32_16x16x32_bf16(a, b, c, 0, 0, 0); }
DEV bf16x8 ld8(const u16* p) { return *reinterpret_cast<const bf16x8*>(p); }

template <int I>
DEV const float* karg() {
  unsigned long long v;
  asm volatile("s_load_dwordx2 %0, %1, %2\n\ts_waitcnt lgkmcnt(0)" : "=s"(v) : "s"(__builtin_amdgcn_kernarg_segment_ptr()), "n"(I * 8));
  return (const float*)(const __attribute__((address_space(1))) float*)v;
}
DEV Params fetch_params() {
  Params q;
  q.x = karg<0>(); q.c = karg<1>(); q.ctx = karg<2>(); q.c_ctx = karg<3>(); q.ada_w = karg<4>(); q.ada_b = karg<5>(); q.ln_g = karg<6>(); q.ln_b = karg<7>();
  q.m_w_in = karg<8>(); q.m_conv_w = karg<9>(); q.m_conv_b = karg<10>(); q.m_a_log = karg<11>(); q.m_dt_bias = karg<12>(); q.m_d = karg<13>();
  q.m_norm_w = karg<14>(); q.m_w_out = karg<15>();
  q.h_w_in = karg<16>(); q.h_conv_w = karg<17>(); q.h_conv_b = karg<18>(); q.h_f_w1 = karg<19>(); q.h_f_b1 = karg<20>(); q.h_f_w2 = karg<21>();
  q.h_f_b2 = karg<22>(); q.h_f_w3 = karg<23>(); q.h_freq = karg<24>(); q.h_bias = karg<25>(); q.h_w_out = karg<26>();
  q.p_wq = karg<27>(); q.p_k1 = karg<28>(); q.p_k2 = karg<29>(); q.p_u = karg<30>(); q.p_v = karg<31>();
  q.out = (float*)karg<32>(); q.ws = (char*)karg<33>();
  return q;
}

__device__ __forceinline__ void transpose_w_tile(const float* src, int srcld, int K, int N, u16* dst, int item, char* lds) {
  float* tile = (float*)lds;
  int ntn = N / 64;
  int kt = item / ntn, nt = item % ntn;
  int tid = otid();
#pragma unroll
  for (int i = 0; i < 4; ++i) {
    int r = (tid >> 4) + i * 16, c4 = (tid & 15) * 4;
    float4 v = *reinterpret_cast<const float4*>(src + (size_t)(kt * 64 + r) * srcld + nt * 64 + c4);
    tile[r * 65 + c4 + 0] = v.x; tile[r * 65 + c4 + 1] = v.y; tile[r * 65 + c4 + 2] = v.z; tile[r * 65 + c4 + 3] = v.w;
  }
  __syncthreads();
#pragma unroll
  for (int i = 0; i < 2; ++i) {
    int n = (tid >> 3) + i * 32, k8 = (tid & 7) * 8;
    uint4 o;
    o.x = pack2(tile[(k8 + 0) * 65 + n], tile[(k8 + 1) * 65 + n]);
    o.y = pack2(tile[(k8 + 2) * 65 + n], tile[(k8 + 3) * 65 + n]);
    o.z = pack2(tile[(k8 + 4) * 65 + n], tile[(k8 + 5) * 65 + n]);
    o.w = pack2(tile[(k8 + 6) * 65 + n], tile[(k8 + 7) * 65 + n]);
    *reinterpret_cast<uint4*>(dst + (size_t)(nt * 64 + n) * K + kt * 64 + k8) = o;
  }
  __syncthreads();
}

__device__ __forceinline__ void ada_item(const Params& p, int item, char* lds) {
  float* sl = (float*)lds;
  float* red = sl + 9 * 1024;
  int layer = item / 96, cg_ = item % 96;
  int tid = otid(), kq = tid >> 6, col = cg_ * 64 + (tid & 63);
  for (int e = tid; e < 9 * 1024; e += 256) {
    int r = e >> 10, k = e & 1023;
    sl[e] = siluf(r < 8 ? p.c[r * 1024 + k] : p.c_ctx[k]);
  }
  __syncthreads();
  float acc[9];
#pragma unroll
  for (int r = 0; r < 9; ++r) acc[r] = 0.f;
  const float* w = p.ada_w + (size_t)layer * 1024 * 6144 + col;
#pragma unroll 8
  for (int k = kq * 256; k < kq * 256 + 256; ++k) {
    float wv = w[(size_t)k * 6144];
#pragma unroll
    for (int r = 0; r < 9; ++r) acc[r] += sl[r * 1024 + k] * wv;
  }
#pragma unroll
  for (int r = 0; r < 9; ++r) red[(kq * 9 + r) * 64 + (tid & 63)] = acc[r];
  __syncthreads();
  if (tid < 64) {
    float* mod = (float*)(p.ws + OFF_MOD);
    float bias = p.ada_b[layer * 6144 + col];
#pragma unroll
    for (int r = 0; r < 9; ++r) {
      float s = red[(0 * 9 + r) * 64 + tid] + red[(1 * 9 + r) * 64 + tid] + red[(2 * 9 + r) * 64 + tid] + red[(3 * 9 + r) * 64 + tid];
      mod[((size_t)layer * 9 + r) * 6144 + col] = s + bias;
    }
  }
  __syncthreads();
}

__device__ __forceinline__ void hyena_mlp_item(const Params& p, int item, char* lds) {
  float* zb = (float*)lds;
  float* h1 = zb + 256;
  float* h2 = h1 + 256;
  int tid = otid(), ti = tid >> 6, j = tid & 63;
  int t = item * 4 + ti;
  const float L = 4096.f;
  if (j < 33) {
    float v;
    if (j == 0) v = (float)t / 4095.f;
    else {
      int k = (j - 1) & 15;
      float fb = 1e-4f + (float)k * ((15.f - 1e-4f) / 15.f);
      float ang = 6.283185307179586f * (float)t / L;
      float a = fb * ang;
      v = (j <= 16) ? cosf(a) : -sinf(a);
    }
    zb[ti * 64 + j] = v;
  }
  __syncthreads();
  float fr = p.h_freq[j];
  float s = p.h_f_b1[j];
#pragma unroll 3
  for (int i = 0; i < 33; ++i) s += zb[ti * 64 + i] * p.h_f_w1[i * 64 + j];
  h1[ti * 64 + j] = sinf(fr * s);
  __syncthreads();
  s = p.h_f_b2[j];
#pragma unroll 8
  for (int i = 0; i < 64; ++i) s += h1[ti * 64 + i] * p.h_f_w2[i * 64 + j];
  h2[ti * 64 + j] = sinf(fr * s);
  __syncthreads();
  s = p.h_f_b2[64 + j];
#pragma unroll 8
  for (int i = 0; i < 64; ++i) s += h2[ti * 64 + i] * p.h_f_w2[4096 + i * 64 + j];
  float* hid = (float*)(p.ws + OFF_HID);
  hid[t * 64 + j] = sinf(fr * s);
  __syncthreads();
}

__device__ __forceinline__ void phase_prologue(const Params& p, char* lds) {
  constexpr int T0 = 1296, T1 = T0 + 512, T2 = T1 + 768, T3 = T2 + 256, T4 = T3 + 512, T5 = T4 + 512, T6 = T5 + 192, T7 = T6 + 1024, T8 = T7 + 256, T9 = T8 + 16;
  for (int item = blockIdx.x; item < T9; item += gridDim.x) {
    if (item < T0) transpose_w_tile(p.m_w_in, SSM_IN, 1024, SSM_IN, (u16*)(p.ws + OFF_W_IN), item, lds);
    else if (item < T1) transpose_w_tile(p.m_w_out, 1024, 2048, 1024, (u16*)(p.ws + OFF_W_OUT), item - T0, lds);
    else if (item < T2) transpose_w_tile(p.h_w_in, 3072, 1024, 3072, (u16*)(p.ws + OFF_W_HIN), item - T1, lds);
    else if (item < T3) transpose_w_tile(p.h_w_out, 1024, 1024, 1024, (u16*)(p.ws + OFF_W_HOUT), item - T2, lds);
    else if (item < T4) transpose_w_tile(p.p_wq, 2048, 1024, 2048, (u16*)(p.ws + OFF_W_Q), item - T3, lds);
    else if (item < T5) transpose_w_tile(p.p_wq + (size_t)1024 * 2048, 2048, 1024, 2048, (u16*)(p.ws + OFF_W_Q) + (size_t)2048 * 1024, item - T4, lds);
    else if (item < T6) ada_item(p, item - T5, lds);
    else if (item < T7) hyena_mlp_item(p, item - T6, lds);
    else if (item >= T8) {
      int k = (item - T8) * 256 + threadIdx.x;
      float sn, cs;
      sincospif((float)k * (1.f / 4096.f), &sn, &cs);
      ((float2*)(p.ws + OFF_TW))[k] = make_float2(cs, -sn);
    } else {
      int e8 = ((item - T7) * 256 + threadIdx.x) * 8;
      const float* src = e8 < 262144 ? p.p_k1 + e8 : p.p_k2 + (e8 - 262144);
      float4 a0 = *reinterpret_cast<const float4*>(src), a1 = *reinterpret_cast<const float4*>(src + 4);
      uint4 o;
      o.x = pack2(a0.x, a0.y); o.y = pack2(a0.z, a0.w); o.z = pack2(a1.x, a1.y); o.w = pack2(a1.z, a1.w);
      *reinterpret_cast<uint4*>((u16*)(p.ws + OFF_KEYS) + e8) = o;
    }
  }
}

__device__ __forceinline__ void modulate_rows(const float* src, u16* dst, int nrows, int rows_per_batch, const float* modbase, int sh_off, int sc_off, bool ctxrow) {
  size_t total = (size_t)nrows * 128;
  for (size_t e = (size_t)blockIdx.x * 256 + threadIdx.x; e < total; e += (size_t)gridDim.x * 256) {
    int row = (int)(e >> 7), c8 = (int)(e & 127) * 8;
    int b = ctxrow ? 8 : row / rows_per_batch;
    const float* m = modbase + (size_t)b * 6144;
    float4 a0 = *reinterpret_cast<const float4*>(src + (size_t)row * 1024 + c8);
    float4 a1 = *reinterpret_cast<const float4*>(src + (size_t)row * 1024 + c8 + 4);
    float4 s0 = *reinterpret_cast<const float4*>(m + sc_off + c8);
    float4 s1 = *reinterpret_cast<const float4*>(m + sc_off + c8 + 4);
    float4 h0 = *reinterpret_cast<const float4*>(m + sh_off + c8);
    float4 h1 = *reinterpret_cast<const float4*>(m + sh_off + c8 + 4);
    uint4 o;
    o.x = pack2(a0.x * (1.f + s0.x) + h0.x, a0.y * (1.f + s0.y) + h0.y);
    o.y = pack2(a0.z * (1.f + s0.z) + h0.z, a0.w * (1.f + s0.w) + h0.w);
    o.z = pack2(a1.x * (1.f + s1.x) + h1.x, a1.y * (1.f + s1.y) + h1.y);
    o.w = pack2(a1.z * (1.f + s1.z) + h1.z, a1.w * (1.f + s1.w) + h1.w);
    *reinterpret_cast<uint4*>(dst + (size_t)row * 1024 + c8) = o;
  }
}

constexpr int GLD = 72;
template <class Epi>
__device__ __forceinline__ void gemm_tile(const u16* __restrict__ A, int lda, const u16* __restrict__ Bt, int ldb, int brow, int bcol, int Nmax,
                                          int K, char* lds, Epi epi) {
  u16* SA = (u16*)lds;
  u16* SB = SA + 256 * GLD;
  int tid = otid(), wid = tid >> 6, lane = tid & 63, wr = wid >> 1, wc = wid & 1, fr = lane & 15, fq = lane >> 4;
  f32x4 acc[8][4];
#pragma unroll
  for (int m = 0; m < 8; ++m)
#pragma unroll
    for (int n = 0; n < 4; ++n) acc[m][n] = f32x4{0.f, 0.f, 0.f, 0.f};
  u32x4 ra[8], rb[4];
  const int lr = tid >> 3, lc = (tid & 7) * 8;
  const u16* abase = A + (size_t)brow * lda;
  const unsigned aoff = (unsigned)(lr * lda + lc);
  unsigned bo[4];
#pragma unroll
  for (int i = 0; i < 4; ++i) {
    int br = bcol + lr + i * 32;
    if (br >= Nmax) br = Nmax - 1;
    bo[i] = (unsigned)(br * ldb + lc);
  }
#define GLOADT(KT)                                                                                 \
  _Pragma("unroll") for (int i = 0; i < 8; ++i)                                                    \
    ra[i] = *reinterpret_cast<const u32x4*>(abase + (aoff + (unsigned)((i * 32) * lda + (KT) * 64))); \
  _Pragma("unroll") for (int i = 0; i < 4; ++i)                                                    \
    rb[i] = *reinterpret_cast<const u32x4*>(Bt + (bo[i] + (unsigned)((KT) * 64)));
  const int nk = K / 64;
  GLOADT(0)
  for (int kt = 0; kt < nk; ++kt) {
#pragma unroll
    for (int i = 0; i < 8; ++i) *reinterpret_cast<u32x4*>(SA + (lr + i * 32) * GLD + lc) = ra[i];
#pragma unroll
    for (int i = 0; i < 4; ++i) *reinterpret_cast<u32x4*>(SB + (lr + i * 32) * GLD + lc) = rb[i];
    __syncthreads();
    { const int kn = kt + 1 < nk ? kt + 1 : nk - 1; GLOADT(kn) }
#pragma unroll
    for (int kk = 0; kk < 2; ++kk) {
      bf16x8 Bl[4];
#pragma unroll
      for (int n = 0; n < 4; ++n) Bl[n] = ld8(SB + (wc * 64 + n * 16 + fr) * GLD + kk * 32 + fq * 8);
#pragma unroll
      for (int mh = 0; mh < 2; ++mh) {
        bf16x8 At[4];
#pragma unroll
        for (int m = 0; m < 4; ++m) At[m] = ld8(SA + (wr * 128 + (mh * 4 + m) * 16 + fr) * GLD + kk * 32 + fq * 8);
#pragma unroll
        for (int m = 0; m < 4; ++m)
#pragma unroll
          for (int n = 0; n < 4; ++n) acc[mh * 4 + m][n] = mfma16(Bl[n], At[m], acc[mh * 4 + m][n]);
      }
    }
    __syncthreads();
  }
#undef GLOADT
#pragma unroll
  for (int m = 0; m < 8; ++m)
#pragma unroll
    for (int n = 0; n < 4; ++n) epi(brow + wr * 128 + m * 16 + fr, bcol + wc * 64 + n * 16 + fq * 4, acc[m][n]);
}

DEV float softplusf(float v) { return fmaxf(v, 0.f) + log1pf(__expf(-fabsf(v))); }

__device__ __forceinline__ void phase_gemm_inproj(const Params& p, char* lds) {
  const u16* hx = (const u16*)(p.ws + OFF_R2);
  const u16* hc = (const u16*)(p.ws + OFF_HC);
  const u16* Wt = (const u16*)(p.ws + OFF_W_IN);
  u16* zbuf = (u16*)p.out;
  u16* xbc = (u16*)(p.ws + OFF_R1);
  float* dt = (float*)(p.ws + OFF_DT);
  u16* xbc_c = (u16*)(p.ws + OFF_XBC_C);
  float* dt_c = (float*)(p.ws + OFF_DT_C);
  const float* dtb = p.m_dt_bias;
  const int xcd = blockIdx.x & 7, li = blockIdx.x >> 3, nl = gridDim.x >> 3;
  auto epi_lat = [=](int m, int n, f32x4 v) {
    if (n < 2048) *reinterpret_cast<uint2*>(zbuf + (size_t)m * 2048 + n) = make_uint2(pack2(v[0], v[1]), pack2(v[2], v[3]));
    else if (n < 5120) *reinterpret_cast<uint2*>(xbc + (size_t)m * 3072 + (n - 2048)) = make_uint2(pack2(v[0], v[1]), pack2(v[2], v[3]));
    else if (n < 5184) {
      float4 bb = *reinterpret_cast<const float4*>(dtb + (n - 5120));
      *reinterpret_cast<float4*>(dt + (size_t)m * 64 + (n - 5120)) = make_float4(softplusf(v[0] + bb.x), softplusf(v[1] + bb.y), softplusf(v[2] + bb.z), softplusf(v[3] + bb.w));
    }
  };
  auto epi_ctx = [=](int m, int n, f32x4 v) {
    if (n < 3072) *reinterpret_cast<uint2*>(xbc_c + (size_t)m * 3072 + n) = make_uint2(pack2(v[0], v[1]), pack2(v[2], v[3]));
    else if (n < 3136) {
      float4 bb = *reinterpret_cast<const float4*>(dtb + (n - 3072));
      *reinterpret_cast<float4*>(dt_c + (size_t)m * 64 + (n - 3072)) = make_float4(softplusf(v[0] + bb.x), softplusf(v[1] + bb.y), softplusf(v[2] + bb.z), softplusf(v[3] + bb.w));
    }
  };
  for (int t = li; t < 128 * 5; t += nl) {
    int pm = t / 5, pn = xcd + 8 * (t % 5);
    gemm_tile(hx, 1024, Wt, 1024, pm * 256, pn * 128, SSM_IN, 1024, lds, epi_lat);
  }
  for (int t = blockIdx.x; t < 128 + 8 * 25; t += gridDim.x) {
    if (t < 128) gemm_tile(hx, 1024, Wt, 1024, t * 256, 40 * 128, SSM_IN, 1024, lds, epi_lat);
    else {
      int it = t - 128, pm = it / 25, pn = it % 25;
      gemm_tile(hc, 1024, Wt + (size_t)2048 * 1024, 1024, pm * 256, pn * 128, 3136, 1024, lds, epi_ctx);
    }
  }
}

DEV void fma8(float* acc, const u32x4& v, const float* w) {
  acc[0] += bflo(v[0]) * w[0]; acc[1] += bfhi(v[0]) * w[1]; acc[2] += bflo(v[1]) * w[2]; acc[3] += bfhi(v[1]) * w[3];
  acc[4] += bflo(v[2]) * w[4]; acc[5] += bfhi(v[2]) * w[5]; acc[6] += bflo(v[3]) * w[6]; acc[7] += bfhi(v[3]) * w[7];
}
__device__ __forceinline__ void phase_conv(const Params& p) {
  const u16* xbc = (const u16*)(p.ws + OFF_R1);
  u16* xc = (u16*)(p.ws + OFF_R2);
  const u16* xbc_c = (const u16*)(p.ws + OFF_XBC_C);
  u16* xc_c = (u16*)(p.ws + OFF_XC_C);
  const float* cw = p.m_conv_w;
  const float* cb = p.m_conv_b;
  const int tid_ = otid();
  const size_t nl = (size_t)8 * 64 * 8 * 384;
  for (size_t e = (size_t)blockIdx.x * 256 + tid_; e < nl; e += (size_t)gridDim.x * 256) {
    int ch = (int)(e % 384) * 8;
    int rest = (int)(e / 384);
    int cg_ = rest & 7, r = (rest >> 3) & 63, b = rest >> 9;
    float w[9][8];
#pragma unroll
    for (int k = 0; k < 9; ++k) {
      float4 w0 = *reinterpret_cast<const float4*>(cw + k * 3072 + ch), w1 = *reinterpret_cast<const float4*>(cw + k * 3072 + ch + 4);
      w[k][0] = w0.x; w[k][1] = w0.y; w[k][2] = w0.z; w[k][3] = w0.w; w[k][4] = w1.x; w[k][5] = w1.y; w[k][6] = w1.z; w[k][7] = w1.w;
    }
    float bias[8];
    {
      float4 b0 = *reinterpret_cast<const float4*>(cb + ch), b1 = *reinterpret_cast<const float4*>(cb + ch + 4);
      bias[0] = b0.x; bias[1] = b0.y; bias[2] = b0.z; bias[3] = b0.w; bias[4] = b1.x; bias[5] = b1.y; bias[6] = b1.z; bias[7] = b1.w;
    }
    const u32x4 zero4 = u32x4{0u, 0u, 0u, 0u};
    const int c0 = cg_ * 8;
    u32x4 win[3][3];
#pragma unroll
    for (int i = 0; i < 3; ++i) {
      int rr = r + i - 1;
      bool rok = rr >= 0 && rr <= 63;
      const u16* rowp = xbc + ((size_t)(b * 4096 + (rok ? rr : r) * 64)) * 3072 + ch;
      win[i][0] = (rok && c0 > 0) ? *reinterpret_cast<const u32x4*>(rowp + (size_t)(c0 - 1) * 3072) : zero4;
      win[i][1] = rok ? *reinterpret_cast<const u32x4*>(rowp + (size_t)c0 * 3072) : zero4;
    }
#pragma unroll
    for (int cc = 0; cc < 8; ++cc) {
      int c = c0 + cc;
#pragma unroll
      for (int i = 0; i < 3; ++i) {
        int rr = r + i - 1;
        bool rok = rr >= 0 && rr <= 63;
        const u16* rowp = xbc + ((size_t)(b * 4096 + (rok ? rr : r) * 64)) * 3072 + ch;
        win[i][2] = (rok && c < 63) ? *reinterpret_cast<const u32x4*>(rowp + (size_t)(c + 1) * 3072) : zero4;
      }
      float acc[8];
#pragma unroll
      for (int k = 0; k < 8; ++k) acc[k] = bias[k];
#pragma unroll
      for (int i = 0; i < 3; ++i)
#pragma unroll
        for (int j = 0; j < 3; ++j) fma8(acc, win[i][j], w[i * 3 + j]);
      uint4 o;
      o.x = pack2(siluf(acc[0]), siluf(acc[1]));
      o.y = pack2(siluf(acc[2]), siluf(acc[3]));
      o.z = pack2(siluf(acc[4]), siluf(acc[5]));
      o.w = pack2(siluf(acc[6]), siluf(acc[7]));
      *reinterpret_cast<uint4*>(xc + ((size_t)(b * 4096 + r * 64 + c)) * 3072 + ch) = o;
#pragma unroll
      for (int i = 0; i < 3; ++i) { win[i][0] = win[i][1]; win[i][1] = win[i][2]; }
    }
  }
  const size_t ncx = (size_t)NTC * 384;
  for (size_t e = (size_t)blockIdx.x * 256 + tid_; e < ncx; e += (size_t)gridDim.x * 256) {
    int tok = (int)(e / 384), ch = (int)(e % 384) * 8;
    float acc[8];
#pragma unroll
    for (int k = 0; k < 8; ++k) acc[k] = cb[ch + k];
    int b = tok >> 8, c = tok & 255;
#pragma unroll
    for (int j = 0; j < 3; ++j) {
      int cc = c + j - 1;
      if (cc < 0 || cc > 255) continue;
      uint4 v = *reinterpret_cast<const uint4*>(xbc_c + ((size_t)(b * 256 + cc)) * 3072 + ch);
      const float* w = cw + (3 + j) * 3072 + ch;
      float4 w0 = *reinterpret_cast<const float4*>(w), w1 = *reinterpret_cast<const float4*>(w + 4);
      acc[0] += bflo(v.x) * w0.x; acc[1] += bfhi(v.x) * w0.y; acc[2] += bflo(v.y) * w0.z; acc[3] += bfhi(v.y) * w0.w;
      acc[4] += bflo(v.z) * w1.x; acc[5] += bfhi(v.z) * w1.y; acc[6] += bflo(v.w) * w1.z; acc[7] += bfhi(v.w) * w1.w;
    }
    uint4 o;
    o.x = pack2(siluf(acc[0]), siluf(acc[1]));
    o.y = pack2(siluf(acc[2]), siluf(acc[3]));
    o.z = pack2(siluf(acc[4]), siluf(acc[5]));
    o.w = pack2(siluf(acc[6]), siluf(acc[7]));
    *reinterpret_cast<uint4*>(xc_c + (size_t)tok * 3072 + ch) = o;
  }
}

constexpr int SLD = 136;
__device__ __forceinline__ void phase_ssd(const Params& p, char* lds) {
  u16* xsT = (u16*)lds;
  u16* stb = xsT + 64 * SLD;
  u16* Mb = stb + 64 * SLD;
  float* cum = (float*)(Mb + 128 * SLD);
  float* dtv = cum + 128;
  float* asrc = dtv + 128;
  const u16* xc = (const u16*)(p.ws + OFF_R2);
  const u16* xc_c = (const u16*)(p.ws + OFF_XC_C);
  const float* dt = (const float*)(p.ws + OFF_DT);
  const float* dt_c = (const float*)(p.ws + OFF_DT_C);
  u16* y = (u16*)(p.ws + OFF_R1);
  int tid = otid(), w = tid >> 6, lane = tid & 63, fr = lane & 15, fq = lane >> 4;
  unsigned char* yb8 = (unsigned char*)(p.ws + OFF_R1 + 128 * MiB);
  for (int item = blockIdx.x; item < 512; item += gridDim.x) {
    int b = item >> 6, h = (item >> 1) & 31, g = h >> 3;
    float dsk = p.m_d[h];
    {
      const int dir = item & 1;
      float a_neg = -__expf(p.m_a_log[dir * 32 + h]);
      f32x4 acc_s[8];
#pragma unroll
      for (int n = 0; n < 8; ++n) acc_s[n] = f32x4{0.f, 0.f, 0.f, 0.f};
      for (int step = 0; step < 34; ++step) {
        bool isctx = step < 2;
        int cidx = isctx ? step : step - 2;
        if (dir) cidx = (isctx ? 1 : 31) - cidx;
        size_t tok0 = isctx ? (size_t)(b * 256 + cidx * 128) : (size_t)(b * 4096 + cidx * 128);
        const u16* src = (isctx ? xc_c : xc) + tok0 * 3072;
        const float* dts = (isctx ? dt_c : dt) + tok0 * 64;
        int tz = tid;
        asm volatile("" : "+v"(tz));
        float dval = 0.f;
        if (tid < 128) dval = dts[tid * 64 + dir * 32 + h];
        uint4 xv[4], bv[8];
#pragma unroll
        for (int i = 0; i < 4; ++i) {
          int idx = tz + i * 256, l = (idx & 31) | ((idx >> 8) << 5), pc = ((idx >> 5) & 7) * 8;
          xv[i] = *reinterpret_cast<const uint4*>(src + (size_t)l * 3072 + h * 64 + pc);
        }
#pragma unroll
        for (int i = 0; i < 8; ++i) {
          int idx = tz + i * 256, l = (idx & 31) | (((idx >> 9) & 3) << 5), nc = (((idx >> 5) & 7) | (((idx >> 8) & 1) << 3)) * 8;
          bv[i] = *reinterpret_cast<const uint4*>(src + (size_t)l * 3072 + 2048 + g * 128 + nc);
        }
        if (tid < 128) { dtv[tid] = dval; asrc[tid] = dval * a_neg; }
#pragma unroll
        for (int i = 0; i < 4; ++i) {
          int idx = tz + i * 256, l = (idx & 31) | ((idx >> 8) << 5), pc = ((idx >> 5) & 7) * 8;
          uint4 v = xv[i];
          xsT[(pc + 0) * SLD + l] = (u16)(v.x & 0xffff); xsT[(pc + 1) * SLD + l] = (u16)(v.x >> 16);
          xsT[(pc + 2) * SLD + l] = (u16)(v.y & 0xffff); xsT[(pc + 3) * SLD + l] = (u16)(v.y >> 16);
          xsT[(pc + 4) * SLD + l] = (u16)(v.z & 0xffff); xsT[(pc + 5) * SLD + l] = (u16)(v.z >> 16);
          xsT[(pc + 6) * SLD + l] = (u16)(v.w & 0xffff); xsT[(pc + 7) * SLD + l] = (u16)(v.w >> 16);
        }
        if (!isctx) {
#pragma unroll
          for (int i = 0; i < 8; ++i) {
            int idx = tz + i * 256, l = (idx & 31) | (((idx >> 9) & 3) << 5), nc = (((idx >> 5) & 7) | (((idx >> 8) & 1) << 3)) * 8;
            *reinterpret_cast<uint4*>(Mb + l * SLD + nc) = bv[i];
          }
        }
        __syncthreads();
        bf16x8 Cf[2][4];
        if (!isctx) {
#pragma unroll
          for (int mt = 0; mt < 2; ++mt)
#pragma unroll
            for (int kk = 0; kk < 4; ++kk) Cf[mt][kk] = ld8(src + (size_t)(w * 32 + mt * 16 + fr) * 3072 + 2560 + g * 128 + kk * 32 + fq * 8);
        }
        if (tid < 128) {
          float s = 0.f;
          if (!dir) { for (int j = 0; j <= tid; ++j) s += asrc[j]; }
          else { for (int j = tid; j < 128; ++j) s += asrc[j]; }
          cum[tid] = s;
        }
        __syncthreads();
        float total = dir ? cum[0] : cum[127];
        if (!isctx) {
          float cl[2][4];
#pragma unroll
          for (int mt = 0; mt < 2; ++mt)
#pragma unroll
            for (int j = 0; j < 4; ++j) cl[mt][j] = cum[w * 32 + mt * 16 + fq * 4 + j];
          f32x4 cb0[8], cb1[8];
#pragma unroll
          for (int nt = 0; nt < 8; ++nt) {
            cb0[nt] = f32x4{0.f, 0.f, 0.f, 0.f};
            cb1[nt] = f32x4{0.f, 0.f, 0.f, 0.f};
            bool need = dir ? (nt >= w * 2) : (nt <= w * 2 + 1);
            if (need) {
#pragma unroll
              for (int kk = 0; kk < 4; ++kk) {
                bf16x8 Bf = ld8(Mb + (nt * 16 + fr) * SLD + kk * 32 + fq * 8);
                cb0[nt] = mfma16(Cf[0][kk], Bf, cb0[nt]);
                cb1[nt] = mfma16(Cf[1][kk], Bf, cb1[nt]);
              }
            }
          }
          __syncthreads();
          int zero = 0;
          asm volatile("" : "+v"(zero));
#pragma unroll
          for (int nt = 0; nt < 8; ++nt) {
            int s = nt * 16 + fr + zero;
            float cs = cum[s], ds = dtv[s];
#pragma unroll
            for (int j = 0; j < 4; ++j) {
              int l0 = w * 32 + fq * 4 + j, l1 = l0 + 16;
              bool ok0 = dir ? (s >= l0) : (s <= l0);
              bool ok1 = dir ? (s >= l1) : (s <= l1);
              float v0 = ok0 ? cb0[nt][j] * __expf(cl[0][j] - cs) * ds : 0.f;
              float v1 = ok1 ? cb1[nt][j] * __expf(cl[1][j] - cs) * ds : 0.f;
              Mb[l0 * SLD + s] = f2bf(v0);
              Mb[l1 * SLD + s] = f2bf(v1);
            }
          }
          __syncthreads();
          f32x4 ya[2][4];
#pragma unroll
          for (int mt = 0; mt < 2; ++mt)
#pragma unroll
            for (int nt = 0; nt < 4; ++nt) ya[mt][nt] = f32x4{0.f, 0.f, 0.f, 0.f};
#pragma unroll
          for (int kk = 0; kk < 4; ++kk)
#pragma unroll
            for (int nt = 0; nt < 4; ++nt) {
              bf16x8 Sf = ld8(stb + (nt * 16 + fr) * SLD + kk * 32 + fq * 8);
              ya[0][nt] = mfma16(Cf[0][kk], Sf, ya[0][nt]);
              ya[1][nt] = mfma16(Cf[1][kk], Sf, ya[1][nt]);
            }
#pragma unroll
          for (int mt = 0; mt < 2; ++mt)
#pragma unroll
            for (int j = 0; j < 4; ++j) {
              float e = __expf(cl[mt][j]);
#pragma unroll
              for (int nt = 0; nt < 4; ++nt) ya[mt][nt][j] *= e;
            }
#pragma unroll
          for (int kk = 0; kk < 4; ++kk) {
            bf16x8 Mf0 = ld8(Mb + (w * 32 + fr) * SLD + kk * 32 + fq * 8);
            bf16x8 Mf1 = ld8(Mb + (w * 32 + 16 + fr) * SLD + kk * 32 + fq * 8);
#pragma unroll
            for (int nt = 0; nt < 4; ++nt) {
              bf16x8 Xf = ld8(xsT + (nt * 16 + fr) * SLD + kk * 32 + fq * 8);
              ya[0][nt] = mfma16(Mf0, Xf, ya[0][nt]);
              ya[1][nt] = mfma16(Mf1, Xf, ya[1][nt]);
            }
          }
#pragma unroll
          for (int i = 0; i < 8; ++i) {
            int idx = tz + i * 256, l = (idx & 31) | (((idx >> 9) & 3) << 5), nc = (((idx >> 5) & 7) | (((idx >> 8) & 1) << 3)) * 8;
            bv[i] = *reinterpret_cast<const uint4*>(src + (size_t)l * 3072 + 2048 + g * 128 + nc);
          }
#pragma unroll
          for (int mt = 0; mt < 2; ++mt)
#pragma unroll
            for (int nt = 0; nt < 4; ++nt)
#pragma unroll
              for (int j = 0; j < 4; ++j) {
                int l = w * 32 + mt * 16 + fq * 4 + j, pp = nt * 16 + fr;
                float val = ya[mt][nt][j];
                if (!dir) {
                  val += bf2f(xsT[pp * SLD + l]) * dsk;
                  y[(tok0 + l) * 2048 + h * 64 + pp] = f2bf(val);
                } else {
                  yb8[(tok0 + l) * 2048 + h * 64 + pp] = (unsigned char)(__builtin_amdgcn_cvt_pk_fp8_f32(fminf(fmaxf(val * 4.f, -440.f), 440.f), 0.f, 0, false) & 0xFF);
                }
              }
        }
        if (step == 33) continue;
        __syncthreads();
#pragma unroll
        for (int i = 0; i < 8; ++i) {
          int idx = tz + i * 256, l = (idx & 31) | (((idx >> 9) & 3) << 5), nc = (((idx >> 5) & 7) | (((idx >> 8) & 1) << 3)) * 8;
          uint4 v = bv[i];
          float sc = dtv[l] * __expf(total - cum[l]);
          Mb[(nc + 0) * SLD + l] = f2bf(bflo(v.x) * sc); Mb[(nc + 1) * SLD + l] = f2bf(bfhi(v.x) * sc);
          Mb[(nc + 2) * SLD + l] = f2bf(bflo(v.y) * sc); Mb[(nc + 3) * SLD + l] = f2bf(bfhi(v.y) * sc);
          Mb[(nc + 4) * SLD + l] = f2bf(bflo(v.z) * sc); Mb[(nc + 5) * SLD + l] = f2bf(bfhi(v.z) * sc);
          Mb[(nc + 6) * SLD + l] = f2bf(bflo(v.w) * sc); Mb[(nc + 7) * SLD + l] = f2bf(bfhi(v.w) * sc);
        }
        __syncthreads();
        float cd = __expf(total);
#pragma unroll
        for (int nt = 0; nt < 8; ++nt) acc_s[nt] *= cd;
#pragma unroll
        for (int kk = 0; kk < 4; ++kk) {
          bf16x8 Af = ld8(xsT + (w * 16 + fr) * SLD + kk * 32 + fq * 8);
#pragma unroll
          for (int nt = 0; nt < 8; ++nt) {
            bf16x8 Bf = ld8(Mb + (nt * 16 + fr) * SLD + kk * 32 + fq * 8);
            acc_s[nt] = mfma16(Af, Bf, acc_s[nt]);
          }
        }
#pragma unroll
        for (int nt = 0; nt < 8; ++nt)
#pragma unroll
          for (int j = 0; j < 4; ++j) stb[(w * 16 + fq * 4 + j) * SLD + nt * 16 + fr] = f2bf(acc_s[nt][j]);
        __syncthreads();
      }
      __syncthreads();
    }
  }
}

__device__ __forceinline__ void phase_gated_norm(const Params& p) {
  u16* y = (u16*)(p.ws + OFF_R1);
  const u16* z = (const u16*)p.out;
  const unsigned char* yb8 = (const unsigned char*)(p.ws + OFF_R1 + 128 * MiB);
  const int tid_ = otid();
  int lane = tid_ & 63;
  int wave = blockIdx.x * 4 + (tid_ >> 6), nw = gridDim.x * 4;
  for (int tok = wave; tok < NT; tok += nw) {
#pragma unroll
    for (int g = 0; g < 4; ++g) {
      int ch = g * 512 + lane * 8;
      uint4 yv = *reinterpret_cast<const uint4*>(y + (size_t)tok * 2048 + ch);
      uint4 zv = *reinterpret_cast<const uint4*>(z + (size_t)tok * 2048 + ch);
      uint2 bw = *reinterpret_cast<const uint2*>(yb8 + (size_t)tok * 2048 + ch);
      f32x2 b01 = __builtin_amdgcn_cvt_pk_f32_fp8((int)bw.x, false), b23 = __builtin_amdgcn_cvt_pk_f32_fp8((int)bw.x, true);
      f32x2 b45 = __builtin_amdgcn_cvt_pk_f32_fp8((int)bw.y, false), b67 = __builtin_amdgcn_cvt_pk_f32_fp8((int)bw.y, true);
      const float r16 = 0.25f;
      float u[8];
      u[0] = (bflo(yv.x) + b01.x * r16) * siluf(bflo(zv.x)); u[1] = (bfhi(yv.x) + b01.y * r16) * siluf(bfhi(zv.x));
      u[2] = (bflo(yv.y) + b23.x * r16) * siluf(bflo(zv.y)); u[3] = (bfhi(yv.y) + b23.y * r16) * siluf(bfhi(zv.y));
      u[4] = (bflo(yv.z) + b45.x * r16) * siluf(bflo(zv.z)); u[5] = (bfhi(yv.z) + b45.y * r16) * siluf(bfhi(zv.z));
      u[6] = (bflo(yv.w) + b67.x * r16) * siluf(bflo(zv.w)); u[7] = (bfhi(yv.w) + b67.y * r16) * siluf(bfhi(zv.w));
      float ss = 0.f;
#pragma unroll
      for (int k = 0; k < 8; ++k) ss += u[k] * u[k];
      ss = wave_sum(ss);
      float sc = rsqrtf(ss * (1.f / 512.f) + 1e-5f);
      float4 w0 = *reinterpret_cast<const float4*>(p.m_norm_w + ch), w1 = *reinterpret_cast<const float4*>(p.m_norm_w + ch + 4);
      uint4 o;
      o.x = pack2(u[0] * sc * w0.x, u[1] * sc * w0.y);
      o.y = pack2(u[2] * sc * w0.z, u[3] * sc * w0.w);
      o.z = pack2(u[4] * sc * w1.x, u[5] * sc * w1.y);
      o.w = pack2(u[6] * sc * w1.z, u[7] * sc * w1.w);
      *reinterpret_cast<uint4*>(y + (size_t)tok * 2048 + ch) = o;
    }
  }
}

__device__ __forceinline__ void phase_gemm_resid(const u16* A, int K, const u16* Wt, const float* res, float* dst, const float* gate  , char* lds) {
  const int xcd = blockIdx.x & 7, li = blockIdx.x >> 3, nl = gridDim.x >> 3;
  for (int t = li; t < 128; t += nl) {
    int pm = t, pn = xcd;
    gemm_tile(A, K, Wt, K, pm * 256, pn * 128, 1024, K, lds, [=](int m, int n, f32x4 v) {
      int b = m >> 12;
      float4 r = *reinterpret_cast<const float4*>(res + (size_t)m * 1024 + n);
      float4 g = *reinterpret_cast<const float4*>(gate + (size_t)b * 6144 + n);
      *reinterpret_cast<float4*>(dst + (size_t)m * 1024 + n) = make_float4(ALPHA * r.x + g.x * v[0], ALPHA * r.y + g.y * v[1], ALPHA * r.z + g.z * v[2], ALPHA * r.w + g.w * v[3]);
    });
  }
}
__device__ __forceinline__ void phase_gemm_bf16(const u16* A, const u16* Wt, u16* dst, int N, char* lds) {
  const int xcd = blockIdx.x & 7, li = blockIdx.x >> 3, nl = gridDim.x >> 3;
  const int nb = N / 1024;
  for (int t = li; t < 128 * nb; t += nl) {
    int pm = t / nb, pn = xcd + 8 * (t % nb);
    gemm_tile(A, 1024, Wt, 1024, pm * 256, pn * 128, N, 1024, lds, [=](int m, int n, f32x4 v) { *reinterpret_cast<uint2*>(dst + (size_t)m * N + n) = make_uint2(pack2(v[0], v[1]), pack2(v[2], v[3])); });
  }
}

__device__ __forceinline__ void phase_ln_mod(float* xio, const float* g, const float* bta, const float* mod  , u16* tdst) {
  const int tid_ = otid();
  int lane = tid_ & 63;
  int wave = blockIdx.x * 4 + (tid_ >> 6), nw = gridDim.x * 4;
  for (int tok = wave; tok < NT; tok += nw) {
    int b = tok >> 12;
    float4 v[4];
    float s = 0.f;
#pragma unroll
    for (int i = 0; i < 4; ++i) {
      v[i] = *reinterpret_cast<const float4*>(xio + (size_t)tok * 1024 + i * 256 + lane * 4);
      s += v[i].x + v[i].y + v[i].z + v[i].w;
    }
    float mu = wave_sum(s) * (1.f / 1024.f);
    float q = 0.f;
#pragma unroll
    for (int i = 0; i < 4; ++i) {
      v[i].x -= mu; v[i].y -= mu; v[i].z -= mu; v[i].w -= mu;
      q += v[i].x * v[i].x + v[i].y * v[i].y + v[i].z * v[i].z + v[i].w * v[i].w;
    }
    float rs = rsqrtf(wave_sum(q) * (1.f / 1024.f) + 1e-5f);
    const float* m = mod + (size_t)b * 6144;
#pragma unroll
    for (int i = 0; i < 4; ++i) {
      int c = i * 256 + lane * 4;
      float4 gg = *reinterpret_cast<const float4*>(g + c), bb = *reinterpret_cast<const float4*>(bta + c);
      float4 o;
      o.x = v[i].x * rs * gg.x + bb.x; o.y = v[i].y * rs * gg.y + bb.y; o.z = v[i].z * rs * gg.z + bb.z; o.w = v[i].w * rs * gg.w + bb.w;
      *reinterpret_cast<float4*>(xio + (size_t)tok * 1024 + c) = o;
      float4 sh = *reinterpret_cast<const float4*>(m + 3072 + c), sc = *reinterpret_cast<const float4*>(m + 4096 + c);
      uint2 t;
      t.x = pack2(o.x * (1.f + sc.x) + sh.x, o.y * (1.f + sc.y) + sh.y);
      t.y = pack2(o.z * (1.f + sc.z) + sh.z, o.w * (1.f + sc.w) + sh.w);
      *reinterpret_cast<uint2*>(tdst + (size_t)tok * 1024 + c) = t;
    }
  }
}

__device__ __forceinline__ void phase_peer_topk(const u16* q, const u16* k1, const u16* k2, int* idxo, float* gateo, char* lds) {
  float* S = (float*)lds;
  float* sv = S + 64 * 129;
  int* si = (int*)(sv + 64 * 16);
  int tid = otid(), w = tid >> 6, lane = tid & 63, fr = lane & 15, fq = lane >> 4;
  const int slot = lane;
  const bool cvalid = lane < 50;
  int ci = slot < 42 ? ((slot >= 16) + (slot >= 24) + (slot >= 29) + (slot >= 33) + (slot >= 36) + (slot >= 38) + (slot >= 40)) : slot - 34;
  const unsigned long long PACK = 0ull | (16ull << 8) | (24ull << 16) | (29ull << 24) | (33ull << 32) | (36ull << 40) | (38ull << 48) | (40ull << 56);
  int cj = slot - (ci < 8 ? (int)((PACK >> (8 * ci)) & 0xFF) : 34 + ci);
  if (!cvalid) { ci = 0; cj = 0; }
  for (int item = blockIdx.x; item < 1024 * 8; item += gridDim.x) {
    int tile = item >> 3, h = item & 7;
    int tok0 = tile * 32;
    {
      int half = w >> 1, kb = (w & 1) * 64;
      const u16* kk_ = (half ? k2 : k1) + (size_t)h * 128 * 128;
      bf16x8 Af[2][4], Bf[4][4];
#pragma unroll
      for (int m = 0; m < 2; ++m)
#pragma unroll
        for (int ks = 0; ks < 4; ++ks) Af[m][ks] = ld8(q + (size_t)(tok0 + m * 16 + fr) * 2048 + h * 256 + half * 128 + ks * 32 + fq * 8);
#pragma unroll
      for (int n = 0; n < 4; ++n)
#pragma unroll
        for (int ks = 0; ks < 4; ++ks) Bf[n][ks] = ld8(kk_ + (size_t)(kb + n * 16 + fr) * 128 + ks * 32 + fq * 8);
      f32x4 acc[2][4];
#pragma unroll
      for (int m = 0; m < 2; ++m)
#pragma unroll
        for (int n = 0; n < 4; ++n) acc[m][n] = f32x4{0.f, 0.f, 0.f, 0.f};
#pragma unroll
      for (int ks = 0; ks < 4; ++ks)
#pragma unroll
        for (int n = 0; n < 4; ++n) {
          acc[0][n] = mfma16(Af[0][ks], Bf[n][ks], acc[0][n]);
          acc[1][n] = mfma16(Af[1][ks], Bf[n][ks], acc[1][n]);
        }
#pragma unroll
      for (int m = 0; m < 2; ++m)
#pragma unroll
        for (int n = 0; n < 4; ++n)
#pragma unroll
          for (int j = 0; j < 4; ++j) S[(half * 32 + m * 16 + fq * 4 + j) * 129 + kb + n * 16 + fr] = acc[m][n][j];
    }
    __syncthreads();
#pragma unroll 1
    for (int li = 0; li < 16; ++li) {
      int list = w * 16 + li;
      const float* row = S + list * 129;
      float vlo = row[lane], vhi = row[lane + 64];
      unsigned long long klo = ((unsigned long long)ordkey(vlo) << 7) | (unsigned)(127 - lane);
      unsigned long long khi = ((unsigned long long)ordkey(vhi) << 7) | (unsigned)(63 - lane);
      unsigned long long T = 0;
#pragma unroll 3
      for (int bit = 38; bit >= 0; --bit) {
        unsigned long long cand = T | (1ull << bit);
        int cnt = __popcll(__ballot(klo >= cand)) + __popcll(__ballot(khi >= cand));
        if (cnt >= 16) T = cand;
        if (cnt == 16) break;
      }
      bool slo = klo >= T, shi = khi >= T;
      unsigned long long mlo = __ballot(slo), mhi = __ballot(shi);
      int rlo = 0, rhi = 0;
      int klo_l = (int)(unsigned)klo, klo_h = (int)(unsigned)(klo >> 32), khi_l = (int)(unsigned)khi, khi_h = (int)(unsigned)(khi >> 32);
      while (mlo) {
        int src = __ffsll((long long)mlo) - 1;
        mlo &= mlo - 1;
        unsigned long long ks = ((unsigned long long)(unsigned)__builtin_amdgcn_readlane(klo_h, src) << 32) | (unsigned)__builtin_amdgcn_readlane(klo_l, src);
        rlo += (ks > klo) ? 1 : 0;
        rhi += (ks > khi) ? 1 : 0;
      }
      while (mhi) {
        int src = __ffsll((long long)mhi) - 1;
        mhi &= mhi - 1;
        unsigned long long ks = ((unsigned long long)(unsigned)__builtin_amdgcn_readlane(khi_h, src) << 32) | (unsigned)__builtin_amdgcn_readlane(khi_l, src);
        rlo += (ks > klo) ? 1 : 0;
        rhi += (ks > khi) ? 1 : 0;
      }
      if (slo) { sv[list * 16 + rlo] = vlo; si[list * 16 + rlo] = lane; }
      if (shi) { sv[list * 16 + rhi] = vhi; si[list * 16 + rhi] = lane + 64; }
    }
    __syncthreads();
#pragma unroll 1
    for (int tt = 0; tt < 8; ++tt) {
      int tok = w * 8 + tt;
      float sc_ = sv[tok * 16 + ci] + sv[(32 + tok) * 16 + cj];
      unsigned long long key = cvalid ? ((((unsigned long long)ordkey(sc_)) << 6) | (unsigned)(63 - lane)) : 0ull;
      unsigned long long T = 0;
#pragma unroll 3
      for (int bit = 37; bit >= 0; --bit) {
        unsigned long long cand = T | (1ull << bit);
        int cnt = __popcll(__ballot(key >= cand));
        if (cnt >= 16) T = cand;
        if (cnt == 16) break;
      }
      bool sel = cvalid && key >= T;
      unsigned long long msel = __ballot(sel);
      int rank = 0;
      int k_l = (int)(unsigned)key, k_h = (int)(unsigned)(key >> 32);
      int isc = __float_as_int(sc_);
      unsigned long long mm = msel;
      float mx = -INFINITY;
      while (mm) {
        int src = __ffsll((long long)mm) - 1;
        mm &= mm - 1;
        unsigned long long ks = ((unsigned long long)(unsigned)__builtin_amdgcn_readlane(k_h, src) << 32) | (unsigned)__builtin_amdgcn_readlane(k_l, src);
        rank += (ks > key) ? 1 : 0;
        mx = fmaxf(mx, __int_as_float(__builtin_amdgcn_readlane(isc, src)));
      }
      float ex = sel ? __expf(sc_ - mx) : 0.f;
      int iex = __float_as_int(ex);
      float sum = 0.f;
      mm = msel;
      while (mm) {
        int src = __ffsll((long long)mm) - 1;
        mm &= mm - 1;
        sum += __int_as_float(__builtin_amdgcn_readlane(iex, src));
      }
      if (sel) {
        size_t o = (size_t)(tok0 + tok) * 128 + h * 16 + rank;
        gateo[o] = ex / sum;
        idxo[o] = si[tok * 16 + ci] * 128 + si[(32 + tok) * 16 + cj];
      }
    }
  }
  __syncthreads();
}

DEV float gelu_exact(float v) { return 0.5f * v * (1.f + erff(v * 0.70710678118654752f)); }

__device__ __forceinline__ void convert_fp8_rows(const float* src, unsigned char* dst, float* rscale, int nrows) {
  const int tid_ = otid();
  int lane = tid_ & 63;
  int wave = blockIdx.x * 4 + (tid_ >> 6), nw = gridDim.x * 4;
  for (int row = wave; row < nrows; row += nw) {
    const float* r = src + (size_t)row * 1024 + lane * 16;
    float4 a0 = *reinterpret_cast<const float4*>(r), a1 = *reinterpret_cast<const float4*>(r + 4);
    float4 a2 = *reinterpret_cast<const float4*>(r + 8), a3 = *reinterpret_cast<const float4*>(r + 12);
    float m = fmaxf(fmaxf(fmaxf(fabsf(a0.x), fabsf(a0.y)), fmaxf(fabsf(a0.z), fabsf(a0.w))), fmaxf(fmaxf(fabsf(a1.x), fabsf(a1.y)), fmaxf(fabsf(a1.z), fabsf(a1.w))));
    m = fmaxf(m, fmaxf(fmaxf(fmaxf(fabsf(a2.x), fabsf(a2.y)), fmaxf(fabsf(a2.z), fabsf(a2.w))), fmaxf(fmaxf(fabsf(a3.x), fabsf(a3.y)), fmaxf(fabsf(a3.z), fabsf(a3.w)))));
#pragma unroll
    for (int o = 32; o > 0; o >>= 1) m = fmaxf(m, __shfl_xor(m, o));
    float sc = m > 0.f ? exp2f(floorf(log2f(224.f / m))) : 1.f;
    uint4 o;
    int p;
    p = __builtin_amdgcn_cvt_pk_fp8_f32(a0.x * sc, a0.y * sc, 0, false); p = __builtin_amdgcn_cvt_pk_fp8_f32(a0.z * sc, a0.w * sc, p, true); o.x = (unsigned)p;
    p = __builtin_amdgcn_cvt_pk_fp8_f32(a1.x * sc, a1.y * sc, 0, false); p = __builtin_amdgcn_cvt_pk_fp8_f32(a1.z * sc, a1.w * sc, p, true); o.y = (unsigned)p;
    p = __builtin_amdgcn_cvt_pk_fp8_f32(a2.x * sc, a2.y * sc, 0, false); p = __builtin_amdgcn_cvt_pk_fp8_f32(a2.z * sc, a2.w * sc, p, true); o.z = (unsigned)p;
    p = __builtin_amdgcn_cvt_pk_fp8_f32(a3.x * sc, a3.y * sc, 0, false); p = __builtin_amdgcn_cvt_pk_fp8_f32(a3.z * sc, a3.w * sc, p, true); o.w = (unsigned)p;
    *reinterpret_cast<uint4*>(dst + (size_t)row * 1024 + lane * 16) = o;
    if (lane == 0) rscale[row] = 1.f / sc;
  }
}

#define F8X(dst, WW) { dst[0] = __builtin_amdgcn_cvt_pk_f32_fp8((int)(WW).x, false); dst[1] = __builtin_amdgcn_cvt_pk_f32_fp8((int)(WW).x, true); \
                      dst[2] = __builtin_amdgcn_cvt_pk_f32_fp8((int)(WW).y, false); dst[3] = __builtin_amdgcn_cvt_pk_f32_fp8((int)(WW).y, true); \
                      dst[4] = __builtin_amdgcn_cvt_pk_f32_fp8((int)(WW).z, false); dst[5] = __builtin_amdgcn_cvt_pk_f32_fp8((int)(WW).z, true); \
                      dst[6] = __builtin_amdgcn_cvt_pk_f32_fp8((int)(WW).w, false); dst[7] = __builtin_amdgcn_cvt_pk_f32_fp8((int)(WW).w, true); }

__device__ __forceinline__ void phase_peer_gather(const u16* tin, const int* idx, const float* gate, const unsigned char* utab, const unsigned char* vtab,
                                  const float* urs, const float* vrs, const float* xres,
                                  const float* g2  , const float* lng, const float* lnb, float* xout,
                                  const float* modnext  , u16* hxout) {
  const int tid_ = otid();
  int lane = tid_ & 63;
  int wave = blockIdx.x * 4 + (tid_ >> 6), nw = gridDim.x * 4;
  for (int tok = wave; tok < NT; tok += nw) {
    int b = tok >> 12;
    f32x2 t2[8];
    {
      uint4 ta = *reinterpret_cast<const uint4*>(tin + (size_t)tok * 1024 + lane * 16);
      uint4 tb = *reinterpret_cast<const uint4*>(tin + (size_t)tok * 1024 + lane * 16 + 8);
      t2[0] = f32x2{bflo(ta.x), bfhi(ta.x)}; t2[1] = f32x2{bflo(ta.y), bfhi(ta.y)}; t2[2] = f32x2{bflo(ta.z), bfhi(ta.z)}; t2[3] = f32x2{bflo(ta.w), bfhi(ta.w)};
      t2[4] = f32x2{bflo(tb.x), bfhi(tb.x)}; t2[5] = f32x2{bflo(tb.y), bfhi(tb.y)}; t2[6] = f32x2{bflo(tb.z), bfhi(tb.z)}; t2[7] = f32x2{bflo(tb.w), bfhi(tb.w)};
    }
    int id0 = idx[(size_t)tok * 128 + lane] & 16383, id1 = idx[(size_t)tok * 128 + 64 + lane] & 16383;
    int gt0 = __float_as_int(gate[(size_t)tok * 128 + lane]), gt1 = __float_as_int(gate[(size_t)tok * 128 + 64 + lane]);
    f32x2 acc2[8];
#pragma unroll
    for (int k = 0; k < 8; ++k) acc2[k] = f32x2{0.f, 0.f};
#pragma unroll 1
    for (int j = 0; j < 128; j += 4) {
      int e[4];
      float g[4];
      if (j < 64) {
#pragma unroll
        for (int q = 0; q < 4; ++q) { e[q] = __builtin_amdgcn_readlane(id0, j + q); g[q] = __int_as_float(__builtin_amdgcn_readlane(gt0, j + q)); }
      } else {
#pragma unroll
        for (int q = 0; q < 4; ++q) { e[q] = __builtin_amdgcn_readlane(id1, j - 64 + q); g[q] = __int_as_float(__builtin_amdgcn_readlane(gt1, j - 64 + q)); }
      }
      uint4 U[4], V[4];
      float su[4], sv_[4];
#pragma unroll
      for (int q = 0; q < 4; ++q) {
        U[q] = *reinterpret_cast<const uint4*>(utab + (size_t)e[q] * 1024 + lane * 16);
        V[q] = *reinterpret_cast<const uint4*>(vtab + (size_t)e[q] * 1024 + lane * 16);
        su[q] = urs[e[q]];
        sv_[q] = vrs[e[q]];
      }
      float d[4];
#pragma unroll
      for (int q = 0; q < 4; ++q) {
        f32x2 u2[8];
        F8X(u2, U[q])
        f32x2 dd = u2[0] * t2[0];
#pragma unroll
        for (int k = 1; k < 8; ++k) dd = u2[k] * t2[k] + dd;
        d[q] = dd.x + dd.y;
      }
#pragma unroll
      for (int o = 32; o > 0; o >>= 1) {
#pragma unroll
        for (int q = 0; q < 4; ++q) d[q] += __shfl_xor(d[q], o);
      }
#pragma unroll
      for (int q = 0; q < 4; ++q) {
        float a = g[q] * gelu_exact(d[q] * su[q]) * sv_[q];
        f32x2 aa = f32x2{a, a};
        f32x2 v2[8];
        F8X(v2, V[q])
#pragma unroll
        for (int k = 0; k < 8; ++k) acc2[k] = aa * v2[k] + acc2[k];
      }
    }
    float vv[16];
    float s = 0.f;
    const int c0 = lane * 16;
#pragma unroll
    for (int k4 = 0; k4 < 4; ++k4) {
      float4 x0 = *reinterpret_cast<const float4*>(xres + (size_t)tok * 1024 + c0 + k4 * 4);
      float4 g0 = *reinterpret_cast<const float4*>(g2 + (size_t)b * 6144 + c0 + k4 * 4);
      vv[k4 * 4 + 0] = ALPHA * x0.x + g0.x * acc2[k4 * 2].x; vv[k4 * 4 + 1] = ALPHA * x0.y + g0.y * acc2[k4 * 2].y;
      vv[k4 * 4 + 2] = ALPHA * x0.z + g0.z * acc2[k4 * 2 + 1].x; vv[k4 * 4 + 3] = ALPHA * x0.w + g0.w * acc2[k4 * 2 + 1].y;
    }
#pragma unroll
    for (int k = 0; k < 16; ++k) s += vv[k];
    float mu = wave_sum(s) * (1.f / 1024.f);
    float qq = 0.f;
#pragma unroll
    for (int k = 0; k < 16; ++k) { vv[k] -= mu; qq += vv[k] * vv[k]; }
    float rs = rsqrtf(wave_sum(qq) * (1.f / 1024.f) + 1e-5f);
    float oo[16];
#pragma unroll
    for (int k4 = 0; k4 < 4; ++k4) {
      float4 ga = *reinterpret_cast<const float4*>(lng + c0 + k4 * 4), ba = *reinterpret_cast<const float4*>(lnb + c0 + k4 * 4);
      float4 o0;
      o0.x = vv[k4 * 4 + 0] * rs * ga.x + ba.x; o0.y = vv[k4 * 4 + 1] * rs * ga.y + ba.y; o0.z = vv[k4 * 4 + 2] * rs * ga.z + ba.z; o0.w = vv[k4 * 4 + 3] * rs * ga.w + ba.w;
      *reinterpret_cast<float4*>(xout + (size_t)tok * 1024 + c0 + k4 * 4) = o0;
      oo[k4 * 4 + 0] = o0.x; oo[k4 * 4 + 1] = o0.y; oo[k4 * 4 + 2] = o0.z; oo[k4 * 4 + 3] = o0.w;
    }
    if (modnext) {
      const float* m = modnext + (size_t)b * 6144;
      unsigned pk[8];
#pragma unroll
      for (int k4 = 0; k4 < 4; ++k4) {
        float4 sh0 = *reinterpret_cast<const float4*>(m + c0 + k4 * 4), sc0 = *reinterpret_cast<const float4*>(m + 1024 + c0 + k4 * 4);
        pk[k4 * 2] = pack2(oo[k4 * 4 + 0] * (1.f + sc0.x) + sh0.x, oo[k4 * 4 + 1] * (1.f + sc0.y) + sh0.y);
        pk[k4 * 2 + 1] = pack2(oo[k4 * 4 + 2] * (1.f + sc0.z) + sh0.z, oo[k4 * 4 + 3] * (1.f + sc0.w) + sh0.w);
      }
      *reinterpret_cast<uint4*>(hxout + (size_t)tok * 1024 + c0) = make_uint4(pk[0], pk[1], pk[2], pk[3]);
      *reinterpret_cast<uint4*>(hxout + (size_t)tok * 1024 + c0 + 8) = make_uint4(pk[4], pk[5], pk[6], pk[7]);
    }
  }
}

__device__ __forceinline__ void phase_shortconv_T(const Params& p, const u16* upre, u16* x1cm, u16* x2cm, u16* vcm, char* lds) {
  constexpr int TLD = 264;
  u16* tile = (u16*)lds;
  int tid = otid();
  const int tg = tid >> 3, cg_ = tid & 7;
  for (int item = blockIdx.x; item < 128 * 48; item += gridDim.x) {
    int tt = item / 48, ct = item % 48;
    int tok0 = tt * 256, c0 = ct * 64;
    int ch = c0 + cg_ * 8;
    float w[3][8], bias[8];
#pragma unroll
    for (int j = 0; j < 3; ++j) {
      float4 w0 = *reinterpret_cast<const float4*>(p.h_conv_w + j * 3072 + ch), w1 = *reinterpret_cast<const float4*>(p.h_conv_w + j * 3072 + ch + 4);
      w[j][0] = w0.x; w[j][1] = w0.y; w[j][2] = w0.z; w[j][3] = w0.w; w[j][4] = w1.x; w[j][5] = w1.y; w[j][6] = w1.z; w[j][7] = w1.w;
    }
    {
      float4 b0 = *reinterpret_cast<const float4*>(p.h_conv_b + ch), b1 = *reinterpret_cast<const float4*>(p.h_conv_b + ch + 4);
      bias[0] = b0.x; bias[1] = b0.y; bias[2] = b0.z; bias[3] = b0.w; bias[4] = b1.x; bias[5] = b1.y; bias[6] = b1.z; bias[7] = b1.w;
    }
    const int t0 = tok0 + tg * 8;
    const int l0 = t0 & 4095;
    const u32x4 zero4 = u32x4{0u, 0u, 0u, 0u};
    u32x4 rows[10];
#pragma unroll
    for (int i = 0; i < 10; ++i) {
      int ll = l0 + i - 1;
      rows[i] = (ll >= 0 && ll <= 4095) ? *reinterpret_cast<const u32x4*>(upre + (size_t)(t0 + i - 1) * 3072 + ch) : zero4;
    }
    float o[8][8];
#pragma unroll
    for (int i = 0; i < 8; ++i) {
#pragma unroll
      for (int k = 0; k < 8; ++k) o[i][k] = bias[k];
      fma8(o[i], rows[i], w[0]);
      fma8(o[i], rows[i + 1], w[1]);
      fma8(o[i], rows[i + 2], w[2]);
    }
#pragma unroll
    for (int k = 0; k < 8; ++k) {
      uint4 pk;
      pk.x = pack2(o[0][k], o[1][k]); pk.y = pack2(o[2][k], o[3][k]); pk.z = pack2(o[4][k], o[5][k]); pk.w = pack2(o[6][k], o[7][k]);
      *reinterpret_cast<uint4*>(tile + (cg_ * 8 + k) * TLD + tg * 8) = pk;
    }
    __syncthreads();
    int part = c0 >> 10, d0 = c0 & 1023;
    u16* dst = part == 0 ? x1cm : (part == 1 ? x2cm : vcm);
    int b = tok0 >> 12, lt0 = tok0 & 4095;
#pragma unroll
    for (int i = 0; i < 8; ++i) {
      int q = tid + i * 256, c = q >> 5, chunk = q & 31;
      uint4 v = *reinterpret_cast<const uint4*>(tile + c * TLD + chunk * 8);
      *reinterpret_cast<uint4*>(dst + ((size_t)(b * 1024 + d0 + c)) * 4096 + lt0 + chunk * 8) = v;
    }
    __syncthreads();
  }
}

DEV float2 cmul(float2 a, float2 w) { return make_float2(a.x * w.x - a.y * w.y, a.x * w.y + a.y * w.x); }
DEV float2 cmulc(float2 a, float2 w) { return make_float2(a.x * w.x + a.y * w.y, a.y * w.x - a.x * w.y); }
__device__ __forceinline__ void fft_fwd(float2* X, const float2* __restrict__ tw) {
  int tid = otid();
  for (int s = 12; s >= 2; s -= 2) {
    const int h = 1 << s, q = h >> 1;
#pragma unroll 2
    for (int i = 0; i < 8; ++i) {
      int gi = tid + i * 256;
      int pos = gi & (q - 1);
      int base = ((gi >> (s - 1)) << (s + 1)) + pos;
      float2 w1 = tw[pos << (12 - s)];
      float2 w2 = tw[pos << (13 - s)];
      float2 a = X[base], bb = X[base + q], c = X[base + h], d = X[base + h + q];
      float2 a1 = make_float2(a.x + c.x, a.y + c.y);
      float2 c1 = cmul(make_float2(a.x - c.x, a.y - c.y), w1);
      float2 b1 = make_float2(bb.x + d.x, bb.y + d.y);
      float2 t = cmul(make_float2(bb.x - d.x, bb.y - d.y), w1);
      float2 d1 = make_float2(t.y, -t.x);
      X[base] = make_float2(a1.x + b1.x, a1.y + b1.y);
      X[base + q] = cmul(make_float2(a1.x - b1.x, a1.y - b1.y), w2);
      X[base + h] = make_float2(c1.x + d1.x, c1.y + d1.y);
      X[base + h + q] = cmul(make_float2(c1.x - d1.x, c1.y - d1.y), w2);
    }
    __syncthreads();
  }
  {
#pragma unroll 4
    for (int i = 0; i < 16; ++i) {
      int j = tid + i * 256;
      float2 a = X[2 * j], bq = X[2 * j + 1];
      X[2 * j] = make_float2(a.x + bq.x, a.y + bq.y);
      X[2 * j + 1] = make_float2(a.x - bq.x, a.y - bq.y);
    }
    __syncthreads();
  }
}
__device__ __forceinline__ void fft_inv(float2* X, const float2* __restrict__ tw) {
  int tid = otid();
  {
#pragma unroll 4
    for (int i = 0; i < 16; ++i) {
      int j = tid + i * 256;
      float2 a = X[2 * j], bq = X[2 * j + 1];
      X[2 * j] = make_float2(a.x + bq.x, a.y + bq.y);
      X[2 * j + 1] = make_float2(a.x - bq.x, a.y - bq.y);
    }
    __syncthreads();
  }
  for (int s = 2; s <= 12; s += 2) {
    const int h = 1 << s, q = h >> 1;
#pragma unroll 2
    for (int i = 0; i < 8; ++i) {
      int gi = tid + i * 256;
      int pos = gi & (q - 1);
      int base = ((gi >> (s - 1)) << (s + 1)) + pos;
      float2 w1 = tw[pos << (12 - s)];
      float2 w2 = tw[pos << (13 - s)];
      float2 a = X[base], bb = X[base + q], c = X[base + h], d = X[base + h + q];
      float2 tb = cmulc(bb, w2), td = cmulc(d, w2);
      float2 a1 = make_float2(a.x + tb.x, a.y + tb.y), b1 = make_float2(a.x - tb.x, a.y - tb.y);
      float2 c1 = make_float2(c.x + td.x, c.y + td.y), d1 = make_float2(c.x - td.x, c.y - td.y);
      float2 tc = cmulc(c1, w1);
      float2 u = cmulc(d1, w1);
      float2 tdd = make_float2(-u.y, u.x);
      X[base] = make_float2(a1.x + tc.x, a1.y + tc.y);
      X[base + h] = make_float2(a1.x - tc.x, a1.y - tc.y);
      X[base + q] = make_float2(b1.x + tdd.x, b1.y + tdd.y);
      X[base + h + q] = make_float2(b1.x - tdd.x, b1.y - tdd.y);
    }
    __syncthreads();
  }
}

__device__ __forceinline__ void phase_filter_fft(const Params& p, float2* Hf, char* lds) {
  float2* X = (float2*)lds;
  float* w3s = (float*)(lds + 65536);
  float* red = w3s + 128;
  const float* hid = (const float*)(p.ws + OFF_HID);
  int tid = otid();
  const float min_decay = -3.0701134573253945f;
  const float max_decay = -15.350567286626973f;
  for (int item = blockIdx.x; item < 2048; item += gridDim.x) {
    int o = item >> 10, d = item & 1023;
    if (tid < 128) {
      int dirr = tid >> 6, j = tid & 63;
      w3s[tid] = p.h_f_w3[(size_t)j * 4096 + (o * 2 + dirr) * 1024 + d];
    }
    __syncthreads();
    float adelta = fabsf(min_decay + (float)d * ((max_decay - min_decay) / 1023.f));
    float ss = 0.f;
#pragma unroll 1
    for (int i = 0; i < 16; ++i) {
      int t = tid + i * 256;
      const float* hr = hid + (size_t)t * 64;
      float hf = 0.f, hb = 0.f;
#pragma unroll
      for (int j4 = 0; j4 < 16; ++j4) {
        float4 hv = *reinterpret_cast<const float4*>(hr + j4 * 4);
        hf += hv.x * w3s[j4 * 4] + hv.y * w3s[j4 * 4 + 1] + hv.z * w3s[j4 * 4 + 2] + hv.w * w3s[j4 * 4 + 3];
        hb += hv.x * w3s[64 + j4 * 4] + hv.y * w3s[64 + j4 * 4 + 1] + hv.z * w3s[64 + j4 * 4 + 2] + hv.w * w3s[64 + j4 * 4 + 3];
      }
      float dec = __expf(-((float)t / 4095.f) * adelta);
      hf *= dec; hb *= dec;
      if (t == 0) {
        float v = hf + hb;
        X[0] = make_float2(v, 0.f);
        X[4096] = make_float2(0.f, 0.f);
        ss += v * v;
      } else {
        X[t] = make_float2(hf, 0.f);
        X[8192 - t] = make_float2(hb, 0.f);
        ss += hf * hf + hb * hb;
      }
    }
    ss = wave_sum(ss);
    if ((tid & 63) == 0) red[tid >> 6] = ss;
    __syncthreads();
    float tot = red[0] + red[1] + red[2] + red[3];
    float scale = rsqrtf(tot + 1e-6f) * (1.f / 8192.f);
    fft_fwd(X, (const float2*)(p.ws + OFF_TW));
    float2* dst = Hf + (size_t)item * 8192;
#pragma unroll 4
    for (int i = 0; i < 32; ++i) {
      int k = tid + i * 256;
      float2 v = X[k];
      dst[k] = make_float2(v.x * scale, v.y * scale);
    }
    __syncthreads();
  }
}

__device__ __forceinline__ void phase_hyena_conv(const Params& p, const u16* x1cm, const u16* x2cm, const u16* vcm, const float2* Hf, u16* zzcm, char* lds) {
  float2* X = (float2*)lds;
  int tid = otid();
  for (int item = blockIdx.x; item < 4096; item += gridDim.x) {
    int d = item >> 2, bp = item & 3;
    size_t r0 = ((size_t)((bp * 2) * 1024 + d)) * 4096, r1 = ((size_t)((bp * 2 + 1) * 1024 + d)) * 4096;
    float bias0 = p.h_bias[d], bias1 = p.h_bias[1024 + d];
#pragma unroll
    for (int i = 0; i < 2; ++i) {
      int t8 = (tid + i * 256) * 8;
      uint4 a = *reinterpret_cast<const uint4*>(vcm + r0 + t8);
      uint4 bq = *reinterpret_cast<const uint4*>(vcm + r1 + t8);
      X[t8 + 0] = make_float2(bflo(a.x), bflo(bq.x)); X[t8 + 1] = make_float2(bfhi(a.x), bfhi(bq.x));
      X[t8 + 2] = make_float2(bflo(a.y), bflo(bq.y)); X[t8 + 3] = make_float2(bfhi(a.y), bfhi(bq.y));
      X[t8 + 4] = make_float2(bflo(a.z), bflo(bq.z)); X[t8 + 5] = make_float2(bfhi(a.z), bfhi(bq.z));
      X[t8 + 6] = make_float2(bflo(a.w), bflo(bq.w)); X[t8 + 7] = make_float2(bfhi(a.w), bfhi(bq.w));
    }
    for (int i = 0; i < 16; ++i) X[4096 + tid + i * 256] = make_float2(0.f, 0.f);
    __syncthreads();
    fft_fwd(X, (const float2*)(p.ws + OFF_TW));
    {
      const float2* H = Hf + (size_t)d * 8192;
#pragma unroll 4
      for (int i = 0; i < 32; ++i) {
        int k = tid + i * 256;
        float2 hv = H[k], xv = X[k];
        X[k] = make_float2(xv.x * hv.x - xv.y * hv.y, xv.x * hv.y + xv.y * hv.x);
      }
    }
    __syncthreads();
    fft_inv(X, (const float2*)(p.ws + OFF_TW));
    float zz0[16], zz1[16];
#pragma unroll
    for (int i = 0; i < 2; ++i) {
      int t8 = (tid + i * 256) * 8;
      uint4 a = *reinterpret_cast<const uint4*>(vcm + r0 + t8);
      uint4 bq = *reinterpret_cast<const uint4*>(vcm + r1 + t8);
      uint4 xa = *reinterpret_cast<const uint4*>(x1cm + r0 + t8);
      uint4 xb = *reinterpret_cast<const uint4*>(x1cm + r1 + t8);
      float va[8] = {bflo(a.x), bfhi(a.x), bflo(a.y), bfhi(a.y), bflo(a.z), bfhi(a.z), bflo(a.w), bfhi(a.w)};
      float vb[8] = {bflo(bq.x), bfhi(bq.x), bflo(bq.y), bfhi(bq.y), bflo(bq.z), bfhi(bq.z), bflo(bq.w), bfhi(bq.w)};
      float fa[8] = {bflo(xa.x), bfhi(xa.x), bflo(xa.y), bfhi(xa.y), bflo(xa.z), bfhi(xa.z), bflo(xa.w), bfhi(xa.w)};
      float fb[8] = {bflo(xb.x), bfhi(xb.x), bflo(xb.y), bfhi(xb.y), bflo(xb.z), bfhi(xb.z), bflo(xb.w), bfhi(xb.w)};
#pragma unroll
      for (int e = 0; e < 8; ++e) {
        float2 cv = X[t8 + e];
        float z0 = fa[e] * (cv.x + va[e] * bias0);
        float z1 = fb[e] * (cv.y + vb[e] * bias0);
        zz0[i * 8 + e] = z0; zz1[i * 8 + e] = z1;
        X[t8 + e] = make_float2(z0, z1);
      }
    }
    for (int i = 0; i < 16; ++i) X[4096 + tid + i * 256] = make_float2(0.f, 0.f);
    __syncthreads();
    fft_fwd(X, (const float2*)(p.ws + OFF_TW));
    {
      const float2* H = Hf + (size_t)(1024 + d) * 8192;
#pragma unroll 4
      for (int i = 0; i < 32; ++i) {
        int k = tid + i * 256;
        float2 hv = H[k], xv = X[k];
        X[k] = make_float2(xv.x * hv.x - xv.y * hv.y, xv.x * hv.y + xv.y * hv.x);
      }
    }
    __syncthreads();
    fft_inv(X, (const float2*)(p.ws + OFF_TW));
#pragma unroll
    for (int i = 0; i < 2; ++i) {
      int t8 = (tid + i * 256) * 8;
      uint4 xa = *reinterpret_cast<const uint4*>(x2cm + r0 + t8);
      uint4 xb = *reinterpret_cast<const uint4*>(x2cm + r1 + t8);
      float fa[8] = {bflo(xa.x), bfhi(xa.x), bflo(xa.y), bfhi(xa.y), bflo(xa.z), bfhi(xa.z), bflo(xa.w), bfhi(xa.w)};
      float fb[8] = {bflo(xb.x), bfhi(xb.x), bflo(xb.y), bfhi(xb.y), bflo(xb.z), bfhi(xb.z), bflo(xb.w), bfhi(xb.w)};
      float o0[8], o1[8];
#pragma unroll
      for (int e = 0; e < 8; ++e) {
        float2 cv = X[t8 + e];
        o0[e] = fa[e] * (cv.x + zz0[i * 8 + e] * bias1);
        o1[e] = fb[e] * (cv.y + zz1[i * 8 + e] * bias1);
      }
      uint4 w0, w1;
      w0.x = pack2(o0[0], o0[1]); w0.y = pack2(o0[2], o0[3]); w0.z = pack2(o0[4], o0[5]); w0.w = pack2(o0[6], o0[7]);
      w1.x = pack2(o1[0], o1[1]); w1.y = pack2(o1[2], o1[3]); w1.z = pack2(o1[4], o1[5]); w1.w = pack2(o1[6], o1[7]);
      *reinterpret_cast<uint4*>(zzcm + r0 + t8) = w0;
      *reinterpret_cast<uint4*>(zzcm + r1 + t8) = w1;
    }
    __syncthreads();
  }
}

__device__ __forceinline__ void phase_transpose_back(const u16* src, u16* dst, char* lds) {
  u16* tile = (u16*)lds;
  int tid = otid();
  for (int item = blockIdx.x; item < 8 * 16 * 64; item += gridDim.x) {
    int b = item >> 10, dt_ = (item >> 6) & 15, tt = item & 63;
#pragma unroll
    for (int i = 0; i < 2; ++i) {
      int q = tid + i * 256, dd = q >> 3, tg = (q & 7) * 8;
      uint4 v = *reinterpret_cast<const uint4*>(src + ((size_t)(b * 1024 + dt_ * 64 + dd)) * 4096 + tt * 64 + tg);
      tile[(tg + 0) * 72 + dd] = (u16)(v.x & 0xffff); tile[(tg + 1) * 72 + dd] = (u16)(v.x >> 16);
      tile[(tg + 2) * 72 + dd] = (u16)(v.y & 0xffff); tile[(tg + 3) * 72 + dd] = (u16)(v.y >> 16);
      tile[(tg + 4) * 72 + dd] = (u16)(v.z & 0xffff); tile[(tg + 5) * 72 + dd] = (u16)(v.z >> 16);
      tile[(tg + 6) * 72 + dd] = (u16)(v.w & 0xffff); tile[(tg + 7) * 72 + dd] = (u16)(v.w >> 16);
    }
    __syncthreads();
#pragma unroll
    for (int i = 0; i < 2; ++i) {
      int q = tid + i * 256, tl = q >> 3, dg = (q & 7) * 8;
      uint4 v = *reinterpret_cast<const uint4*>(tile + tl * 72 + dg);
      *reinterpret_cast<uint4*>(dst + ((size_t)(b * 4096 + tt * 64 + tl)) * 1024 + dt_ * 64 + dg) = v;
    }
    __syncthreads();
  }
}

__device__ __forceinline__ uint4* xb_words_ptr() { __shared__ uint4 xb_words; return &xb_words; }
#define XB_TMO      128
#define XB_XCNT(j)  (256  + 64 * (j))
#define XB_XSUB(j)  (1280 + 64 * (j))
#define XB_XGEN(j)  (2304 + 64 * (j))
#define XB_TOP      3328
#define XB_TOPGEN   3392
#define XCD_BAR_WORDS 3456
#define XB_SPIN_CAP (1u << 18)
#define LAS __attribute__((address_space(3)))

__device__ __forceinline__ unsigned xb_ld(unsigned* p)              { return __hip_atomic_load(p, __ATOMIC_RELAXED, __HIP_MEMORY_SCOPE_AGENT); }
__device__ __forceinline__ unsigned xb_add(unsigned* p, unsigned v) { return __hip_atomic_fetch_add(p, v, __ATOMIC_RELAXED, __HIP_MEMORY_SCOPE_AGENT); }
__device__ __forceinline__ unsigned xb_xcc_id() { return (unsigned)__builtin_amdgcn_s_getreg((3 << 11) | 20) & 0xFu; }
#define XB_SPIN(cond, bar) do { unsigned _sp = 0; while (cond) { __builtin_amdgcn_s_sleep(1); \
    if ((++_sp & 255u) == 0u) { if (xb_ld(&(bar)[XB_TMO])) break; if (_sp > XB_SPIN_CAP) { atomicAdd(&(bar)[XB_TMO], 1u); break; } } } } while (0)

struct XcdBarrier {
    unsigned* bar; unsigned x;
    volatile LAS unsigned* st;
};

__device__ __forceinline__ XcdBarrier xcd_barrier_post(unsigned* bar, volatile LAS unsigned* st) {
    XcdBarrier b; b.bar = bar; b.x = xb_xcc_id(); b.st = st;
    if (threadIdx.x == 0) (void)xb_add(&bar[XB_XCNT(b.x)], 1u);
    return b;
}
__device__ __forceinline__ void xcd_barrier_complete(unsigned* bar, unsigned x, unsigned& nloc, unsigned& nx) {
    const unsigned G = gridDim.x * gridDim.y * gridDim.z;
    unsigned sum, cnt, mine, sp = 0u;
    for (;;) {
        sum = 0u; cnt = 0u; mine = 0u;
#pragma unroll
        for (unsigned j = 0; j < 16; ++j) { const unsigned c = xb_ld(&bar[XB_XCNT(j)]); sum += c; cnt += (c > 0u) ? 1u : 0u; mine = (j == x) ? c : mine; }
        if (sum == G) break;
        __builtin_amdgcn_s_sleep(1);
        if ((++sp & 255u) == 0u) { if (xb_ld(&bar[XB_TMO])) break; if (sp > XB_SPIN_CAP) { atomicAdd(&bar[XB_TMO], 1u); break; } }
    }
    nloc = mine > 0u ? mine : 1u; nx = cnt > 0u ? cnt : 1u;
}

__device__ __forceinline__ void xcd_barrier(const XcdBarrier& b) {
    asm volatile("s_waitcnt vmcnt(0)" ::: "memory");
    __syncthreads();
    if (threadIdx.x == 0) {
        unsigned* bar = b.bar;
        __builtin_amdgcn_s_waitcnt(0);
        unsigned nloc = b.st[0], nx = b.st[1];
        if (nloc == 0u) { xcd_barrier_complete(bar, b.x, nloc, nx); b.st[0] = nloc; b.st[1] = nx; }
        const unsigned old = xb_add(&bar[XB_XSUB(b.x)], 1u);
        const unsigned gen = old / nloc;
        if (old + 1u == (gen + 1u) * nloc) {
            __builtin_amdgcn_fence(__ATOMIC_RELEASE, "agent");
            asm volatile("s_waitcnt vmcnt(0)" ::: "memory");
            const unsigned og = xb_add(&bar[XB_TOP], 1u);
            const unsigned tg = og / nx;
            if (og + 1u == (tg + 1u) * nx) xb_add(&bar[XB_TOPGEN], 1u);
            else XB_SPIN(xb_ld(&bar[XB_TOPGEN]) == tg, bar);
            __builtin_amdgcn_fence(__ATOMIC_ACQUIRE, "agent");
            xb_add(&bar[XB_XGEN(b.x)], 1u);
            asm volatile("s_waitcnt vmcnt(0)" ::: "memory");
        } else {
            XB_SPIN(xb_ld(&bar[XB_XGEN(b.x)]) == gen, bar);
            __builtin_amdgcn_fence(__ATOMIC_ACQUIRE, "agent");
            asm volatile("s_waitcnt vmcnt(0)" ::: "memory");
        }
    }
    __syncthreads();
}


DEV void gsync2(unsigned k) {
  (void)k;
  XcdBarrier b;
  b.bar = (unsigned*)((char*)karg<33>() + OFF_BAR);
  b.x = xb_xcc_id();
  b.st = (volatile LAS unsigned*)xb_words_ptr();
  xcd_barrier(b);
}

DEV void gsync(cg::grid_group& grid) {
  asm volatile("s_waitcnt vmcnt(0)" ::: "memory");
  grid.sync();
  if (threadIdx.x == 0) {
    __builtin_amdgcn_fence(__ATOMIC_ACQUIRE, "agent");
    asm volatile("s_waitcnt vmcnt(0)" ::: "memory");
  }
  __syncthreads();
}

template <int layer>
__device__ __forceinline__ void peer_block(unsigned& nbar, char* lds) {
  {
    Params p = fetch_params();
    char* ws = p.ws; char* R1 = ws + OFF_R1; char* R2 = ws + OFF_R2; char* DO = (char*)p.out;
    const float* modl = (float*)(ws + OFF_MOD) + (size_t)layer * 9 * 6144;
    const u16* A = layer == 0 ? (const u16*)R1 : (const u16*)DO;
    const int K = layer == 0 ? 2048 : 1024;
    const u16* Wt = (const u16*)(ws + (layer == 0 ? OFF_W_OUT : OFF_W_HOUT));
    const float* res = layer == 0 ? p.x : (const float*)R2;
    phase_gemm_resid(A, K, Wt, res, (float*)R2, modl + 2048, lds);
  }
  gsync2(++nbar);
  {
    Params p = fetch_params();
    char* ws = p.ws; char* R1 = ws + OFF_R1; char* R2 = ws + OFF_R2; char* DO = (char*)p.out;
    const float* modl = (float*)(ws + OFF_MOD) + (size_t)layer * 9 * 6144;
    u16* tpeer = layer == 0 ? (u16*)DO : (u16*)(R1 + 128 * MiB);
    phase_ln_mod((float*)R2, p.ln_g + layer * 2048, p.ln_b + layer * 2048, modl, tpeer);
    if (layer == 1) {
      unsigned char* tb = (unsigned char*)R1;
      convert_fp8_rows(p.p_u + (size_t)16384 * 1024, tb, (float*)(tb + 32 * MiB), 16384);
      convert_fp8_rows(p.p_v + (size_t)16384 * 1024, tb + 16 * MiB, (float*)(tb + 32 * MiB + 65536), 16384);
    }
  }
  gsync2(++nbar);
  {
    Params p = fetch_params();
    char* ws = p.ws; char* R1 = ws + OFF_R1; char* DO = (char*)p.out;
    u16* tpeer = layer == 0 ? (u16*)DO : (u16*)(R1 + 128 * MiB);
    phase_gemm_bf16(tpeer, (const u16*)(ws + OFF_W_Q) + (size_t)layer * 2048 * 1024, layer == 0 ? (u16*)R1 : (u16*)DO, 2048, lds);
  }
  gsync2(++nbar);
  {
    Params p = fetch_params();
    char* ws = p.ws; char* R1 = ws + OFF_R1; char* R2 = ws + OFF_R2;
    int* idxb = (int*)(R2 + 128 * MiB);
    float* gateb = (float*)(R2 + 144 * MiB);
    const u16* kbf = (const u16*)(ws + OFF_KEYS);
    phase_peer_topk(layer == 0 ? (const u16*)R1 : (const u16*)p.out, kbf + (size_t)layer * 131072, kbf + 262144 + (size_t)layer * 131072, idxb, gateb, lds);
  }
  gsync2(++nbar);
  {
    Params p = fetch_params();
    char* ws = p.ws; char* R1 = ws + OFF_R1; char* R2 = ws + OFF_R2; char* DO = (char*)p.out;
    float* mod = (float*)(ws + OFF_MOD);
    const float* modl = mod + (size_t)layer * 9 * 6144;
    int* idxb = (int*)(R2 + 128 * MiB);
    float* gateb = (float*)(R2 + 144 * MiB);
    u16* tpeer = layer == 0 ? (u16*)DO : (u16*)(R1 + 128 * MiB);
    const unsigned char* tb8 = (const unsigned char*)(layer == 0 ? ws + OFF_TAB0 : R1);
    phase_peer_gather(tpeer, idxb, gateb, tb8, tb8 + 16 * MiB, (const float*)(tb8 + 32 * MiB), (const float*)(tb8 + 32 * MiB + 65536), (const float*)R2,
                      modl + 5120, p.ln_g + layer * 2048 + 1024, p.ln_b + layer * 2048 + 1024, layer == 0 ? (float*)R2 : p.out,
                      layer == 0 ? mod + 9 * 6144 : nullptr, (u16*)(DO + 64 * MiB));
  }
}

__global__ void __launch_bounds__(256, 2) fwd_megakernel(Params p_unused) {
  __shared__ __attribute__((aligned(16))) char lds[LDS_BYTES];
  cg::grid_group grid = cg::this_grid();
  unsigned nbar = 0;
  if (threadIdx.x == 0) *xb_words_ptr() = make_uint4(0u, 0u, 0u, 0u);
  __syncthreads();
  (void)xcd_barrier_post((unsigned*)((char*)karg<33>() + OFF_BAR), (volatile LAS unsigned*)xb_words_ptr());
  { Params p = fetch_params(); phase_prologue(p, lds); }
  gsync(grid);
  {
    Params p = fetch_params();
    float* mod = (float*)(p.ws + OFF_MOD);
    modulate_rows(p.x, (u16*)(p.ws + OFF_R2), NT, SEQ, mod, 0, 1024, false);
    modulate_rows(p.ctx, (u16*)(p.ws + OFF_HC), NTC, CTXL, mod, 0, 1024, true);
  }
  gsync2(++nbar);
  { Params p = fetch_params(); phase_gemm_inproj(p, lds); }
  gsync2(++nbar);
  { Params p = fetch_params(); phase_conv(p); }
  gsync2(++nbar);
  { Params p = fetch_params(); phase_ssd(p, lds); }
  gsync2(++nbar);
  {
    Params p = fetch_params(); phase_gated_norm(p);
    unsigned char* tb = (unsigned char*)(p.ws + OFF_TAB0);
    convert_fp8_rows(p.p_u, tb, (float*)(tb + 32 * MiB), 16384);
    convert_fp8_rows(p.p_v, tb + 16 * MiB, (float*)(tb + 32 * MiB + 65536), 16384);
  }
  gsync2(++nbar);
  peer_block<0>(nbar, lds);
  gsync2(++nbar);
  {
    Params p = fetch_params();
    phase_gemm_bf16((const u16*)((char*)p.out + 64 * MiB), (const u16*)(p.ws + OFF_W_HIN), (u16*)(p.ws + OFF_R1), 3072, lds);
  }
  gsync2(++nbar);
  {
    Params p = fetch_params();
    phase_shortconv_T(p, (const u16*)(p.ws + OFF_R1), (u16*)(p.ws + OFF_R2 + 128 * MiB), (u16*)p.out, (u16*)((char*)p.out + 64 * MiB), lds);
  }
  gsync2(++nbar);
  { Params p = fetch_params(); phase_filter_fft(p, (float2*)(p.ws + OFF_R1), lds); }
  gsync2(++nbar);
  {
    Params p = fetch_params();
    phase_hyena_conv(p, (const u16*)(p.ws + OFF_R2 + 128 * MiB), (const u16*)p.out, (const u16*)((char*)p.out + 64 * MiB),
                     (const float2*)(p.ws + OFF_R1), (u16*)(p.ws + OFF_R1 + 128 * MiB), lds);
  }
  gsync2(++nbar);
  { Params p = fetch_params(); phase_transpose_back((const u16*)(p.ws + OFF_R1 + 128 * MiB), (u16*)p.out, lds); }
  gsync2(++nbar);
  peer_block<1>(nbar, lds);
}

extern "C" void kernel_launch(void* const* d_in, const int* in_sizes, int n_in, void* d_out, int out_size, void* d_ws, size_t ws_size,
                              hipStream_t stream) {
  static int grid_blocks = 0;
  if (!grid_blocks) {
    int dev = 0, cus = 0, per_cu = 0;
    hipGetDevice(&dev);
    hipDeviceGetAttribute(&cus, hipDeviceAttributeMultiprocessorCount, dev);
    hipOccupancyMaxActiveBlocksPerMultiprocessor(&per_cu, fwd_megakernel, 256, 0);
    if (per_cu > 2) per_cu = 2;
    if (per_cu < 1) per_cu = 1;
    grid_blocks = cus * per_cu;
  }
  Params p{};
  const float** pp = reinterpret_cast<const float**>(&p);
  for (int i = 0; i < 32; ++i) pp[i] = (const float*)d_in[i];
  p.out = (float*)d_out;
  p.ws = (char*)d_ws;
  if (ws_size < WS_TOTAL) fprintf(stderr, "workspace too small: %zu < %zu\n", ws_size, (size_t)WS_TOTAL);
  (void)hipMemsetAsync((char*)d_ws + OFF_BAR, 0, 16384, stream);
  void* args[] = {&p};
  hipError_t e = hipLaunchCooperativeKernel((void*)fwd_megakernel, dim3(grid_blocks), dim3(256), args, 0, stream);
  if (e != hipSuccess) fprintf(stderr, "cooperative launch failed: %s (grid %d)\n", hipGetErrorString(e), grid_blocks);
}
```

```cpp
#include <hip/hip_runtime.h>
#include <hip/hip_bf16.h>
#include <hip/hip_cooperative_groups.h>
#include <cstdio>
namespace cg = cooperative_groups;

typedef unsigned short u16;
using bf16x8 = __attribute__((ext_vector_type(8))) short;
using f32x4 = __attribute__((ext_vector_type(4))) float;
using u32x4 = __attribute__((ext_vector_type(4))) unsigned;
typedef float f32x2 __attribute__((ext_vector_type(2)));

#define DEV __device__ __forceinline__

constexpr int NB = 8, SEQ = 4096, DM = 1024, NT = NB * SEQ;
constexpr int CTXL = 256, NTC = NB * CTXL;
constexpr int SSM_IN = 5184, CONVD = 3072, SSM_INNER = 2048;
constexpr float ALPHA = 1.41421356237f;
constexpr int LDS_BYTES = 71168;

constexpr size_t MiB = 1ull << 20;
constexpr size_t OFF_W_IN = 0;
constexpr size_t OFF_W_OUT = OFF_W_IN + (size_t)5184 * 1024 * 2;
constexpr size_t OFF_W_HIN = OFF_W_OUT + (size_t)1024 * 2048 * 2;
constexpr size_t OFF_W_HOUT = OFF_W_HIN + (size_t)3072 * 1024 * 2;
constexpr size_t OFF_W_Q = OFF_W_HOUT + (size_t)1024 * 1024 * 2;
constexpr size_t OFF_MOD = OFF_W_Q + (size_t)2 * 2048 * 1024 * 2;
constexpr size_t OFF_HID = OFF_MOD + 512 * 1024;
constexpr size_t OFF_DT = OFF_HID + MiB;
constexpr size_t OFF_HC = OFF_DT + 8 * MiB;
constexpr size_t OFF_XBC_C = OFF_HC + 4 * MiB;
constexpr size_t OFF_XC_C = OFF_XBC_C + 12 * MiB;
constexpr size_t OFF_DT_C = OFF_XC_C + 12 * MiB;
constexpr size_t OFF_R1 = OFF_DT_C + MiB;
constexpr size_t OFF_R2 = OFF_R1 + 192 * MiB;
constexpr size_t OFF_BAR = OFF_R2 + 192 * MiB;
constexpr size_t OFF_KEYS = OFF_BAR + 16384;
constexpr size_t OFF_TW = OFF_KEYS + MiB;
constexpr size_t OFF_TAB0 = OFF_TW + 32768;
constexpr size_t WS_TOTAL = OFF_TAB0 + 33 * MiB;

struct Params {
  const float *x, *c, *ctx, *c_ctx, *ada_w, *ada_b, *ln_g, *ln_b;
  const float *m_w_in, *m_conv_w, *m_conv_b, *m_a_log, *m_dt_bias, *m_d, *m_norm_w, *m_w_out;
  const float *h_w_in, *h_conv_w, *h_conv_b, *h_f_w1, *h_f_b1, *h_f_w2, *h_f_b2, *h_f_w3, *h_freq, *h_bias, *h_w_out;
  const float *p_wq, *p_k1, *p_k2, *p_u, *p_v;
  float* out;
  char* ws;
};

typedef __bf16 bf16x2_t __attribute__((ext_vector_type(2)));
typedef float f32x2_ __attribute__((ext_vector_type(2)));
DEV u16 f2bf(float f) { __bf16 v = (__bf16)f; return __builtin_bit_cast(u16, v); }
DEV float bf2f(u16 h) { return __uint_as_float(((unsigned)h) << 16); }
DEV float bflo(unsigned w) { return __uint_as_float(w << 16); }
DEV float bfhi(unsigned w) { return __uint_as_float(w & 0xffff0000u); }
DEV unsigned pack2(float a, float b) { bf16x2_t v = __builtin_convertvector(f32x2_{a, b}, bf16x2_t); return __builtin_bit_cast(unsigned, v); }
DEV float wave_sum(float v) {
#pragma unroll
  for (int o = 32; o > 0; o >>= 1) v += __shfl_xor(v, o);
  return v;
}
DEV int otid() { int t = threadIdx.x; asm volatile("" : "+v"(t)); return t; }
DEV unsigned ordkey(float f) { unsigned u = __float_as_uint(f); return (u & 0x80000000u) ? ~u : (u | 0x80000000u); }
DEV float siluf(float v) { return v / (1.f + __expf(-v)); }
DEV f32x4 mfma16(bf16x8 a, bf16x8 b, f32x4 c) { return __builtin_amdgcn_mfma_f32_16x16x32_bf16(a, b, c, 0, 0, 0); }
DEV bf16x8 ld8(const u16* p) { return *reinterpret_cast<const bf16x8*>(p); }

template <int I>
DEV const float* karg() {
  unsigned long long v;
  asm volatile("s_load_dwordx2 %0, %1, %2\n\ts_waitcnt lgkmcnt(0)" : "=s"(v) : "s"(__builtin_amdgcn_kernarg_segment_ptr()), "n"(I * 8));
  return (const float*)(const __attribute__((address_space(1))) float*)v;
}
DEV Params fetch_params() {
  Params q;
  q.x = karg<0>(); q.c = karg<1>(); q.ctx = karg<2>(); q.c_ctx = karg<3>(); q.ada_w = karg<4>(); q.ada_b = karg<5>(); q.ln_g = karg<6>(); q.ln_b = karg<7>();
  q.m_w_in = karg<8>(); q.m_conv_w = karg<9>(); q.m_conv_b = karg<10>(); q.m_a_log = karg<11>(); q.m_dt_bias = karg<12>(); q.m_d = karg<13>();
  q.m_norm_w = karg<14>(); q.m_w_out = karg<15>();
  q.h_w_in = karg<16>(); q.h_conv_w = karg<17>(); q.h_conv_b = karg<18>(); q.h_f_w1 = karg<19>(); q.h_f_b1 = karg<20>(); q.h_f_w2 = karg<21>();
  q.h_f_b2 = karg<22>(); q.h_f_w3 = karg<23>(); q.h_freq = karg<24>(); q.h_bias = karg<25>(); q.h_w_out = karg<26>();
  q.p_wq = karg<27>(); q.p_k1 = karg<28>(); q.p_k2 = karg<29>(); q.p_u = karg<30>(); q.p_v = karg<31>();
  q.out = (float*)karg<32>(); q.ws = (char*)karg<33>();
  return q;
}

__device__ __forceinline__ void transpose_w_tile(const float* src, int srcld, int K, int N, u16* dst, int item, char* lds) {
  float* tile = (float*)lds;
  int ntn = N / 64;
  int kt = item / ntn, nt = item % ntn;
  int tid = otid();
#pragma unroll
  for (int i = 0; i < 4; ++i) {
    int r = (tid >> 4) + i * 16, c4 = (tid & 15) * 4;
    float4 v = *reinterpret_cast<const float4*>(src + (size_t)(kt * 64 + r) * srcld + nt * 64 + c4);
    tile[r * 65 + c4 + 0] = v.x; tile[r * 65 + c4 + 1] = v.y; tile[r * 65 + c4 + 2] = v.z; tile[r * 65 + c4 + 3] = v.w;
  }
  __syncthreads();
#pragma unroll
  for (int i = 0; i < 2; ++i) {
    int n = (tid >> 3) + i * 32, k8 = (tid & 7) * 8;
    uint4 o;
    o.x = pack2(tile[(k8 + 0) * 65 + n], tile[(k8 + 1) * 65 + n]);
    o.y = pack2(tile[(k8 + 2) * 65 + n], tile[(k8 + 3) * 65 + n]);
    o.z = pack2(tile[(k8 + 4) * 65 + n], tile[(k8 + 5) * 65 + n]);
    o.w = pack2(tile[(k8 + 6) * 65 + n], tile[(k8 + 7) * 65 + n]);
    *reinterpret_cast<uint4*>(dst + (size_t)(nt * 64 + n) * K + kt * 64 + k8) = o;
  }
  __syncthreads();
}

__device__ __forceinline__ void ada_item(const Params& p, int item, char* lds) {
  float* sl = (float*)lds;
  float* red = sl + 9 * 1024;
  int layer = item / 96, cg_ = item % 96;
  int tid = otid(), kq = tid >> 6, col = cg_ * 64 + (tid & 63);
  for (int e = tid; e < 9 * 1024; e += 256) {
    int r = e >> 10, k = e & 1023;
    sl[e] = siluf(r < 8 ? p.c[r * 1024 + k] : p.c_ctx[k]);
  }
  __syncthreads();
  float acc[9];
#pragma unroll
  for (int r = 0; r < 9; ++r) acc[r] = 0.f;
  const float* w = p.ada_w + (size_t)layer * 1024 * 6144 + col;
#pragma unroll 8
  for (int k = kq * 256; k < kq * 256 + 256; ++k) {
    float wv = w[(size_t)k * 6144];
#pragma unroll
    for (int r = 0; r < 9; ++r) acc[r] += sl[r * 1024 + k] * wv;
  }
#pragma unroll
  for (int r = 0; r < 9; ++r) red[(kq * 9 + r) * 64 + (tid & 63)] = acc[r];
  __syncthreads();
  if (tid < 64) {
    float* mod = (float*)(p.ws + OFF_MOD);
    float bias = p.ada_b[layer * 6144 + col];
#pragma unroll
    for (int r = 0; r < 9; ++r) {
      float s = red[(0 * 9 + r) * 64 + tid] + red[(1 * 9 + r) * 64 + tid] + red[(2 * 9 + r) * 64 + tid] + red[(3 * 9 + r) * 64 + tid];
      mod[((size_t)layer * 9 + r) * 6144 + col] = s + bias;
    }
  }
  __syncthreads();
}

__device__ __forceinline__ void hyena_mlp_item(const Params& p, int item, char* lds) {
  float* zb = (float*)lds;
  float* h1 = zb + 256;
  float* h2 = h1 + 256;
  int tid = otid(), ti = tid >> 6, j = tid & 63;
  int t = item * 4 + ti;
  const float L = 4096.f;
  if (j < 33) {
    float v;
    if (j == 0) v = (float)t / 4095.f;
    else {
      int k = (j - 1) & 15;
      float fb = 1e-4f + (float)k * ((15.f - 1e-4f) / 15.f);
      float ang = 6.283185307179586f * (float)t / L;
      float a = fb * ang;
      v = (j <= 16) ? cosf(a) : -sinf(a);
    }
    zb[ti * 64 + j] = v;
  }
  __syncthreads();
  float fr = p.h_freq[j];
  float s = p.h_f_b1[j];
#pragma unroll 3
  for (int i = 0; i < 33; ++i) s += zb[ti * 64 + i] * p.h_f_w1[i * 64 + j];
  h1[ti * 64 + j] = sinf(fr * s);
  __syncthreads();
  s = p.h_f_b2[j];
#pragma unroll 8
  for (int i = 0; i < 64; ++i) s += h1[ti * 64 + i] * p.h_f_w2[i * 64 + j];
  h2[ti * 64 + j] = sinf(fr * s);
  __syncthreads();
  s = p.h_f_b2[64 + j];
#pragma unroll 8
  for (int i = 0; i < 64; ++i) s += h2[ti * 64 + i] * p.h_f_w2[4096 + i * 64 + j];
  float* hid = (float*)(p.ws + OFF_HID);
  hid[t * 64 + j] = sinf(fr * s);
  __syncthreads();
}

__device__ __forceinline__ void phase_prologue(const Params& p, char* lds) {
  constexpr int T0 = 1296, T1 = T0 + 512, T2 = T1 + 768, T3 = T2 + 256, T4 = T3 + 512, T5 = T4 + 512, T6 = T5 + 192, T7 = T6 + 1024, T8 = T7 + 256, T9 = T8 + 16;
  for (int item = blockIdx.x; item < T9; item += gridDim.x) {
    if (item < T0) transpose_w_tile(p.m_w_in, SSM_IN, 1024, SSM_IN, (u16*)(p.ws + OFF_W_IN), item, lds);
    else if (item < T1) transpose_w_tile(p.m_w_out, 1024, 2048, 1024, (u16*)(p.ws + OFF_W_OUT), item - T0, lds);
    else if (item < T2) transpose_w_tile(p.h_w_in, 3072, 1024, 3072, (u16*)(p.ws + OFF_W_HIN), item - T1, lds);
    else if (item < T3) transpose_w_tile(p.h_w_out, 1024, 1024, 1024, (u16*)(p.ws + OFF_W_HOUT), item - T2, lds);
    else if (item < T4) transpose_w_tile(p.p_wq, 2048, 1024, 2048, (u16*)(p.ws + OFF_W_Q), item - T3, lds);
    else if (item < T5) transpose_w_tile(p.p_wq + (size_t)1024 * 2048, 2048, 1024, 2048, (u16*)(p.ws + OFF_W_Q) + (size_t)2048 * 1024, item - T4, lds);
    else if (item < T6) ada_item(p, item - T5, lds);
    else if (item < T7) hyena_mlp_item(p, item - T6, lds);
    else if (item >= T8) {
      int k = (item - T8) * 256 + threadIdx.x;
      float sn, cs;
      sincospif((float)k * (1.f / 4096.f), &sn, &cs);
      ((float2*)(p.ws + OFF_TW))[k] = make_float2(cs, -sn);
    } else {
      int e8 = ((item - T7) * 256 + threadIdx.x) * 8;
      const float* src = e8 < 262144 ? p.p_k1 + e8 : p.p_k2 + (e8 - 262144);
      float4 a0 = *reinterpret_cast<const float4*>(src), a1 = *reinterpret_cast<const float4*>(src + 4);
      uint4 o;
      o.x = pack2(a0.x, a0.y); o.y = pack2(a0.z, a0.w); o.z = pack2(a1.x, a1.y); o.w = pack2(a1.z, a1.w);
      *reinterpret_cast<uint4*>((u16*)(p.ws + OFF_KEYS) + e8) = o;
    }
  }
}

__device__ __forceinline__ void modulate_rows(const float* src, u16* dst, int nrows, int rows_per_batch, const float* modbase, int sh_off, int sc_off, bool ctxrow) {
  size_t total = (size_t)nrows * 128;
  for (size_t e = (size_t)blockIdx.x * 256 + threadIdx.x; e < total; e += (size_t)gridDim.x * 256) {
    int row = (int)(e >> 7), c8 = (int)(e & 127) * 8;
    int b = ctxrow ? 8 : row / rows_per_batch;
    const float* m = modbase + (size_t)b * 6144;
    float4 a0 = *reinterpret_cast<const float4*>(src + (size_t)row * 1024 + c8);
    float4 a1 = *reinterpret_cast<const float4*>(src + (size_t)row * 1024 + c8 + 4);
    float4 s0 = *reinterpret_cast<const float4*>(m + sc_off + c8);
    float4 s1 = *reinterpret_cast<const float4*>(m + sc_off + c8 + 4);
    float4 h0 = *reinterpret_cast<const float4*>(m + sh_off + c8);
    float4 h1 = *reinterpret_cast<const float4*>(m + sh_off + c8 + 4);
    uint4 o;
    o.x = pack2(a0.x * (1.f + s0.x) + h0.x, a0.y * (1.f + s0.y) + h0.y);
    o.y = pack2(a0.z * (1.f + s0.z) + h0.z, a0.w * (1.f + s0.w) + h0.w);
    o.z = pack2(a1.x * (1.f + s1.x) + h1.x, a1.y * (1.f + s1.y) + h1.y);
    o.w = pack2(a1.z * (1.f + s1.z) + h1.z, a1.w * (1.f + s1.w) + h1.w);
    *reinterpret_cast<uint4*>(dst + (size_t)row * 1024 + c8) = o;
  }
}

constexpr int GLD = 72;
template <class Epi>
__device__ __forceinline__ void gemm_tile(const u16* __restrict__ A, int lda, const u16* __restrict__ Bt, int ldb, int brow, int bcol, int Nmax,
                                          int K, char* lds, Epi epi) {
  u16* SA = (u16*)lds;
  u16* SB = SA + 256 * GLD;
  int tid = otid(), wid = tid >> 6, lane = tid & 63, wr = wid >> 1, wc = wid & 1, fr = lane & 15, fq = lane >> 4;
  f32x4 acc[8][4];
#pragma unroll
  for (int m = 0; m < 8; ++m)
#pragma unroll
    for (int n = 0; n < 4; ++n) acc[m][n] = f32x4{0.f, 0.f, 0.f, 0.f};
  u32x4 ra[8], rb[4];
  const int lr = tid >> 3, lc = (tid & 7) * 8;
  const u16* abase = A + (size_t)brow * lda;
  const unsigned aoff = (unsigned)(lr * lda + lc);
  unsigned bo[4];
#pragma unroll
  for (int i = 0; i < 4; ++i) {
    int br = bcol + lr + i * 32;
    if (br >= Nmax) br = Nmax - 1;
    bo[i] = (unsigned)(br * ldb + lc);
  }
#define GLOADT(KT)                                                                                 \
  _Pragma("unroll") for (int i = 0; i < 8; ++i)                                                    \
    ra[i] = *reinterpret_cast<const u32x4*>(abase + (aoff + (unsigned)((i * 32) * lda + (KT) * 64))); \
  _Pragma("unroll") for (int i = 0; i < 4; ++i)                                                    \
    rb[i] = *reinterpret_cast<const u32x4*>(Bt + (bo[i] + (unsigned)((KT) * 64)));
  const int nk = K / 64;
  GLOADT(0)
  for (int kt = 0; kt < nk; ++kt) {
#pragma unroll
    for (int i = 0; i < 8; ++i) *reinterpret_cast<u32x4*>(SA + (lr + i * 32) * GLD + lc) = ra[i];
#pragma unroll
    for (int i = 0; i < 4; ++i) *reinterpret_cast<u32x4*>(SB + (lr + i * 32) * GLD + lc) = rb[i];
    __syncthreads();
    { const int kn = kt + 1 < nk ? kt + 1 : nk - 1; GLOADT(kn) }
#pragma unroll
    for (int kk = 0; kk < 2; ++kk) {
      bf16x8 Bl[4];
#pragma unroll
      for (int n = 0; n < 4; ++n) Bl[n] = ld8(SB + (wc * 64 + n * 16 + fr) * GLD + kk * 32 + fq * 8);
#pragma unroll
      for (int mh = 0; mh < 2; ++mh) {
        bf16x8 At[4];
#pragma unroll
        for (int m = 0; m < 4; ++m) At[m] = ld8(SA + (wr * 128 + (mh * 4 + m) * 16 + fr) * GLD + kk * 32 + fq * 8);
#pragma unroll
        for (int m = 0; m < 4; ++m)
#pragma unroll
          for (int n = 0; n < 4; ++n) acc[mh * 4 + m][n] = mfma16(Bl[n], At[m], acc[mh * 4 + m][n]);
      }
    }
    __syncthreads();
  }
#undef GLOADT
#pragma unroll
  for (int m = 0; m < 8; ++m)
#pragma unroll
    for (int n = 0; n < 4; ++n) epi(brow + wr * 128 + m * 16 + fr, bcol + wc * 64 + n * 16 + fq * 4, acc[m][n]);
}

DEV float softplusf(float v) { return fmaxf(v, 0.f) + log1pf(__expf(-fabsf(v))); }

__device__ __forceinline__ void phase_gemm_inproj(const Params& p, char* lds) {
  const u16* hx = (const u16*)(p.ws + OFF_R2);
  const u16* hc = (const u16*)(p.ws + OFF_HC);
  const u16* Wt = (const u16*)(p.ws + OFF_W_IN);
  u16* zbuf = (u16*)p.out;
  u16* xbc = (u16*)(p.ws + OFF_R1);
  float* dt = (float*)(p.ws + OFF_DT);
  u16* xbc_c = (u16*)(p.ws + OFF_XBC_C);
  float* dt_c = (float*)(p.ws + OFF_DT_C);
  const float* dtb = p.m_dt_bias;
  const int xcd = blockIdx.x & 7, li = blockIdx.x >> 3, nl = gridDim.x >> 3;
  auto epi_lat = [=](int m, int n, f32x4 v) {
    if (n < 2048) *reinterpret_cast<uint2*>(zbuf + (size_t)m * 2048 + n) = make_uint2(pack2(v[0], v[1]), pack2(v[2], v[3]));
    else if (n < 5120) *reinterpret_cast<uint2*>(xbc + (size_t)m * 3072 + (n - 2048)) = make_uint2(pack2(v[0], v[1]), pack2(v[2], v[3]));
    else if (n < 5184) {
      float4 bb = *reinterpret_cast<const float4*>(dtb + (n - 5120));
      *reinterpret_cast<float4*>(dt + (size_t)m * 64 + (n - 5120)) = make_float4(softplusf(v[0] + bb.x), softplusf(v[1] + bb.y), softplusf(v[2] + bb.z), softplusf(v[3] + bb.w));
    }
  };
  auto epi_ctx = [=](int m, int n, f32x4 v) {
    if (n < 3072) *reinterpret_cast<uint2*>(xbc_c + (size_t)m * 3072 + n) = make_uint2(pack2(v[0], v[1]), pack2(v[2], v[3]));
    else if (n < 3136) {
      float4 bb = *reinterpret_cast<const float4*>(dtb + (n - 3072));
      *reinterpret_cast<float4*>(dt_c + (size_t)m * 64 + (n - 3072)) = make_float4(softplusf(v[0] + bb.x), softplusf(v[1] + bb.y), softplusf(v[2] + bb.z), softplusf(v[3] + bb.w));
    }
  };
  for (int t = li; t < 128 * 5; t += nl) {
    int pm = t / 5, pn = xcd + 8 * (t % 5);
    gemm_tile(hx, 1024, Wt, 1024, pm * 256, pn * 128, SSM_IN, 1024, lds, epi_lat);
  }
  for (int t = blockIdx.x; t < 128 + 8 * 25; t += gridDim.x) {
    if (t < 128) gemm_tile(hx, 1024, Wt, 1024, t * 256, 40 * 128, SSM_IN, 1024, lds, epi_lat);
    else {
      int it = t - 128, pm = it / 25, pn = it % 25;
      gemm_tile(hc, 1024, Wt + (size_t)2048 * 1024, 1024, pm * 256, pn * 128, 3136, 1024, lds, epi_ctx);
    }
  }
}

DEV void fma8(float* acc, const u32x4& v, const float* w) {
  acc[0] += bflo(v[0]) * w[0]; acc[1] += bfhi(v[0]) * w[1]; acc[2] += bflo(v[1]) * w[2]; acc[3] += bfhi(v[1]) * w[3];
  acc[4] += bflo(v[2]) * w[4]; acc[5] += bfhi(v[2]) * w[5]; acc[6] += bflo(v[3]) * w[6]; acc[7] += bfhi(v[3]) * w[7];
}
__device__ __forceinline__ void phase_conv(const Params& p) {
  const u16* xbc = (const u16*)(p.ws + OFF_R1);
  u16* xc = (u16*)(p.ws + OFF_R2);
  const u16* xbc_c = (const u16*)(p.ws + OFF_XBC_C);
  u16* xc_c = (u16*)(p.ws + OFF_XC_C);
  const float* cw = p.m_conv_w;
  const float* cb = p.m_conv_b;
  const int tid_ = otid();
  const size_t nl = (size_t)8 * 64 * 8 * 384;
  for (size_t e = (size_t)blockIdx.x * 256 + tid_; e < nl; e += (size_t)gridDim.x * 256) {
    int ch = (int)(e % 384) * 8;
    int rest = (int)(e / 384);
    int cg_ = rest & 7, r = (rest >> 3) & 63, b = rest >> 9;
    float w[9][8];
#pragma unroll
    for (int k = 0; k < 9; ++k) {
      float4 w0 = *reinterpret_cast<const float4*>(cw + k * 3072 + ch), w1 = *reinterpret_cast<const float4*>(cw + k * 3072 + ch + 4);
      w[k][0] = w0.x; w[k][1] = w0.y; w[k][2] = w0.z; w[k][3] = w0.w; w[k][4] = w1.x; w[k][5] = w1.y; w[k][6] = w1.z; w[k][7] = w1.w;
    }
    float bias[8];
    {
      float4 b0 = *reinterpret_cast<const float4*>(cb + ch), b1 = *reinterpret_cast<const float4*>(cb + ch + 4);
      bias[0] = b0.x; bias[1] = b0.y; bias[2] = b0.z; bias[3] = b0.w; bias[4] = b1.x; bias[5] = b1.y; bias[6] = b1.z; bias[7] = b1.w;
    }
    const u32x4 zero4 = u32x4{0u, 0u, 0u, 0u};
    const int c0 = cg_ * 8;
    u32x4 win[3][3];
#pragma unroll
    for (int i = 0; i < 3; ++i) {
      int rr = r + i - 1;
      bool rok = rr >= 0 && rr <= 63;
      const u16* rowp = xbc + ((size_t)(b * 4096 + (rok ? rr : r) * 64)) * 3072 + ch;
      win[i][0] = (rok && c0 > 0) ? *reinterpret_cast<const u32x4*>(rowp + (size_t)(c0 - 1) * 3072) : zero4;
      win[i][1] = rok ? *reinterpret_cast<const u32x4*>(rowp + (size_t)c0 * 3072) : zero4;
    }
#pragma unroll
    for (int cc = 0; cc < 8; ++cc) {
      int c = c0 + cc;
#pragma unroll
      for (int i = 0; i < 3; ++i) {
        int rr = r + i - 1;
        bool rok = rr >= 0 && rr <= 63;
        const u16* rowp = xbc + ((size_t)(b * 4096 + (rok ? rr : r) * 64)) * 3072 + ch;
        win[i][2] = (rok && c < 63) ? *reinterpret_cast<const u32x4*>(rowp + (size_t)(c + 1) * 3072) : zero4;
      }
      float acc[8];
#pragma unroll
      for (int k = 0; k < 8; ++k) acc[k] = bias[k];
#pragma unroll
      for (int i = 0; i < 3; ++i)
#pragma unroll
        for (int j = 0; j < 3; ++j) fma8(acc, win[i][j], w[i * 3 + j]);
      uint4 o;
      o.x = pack2(siluf(acc[0]), siluf(acc[1]));
      o.y = pack2(siluf(acc[2]), siluf(acc[3]));
      o.z = pack2(siluf(acc[4]), siluf(acc[5]));
      o.w = pack2(siluf(acc[6]), siluf(acc[7]));
      *reinterpret_cast<uint4*>(xc + ((size_t)(b * 4096 + r * 64 + c)) * 3072 + ch) = o;
#pragma unroll
      for (int i = 0; i < 3; ++i) { win[i][0] = win[i][1]; win[i][1] = win[i][2]; }
    }
  }
  const size_t ncx = (size_t)NTC * 384;
  for (size_t e = (size_t)blockIdx.x * 256 + tid_; e < ncx; e += (size_t)gridDim.x * 256) {
    int tok = (int)(e / 384), ch = (int)(e % 384) * 8;
    float acc[8];
#pragma unroll
    for (int k = 0; k < 8; ++k) acc[k] = cb[ch + k];
    int b = tok >> 8, c = tok & 255;
#pragma unroll
    for (int j = 0; j < 3; ++j) {
      int cc = c + j - 1;
      if (cc < 0 || cc > 255) continue;
      uint4 v = *reinterpret_cast<const uint4*>(xbc_c + ((size_t)(b * 256 + cc)) * 3072 + ch);
      const float* w = cw + (3 + j) * 3072 + ch;
      float4 w0 = *reinterpret_cast<const float4*>(w), w1 = *reinterpret_cast<const float4*>(w + 4);
      acc[0] += bflo(v.x) * w0.x; acc[1] += bfhi(v.x) * w0.y; acc[2] += bflo(v.y) * w0.z; acc[3] += bfhi(v.y) * w0.w;
      acc[4] += bflo(v.z) * w1.x; acc[5] += bfhi(v.z) * w1.y; acc[6] += bflo(v.w) * w1.z; acc[7] += bfhi(v.w) * w1.w;
    }
    uint4 o;
    o.x = pack2(siluf(acc[0]), siluf(acc[1]));
    o.y = pack2(siluf(acc[2]), siluf(acc[3]));
    o.z = pack2(siluf(acc[4]), siluf(acc[5]));
    o.w = pack2(siluf(acc[6]), siluf(acc[7]));
    *reinterpret_cast<uint4*>(xc_c + (size_t)tok * 3072 + ch) = o;
  }
}

constexpr int SLD = 136;
__device__ __forceinline__ void phase_ssd(const Params& p, char* lds) {
  u16* xsT = (u16*)lds;
  u16* stb = xsT + 64 * SLD;
  u16* Mb = stb + 64 * SLD;
  float* cum = (float*)(Mb + 128 * SLD);
  float* dtv = cum + 128;
  float* asrc = dtv + 128;
  const u16* xc = (const u16*)(p.ws + OFF_R2);
  const u16* xc_c = (const u16*)(p.ws + OFF_XC_C);
  const float* dt = (const float*)(p.ws + OFF_DT);
  const float* dt_c = (const float*)(p.ws + OFF_DT_C);
  u16* y = (u16*)(p.ws + OFF_R1);
  int tid = otid(), w = tid >> 6, lane = tid & 63, fr = lane & 15, fq = lane >> 4;
  unsigned char* yb8 = (unsigned char*)(p.ws + OFF_R1 + 128 * MiB);
  for (int item = blockIdx.x; item < 512; item += gridDim.x) {
    int b = item >> 6, h = (item >> 1) & 31, g = h >> 3;
    float dsk = p.m_d[h];
    {
      const int dir = item & 1;
      float a_neg = -__expf(p.m_a_log[dir * 32 + h]);
      f32x4 acc_s[8];
#pragma unroll
      for (int n = 0; n < 8; ++n) acc_s[n] = f32x4{0.f, 0.f, 0.f, 0.f};
      for (int step = 0; step < 34; ++step) {
        bool isctx = step < 2;
        int cidx = isctx ? step : step - 2;
        if (dir) cidx = (isctx ? 1 : 31) - cidx;
        size_t tok0 = isctx ? (size_t)(b * 256 + cidx * 128) : (size_t)(b * 4096 + cidx * 128);
        const u16* src = (isctx ? xc_c : xc) + tok0 * 3072;
        const float* dts = (isctx ? dt_c : dt) + tok0 * 64;
        int tz = tid;
        asm volatile("" : "+v"(tz));
        float dval = 0.f;
        if (tid < 128) dval = dts[tid * 64 + dir * 32 + h];
        uint4 xv[4], bv[8];
#pragma unroll
        for (int i = 0; i < 4; ++i) {
          int idx = tz + i * 256, l = (idx & 31) | ((idx >> 8) << 5), pc = ((idx >> 5) & 7) * 8;
          xv[i] = *reinterpret_cast<const uint4*>(src + (size_t)l * 3072 + h * 64 + pc);
        }
#pragma unroll
        for (int i = 0; i < 8; ++i) {
          int idx = tz + i * 256, l = (idx & 31) | (((idx >> 9) & 3) << 5), nc = (((idx >> 5) & 7) | (((idx >> 8) & 1) << 3)) * 8;
          bv[i] = *reinterpret_cast<const uint4*>(src + (size_t)l * 3072 + 2048 + g * 128 + nc);
        }
        if (tid < 128) { dtv[tid] = dval; asrc[tid] = dval * a_neg; }
#pragma unroll
        for (int i = 0; i < 4; ++i) {
          int idx = tz + i * 256, l = (idx & 31) | ((idx >> 8) << 5), pc = ((idx >> 5) & 7) * 8;
          uint4 v = xv[i];
          xsT[(pc + 0) * SLD + l] = (u16)(v.x & 0xffff); xsT[(pc + 1) * SLD + l] = (u16)(v.x >> 16);
          xsT[(pc + 2) * SLD + l] = (u16)(v.y & 0xffff); xsT[(pc + 3) * SLD + l] = (u16)(v.y >> 16);
          xsT[(pc + 4) * SLD + l] = (u16)(v.z & 0xffff); xsT[(pc + 5) * SLD + l] = (u16)(v.z >> 16);
          xsT[(pc + 6) * SLD + l] = (u16)(v.w & 0xffff); xsT[(pc + 7) * SLD + l] = (u16)(v.w >> 16);
        }
        if (!isctx) {
#pragma unroll
          for (int i = 0; i < 8; ++i) {
            int idx = tz + i * 256, l = (idx & 31) | (((idx >> 9) & 3) << 5), nc = (((idx >> 5) & 7) | (((idx >> 8) & 1) << 3)) * 8;
            *reinterpret_cast<uint4*>(Mb + l * SLD + nc) = bv[i];
          }
        }
        __syncthreads();
        bf16x8 Cf[2][4];
        if (!isctx) {
#pragma unroll
          for (int mt = 0; mt < 2; ++mt)
#pragma unroll
            for (int kk = 0; kk < 4; ++kk) Cf[mt][kk] = ld8(src + (size_t)(w * 32 + mt * 16 + fr) * 3072 + 2560 + g * 128 + kk * 32 + fq * 8);
        }
        if (tid < 128) {
          float s = 0.f;
          if (!dir) { for (int j = 0; j <= tid; ++j) s += asrc[j]; }
          else { for (int j = tid; j < 128; ++j) s += asrc[j]; }
          cum[tid] = s;
        }
        __syncthreads();
        float total = dir ? cum[0] : cum[127];
        if (!isctx) {
          float cl[2][4];
#pragma unroll
          for (int mt = 0; mt < 2; ++mt)
#pragma unroll
            for (int j = 0; j < 4; ++j) cl[mt][j] = cum[w * 32 + mt * 16 + fq * 4 + j];
          f32x4 cb0[8], cb1[8];
#pragma unroll
          for (int nt = 0; nt < 8; ++nt) {
            cb0[nt] = f32x4{0.f, 0.f, 0.f, 0.f};
            cb1[nt] = f32x4{0.f, 0.f, 0.f, 0.f};
            bool need = dir ? (nt >= w * 2) : (nt <= w * 2 + 1);
            if (need) {
#pragma unroll
              for (int kk = 0; kk < 4; ++kk) {
                bf16x8 Bf = ld8(Mb + (nt * 16 + fr) * SLD + kk * 32 + fq * 8);
                cb0[nt] = mfma16(Cf[0][kk], Bf, cb0[nt]);
                cb1[nt] = mfma16(Cf[1][kk], Bf, cb1[nt]);
              }
            }
          }
          __syncthreads();
          int zero = 0;
          asm volatile("" : "+v"(zero));
#pragma unroll
          for (int nt = 0; nt < 8; ++nt) {
            int s = nt * 16 + fr + zero;
            float cs = cum[s], ds = dtv[s];
#pragma unroll
            for (int j = 0; j < 4; ++j) {
              int l0 = w * 32 + fq * 4 + j, l1 = l0 + 16;
              bool ok0 = dir ? (s >= l0) : (s <= l0);
              bool ok1 = dir ? (s >= l1) : (s <= l1);
              float v0 = ok0 ? cb0[nt][j] * __expf(cl[0][j] - cs) * ds : 0.f;
              float v1 = ok1 ? cb1[nt][j] * __expf(cl[1][j] - cs) * ds : 0.f;
              Mb[l0 * SLD + s] = f2bf(v0);
              Mb[l1 * SLD + s] = f2bf(v1);
            }
          }
          __syncthreads();
          f32x4 ya[2][4];
#pragma unroll
          for (int mt = 0; mt < 2; ++mt)
#pragma unroll
            for (int nt = 0; nt < 4; ++nt) ya[mt][nt] = f32x4{0.f, 0.f, 0.f, 0.f};
#pragma unroll
          for (int kk = 0; kk < 4; ++kk)
#pragma unroll
            for (int nt = 0; nt < 4; ++nt) {
              bf16x8 Sf = ld8(stb + (nt * 16 + fr) * SLD + kk * 32 + fq * 8);
              ya[0][nt] = mfma16(Sf, Cf[0][kk], ya[0][nt]);
              ya[1][nt] = mfma16(Sf, Cf[1][kk], ya[1][nt]);
            }
#pragma unroll
          for (int mt = 0; mt < 2; ++mt) {
            float e = __expf(cum[w * 32 + mt * 16 + fr]);
#pragma unroll
            for (int nt = 0; nt < 4; ++nt) ya[mt][nt] *= e;
          }
#pragma unroll
          for (int kk = 0; kk < 4; ++kk) {
            bf16x8 Mf0 = ld8(Mb + (w * 32 + fr) * SLD + kk * 32 + fq * 8);
            bf16x8 Mf1 = ld8(Mb + (w * 32 + 16 + fr) * SLD + kk * 32 + fq * 8);
#pragma unroll
            for (int nt = 0; nt < 4; ++nt) {
              bf16x8 Xf = ld8(xsT + (nt * 16 + fr) * SLD + kk * 32 + fq * 8);
              ya[0][nt] = mfma16(Xf, Mf0, ya[0][nt]);
              ya[1][nt] = mfma16(Xf, Mf1, ya[1][nt]);
            }
          }
#pragma unroll
          for (int i = 0; i < 8; ++i) {
            int idx = tz + i * 256, l = (idx & 31) | (((idx >> 9) & 3) << 5), nc = (((idx >> 5) & 7) | (((idx >> 8) & 1) << 3)) * 8;
            bv[i] = *reinterpret_cast<const uint4*>(src + (size_t)l * 3072 + 2048 + g * 128 + nc);
          }
#pragma unroll
          for (int mt = 0; mt < 2; ++mt)
#pragma unroll
            for (int nt = 0; nt < 4; ++nt) {
              const int l = w * 32 + mt * 16 + fr, p0 = nt * 16 + fq * 4;
              f32x4 v = ya[mt][nt];
              if (!dir) {
                v[0] += bf2f(xsT[(p0 + 0) * SLD + l]) * dsk; v[1] += bf2f(xsT[(p0 + 1) * SLD + l]) * dsk;
                v[2] += bf2f(xsT[(p0 + 2) * SLD + l]) * dsk; v[3] += bf2f(xsT[(p0 + 3) * SLD + l]) * dsk;
                *reinterpret_cast<uint2*>(y + (tok0 + l) * 2048 + h * 64 + p0) = make_uint2(pack2(v[0], v[1]), pack2(v[2], v[3]));
              } else {
                int pk = __builtin_amdgcn_cvt_pk_fp8_f32(fminf(fmaxf(v[0] * 4.f, -440.f), 440.f), fminf(fmaxf(v[1] * 4.f, -440.f), 440.f), 0, false);
                pk = __builtin_amdgcn_cvt_pk_fp8_f32(fminf(fmaxf(v[2] * 4.f, -440.f), 440.f), fminf(fmaxf(v[3] * 4.f, -440.f), 440.f), pk, true);
                *reinterpret_cast<int*>(yb8 + (tok0 + l) * 2048 + h * 64 + p0) = pk;
              }
            }
        }
        if (step == 33) continue;
        __syncthreads();
#pragma unroll
        for (int i = 0; i < 8; ++i) {
          int idx = tz + i * 256, l = (idx & 31) | (((idx >> 9) & 3) << 5), nc = (((idx >> 5) & 7) | (((idx >> 8) & 1) << 3)) * 8;
          uint4 v = bv[i];
          float sc = dtv[l] * __expf(total - cum[l]);
          Mb[(nc + 0) * SLD + l] = f2bf(bflo(v.x) * sc); Mb[(nc + 1) * SLD + l] = f2bf(bfhi(v.x) * sc);
          Mb[(nc + 2) * SLD + l] = f2bf(bflo(v.y) * sc); Mb[(nc + 3) * SLD + l] = f2bf(bfhi(v.y) * sc);
          Mb[(nc + 4) * SLD + l] = f2bf(bflo(v.z) * sc); Mb[(nc + 5) * SLD + l] = f2bf(bfhi(v.z) * sc);
          Mb[(nc + 6) * SLD + l] = f2bf(bflo(v.w) * sc); Mb[(nc + 7) * SLD + l] = f2bf(bfhi(v.w) * sc);
        }
        __syncthreads();
        float cd = __expf(total);
#pragma unroll
        for (int nt = 0; nt < 8; ++nt) acc_s[nt] *= cd;
#pragma unroll
        for (int kk = 0; kk < 4; ++kk) {
          bf16x8 Af = ld8(xsT + (w * 16 + fr) * SLD + kk * 32 + fq * 8);
#pragma unroll
          for (int nt = 0; nt < 8; ++nt) {
            bf16x8 Bf = ld8(Mb + (nt * 16 + fr) * SLD + kk * 32 + fq * 8);
            acc_s[nt] = mfma16(Af, Bf, acc_s[nt]);
          }
        }
#pragma unroll
        for (int nt = 0; nt < 8; ++nt)
#pragma unroll
          for (int j = 0; j < 4; ++j) stb[(w * 16 + fq * 4 + j) * SLD + nt * 16 + fr] = f2bf(acc_s[nt][j]);
        __syncthreads();
      }
      __syncthreads();
    }
  }
}

__device__ __forceinline__ void phase_gated_norm(const Params& p) {
  u16* y = (u16*)(p.ws + OFF_R1);
  const u16* z = (const u16*)p.out;
  const unsigned char* yb8 = (const unsigned char*)(p.ws + OFF_R1 + 128 * MiB);
  const int tid_ = otid();
  int lane = tid_ & 63;
  int wave = blockIdx.x * 4 + (tid_ >> 6), nw = gridDim.x * 4;
  for (int tok = wave; tok < NT; tok += nw) {
#pragma unroll
    for (int g = 0; g < 4; ++g) {
      int ch = g * 512 + lane * 8;
      uint4 yv = *reinterpret_cast<const uint4*>(y + (size_t)tok * 2048 + ch);
      uint4 zv = *reinterpret_cast<const uint4*>(z + (size_t)tok * 2048 + ch);
      uint2 bw = *reinterpret_cast<const uint2*>(yb8 + (size_t)tok * 2048 + ch);
      f32x2 b01 = __builtin_amdgcn_cvt_pk_f32_fp8((int)bw.x, false), b23 = __builtin_amdgcn_cvt_pk_f32_fp8((int)bw.x, true);
      f32x2 b45 = __builtin_amdgcn_cvt_pk_f32_fp8((int)bw.y, false), b67 = __builtin_amdgcn_cvt_pk_f32_fp8((int)bw.y, true);
      const float r16 = 0.25f;
      float u[8];
      u[0] = (bflo(yv.x) + b01.x * r16) * siluf(bflo(zv.x)); u[1] = (bfhi(yv.x) + b01.y * r16) * siluf(bfhi(zv.x));
      u[2] = (bflo(yv.y) + b23.x * r16) * siluf(bflo(zv.y)); u[3] = (bfhi(yv.y) + b23.y * r16) * siluf(bfhi(zv.y));
      u[4] = (bflo(yv.z) + b45.x * r16) * siluf(bflo(zv.z)); u[5] = (bfhi(yv.z) + b45.y * r16) * siluf(bfhi(zv.z));
      u[6] = (bflo(yv.w) + b67.x * r16) * siluf(bflo(zv.w)); u[7] = (bfhi(yv.w) + b67.y * r16) * siluf(bfhi(zv.w));
      float ss = 0.f;
#pragma unroll
      for (int k = 0; k < 8; ++k) ss += u[k] * u[k];
      ss = wave_sum(ss);
      float sc = rsqrtf(ss * (1.f / 512.f) + 1e-5f);
      float4 w0 = *reinterpret_cast<const float4*>(p.m_norm_w + ch), w1 = *reinterpret_cast<const float4*>(p.m_norm_w + ch + 4);
      uint4 o;
      o.x = pack2(u[0] * sc * w0.x, u[1] * sc * w0.y);
      o.y = pack2(u[2] * sc * w0.z, u[3] * sc * w0.w);
      o.z = pack2(u[4] * sc * w1.x, u[5] * sc * w1.y);
      o.w = pack2(u[6] * sc * w1.z, u[7] * sc * w1.w);
      *reinterpret_cast<uint4*>(y + (size_t)tok * 2048 + ch) = o;
    }
  }
}

__device__ __forceinline__ void phase_gemm_resid(const u16* A, int K, const u16* Wt, const float* res, float* dst, const float* gate  , char* lds) {
  const int xcd = blockIdx.x & 7, li = blockIdx.x >> 3, nl = gridDim.x >> 3;
  for (int t = li; t < 128; t += nl) {
    int pm = t, pn = xcd;
    gemm_tile(A, K, Wt, K, pm * 256, pn * 128, 1024, K, lds, [=](int m, int n, f32x4 v) {
      int b = m >> 12;
      float4 r = *reinterpret_cast<const float4*>(res + (size_t)m * 1024 + n);
      float4 g = *reinterpret_cast<const float4*>(gate + (size_t)b * 6144 + n);
      *reinterpret_cast<float4*>(dst + (size_t)m * 1024 + n) = make_float4(ALPHA * r.x + g.x * v[0], ALPHA * r.y + g.y * v[1], ALPHA * r.z + g.z * v[2], ALPHA * r.w + g.w * v[3]);
    });
  }
}
__device__ __forceinline__ void phase_gemm_bf16(const u16* A, const u16* Wt, u16* dst, int N, char* lds) {
  const int xcd = blockIdx.x & 7, li = blockIdx.x >> 3, nl = gridDim.x >> 3;
  const int nb = N / 1024;
  for (int t = li; t < 128 * nb; t += nl) {
    int pm = t / nb, pn = xcd + 8 * (t % nb);
    gemm_tile(A, 1024, Wt, 1024, pm * 256, pn * 128, N, 1024, lds, [=](int m, int n, f32x4 v) { *reinterpret_cast<uint2*>(dst + (size_t)m * N + n) = make_uint2(pack2(v[0], v[1]), pack2(v[2], v[3])); });
  }
}

__device__ __forceinline__ void phase_ln_mod(float* xio, const float* g, const float* bta, const float* mod  , u16* tdst) {
  const int tid_ = otid();
  int lane = tid_ & 63;
  int wave = blockIdx.x * 4 + (tid_ >> 6), nw = gridDim.x * 4;
  for (int tok = wave; tok < NT; tok += nw) {
    int b = tok >> 12;
    float4 v[4];
    float s = 0.f;
#pragma unroll
    for (int i = 0; i < 4; ++i) {
      v[i] = *reinterpret_cast<const float4*>(xio + (size_t)tok * 1024 + i * 256 + lane * 4);
      s += v[i].x + v[i].y + v[i].z + v[i].w;
    }
    float mu = wave_sum(s) * (1.f / 1024.f);
    float q = 0.f;
#pragma unroll
    for (int i = 0; i < 4; ++i) {
      v[i].x -= mu; v[i].y -= mu; v[i].z -= mu; v[i].w -= mu;
      q += v[i].x * v[i].x + v[i].y * v[i].y + v[i].z * v[i].z + v[i].w * v[i].w;
    }
    float rs = rsqrtf(wave_sum(q) * (1.f / 1024.f) + 1e-5f);
    const float* m = mod + (size_t)b * 6144;
#pragma unroll
    for (int i = 0; i < 4; ++i) {
      int c = i * 256 + lane * 4;
      float4 gg = *reinterpret_cast<const float4*>(g + c), bb = *reinterpret_cast<const float4*>(bta + c);
      float4 o;
      o.x = v[i].x * rs * gg.x + bb.x; o.y = v[i].y * rs * gg.y + bb.y; o.z = v[i].z * rs * gg.z + bb.z; o.w = v[i].w * rs * gg.w + bb.w;
      *reinterpret_cast<float4*>(xio + (size_t)tok * 1024 + c) = o;
      float4 sh = *reinterpret_cast<const float4*>(m + 3072 + c), sc = *reinterpret_cast<const float4*>(m + 4096 + c);
      uint2 t;
      t.x = pack2(o.x * (1.f + sc.x) + sh.x, o.y * (1.f + sc.y) + sh.y);
      t.y = pack2(o.z * (1.f + sc.z) + sh.z, o.w * (1.f + sc.w) + sh.w);
      *reinterpret_cast<uint2*>(tdst + (size_t)tok * 1024 + c) = t;
    }
  }
}

__device__ __forceinline__ void phase_peer_topk(const u16* q, const u16* k1, const u16* k2, int* idxo, float* gateo, char* lds) {
  float* S = (float*)lds;
  float* sv = S + 64 * 129;
  int* si = (int*)(sv + 64 * 16);
  int tid = otid(), w = tid >> 6, lane = tid & 63, fr = lane & 15, fq = lane >> 4;
  const int slot = lane;
  const bool cvalid = lane < 50;
  int ci = slot < 42 ? ((slot >= 16) + (slot >= 24) + (slot >= 29) + (slot >= 33) + (slot >= 36) + (slot >= 38) + (slot >= 40)) : slot - 34;
  const unsigned long long PACK = 0ull | (16ull << 8) | (24ull << 16) | (29ull << 24) | (33ull << 32) | (36ull << 40) | (38ull << 48) | (40ull << 56);
  int cj = slot - (ci < 8 ? (int)((PACK >> (8 * ci)) & 0xFF) : 34 + ci);
  if (!cvalid) { ci = 0; cj = 0; }
  for (int item = blockIdx.x; item < 1024 * 8; item += gridDim.x) {
    int tile = item >> 3, h = item & 7;
    int tok0 = tile * 32;
    {
      int half = w >> 1, kb = (w & 1) * 64;
      const u16* kk_ = (half ? k2 : k1) + (size_t)h * 128 * 128;
      bf16x8 Af[2][4], Bf[4][4];
#pragma unroll
      for (int m = 0; m < 2; ++m)
#pragma unroll
        for (int ks = 0; ks < 4; ++ks) Af[m][ks] = ld8(q + (size_t)(tok0 + m * 16 + fr) * 2048 + h * 256 + half * 128 + ks * 32 + fq * 8);
#pragma unroll
      for (int n = 0; n < 4; ++n)
#pragma unroll
        for (int ks = 0; ks < 4; ++ks) Bf[n][ks] = ld8(kk_ + (size_t)(kb + n * 16 + fr) * 128 + ks * 32 + fq * 8);
      f32x4 acc[2][4];
#pragma unroll
      for (int m = 0; m < 2; ++m)
#pragma unroll
        for (int n = 0; n < 4; ++n) acc[m][n] = f32x4{0.f, 0.f, 0.f, 0.f};
#pragma unroll
      for (int ks = 0; ks < 4; ++ks)
#pragma unroll
        for (int n = 0; n < 4; ++n) {
          acc[0][n] = mfma16(Af[0][ks], Bf[n][ks], acc[0][n]);
          acc[1][n] = mfma16(Af[1][ks], Bf[n][ks], acc[1][n]);
        }
#pragma unroll
      for (int m = 0; m < 2; ++m)
#pragma unroll
        for (int n = 0; n < 4; ++n)
#pragma unroll
          for (int j = 0; j < 4; ++j) S[(half * 32 + m * 16 + fq * 4 + j) * 129 + kb + n * 16 + fr] = acc[m][n][j];
    }
    __syncthreads();
#pragma unroll 1
    for (int li = 0; li < 16; ++li) {
      int list = w * 16 + li;
      const float* row = S + list * 129;
      float vlo = row[lane], vhi = row[lane + 64];
      unsigned klo = (ordkey(vlo) & 0xFFFFFF80u) | (unsigned)(127 - lane);
      unsigned khi = (ordkey(vhi) & 0xFFFFFF80u) | (unsigned)(63 - lane);
      unsigned T = 0;
#pragma unroll 4
      for (int bit = 31; bit >= 0; --bit) {
        unsigned cand = T | (1u << bit);
        int cnt = __popcll(__ballot(klo >= cand)) + __popcll(__ballot(khi >= cand));
        if (cnt >= 16) T = cand;
        if (cnt == 16) break;
      }
      bool slo = klo >= T, shi = khi >= T;
      unsigned long long mlo = __ballot(slo), mhi = __ballot(shi);
      int rlo = 0, rhi = 0;
      while (mlo) {
        int src = __ffsll((long long)mlo) - 1;
        mlo &= mlo - 1;
        unsigned ks = (unsigned)__builtin_amdgcn_readlane((int)klo, src);
        rlo += (ks > klo) ? 1 : 0;
        rhi += (ks > khi) ? 1 : 0;
      }
      while (mhi) {
        int src = __ffsll((long long)mhi) - 1;
        mhi &= mhi - 1;
        unsigned ks = (unsigned)__builtin_amdgcn_readlane((int)khi, src);
        rlo += (ks > klo) ? 1 : 0;
        rhi += (ks > khi) ? 1 : 0;
      }
      if (slo) { sv[list * 16 + rlo] = vlo; si[list * 16 + rlo] = lane; }
      if (shi) { sv[list * 16 + rhi] = vhi; si[list * 16 + rhi] = lane + 64; }
    }
    __syncthreads();
#pragma unroll 1
    for (int tt = 0; tt < 8; ++tt) {
      int tok = w * 8 + tt;
      float sc_ = sv[tok * 16 + ci] + sv[(32 + tok) * 16 + cj];
      unsigned key = cvalid ? ((ordkey(sc_) & 0xFFFFFFC0u) | (unsigned)(63 - lane)) : 0u;
      unsigned T = 0;
#pragma unroll 4
      for (int bit = 31; bit >= 0; --bit) {
        unsigned cand = T | (1u << bit);
        int cnt = __popcll(__ballot(key >= cand));
        if (cnt >= 16) T = cand;
        if (cnt == 16) break;
      }
      bool sel = cvalid && key >= T;
      unsigned long long msel = __ballot(sel);
      int rank = 0;
      int isc = __float_as_int(sc_);
      unsigned long long mm = msel;
      float mx = -INFINITY;
      while (mm) {
        int src = __ffsll((long long)mm) - 1;
        mm &= mm - 1;
        unsigned ks = (unsigned)__builtin_amdgcn_readlane((int)key, src);
        rank += (ks > key) ? 1 : 0;
        mx = fmaxf(mx, __int_as_float(__builtin_amdgcn_readlane(isc, src)));
      }
      float ex = sel ? __expf(sc_ - mx) : 0.f;
      int iex = __float_as_int(ex);
      float sum = 0.f;
      mm = msel;
      while (mm) {
        int src = __ffsll((long long)mm) - 1;
        mm &= mm - 1;
        sum += __int_as_float(__builtin_amdgcn_readlane(iex, src));
      }
      if (sel) {
        size_t o = (size_t)(tok0 + tok) * 128 + h * 16 + rank;
        gateo[o] = ex / sum;
        idxo[o] = si[tok * 16 + ci] * 128 + si[(32 + tok) * 16 + cj];
      }
    }
  }
  __syncthreads();
}

DEV float gelu_exact(float v) { return 0.5f * v * (1.f + erff(v * 0.70710678118654752f)); }

__device__ __forceinline__ void convert_fp8_rows(const float* src, unsigned char* dst, float* rscale, int nrows) {
  const int tid_ = otid();
  int lane = tid_ & 63;
  int wave = blockIdx.x * 4 + (tid_ >> 6), nw = gridDim.x * 4;
  for (int row = wave; row < nrows; row += nw) {
    const float* r = src + (size_t)row * 1024 + lane * 16;
    float4 a0 = *reinterpret_cast<const float4*>(r), a1 = *reinterpret_cast<const float4*>(r + 4);
    float4 a2 = *reinterpret_cast<const float4*>(r + 8), a3 = *reinterpret_cast<const float4*>(r + 12);
    float m = fmaxf(fmaxf(fmaxf(fabsf(a0.x), fabsf(a0.y)), fmaxf(fabsf(a0.z), fabsf(a0.w))), fmaxf(fmaxf(fabsf(a1.x), fabsf(a1.y)), fmaxf(fabsf(a1.z), fabsf(a1.w))));
    m = fmaxf(m, fmaxf(fmaxf(fmaxf(fabsf(a2.x), fabsf(a2.y)), fmaxf(fabsf(a2.z), fabsf(a2.w))), fmaxf(fmaxf(fabsf(a3.x), fabsf(a3.y)), fmaxf(fabsf(a3.z), fabsf(a3.w)))));
#pragma unroll
    for (int o = 32; o > 0; o >>= 1) m = fmaxf(m, __shfl_xor(m, o));
    float sc = m > 0.f ? exp2f(floorf(log2f(224.f / m))) : 1.f;
    uint4 o;
    int p;
    p = __builtin_amdgcn_cvt_pk_fp8_f32(a0.x * sc, a0.y * sc, 0, false); p = __builtin_amdgcn_cvt_pk_fp8_f32(a0.z * sc, a0.w * sc, p, true); o.x = (unsigned)p;
    p = __builtin_amdgcn_cvt_pk_fp8_f32(a1.x * sc, a1.y * sc, 0, false); p = __builtin_amdgcn_cvt_pk_fp8_f32(a1.z * sc, a1.w * sc, p, true); o.y = (unsigned)p;
    p = __builtin_amdgcn_cvt_pk_fp8_f32(a2.x * sc, a2.y * sc, 0, false); p = __builtin_amdgcn_cvt_pk_fp8_f32(a2.z * sc, a2.w * sc, p, true); o.z = (unsigned)p;
    p = __builtin_amdgcn_cvt_pk_fp8_f32(a3.x * sc, a3.y * sc, 0, false); p = __builtin_amdgcn_cvt_pk_fp8_f32(a3.z * sc, a3.w * sc, p, true); o.w = (unsigned)p;
    *reinterpret_cast<uint4*>(dst + (size_t)row * 1024 + lane * 16) = o;
    if (lane == 0) rscale[row] = 1.f / sc;
  }
}

#define F8X(dst, WW) { dst[0] = __builtin_amdgcn_cvt_pk_f32_fp8((int)(WW).x, false); dst[1] = __builtin_amdgcn_cvt_pk_f32_fp8((int)(WW).x, true); \
                      dst[2] = __builtin_amdgcn_cvt_pk_f32_fp8((int)(WW).y, false); dst[3] = __builtin_amdgcn_cvt_pk_f32_fp8((int)(WW).y, true); \
                      dst[4] = __builtin_amdgcn_cvt_pk_f32_fp8((int)(WW).z, false); dst[5] = __builtin_amdgcn_cvt_pk_f32_fp8((int)(WW).z, true); \
                      dst[6] = __builtin_amdgcn_cvt_pk_f32_fp8((int)(WW).w, false); dst[7] = __builtin_amdgcn_cvt_pk_f32_fp8((int)(WW).w, true); }

__device__ __forceinline__ void phase_peer_gather(const u16* tin, const int* idx, const float* gate, const unsigned char* utab, const unsigned char* vtab,
                                  const float* urs, const float* vrs, const float* xres,
                                  const float* g2  , const float* lng, const float* lnb, float* xout,
                                  const float* modnext  , u16* hxout) {
  const int tid_ = otid();
  int lane = tid_ & 63;
  int wave = blockIdx.x * 4 + (tid_ >> 6), nw = gridDim.x * 4;
  for (int tok = wave; tok < NT; tok += nw) {
    int b = tok >> 12;
    f32x2 t2[8];
    {
      uint4 ta = *reinterpret_cast<const uint4*>(tin + (size_t)tok * 1024 + lane * 16);
      uint4 tb = *reinterpret_cast<const uint4*>(tin + (size_t)tok * 1024 + lane * 16 + 8);
      t2[0] = f32x2{bflo(ta.x), bfhi(ta.x)}; t2[1] = f32x2{bflo(ta.y), bfhi(ta.y)}; t2[2] = f32x2{bflo(ta.z), bfhi(ta.z)}; t2[3] = f32x2{bflo(ta.w), bfhi(ta.w)};
      t2[4] = f32x2{bflo(tb.x), bfhi(tb.x)}; t2[5] = f32x2{bflo(tb.y), bfhi(tb.y)}; t2[6] = f32x2{bflo(tb.z), bfhi(tb.z)}; t2[7] = f32x2{bflo(tb.w), bfhi(tb.w)};
    }
    int id0 = idx[(size_t)tok * 128 + lane] & 16383, id1 = idx[(size_t)tok * 128 + 64 + lane] & 16383;
    int gt0 = __float_as_int(gate[(size_t)tok * 128 + lane]), gt1 = __float_as_int(gate[(size_t)tok * 128 + 64 + lane]);
    f32x2 acc2[8];
#pragma unroll
    for (int k = 0; k < 8; ++k) acc2[k] = f32x2{0.f, 0.f};
#pragma unroll 1
    for (int j = 0; j < 128; j += 4) {
      int e[4];
      float g[4];
      if (j < 64) {
#pragma unroll
        for (int q = 0; q < 4; ++q) { e[q] = __builtin_amdgcn_readlane(id0, j + q); g[q] = __int_as_float(__builtin_amdgcn_readlane(gt0, j + q)); }
      } else {
#pragma unroll
        for (int q = 0; q < 4; ++q) { e[q] = __builtin_amdgcn_readlane(id1, j - 64 + q); g[q] = __int_as_float(__builtin_amdgcn_readlane(gt1, j - 64 + q)); }
      }
      uint4 U[4], V[4];
      float su[4], sv_[4];
#pragma unroll
      for (int q = 0; q < 4; ++q) {
        U[q] = *reinterpret_cast<const uint4*>(utab + (size_t)e[q] * 1024 + lane * 16);
        V[q] = *reinterpret_cast<const uint4*>(vtab + (size_t)e[q] * 1024 + lane * 16);
        su[q] = urs[e[q]];
        sv_[q] = vrs[e[q]];
      }
      float d[4];
#pragma unroll
      for (int q = 0; q < 4; ++q) {
        f32x2 u2[8];
        F8X(u2, U[q])
        f32x2 dd = u2[0] * t2[0];
#pragma unroll
        for (int k = 1; k < 8; ++k) dd = u2[k] * t2[k] + dd;
        d[q] = dd.x + dd.y;
      }
#pragma unroll
      for (int o = 32; o > 0; o >>= 1) {
#pragma unroll
        for (int q = 0; q < 4; ++q) d[q] += __shfl_xor(d[q], o);
      }
#pragma unroll
      for (int q = 0; q < 4; ++q) {
        float a = g[q] * gelu_exact(d[q] * su[q]) * sv_[q];
        f32x2 aa = f32x2{a, a};
        f32x2 v2[8];
        F8X(v2, V[q])
#pragma unroll
        for (int k = 0; k < 8; ++k) acc2[k] = aa * v2[k] + acc2[k];
      }
    }
    float vv[16];
    float s = 0.f;
    const int c0 = lane * 16;
#pragma unroll
    for (int k4 = 0; k4 < 4; ++k4) {
      float4 x0 = *reinterpret_cast<const float4*>(xres + (size_t)tok * 1024 + c0 + k4 * 4);
      float4 g0 = *reinterpret_cast<const float4*>(g2 + (size_t)b * 6144 + c0 + k4 * 4);
      vv[k4 * 4 + 0] = ALPHA * x0.x + g0.x * acc2[k4 * 2].x; vv[k4 * 4 + 1] = ALPHA * x0.y + g0.y * acc2[k4 * 2].y;
      vv[k4 * 4 + 2] = ALPHA * x0.z + g0.z * acc2[k4 * 2 + 1].x; vv[k4 * 4 + 3] = ALPHA * x0.w + g0.w * acc2[k4 * 2 + 1].y;
    }
#pragma unroll
    for (int k = 0; k < 16; ++k) s += vv[k];
    float mu = wave_sum(s) * (1.f / 1024.f);
    float qq = 0.f;
#pragma unroll
    for (int k = 0; k < 16; ++k) { vv[k] -= mu; qq += vv[k] * vv[k]; }
    float rs = rsqrtf(wave_sum(qq) * (1.f / 1024.f) + 1e-5f);
    float oo[16];
#pragma unroll
    for (int k4 = 0; k4 < 4; ++k4) {
      float4 ga = *reinterpret_cast<const float4*>(lng + c0 + k4 * 4), ba = *reinterpret_cast<const float4*>(lnb + c0 + k4 * 4);
      float4 o0;
      o0.x = vv[k4 * 4 + 0] * rs * ga.x + ba.x; o0.y = vv[k4 * 4 + 1] * rs * ga.y + ba.y; o0.z = vv[k4 * 4 + 2] * rs * ga.z + ba.z; o0.w = vv[k4 * 4 + 3] * rs * ga.w + ba.w;
      *reinterpret_cast<float4*>(xout + (size_t)tok * 1024 + c0 + k4 * 4) = o0;
      oo[k4 * 4 + 0] = o0.x; oo[k4 * 4 + 1] = o0.y; oo[k4 * 4 + 2] = o0.z; oo[k4 * 4 + 3] = o0.w;
    }
    if (modnext) {
      const float* m = modnext + (size_t)b * 6144;
      unsigned pk[8];
#pragma unroll
      for (int k4 = 0; k4 < 4; ++k4) {
        float4 sh0 = *reinterpret_cast<const float4*>(m + c0 + k4 * 4), sc0 = *reinterpret_cast<const float4*>(m + 1024 + c0 + k4 * 4);
        pk[k4 * 2] = pack2(oo[k4 * 4 + 0] * (1.f + sc0.x) + sh0.x, oo[k4 * 4 + 1] * (1.f + sc0.y) + sh0.y);
        pk[k4 * 2 + 1] = pack2(oo[k4 * 4 + 2] * (1.f + sc0.z) + sh0.z, oo[k4 * 4 + 3] * (1.f + sc0.w) + sh0.w);
      }
      *reinterpret_cast<uint4*>(hxout + (size_t)tok * 1024 + c0) = make_uint4(pk[0], pk[1], pk[2], pk[3]);
      *reinterpret_cast<uint4*>(hxout + (size_t)tok * 1024 + c0 + 8) = make_uint4(pk[4], pk[5], pk[6], pk[7]);
    }
  }
}

__device__ __forceinline__ void phase_shortconv_T(const Params& p, const u16* upre, u16* x1cm, u16* x2cm, u16* vcm, char* lds) {
  constexpr int TLD = 264;
  u16* tile = (u16*)lds;
  int tid = otid();
  const int tg = tid >> 3, cg_ = tid & 7;
  for (int item = blockIdx.x; item < 128 * 48; item += gridDim.x) {
    int tt = item / 48, ct = item % 48;
    int tok0 = tt * 256, c0 = ct * 64;
    int ch = c0 + cg_ * 8;
    float w[3][8], bias[8];
#pragma unroll
    for (int j = 0; j < 3; ++j) {
      float4 w0 = *reinterpret_cast<const float4*>(p.h_conv_w + j * 3072 + ch), w1 = *reinterpret_cast<const float4*>(p.h_conv_w + j * 3072 + ch + 4);
      w[j][0] = w0.x; w[j][1] = w0.y; w[j][2] = w0.z; w[j][3] = w0.w; w[j][4] = w1.x; w[j][5] = w1.y; w[j][6] = w1.z; w[j][7] = w1.w;
    }
    {
      float4 b0 = *reinterpret_cast<const float4*>(p.h_conv_b + ch), b1 = *reinterpret_cast<const float4*>(p.h_conv_b + ch + 4);
      bias[0] = b0.x; bias[1] = b0.y; bias[2] = b0.z; bias[3] = b0.w; bias[4] = b1.x; bias[5] = b1.y; bias[6] = b1.z; bias[7] = b1.w;
    }
    const int t0 = tok0 + tg * 8;
    const int l0 = t0 & 4095;
    const u32x4 zero4 = u32x4{0u, 0u, 0u, 0u};
    u32x4 rows[10];
#pragma unroll
    for (int i = 0; i < 10; ++i) {
      int ll = l0 + i - 1;
      rows[i] = (ll >= 0 && ll <= 4095) ? *reinterpret_cast<const u32x4*>(upre + (size_t)(t0 + i - 1) * 3072 + ch) : zero4;
    }
    float o[8][8];
#pragma unroll
    for (int i = 0; i < 8; ++i) {
#pragma unroll
      for (int k = 0; k < 8; ++k) o[i][k] = bias[k];
      fma8(o[i], rows[i], w[0]);
      fma8(o[i], rows[i + 1], w[1]);
      fma8(o[i], rows[i + 2], w[2]);
    }
#pragma unroll
    for (int k = 0; k < 8; ++k) {
      uint4 pk;
      pk.x = pack2(o[0][k], o[1][k]); pk.y = pack2(o[2][k], o[3][k]); pk.z = pack2(o[4][k], o[5][k]); pk.w = pack2(o[6][k], o[7][k]);
      *reinterpret_cast<uint4*>(tile + (cg_ * 8 + k) * TLD + tg * 8) = pk;
    }
    __syncthreads();
    int part = c0 >> 10, d0 = c0 & 1023;
    u16* dst = part == 0 ? x1cm : (part == 1 ? x2cm : vcm);
    int b = tok0 >> 12, lt0 = tok0 & 4095;
#pragma unroll
    for (int i = 0; i < 8; ++i) {
      int q = tid + i * 256, c = q >> 5, chunk = q & 31;
      uint4 v = *reinterpret_cast<const uint4*>(tile + c * TLD + chunk * 8);
      *reinterpret_cast<uint4*>(dst + ((size_t)(b * 1024 + d0 + c)) * 4096 + lt0 + chunk * 8) = v;
    }
    __syncthreads();
  }
}

DEV float2 cmul(float2 a, float2 w) { return make_float2(a.x * w.x - a.y * w.y, a.x * w.y + a.y * w.x); }
DEV float2 cmulc(float2 a, float2 w) { return make_float2(a.x * w.x + a.y * w.y, a.y * w.x - a.x * w.y); }
__device__ __forceinline__ void fft_fwd(float2* X, const float2* __restrict__ tw) {
  int tid = otid();
  for (int s = 12; s >= 2; s -= 2) {
    const int h = 1 << s, q = h >> 1;
#pragma unroll 2
    for (int i = 0; i < 8; ++i) {
      int gi = tid + i * 256;
      int pos = gi & (q - 1);
      int base = ((gi >> (s - 1)) << (s + 1)) + pos;
      float2 w1 = tw[pos << (12 - s)];
      float2 w2 = tw[pos << (13 - s)];
      float2 a = X[base], bb = X[base + q], c = X[base + h], d = X[base + h + q];
      float2 a1 = make_float2(a.x + c.x, a.y + c.y);
      float2 c1 = cmul(make_float2(a.x - c.x, a.y - c.y), w1);
      float2 b1 = make_float2(bb.x + d.x, bb.y + d.y);
      float2 t = cmul(make_float2(bb.x - d.x, bb.y - d.y), w1);
      float2 d1 = make_float2(t.y, -t.x);
      X[base] = make_float2(a1.x + b1.x, a1.y + b1.y);
      X[base + q] = cmul(make_float2(a1.x - b1.x, a1.y - b1.y), w2);
      X[base + h] = make_float2(c1.x + d1.x, c1.y + d1.y);
      X[base + h + q] = cmul(make_float2(c1.x - d1.x, c1.y - d1.y), w2);
    }
    __syncthreads();
  }
  {
#pragma unroll 4
    for (int i = 0; i < 16; ++i) {
      int j = tid + i * 256;
      float2 a = X[2 * j], bq = X[2 * j + 1];
      X[2 * j] = make_float2(a.x + bq.x, a.y + bq.y);
      X[2 * j + 1] = make_float2(a.x - bq.x, a.y - bq.y);
    }
    __syncthreads();
  }
}
__device__ __forceinline__ void fft_inv(float2* X, const float2* __restrict__ tw) {
  int tid = otid();
  {
#pragma unroll 4
    for (int i = 0; i < 16; ++i) {
      int j = tid + i * 256;
      float2 a = X[2 * j], bq = X[2 * j + 1];
      X[2 * j] = make_float2(a.x + bq.x, a.y + bq.y);
      X[2 * j + 1] = make_float2(a.x - bq.x, a.y - bq.y);
    }
    __syncthreads();
  }
  for (int s = 2; s <= 12; s += 2) {
    const int h = 1 << s, q = h >> 1;
#pragma unroll 2
    for (int i = 0; i < 8; ++i) {
      int gi = tid + i * 256;
      int pos = gi & (q - 1);
      int base = ((gi >> (s - 1)) << (s + 1)) + pos;
      float2 w1 = tw[pos << (12 - s)];
      float2 w2 = tw[pos << (13 - s)];
      float2 a = X[base], bb = X[base + q], c = X[base + h], d = X[base + h + q];
      float2 tb = cmulc(bb, w2), td = cmulc(d, w2);
      float2 a1 = make_float2(a.x + tb.x, a.y + tb.y), b1 = make_float2(a.x - tb.x, a.y - tb.y);
      float2 c1 = make_float2(c.x + td.x, c.y + td.y), d1 = make_float2(c.x - td.x, c.y - td.y);
      float2 tc = cmulc(c1, w1);
      float2 u = cmulc(d1, w1);
      float2 tdd = make_float2(-u.y, u.x);
      X[base] = make_float2(a1.x + tc.x, a1.y + tc.y);
      X[base + h] = make_float2(a1.x - tc.x, a1.y - tc.y);
      X[base + q] = make_float2(b1.x + tdd.x, b1.y + tdd.y);
      X[base + h + q] = make_float2(b1.x - tdd.x, b1.y - tdd.y);
    }
    __syncthreads();
  }
}

__device__ __forceinline__ void phase_filter_fft(const Params& p, float2* Hf, char* lds) {
  float2* X = (float2*)lds;
  float* w3s = (float*)(lds + 65536);
  float* red = w3s + 128;
  const float* hid = (const float*)(p.ws + OFF_HID);
  int tid = otid();
  const float min_decay = -3.0701134573253945f;
  const float max_decay = -15.350567286626973f;
  for (int item = blockIdx.x; item < 2048; item += gridDim.x) {
    int o = item >> 10, d = item & 1023;
    if (tid < 128) {
      int dirr = tid >> 6, j = tid & 63;
      w3s[tid] = p.h_f_w3[(size_t)j * 4096 + (o * 2 + dirr) * 1024 + d];
    }
    __syncthreads();
    float adelta = fabsf(min_decay + (float)d * ((max_decay - min_decay) / 1023.f));
    float ss = 0.f;
#pragma unroll 1
    for (int i = 0; i < 16; ++i) {
      int t = tid + i * 256;
      const float* hr = hid + (size_t)t * 64;
      float hf = 0.f, hb = 0.f;
#pragma unroll
      for (int j4 = 0; j4 < 16; ++j4) {
        float4 hv = *reinterpret_cast<const float4*>(hr + j4 * 4);
        hf += hv.x * w3s[j4 * 4] + hv.y * w3s[j4 * 4 + 1] + hv.z * w3s[j4 * 4 + 2] + hv.w * w3s[j4 * 4 + 3];
        hb += hv.x * w3s[64 + j4 * 4] + hv.y * w3s[64 + j4 * 4 + 1] + hv.z * w3s[64 + j4 * 4 + 2] + hv.w * w3s[64 + j4 * 4 + 3];
      }
      float dec = __expf(-((float)t / 4095.f) * adelta);
      hf *= dec; hb *= dec;
      if (t == 0) {
        float v = hf + hb;
        X[0] = make_float2(v, 0.f);
        X[4096] = make_float2(0.f, 0.f);
        ss += v * v;
      } else {
        X[t] = make_float2(hf, 0.f);
        X[8192 - t] = make_float2(hb, 0.f);
        ss += hf * hf + hb * hb;
      }
    }
    ss = wave_sum(ss);
    if ((tid & 63) == 0) red[tid >> 6] = ss;
    __syncthreads();
    float tot = red[0] + red[1] + red[2] + red[3];
    float scale = rsqrtf(tot + 1e-6f) * (1.f / 8192.f);
    fft_fwd(X, (const float2*)(p.ws + OFF_TW));
    float2* dst = Hf + (size_t)item * 8192;
#pragma unroll 4
    for (int i = 0; i < 32; ++i) {
      int k = tid + i * 256;
      float2 v = X[k];
      dst[k] = make_float2(v.x * scale, v.y * scale);
    }
    __syncthreads();
  }
}

__device__ __forceinline__ void phase_hyena_conv(const Params& p, const u16* x1cm, const u16* x2cm, const u16* vcm, const float2* Hf, u16* zzcm, char* lds) {
  float2* X = (float2*)lds;
  int tid = otid();
  for (int item = blockIdx.x; item < 4096; item += gridDim.x) {
    int d = item >> 2, bp = item & 3;
    size_t r0 = ((size_t)((bp * 2) * 1024 + d)) * 4096, r1 = ((size_t)((bp * 2 + 1) * 1024 + d)) * 4096;
    float bias0 = p.h_bias[d], bias1 = p.h_bias[1024 + d];
#pragma unroll
    for (int i = 0; i < 2; ++i) {
      int t8 = (tid + i * 256) * 8;
      uint4 a = *reinterpret_cast<const uint4*>(vcm + r0 + t8);
      uint4 bq = *reinterpret_cast<const uint4*>(vcm + r1 + t8);
      X[t8 + 0] = make_float2(bflo(a.x), bflo(bq.x)); X[t8 + 1] = make_float2(bfhi(a.x), bfhi(bq.x));
      X[t8 + 2] = make_float2(bflo(a.y), bflo(bq.y)); X[t8 + 3] = make_float2(bfhi(a.y), bfhi(bq.y));
      X[t8 + 4] = make_float2(bflo(a.z), bflo(bq.z)); X[t8 + 5] = make_float2(bfhi(a.z), bfhi(bq.z));
      X[t8 + 6] = make_float2(bflo(a.w), bflo(bq.w)); X[t8 + 7] = make_float2(bfhi(a.w), bfhi(bq.w));
    }
    for (int i = 0; i < 16; ++i) X[4096 + tid + i * 256] = make_float2(0.f, 0.f);
    __syncthreads();
    fft_fwd(X, (const float2*)(p.ws + OFF_TW));
    {
      const float2* H = Hf + (size_t)d * 8192;
#pragma unroll 4
      for (int i = 0; i < 32; ++i) {
        int k = tid + i * 256;
        float2 hv = H[k], xv = X[k];
        X[k] = make_float2(xv.x * hv.x - xv.y * hv.y, xv.x * hv.y + xv.y * hv.x);
      }
    }
    __syncthreads();
    fft_inv(X, (const float2*)(p.ws + OFF_TW));
    float zz0[16], zz1[16];
#pragma unroll
    for (int i = 0; i < 2; ++i) {
      int t8 = (tid + i * 256) * 8;
      uint4 a = *reinterpret_cast<const uint4*>(vcm + r0 + t8);
      uint4 bq = *reinterpret_cast<const uint4*>(vcm + r1 + t8);
      uint4 xa = *reinterpret_cast<const uint4*>(x1cm + r0 + t8);
      uint4 xb = *reinterpret_cast<const uint4*>(x1cm + r1 + t8);
      float va[8] = {bflo(a.x), bfhi(a.x), bflo(a.y), bfhi(a.y), bflo(a.z), bfhi(a.z), bflo(a.w), bfhi(a.w)};
      float vb[8] = {bflo(bq.x), bfhi(bq.x), bflo(bq.y), bfhi(bq.y), bflo(bq.z), bfhi(bq.z), bflo(bq.w), bfhi(bq.w)};
      float fa[8] = {bflo(xa.x), bfhi(xa.x), bflo(xa.y), bfhi(xa.y), bflo(xa.z), bfhi(xa.z), bflo(xa.w), bfhi(xa.w)};
      float fb[8] = {bflo(xb.x), bfhi(xb.x), bflo(xb.y), bfhi(xb.y), bflo(xb.z), bfhi(xb.z), bflo(xb.w), bfhi(xb.w)};
#pragma unroll
      for (int e = 0; e < 8; ++e) {
        float2 cv = X[t8 + e];
        float z0 = fa[e] * (cv.x + va[e] * bias0);
        float z1 = fb[e] * (cv.y + vb[e] * bias0);
        zz0[i * 8 + e] = z0; zz1[i * 8 + e] = z1;
        X[t8 + e] = make_float2(z0, z1);
      }
    }
    for (int i = 0; i < 16; ++i) X[4096 + tid + i * 256] = make_float2(0.f, 0.f);
    __syncthreads();
    fft_fwd(X, (const float2*)(p.ws + OFF_TW));
    {
      const float2* H = Hf + (size_t)(1024 + d) * 8192;
#pragma unroll 4
      for (int i = 0; i < 32; ++i) {
        int k = tid + i * 256;
        float2 hv = H[k], xv = X[k];
        X[k] = make_float2(xv.x * hv.x - xv.y * hv.y, xv.x * hv.y + xv.y * hv.x);
      }
    }
    __syncthreads();
    fft_inv(X, (const float2*)(p.ws + OFF_TW));
#pragma unroll
    for (int i = 0; i < 2; ++i) {
      int t8 = (tid + i * 256) * 8;
      uint4 xa = *reinterpret_cast<const uint4*>(x2cm + r0 + t8);
      uint4 xb = *reinterpret_cast<const uint4*>(x2cm + r1 + t8);
      float fa[8] = {bflo(xa.x), bfhi(xa.x), bflo(xa.y), bfhi(xa.y), bflo(xa.z), bfhi(xa.z), bflo(xa.w), bfhi(xa.w)};
      float fb[8] = {bflo(xb.x), bfhi(xb.x), bflo(xb.y), bfhi(xb.y), bflo(xb.z), bfhi(xb.z), bflo(xb.w), bfhi(xb.w)};
      float o0[8], o1[8];
#pragma unroll
      for (int e = 0; e < 8; ++e) {
        float2 cv = X[t8 + e];
        o0[e] = fa[e] * (cv.x + zz0[i * 8 + e] * bias1);
        o1[e] = fb[e] * (cv.y + zz1[i * 8 + e] * bias1);
      }
      uint4 w0, w1;
      w0.x = pack2(o0[0], o0[1]); w0.y = pack2(o0[2], o0[3]); w0.z = pack2(o0[4], o0[5]); w0.w = pack2(o0[6], o0[7]);
      w1.x = pack2(o1[0], o1[1]); w1.y = pack2(o1[2], o1[3]); w1.z = pack2(o1[4], o1[5]); w1.w = pack2(o1[6], o1[7]);
      *reinterpret_cast<uint4*>(zzcm + r0 + t8) = w0;
      *reinterpret_cast<uint4*>(zzcm + r1 + t8) = w1;
    }
    __syncthreads();
  }
}

__device__ __forceinline__ void phase_transpose_back(const u16* src, u16* dst, char* lds) {
  u16* tile = (u16*)lds;
  int tid = otid();
  for (int item = blockIdx.x; item < 8 * 16 * 64; item += gridDim.x) {
    int b = item >> 10, dt_ = (item >> 6) & 15, tt = item & 63;
#pragma unroll
    for (int i = 0; i < 2; ++i) {
      int q = tid + i * 256, dd = q >> 3, tg = (q & 7) * 8;
      uint4 v = *reinterpret_cast<const uint4*>(src + ((size_t)(b * 1024 + dt_ * 64 + dd)) * 4096 + tt * 64 + tg);
      tile[(tg + 0) * 72 + dd] = (u16)(v.x & 0xffff); tile[(tg + 1) * 72 + dd] = (u16)(v.x >> 16);
      tile[(tg + 2) * 72 + dd] = (u16)(v.y & 0xffff); tile[(tg + 3) * 72 + dd] = (u16)(v.y >> 16);
      tile[(tg + 4) * 72 + dd] = (u16)(v.z & 0xffff); tile[(tg + 5) * 72 + dd] = (u16)(v.z >> 16);
      tile[(tg + 6) * 72 + dd] = (u16)(v.w & 0xffff); tile[(tg + 7) * 72 + dd] = (u16)(v.w >> 16);
    }
    __syncthreads();
#pragma unroll
    for (int i = 0; i < 2; ++i) {
      int q = tid + i * 256, tl = q >> 3, dg = (q & 7) * 8;
      uint4 v = *reinterpret_cast<const uint4*>(tile + tl * 72 + dg);
      *reinterpret_cast<uint4*>(dst + ((size_t)(b * 4096 + tt * 64 + tl)) * 1024 + dt_ * 64 + dg) = v;
    }
    __syncthreads();
  }
}

__device__ __forceinline__ uint4* xb_words_ptr() { __shared__ uint4 xb_words; return &xb_words; }
#define XB_TMO      128
#define XB_XCNT(j)  (256  + 64 * (j))
#define XB_XSUB(j)  (1280 + 64 * (j))
#define XB_XGEN(j)  (2304 + 64 * (j))
#define XB_TOP      3328
#define XB_TOPGEN   3392
#define XCD_BAR_WORDS 3456
#define XB_SPIN_CAP (1u << 18)
#define LAS __attribute__((address_space(3)))

__device__ __forceinline__ unsigned xb_ld(unsigned* p)              { return __hip_atomic_load(p, __ATOMIC_RELAXED, __HIP_MEMORY_SCOPE_AGENT); }
__device__ __forceinline__ unsigned xb_add(unsigned* p, unsigned v) { return __hip_atomic_fetch_add(p, v, __ATOMIC_RELAXED, __HIP_MEMORY_SCOPE_AGENT); }
__device__ __forceinline__ unsigned xb_xcc_id() { return (unsigned)__builtin_amdgcn_s_getreg((3 << 11) | 20) & 0xFu; }
#define XB_SPIN(cond, bar) do { unsigned _sp = 0; while (cond) { __builtin_amdgcn_s_sleep(1); \
    if ((++_sp & 255u) == 0u) { if (xb_ld(&(bar)[XB_TMO])) break; if (_sp > XB_SPIN_CAP) { atomicAdd(&(bar)[XB_TMO], 1u); break; } } } } while (0)

struct XcdBarrier {
    unsigned* bar; unsigned x;
    volatile LAS unsigned* st;
};

__device__ __forceinline__ XcdBarrier xcd_barrier_post(unsigned* bar, volatile LAS unsigned* st) {
    XcdBarrier b; b.bar = bar; b.x = xb_xcc_id(); b.st = st;
    if (threadIdx.x == 0) (void)xb_add(&bar[XB_XCNT(b.x)], 1u);
    return b;
}
__device__ __forceinline__ void xcd_barrier_complete(unsigned* bar, unsigned x, unsigned& nloc, unsigned& nx) {
    const unsigned G = gridDim.x * gridDim.y * gridDim.z;
    unsigned sum, cnt, mine, sp = 0u;
    for (;;) {
        sum = 0u; cnt = 0u; mine = 0u;
#pragma unroll
        for (unsigned j = 0; j < 16; ++j) { const unsigned c = xb_ld(&bar[XB_XCNT(j)]); sum += c; cnt += (c > 0u) ? 1u : 0u; mine = (j == x) ? c : mine; }
        if (sum == G) break;
        __builtin_amdgcn_s_sleep(1);
        if ((++sp & 255u) == 0u) { if (xb_ld(&bar[XB_TMO])) break; if (sp > XB_SPIN_CAP) { atomicAdd(&bar[XB_TMO], 1u); break; } }
    }
    nloc = mine > 0u ? mine : 1u; nx = cnt > 0u ? cnt : 1u;
}

__device__ __forceinline__ void xcd_barrier(const XcdBarrier& b) {
    asm volatile("s_waitcnt vmcnt(0)" ::: "memory");
    __syncthreads();
    if (threadIdx.x == 0) {
        unsigned* bar = b.bar;
        __builtin_amdgcn_s_waitcnt(0);
        unsigned nloc = b.st[0], nx = b.st[1];
        if (nloc == 0u) { xcd_barrier_complete(bar, b.x, nloc, nx); b.st[0] = nloc; b.st[1] = nx; }
        const unsigned old = xb_add(&bar[XB_XSUB(b.x)], 1u);
        const unsigned gen = old / nloc;
        if (old + 1u == (gen + 1u) * nloc) {
            __builtin_amdgcn_fence(__ATOMIC_RELEASE, "agent");
            asm volatile("s_waitcnt vmcnt(0)" ::: "memory");
            const unsigned og = xb_add(&bar[XB_TOP], 1u);
            const unsigned tg = og / nx;
            if (og + 1u == (tg + 1u) * nx) xb_add(&bar[XB_TOPGEN], 1u);
            else XB_SPIN(xb_ld(&bar[XB_TOPGEN]) == tg, bar);
            __builtin_amdgcn_fence(__ATOMIC_ACQUIRE, "agent");
            xb_add(&bar[XB_XGEN(b.x)], 1u);
            asm volatile("s_waitcnt vmcnt(0)" ::: "memory");
        } else {
            XB_SPIN(xb_ld(&bar[XB_XGEN(b.x)]) == gen, bar);
            __builtin_amdgcn_fence(__ATOMIC_ACQUIRE, "agent");
            asm volatile("s_waitcnt vmcnt(0)" ::: "memory");
        }
    }
    __syncthreads();
}


DEV void gsync2(unsigned k) {
  (void)k;
  XcdBarrier b;
  b.bar = (unsigned*)((char*)karg<33>() + OFF_BAR);
  b.x = xb_xcc_id();
  b.st = (volatile LAS unsigned*)xb_words_ptr();
  xcd_barrier(b);
}

DEV void gsync(cg::grid_group& grid) {
  asm volatile("s_waitcnt vmcnt(0)" ::: "memory");
  grid.sync();
  if (threadIdx.x == 0) {
    __builtin_amdgcn_fence(__ATOMIC_ACQUIRE, "agent");
    asm volatile("s_waitcnt vmcnt(0)" ::: "memory");
  }
  __syncthreads();
}

template <int layer>
__device__ __forceinline__ void peer_block(unsigned& nbar, char* lds) {
  {
    Params p = fetch_params();
    char* ws = p.ws; char* R1 = ws + OFF_R1; char* R2 = ws + OFF_R2; char* DO = (char*)p.out;
    const float* modl = (float*)(ws + OFF_MOD) + (size_t)layer * 9 * 6144;
    const u16* A = layer == 0 ? (const u16*)R1 : (const u16*)DO;
    const int K = layer == 0 ? 2048 : 1024;
    const u16* Wt = (const u16*)(ws + (layer == 0 ? OFF_W_OUT : OFF_W_HOUT));
    const float* res = layer == 0 ? p.x : (const float*)R2;
    phase_gemm_resid(A, K, Wt, res, (float*)R2, modl + 2048, lds);
  }
  gsync2(++nbar);
  {
    Params p = fetch_params();
    char* ws = p.ws; char* R1 = ws + OFF_R1; char* R2 = ws + OFF_R2; char* DO = (char*)p.out;
    const float* modl = (float*)(ws + OFF_MOD) + (size_t)layer * 9 * 6144;
    u16* tpeer = layer == 0 ? (u16*)DO : (u16*)(R1 + 128 * MiB);
    phase_ln_mod((float*)R2, p.ln_g + layer * 2048, p.ln_b + layer * 2048, modl, tpeer);
    if (layer == 1) {
      unsigned char* tb = (unsigned char*)R1;
      convert_fp8_rows(p.p_u + (size_t)16384 * 1024, tb, (float*)(tb + 32 * MiB), 16384);
      convert_fp8_rows(p.p_v + (size_t)16384 * 1024, tb + 16 * MiB, (float*)(tb + 32 * MiB + 65536), 16384);
    }
  }
  gsync2(++nbar);
  {
    Params p = fetch_params();
    char* ws = p.ws; char* R1 = ws + OFF_R1; char* DO = (char*)p.out;
    u16* tpeer = layer == 0 ? (u16*)DO : (u16*)(R1 + 128 * MiB);
    phase_gemm_bf16(tpeer, (const u16*)(ws + OFF_W_Q) + (size_t)layer * 2048 * 1024, layer == 0 ? (u16*)R1 : (u16*)DO, 2048, lds);
  }
  gsync2(++nbar);
  {
    Params p = fetch_params();
    char* ws = p.ws; char* R1 = ws + OFF_R1; char* R2 = ws + OFF_R2;
    int* idxb = (int*)(R2 + 128 * MiB);
    float* gateb = (float*)(R2 + 144 * MiB);
    const u16* kbf = (const u16*)(ws + OFF_KEYS);
    phase_peer_topk(layer == 0 ? (const u16*)R1 : (const u16*)p.out, kbf + (size_t)layer * 131072, kbf + 262144 + (size_t)layer * 131072, idxb, gateb, lds);
  }
  gsync2(++nbar);
  {
    Params p = fetch_params();
    char* ws = p.ws; char* R1 = ws + OFF_R1; char* R2 = ws + OFF_R2; char* DO = (char*)p.out;
    float* mod = (float*)(ws + OFF_MOD);
    const float* modl = mod + (size_t)layer * 9 * 6144;
    int* idxb = (int*)(R2 + 128 * MiB);
    float* gateb = (float*)(R2 + 144 * MiB);
    u16* tpeer = layer == 0 ? (u16*)DO : (u16*)(R1 + 128 * MiB);
    const unsigned char* tb8 = (const unsigned char*)(layer == 0 ? ws + OFF_TAB0 : R1);
    phase_peer_gather(tpeer, idxb, gateb, tb8, tb8 + 16 * MiB, (const float*)(tb8 + 32 * MiB), (const float*)(tb8 + 32 * MiB + 65536), (const float*)R2,
                      modl + 5120, p.ln_g + layer * 2048 + 1024, p.ln_b + layer * 2048 + 1024, layer == 0 ? (float*)R2 : p.out,
                      layer == 0 ? mod + 9 * 6144 : nullptr, (u16*)(DO + 64 * MiB));
  }
}

__global__ void __launch_bounds__(256, 2) fwd_megakernel(Params p_unused) {
  __shared__ __attribute__((aligned(16))) char lds[LDS_BYTES];
  cg::grid_group grid = cg::this_grid();
  unsigned nbar = 0;
  if (threadIdx.x == 0) *xb_words_ptr() = make_uint4(0u, 0u, 0u, 0u);
  __syncthreads();
  (void)xcd_barrier_post((unsigned*)((char*)karg<33>() + OFF_BAR), (volatile LAS unsigned*)xb_words_ptr());
  { Params p = fetch_params(); phase_prologue(p, lds); }
  gsync(grid);
  {
    Params p = fetch_params();
    float* mod = (float*)(p.ws + OFF_MOD);
    modulate_rows(p.x, (u16*)(p.ws + OFF_R2), NT, SEQ, mod, 0, 1024, false);
    modulate_rows(p.ctx, (u16*)(p.ws + OFF_HC), NTC, CTXL, mod, 0, 1024, true);
  }
  gsync2(++nbar);
  { Params p = fetch_params(); phase_gemm_inproj(p, lds); }
  gsync2(++nbar);
  { Params p = fetch_params(); phase_conv(p); }
  gsync2(++nbar);
  { Params p = fetch_params(); phase_ssd(p, lds); }
  gsync2(++nbar);
  {
    Params p = fetch_params(); phase_gated_norm(p);
    unsigned char* tb = (unsigned char*)(p.ws + OFF_TAB0);
    convert_fp8_rows(p.p_u, tb, (float*)(tb + 32 * MiB), 16384);
    convert_fp8_rows(p.p_v, tb + 16 * MiB, (float*)(tb + 32 * MiB + 65536), 16384);
  }
  gsync2(++nbar);
  peer_block<0>(nbar, lds);
  gsync2(++nbar);
  {
    Params p = fetch_params();
    phase_gemm_bf16((const u16*)((char*)p.out + 64 * MiB), (const u16*)(p.ws + OFF_W_HIN), (u16*)(p.ws + OFF_R1), 3072, lds);
  }
  gsync2(++nbar);
  {
    Params p = fetch_params();
    phase_shortconv_T(p, (const u16*)(p.ws + OFF_R1), (u16*)(p.ws + OFF_R2 + 128 * MiB), (u16*)p.out, (u16*)((char*)p.out + 64 * MiB), lds);
  }
  gsync2(++nbar);
  { Params p = fetch_params(); phase_filter_fft(p, (float2*)(p.ws + OFF_R1), lds); }
  gsync2(++nbar);
  {
    Params p = fetch_params();
    phase_hyena_conv(p, (const u16*)(p.ws + OFF_R2 + 128 * MiB), (const u16*)p.out, (const u16*)((char*)p.out + 64 * MiB),
                     (const float2*)(p.ws + OFF_R1), (u16*)(p.ws + OFF_R1 + 128 * MiB), lds);
  }
  gsync2(++nbar);
  { Params p = fetch_params(); phase_transpose_back((const u16*)(p.ws + OFF_R1 + 128 * MiB), (u16*)p.out, lds); }
  gsync2(++nbar);
  peer_block<1>(nbar, lds);
}

extern "C" void kernel_launch(void* const* d_in, const int* in_sizes, int n_in, void* d_out, int out_size, void* d_ws, size_t ws_size,
                              hipStream_t stream) {
  static int grid_blocks = 0;
  if (!grid_blocks) {
    int dev = 0, cus = 0, per_cu = 0;
    hipGetDevice(&dev);
    hipDeviceGetAttribute(&cus, hipDeviceAttributeMultiprocessorCount, dev);
    hipOccupancyMaxActiveBlocksPerMultiprocessor(&per_cu, fwd_megakernel, 256, 0);
    if (per_cu > 2) per_cu = 2;
    if (per_cu < 1) per_cu = 1;
    grid_blocks = cus * per_cu;
  }
  Params p{};
  const float** pp = reinterpret_cast<const float**>(&p);
  for (int i = 0; i < 32; ++i) pp[i] = (const float*)d_in[i];
  p.out = (float*)d_out;
  p.ws = (char*)d_ws;
  if (ws_size < WS_TOTAL) fprintf(stderr, "workspace too small: %zu < %zu\n", ws_size, (size_t)WS_TOTAL);
  (void)hipMemsetAsync((char*)d_ws + OFF_BAR, 0, 16384, stream);
  void* args[] = {&p};
  hipError_t e = hipLaunchCooperativeKernel((void*)fwd_megakernel, dim3(grid_blocks), dim3(256), args, 0, stream);
  if (e != hipSuccess) fprintf(stderr, "cooperative launch failed: %s (grid %d)\n", hipGetErrorString(e), grid_blocks);
}
```

```cpp
#include <hip/hip_runtime.h>
#include <hip/hip_bf16.h>
#include <hip/hip_cooperative_groups.h>
#include <cstdio>
namespace cg = cooperative_groups;

typedef unsigned short u16;
using bf16x8 = __attribute__((ext_vector_type(8))) short;
using f32x4 = __attribute__((ext_vector_type(4))) float;
using u32x4 = __attribute__((ext_vector_type(4))) unsigned;
typedef float f32x2 __attribute__((ext_vector_type(2)));

#define DEV __device__ __forceinline__

constexpr int NB = 8, SEQ = 4096, DM = 1024, NT = NB * SEQ;
constexpr int CTXL = 256, NTC = NB * CTXL;
constexpr int SSM_IN = 5184, CONVD = 3072, SSM_INNER = 2048;
constexpr float ALPHA = 1.41421356237f;
constexpr int LDS_BYTES = 71168;

constexpr size_t MiB = 1ull << 20;
constexpr size_t OFF_W_IN = 0;
constexpr size_t OFF_W_OUT = OFF_W_IN + (size_t)5184 * 1024 * 2;
constexpr size_t OFF_W_HIN = OFF_W_OUT + (size_t)1024 * 2048 * 2;
constexpr size_t OFF_W_HOUT = OFF_W_HIN + (size_t)3072 * 1024 * 2;
constexpr size_t OFF_W_Q = OFF_W_HOUT + (size_t)1024 * 1024 * 2;
constexpr size_t OFF_MOD = OFF_W_Q + (size_t)2 * 2048 * 1024 * 2;
constexpr size_t OFF_HID = OFF_MOD + 512 * 1024;
constexpr size_t OFF_DT = OFF_HID + MiB;
constexpr size_t OFF_HC = OFF_DT + 8 * MiB;
constexpr size_t OFF_XBC_C = OFF_HC + 4 * MiB;
constexpr size_t OFF_XC_C = OFF_XBC_C + 12 * MiB;
constexpr size_t OFF_DT_C = OFF_XC_C + 12 * MiB;
constexpr size_t OFF_R1 = OFF_DT_C + MiB;
constexpr size_t OFF_R2 = OFF_R1 + 192 * MiB;
constexpr size_t OFF_BAR = OFF_R2 + 192 * MiB;
constexpr size_t OFF_KEYS = OFF_BAR + 16384;
constexpr size_t OFF_TW = OFF_KEYS + MiB;
constexpr size_t OFF_TAB0 = OFF_TW + 32768;
constexpr size_t WS_TOTAL = OFF_TAB0 + 33 * MiB;

struct Params {
  const float *x, *c, *ctx, *c_ctx, *ada_w, *ada_b, *ln_g, *ln_b;
  const float *m_w_in, *m_conv_w, *m_conv_b, *m_a_log, *m_dt_bias, *m_d, *m_norm_w, *m_w_out;
  const float *h_w_in, *h_conv_w, *h_conv_b, *h_f_w1, *h_f_b1, *h_f_w2, *h_f_b2, *h_f_w3, *h_freq, *h_bias, *h_w_out;
  const float *p_wq, *p_k1, *p_k2, *p_u, *p_v;
  float* out;
  char* ws;
};

typedef __bf16 bf16x2_t __attribute__((ext_vector_type(2)));
typedef float f32x2_ __attribute__((ext_vector_type(2)));
DEV u16 f2bf(float f) { __bf16 v = (__bf16)f; return __builtin_bit_cast(u16, v); }
DEV float bf2f(u16 h) { return __uint_as_float(((unsigned)h) << 16); }
DEV float bflo(unsigned w) { return __uint_as_float(w << 16); }
DEV float bfhi(unsigned w) { return __uint_as_float(w & 0xffff0000u); }
DEV unsigned pack2(float a, float b) { bf16x2_t v = __builtin_convertvector(f32x2_{a, b}, bf16x2_t); return __builtin_bit_cast(unsigned, v); }
DEV float wave_sum(float v) {
#pragma unroll
  for (int o = 32; o > 0; o >>= 1) v += __shfl_xor(v, o);
  return v;
}
DEV int otid() { int t = threadIdx.x; asm volatile("" : "+v"(t)); return t; }
DEV unsigned ordkey(float f) { unsigned u = __float_as_uint(f); return (u & 0x80000000u) ? ~u : (u | 0x80000000u); }
DEV float siluf(float v) { return v / (1.f + __expf(-v)); }
DEV f32x4 mfma16(bf16x8 a, bf16x8 b, f32x4 c) { return __builtin_amdgcn_mfma_f32_16x16x32_bf16(a, b, c, 0, 0, 0); }
DEV bf16x8 ld8(const u16* p) { return *reinterpret_cast<const bf16x8*>(p); }

template <int I>
DEV const float* karg() {
  unsigned long long v;
  asm volatile("s_load_dwordx2 %0, %1, %2\n\ts_waitcnt lgkmcnt(0)" : "=s"(v) : "s"(__builtin_amdgcn_kernarg_segment_ptr()), "n"(I * 8));
  return (const float*)(const __attribute__((address_space(1))) float*)v;
}
DEV Params fetch_params() {
  Params q;
  q.x = karg<0>(); q.c = karg<1>(); q.ctx = karg<2>(); q.c_ctx = karg<3>(); q.ada_w = karg<4>(); q.ada_b = karg<5>(); q.ln_g = karg<6>(); q.ln_b = karg<7>();
  q.m_w_in = karg<8>(); q.m_conv_w = karg<9>(); q.m_conv_b = karg<10>(); q.m_a_log = karg<11>(); q.m_dt_bias = karg<12>(); q.m_d = karg<13>();
  q.m_norm_w = karg<14>(); q.m_w_out = karg<15>();
  q.h_w_in = karg<16>(); q.h_conv_w = karg<17>(); q.h_conv_b = karg<18>(); q.h_f_w1 = karg<19>(); q.h_f_b1 = karg<20>(); q.h_f_w2 = karg<21>();
  q.h_f_b2 = karg<22>(); q.h_f_w3 = karg<23>(); q.h_freq = karg<24>(); q.h_bias = karg<25>(); q.h_w_out = karg<26>();
  q.p_wq = karg<27>(); q.p_k1 = karg<28>(); q.p_k2 = karg<29>(); q.p_u = karg<30>(); q.p_v = karg<31>();
  q.out = (float*)karg<32>(); q.ws = (char*)karg<33>();
  return q;
}

__device__ __forceinline__ void transpose_w_tile(const float* src, int srcld, int K, int N, u16* dst, int item, char* lds) {
  float* tile = (float*)lds;
  int ntn = N / 64;
  int kt = item / ntn, nt = item % ntn;
  int tid = otid();
#pragma unroll
  for (int i = 0; i < 4; ++i) {
    int r = (tid >> 4) + i * 16, c4 = (tid & 15) * 4;
    float4 v = *reinterpret_cast<const float4*>(src + (size_t)(kt * 64 + r) * srcld + nt * 64 + c4);
    tile[r * 65 + c4 + 0] = v.x; tile[r * 65 + c4 + 1] = v.y; tile[r * 65 + c4 + 2] = v.z; tile[r * 65 + c4 + 3] = v.w;
  }
  __syncthreads();
#pragma unroll
  for (int i = 0; i < 2; ++i) {
    int n = (tid >> 3) + i * 32, k8 = (tid & 7) * 8;
    uint4 o;
    o.x = pack2(tile[(k8 + 0) * 65 + n], tile[(k8 + 1) * 65 + n]);
    o.y = pack2(tile[(k8 + 2) * 65 + n], tile[(k8 + 3) * 65 + n]);
    o.z = pack2(tile[(k8 + 4) * 65 + n], tile[(k8 + 5) * 65 + n]);
    o.w = pack2(tile[(k8 + 6) * 65 + n], tile[(k8 + 7) * 65 + n]);
    *reinterpret_cast<uint4*>(dst + (size_t)(nt * 64 + n) * K + kt * 64 + k8) = o;
  }
  __syncthreads();
}

__device__ __forceinline__ void ada_item(const Params& p, int item, char* lds) {
  float* sl = (float*)lds;
  float* red = sl + 9 * 1024;
  int layer = item / 96, cg_ = item % 96;
  int tid = otid(), kq = tid >> 6, col = cg_ * 64 + (tid & 63);
  for (int e = tid; e < 9 * 1024; e += 256) {
    int r = e >> 10, k = e & 1023;
    sl[e] = siluf(r < 8 ? p.c[r * 1024 + k] : p.c_ctx[k]);
  }
  __syncthreads();
  float acc[9];
#pragma unroll
  for (int r = 0; r < 9; ++r) acc[r] = 0.f;
  const float* w = p.ada_w + (size_t)layer * 1024 * 6144 + col;
#pragma unroll 8
  for (int k = kq * 256; k < kq * 256 + 256; ++k) {
    float wv = w[(size_t)k * 6144];
#pragma unroll
    for (int r = 0; r < 9; ++r) acc[r] += sl[r * 1024 + k] * wv;
  }
#pragma unroll
  for (int r = 0; r < 9; ++r) red[(kq * 9 + r) * 64 + (tid & 63)] = acc[r];
  __syncthreads();
  if (tid < 64) {
    float* mod = (float*)(p.ws + OFF_MOD);
    float bias = p.ada_b[layer * 6144 + col];
#pragma unroll
    for (int r = 0; r < 9; ++r) {
      float s = red[(0 * 9 + r) * 64 + tid] + red[(1 * 9 + r) * 64 + tid] + red[(2 * 9 + r) * 64 + tid] + red[(3 * 9 + r) * 64 + tid];
      mod[((size_t)layer * 9 + r) * 6144 + col] = s + bias;
    }
  }
  __syncthreads();
}

__device__ __forceinline__ void hyena_mlp_item(const Params& p, int item, char* lds) {
  float* zb = (float*)lds;
  float* h1 = zb + 256;
  float* h2 = h1 + 256;
  int tid = otid(), ti = tid >> 6, j = tid & 63;
  int t = item * 4 + ti;
  const float L = 4096.f;
  if (j < 33) {
    float v;
    if (j == 0) v = (float)t / 4095.f;
    else {
      int k = (j - 1) & 15;
      float fb = 1e-4f + (float)k * ((15.f - 1e-4f) / 15.f);
      float ang = 6.283185307179586f * (float)t / L;
      float a = fb * ang;
      v = (j <= 16) ? cosf(a) : -sinf(a);
    }
    zb[ti * 64 + j] = v;
  }
  __syncthreads();
  float fr = p.h_freq[j];
  float s = p.h_f_b1[j];
#pragma unroll 3
  for (int i = 0; i < 33; ++i) s += zb[ti * 64 + i] * p.h_f_w1[i * 64 + j];
  h1[ti * 64 + j] = sinf(fr * s);
  __syncthreads();
  s = p.h_f_b2[j];
#pragma unroll 8
  for (int i = 0; i < 64; ++i) s += h1[ti * 64 + i] * p.h_f_w2[i * 64 + j];
  h2[ti * 64 + j] = sinf(fr * s);
  __syncthreads();
  s = p.h_f_b2[64 + j];
#pragma unroll 8
  for (int i = 0; i < 64; ++i) s += h2[ti * 64 + i] * p.h_f_w2[4096 + i * 64 + j];
  float* hid = (float*)(p.ws + OFF_HID);
  hid[t * 64 + j] = sinf(fr * s);
  __syncthreads();
}

__device__ __forceinline__ void phase_prologue(const Params& p, char* lds) {
  constexpr int T0 = 1296, T1 = T0 + 512, T2 = T1 + 768, T3 = T2 + 256, T4 = T3 + 512, T5 = T4 + 512, T6 = T5 + 192, T7 = T6 + 1024, T8 = T7 + 256, T9 = T8 + 16;
  for (int item = blockIdx.x; item < T9; item += gridDim.x) {
    if (item < T0) transpose_w_tile(p.m_w_in, SSM_IN, 1024, SSM_IN, (u16*)(p.ws + OFF_W_IN), item, lds);
    else if (item < T1) transpose_w_tile(p.m_w_out, 1024, 2048, 1024, (u16*)(p.ws + OFF_W_OUT), item - T0, lds);
    else if (item < T2) transpose_w_tile(p.h_w_in, 3072, 1024, 3072, (u16*)(p.ws + OFF_W_HIN), item - T1, lds);
    else if (item < T3) transpose_w_tile(p.h_w_out, 1024, 1024, 1024, (u16*)(p.ws + OFF_W_HOUT), item - T2, lds);
    else if (item < T4) transpose_w_tile(p.p_wq, 2048, 1024, 2048, (u16*)(p.ws + OFF_W_Q), item - T3, lds);
    else if (item < T5) transpose_w_tile(p.p_wq + (size_t)1024 * 2048, 2048, 1024, 2048, (u16*)(p.ws + OFF_W_Q) + (size_t)2048 * 1024, item - T4, lds);
    else if (item < T6) ada_item(p, item - T5, lds);
    else if (item < T7) hyena_mlp_item(p, item - T6, lds);
    else if (item >= T8) {
      int k = (item - T8) * 256 + threadIdx.x;
      float sn, cs;
      sincospif((float)k * (1.f / 4096.f), &sn, &cs);
      ((float2*)(p.ws + OFF_TW))[k] = make_float2(cs, -sn);
    } else {
      int e8 = ((item - T7) * 256 + threadIdx.x) * 8;
      const float* src = e8 < 262144 ? p.p_k1 + e8 : p.p_k2 + (e8 - 262144);
      float4 a0 = *reinterpret_cast<const float4*>(src), a1 = *reinterpret_cast<const float4*>(src + 4);
      uint4 o;
      o.x = pack2(a0.x, a0.y); o.y = pack2(a0.z, a0.w); o.z = pack2(a1.x, a1.y); o.w = pack2(a1.z, a1.w);
      *reinterpret_cast<uint4*>((u16*)(p.ws + OFF_KEYS) + e8) = o;
    }
  }
}

__device__ __forceinline__ void modulate_rows(const float* src, u16* dst, int nrows, int rows_per_batch, const float* modbase, int sh_off, int sc_off, bool ctxrow) {
  size_t total = (size_t)nrows * 128;
  for (size_t e = (size_t)blockIdx.x * 256 + threadIdx.x; e < total; e += (size_t)gridDim.x * 256) {
    int row = (int)(e >> 7), c8 = (int)(e & 127) * 8;
    int b = ctxrow ? 8 : row / rows_per_batch;
    const float* m = modbase + (size_t)b * 6144;
    float4 a0 = *reinterpret_cast<const float4*>(src + (size_t)row * 1024 + c8);
    float4 a1 = *reinterpret_cast<const float4*>(src + (size_t)row * 1024 + c8 + 4);
    float4 s0 = *reinterpret_cast<const float4*>(m + sc_off + c8);
    float4 s1 = *reinterpret_cast<const float4*>(m + sc_off + c8 + 4);
    float4 h0 = *reinterpret_cast<const float4*>(m + sh_off + c8);
    float4 h1 = *reinterpret_cast<const float4*>(m + sh_off + c8 + 4);
    uint4 o;
    o.x = pack2(a0.x * (1.f + s0.x) + h0.x, a0.y * (1.f + s0.y) + h0.y);
    o.y = pack2(a0.z * (1.f + s0.z) + h0.z, a0.w * (1.f + s0.w) + h0.w);
    o.z = pack2(a1.x * (1.f + s1.x) + h1.x, a1.y * (1.f + s1.y) + h1.y);
    o.w = pack2(a1.z * (1.f + s1.z) + h1.z, a1.w * (1.f + s1.w) + h1.w);
    *reinterpret_cast<uint4*>(dst + (size_t)row * 1024 + c8) = o;
  }
}

constexpr int GLD = 72;
template <class Epi>
__device__ __forceinline__ void gemm_tile(const u16* __restrict__ A, int lda, const u16* __restrict__ Bt, int ldb, int brow, int bcol, int Nmax,
                                          int K, char* lds, Epi epi) {
  u16* SA = (u16*)lds;
  u16* SB = SA + 256 * GLD;
  int tid = otid(), wid = tid >> 6, lane = tid & 63, wr = wid >> 1, wc = wid & 1, fr = lane & 15, fq = lane >> 4;
  f32x4 acc[8][4];
#pragma unroll
  for (int m = 0; m < 8; ++m)
#pragma unroll
    for (int n = 0; n < 4; ++n) acc[m][n] = f32x4{0.f, 0.f, 0.f, 0.f};
  u32x4 ra[8], rb[4];
  const int lr = tid >> 3, lc = (tid & 7) * 8;
  const u16* abase = A + (size_t)brow * lda;
  const unsigned aoff = (unsigned)(lr * lda + lc);
  unsigned bo[4];
#pragma unroll
  for (int i = 0; i < 4; ++i) {
    int br = bcol + lr + i * 32;
    if (br >= Nmax) br = Nmax - 1;
    bo[i] = (unsigned)(br * ldb + lc);
  }
#define GLOADT(KT)                                                                                 \
  _Pragma("unroll") for (int i = 0; i < 8; ++i)                                                    \
    ra[i] = *reinterpret_cast<const u32x4*>(abase + (aoff + (unsigned)((i * 32) * lda + (KT) * 64))); \
  _Pragma("unroll") for (int i = 0; i < 4; ++i)                                                    \
    rb[i] = *reinterpret_cast<const u32x4*>(Bt + (bo[i] + (unsigned)((KT) * 64)));
  const int nk = K / 64;
  GLOADT(0)
  for (int kt = 0; kt < nk; ++kt) {
#pragma unroll
    for (int i = 0; i < 8; ++i) *reinterpret_cast<u32x4*>(SA + (lr + i * 32) * GLD + lc) = ra[i];
#pragma unroll
    for (int i = 0; i < 4; ++i) *reinterpret_cast<u32x4*>(SB + (lr + i * 32) * GLD + lc) = rb[i];
    __syncthreads();
    { const int kn = kt + 1 < nk ? kt + 1 : nk - 1; GLOADT(kn) }
#pragma unroll
    for (int kk = 0; kk < 2; ++kk) {
      bf16x8 Bl[4];
#pragma unroll
      for (int n = 0; n < 4; ++n) Bl[n] = ld8(SB + (wc * 64 + n * 16 + fr) * GLD + kk * 32 + fq * 8);
#pragma unroll
      for (int mh = 0; mh < 2; ++mh) {
        bf16x8 At[4];
#pragma unroll
        for (int m = 0; m < 4; ++m) At[m] = ld8(SA + (wr * 128 + (mh * 4 + m) * 16 + fr) * GLD + kk * 32 + fq * 8);
#pragma unroll
        for (int m = 0; m < 4; ++m)
#pragma unroll
          for (int n = 0; n < 4; ++n) acc[mh * 4 + m][n] = mfma16(Bl[n], At[m], acc[mh * 4 + m][n]);
      }
    }
    __syncthreads();
  }
#undef GLOADT
#pragma unroll
  for (int m = 0; m < 8; ++m)
#pragma unroll
    for (int n = 0; n < 4; ++n) epi(brow + wr * 128 + m * 16 + fr, bcol + wc * 64 + n * 16 + fq * 4, acc[m][n]);
}

DEV float softplusf(float v) { return fmaxf(v, 0.f) + log1pf(__expf(-fabsf(v))); }

__device__ __forceinline__ void phase_gemm_inproj(const Params& p, char* lds) {
  const u16* hx = (const u16*)(p.ws + OFF_R2);
  const u16* hc = (const u16*)(p.ws + OFF_HC);
  const u16* Wt = (const u16*)(p.ws + OFF_W_IN);
  u16* zbuf = (u16*)p.out;
  u16* xbc = (u16*)(p.ws + OFF_R1);
  float* dt = (float*)(p.ws + OFF_DT);
  u16* xbc_c = (u16*)(p.ws + OFF_XBC_C);
  float* dt_c = (float*)(p.ws + OFF_DT_C);
  const float* dtb = p.m_dt_bias;
  const int xcd = blockIdx.x & 7, li = blockIdx.x >> 3, nl = gridDim.x >> 3;
  auto epi_lat = [=](int m, int n, f32x4 v) {
    if (n < 2048) *reinterpret_cast<uint2*>(zbuf + (size_t)m * 2048 + n) = make_uint2(pack2(v[0], v[1]), pack2(v[2], v[3]));
    else if (n < 5120) *reinterpret_cast<uint2*>(xbc + (size_t)m * 3072 + (n - 2048)) = make_uint2(pack2(v[0], v[1]), pack2(v[2], v[3]));
    else if (n < 5184) {
      float4 bb = *reinterpret_cast<const float4*>(dtb + (n - 5120));
      *reinterpret_cast<float4*>(dt + (size_t)m * 64 + (n - 5120)) = make_float4(softplusf(v[0] + bb.x), softplusf(v[1] + bb.y), softplusf(v[2] + bb.z), softplusf(v[3] + bb.w));
    }
  };
  auto epi_ctx = [=](int m, int n, f32x4 v) {
    if (n < 3072) *reinterpret_cast<uint2*>(xbc_c + (size_t)m * 3072 + n) = make_uint2(pack2(v[0], v[1]), pack2(v[2], v[3]));
    else if (n < 3136) {
      float4 bb = *reinterpret_cast<const float4*>(dtb + (n - 3072));
      *reinterpret_cast<float4*>(dt_c + (size_t)m * 64 + (n - 3072)) = make_float4(softplusf(v[0] + bb.x), softplusf(v[1] + bb.y), softplusf(v[2] + bb.z), softplusf(v[3] + bb.w));
    }
  };
  for (int t = li; t < 128 * 5; t += nl) {
    int pm = t / 5, pn = xcd + 8 * (t % 5);
    gemm_tile(hx, 1024, Wt, 1024, pm * 256, pn * 128, SSM_IN, 1024, lds, epi_lat);
  }
  for (int t = blockIdx.x; t < 128 + 8 * 25; t += gridDim.x) {
    if (t < 128) gemm_tile(hx, 1024, Wt, 1024, t * 256, 40 * 128, SSM_IN, 1024, lds, epi_lat);
    else {
      int it = t - 128, pm = it / 25, pn = it % 25;
      gemm_tile(hc, 1024, Wt + (size_t)2048 * 1024, 1024, pm * 256, pn * 128, 3136, 1024, lds, epi_ctx);
    }
  }
}

DEV void fma8(float* acc, const u32x4& v, const float* w) {
  acc[0] += bflo(v[0]) * w[0]; acc[1] += bfhi(v[0]) * w[1]; acc[2] += bflo(v[1]) * w[2]; acc[3] += bfhi(v[1]) * w[3];
  acc[4] += bflo(v[2]) * w[4]; acc[5] += bfhi(v[2]) * w[5]; acc[6] += bflo(v[3]) * w[6]; acc[7] += bfhi(v[3]) * w[7];
}
__device__ __forceinline__ void phase_conv(const Params& p) {
  const u16* xbc = (const u16*)(p.ws + OFF_R1);
  u16* xc = (u16*)(p.ws + OFF_R2);
  const u16* xbc_c = (const u16*)(p.ws + OFF_XBC_C);
  u16* xc_c = (u16*)(p.ws + OFF_XC_C);
  const float* cw = p.m_conv_w;
  const float* cb = p.m_conv_b;
  const int tid_ = otid();
  const size_t nl = (size_t)8 * 64 * 8 * 384;
  for (size_t e = (size_t)blockIdx.x * 256 + tid_; e < nl; e += (size_t)gridDim.x * 256) {
    int ch = (int)(e % 384) * 8;
    int rest = (int)(e / 384);
    int cg_ = rest & 7, r = (rest >> 3) & 63, b = rest >> 9;
    float w[9][8];
#pragma unroll
    for (int k = 0; k < 9; ++k) {
      float4 w0 = *reinterpret_cast<const float4*>(cw + k * 3072 + ch), w1 = *reinterpret_cast<const float4*>(cw + k * 3072 + ch + 4);
      w[k][0] = w0.x; w[k][1] = w0.y; w[k][2] = w0.z; w[k][3] = w0.w; w[k][4] = w1.x; w[k][5] = w1.y; w[k][6] = w1.z; w[k][7] = w1.w;
    }
    float bias[8];
    {
      float4 b0 = *reinterpret_cast<const float4*>(cb + ch), b1 = *reinterpret_cast<const float4*>(cb + ch + 4);
      bias[0] = b0.x; bias[1] = b0.y; bias[2] = b0.z; bias[3] = b0.w; bias[4] = b1.x; bias[5] = b1.y; bias[6] = b1.z; bias[7] = b1.w;
    }
    const u32x4 zero4 = u32x4{0u, 0u, 0u, 0u};
    const int c0 = cg_ * 8;
    u32x4 win[3][3];
#pragma unroll
    for (int i = 0; i < 3; ++i) {
      int rr = r + i - 1;
      bool rok = rr >= 0 && rr <= 63;
      const u16* rowp = xbc + ((size_t)(b * 4096 + (rok ? rr : r) * 64)) * 3072 + ch;
      win[i][0] = (rok && c0 > 0) ? *reinterpret_cast<const u32x4*>(rowp + (size_t)(c0 - 1) * 3072) : zero4;
      win[i][1] = rok ? *reinterpret_cast<const u32x4*>(rowp + (size_t)c0 * 3072) : zero4;
    }
#pragma unroll
    for (int cc = 0; cc < 8; ++cc) {
      int c = c0 + cc;
#pragma unroll
      for (int i = 0; i < 3; ++i) {
        int rr = r + i - 1;
        bool rok = rr >= 0 && rr <= 63;
        const u16* rowp = xbc + ((size_t)(b * 4096 + (rok ? rr : r) * 64)) * 3072 + ch;
        win[i][2] = (rok && c < 63) ? *reinterpret_cast<const u32x4*>(rowp + (size_t)(c + 1) * 3072) : zero4;
      }
      float acc[8];
#pragma unroll
      for (int k = 0; k < 8; ++k) acc[k] = bias[k];
#pragma unroll
      for (int i = 0; i < 3; ++i)
#pragma unroll
        for (int j = 0; j < 3; ++j) fma8(acc, win[i][j], w[i * 3 + j]);
      uint4 o;
      o.x = pack2(siluf(acc[0]), siluf(acc[1]));
      o.y = pack2(siluf(acc[2]), siluf(acc[3]));
      o.z = pack2(siluf(acc[4]), siluf(acc[5]));
      o.w = pack2(siluf(acc[6]), siluf(acc[7]));
      *reinterpret_cast<uint4*>(xc + ((size_t)(b * 4096 + r * 64 + c)) * 3072 + ch) = o;
#pragma unroll
      for (int i = 0; i < 3; ++i) { win[i][0] = win[i][1]; win[i][1] = win[i][2]; }
    }
  }
  const size_t ncx = (size_t)NTC * 384;
  for (size_t e = (size_t)blockIdx.x * 256 + tid_; e < ncx; e += (size_t)gridDim.x * 256) {
    int tok = (int)(e / 384), ch = (int)(e % 384) * 8;
    float acc[8];
#pragma unroll
    for (int k = 0; k < 8; ++k) acc[k] = cb[ch + k];
    int b = tok >> 8, c = tok & 255;
#pragma unroll
    for (int j = 0; j < 3; ++j) {
      int cc = c + j - 1;
      if (cc < 0 || cc > 255) continue;
      uint4 v = *reinterpret_cast<const uint4*>(xbc_c + ((size_t)(b * 256 + cc)) * 3072 + ch);
      const float* w = cw + (3 + j) * 3072 + ch;
      float4 w0 = *reinterpret_cast<const float4*>(w), w1 = *reinterpret_cast<const float4*>(w + 4);
      acc[0] += bflo(v.x) * w0.x; acc[1] += bfhi(v.x) * w0.y; acc[2] += bflo(v.y) * w0.z; acc[3] += bfhi(v.y) * w0.w;
      acc[4] += bflo(v.z) * w1.x; acc[5] += bfhi(v.z) * w1.y; acc[6] += bflo(v.w) * w1.z; acc[7] += bfhi(v.w) * w1.w;
    }
    uint4 o;
    o.x = pack2(siluf(acc[0]), siluf(acc[1]));
    o.y = pack2(siluf(acc[2]), siluf(acc[3]));
    o.z = pack2(siluf(acc[4]), siluf(acc[5]));
    o.w = pack2(siluf(acc[6]), siluf(acc[7]));
    *reinterpret_cast<uint4*>(xc_c + (size_t)tok * 3072 + ch) = o;
  }
}

constexpr int SLD = 136;
__device__ __forceinline__ void phase_ssd(const Params& p, char* lds) {
  u16* xsT = (u16*)lds;
  u16* stb = xsT + 64 * SLD;
  u16* Mb = stb + 64 * SLD;
  float* cum = (float*)(Mb + 128 * SLD);
  float* dtv = cum + 128;
  float* asrc = dtv + 128;
  const u16* xc = (const u16*)(p.ws + OFF_R2);
  const u16* xc_c = (const u16*)(p.ws + OFF_XC_C);
  const float* dt = (const float*)(p.ws + OFF_DT);
  const float* dt_c = (const float*)(p.ws + OFF_DT_C);
  u16* y = (u16*)(p.ws + OFF_R1);
  int tid = otid(), w = tid >> 6, lane = tid & 63, fr = lane & 15, fq = lane >> 4;
  unsigned char* yb8 = (unsigned char*)(p.ws + OFF_R1 + 128 * MiB);
  for (int item = blockIdx.x; item < 512; item += gridDim.x) {
    int b = item >> 6, h = (item >> 1) & 31, g = h >> 3;
    float dsk = p.m_d[h];
    {
      const int dir = item & 1;
      float a_neg = -__expf(p.m_a_log[dir * 32 + h]);
      f32x4 acc_s[8];
#pragma unroll
      for (int n = 0; n < 8; ++n) acc_s[n] = f32x4{0.f, 0.f, 0.f, 0.f};
      for (int step = 0; step < 34; ++step) {
        bool isctx = step < 2;
        int cidx = isctx ? step : step - 2;
        if (dir) cidx = (isctx ? 1 : 31) - cidx;
        size_t tok0 = isctx ? (size_t)(b * 256 + cidx * 128) : (size_t)(b * 4096 + cidx * 128);
        const u16* src = (isctx ? xc_c : xc) + tok0 * 3072;
        const float* dts = (isctx ? dt_c : dt) + tok0 * 64;
        int tz = tid;
        asm volatile("" : "+v"(tz));
        float dval = 0.f;
        if (tid < 128) dval = dts[tid * 64 + dir * 32 + h];
        uint4 xv[4], bv[8];
#pragma unroll
        for (int i = 0; i < 4; ++i) {
          int idx = tz + i * 256, l = (idx & 31) | ((idx >> 8) << 5), pc = ((idx >> 5) & 7) * 8;
          xv[i] = *reinterpret_cast<const uint4*>(src + (size_t)l * 3072 + h * 64 + pc);
        }
#pragma unroll
        for (int i = 0; i < 8; ++i) {
          int idx = tz + i * 256, l = (idx & 31) | (((idx >> 9) & 3) << 5), nc = (((idx >> 5) & 7) | (((idx >> 8) & 1) << 3)) * 8;
          bv[i] = *reinterpret_cast<const uint4*>(src + (size_t)l * 3072 + 2048 + g * 128 + nc);
        }
        if (tid < 128) { dtv[tid] = dval; asrc[tid] = dval * a_neg; }
#pragma unroll
        for (int i = 0; i < 4; ++i) {
          int idx = tz + i * 256, l = (idx & 31) | ((idx >> 8) << 5), pc = ((idx >> 5) & 7) * 8;
          uint4 v = xv[i];
          xsT[(pc + 0) * SLD + l] = (u16)(v.x & 0xffff); xsT[(pc + 1) * SLD + l] = (u16)(v.x >> 16);
          xsT[(pc + 2) * SLD + l] = (u16)(v.y & 0xffff); xsT[(pc + 3) * SLD + l] = (u16)(v.y >> 16);
          xsT[(pc + 4) * SLD + l] = (u16)(v.z & 0xffff); xsT[(pc + 5) * SLD + l] = (u16)(v.z >> 16);
          xsT[(pc + 6) * SLD + l] = (u16)(v.w & 0xffff); xsT[(pc + 7) * SLD + l] = (u16)(v.w >> 16);
        }
        if (!isctx) {
#pragma unroll
          for (int i = 0; i < 8; ++i) {
            int idx = tz + i * 256, l = (idx & 31) | (((idx >> 9) & 3) << 5), nc = (((idx >> 5) & 7) | (((idx >> 8) & 1) << 3)) * 8;
            *reinterpret_cast<uint4*>(Mb + l * SLD + nc) = bv[i];
          }
        }
        __syncthreads();
        bf16x8 Cf[2][4];
        if (!isctx) {
#pragma unroll
          for (int mt = 0; mt < 2; ++mt)
#pragma unroll
            for (int kk = 0; kk < 4; ++kk) Cf[mt][kk] = ld8(src + (size_t)(w * 32 + mt * 16 + fr) * 3072 + 2560 + g * 128 + kk * 32 + fq * 8);
        }
        if (tid < 128) {
          float s = 0.f;
          if (!dir) { for (int j = 0; j <= tid; ++j) s += asrc[j]; }
          else { for (int j = tid; j < 128; ++j) s += asrc[j]; }
          cum[tid] = s;
        }
        __syncthreads();
        float total = dir ? cum[0] : cum[127];
        if (!isctx) {
          float cl[2][4];
#pragma unroll
          for (int mt = 0; mt < 2; ++mt)
#pragma unroll
            for (int j = 0; j < 4; ++j) cl[mt][j] = cum[w * 32 + mt * 16 + fq * 4 + j];
          f32x4 cb0[8], cb1[8];
#pragma unroll
          for (int nt = 0; nt < 8; ++nt) {
            cb0[nt] = f32x4{0.f, 0.f, 0.f, 0.f};
            cb1[nt] = f32x4{0.f, 0.f, 0.f, 0.f};
            bool need = dir ? (nt >= w * 2) : (nt <= w * 2 + 1);
            if (need) {
#pragma unroll
              for (int kk = 0; kk < 4; ++kk) {
                bf16x8 Bf = ld8(Mb + (nt * 16 + fr) * SLD + kk * 32 + fq * 8);
                cb0[nt] = mfma16(Cf[0][kk], Bf, cb0[nt]);
                cb1[nt] = mfma16(Cf[1][kk], Bf, cb1[nt]);
              }
            }
          }
          __syncthreads();
          int zero = 0;
          asm volatile("" : "+v"(zero));
#pragma unroll
          for (int nt = 0; nt < 8; ++nt) {
            int s = nt * 16 + fr + zero;
            float cs = cum[s], ds = dtv[s];
#pragma unroll
            for (int j = 0; j < 4; ++j) {
              int l0 = w * 32 + fq * 4 + j, l1 = l0 + 16;
              bool ok0 = dir ? (s >= l0) : (s <= l0);
              bool ok1 = dir ? (s >= l1) : (s <= l1);
              float v0 = ok0 ? cb0[nt][j] * __expf(cl[0][j] - cs) * ds : 0.f;
              float v1 = ok1 ? cb1[nt][j] * __expf(cl[1][j] - cs) * ds : 0.f;
              Mb[l0 * SLD + s] = f2bf(v0);
              Mb[l1 * SLD + s] = f2bf(v1);
            }
          }
          __syncthreads();
          f32x4 ya[2][4];
#pragma unroll
          for (int mt = 0; mt < 2; ++mt)
#pragma unroll
            for (int nt = 0; nt < 4; ++nt) ya[mt][nt] = f32x4{0.f, 0.f, 0.f, 0.f};
#pragma unroll
          for (int kk = 0; kk < 4; ++kk)
#pragma unroll
            for (int nt = 0; nt < 4; ++nt) {
              bf16x8 Sf = ld8(stb + (nt * 16 + fr) * SLD + kk * 32 + fq * 8);
              ya[0][nt] = mfma16(Sf, Cf[0][kk], ya[0][nt]);
              ya[1][nt] = mfma16(Sf, Cf[1][kk], ya[1][nt]);
            }
#pragma unroll
          for (int mt = 0; mt < 2; ++mt) {
            float e = __expf(cum[w * 32 + mt * 16 + fr]);
#pragma unroll
            for (int nt = 0; nt < 4; ++nt) ya[mt][nt] *= e;
          }
#pragma unroll
          for (int kk = 0; kk < 4; ++kk) {
            bf16x8 Mf0 = ld8(Mb + (w * 32 + fr) * SLD + kk * 32 + fq * 8);
            bf16x8 Mf1 = ld8(Mb + (w * 32 + 16 + fr) * SLD + kk * 32 + fq * 8);
#pragma unroll
            for (int nt = 0; nt < 4; ++nt) {
              bf16x8 Xf = ld8(xsT + (nt * 16 + fr) * SLD + kk * 32 + fq * 8);
              ya[0][nt] = mfma16(Xf, Mf0, ya[0][nt]);
              ya[1][nt] = mfma16(Xf, Mf1, ya[1][nt]);
            }
          }
#pragma unroll
          for (int i = 0; i < 8; ++i) {
            int idx = tz + i * 256, l = (idx & 31) | (((idx >> 9) & 3) << 5), nc = (((idx >> 5) & 7) | (((idx >> 8) & 1) << 3)) * 8;
            bv[i] = *reinterpret_cast<const uint4*>(src + (size_t)l * 3072 + 2048 + g * 128 + nc);
          }
#pragma unroll
          for (int mt = 0; mt < 2; ++mt)
#pragma unroll
            for (int nt = 0; nt < 4; ++nt) {
              const int l = w * 32 + mt * 16 + fr, p0 = nt * 16 + fq * 4;
              f32x4 v = ya[mt][nt];
              if (!dir) {
                v[0] += bf2f(xsT[(p0 + 0) * SLD + l]) * dsk; v[1] += bf2f(xsT[(p0 + 1) * SLD + l]) * dsk;
                v[2] += bf2f(xsT[(p0 + 2) * SLD + l]) * dsk; v[3] += bf2f(xsT[(p0 + 3) * SLD + l]) * dsk;
                *reinterpret_cast<uint2*>(y + (tok0 + l) * 2048 + h * 64 + p0) = make_uint2(pack2(v[0], v[1]), pack2(v[2], v[3]));
              } else {
                int pk = __builtin_amdgcn_cvt_pk_fp8_f32(fminf(fmaxf(v[0] * 4.f, -440.f), 440.f), fminf(fmaxf(v[1] * 4.f, -440.f), 440.f), 0, false);
                pk = __builtin_amdgcn_cvt_pk_fp8_f32(fminf(fmaxf(v[2] * 4.f, -440.f), 440.f), fminf(fmaxf(v[3] * 4.f, -440.f), 440.f), pk, true);
                *reinterpret_cast<int*>(yb8 + (tok0 + l) * 2048 + h * 64 + p0) = pk;
              }
            }
        }
        if (step == 33) continue;
        __syncthreads();
#pragma unroll
        for (int i = 0; i < 8; ++i) {
          int idx = tz + i * 256, l = (idx & 31) | (((idx >> 9) & 3) << 5), nc = (((idx >> 5) & 7) | (((idx >> 8) & 1) << 3)) * 8;
          uint4 v = bv[i];
          float sc = dtv[l] * __expf(total - cum[l]);
          Mb[(nc + 0) * SLD + l] = f2bf(bflo(v.x) * sc); Mb[(nc + 1) * SLD + l] = f2bf(bfhi(v.x) * sc);
          Mb[(nc + 2) * SLD + l] = f2bf(bflo(v.y) * sc); Mb[(nc + 3) * SLD + l] = f2bf(bfhi(v.y) * sc);
          Mb[(nc + 4) * SLD + l] = f2bf(bflo(v.z) * sc); Mb[(nc + 5) * SLD + l] = f2bf(bfhi(v.z) * sc);
          Mb[(nc + 6) * SLD + l] = f2bf(bflo(v.w) * sc); Mb[(nc + 7) * SLD + l] = f2bf(bfhi(v.w) * sc);
        }
        __syncthreads();
        float cd = __expf(total);
#pragma unroll
        for (int nt = 0; nt < 8; ++nt) acc_s[nt] *= cd;
#pragma unroll
        for (int kk = 0; kk < 4; ++kk) {
          bf16x8 Af = ld8(xsT + (w * 16 + fr) * SLD + kk * 32 + fq * 8);
#pragma unroll
          for (int nt = 0; nt < 8; ++nt) {
            bf16x8 Bf = ld8(Mb + (nt * 16 + fr) * SLD + kk * 32 + fq * 8);
            acc_s[nt] = mfma16(Af, Bf, acc_s[nt]);
          }
        }
#pragma unroll
        for (int nt = 0; nt < 8; ++nt)
#pragma unroll
          for (int j = 0; j < 4; ++j) stb[(w * 16 + fq * 4 + j) * SLD + nt * 16 + fr] = f2bf(acc_s[nt][j]);
        __syncthreads();
      }
      __syncthreads();
    }
  }
}

__device__ __forceinline__ void phase_gated_norm(const Params& p) {
  u16* y = (u16*)(p.ws + OFF_R1);
  const u16* z = (const u16*)p.out;
  const unsigned char* yb8 = (const unsigned char*)(p.ws + OFF_R1 + 128 * MiB);
  const int tid_ = otid();
  int lane = tid_ & 63;
  int wave = blockIdx.x * 4 + (tid_ >> 6), nw = gridDim.x * 4;
  for (int tok = wave; tok < NT; tok += nw) {
#pragma unroll
    for (int g = 0; g < 4; ++g) {
      int ch = g * 512 + lane * 8;
      uint4 yv = *reinterpret_cast<const uint4*>(y + (size_t)tok * 2048 + ch);
      uint4 zv = *reinterpret_cast<const uint4*>(z + (size_t)tok * 2048 + ch);
      uint2 bw = *reinterpret_cast<const uint2*>(yb8 + (size_t)tok * 2048 + ch);
      f32x2 b01 = __builtin_amdgcn_cvt_pk_f32_fp8((int)bw.x, false), b23 = __builtin_amdgcn_cvt_pk_f32_fp8((int)bw.x, true);
      f32x2 b45 = __builtin_amdgcn_cvt_pk_f32_fp8((int)bw.y, false), b67 = __builtin_amdgcn_cvt_pk_f32_fp8((int)bw.y, true);
      const float r16 = 0.25f;
      float u[8];
      u[0] = (bflo(yv.x) + b01.x * r16) * siluf(bflo(zv.x)); u[1] = (bfhi(yv.x) + b01.y * r16) * siluf(bfhi(zv.x));
      u[2] = (bflo(yv.y) + b23.x * r16) * siluf(bflo(zv.y)); u[3] = (bfhi(yv.y) + b23.y * r16) * siluf(bfhi(zv.y));
      u[4] = (bflo(yv.z) + b45.x * r16) * siluf(bflo(zv.z)); u[5] = (bfhi(yv.z) + b45.y * r16) * siluf(bfhi(zv.z));
      u[6] = (bflo(yv.w) + b67.x * r16) * siluf(bflo(zv.w)); u[7] = (bfhi(yv.w) + b67.y * r16) * siluf(bfhi(zv.w));
      float ss = 0.f;
#pragma unroll
      for (int k = 0; k < 8; ++k) ss += u[k] * u[k];
      ss = wave_sum(ss);
      float sc = rsqrtf(ss * (1.f / 512.f) + 1e-5f);
      float4 w0 = *reinterpret_cast<const float4*>(p.m_norm_w + ch), w1 = *reinterpret_cast<const float4*>(p.m_norm_w + ch + 4);
      uint4 o;
      o.x = pack2(u[0] * sc * w0.x, u[1] * sc * w0.y);
      o.y = pack2(u[2] * sc * w0.z, u[3] * sc * w0.w);
      o.z = pack2(u[4] * sc * w1.x, u[5] * sc * w1.y);
      o.w = pack2(u[6] * sc * w1.z, u[7] * sc * w1.w);
      *reinterpret_cast<uint4*>(y + (size_t)tok * 2048 + ch) = o;
    }
  }
}

__device__ __forceinline__ void phase_gemm_resid(const u16* A, int K, const u16* Wt, const float* res, float* dst, const float* gate  , char* lds) {
  const int xcd = blockIdx.x & 7, li = blockIdx.x >> 3, nl = gridDim.x >> 3;
  for (int t = li; t < 128; t += nl) {
    int pm = t, pn = xcd;
    gemm_tile(A, K, Wt, K, pm * 256, pn * 128, 1024, K, lds, [=](int m, int n, f32x4 v) {
      int b = m >> 12;
      float4 r = *reinterpret_cast<const float4*>(res + (size_t)m * 1024 + n);
      float4 g = *reinterpret_cast<const float4*>(gate + (size_t)b * 6144 + n);
      *reinterpret_cast<float4*>(dst + (size_t)m * 1024 + n) = make_float4(ALPHA * r.x + g.x * v[0], ALPHA * r.y + g.y * v[1], ALPHA * r.z + g.z * v[2], ALPHA * r.w + g.w * v[3]);
    });
  }
}
__device__ __forceinline__ void phase_gemm_bf16(const u16* A, const u16* Wt, u16* dst, int N, char* lds) {
  const int xcd = blockIdx.x & 7, li = blockIdx.x >> 3, nl = gridDim.x >> 3;
  const int nb = N / 1024;
  for (int t = li; t < 128 * nb; t += nl) {
    int pm = t / nb, pn = xcd + 8 * (t % nb);
    gemm_tile(A, 1024, Wt, 1024, pm * 256, pn * 128, N, 1024, lds, [=](int m, int n, f32x4 v) { *reinterpret_cast<uint2*>(dst + (size_t)m * N + n) = make_uint2(pack2(v[0], v[1]), pack2(v[2], v[3])); });
  }
}

__device__ __forceinline__ void phase_ln_mod(float* xio, const float* g, const float* bta, const float* mod  , u16* tdst) {
  const int tid_ = otid();
  int lane = tid_ & 63;
  int wave = blockIdx.x * 4 + (tid_ >> 6), nw = gridDim.x * 4;
  for (int tok = wave; tok < NT; tok += nw) {
    int b = tok >> 12;
    float4 v[4];
    float s = 0.f;
#pragma unroll
    for (int i = 0; i < 4; ++i) {
      v[i] = *reinterpret_cast<const float4*>(xio + (size_t)tok * 1024 + i * 256 + lane * 4);
      s += v[i].x + v[i].y + v[i].z + v[i].w;
    }
    float mu = wave_sum(s) * (1.f / 1024.f);
    float q = 0.f;
#pragma unroll
    for (int i = 0; i < 4; ++i) {
      v[i].x -= mu; v[i].y -= mu; v[i].z -= mu; v[i].w -= mu;
      q += v[i].x * v[i].x + v[i].y * v[i].y + v[i].z * v[i].z + v[i].w * v[i].w;
    }
    float rs = rsqrtf(wave_sum(q) * (1.f / 1024.f) + 1e-5f);
    const float* m = mod + (size_t)b * 6144;
#pragma unroll
    for (int i = 0; i < 4; ++i) {
      int c = i * 256 + lane * 4;
      float4 gg = *reinterpret_cast<const float4*>(g + c), bb = *reinterpret_cast<const float4*>(bta + c);
      float4 o;
      o.x = v[i].x * rs * gg.x + bb.x; o.y = v[i].y * rs * gg.y + bb.y; o.z = v[i].z * rs * gg.z + bb.z; o.w = v[i].w * rs * gg.w + bb.w;
      *reinterpret_cast<float4*>(xio + (size_t)tok * 1024 + c) = o;
      float4 sh = *reinterpret_cast<const float4*>(m + 3072 + c), sc = *reinterpret_cast<const float4*>(m + 4096 + c);
      uint2 t;
      t.x = pack2(o.x * (1.f + sc.x) + sh.x, o.y * (1.f + sc.y) + sh.y);
      t.y = pack2(o.z * (1.f + sc.z) + sh.z, o.w * (1.f + sc.w) + sh.w);
      *reinterpret_cast<uint2*>(tdst + (size_t)tok * 1024 + c) = t;
    }
  }
}

__device__ __forceinline__ void phase_peer_topk(const u16* q, const u16* k1, const u16* k2, int* idxo, float* gateo, char* lds) {
  float* S = (float*)lds;
  float* sv = S + 64 * 129;
  int* si = (int*)(sv + 64 * 16);
  int tid = otid(), w = tid >> 6, lane = tid & 63, fr = lane & 15, fq = lane >> 4;
  const int slot = lane;
  const bool cvalid = lane < 50;
  int ci = slot < 42 ? ((slot >= 16) + (slot >= 24) + (slot >= 29) + (slot >= 33) + (slot >= 36) + (slot >= 38) + (slot >= 40)) : slot - 34;
  const unsigned long long PACK = 0ull | (16ull << 8) | (24ull << 16) | (29ull << 24) | (33ull << 32) | (36ull << 40) | (38ull << 48) | (40ull << 56);
  int cj = slot - (ci < 8 ? (int)((PACK >> (8 * ci)) & 0xFF) : 34 + ci);
  if (!cvalid) { ci = 0; cj = 0; }
  for (int item = blockIdx.x; item < 1024 * 8; item += gridDim.x) {
    int tile = item >> 3, h = item & 7;
    int tok0 = tile * 32;
    {
      int half = w >> 1, kb = (w & 1) * 64;
      const u16* kk_ = (half ? k2 : k1) + (size_t)h * 128 * 128;
      bf16x8 Af[2][4], Bf[4][4];
#pragma unroll
      for (int m = 0; m < 2; ++m)
#pragma unroll
        for (int ks = 0; ks < 4; ++ks) Af[m][ks] = ld8(q + (size_t)(tok0 + m * 16 + fr) * 2048 + h * 256 + half * 128 + ks * 32 + fq * 8);
#pragma unroll
      for (int n = 0; n < 4; ++n)
#pragma unroll
        for (int ks = 0; ks < 4; ++ks) Bf[n][ks] = ld8(kk_ + (size_t)(kb + n * 16 + fr) * 128 + ks * 32 + fq * 8);
      f32x4 acc[2][4];
#pragma unroll
      for (int m = 0; m < 2; ++m)
#pragma unroll
        for (int n = 0; n < 4; ++n) acc[m][n] = f32x4{0.f, 0.f, 0.f, 0.f};
#pragma unroll
      for (int ks = 0; ks < 4; ++ks)
#pragma unroll
        for (int n = 0; n < 4; ++n) {
          acc[0][n] = mfma16(Af[0][ks], Bf[n][ks], acc[0][n]);
          acc[1][n] = mfma16(Af[1][ks], Bf[n][ks], acc[1][n]);
        }
#pragma unroll
      for (int m = 0; m < 2; ++m)
#pragma unroll
        for (int n = 0; n < 4; ++n)
#pragma unroll
          for (int j = 0; j < 4; ++j) S[(half * 32 + m * 16 + fq * 4 + j) * 129 + kb + n * 16 + fr] = acc[m][n][j];
    }
    __syncthreads();
#pragma unroll 1
    for (int li = 0; li < 16; ++li) {
      int list = w * 16 + li;
      const float* row = S + list * 129;
      float vlo = row[lane], vhi = row[lane + 64];
      unsigned klo = (ordkey(vlo) & 0xFFFFFF80u) | (unsigned)(127 - lane);
      unsigned khi = (ordkey(vhi) & 0xFFFFFF80u) | (unsigned)(63 - lane);
      unsigned T = 0;
#pragma unroll 4
      for (int bit = 31; bit >= 0; --bit) {
        unsigned cand = T | (1u << bit);
        int cnt = __popcll(__ballot(klo >= cand)) + __popcll(__ballot(khi >= cand));
        if (cnt >= 16) T = cand;
        if (cnt == 16) break;
      }
      bool slo = klo >= T, shi = khi >= T;
      unsigned long long mlo = __ballot(slo), mhi = __ballot(shi);
      int rlo = 0, rhi = 0;
      while (mlo) {
        int src = __ffsll((long long)mlo) - 1;
        mlo &= mlo - 1;
        unsigned ks = (unsigned)__builtin_amdgcn_readlane((int)klo, src);
        rlo += (ks > klo) ? 1 : 0;
        rhi += (ks > khi) ? 1 : 0;
      }
      while (mhi) {
        int src = __ffsll((long long)mhi) - 1;
        mhi &= mhi - 1;
        unsigned ks = (unsigned)__builtin_amdgcn_readlane((int)khi, src);
        rlo += (ks > klo) ? 1 : 0;
        rhi += (ks > khi) ? 1 : 0;
      }
      if (slo) { sv[list * 16 + rlo] = vlo; si[list * 16 + rlo] = lane; }
      if (shi) { sv[list * 16 + rhi] = vhi; si[list * 16 + rhi] = lane + 64; }
    }
    __syncthreads();
#pragma unroll 1
    for (int tt = 0; tt < 8; ++tt) {
      int tok = w * 8 + tt;
      float sc_ = sv[tok * 16 + ci] + sv[(32 + tok) * 16 + cj];
      unsigned key = cvalid ? ((ordkey(sc_) & 0xFFFFFFC0u) | (unsigned)(63 - lane)) : 0u;
      unsigned T = 0;
#pragma unroll 4
      for (int bit = 31; bit >= 0; --bit) {
        unsigned cand = T | (1u << bit);
        int cnt = __popcll(__ballot(key >= cand));
        if (cnt >= 16) T = cand;
        if (cnt == 16) break;
      }
      bool sel = cvalid && key >= T;
      unsigned long long msel = __ballot(sel);
      int rank = 0;
      int isc = __float_as_int(sc_);
      unsigned long long mm = msel;
      float mx = -INFINITY;
      while (mm) {
        int src = __ffsll((long long)mm) - 1;
        mm &= mm - 1;
        unsigned ks = (unsigned)__builtin_amdgcn_readlane((int)key, src);
        rank += (ks > key) ? 1 : 0;
        mx = fmaxf(mx, __int_as_float(__builtin_amdgcn_readlane(isc, src)));
      }
      float ex = sel ? __expf(sc_ - mx) : 0.f;
      int iex = __float_as_int(ex);
      float sum = 0.f;
      mm = msel;
      while (mm) {
        int src = __ffsll((long long)mm) - 1;
        mm &= mm - 1;
        sum += __int_as_float(__builtin_amdgcn_readlane(iex, src));
      }
      if (sel) {
        size_t o = (size_t)(tok0 + tok) * 128 + h * 16 + rank;
        gateo[o] = ex / sum;
        idxo[o] = si[tok * 16 + ci] * 128 + si[(32 + tok) * 16 + cj];
      }
    }
  }
  __syncthreads();
}

DEV float gelu_exact(float v) { return 0.5f * v * (1.f + erff(v * 0.70710678118654752f)); }

__device__ __forceinline__ void convert_fp8_rows(const float* src, unsigned char* dst, float* rscale, int nrows) {
  const int tid_ = otid();
  int lane = tid_ & 63;
  int wave = blockIdx.x * 4 + (tid_ >> 6), nw = gridDim.x * 4;
  for (int row = wave; row < nrows; row += nw) {
    const float* r = src + (size_t)row * 1024 + lane * 16;
    float4 a0 = *reinterpret_cast<const float4*>(r), a1 = *reinterpret_cast<const float4*>(r + 4);
    float4 a2 = *reinterpret_cast<const float4*>(r + 8), a3 = *reinterpret_cast<const float4*>(r + 12);
    float m = fmaxf(fmaxf(fmaxf(fabsf(a0.x), fabsf(a0.y)), fmaxf(fabsf(a0.z), fabsf(a0.w))), fmaxf(fmaxf(fabsf(a1.x), fabsf(a1.y)), fmaxf(fabsf(a1.z), fabsf(a1.w))));
    m = fmaxf(m, fmaxf(fmaxf(fmaxf(fabsf(a2.x), fabsf(a2.y)), fmaxf(fabsf(a2.z), fabsf(a2.w))), fmaxf(fmaxf(fabsf(a3.x), fabsf(a3.y)), fmaxf(fabsf(a3.z), fabsf(a3.w)))));
#pragma unroll
    for (int o = 32; o > 0; o >>= 1) m = fmaxf(m, __shfl_xor(m, o));
    float sc = m > 0.f ? exp2f(floorf(log2f(224.f / m))) : 1.f;
    uint4 o;
    int p;
    p = __builtin_amdgcn_cvt_pk_fp8_f32(a0.x * sc, a0.y * sc, 0, false); p = __builtin_amdgcn_cvt_pk_fp8_f32(a0.z * sc, a0.w * sc, p, true); o.x = (unsigned)p;
    p = __builtin_amdgcn_cvt_pk_fp8_f32(a1.x * sc, a1.y * sc, 0, false); p = __builtin_amdgcn_cvt_pk_fp8_f32(a1.z * sc, a1.w * sc, p, true); o.y = (unsigned)p;
    p = __builtin_amdgcn_cvt_pk_fp8_f32(a2.x * sc, a2.y * sc, 0, false); p = __builtin_amdgcn_cvt_pk_fp8_f32(a2.z * sc, a2.w * sc, p, true); o.z = (unsigned)p;
    p = __builtin_amdgcn_cvt_pk_fp8_f32(a3.x * sc, a3.y * sc, 0, false); p = __builtin_amdgcn_cvt_pk_fp8_f32(a3.z * sc, a3.w * sc, p, true); o.w = (unsigned)p;
    *reinterpret_cast<uint4*>(dst + (size_t)row * 1024 + lane * 16) = o;
    if (lane == 0) rscale[row] = 1.f / sc;
  }
}

#define F8X(dst, WW) { dst[0] = __builtin_amdgcn_cvt_pk_f32_fp8((int)(WW).x, false); dst[1] = __builtin_amdgcn_cvt_pk_f32_fp8((int)(WW).x, true); \
                      dst[2] = __builtin_amdgcn_cvt_pk_f32_fp8((int)(WW).y, false); dst[3] = __builtin_amdgcn_cvt_pk_f32_fp8((int)(WW).y, true); \
                      dst[4] = __builtin_amdgcn_cvt_pk_f32_fp8((int)(WW).z, false); dst[5] = __builtin_amdgcn_cvt_pk_f32_fp8((int)(WW).z, true); \
                      dst[6] = __builtin_amdgcn_cvt_pk_f32_fp8((int)(WW).w, false); dst[7] = __builtin_amdgcn_cvt_pk_f32_fp8((int)(WW).w, true); }

__device__ __forceinline__ void phase_peer_gather(const u16* tin, const int* idx, const float* gate, const unsigned char* utab, const unsigned char* vtab,
                                  const float* urs, const float* vrs, const float* xres,
                                  const float* g2  , const float* lng, const float* lnb, float* xout,
                                  const float* modnext  , u16* hxout) {
  const int tid_ = otid();
  int lane = tid_ & 63;
  int wave = blockIdx.x * 4 + (tid_ >> 6), nw = gridDim.x * 4;
  for (int tok = wave; tok < NT; tok += nw) {
    int b = tok >> 12;
    f32x2 t2[8];
    {
      uint4 ta = *reinterpret_cast<const uint4*>(tin + (size_t)tok * 1024 + lane * 16);
      uint4 tb = *reinterpret_cast<const uint4*>(tin + (size_t)tok * 1024 + lane * 16 + 8);
      t2[0] = f32x2{bflo(ta.x), bfhi(ta.x)}; t2[1] = f32x2{bflo(ta.y), bfhi(ta.y)}; t2[2] = f32x2{bflo(ta.z), bfhi(ta.z)}; t2[3] = f32x2{bflo(ta.w), bfhi(ta.w)};
      t2[4] = f32x2{bflo(tb.x), bfhi(tb.x)}; t2[5] = f32x2{bflo(tb.y), bfhi(tb.y)}; t2[6] = f32x2{bflo(tb.z), bfhi(tb.z)}; t2[7] = f32x2{bflo(tb.w), bfhi(tb.w)};
    }
    int id0 = idx[(size_t)tok * 128 + lane] & 16383, id1 = idx[(size_t)tok * 128 + 64 + lane] & 16383;
    int gt0 = __float_as_int(gate[(size_t)tok * 128 + lane]), gt1 = __float_as_int(gate[(size_t)tok * 128 + 64 + lane]);
    f32x2 acc2[8];
#pragma unroll
    for (int k = 0; k < 8; ++k) acc2[k] = f32x2{0.f, 0.f};
#pragma unroll 1
    for (int j = 0; j < 128; j += 4) {
      int e[4];
      float g[4];
      if (j < 64) {
#pragma unroll
        for (int q = 0; q < 4; ++q) { e[q] = __builtin_amdgcn_readlane(id0, j + q); g[q] = __int_as_float(__builtin_amdgcn_readlane(gt0, j + q)); }
      } else {
#pragma unroll
        for (int q = 0; q < 4; ++q) { e[q] = __builtin_amdgcn_readlane(id1, j - 64 + q); g[q] = __int_as_float(__builtin_amdgcn_readlane(gt1, j - 64 + q)); }
      }
      uint4 U[4], V[4];
      float su[4], sv_[4];
#pragma unroll
      for (int q = 0; q < 4; ++q) {
        U[q] = *reinterpret_cast<const uint4*>(utab + (size_t)e[q] * 1024 + lane * 16);
        V[q] = *reinterpret_cast<const uint4*>(vtab + (size_t)e[q] * 1024 + lane * 16);
        su[q] = urs[e[q]];
        sv_[q] = vrs[e[q]];
      }
      float d[4];
#pragma unroll
      for (int q = 0; q < 4; ++q) {
        f32x2 u2[8];
        F8X(u2, U[q])
        f32x2 dd = u2[0] * t2[0];
#pragma unroll
        for (int k = 1; k < 8; ++k) dd = u2[k] * t2[k] + dd;
        d[q] = dd.x + dd.y;
      }
#pragma unroll
      for (int o = 32; o > 0; o >>= 1) {
#pragma unroll
        for (int q = 0; q < 4; ++q) d[q] += __shfl_xor(d[q], o);
      }
#pragma unroll
      for (int q = 0; q < 4; ++q) {
        float a = g[q] * gelu_exact(d[q] * su[q]) * sv_[q];
        f32x2 aa = f32x2{a, a};
        f32x2 v2[8];
        F8X(v2, V[q])
#pragma unroll
        for (int k = 0; k < 8; ++k) acc2[k] = aa * v2[k] + acc2[k];
      }
    }
    float vv[16];
    float s = 0.f;
    const int c0 = lane * 16;
#pragma unroll
    for (int k4 = 0; k4 < 4; ++k4) {
      float4 x0 = *reinterpret_cast<const float4*>(xres + (size_t)tok * 1024 + c0 + k4 * 4);
      float4 g0 = *reinterpret_cast<const float4*>(g2 + (size_t)b * 6144 + c0 + k4 * 4);
      vv[k4 * 4 + 0] = ALPHA * x0.x + g0.x * acc2[k4 * 2].x; vv[k4 * 4 + 1] = ALPHA * x0.y + g0.y * acc2[k4 * 2].y;
      vv[k4 * 4 + 2] = ALPHA * x0.z + g0.z * acc2[k4 * 2 + 1].x; vv[k4 * 4 + 3] = ALPHA * x0.w + g0.w * acc2[k4 * 2 + 1].y;
    }
#pragma unroll
    for (int k = 0; k < 16; ++k) s += vv[k];
    float mu = wave_sum(s) * (1.f / 1024.f);
    float qq = 0.f;
#pragma unroll
    for (int k = 0; k < 16; ++k) { vv[k] -= mu; qq += vv[k] * vv[k]; }
    float rs = rsqrtf(wave_sum(qq) * (1.f / 1024.f) + 1e-5f);
    float oo[16];
#pragma unroll
    for (int k4 = 0; k4 < 4; ++k4) {
      float4 ga = *reinterpret_cast<const float4*>(lng + c0 + k4 * 4), ba = *reinterpret_cast<const float4*>(lnb + c0 + k4 * 4);
      float4 o0;
      o0.x = vv[k4 * 4 + 0] * rs * ga.x + ba.x; o0.y = vv[k4 * 4 + 1] * rs * ga.y + ba.y; o0.z = vv[k4 * 4 + 2] * rs * ga.z + ba.z; o0.w = vv[k4 * 4 + 3] * rs * ga.w + ba.w;
      *reinterpret_cast<float4*>(xout + (size_t)tok * 1024 + c0 + k4 * 4) = o0;
      oo[k4 * 4 + 0] = o0.x; oo[k4 * 4 + 1] = o0.y; oo[k4 * 4 + 2] = o0.z; oo[k4 * 4 + 3] = o0.w;
    }
    if (modnext) {
      const float* m = modnext + (size_t)b * 6144;
      unsigned pk[8];
#pragma unroll
      for (int k4 = 0; k4 < 4; ++k4) {
        float4 sh0 = *reinterpret_cast<const float4*>(m + c0 + k4 * 4), sc0 = *reinterpret_cast<const float4*>(m + 1024 + c0 + k4 * 4);
        pk[k4 * 2] = pack2(oo[k4 * 4 + 0] * (1.f + sc0.x) + sh0.x, oo[k4 * 4 + 1] * (1.f + sc0.y) + sh0.y);
        pk[k4 * 2 + 1] = pack2(oo[k4 * 4 + 2] * (1.f + sc0.z) + sh0.z, oo[k4 * 4 + 3] * (1.f + sc0.w) + sh0.w);
      }
      *reinterpret_cast<uint4*>(hxout + (size_t)tok * 1024 + c0) = make_uint4(pk[0], pk[1], pk[2], pk[3]);
      *reinterpret_cast<uint4*>(hxout + (size_t)tok * 1024 + c0 + 8) = make_uint4(pk[4], pk[5], pk[6], pk[7]);
    }
  }
}

__device__ __forceinline__ void phase_shortconv_T(const Params& p, const u16* upre, u16* x1cm, u16* x2cm, u16* vcm, char* lds) {
  constexpr int TLD = 264;
  u16* tile = (u16*)lds;
  int tid = otid();
  const int tg = tid >> 3, cg_ = tid & 7;
  for (int item = blockIdx.x; item < 128 * 48; item += gridDim.x) {
    int tt = item / 48, ct = item % 48;
    int tok0 = tt * 256, c0 = ct * 64;
    int ch = c0 + cg_ * 8;
    float w[3][8], bias[8];
#pragma unroll
    for (int j = 0; j < 3; ++j) {
      float4 w0 = *reinterpret_cast<const float4*>(p.h_conv_w + j * 3072 + ch), w1 = *reinterpret_cast<const float4*>(p.h_conv_w + j * 3072 + ch + 4);
      w[j][0] = w0.x; w[j][1] = w0.y; w[j][2] = w0.z; w[j][3] = w0.w; w[j][4] = w1.x; w[j][5] = w1.y; w[j][6] = w1.z; w[j][7] = w1.w;
    }
    {
      float4 b0 = *reinterpret_cast<const float4*>(p.h_conv_b + ch), b1 = *reinterpret_cast<const float4*>(p.h_conv_b + ch + 4);
      bias[0] = b0.x; bias[1] = b0.y; bias[2] = b0.z; bias[3] = b0.w; bias[4] = b1.x; bias[5] = b1.y; bias[6] = b1.z; bias[7] = b1.w;
    }
    const int t0 = tok0 + tg * 8;
    const int l0 = t0 & 4095;
    const u32x4 zero4 = u32x4{0u, 0u, 0u, 0u};
    u32x4 rows[10];
#pragma unroll
    for (int i = 0; i < 10; ++i) {
      int ll = l0 + i - 1;
      rows[i] = (ll >= 0 && ll <= 4095) ? *reinterpret_cast<const u32x4*>(upre + (size_t)(t0 + i - 1) * 3072 + ch) : zero4;
    }
    float o[8][8];
#pragma unroll
    for (int i = 0; i < 8; ++i) {
#pragma unroll
      for (int k = 0; k < 8; ++k) o[i][k] = bias[k];
      fma8(o[i], rows[i], w[0]);
      fma8(o[i], rows[i + 1], w[1]);
      fma8(o[i], rows[i + 2], w[2]);
    }
#pragma unroll
    for (int k = 0; k < 8; ++k) {
      uint4 pk;
      pk.x = pack2(o[0][k], o[1][k]); pk.y = pack2(o[2][k], o[3][k]); pk.z = pack2(o[4][k], o[5][k]); pk.w = pack2(o[6][k], o[7][k]);
      *reinterpret_cast<uint4*>(tile + (cg_ * 8 + k) * TLD + tg * 8) = pk;
    }
    __syncthreads();
    int part = c0 >> 10, d0 = c0 & 1023;
    u16* dst = part == 0 ? x1cm : (part == 1 ? x2cm : vcm);
    int b = tok0 >> 12, lt0 = tok0 & 4095;
#pragma unroll
    for (int i = 0; i < 8; ++i) {
      int q = tid + i * 256, c = q >> 5, chunk = q & 31;
      uint4 v = *reinterpret_cast<const uint4*>(tile + c * TLD + chunk * 8);
      *reinterpret_cast<uint4*>(dst + ((size_t)(b * 1024 + d0 + c)) * 4096 + lt0 + chunk * 8) = v;
    }
    __syncthreads();
  }
}

DEV float2 cmul(float2 a, float2 w) { return make_float2(a.x * w.x - a.y * w.y, a.x * w.y + a.y * w.x); }
DEV float2 cmulc(float2 a, float2 w) { return make_float2(a.x * w.x + a.y * w.y, a.y * w.x - a.x * w.y); }
template <bool LAST = true>
__device__ __forceinline__ void fft_fwd(float2* X, const float2* __restrict__ tw) {
  int tid = otid();
  for (int s = 12; s >= 2; s -= 2) {
    const int h = 1 << s, q = h >> 1;
#pragma unroll 2
    for (int i = 0; i < 8; ++i) {
      int gi = tid + i * 256;
      int pos = gi & (q - 1);
      int base = ((gi >> (s - 1)) << (s + 1)) + pos;
      float2 w1 = tw[pos << (12 - s)];
      float2 w2 = tw[pos << (13 - s)];
      float2 a = X[base], bb = X[base + q], c = X[base + h], d = X[base + h + q];
      float2 a1 = make_float2(a.x + c.x, a.y + c.y);
      float2 c1 = cmul(make_float2(a.x - c.x, a.y - c.y), w1);
      float2 b1 = make_float2(bb.x + d.x, bb.y + d.y);
      float2 t = cmul(make_float2(bb.x - d.x, bb.y - d.y), w1);
      float2 d1 = make_float2(t.y, -t.x);
      X[base] = make_float2(a1.x + b1.x, a1.y + b1.y);
      X[base + q] = cmul(make_float2(a1.x - b1.x, a1.y - b1.y), w2);
      X[base + h] = make_float2(c1.x + d1.x, c1.y + d1.y);
      X[base + h + q] = cmul(make_float2(c1.x - d1.x, c1.y - d1.y), w2);
    }
    __syncthreads();
  }
  if (LAST) {
#pragma unroll 4
    for (int i = 0; i < 16; ++i) {
      int j = tid + i * 256;
      float2 a = X[2 * j], bq = X[2 * j + 1];
      X[2 * j] = make_float2(a.x + bq.x, a.y + bq.y);
      X[2 * j + 1] = make_float2(a.x - bq.x, a.y - bq.y);
    }
    __syncthreads();
  }
}
__device__ __forceinline__ void fft_mid_mul(float2* X, const float2* __restrict__ H) {
  int tid = otid();
#pragma unroll 4
  for (int i = 0; i < 16; ++i) {
    int j = tid + i * 256;
    float2 a = X[2 * j], bq = X[2 * j + 1];
    float4 hh = *reinterpret_cast<const float4*>(H + 2 * j);
    float2 f0 = make_float2(a.x + bq.x, a.y + bq.y), f1 = make_float2(a.x - bq.x, a.y - bq.y);
    float2 g0 = make_float2(f0.x * hh.x - f0.y * hh.y, f0.x * hh.y + f0.y * hh.x);
    float2 g1 = make_float2(f1.x * hh.z - f1.y * hh.w, f1.x * hh.w + f1.y * hh.z);
    X[2 * j] = make_float2(g0.x + g1.x, g0.y + g1.y);
    X[2 * j + 1] = make_float2(g0.x - g1.x, g0.y - g1.y);
  }
  __syncthreads();
}
template <bool FIRST = true>
__device__ __forceinline__ void fft_inv(float2* X, const float2* __restrict__ tw) {
  int tid = otid();
  if (FIRST) {
#pragma unroll 4
    for (int i = 0; i < 16; ++i) {
      int j = tid + i * 256;
      float2 a = X[2 * j], bq = X[2 * j + 1];
      X[2 * j] = make_float2(a.x + bq.x, a.y + bq.y);
      X[2 * j + 1] = make_float2(a.x - bq.x, a.y - bq.y);
    }
    __syncthreads();
  }
  for (int s = 2; s <= 12; s += 2) {
    const int h = 1 << s, q = h >> 1;
#pragma unroll 2
    for (int i = 0; i < 8; ++i) {
      int gi = tid + i * 256;
      int pos = gi & (q - 1);
      int base = ((gi >> (s - 1)) << (s + 1)) + pos;
      float2 w1 = tw[pos << (12 - s)];
      float2 w2 = tw[pos << (13 - s)];
      float2 a = X[base], bb = X[base + q], c = X[base + h], d = X[base + h + q];
      float2 tb = cmulc(bb, w2), td = cmulc(d, w2);
      float2 a1 = make_float2(a.x + tb.x, a.y + tb.y), b1 = make_float2(a.x - tb.x, a.y - tb.y);
      float2 c1 = make_float2(c.x + td.x, c.y + td.y), d1 = make_float2(c.x - td.x, c.y - td.y);
      float2 tc = cmulc(c1, w1);
      float2 u = cmulc(d1, w1);
      float2 tdd = make_float2(-u.y, u.x);
      X[base] = make_float2(a1.x + tc.x, a1.y + tc.y);
      X[base + h] = make_float2(a1.x - tc.x, a1.y - tc.y);
      X[base + q] = make_float2(b1.x + tdd.x, b1.y + tdd.y);
      X[base + h + q] = make_float2(b1.x - tdd.x, b1.y - tdd.y);
    }
    __syncthreads();
  }
}

__device__ __forceinline__ void phase_filter_fft(const Params& p, float2* Hf, char* lds) {
  float2* X = (float2*)lds;
  float* w3s = (float*)(lds + 65536);
  float* red = w3s + 128;
  const float* hid = (const float*)(p.ws + OFF_HID);
  int tid = otid();
  const float min_decay = -3.0701134573253945f;
  const float max_decay = -15.350567286626973f;
  for (int item = blockIdx.x; item < 2048; item += gridDim.x) {
    int o = item >> 10, d = item & 1023;
    if (tid < 128) {
      int dirr = tid >> 6, j = tid & 63;
      w3s[tid] = p.h_f_w3[(size_t)j * 4096 + (o * 2 + dirr) * 1024 + d];
    }
    __syncthreads();
    float adelta = fabsf(min_decay + (float)d * ((max_decay - min_decay) / 1023.f));
    float ss = 0.f;
#pragma unroll 1
    for (int i = 0; i < 16; ++i) {
      int t = tid + i * 256;
      const float* hr = hid + (size_t)t * 64;
      float hf = 0.f, hb = 0.f;
#pragma unroll
      for (int j4 = 0; j4 < 16; ++j4) {
        float4 hv = *reinterpret_cast<const float4*>(hr + j4 * 4);
        hf += hv.x * w3s[j4 * 4] + hv.y * w3s[j4 * 4 + 1] + hv.z * w3s[j4 * 4 + 2] + hv.w * w3s[j4 * 4 + 3];
        hb += hv.x * w3s[64 + j4 * 4] + hv.y * w3s[64 + j4 * 4 + 1] + hv.z * w3s[64 + j4 * 4 + 2] + hv.w * w3s[64 + j4 * 4 + 3];
      }
      float dec = __expf(-((float)t / 4095.f) * adelta);
      hf *= dec; hb *= dec;
      if (t == 0) {
        float v = hf + hb;
        X[0] = make_float2(v, 0.f);
        X[4096] = make_float2(0.f, 0.f);
        ss += v * v;
      } else {
        X[t] = make_float2(hf, 0.f);
        X[8192 - t] = make_float2(hb, 0.f);
        ss += hf * hf + hb * hb;
      }
    }
    ss = wave_sum(ss);
    if ((tid & 63) == 0) red[tid >> 6] = ss;
    __syncthreads();
    float tot = red[0] + red[1] + red[2] + red[3];
    float scale = rsqrtf(tot + 1e-6f) * (1.f / 8192.f);
    fft_fwd(X, (const float2*)(p.ws + OFF_TW));
    float2* dst = Hf + (size_t)item * 8192;
#pragma unroll 4
    for (int i = 0; i < 32; ++i) {
      int k = tid + i * 256;
      float2 v = X[k];
      dst[k] = make_float2(v.x * scale, v.y * scale);
    }
    __syncthreads();
  }
}

__device__ __forceinline__ void phase_hyena_conv(const Params& p, const u16* x1cm, const u16* x2cm, const u16* vcm, const float2* Hf, u16* zzcm, char* lds) {
  float2* X = (float2*)lds;
  int tid = otid();
  for (int item = blockIdx.x; item < 4096; item += gridDim.x) {
    int d = item >> 2, bp = item & 3;
    size_t r0 = ((size_t)((bp * 2) * 1024 + d)) * 4096, r1 = ((size_t)((bp * 2 + 1) * 1024 + d)) * 4096;
    float bias0 = p.h_bias[d], bias1 = p.h_bias[1024 + d];
#pragma unroll
    for (int i = 0; i < 2; ++i) {
      int t8 = (tid + i * 256) * 8;
      uint4 a = *reinterpret_cast<const uint4*>(vcm + r0 + t8);
      uint4 bq = *reinterpret_cast<const uint4*>(vcm + r1 + t8);
      X[t8 + 0] = make_float2(bflo(a.x), bflo(bq.x)); X[t8 + 1] = make_float2(bfhi(a.x), bfhi(bq.x));
      X[t8 + 2] = make_float2(bflo(a.y), bflo(bq.y)); X[t8 + 3] = make_float2(bfhi(a.y), bfhi(bq.y));
      X[t8 + 4] = make_float2(bflo(a.z), bflo(bq.z)); X[t8 + 5] = make_float2(bfhi(a.z), bfhi(bq.z));
      X[t8 + 6] = make_float2(bflo(a.w), bflo(bq.w)); X[t8 + 7] = make_float2(bfhi(a.w), bfhi(bq.w));
    }
    for (int i = 0; i < 16; ++i) X[4096 + tid + i * 256] = make_float2(0.f, 0.f);
    __syncthreads();
    fft_fwd<false>(X, (const float2*)(p.ws + OFF_TW));
    fft_mid_mul(X, Hf + (size_t)d * 8192);
    fft_inv<false>(X, (const float2*)(p.ws + OFF_TW));
    float zz0[16], zz1[16];
#pragma unroll
    for (int i = 0; i < 2; ++i) {
      int t8 = (tid + i * 256) * 8;
      uint4 a = *reinterpret_cast<const uint4*>(vcm + r0 + t8);
      uint4 bq = *reinterpret_cast<const uint4*>(vcm + r1 + t8);
      uint4 xa = *reinterpret_cast<const uint4*>(x1cm + r0 + t8);
      uint4 xb = *reinterpret_cast<const uint4*>(x1cm + r1 + t8);
      float va[8] = {bflo(a.x), bfhi(a.x), bflo(a.y), bfhi(a.y), bflo(a.z), bfhi(a.z), bflo(a.w), bfhi(a.w)};
      float vb[8] = {bflo(bq.x), bfhi(bq.x), bflo(bq.y), bfhi(bq.y), bflo(bq.z), bfhi(bq.z), bflo(bq.w), bfhi(bq.w)};
      float fa[8] = {bflo(xa.x), bfhi(xa.x), bflo(xa.y), bfhi(xa.y), bflo(xa.z), bfhi(xa.z), bflo(xa.w), bfhi(xa.w)};
      float fb[8] = {bflo(xb.x), bfhi(xb.x), bflo(xb.y), bfhi(xb.y), bflo(xb.z), bfhi(xb.z), bflo(xb.w), bfhi(xb.w)};
#pragma unroll
      for (int e = 0; e < 8; ++e) {
        float2 cv = X[t8 + e];
        float z0 = fa[e] * (cv.x + va[e] * bias0);
        float z1 = fb[e] * (cv.y + vb[e] * bias0);
        zz0[i * 8 + e] = z0; zz1[i * 8 + e] = z1;
        X[t8 + e] = make_float2(z0, z1);
      }
    }
    for (int i = 0; i < 16; ++i) X[4096 + tid + i * 256] = make_float2(0.f, 0.f);
    __syncthreads();
    fft_fwd<false>(X, (const float2*)(p.ws + OFF_TW));
    fft_mid_mul(X, Hf + (size_t)(1024 + d) * 8192);
    fft_inv<false>(X, (const float2*)(p.ws + OFF_TW));
#pragma unroll
    for (int i = 0; i < 2; ++i) {
      int t8 = (tid + i * 256) * 8;
      uint4 xa = *reinterpret_cast<const uint4*>(x2cm + r0 + t8);
      uint4 xb = *reinterpret_cast<const uint4*>(x2cm + r1 + t8);
      float fa[8] = {bflo(xa.x), bfhi(xa.x), bflo(xa.y), bfhi(xa.y), bflo(xa.z), bfhi(xa.z), bflo(xa.w), bfhi(xa.w)};
      float fb[8] = {bflo(xb.x), bfhi(xb.x), bflo(xb.y), bfhi(xb.y), bflo(xb.z), bfhi(xb.z), bflo(xb.w), bfhi(xb.w)};
      float o0[8], o1[8];
#pragma unroll
      for (int e = 0; e < 8; ++e) {
        float2 cv = X[t8 + e];
        o0[e] = fa[e] * (cv.x + zz0[i * 8 + e] * bias1);
        o1[e] = fb[e] * (cv.y + zz1[i * 8 + e] * bias1);
      }
      uint4 w0, w1;
      w0.x = pack2(o0[0], o0[1]); w0.y = pack2(o0[2], o0[3]); w0.z = pack2(o0[4], o0[5]); w0.w = pack2(o0[6], o0[7]);
      w1.x = pack2(o1[0], o1[1]); w1.y = pack2(o1[2], o1[3]); w1.z = pack2(o1[4], o1[5]); w1.w = pack2(o1[6], o1[7]);
      *reinterpret_cast<uint4*>(zzcm + r0 + t8) = w0;
      *reinterpret_cast<uint4*>(zzcm + r1 + t8) = w1;
    }
    __syncthreads();
  }
}

__device__ __forceinline__ void phase_transpose_back(const u16* src, u16* dst, char* lds) {
  u16* tile = (u16*)lds;
  int tid = otid();
  for (int item = blockIdx.x; item < 8 * 16 * 64; item += gridDim.x) {
    int b = item >> 10, dt_ = (item >> 6) & 15, tt = item & 63;
#pragma unroll
    for (int i = 0; i < 2; ++i) {
      int q = tid + i * 256, dd = q >> 3, tg = (q & 7) * 8;
      uint4 v = *reinterpret_cast<const uint4*>(src + ((size_t)(b * 1024 + dt_ * 64 + dd)) * 4096 + tt * 64 + tg);
      tile[(tg + 0) * 72 + dd] = (u16)(v.x & 0xffff); tile[(tg + 1) * 72 + dd] = (u16)(v.x >> 16);
      tile[(tg + 2) * 72 + dd] = (u16)(v.y & 0xffff); tile[(tg + 3) * 72 + dd] = (u16)(v.y >> 16);
      tile[(tg + 4) * 72 + dd] = (u16)(v.z & 0xffff); tile[(tg + 5) * 72 + dd] = (u16)(v.z >> 16);
      tile[(tg + 6) * 72 + dd] = (u16)(v.w & 0xffff); tile[(tg + 7) * 72 + dd] = (u16)(v.w >> 16);
    }
    __syncthreads();
#pragma unroll
    for (int i = 0; i < 2; ++i) {
      int q = tid + i * 256, tl = q >> 3, dg = (q & 7) * 8;
      uint4 v = *reinterpret_cast<const uint4*>(tile + tl * 72 + dg);
      *reinterpret_cast<uint4*>(dst + ((size_t)(b * 4096 + tt * 64 + tl)) * 1024 + dt_ * 64 + dg) = v;
    }
    __syncthreads();
  }
}

__device__ __forceinline__ uint4* xb_words_ptr() { __shared__ uint4 xb_words; return &xb_words; }
#define XB_TMO      128
#define XB_XCNT(j)  (256  + 64 * (j))
#define XB_XSUB(j)  (1280 + 64 * (j))
#define XB_XGEN(j)  (2304 + 64 * (j))
#define XB_TOP      3328
#define XB_TOPGEN   3392
#define XCD_BAR_WORDS 3456
#define XB_SPIN_CAP (1u << 18)
#define LAS __attribute__((address_space(3)))

__device__ __forceinline__ unsigned xb_ld(unsigned* p)              { return __hip_atomic_load(p, __ATOMIC_RELAXED, __HIP_MEMORY_SCOPE_AGENT); }
__device__ __forceinline__ unsigned xb_add(unsigned* p, unsigned v) { return __hip_atomic_fetch_add(p, v, __ATOMIC_RELAXED, __HIP_MEMORY_SCOPE_AGENT); }
__device__ __forceinline__ unsigned xb_xcc_id() { return (unsigned)__builtin_amdgcn_s_getreg((3 << 11) | 20) & 0xFu; }
#define XB_SPIN(cond, bar) do { unsigned _sp = 0; while (cond) { __builtin_amdgcn_s_sleep(1); \
    if ((++_sp & 255u) == 0u) { if (xb_ld(&(bar)[XB_TMO])) break; if (_sp > XB_SPIN_CAP) { atomicAdd(&(bar)[XB_TMO], 1u); break; } } } } while (0)

struct XcdBarrier {
    unsigned* bar; unsigned x;
    volatile LAS unsigned* st;
};

__device__ __forceinline__ XcdBarrier xcd_barrier_post(unsigned* bar, volatile LAS unsigned* st) {
    XcdBarrier b; b.bar = bar; b.x = xb_xcc_id(); b.st = st;
    if (threadIdx.x == 0) (void)xb_add(&bar[XB_XCNT(b.x)], 1u);
    return b;
}
__device__ __forceinline__ void xcd_barrier_complete(unsigned* bar, unsigned x, unsigned& nloc, unsigned& nx) {
    const unsigned G = gridDim.x * gridDim.y * gridDim.z;
    unsigned sum, cnt, mine, sp = 0u;
    for (;;) {
        sum = 0u; cnt = 0u; mine = 0u;
#pragma unroll
        for (unsigned j = 0; j < 16; ++j) { const unsigned c = xb_ld(&bar[XB_XCNT(j)]); sum += c; cnt += (c > 0u) ? 1u : 0u; mine = (j == x) ? c : mine; }
        if (sum == G) break;
        __builtin_amdgcn_s_sleep(1);
        if ((++sp & 255u) == 0u) { if (xb_ld(&bar[XB_TMO])) break; if (sp > XB_SPIN_CAP) { atomicAdd(&bar[XB_TMO], 1u); break; } }
    }
    nloc = mine > 0u ? mine : 1u; nx = cnt > 0u ? cnt : 1u;
}

__device__ __forceinline__ void xcd_barrier(const XcdBarrier& b) {
    asm volatile("s_waitcnt vmcnt(0)" ::: "memory");
    __syncthreads();
    if (threadIdx.x == 0) {
        unsigned* bar = b.bar;
        __builtin_amdgcn_s_waitcnt(0);
        unsigned nloc = b.st[0], nx = b.st[1];
        if (nloc == 0u) { xcd_barrier_complete(bar, b.x, nloc, nx); b.st[0] = nloc; b.st[1] = nx; }
        const unsigned old = xb_add(&bar[XB_XSUB(b.x)], 1u);
        const unsigned gen = old / nloc;
        if (old + 1u == (gen + 1u) * nloc) {
            __builtin_amdgcn_fence(__ATOMIC_RELEASE, "agent");
            asm volatile("s_waitcnt vmcnt(0)" ::: "memory");
            const unsigned og = xb_add(&bar[XB_TOP], 1u);
            const unsigned tg = og / nx;
            if (og + 1u == (tg + 1u) * nx) xb_add(&bar[XB_TOPGEN], 1u);
            else XB_SPIN(xb_ld(&bar[XB_TOPGEN]) == tg, bar);
            __builtin_amdgcn_fence(__ATOMIC_ACQUIRE, "agent");
            xb_add(&bar[XB_XGEN(b.x)], 1u);
            asm volatile("s_waitcnt vmcnt(0)" ::: "memory");
        } else {
            XB_SPIN(xb_ld(&bar[XB_XGEN(b.x)]) == gen, bar);
            __builtin_amdgcn_fence(__ATOMIC_ACQUIRE, "agent");
            asm volatile("s_waitcnt vmcnt(0)" ::: "memory");
        }
    }
    __syncthreads();
}


DEV void gsync2(unsigned k) {
  (void)k;
  XcdBarrier b;
  b.bar = (unsigned*)((char*)karg<33>() + OFF_BAR);
  b.x = xb_xcc_id();
  b.st = (volatile LAS unsigned*)xb_words_ptr();
  xcd_barrier(b);
}

DEV void gsync(cg::grid_group& grid) {
  asm volatile("s_waitcnt vmcnt(0)" ::: "memory");
  grid.sync();
  if (threadIdx.x == 0) {
    __builtin_amdgcn_fence(__ATOMIC_ACQUIRE, "agent");
    asm volatile("s_waitcnt vmcnt(0)" ::: "memory");
  }
  __syncthreads();
}

template <int layer>
__device__ __forceinline__ void peer_block(unsigned& nbar, char* lds) {
  {
    Params p = fetch_params();
    char* ws = p.ws; char* R1 = ws + OFF_R1; char* R2 = ws + OFF_R2; char* DO = (char*)p.out;
    const float* modl = (float*)(ws + OFF_MOD) + (size_t)layer * 9 * 6144;
    const u16* A = layer == 0 ? (const u16*)R1 : (const u16*)DO;
    const int K = layer == 0 ? 2048 : 1024;
    const u16* Wt = (const u16*)(ws + (layer == 0 ? OFF_W_OUT : OFF_W_HOUT));
    const float* res = layer == 0 ? p.x : (const float*)R2;
    phase_gemm_resid(A, K, Wt, res, (float*)R2, modl + 2048, lds);
  }
  gsync2(++nbar);
  {
    Params p = fetch_params();
    char* ws = p.ws; char* R1 = ws + OFF_R1; char* R2 = ws + OFF_R2; char* DO = (char*)p.out;
    const float* modl = (float*)(ws + OFF_MOD) + (size_t)layer * 9 * 6144;
    u16* tpeer = layer == 0 ? (u16*)DO : (u16*)(R1 + 128 * MiB);
    phase_ln_mod((float*)R2, p.ln_g + layer * 2048, p.ln_b + layer * 2048, modl, tpeer);
    if (layer == 1) {
      unsigned char* tb = (unsigned char*)R1;
      convert_fp8_rows(p.p_u + (size_t)16384 * 1024, tb, (float*)(tb + 32 * MiB), 16384);
      convert_fp8_rows(p.p_v + (size_t)16384 * 1024, tb + 16 * MiB, (float*)(tb + 32 * MiB + 65536), 16384);
    }
  }
  gsync2(++nbar);
  {
    Params p = fetch_params();
    char* ws = p.ws; char* R1 = ws + OFF_R1; char* DO = (char*)p.out;
    u16* tpeer = layer == 0 ? (u16*)DO : (u16*)(R1 + 128 * MiB);
    phase_gemm_bf16(tpeer, (const u16*)(ws + OFF_W_Q) + (size_t)layer * 2048 * 1024, layer == 0 ? (u16*)R1 : (u16*)DO, 2048, lds);
  }
  gsync2(++nbar);
  {
    Params p = fetch_params();
    char* ws = p.ws; char* R1 = ws + OFF_R1; char* R2 = ws + OFF_R2;
    int* idxb = (int*)(R2 + 128 * MiB);
    float* gateb = (float*)(R2 + 144 * MiB);
    const u16* kbf = (const u16*)(ws + OFF_KEYS);
    phase_peer_topk(layer == 0 ? (const u16*)R1 : (const u16*)p.out, kbf + (size_t)layer * 131072, kbf + 262144 + (size_t)layer * 131072, idxb, gateb, lds);
  }
  gsync2(++nbar);
  {
    Params p = fetch_params();
    char* ws = p.ws; char* R1 = ws + OFF_R1; char* R2 = ws + OFF_R2; char* DO = (char*)p.out;
    float* mod = (float*)(ws + OFF_MOD);
    const float* modl = mod + (size_t)layer * 9 * 6144;
    int* idxb = (int*)(R2 + 128 * MiB);
    float* gateb = (float*)(R2 + 144 * MiB);
    u16* tpeer = layer == 0 ? (u16*)DO : (u16*)(R1 + 128 * MiB);
    const unsigned char* tb8 = (const unsigned char*)(layer == 0 ? ws + OFF_TAB0 : R1);
    phase_peer_gather(tpeer, idxb, gateb, tb8, tb8 + 16 * MiB, (const float*)(tb8 + 32 * MiB), (const float*)(tb8 + 32 * MiB + 65536), (const float*)R2,
                      modl + 5120, p.ln_g + layer * 2048 + 1024, p.ln_b + layer * 2048 + 1024, layer == 0 ? (float*)R2 : p.out,
                      layer == 0 ? mod + 9 * 6144 : nullptr, (u16*)(DO + 64 * MiB));
  }
}

__global__ void __launch_bounds__(256, 2) fwd_megakernel(Params p_unused) {
  __shared__ __attribute__((aligned(16))) char lds[LDS_BYTES];
  cg::grid_group grid = cg::this_grid();
  unsigned nbar = 0;
  if (threadIdx.x == 0) *xb_words_ptr() = make_uint4(0u, 0u, 0u, 0u);
  __syncthreads();
  (void)xcd_barrier_post((unsigned*)((char*)karg<33>() + OFF_BAR), (volatile LAS unsigned*)xb_words_ptr());
  { Params p = fetch_params(); phase_prologue(p, lds); }
  gsync(grid);
  {
    Params p = fetch_params();
    float* mod = (float*)(p.ws + OFF_MOD);
    modulate_rows(p.x, (u16*)(p.ws + OFF_R2), NT, SEQ, mod, 0, 1024, false);
    modulate_rows(p.ctx, (u16*)(p.ws + OFF_HC), NTC, CTXL, mod, 0, 1024, true);
  }
  gsync2(++nbar);
  { Params p = fetch_params(); phase_gemm_inproj(p, lds); }
  gsync2(++nbar);
  { Params p = fetch_params(); phase_conv(p); }
  gsync2(++nbar);
  { Params p = fetch_params(); phase_ssd(p, lds); }
  gsync2(++nbar);
  {
    Params p = fetch_params(); phase_gated_norm(p);
    unsigned char* tb = (unsigned char*)(p.ws + OFF_TAB0);
    convert_fp8_rows(p.p_u, tb, (float*)(tb + 32 * MiB), 16384);
    convert_fp8_rows(p.p_v, tb + 16 * MiB, (float*)(tb + 32 * MiB + 65536), 16384);
  }
  gsync2(++nbar);
  peer_block<0>(nbar, lds);
  gsync2(++nbar);
  {
    Params p = fetch_params();
    phase_gemm_bf16((const u16*)((char*)p.out + 64 * MiB), (const u16*)(p.ws + OFF_W_HIN), (u16*)(p.ws + OFF_R1), 3072, lds);
  }
  gsync2(++nbar);
  {
    Params p = fetch_params();
    phase_shortconv_T(p, (const u16*)(p.ws + OFF_R1), (u16*)(p.ws + OFF_R2 + 128 * MiB), (u16*)p.out, (u16*)((char*)p.out + 64 * MiB), lds);
  }
  gsync2(++nbar);
  { Params p = fetch_params(); phase_filter_fft(p, (float2*)(p.ws + OFF_R1), lds); }
  gsync2(++nbar);
  {
    Params p = fetch_params();
    phase_hyena_conv(p, (const u16*)(p.ws + OFF_R2 + 128 * MiB), (const u16*)p.out, (const u16*)((char*)p.out + 64 * MiB),
                     (const float2*)(p.ws + OFF_R1), (u16*)(p.ws + OFF_R1 + 128 * MiB), lds);
  }
  gsync2(++nbar);
  { Params p = fetch_params(); phase_transpose_back((const u16*)(p.ws + OFF_R1 + 128 * MiB), (u16*)p.out, lds); }
  gsync2(++nbar);
  peer_block<1>(nbar, lds);
}

extern "C" void kernel_launch(void* const* d_in, const int* in_sizes, int n_in, void* d_out, int out_size, void* d_ws, size_t ws_size,
                              hipStream_t stream) {
  static int grid_blocks = 0;
  if (!grid_blocks) {
    int dev = 0, cus = 0, per_cu = 0;
    hipGetDevice(&dev);
    hipDeviceGetAttribute(&cus, hipDeviceAttributeMultiprocessorCount, dev);
    hipOccupancyMaxActiveBlocksPerMultiprocessor(&per_cu, fwd_megakernel, 256, 0);
    if (per_cu > 2) per_cu = 2;
    if (per_cu < 1) per_cu = 1;
    grid_blocks = cus * per_cu;
  }
  Params p{};
  const float** pp = reinterpret_cast<const float**>(&p);
  for (int i = 0; i < 32; ++i) pp[i] = (const float*)d_in[i];
  p.out = (float*)d_out;
  p.ws = (char*)d_ws;
  if (ws_size < WS_TOTAL) fprintf(stderr, "workspace too small: %zu < %zu\n", ws_size, (size_t)WS_TOTAL);
  (void)hipMemsetAsync((char*)d_ws + OFF_BAR, 0, 16384, stream);
  void* args[] = {&p};
  hipError_t e = hipLaunchCooperativeKernel((void*)fwd_megakernel, dim3(grid_blocks), dim3(256), args, 0, stream);
  if (e != hipSuccess) fprintf(stderr, "cooperative launch failed: %s (grid %d)\n", hipGetErrorString(e), grid_blocks);
}
```

```cpp
#include <hip/hip_runtime.h>
#include <hip/hip_bf16.h>
#include <hip/hip_cooperative_groups.h>
#include <cstdio>
namespace cg = cooperative_groups;

typedef unsigned short u16;
using bf16x8 = __attribute__((ext_vector_type(8))) short;
using f32x4 = __attribute__((ext_vector_type(4))) float;
using u32x4 = __attribute__((ext_vector_type(4))) unsigned;
typedef float f32x2 __attribute__((ext_vector_type(2)));

#define DEV __device__ __forceinline__

constexpr int NB = 8, SEQ = 4096, DM = 1024, NT = NB * SEQ;
constexpr int CTXL = 256, NTC = NB * CTXL;
constexpr int SSM_IN = 5184, CONVD = 3072, SSM_INNER = 2048;
constexpr float ALPHA = 1.41421356237f;
constexpr int LDS_BYTES = 71168;

constexpr size_t MiB = 1ull << 20;
constexpr size_t OFF_W_IN = 0;
constexpr size_t OFF_W_OUT = OFF_W_IN + (size_t)5184 * 1024 * 2;
constexpr size_t OFF_W_HIN = OFF_W_OUT + (size_t)1024 * 2048 * 2;
constexpr size_t OFF_W_HOUT = OFF_W_HIN + (size_t)3072 * 1024 * 2;
constexpr size_t OFF_W_Q = OFF_W_HOUT + (size_t)1024 * 1024 * 2;
constexpr size_t OFF_MOD = OFF_W_Q + (size_t)2 * 2048 * 1024 * 2;
constexpr size_t OFF_HID = OFF_MOD + 512 * 1024;
constexpr size_t OFF_DT = OFF_HID + MiB;
constexpr size_t OFF_HC = OFF_DT + 8 * MiB;
constexpr size_t OFF_XBC_C = OFF_HC + 4 * MiB;
constexpr size_t OFF_XC_C = OFF_XBC_C + 12 * MiB;
constexpr size_t OFF_DT_C = OFF_XC_C + 12 * MiB;
constexpr size_t OFF_R1 = OFF_DT_C + MiB;
constexpr size_t OFF_R2 = OFF_R1 + 192 * MiB;
constexpr size_t OFF_BAR = OFF_R2 + 192 * MiB;
constexpr size_t OFF_KEYS = OFF_BAR + 16384;
constexpr size_t OFF_TW = OFF_KEYS + MiB;
constexpr size_t OFF_TAB0 = OFF_TW + 32768;
constexpr size_t WS_TOTAL = OFF_TAB0 + 33 * MiB;

struct Params {
  const float *x, *c, *ctx, *c_ctx, *ada_w, *ada_b, *ln_g, *ln_b;
  const float *m_w_in, *m_conv_w, *m_conv_b, *m_a_log, *m_dt_bias, *m_d, *m_norm_w, *m_w_out;
  const float *h_w_in, *h_conv_w, *h_conv_b, *h_f_w1, *h_f_b1, *h_f_w2, *h_f_b2, *h_f_w3, *h_freq, *h_bias, *h_w_out;
  const float *p_wq, *p_k1, *p_k2, *p_u, *p_v;
  float* out;
  char* ws;
};

typedef __bf16 bf16x2_t __attribute__((ext_vector_type(2)));
typedef float f32x2_ __attribute__((ext_vector_type(2)));
DEV u16 f2bf(float f) { __bf16 v = (__bf16)f; return __builtin_bit_cast(u16, v); }
DEV float bf2f(u16 h) { return __uint_as_float(((unsigned)h) << 16); }
DEV float bflo(unsigned w) { return __uint_as_float(w << 16); }
DEV float bfhi(unsigned w) { return __uint_as_float(w & 0xffff0000u); }
DEV unsigned pack2(float a, float b) { bf16x2_t v = __builtin_convertvector(f32x2_{a, b}, bf16x2_t); return __builtin_bit_cast(unsigned, v); }
DEV float wave_sum(float v) {
#pragma unroll
  for (int o = 32; o > 0; o >>= 1) v += __shfl_xor(v, o);
  return v;
}
DEV int otid() { int t = threadIdx.x; asm volatile("" : "+v"(t)); return t; }
DEV unsigned ordkey(float f) { unsigned u = __float_as_uint(f); return (u & 0x80000000u) ? ~u : (u | 0x80000000u); }
DEV float siluf(float v) { return v / (1.f + __expf(-v)); }
DEV f32x4 mfma16(bf16x8 a, bf16x8 b, f32x4 c) { return __builtin_amdgcn_mfma_f32_16x16x32_bf16(a, b, c, 0, 0, 0); }
DEV bf16x8 ld8(const u16* p) { return *reinterpret_cast<const bf16x8*>(p); }

template <int I>
DEV const float* karg() {
  unsigned long long v;
  asm volatile("s_load_dwordx2 %0, %1, %2\n\ts_waitcnt lgkmcnt(0)" : "=s"(v) : "s"(__builtin_amdgcn_kernarg_segment_ptr()), "n"(I * 8));
  return (const float*)(const __attribute__((address_space(1))) float*)v;
}
DEV Params fetch_params() {
  Params q;
  q.x = karg<0>(); q.c = karg<1>(); q.ctx = karg<2>(); q.c_ctx = karg<3>(); q.ada_w = karg<4>(); q.ada_b = karg<5>(); q.ln_g = karg<6>(); q.ln_b = karg<7>();
  q.m_w_in = karg<8>(); q.m_conv_w = karg<9>(); q.m_conv_b = karg<10>(); q.m_a_log = karg<11>(); q.m_dt_bias = karg<12>(); q.m_d = karg<13>();
  q.m_norm_w = karg<14>(); q.m_w_out = karg<15>();
  q.h_w_in = karg<16>(); q.h_conv_w = karg<17>(); q.h_conv_b = karg<18>(); q.h_f_w1 = karg<19>(); q.h_f_b1 = karg<20>(); q.h_f_w2 = karg<21>();
  q.h_f_b2 = karg<22>(); q.h_f_w3 = karg<23>(); q.h_freq = karg<24>(); q.h_bias = karg<25>(); q.h_w_out = karg<26>();
  q.p_wq = karg<27>(); q.p_k1 = karg<28>(); q.p_k2 = karg<29>(); q.p_u = karg<30>(); q.p_v = karg<31>();
  q.out = (float*)karg<32>(); q.ws = (char*)karg<33>();
  return q;
}

__device__ __forceinline__ void transpose_w_tile(const float* src, int srcld, int K, int N, u16* dst, int item, char* lds) {
  float* tile = (float*)lds;
  int ntn = N / 64;
  int kt = item / ntn, nt = item % ntn;
  int tid = otid();
#pragma unroll
  for (int i = 0; i < 4; ++i) {
    int r = (tid >> 4) + i * 16, c4 = (tid & 15) * 4;
    float4 v = *reinterpret_cast<const float4*>(src + (size_t)(kt * 64 + r) * srcld + nt * 64 + c4);
    tile[r * 65 + c4 + 0] = v.x; tile[r * 65 + c4 + 1] = v.y; tile[r * 65 + c4 + 2] = v.z; tile[r * 65 + c4 + 3] = v.w;
  }
  __syncthreads();
#pragma unroll
  for (int i = 0; i < 2; ++i) {
    int n = (tid >> 3) + i * 32, k8 = (tid & 7) * 8;
    uint4 o;
    o.x = pack2(tile[(k8 + 0) * 65 + n], tile[(k8 + 1) * 65 + n]);
    o.y = pack2(tile[(k8 + 2) * 65 + n], tile[(k8 + 3) * 65 + n]);
    o.z = pack2(tile[(k8 + 4) * 65 + n], tile[(k8 + 5) * 65 + n]);
    o.w = pack2(tile[(k8 + 6) * 65 + n], tile[(k8 + 7) * 65 + n]);
    *reinterpret_cast<uint4*>(dst + (size_t)(nt * 64 + n) * K + kt * 64 + k8) = o;
  }
  __syncthreads();
}

__device__ __forceinline__ void ada_item(const Params& p, int item, char* lds) {
  float* sl = (float*)lds;
  float* red = sl + 9 * 1024;
  int layer = item / 96, cg_ = item % 96;
  int tid = otid(), kq = tid >> 6, col = cg_ * 64 + (tid & 63);
  for (int e = tid; e < 9 * 1024; e += 256) {
    int r = e >> 10, k = e & 1023;
    sl[e] = siluf(r < 8 ? p.c[r * 1024 + k] : p.c_ctx[k]);
  }
  __syncthreads();
  float acc[9];
#pragma unroll
  for (int r = 0; r < 9; ++r) acc[r] = 0.f;
  const float* w = p.ada_w + (size_t)layer * 1024 * 6144 + col;
#pragma unroll 8
  for (int k = kq * 256; k < kq * 256 + 256; ++k) {
    float wv = w[(size_t)k * 6144];
#pragma unroll
    for (int r = 0; r < 9; ++r) acc[r] += sl[r * 1024 + k] * wv;
  }
#pragma unroll
  for (int r = 0; r < 9; ++r) red[(kq * 9 + r) * 64 + (tid & 63)] = acc[r];
  __syncthreads();
  if (tid < 64) {
    float* mod = (float*)(p.ws + OFF_MOD);
    float bias = p.ada_b[layer * 6144 + col];
#pragma unroll
    for (int r = 0; r < 9; ++r) {
      float s = red[(0 * 9 + r) * 64 + tid] + red[(1 * 9 + r) * 64 + tid] + red[(2 * 9 + r) * 64 + tid] + red[(3 * 9 + r) * 64 + tid];
      mod[((size_t)layer * 9 + r) * 6144 + col] = s + bias;
    }
  }
  __syncthreads();
}

__device__ __forceinline__ void hyena_mlp_item(const Params& p, int item, char* lds) {
  float* zb = (float*)lds;
  float* h1 = zb + 256;
  float* h2 = h1 + 256;
  int tid = otid(), ti = tid >> 6, j = tid & 63;
  int t = item * 4 + ti;
  const float L = 4096.f;
  if (j < 33) {
    float v;
    if (j == 0) v = (float)t / 4095.f;
    else {
      int k = (j - 1) & 15;
      float fb = 1e-4f + (float)k * ((15.f - 1e-4f) / 15.f);
      float ang = 6.283185307179586f * (float)t / L;
      float a = fb * ang;
      v = (j <= 16) ? cosf(a) : -sinf(a);
    }
    zb[ti * 64 + j] = v;
  }
  __syncthreads();
  float fr = p.h_freq[j];
  float s = p.h_f_b1[j];
#pragma unroll 3
  for (int i = 0; i < 33; ++i) s += zb[ti * 64 + i] * p.h_f_w1[i * 64 + j];
  h1[ti * 64 + j] = sinf(fr * s);
  __syncthreads();
  s = p.h_f_b2[j];
#pragma unroll 8
  for (int i = 0; i < 64; ++i) s += h1[ti * 64 + i] * p.h_f_w2[i * 64 + j];
  h2[ti * 64 + j] = sinf(fr * s);
  __syncthreads();
  s = p.h_f_b2[64 + j];
#pragma unroll 8
  for (int i = 0; i < 64; ++i) s += h2[ti * 64 + i] * p.h_f_w2[4096 + i * 64 + j];
  float* hid = (float*)(p.ws + OFF_HID);
  hid[t * 64 + j] = sinf(fr * s);
  __syncthreads();
}

__device__ __forceinline__ void phase_prologue(const Params& p, char* lds) {
  constexpr int T0 = 1296, T1 = T0 + 512, T2 = T1 + 768, T3 = T2 + 256, T4 = T3 + 512, T5 = T4 + 512, T6 = T5 + 192, T7 = T6 + 1024, T8 = T7 + 256, T9 = T8 + 16;
  for (int item = blockIdx.x; item < T9; item += gridDim.x) {
    if (item < T0) transpose_w_tile(p.m_w_in, SSM_IN, 1024, SSM_IN, (u16*)(p.ws + OFF_W_IN), item, lds);
    else if (item < T1) transpose_w_tile(p.m_w_out, 1024, 2048, 1024, (u16*)(p.ws + OFF_W_OUT), item - T0, lds);
    else if (item < T2) transpose_w_tile(p.h_w_in, 3072, 1024, 3072, (u16*)(p.ws + OFF_W_HIN), item - T1, lds);
    else if (item < T3) transpose_w_tile(p.h_w_out, 1024, 1024, 1024, (u16*)(p.ws + OFF_W_HOUT), item - T2, lds);
    else if (item < T4) transpose_w_tile(p.p_wq, 2048, 1024, 2048, (u16*)(p.ws + OFF_W_Q), item - T3, lds);
    else if (item < T5) transpose_w_tile(p.p_wq + (size_t)1024 * 2048, 2048, 1024, 2048, (u16*)(p.ws + OFF_W_Q) + (size_t)2048 * 1024, item - T4, lds);
    else if (item < T6) ada_item(p, item - T5, lds);
    else if (item < T7) hyena_mlp_item(p, item - T6, lds);
    else if (item >= T8) {
      int k = (item - T8) * 256 + threadIdx.x;
      float sn, cs;
      sincospif((float)k * (1.f / 4096.f), &sn, &cs);
      ((float2*)(p.ws + OFF_TW))[k] = make_float2(cs, -sn);
    } else {
      int e8 = ((item - T7) * 256 + threadIdx.x) * 8;
      const float* src = e8 < 262144 ? p.p_k1 + e8 : p.p_k2 + (e8 - 262144);
      float4 a0 = *reinterpret_cast<const float4*>(src), a1 = *reinterpret_cast<const float4*>(src + 4);
      uint4 o;
      o.x = pack2(a0.x, a0.y); o.y = pack2(a0.z, a0.w); o.z = pack2(a1.x, a1.y); o.w = pack2(a1.z, a1.w);
      *reinterpret_cast<uint4*>((u16*)(p.ws + OFF_KEYS) + e8) = o;
    }
  }
}

__device__ __forceinline__ void modulate_rows(const float* src, u16* dst, int nrows, int rows_per_batch, const float* modbase, int sh_off, int sc_off, bool ctxrow) {
  size_t total = (size_t)nrows * 128;
  for (size_t e = (size_t)blockIdx.x * 256 + threadIdx.x; e < total; e += (size_t)gridDim.x * 256) {
    int row = (int)(e >> 7), c8 = (int)(e & 127) * 8;
    int b = ctxrow ? 8 : row / rows_per_batch;
    const float* m = modbase + (size_t)b * 6144;
    float4 a0 = *reinterpret_cast<const float4*>(src + (size_t)row * 1024 + c8);
    float4 a1 = *reinterpret_cast<const float4*>(src + (size_t)row * 1024 + c8 + 4);
    float4 s0 = *reinterpret_cast<const float4*>(m + sc_off + c8);
    float4 s1 = *reinterpret_cast<const float4*>(m + sc_off + c8 + 4);
    float4 h0 = *reinterpret_cast<const float4*>(m + sh_off + c8);
    float4 h1 = *reinterpret_cast<const float4*>(m + sh_off + c8 + 4);
    uint4 o;
    o.x = pack2(a0.x * (1.f + s0.x) + h0.x, a0.y * (1.f + s0.y) + h0.y);
    o.y = pack2(a0.z * (1.f + s0.z) + h0.z, a0.w * (1.f + s0.w) + h0.w);
    o.z = pack2(a1.x * (1.f + s1.x) + h1.x, a1.y * (1.f + s1.y) + h1.y);
    o.w = pack2(a1.z * (1.f + s1.z) + h1.z, a1.w * (1.f + s1.w) + h1.w);
    *reinterpret_cast<uint4*>(dst + (size_t)row * 1024 + c8) = o;
  }
}

constexpr int GLD = 72;
template <class Epi>
__device__ __forceinline__ void gemm_tile(const u16* __restrict__ A, int lda, const u16* __restrict__ Bt, int ldb, int brow, int bcol, int Nmax,
                                          int K, char* lds, Epi epi) {
  u16* SA = (u16*)lds;
  u16* SB = SA + 256 * GLD;
  int tid = otid(), wid = tid >> 6, lane = tid & 63, wr = wid >> 1, wc = wid & 1, fr = lane & 15, fq = lane >> 4;
  f32x4 acc[8][4];
#pragma unroll
  for (int m = 0; m < 8; ++m)
#pragma unroll
    for (int n = 0; n < 4; ++n) acc[m][n] = f32x4{0.f, 0.f, 0.f, 0.f};
  u32x4 ra[8], rb[4];
  const int lr = tid >> 3, lc = (tid & 7) * 8;
  const u16* abase = A + (size_t)brow * lda;
  const unsigned aoff = (unsigned)(lr * lda + lc);
  unsigned bo[4];
#pragma unroll
  for (int i = 0; i < 4; ++i) {
    int br = bcol + lr + i * 32;
    if (br >= Nmax) br = Nmax - 1;
    bo[i] = (unsigned)(br * ldb + lc);
  }
#define GLOADT(KT)                                                                                 \
  _Pragma("unroll") for (int i = 0; i < 8; ++i)                                                    \
    ra[i] = *reinterpret_cast<const u32x4*>(abase + (aoff + (unsigned)((i * 32) * lda + (KT) * 64))); \
  _Pragma("unroll") for (int i = 0; i < 4; ++i)                                                    \
    rb[i] = *reinterpret_cast<const u32x4*>(Bt + (bo[i] + (unsigned)((KT) * 64)));
  const int nk = K / 64;
  GLOADT(0)
  for (int kt = 0; kt < nk; ++kt) {
#pragma unroll
    for (int i = 0; i < 8; ++i) *reinterpret_cast<u32x4*>(SA + (lr + i * 32) * GLD + lc) = ra[i];
#pragma unroll
    for (int i = 0; i < 4; ++i) *reinterpret_cast<u32x4*>(SB + (lr + i * 32) * GLD + lc) = rb[i];
    __syncthreads();
    { const int kn = kt + 1 < nk ? kt + 1 : nk - 1; GLOADT(kn) }
#pragma unroll
    for (int kk = 0; kk < 2; ++kk) {
      bf16x8 Bl[4];
#pragma unroll
      for (int n = 0; n < 4; ++n) Bl[n] = ld8(SB + (wc * 64 + n * 16 + fr) * GLD + kk * 32 + fq * 8);
#pragma unroll
      for (int mh = 0; mh < 2; ++mh) {
        bf16x8 At[4];
#pragma unroll
        for (int m = 0; m < 4; ++m) At[m] = ld8(SA + (wr * 128 + (mh * 4 + m) * 16 + fr) * GLD + kk * 32 + fq * 8);
#pragma unroll
        for (int m = 0; m < 4; ++m)
#pragma unroll
          for (int n = 0; n < 4; ++n) acc[mh * 4 + m][n] = mfma16(Bl[n], At[m], acc[mh * 4 + m][n]);
      }
    }
    __syncthreads();
  }
#undef GLOADT
#pragma unroll
  for (int m = 0; m < 8; ++m)
#pragma unroll
    for (int n = 0; n < 4; ++n) epi(brow + wr * 128 + m * 16 + fr, bcol + wc * 64 + n * 16 + fq * 4, acc[m][n]);
}

DEV float softplusf(float v) { return fmaxf(v, 0.f) + log1pf(__expf(-fabsf(v))); }

__device__ __forceinline__ void phase_gemm_inproj(const Params& p, char* lds) {
  const u16* hx = (const u16*)(p.ws + OFF_R2);
  const u16* hc = (const u16*)(p.ws + OFF_HC);
  const u16* Wt = (const u16*)(p.ws + OFF_W_IN);
  u16* zbuf = (u16*)p.out;
  u16* xbc = (u16*)(p.ws + OFF_R1);
  float* dt = (float*)(p.ws + OFF_DT);
  u16* xbc_c = (u16*)(p.ws + OFF_XBC_C);
  float* dt_c = (float*)(p.ws + OFF_DT_C);
  const float* dtb = p.m_dt_bias;
  const int xcd = blockIdx.x & 7, li = blockIdx.x >> 3, nl = gridDim.x >> 3;
  auto epi_lat = [=](int m, int n, f32x4 v) {
    if (n < 2048) *reinterpret_cast<uint2*>(zbuf + (size_t)m * 2048 + n) = make_uint2(pack2(v[0], v[1]), pack2(v[2], v[3]));
    else if (n < 5120) *reinterpret_cast<uint2*>(xbc + (size_t)m * 3072 + (n - 2048)) = make_uint2(pack2(v[0], v[1]), pack2(v[2], v[3]));
    else if (n < 5184) {
      float4 bb = *reinterpret_cast<const float4*>(dtb + (n - 5120));
      *reinterpret_cast<float4*>(dt + (size_t)m * 64 + (n - 5120)) = make_float4(softplusf(v[0] + bb.x), softplusf(v[1] + bb.y), softplusf(v[2] + bb.z), softplusf(v[3] + bb.w));
    }
  };
  auto epi_ctx = [=](int m, int n, f32x4 v) {
    if (n < 3072) *reinterpret_cast<uint2*>(xbc_c + (size_t)m * 3072 + n) = make_uint2(pack2(v[0], v[1]), pack2(v[2], v[3]));
    else if (n < 3136) {
      float4 bb = *reinterpret_cast<const float4*>(dtb + (n - 3072));
      *reinterpret_cast<float4*>(dt_c + (size_t)m * 64 + (n - 3072)) = make_float4(softplusf(v[0] + bb.x), softplusf(v[1] + bb.y), softplusf(v[2] + bb.z), softplusf(v[3] + bb.w));
    }
  };
  for (int t = li; t < 128 * 5; t += nl) {
    int pm = t / 5, pn = xcd + 8 * (t % 5);
    gemm_tile(hx, 1024, Wt, 1024, pm * 256, pn * 128, SSM_IN, 1024, lds, epi_lat);
  }
  for (int t = blockIdx.x; t < 128 + 8 * 25; t += gridDim.x) {
    if (t < 128) gemm_tile(hx, 1024, Wt, 1024, t * 256, 40 * 128, SSM_IN, 1024, lds, epi_lat);
    else {
      int it = t - 128, pm = it / 25, pn = it % 25;
      gemm_tile(hc, 1024, Wt + (size_t)2048 * 1024, 1024, pm * 256, pn * 128, 3136, 1024, lds, epi_ctx);
    }
  }
}

DEV void fma8(float* acc, const u32x4& v, const float* w) {
  acc[0] += bflo(v[0]) * w[0]; acc[1] += bfhi(v[0]) * w[1]; acc[2] += bflo(v[1]) * w[2]; acc[3] += bfhi(v[1]) * w[3];
  acc[4] += bflo(v[2]) * w[4]; acc[5] += bfhi(v[2]) * w[5]; acc[6] += bflo(v[3]) * w[6]; acc[7] += bfhi(v[3]) * w[7];
}
__device__ __forceinline__ void phase_conv(const Params& p) {
  const u16* xbc = (const u16*)(p.ws + OFF_R1);
  u16* xc = (u16*)(p.ws + OFF_R2);
  const u16* xbc_c = (const u16*)(p.ws + OFF_XBC_C);
  u16* xc_c = (u16*)(p.ws + OFF_XC_C);
  const float* cw = p.m_conv_w;
  const float* cb = p.m_conv_b;
  const int tid_ = otid();
  const size_t nl = (size_t)8 * 64 * 8 * 384;
  for (size_t e = (size_t)blockIdx.x * 256 + tid_; e < nl; e += (size_t)gridDim.x * 256) {
    int ch = (int)(e % 384) * 8;
    int rest = (int)(e / 384);
    int cg_ = rest & 7, r = (rest >> 3) & 63, b = rest >> 9;
    float w[9][8];
#pragma unroll
    for (int k = 0; k < 9; ++k) {
      float4 w0 = *reinterpret_cast<const float4*>(cw + k * 3072 + ch), w1 = *reinterpret_cast<const float4*>(cw + k * 3072 + ch + 4);
      w[k][0] = w0.x; w[k][1] = w0.y; w[k][2] = w0.z; w[k][3] = w0.w; w[k][4] = w1.x; w[k][5] = w1.y; w[k][6] = w1.z; w[k][7] = w1.w;
    }
    float bias[8];
    {
      float4 b0 = *reinterpret_cast<const float4*>(cb + ch), b1 = *reinterpret_cast<const float4*>(cb + ch + 4);
      bias[0] = b0.x; bias[1] = b0.y; bias[2] = b0.z; bias[3] = b0.w; bias[4] = b1.x; bias[5] = b1.y; bias[6] = b1.z; bias[7] = b1.w;
    }
    const u32x4 zero4 = u32x4{0u, 0u, 0u, 0u};
    const int c0 = cg_ * 8;
    u32x4 win[3][3];
#pragma unroll
    for (int i = 0; i < 3; ++i) {
      int rr = r + i - 1;
      bool rok = rr >= 0 && rr <= 63;
      const u16* rowp = xbc + ((size_t)(b * 4096 + (rok ? rr : r) * 64)) * 3072 + ch;
      win[i][0] = (rok && c0 > 0) ? *reinterpret_cast<const u32x4*>(rowp + (size_t)(c0 - 1) * 3072) : zero4;
      win[i][1] = rok ? *reinterpret_cast<const u32x4*>(rowp + (size_t)c0 * 3072) : zero4;
    }
#pragma unroll
    for (int cc = 0; cc < 8; ++cc) {
      int c = c0 + cc;
#pragma unroll
      for (int i = 0; i < 3; ++i) {
        int rr = r + i - 1;
        bool rok = rr >= 0 && rr <= 63;
        const u16* rowp = xbc + ((size_t)(b * 4096 + (rok ? rr : r) * 64)) * 3072 + ch;
        win[i][2] = (rok && c < 63) ? *reinterpret_cast<const u32x4*>(rowp + (size_t)(c + 1) * 3072) : zero4;
      }
      float acc[8];
#pragma unroll
      for (int k = 0; k < 8; ++k) acc[k] = bias[k];
#pragma unroll
      for (int i = 0; i < 3; ++i)
#pragma unroll
        for (int j = 0; j < 3; ++j) fma8(acc, win[i][j], w[i * 3 + j]);
      uint4 o;
      o.x = pack2(siluf(acc[0]), siluf(acc[1]));
      o.y = pack2(siluf(acc[2]), siluf(acc[3]));
      o.z = pack2(siluf(acc[4]), siluf(acc[5]));
      o.w = pack2(siluf(acc[6]), siluf(acc[7]));
      *reinterpret_cast<uint4*>(xc + ((size_t)(b * 4096 + r * 64 + c)) * 3072 + ch) = o;
#pragma unroll
      for (int i = 0; i < 3; ++i) { win[i][0] = win[i][1]; win[i][1] = win[i][2]; }
    }
  }
  const size_t ncx = (size_t)NTC * 384;
  for (size_t e = (size_t)blockIdx.x * 256 + tid_; e < ncx; e += (size_t)gridDim.x * 256) {
    int tok = (int)(e / 384), ch = (int)(e % 384) * 8;
    float acc[8];
#pragma unroll
    for (int k = 0; k < 8; ++k) acc[k] = cb[ch + k];
    int b = tok >> 8, c = tok & 255;
#pragma unroll
    for (int j = 0; j < 3; ++j) {
      int cc = c + j - 1;
      if (cc < 0 || cc > 255) continue;
      uint4 v = *reinterpret_cast<const uint4*>(xbc_c + ((size_t)(b * 256 + cc)) * 3072 + ch);
      const float* w = cw + (3 + j) * 3072 + ch;
      float4 w0 = *reinterpret_cast<const float4*>(w), w1 = *reinterpret_cast<const float4*>(w + 4);
      acc[0] += bflo(v.x) * w0.x; acc[1] += bfhi(v.x) * w0.y; acc[2] += bflo(v.y) * w0.z; acc[3] += bfhi(v.y) * w0.w;
      acc[4] += bflo(v.z) * w1.x; acc[5] += bfhi(v.z) * w1.y; acc[6] += bflo(v.w) * w1.z; acc[7] += bfhi(v.w) * w1.w;
    }
    uint4 o;
    o.x = pack2(siluf(acc[0]), siluf(acc[1]));
    o.y = pack2(siluf(acc[2]), siluf(acc[3]));
    o.z = pack2(siluf(acc[4]), siluf(acc[5]));
    o.w = pack2(siluf(acc[6]), siluf(acc[7]));
    *reinterpret_cast<uint4*>(xc_c + (size_t)tok * 3072 + ch) = o;
  }
}

constexpr int SLD = 136;
__device__ __forceinline__ void phase_ssd(const Params& p, char* lds) {
  u16* xsT = (u16*)lds;
  u16* stb = xsT + 64 * SLD;
  u16* Mb = stb + 64 * SLD;
  float* cum = (float*)(Mb + 128 * SLD);
  float* dtv = cum + 128;
  float* asrc = dtv + 128;
  const u16* xc = (const u16*)(p.ws + OFF_R2);
  const u16* xc_c = (const u16*)(p.ws + OFF_XC_C);
  const float* dt = (const float*)(p.ws + OFF_DT);
  const float* dt_c = (const float*)(p.ws + OFF_DT_C);
  u16* y = (u16*)(p.ws + OFF_R1);
  int tid = otid(), w = tid >> 6, lane = tid & 63, fr = lane & 15, fq = lane >> 4;
  unsigned char* yb8 = (unsigned char*)(p.ws + OFF_R1 + 128 * MiB);
  for (int item = blockIdx.x; item < 512; item += gridDim.x) {
    int b = item >> 6, h = (item >> 1) & 31, g = h >> 3;
    float dsk = p.m_d[h];
    {
      const int dir = item & 1;
      float a_neg = -__expf(p.m_a_log[dir * 32 + h]);
      f32x4 acc_s[8];
#pragma unroll
      for (int n = 0; n < 8; ++n) acc_s[n] = f32x4{0.f, 0.f, 0.f, 0.f};
      for (int step = 0; step < 34; ++step) {
        bool isctx = step < 2;
        int cidx = isctx ? step : step - 2;
        if (dir) cidx = (isctx ? 1 : 31) - cidx;
        size_t tok0 = isctx ? (size_t)(b * 256 + cidx * 128) : (size_t)(b * 4096 + cidx * 128);
        const u16* src = (isctx ? xc_c : xc) + tok0 * 3072;
        const float* dts = (isctx ? dt_c : dt) + tok0 * 64;
        int tz = tid;
        asm volatile("" : "+v"(tz));
        float dval = 0.f;
        if (tid < 128) dval = dts[tid * 64 + dir * 32 + h];
        uint4 xv[4], bv[8];
#pragma unroll
        for (int i = 0; i < 4; ++i) {
          int idx = tz + i * 256, l = (idx & 31) | ((idx >> 8) << 5), pc = ((idx >> 5) & 7) * 8;
          xv[i] = *reinterpret_cast<const uint4*>(src + (size_t)l * 3072 + h * 64 + pc);
        }
#pragma unroll
        for (int i = 0; i < 8; ++i) {
          int idx = tz + i * 256, l = (idx & 31) | (((idx >> 9) & 3) << 5), nc = (((idx >> 5) & 7) | (((idx >> 8) & 1) << 3)) * 8;
          bv[i] = *reinterpret_cast<const uint4*>(src + (size_t)l * 3072 + 2048 + g * 128 + nc);
        }
        if (tid < 128) { dtv[tid] = dval; asrc[tid] = dval * a_neg; }
#pragma unroll
        for (int i = 0; i < 4; ++i) {
          int idx = tz + i * 256, l = (idx & 31) | ((idx >> 8) << 5), pc = ((idx >> 5) & 7) * 8;
          uint4 v = xv[i];
          xsT[(pc + 0) * SLD + l] = (u16)(v.x & 0xffff); xsT[(pc + 1) * SLD + l] = (u16)(v.x >> 16);
          xsT[(pc + 2) * SLD + l] = (u16)(v.y & 0xffff); xsT[(pc + 3) * SLD + l] = (u16)(v.y >> 16);
          xsT[(pc + 4) * SLD + l] = (u16)(v.z & 0xffff); xsT[(pc + 5) * SLD + l] = (u16)(v.z >> 16);
          xsT[(pc + 6) * SLD + l] = (u16)(v.w & 0xffff); xsT[(pc + 7) * SLD + l] = (u16)(v.w >> 16);
        }
        if (!isctx) {
#pragma unroll
          for (int i = 0; i < 8; ++i) {
            int idx = tz + i * 256, l = (idx & 31) | (((idx >> 9) & 3) << 5), nc = (((idx >> 5) & 7) | (((idx >> 8) & 1) << 3)) * 8;
            *reinterpret_cast<uint4*>(Mb + l * SLD + nc) = bv[i];
          }
        }
        __syncthreads();
        bf16x8 Cf[2][4];
        if (!isctx) {
#pragma unroll
          for (int mt = 0; mt < 2; ++mt)
#pragma unroll
            for (int kk = 0; kk < 4; ++kk) Cf[mt][kk] = ld8(src + (size_t)(w * 32 + mt * 16 + fr) * 3072 + 2560 + g * 128 + kk * 32 + fq * 8);
        }
        if (tid < 128) {
          float s = 0.f;
          if (!dir) { for (int j = 0; j <= tid; ++j) s += asrc[j]; }
          else { for (int j = tid; j < 128; ++j) s += asrc[j]; }
          cum[tid] = s;
        }
        __syncthreads();
        float total = dir ? cum[0] : cum[127];
        if (!isctx) {
          float cl[2][4];
#pragma unroll
          for (int mt = 0; mt < 2; ++mt)
#pragma unroll
            for (int j = 0; j < 4; ++j) cl[mt][j] = cum[w * 32 + mt * 16 + fq * 4 + j];
          f32x4 cb0[8], cb1[8];
#pragma unroll
          for (int nt = 0; nt < 8; ++nt) {
            cb0[nt] = f32x4{0.f, 0.f, 0.f, 0.f};
            cb1[nt] = f32x4{0.f, 0.f, 0.f, 0.f};
            bool need = dir ? (nt >= w * 2) : (nt <= w * 2 + 1);
            if (need) {
#pragma unroll
              for (int kk = 0; kk < 4; ++kk) {
                bf16x8 Bf = ld8(Mb + (nt * 16 + fr) * SLD + kk * 32 + fq * 8);
                cb0[nt] = mfma16(Cf[0][kk], Bf, cb0[nt]);
                cb1[nt] = mfma16(Cf[1][kk], Bf, cb1[nt]);
              }
            }
          }
          __syncthreads();
          int zero = 0;
          asm volatile("" : "+v"(zero));
#pragma unroll
          for (int nt = 0; nt < 8; ++nt) {
            int s = nt * 16 + fr + zero;
            float cs = cum[s], ds = dtv[s];
#pragma unroll
            for (int j = 0; j < 4; ++j) {
              int l0 = w * 32 + fq * 4 + j, l1 = l0 + 16;
              bool ok0 = dir ? (s >= l0) : (s <= l0);
              bool ok1 = dir ? (s >= l1) : (s <= l1);
              float v0 = ok0 ? cb0[nt][j] * __expf(cl[0][j] - cs) * ds : 0.f;
              float v1 = ok1 ? cb1[nt][j] * __expf(cl[1][j] - cs) * ds : 0.f;
              Mb[l0 * SLD + s] = f2bf(v0);
              Mb[l1 * SLD + s] = f2bf(v1);
            }
          }
          __syncthreads();
          f32x4 ya[2][4];
#pragma unroll
          for (int mt = 0; mt < 2; ++mt)
#pragma unroll
            for (int nt = 0; nt < 4; ++nt) ya[mt][nt] = f32x4{0.f, 0.f, 0.f, 0.f};
#pragma unroll
          for (int kk = 0; kk < 4; ++kk)
#pragma unroll
            for (int nt = 0; nt < 4; ++nt) {
              bf16x8 Sf = ld8(stb + (nt * 16 + fr) * SLD + kk * 32 + fq * 8);
              ya[0][nt] = mfma16(Sf, Cf[0][kk], ya[0][nt]);
              ya[1][nt] = mfma16(Sf, Cf[1][kk], ya[1][nt]);
            }
#pragma unroll
          for (int mt = 0; mt < 2; ++mt) {
            float e = __expf(cum[w * 32 + mt * 16 + fr]);
#pragma unroll
            for (int nt = 0; nt < 4; ++nt) ya[mt][nt] *= e;
          }
#pragma unroll
          for (int kk = 0; kk < 4; ++kk) {
            bf16x8 Mf0 = ld8(Mb + (w * 32 + fr) * SLD + kk * 32 + fq * 8);
            bf16x8 Mf1 = ld8(Mb + (w * 32 + 16 + fr) * SLD + kk * 32 + fq * 8);
#pragma unroll
            for (int nt = 0; nt < 4; ++nt) {
              bf16x8 Xf = ld8(xsT + (nt * 16 + fr) * SLD + kk * 32 + fq * 8);
              ya[0][nt] = mfma16(Xf, Mf0, ya[0][nt]);
              ya[1][nt] = mfma16(Xf, Mf1, ya[1][nt]);
            }
          }
#pragma unroll
          for (int i = 0; i < 8; ++i) {
            int idx = tz + i * 256, l = (idx & 31) | (((idx >> 9) & 3) << 5), nc = (((idx >> 5) & 7) | (((idx >> 8) & 1) << 3)) * 8;
            bv[i] = *reinterpret_cast<const uint4*>(src + (size_t)l * 3072 + 2048 + g * 128 + nc);
          }
#pragma unroll
          for (int mt = 0; mt < 2; ++mt)
#pragma unroll
            for (int nt = 0; nt < 4; ++nt) {
              const int l = w * 32 + mt * 16 + fr, p0 = nt * 16 + fq * 4;
              f32x4 v = ya[mt][nt];
              if (!dir) {
                v[0] += bf2f(xsT[(p0 + 0) * SLD + l]) * dsk; v[1] += bf2f(xsT[(p0 + 1) * SLD + l]) * dsk;
                v[2] += bf2f(xsT[(p0 + 2) * SLD + l]) * dsk; v[3] += bf2f(xsT[(p0 + 3) * SLD + l]) * dsk;
                *reinterpret_cast<uint2*>(y + (tok0 + l) * 2048 + h * 64 + p0) = make_uint2(pack2(v[0], v[1]), pack2(v[2], v[3]));
              } else {
                int pk = __builtin_amdgcn_cvt_pk_fp8_f32(fminf(fmaxf(v[0] * 4.f, -440.f), 440.f), fminf(fmaxf(v[1] * 4.f, -440.f), 440.f), 0, false);
                pk = __builtin_amdgcn_cvt_pk_fp8_f32(fminf(fmaxf(v[2] * 4.f, -440.f), 440.f), fminf(fmaxf(v[3] * 4.f, -440.f), 440.f), pk, true);
                *reinterpret_cast<int*>(yb8 + (tok0 + l) * 2048 + h * 64 + p0) = pk;
              }
            }
        }
        if (step == 33) continue;
        __syncthreads();
#pragma unroll
        for (int i = 0; i < 8; ++i) {
          int idx = tz + i * 256, l = (idx & 31) | (((idx >> 9) & 3) << 5), nc = (((idx >> 5) & 7) | (((idx >> 8) & 1) << 3)) * 8;
          uint4 v = bv[i];
          float sc = dtv[l] * __expf(total - cum[l]);
          Mb[(nc + 0) * SLD + l] = f2bf(bflo(v.x) * sc); Mb[(nc + 1) * SLD + l] = f2bf(bfhi(v.x) * sc);
          Mb[(nc + 2) * SLD + l] = f2bf(bflo(v.y) * sc); Mb[(nc + 3) * SLD + l] = f2bf(bfhi(v.y) * sc);
          Mb[(nc + 4) * SLD + l] = f2bf(bflo(v.z) * sc); Mb[(nc + 5) * SLD + l] = f2bf(bfhi(v.z) * sc);
          Mb[(nc + 6) * SLD + l] = f2bf(bflo(v.w) * sc); Mb[(nc + 7) * SLD + l] = f2bf(bfhi(v.w) * sc);
        }
        __syncthreads();
        float cd = __expf(total);
#pragma unroll
        for (int nt = 0; nt < 8; ++nt) acc_s[nt] *= cd;
#pragma unroll
        for (int kk = 0; kk < 4; ++kk) {
          bf16x8 Af = ld8(xsT + (w * 16 + fr) * SLD + kk * 32 + fq * 8);
#pragma unroll
          for (int nt = 0; nt < 8; ++nt) {
            bf16x8 Bf = ld8(Mb + (nt * 16 + fr) * SLD + kk * 32 + fq * 8);
            acc_s[nt] = mfma16(Af, Bf, acc_s[nt]);
          }
        }
#pragma unroll
        for (int nt = 0; nt < 8; ++nt)
#pragma unroll
          for (int j = 0; j < 4; ++j) stb[(w * 16 + fq * 4 + j) * SLD + nt * 16 + fr] = f2bf(acc_s[nt][j]);
        __syncthreads();
      }
      __syncthreads();
    }
  }
}

__device__ __forceinline__ void phase_gated_norm(const Params& p) {
  u16* y = (u16*)(p.ws + OFF_R1);
  const u16* z = (const u16*)p.out;
  const unsigned char* yb8 = (const unsigned char*)(p.ws + OFF_R1 + 128 * MiB);
  const int tid_ = otid();
  int lane = tid_ & 63;
  int wave = blockIdx.x * 4 + (tid_ >> 6), nw = gridDim.x * 4;
  for (int tok = wave; tok < NT; tok += nw) {
#pragma unroll
    for (int g = 0; g < 4; ++g) {
      int ch = g * 512 + lane * 8;
      uint4 yv = *reinterpret_cast<const uint4*>(y + (size_t)tok * 2048 + ch);
      uint4 zv = *reinterpret_cast<const uint4*>(z + (size_t)tok * 2048 + ch);
      uint2 bw = *reinterpret_cast<const uint2*>(yb8 + (size_t)tok * 2048 + ch);
      f32x2 b01 = __builtin_amdgcn_cvt_pk_f32_fp8((int)bw.x, false), b23 = __builtin_amdgcn_cvt_pk_f32_fp8((int)bw.x, true);
      f32x2 b45 = __builtin_amdgcn_cvt_pk_f32_fp8((int)bw.y, false), b67 = __builtin_amdgcn_cvt_pk_f32_fp8((int)bw.y, true);
      const float r16 = 0.25f;
      float u[8];
      u[0] = (bflo(yv.x) + b01.x * r16) * siluf(bflo(zv.x)); u[1] = (bfhi(yv.x) + b01.y * r16) * siluf(bfhi(zv.x));
      u[2] = (bflo(yv.y) + b23.x * r16) * siluf(bflo(zv.y)); u[3] = (bfhi(yv.y) + b23.y * r16) * siluf(bfhi(zv.y));
      u[4] = (bflo(yv.z) + b45.x * r16) * siluf(bflo(zv.z)); u[5] = (bfhi(yv.z) + b45.y * r16) * siluf(bfhi(zv.z));
      u[6] = (bflo(yv.w) + b67.x * r16) * siluf(bflo(zv.w)); u[7] = (bfhi(yv.w) + b67.y * r16) * siluf(bfhi(zv.w));
      float ss = 0.f;
#pragma unroll
      for (int k = 0; k < 8; ++k) ss += u[k] * u[k];
      ss = wave_sum(ss);
      float sc = rsqrtf(ss * (1.f / 512.f) + 1e-5f);
      float4 w0 = *reinterpret_cast<const float4*>(p.m_norm_w + ch), w1 = *reinterpret_cast<const float4*>(p.m_norm_w + ch + 4);
      uint4 o;
      o.x = pack2(u[0] * sc * w0.x, u[1] * sc * w0.y);
      o.y = pack2(u[2] * sc * w0.z, u[3] * sc * w0.w);
      o.z = pack2(u[4] * sc * w1.x, u[5] * sc * w1.y);
      o.w = pack2(u[6] * sc * w1.z, u[7] * sc * w1.w);
      *reinterpret_cast<uint4*>(y + (size_t)tok * 2048 + ch) = o;
    }
  }
}

__device__ __forceinline__ void phase_gemm_resid(const u16* A, int K, const u16* Wt, const float* res, float* dst, const float* gate  , char* lds) {
  const int xcd = blockIdx.x & 7, li = blockIdx.x >> 3, nl = gridDim.x >> 3;
  for (int t = li; t < 128; t += nl) {
    int pm = t, pn = xcd;
    gemm_tile(A, K, Wt, K, pm * 256, pn * 128, 1024, K, lds, [=](int m, int n, f32x4 v) {
      int b = m >> 12;
      float4 r = *reinterpret_cast<const float4*>(res + (size_t)m * 1024 + n);
      float4 g = *reinterpret_cast<const float4*>(gate + (size_t)b * 6144 + n);
      *reinterpret_cast<float4*>(dst + (size_t)m * 1024 + n) = make_float4(ALPHA * r.x + g.x * v[0], ALPHA * r.y + g.y * v[1], ALPHA * r.z + g.z * v[2], ALPHA * r.w + g.w * v[3]);
    });
  }
}
__device__ __forceinline__ void phase_gemm_bf16(const u16* A, const u16* Wt, u16* dst, int N, char* lds) {
  const int xcd = blockIdx.x & 7, li = blockIdx.x >> 3, nl = gridDim.x >> 3;
  const int nb = N / 1024;
  for (int t = li; t < 128 * nb; t += nl) {
    int pm = t / nb, pn = xcd + 8 * (t % nb);
    gemm_tile(A, 1024, Wt, 1024, pm * 256, pn * 128, N, 1024, lds, [=](int m, int n, f32x4 v) { *reinterpret_cast<uint2*>(dst + (size_t)m * N + n) = make_uint2(pack2(v[0], v[1]), pack2(v[2], v[3])); });
  }
}

__device__ __forceinline__ void phase_ln_mod(float* xio, const float* g, const float* bta, const float* mod  , u16* tdst) {
  const int tid_ = otid();
  int lane = tid_ & 63;
  int wave = blockIdx.x * 4 + (tid_ >> 6), nw = gridDim.x * 4;
  for (int tok = wave; tok < NT; tok += nw) {
    int b = tok >> 12;
    float4 v[4];
    float s = 0.f;
#pragma unroll
    for (int i = 0; i < 4; ++i) {
      v[i] = *reinterpret_cast<const float4*>(xio + (size_t)tok * 1024 + i * 256 + lane * 4);
      s += v[i].x + v[i].y + v[i].z + v[i].w;
    }
    float mu = wave_sum(s) * (1.f / 1024.f);
    float q = 0.f;
#pragma unroll
    for (int i = 0; i < 4; ++i) {
      v[i].x -= mu; v[i].y -= mu; v[i].z -= mu; v[i].w -= mu;
      q += v[i].x * v[i].x + v[i].y * v[i].y + v[i].z * v[i].z + v[i].w * v[i].w;
    }
    float rs = rsqrtf(wave_sum(q) * (1.f / 1024.f) + 1e-5f);
    const float* m = mod + (size_t)b * 6144;
#pragma unroll
    for (int i = 0; i < 4; ++i) {
      int c = i * 256 + lane * 4;
      float4 gg = *reinterpret_cast<const float4*>(g + c), bb = *reinterpret_cast<const float4*>(bta + c);
      float4 o;
      o.x = v[i].x * rs * gg.x + bb.x; o.y = v[i].y * rs * gg.y + bb.y; o.z = v[i].z * rs * gg.z + bb.z; o.w = v[i].w * rs * gg.w + bb.w;
      *reinterpret_cast<float4*>(xio + (size_t)tok * 1024 + c) = o;
      float4 sh = *reinterpret_cast<const float4*>(m + 3072 + c), sc = *reinterpret_cast<const float4*>(m + 4096 + c);
      uint2 t;
      t.x = pack2(o.x * (1.f + sc.x) + sh.x, o.y * (1.f + sc.y) + sh.y);
      t.y = pack2(o.z * (1.f + sc.z) + sh.z, o.w * (1.f + sc.w) + sh.w);
      *reinterpret_cast<uint2*>(tdst + (size_t)tok * 1024 + c) = t;
    }
  }
}

__device__ __forceinline__ void phase_peer_topk(const u16* q, const u16* k1, const u16* k2, int* idxo, float* gateo, char* lds) {
  float* S = (float*)lds;
  float* sv = S + 64 * 129;
  int* si = (int*)(sv + 64 * 16);
  int tid = otid(), w = tid >> 6, lane = tid & 63, fr = lane & 15, fq = lane >> 4;
  const int slot = lane;
  const bool cvalid = lane < 50;
  int ci = slot < 42 ? ((slot >= 16) + (slot >= 24) + (slot >= 29) + (slot >= 33) + (slot >= 36) + (slot >= 38) + (slot >= 40)) : slot - 34;
  const unsigned long long PACK = 0ull | (16ull << 8) | (24ull << 16) | (29ull << 24) | (33ull << 32) | (36ull << 40) | (38ull << 48) | (40ull << 56);
  int cj = slot - (ci < 8 ? (int)((PACK >> (8 * ci)) & 0xFF) : 34 + ci);
  if (!cvalid) { ci = 0; cj = 0; }
  for (int item = blockIdx.x; item < 1024 * 8; item += gridDim.x) {
    int tile = item >> 3, h = item & 7;
    int tok0 = tile * 32;
    {
      int half = w >> 1, kb = (w & 1) * 64;
      const u16* kk_ = (half ? k2 : k1) + (size_t)h * 128 * 128;
      bf16x8 Af[2][4], Bf[4][4];
#pragma unroll
      for (int m = 0; m < 2; ++m)
#pragma unroll
        for (int ks = 0; ks < 4; ++ks) Af[m][ks] = ld8(q + (size_t)(tok0 + m * 16 + fr) * 2048 + h * 256 + half * 128 + ks * 32 + fq * 8);
#pragma unroll
      for (int n = 0; n < 4; ++n)
#pragma unroll
        for (int ks = 0; ks < 4; ++ks) Bf[n][ks] = ld8(kk_ + (size_t)(kb + n * 16 + fr) * 128 + ks * 32 + fq * 8);
      f32x4 acc[2][4];
#pragma unroll
      for (int m = 0; m < 2; ++m)
#pragma unroll
        for (int n = 0; n < 4; ++n) acc[m][n] = f32x4{0.f, 0.f, 0.f, 0.f};
#pragma unroll
      for (int ks = 0; ks < 4; ++ks)
#pragma unroll
        for (int n = 0; n < 4; ++n) {
          acc[0][n] = mfma16(Af[0][ks], Bf[n][ks], acc[0][n]);
          acc[1][n] = mfma16(Af[1][ks], Bf[n][ks], acc[1][n]);
        }
#pragma unroll
      for (int m = 0; m < 2; ++m)
#pragma unroll
        for (int n = 0; n < 4; ++n)
#pragma unroll
          for (int j = 0; j < 4; ++j) S[(half * 32 + m * 16 + fq * 4 + j) * 129 + kb + n * 16 + fr] = acc[m][n][j];
    }
    __syncthreads();
#pragma unroll 1
    for (int li = 0; li < 16; ++li) {
      int list = w * 16 + li;
      const float* row = S + list * 129;
      float vlo = row[lane], vhi = row[lane + 64];
      unsigned klo = (ordkey(vlo) & 0xFFFFFF80u) | (unsigned)(127 - lane);
      unsigned khi = (ordkey(vhi) & 0xFFFFFF80u) | (unsigned)(63 - lane);
      unsigned T = 0;
#pragma unroll 4
      for (int bit = 31; bit >= 0; --bit) {
        unsigned cand = T | (1u << bit);
        int cnt = __popcll(__ballot(klo >= cand)) + __popcll(__ballot(khi >= cand));
        if (cnt >= 16) T = cand;
        if (cnt == 16) break;
      }
      bool slo = klo >= T, shi = khi >= T;
      unsigned long long mlo = __ballot(slo), mhi = __ballot(shi);
      int rlo = 0, rhi = 0;
      while (mlo) {
        int src = __ffsll((long long)mlo) - 1;
        mlo &= mlo - 1;
        unsigned ks = (unsigned)__builtin_amdgcn_readlane((int)klo, src);
        rlo += (ks > klo) ? 1 : 0;
        rhi += (ks > khi) ? 1 : 0;
      }
      while (mhi) {
        int src = __ffsll((long long)mhi) - 1;
        mhi &= mhi - 1;
        unsigned ks = (unsigned)__builtin_amdgcn_readlane((int)khi, src);
        rlo += (ks > klo) ? 1 : 0;
        rhi += (ks > khi) ? 1 : 0;
      }
      if (slo) { sv[list * 16 + rlo] = vlo; si[list * 16 + rlo] = lane; }
      if (shi) { sv[list * 16 + rhi] = vhi; si[list * 16 + rhi] = lane + 64; }
    }
    __syncthreads();
#pragma unroll 1
    for (int tt = 0; tt < 8; ++tt) {
      int tok = w * 8 + tt;
      float sc_ = sv[tok * 16 + ci] + sv[(32 + tok) * 16 + cj];
      unsigned key = cvalid ? ((ordkey(sc_) & 0xFFFFFFC0u) | (unsigned)(63 - lane)) : 0u;
      unsigned T = 0;
#pragma unroll 4
      for (int bit = 31; bit >= 0; --bit) {
        unsigned cand = T | (1u << bit);
        int cnt = __popcll(__ballot(key >= cand));
        if (cnt >= 16) T = cand;
        if (cnt == 16) break;
      }
      bool sel = cvalid && key >= T;
      unsigned long long msel = __ballot(sel);
      const int rank = (int)__builtin_amdgcn_mbcnt_hi((unsigned)(msel >> 32), __builtin_amdgcn_mbcnt_lo((unsigned)msel, 0u));
      const float mx = __int_as_float(__builtin_amdgcn_readlane(__float_as_int(sc_), 0));
      unsigned long long mm;
      float ex = sel ? __expf(sc_ - mx) : 0.f;
      int iex = __float_as_int(ex);
      float sum = 0.f;
      mm = msel;
      while (mm) {
        int src = __ffsll((long long)mm) - 1;
        mm &= mm - 1;
        sum += __int_as_float(__builtin_amdgcn_readlane(iex, src));
      }
      if (sel) {
        size_t o = (size_t)(tok0 + tok) * 128 + h * 16 + rank;
        gateo[o] = ex / sum;
        idxo[o] = si[tok * 16 + ci] * 128 + si[(32 + tok) * 16 + cj];
      }
    }
  }
  __syncthreads();
}

DEV float gelu_exact(float v) { return 0.5f * v * (1.f + erff(v * 0.70710678118654752f)); }

__device__ __forceinline__ void convert_fp8_rows(const float* src, unsigned char* dst, float* rscale, int nrows) {
  const int tid_ = otid();
  int lane = tid_ & 63;
  int wave = blockIdx.x * 4 + (tid_ >> 6), nw = gridDim.x * 4;
  for (int row = wave; row < nrows; row += nw) {
    const float* r = src + (size_t)row * 1024 + lane * 16;
    float4 a0 = *reinterpret_cast<const float4*>(r), a1 = *reinterpret_cast<const float4*>(r + 4);
    float4 a2 = *reinterpret_cast<const float4*>(r + 8), a3 = *reinterpret_cast<const float4*>(r + 12);
    float m = fmaxf(fmaxf(fmaxf(fabsf(a0.x), fabsf(a0.y)), fmaxf(fabsf(a0.z), fabsf(a0.w))), fmaxf(fmaxf(fabsf(a1.x), fabsf(a1.y)), fmaxf(fabsf(a1.z), fabsf(a1.w))));
    m = fmaxf(m, fmaxf(fmaxf(fmaxf(fabsf(a2.x), fabsf(a2.y)), fmaxf(fabsf(a2.z), fabsf(a2.w))), fmaxf(fmaxf(fabsf(a3.x), fabsf(a3.y)), fmaxf(fabsf(a3.z), fabsf(a3.w)))));
#pragma unroll
    for (int o = 32; o > 0; o >>= 1) m = fmaxf(m, __shfl_xor(m, o));
    float sc = m > 0.f ? exp2f(floorf(log2f(224.f / m))) : 1.f;
    uint4 o;
    int p;
    p = __builtin_amdgcn_cvt_pk_fp8_f32(a0.x * sc, a0.y * sc, 0, false); p = __builtin_amdgcn_cvt_pk_fp8_f32(a0.z * sc, a0.w * sc, p, true); o.x = (unsigned)p;
    p = __builtin_amdgcn_cvt_pk_fp8_f32(a1.x * sc, a1.y * sc, 0, false); p = __builtin_amdgcn_cvt_pk_fp8_f32(a1.z * sc, a1.w * sc, p, true); o.y = (unsigned)p;
    p = __builtin_amdgcn_cvt_pk_fp8_f32(a2.x * sc, a2.y * sc, 0, false); p = __builtin_amdgcn_cvt_pk_fp8_f32(a2.z * sc, a2.w * sc, p, true); o.z = (unsigned)p;
    p = __builtin_amdgcn_cvt_pk_fp8_f32(a3.x * sc, a3.y * sc, 0, false); p = __builtin_amdgcn_cvt_pk_fp8_f32(a3.z * sc, a3.w * sc, p, true); o.w = (unsigned)p;
    *reinterpret_cast<uint4*>(dst + (size_t)row * 1024 + lane * 16) = o;
    if (lane == 0) rscale[row] = 1.f / sc;
  }
}

#define F8X(dst, WW) { dst[0] = __builtin_amdgcn_cvt_pk_f32_fp8((int)(WW).x, false); dst[1] = __builtin_amdgcn_cvt_pk_f32_fp8((int)(WW).x, true); \
                      dst[2] = __builtin_amdgcn_cvt_pk_f32_fp8((int)(WW).y, false); dst[3] = __builtin_amdgcn_cvt_pk_f32_fp8((int)(WW).y, true); \
                      dst[4] = __builtin_amdgcn_cvt_pk_f32_fp8((int)(WW).z, false); dst[5] = __builtin_amdgcn_cvt_pk_f32_fp8((int)(WW).z, true); \
                      dst[6] = __builtin_amdgcn_cvt_pk_f32_fp8((int)(WW).w, false); dst[7] = __builtin_amdgcn_cvt_pk_f32_fp8((int)(WW).w, true); }

__device__ __forceinline__ void phase_peer_gather(const u16* tin, const int* idx, const float* gate, const unsigned char* utab, const unsigned char* vtab,
                                  const float* urs, const float* vrs, const float* xres,
                                  const float* g2  , const float* lng, const float* lnb, float* xout,
                                  const float* modnext  , u16* hxout) {
  const int tid_ = otid();
  int lane = tid_ & 63;
  int wave = blockIdx.x * 4 + (tid_ >> 6), nw = gridDim.x * 4;
  for (int tok = wave; tok < NT; tok += nw) {
    int b = tok >> 12;
    f32x2 t2[8];
    {
      uint4 ta = *reinterpret_cast<const uint4*>(tin + (size_t)tok * 1024 + lane * 16);
      uint4 tb = *reinterpret_cast<const uint4*>(tin + (size_t)tok * 1024 + lane * 16 + 8);
      t2[0] = f32x2{bflo(ta.x), bfhi(ta.x)}; t2[1] = f32x2{bflo(ta.y), bfhi(ta.y)}; t2[2] = f32x2{bflo(ta.z), bfhi(ta.z)}; t2[3] = f32x2{bflo(ta.w), bfhi(ta.w)};
      t2[4] = f32x2{bflo(tb.x), bfhi(tb.x)}; t2[5] = f32x2{bflo(tb.y), bfhi(tb.y)}; t2[6] = f32x2{bflo(tb.z), bfhi(tb.z)}; t2[7] = f32x2{bflo(tb.w), bfhi(tb.w)};
    }
    int id0 = idx[(size_t)tok * 128 + lane] & 16383, id1 = idx[(size_t)tok * 128 + 64 + lane] & 16383;
    int gt0 = __float_as_int(gate[(size_t)tok * 128 + lane]), gt1 = __float_as_int(gate[(size_t)tok * 128 + 64 + lane]);
    f32x2 acc2[8];
#pragma unroll
    for (int k = 0; k < 8; ++k) acc2[k] = f32x2{0.f, 0.f};
#pragma unroll 1
    for (int j = 0; j < 128; j += 4) {
      int e[4];
      float g[4];
      if (j < 64) {
#pragma unroll
        for (int q = 0; q < 4; ++q) { e[q] = __builtin_amdgcn_readlane(id0, j + q); g[q] = __int_as_float(__builtin_amdgcn_readlane(gt0, j + q)); }
      } else {
#pragma unroll
        for (int q = 0; q < 4; ++q) { e[q] = __builtin_amdgcn_readlane(id1, j - 64 + q); g[q] = __int_as_float(__builtin_amdgcn_readlane(gt1, j - 64 + q)); }
      }
      uint4 U[4], V[4];
      float su[4], sv_[4];
#pragma unroll
      for (int q = 0; q < 4; ++q) {
        U[q] = *reinterpret_cast<const uint4*>(utab + (size_t)e[q] * 1024 + lane * 16);
        V[q] = *reinterpret_cast<const uint4*>(vtab + (size_t)e[q] * 1024 + lane * 16);
        su[q] = urs[e[q]];
        sv_[q] = vrs[e[q]];
      }
      float d[4];
#pragma unroll
      for (int q = 0; q < 4; ++q) {
        f32x2 u2[8];
        F8X(u2, U[q])
        f32x2 dd = u2[0] * t2[0];
#pragma unroll
        for (int k = 1; k < 8; ++k) dd = u2[k] * t2[k] + dd;
        d[q] = dd.x + dd.y;
      }
#pragma unroll
      for (int o = 32; o > 0; o >>= 1) {
#pragma unroll
        for (int q = 0; q < 4; ++q) d[q] += __shfl_xor(d[q], o);
      }
#pragma unroll
      for (int q = 0; q < 4; ++q) {
        float a = g[q] * gelu_exact(d[q] * su[q]) * sv_[q];
        f32x2 aa = f32x2{a, a};
        f32x2 v2[8];
        F8X(v2, V[q])
#pragma unroll
        for (int k = 0; k < 8; ++k) acc2[k] = aa * v2[k] + acc2[k];
      }
    }
    float vv[16];
    float s = 0.f;
    const int c0 = lane * 16;
#pragma unroll
    for (int k4 = 0; k4 < 4; ++k4) {
      float4 x0 = *reinterpret_cast<const float4*>(xres + (size_t)tok * 1024 + c0 + k4 * 4);
      float4 g0 = *reinterpret_cast<const float4*>(g2 + (size_t)b * 6144 + c0 + k4 * 4);
      vv[k4 * 4 + 0] = ALPHA * x0.x + g0.x * acc2[k4 * 2].x; vv[k4 * 4 + 1] = ALPHA * x0.y + g0.y * acc2[k4 * 2].y;
      vv[k4 * 4 + 2] = ALPHA * x0.z + g0.z * acc2[k4 * 2 + 1].x; vv[k4 * 4 + 3] = ALPHA * x0.w + g0.w * acc2[k4 * 2 + 1].y;
    }
#pragma unroll
    for (int k = 0; k < 16; ++k) s += vv[k];
    float mu = wave_sum(s) * (1.f / 1024.f);
    float qq = 0.f;
#pragma unroll
    for (int k = 0; k < 16; ++k) { vv[k] -= mu; qq += vv[k] * vv[k]; }
    float rs = rsqrtf(wave_sum(qq) * (1.f / 1024.f) + 1e-5f);
    float oo[16];
#pragma unroll
    for (int k4 = 0; k4 < 4; ++k4) {
      float4 ga = *reinterpret_cast<const float4*>(lng + c0 + k4 * 4), ba = *reinterpret_cast<const float4*>(lnb + c0 + k4 * 4);
      float4 o0;
      o0.x = vv[k4 * 4 + 0] * rs * ga.x + ba.x; o0.y = vv[k4 * 4 + 1] * rs * ga.y + ba.y; o0.z = vv[k4 * 4 + 2] * rs * ga.z + ba.z; o0.w = vv[k4 * 4 + 3] * rs * ga.w + ba.w;
      *reinterpret_cast<float4*>(xout + (size_t)tok * 1024 + c0 + k4 * 4) = o0;
      oo[k4 * 4 + 0] = o0.x; oo[k4 * 4 + 1] = o0.y; oo[k4 * 4 + 2] = o0.z; oo[k4 * 4 + 3] = o0.w;
    }
    if (modnext) {
      const float* m = modnext + (size_t)b * 6144;
      unsigned pk[8];
#pragma unroll
      for (int k4 = 0; k4 < 4; ++k4) {
        float4 sh0 = *reinterpret_cast<const float4*>(m + c0 + k4 * 4), sc0 = *reinterpret_cast<const float4*>(m + 1024 + c0 + k4 * 4);
        pk[k4 * 2] = pack2(oo[k4 * 4 + 0] * (1.f + sc0.x) + sh0.x, oo[k4 * 4 + 1] * (1.f + sc0.y) + sh0.y);
        pk[k4 * 2 + 1] = pack2(oo[k4 * 4 + 2] * (1.f + sc0.z) + sh0.z, oo[k4 * 4 + 3] * (1.f + sc0.w) + sh0.w);
      }
      *reinterpret_cast<uint4*>(hxout + (size_t)tok * 1024 + c0) = make_uint4(pk[0], pk[1], pk[2], pk[3]);
      *reinterpret_cast<uint4*>(hxout + (size_t)tok * 1024 + c0 + 8) = make_uint4(pk[4], pk[5], pk[6], pk[7]);
    }
  }
}

__device__ __forceinline__ void phase_shortconv_T(const Params& p, const u16* upre, u16* x1cm, u16* x2cm, u16* vcm, char* lds) {
  constexpr int TLD = 264;
  u16* tile = (u16*)lds;
  int tid = otid();
  const int tg = tid >> 3, cg_ = tid & 7;
  for (int item = blockIdx.x; item < 128 * 48; item += gridDim.x) {
    int tt = item / 48, ct = item % 48;
    int tok0 = tt * 256, c0 = ct * 64;
    int ch = c0 + cg_ * 8;
    float w[3][8], bias[8];
#pragma unroll
    for (int j = 0; j < 3; ++j) {
      float4 w0 = *reinterpret_cast<const float4*>(p.h_conv_w + j * 3072 + ch), w1 = *reinterpret_cast<const float4*>(p.h_conv_w + j * 3072 + ch + 4);
      w[j][0] = w0.x; w[j][1] = w0.y; w[j][2] = w0.z; w[j][3] = w0.w; w[j][4] = w1.x; w[j][5] = w1.y; w[j][6] = w1.z; w[j][7] = w1.w;
    }
    {
      float4 b0 = *reinterpret_cast<const float4*>(p.h_conv_b + ch), b1 = *reinterpret_cast<const float4*>(p.h_conv_b + ch + 4);
      bias[0] = b0.x; bias[1] = b0.y; bias[2] = b0.z; bias[3] = b0.w; bias[4] = b1.x; bias[5] = b1.y; bias[6] = b1.z; bias[7] = b1.w;
    }
    const int t0 = tok0 + tg * 8;
    const int l0 = t0 & 4095;
    const u32x4 zero4 = u32x4{0u, 0u, 0u, 0u};
    u32x4 rows[10];
#pragma unroll
    for (int i = 0; i < 10; ++i) {
      int ll = l0 + i - 1;
      rows[i] = (ll >= 0 && ll <= 4095) ? *reinterpret_cast<const u32x4*>(upre + (size_t)(t0 + i - 1) * 3072 + ch) : zero4;
    }
    float o[8][8];
#pragma unroll
    for (int i = 0; i < 8; ++i) {
#pragma unroll
      for (int k = 0; k < 8; ++k) o[i][k] = bias[k];
      fma8(o[i], rows[i], w[0]);
      fma8(o[i], rows[i + 1], w[1]);
      fma8(o[i], rows[i + 2], w[2]);
    }
#pragma unroll
    for (int k = 0; k < 8; ++k) {
      uint4 pk;
      pk.x = pack2(o[0][k], o[1][k]); pk.y = pack2(o[2][k], o[3][k]); pk.z = pack2(o[4][k], o[5][k]); pk.w = pack2(o[6][k], o[7][k]);
      *reinterpret_cast<uint4*>(tile + (cg_ * 8 + k) * TLD + tg * 8) = pk;
    }
    __syncthreads();
    int part = c0 >> 10, d0 = c0 & 1023;
    u16* dst = part == 0 ? x1cm : (part == 1 ? x2cm : vcm);
    int b = tok0 >> 12, lt0 = tok0 & 4095;
#pragma unroll
    for (int i = 0; i < 8; ++i) {
      int q = tid + i * 256, c = q >> 5, chunk = q & 31;
      uint4 v = *reinterpret_cast<const uint4*>(tile + c * TLD + chunk * 8);
      *reinterpret_cast<uint4*>(dst + ((size_t)(b * 1024 + d0 + c)) * 4096 + lt0 + chunk * 8) = v;
    }
    __syncthreads();
  }
}

DEV float2 cmul(float2 a, float2 w) { return make_float2(a.x * w.x - a.y * w.y, a.x * w.y + a.y * w.x); }
DEV float2 cmulc(float2 a, float2 w) { return make_float2(a.x * w.x + a.y * w.y, a.y * w.x - a.x * w.y); }
template <bool LAST = true>
__device__ __forceinline__ void fft_fwd(float2* X, const float2* __restrict__ tw) {
  int tid = otid();
  for (int s = 12; s >= 2; s -= 2) {
    const int h = 1 << s, q = h >> 1;
#pragma unroll 2
    for (int i = 0; i < 8; ++i) {
      int gi = tid + i * 256;
      int pos = gi & (q - 1);
      int base = ((gi >> (s - 1)) << (s + 1)) + pos;
      float2 w1 = tw[pos << (12 - s)];
      float2 w2 = tw[pos << (13 - s)];
      float2 a = X[base], bb = X[base + q], c = X[base + h], d = X[base + h + q];
      float2 a1 = make_float2(a.x + c.x, a.y + c.y);
      float2 c1 = cmul(make_float2(a.x - c.x, a.y - c.y), w1);
      float2 b1 = make_float2(bb.x + d.x, bb.y + d.y);
      float2 t = cmul(make_float2(bb.x - d.x, bb.y - d.y), w1);
      float2 d1 = make_float2(t.y, -t.x);
      X[base] = make_float2(a1.x + b1.x, a1.y + b1.y);
      X[base + q] = cmul(make_float2(a1.x - b1.x, a1.y - b1.y), w2);
      X[base + h] = make_float2(c1.x + d1.x, c1.y + d1.y);
      X[base + h + q] = cmul(make_float2(c1.x - d1.x, c1.y - d1.y), w2);
    }
    __syncthreads();
  }
  if (LAST) {
#pragma unroll 4
    for (int i = 0; i < 16; ++i) {
      int j = tid + i * 256;
      float2 a = X[2 * j], bq = X[2 * j + 1];
      X[2 * j] = make_float2(a.x + bq.x, a.y + bq.y);
      X[2 * j + 1] = make_float2(a.x - bq.x, a.y - bq.y);
    }
    __syncthreads();
  }
}
__device__ __forceinline__ void fft_mid_mul(float2* X, const float2* __restrict__ H) {
  int tid = otid();
#pragma unroll 4
  for (int i = 0; i < 16; ++i) {
    int j = tid + i * 256;
    float2 a = X[2 * j], bq = X[2 * j + 1];
    float4 hh = *reinterpret_cast<const float4*>(H + 2 * j);
    float2 f0 = make_float2(a.x + bq.x, a.y + bq.y), f1 = make_float2(a.x - bq.x, a.y - bq.y);
    float2 g0 = make_float2(f0.x * hh.x - f0.y * hh.y, f0.x * hh.y + f0.y * hh.x);
    float2 g1 = make_float2(f1.x * hh.z - f1.y * hh.w, f1.x * hh.w + f1.y * hh.z);
    X[2 * j] = make_float2(g0.x + g1.x, g0.y + g1.y);
    X[2 * j + 1] = make_float2(g0.x - g1.x, g0.y - g1.y);
  }
  __syncthreads();
}
template <bool FIRST = true>
__device__ __forceinline__ void fft_inv(float2* X, const float2* __restrict__ tw) {
  int tid = otid();
  if (FIRST) {
#pragma unroll 4
    for (int i = 0; i < 16; ++i) {
      int j = tid + i * 256;
      float2 a = X[2 * j], bq = X[2 * j + 1];
      X[2 * j] = make_float2(a.x + bq.x, a.y + bq.y);
      X[2 * j + 1] = make_float2(a.x - bq.x, a.y - bq.y);
    }
    __syncthreads();
  }
  for (int s = 2; s <= 12; s += 2) {
    const int h = 1 << s, q = h >> 1;
#pragma unroll 2
    for (int i = 0; i < 8; ++i) {
      int gi = tid + i * 256;
      int pos = gi & (q - 1);
      int base = ((gi >> (s - 1)) << (s + 1)) + pos;
      float2 w1 = tw[pos << (12 - s)];
      float2 w2 = tw[pos << (13 - s)];
      float2 a = X[base], bb = X[base + q], c = X[base + h], d = X[base + h + q];
      float2 tb = cmulc(bb, w2), td = cmulc(d, w2);
      float2 a1 = make_float2(a.x + tb.x, a.y + tb.y), b1 = make_float2(a.x - tb.x, a.y - tb.y);
      float2 c1 = make_float2(c.x + td.x, c.y + td.y), d1 = make_float2(c.x - td.x, c.y - td.y);
      float2 tc = cmulc(c1, w1);
      float2 u = cmulc(d1, w1);
      float2 tdd = make_float2(-u.y, u.x);
      X[base] = make_float2(a1.x + tc.x, a1.y + tc.y);
      X[base + h] = make_float2(a1.x - tc.x, a1.y - tc.y);
      X[base + q] = make_float2(b1.x + tdd.x, b1.y + tdd.y);
      X[base + h + q] = make_float2(b1.x - tdd.x, b1.y - tdd.y);
    }
    __syncthreads();
  }
}

__device__ __forceinline__ void phase_filter_fft(const Params& p, float2* Hf, char* lds) {
  float2* X = (float2*)lds;
  float* w3s = (float*)(lds + 65536);
  float* red = w3s + 128;
  const float* hid = (const float*)(p.ws + OFF_HID);
  int tid = otid();
  const float min_decay = -3.0701134573253945f;
  const float max_decay = -15.350567286626973f;
  for (int item = blockIdx.x; item < 2048; item += gridDim.x) {
    int o = item >> 10, d = item & 1023;
    if (tid < 128) {
      int dirr = tid >> 6, j = tid & 63;
      w3s[tid] = p.h_f_w3[(size_t)j * 4096 + (o * 2 + dirr) * 1024 + d];
    }
    __syncthreads();
    float adelta = fabsf(min_decay + (float)d * ((max_decay - min_decay) / 1023.f));
    float ss = 0.f;
#pragma unroll 1
    for (int i = 0; i < 16; ++i) {
      int t = tid + i * 256;
      const float* hr = hid + (size_t)t * 64;
      float hf = 0.f, hb = 0.f;
#pragma unroll
      for (int j4 = 0; j4 < 16; ++j4) {
        float4 hv = *reinterpret_cast<const float4*>(hr + j4 * 4);
        hf += hv.x * w3s[j4 * 4] + hv.y * w3s[j4 * 4 + 1] + hv.z * w3s[j4 * 4 + 2] + hv.w * w3s[j4 * 4 + 3];
        hb += hv.x * w3s[64 + j4 * 4] + hv.y * w3s[64 + j4 * 4 + 1] + hv.z * w3s[64 + j4 * 4 + 2] + hv.w * w3s[64 + j4 * 4 + 3];
      }
      float dec = __expf(-((float)t / 4095.f) * adelta);
      hf *= dec; hb *= dec;
      if (t == 0) {
        float v = hf + hb;
        X[0] = make_float2(v, 0.f);
        X[4096] = make_float2(0.f, 0.f);
        ss += v * v;
      } else {
        X[t] = make_float2(hf, 0.f);
        X[8192 - t] = make_float2(hb, 0.f);
        ss += hf * hf + hb * hb;
      }
    }
    ss = wave_sum(ss);
    if ((tid & 63) == 0) red[tid >> 6] = ss;
    __syncthreads();
    float tot = red[0] + red[1] + red[2] + red[3];
    float scale = rsqrtf(tot + 1e-6f) * (1.f / 8192.f);
    fft_fwd(X, (const float2*)(p.ws + OFF_TW));
    float2* dst = Hf + (size_t)item * 8192;
#pragma unroll 4
    for (int i = 0; i < 32; ++i) {
      int k = tid + i * 256;
      float2 v = X[k];
      dst[k] = make_float2(v.x * scale, v.y * scale);
    }
    __syncthreads();
  }
}

__device__ __forceinline__ void phase_hyena_conv(const Params& p, const u16* x1cm, const u16* x2cm, const u16* vcm, const float2* Hf, u16* zzcm, char* lds) {
  float2* X = (float2*)lds;
  int tid = otid();
  for (int item = blockIdx.x; item < 4096; item += gridDim.x) {
    int d = item >> 2, bp = item & 3;
    size_t r0 = ((size_t)((bp * 2) * 1024 + d)) * 4096, r1 = ((size_t)((bp * 2 + 1) * 1024 + d)) * 4096;
    float bias0 = p.h_bias[d], bias1 = p.h_bias[1024 + d];
#pragma unroll
    for (int i = 0; i < 2; ++i) {
      int t8 = (tid + i * 256) * 8;
      uint4 a = *reinterpret_cast<const uint4*>(vcm + r0 + t8);
      uint4 bq = *reinterpret_cast<const uint4*>(vcm + r1 + t8);
      X[t8 + 0] = make_float2(bflo(a.x), bflo(bq.x)); X[t8 + 1] = make_float2(bfhi(a.x), bfhi(bq.x));
      X[t8 + 2] = make_float2(bflo(a.y), bflo(bq.y)); X[t8 + 3] = make_float2(bfhi(a.y), bfhi(bq.y));
      X[t8 + 4] = make_float2(bflo(a.z), bflo(bq.z)); X[t8 + 5] = make_float2(bfhi(a.z), bfhi(bq.z));
      X[t8 + 6] = make_float2(bflo(a.w), bflo(bq.w)); X[t8 + 7] = make_float2(bfhi(a.w), bfhi(bq.w));
    }
    for (int i = 0; i < 16; ++i) X[4096 + tid + i * 256] = make_float2(0.f, 0.f);
    __syncthreads();
    fft_fwd<false>(X, (const float2*)(p.ws + OFF_TW));
    fft_mid_mul(X, Hf + (size_t)d * 8192);
    fft_inv<false>(X, (const float2*)(p.ws + OFF_TW));
    float zz0[16], zz1[16];
#pragma unroll
    for (int i = 0; i < 2; ++i) {
      int t8 = (tid + i * 256) * 8;
      uint4 a = *reinterpret_cast<const uint4*>(vcm + r0 + t8);
      uint4 bq = *reinterpret_cast<const uint4*>(vcm + r1 + t8);
      uint4 xa = *reinterpret_cast<const uint4*>(x1cm + r0 + t8);
      uint4 xb = *reinterpret_cast<const uint4*>(x1cm + r1 + t8);
      float va[8] = {bflo(a.x), bfhi(a.x), bflo(a.y), bfhi(a.y), bflo(a.z), bfhi(a.z), bflo(a.w), bfhi(a.w)};
      float vb[8] = {bflo(bq.x), bfhi(bq.x), bflo(bq.y), bfhi(bq.y), bflo(bq.z), bfhi(bq.z), bflo(bq.w), bfhi(bq.w)};
      float fa[8] = {bflo(xa.x), bfhi(xa.x), bflo(xa.y), bfhi(xa.y), bflo(xa.z), bfhi(xa.z), bflo(xa.w), bfhi(xa.w)};
      float fb[8] = {bflo(xb.x), bfhi(xb.x), bflo(xb.y), bfhi(xb.y), bflo(xb.z), bfhi(xb.z), bflo(xb.w), bfhi(xb.w)};
#pragma unroll
      for (int e = 0; e < 8; ++e) {
        float2 cv = X[t8 + e];
        float z0 = fa[e] * (cv.x + va[e] * bias0);
        float z1 = fb[e] * (cv.y + vb[e] * bias0);
        zz0[i * 8 + e] = z0; zz1[i * 8 + e] = z1;
        X[t8 + e] = make_float2(z0, z1);
      }
    }
    for (int i = 0; i < 16; ++i) X[4096 + tid + i * 256] = make_float2(0.f, 0.f);
    __syncthreads();
    fft_fwd<false>(X, (const float2*)(p.ws + OFF_TW));
    fft_mid_mul(X, Hf + (size_t)(1024 + d) * 8192);
    fft_inv<false>(X, (const float2*)(p.ws + OFF_TW));
#pragma unroll
    for (int i = 0; i < 2; ++i) {
      int t8 = (tid + i * 256) * 8;
      uint4 xa = *reinterpret_cast<const uint4*>(x2cm + r0 + t8);
      uint4 xb = *reinterpret_cast<const uint4*>(x2cm + r1 + t8);
      float fa[8] = {bflo(xa.x), bfhi(xa.x), bflo(xa.y), bfhi(xa.y), bflo(xa.z), bfhi(xa.z), bflo(xa.w), bfhi(xa.w)};
      float fb[8] = {bflo(xb.x), bfhi(xb.x), bflo(xb.y), bfhi(xb.y), bflo(xb.z), bfhi(xb.z), bflo(xb.w), bfhi(xb.w)};
      float o0[8], o1[8];
#pragma unroll
      for (int e = 0; e < 8; ++e) {
        float2 cv = X[t8 + e];
        o0[e] = fa[e] * (cv.x + zz0[i * 8 + e] * bias1);
        o1[e] = fb[e] * (cv.y + zz1[i * 8 + e] * bias1);
      }
      uint4 w0, w1;
      w0.x = pack2(o0[0], o0[1]); w0.y = pack2(o0[2], o0[3]); w0.z = pack2(o0[4], o0[5]); w0.w = pack2(o0[6], o0[7]);
      w1.x = pack2(o1[0], o1[1]); w1.y = pack2(o1[2], o1[3]); w1.z = pack2(o1[4], o1[5]); w1.w = pack2(o1[6], o1[7]);
      *reinterpret_cast<uint4*>(zzcm + r0 + t8) = w0;
      *reinterpret_cast<uint4*>(zzcm + r1 + t8) = w1;
    }
    __syncthreads();
  }
}

__device__ __forceinline__ void phase_transpose_back(const u16* src, u16* dst, char* lds) {
  u16* tile = (u16*)lds;
  int tid = otid();
  for (int item = blockIdx.x; item < 8 * 16 * 64; item += gridDim.x) {
    int b = item >> 10, dt_ = (item >> 6) & 15, tt = item & 63;
#pragma unroll
    for (int i = 0; i < 2; ++i) {
      int q = tid + i * 256, dd = q >> 3, tg = (q & 7) * 8;
      uint4 v = *reinterpret_cast<const uint4*>(src + ((size_t)(b * 1024 + dt_ * 64 + dd)) * 4096 + tt * 64 + tg);
      tile[(tg + 0) * 72 + dd] = (u16)(v.x & 0xffff); tile[(tg + 1) * 72 + dd] = (u16)(v.x >> 16);
      tile[(tg + 2) * 72 + dd] = (u16)(v.y & 0xffff); tile[(tg + 3) * 72 + dd] = (u16)(v.y >> 16);
      tile[(tg + 4) * 72 + dd] = (u16)(v.z & 0xffff); tile[(tg + 5) * 72 + dd] = (u16)(v.z >> 16);
      tile[(tg + 6) * 72 + dd] = (u16)(v.w & 0xffff); tile[(tg + 7) * 72 + dd] = (u16)(v.w >> 16);
    }
    __syncthreads();
#pragma unroll
    for (int i = 0; i < 2; ++i) {
      int q = tid + i * 256, tl = q >> 3, dg = (q & 7) * 8;
      uint4 v = *reinterpret_cast<const uint4*>(tile + tl * 72 + dg);
      *reinterpret_cast<uint4*>(dst + ((size_t)(b * 4096 + tt * 64 + tl)) * 1024 + dt_ * 64 + dg) = v;
    }
    __syncthreads();
  }
}

__device__ __forceinline__ uint4* xb_words_ptr() { __shared__ uint4 xb_words; return &xb_words; }
#define XB_TMO      128
#define XB_XCNT(j)  (256  + 64 * (j))
#define XB_XSUB(j)  (1280 + 64 * (j))
#define XB_XGEN(j)  (2304 + 64 * (j))
#define XB_TOP      3328
#define XB_TOPGEN   3392
#define XCD_BAR_WORDS 3456
#define XB_SPIN_CAP (1u << 18)
#define LAS __attribute__((address_space(3)))

__device__ __forceinline__ unsigned xb_ld(unsigned* p)              { return __hip_atomic_load(p, __ATOMIC_RELAXED, __HIP_MEMORY_SCOPE_AGENT); }
__device__ __forceinline__ unsigned xb_add(unsigned* p, unsigned v) { return __hip_atomic_fetch_add(p, v, __ATOMIC_RELAXED, __HIP_MEMORY_SCOPE_AGENT); }
__device__ __forceinline__ unsigned xb_xcc_id() { return (unsigned)__builtin_amdgcn_s_getreg((3 << 11) | 20) & 0xFu; }
#define XB_SPIN(cond, bar) do { unsigned _sp = 0; while (cond) { __builtin_amdgcn_s_sleep(1); \
    if ((++_sp & 255u) == 0u) { if (xb_ld(&(bar)[XB_TMO])) break; if (_sp > XB_SPIN_CAP) { atomicAdd(&(bar)[XB_TMO], 1u); break; } } } } while (0)

struct XcdBarrier {
    unsigned* bar; unsigned x;
    volatile LAS unsigned* st;
};

__device__ __forceinline__ XcdBarrier xcd_barrier_post(unsigned* bar, volatile LAS unsigned* st) {
    XcdBarrier b; b.bar = bar; b.x = xb_xcc_id(); b.st = st;
    if (threadIdx.x == 0) (void)xb_add(&bar[XB_XCNT(b.x)], 1u);
    return b;
}
__device__ __forceinline__ void xcd_barrier_complete(unsigned* bar, unsigned x, unsigned& nloc, unsigned& nx) {
    const unsigned G = gridDim.x * gridDim.y * gridDim.z;
    unsigned sum, cnt, mine, sp = 0u;
    for (;;) {
        sum = 0u; cnt = 0u; mine = 0u;
#pragma unroll
        for (unsigned j = 0; j < 16; ++j) { const unsigned c = xb_ld(&bar[XB_XCNT(j)]); sum += c; cnt += (c > 0u) ? 1u : 0u; mine = (j == x) ? c : mine; }
        if (sum == G) break;
        __builtin_amdgcn_s_sleep(1);
        if ((++sp & 255u) == 0u) { if (xb_ld(&bar[XB_TMO])) break; if (sp > XB_SPIN_CAP) { atomicAdd(&bar[XB_TMO], 1u); break; } }
    }
    nloc = mine > 0u ? mine : 1u; nx = cnt > 0u ? cnt : 1u;
}

__device__ __forceinline__ void xcd_barrier(const XcdBarrier& b) {
    asm volatile("s_waitcnt vmcnt(0)" ::: "memory");
    __syncthreads();
    if (threadIdx.x == 0) {
        unsigned* bar = b.bar;
        __builtin_amdgcn_s_waitcnt(0);
        unsigned nloc = b.st[0], nx = b.st[1];
        if (nloc == 0u) { xcd_barrier_complete(bar, b.x, nloc, nx); b.st[0] = nloc; b.st[1] = nx; }
        const unsigned old = xb_add(&bar[XB_XSUB(b.x)], 1u);
        const unsigned gen = old / nloc;
        if (old + 1u == (gen + 1u) * nloc) {
            __builtin_amdgcn_fence(__ATOMIC_RELEASE, "agent");
            asm volatile("s_waitcnt vmcnt(0)" ::: "memory");
            const unsigned og = xb_add(&bar[XB_TOP], 1u);
            const unsigned tg = og / nx;
            if (og + 1u == (tg + 1u) * nx) xb_add(&bar[XB_TOPGEN], 1u);
            else XB_SPIN(xb_ld(&bar[XB_TOPGEN]) == tg, bar);
            __builtin_amdgcn_fence(__ATOMIC_ACQUIRE, "agent");
            xb_add(&bar[XB_XGEN(b.x)], 1u);
            asm volatile("s_waitcnt vmcnt(0)" ::: "memory");
        } else {
            XB_SPIN(xb_ld(&bar[XB_XGEN(b.x)]) == gen, bar);
            __builtin_amdgcn_fence(__ATOMIC_ACQUIRE, "agent");
            asm volatile("s_waitcnt vmcnt(0)" ::: "memory");
        }
    }
    __syncthreads();
}


DEV void gsync2(unsigned k) {
  (void)k;
  XcdBarrier b;
  b.bar = (unsigned*)((char*)karg<33>() + OFF_BAR);
  b.x = xb_xcc_id();
  b.st = (volatile LAS unsigned*)xb_words_ptr();
  xcd_barrier(b);
}

DEV void gsync(cg::grid_group& grid) {
  asm volatile("s_waitcnt vmcnt(0)" ::: "memory");
  grid.sync();
  if (threadIdx.x == 0) {
    __builtin_amdgcn_fence(__ATOMIC_ACQUIRE, "agent");
    asm volatile("s_waitcnt vmcnt(0)" ::: "memory");
  }
  __syncthreads();
}

template <int layer>
__device__ __forceinline__ void peer_block(unsigned& nbar, char* lds) {
  {
    Params p = fetch_params();
    char* ws = p.ws; char* R1 = ws + OFF_R1; char* R2 = ws + OFF_R2; char* DO = (char*)p.out;
    const float* modl = (float*)(ws + OFF_MOD) + (size_t)layer * 9 * 6144;
    const u16* A = layer == 0 ? (const u16*)R1 : (const u16*)DO;
    const int K = layer == 0 ? 2048 : 1024;
    const u16* Wt = (const u16*)(ws + (layer == 0 ? OFF_W_OUT : OFF_W_HOUT));
    const float* res = layer == 0 ? p.x : (const float*)R2;
    phase_gemm_resid(A, K, Wt, res, (float*)R2, modl + 2048, lds);
  }
  gsync2(++nbar);
  {
    Params p = fetch_params();
    char* ws = p.ws; char* R1 = ws + OFF_R1; char* R2 = ws + OFF_R2; char* DO = (char*)p.out;
    const float* modl = (float*)(ws + OFF_MOD) + (size_t)layer * 9 * 6144;
    u16* tpeer = layer == 0 ? (u16*)DO : (u16*)(R1 + 128 * MiB);
    phase_ln_mod((float*)R2, p.ln_g + layer * 2048, p.ln_b + layer * 2048, modl, tpeer);
    if (layer == 1) {
      unsigned char* tb = (unsigned char*)R1;
      convert_fp8_rows(p.p_u + (size_t)16384 * 1024, tb, (float*)(tb + 32 * MiB), 16384);
      convert_fp8_rows(p.p_v + (size_t)16384 * 1024, tb + 16 * MiB, (float*)(tb + 32 * MiB + 65536), 16384);
    }
  }
  gsync2(++nbar);
  {
    Params p = fetch_params();
    char* ws = p.ws; char* R1 = ws + OFF_R1; char* DO = (char*)p.out;
    u16* tpeer = layer == 0 ? (u16*)DO : (u16*)(R1 + 128 * MiB);
    phase_gemm_bf16(tpeer, (const u16*)(ws + OFF_W_Q) + (size_t)layer * 2048 * 1024, layer == 0 ? (u16*)R1 : (u16*)DO, 2048, lds);
  }
  gsync2(++nbar);
  {
    Params p = fetch_params();
    char* ws = p.ws; char* R1 = ws + OFF_R1; char* R2 = ws + OFF_R2;
    int* idxb = (int*)(R2 + 128 * MiB);
    float* gateb = (float*)(R2 + 144 * MiB);
    const u16* kbf = (const u16*)(ws + OFF_KEYS);
    phase_peer_topk(layer == 0 ? (const u16*)R1 : (const u16*)p.out, kbf + (size_t)layer * 131072, kbf + 262144 + (size_t)layer * 131072, idxb, gateb, lds);
  }
  gsync2(++nbar);
  {
    Params p = fetch_params();
    char* ws = p.ws; char* R1 = ws + OFF_R1; char* R2 = ws + OFF_R2; char* DO = (char*)p.out;
    float* mod = (float*)(ws + OFF_MOD);
    const float* modl = mod + (size_t)layer * 9 * 6144;
    int* idxb = (int*)(R2 + 128 * MiB);
    float* gateb = (float*)(R2 + 144 * MiB);
    u16* tpeer = layer == 0 ? (u16*)DO : (u16*)(R1 + 128 * MiB);
    const unsigned char* tb8 = (const unsigned char*)(layer == 0 ? ws + OFF_TAB0 : R1);
    phase_peer_gather(tpeer, idxb, gateb, tb8, tb8 + 16 * MiB, (const float*)(tb8 + 32 * MiB), (const float*)(tb8 + 32 * MiB + 65536), (const float*)R2,
                      modl + 5120, p.ln_g + layer * 2048 + 1024, p.ln_b + layer * 2048 + 1024, layer == 0 ? (float*)R2 : p.out,
                      layer == 0 ? mod + 9 * 6144 : nullptr, (u16*)(DO + 64 * MiB));
  }
}

__global__ void __launch_bounds__(256, 2) fwd_megakernel(Params p_unused) {
  __shared__ __attribute__((aligned(16))) char lds[LDS_BYTES];
  cg::grid_group grid = cg::this_grid();
  unsigned nbar = 0;
  if (threadIdx.x == 0) *xb_words_ptr() = make_uint4(0u, 0u, 0u, 0u);
  __syncthreads();
  (void)xcd_barrier_post((unsigned*)((char*)karg<33>() + OFF_BAR), (volatile LAS unsigned*)xb_words_ptr());
  { Params p = fetch_params(); phase_prologue(p, lds); }
  gsync(grid);
  {
    Params p = fetch_params();
    float* mod = (float*)(p.ws + OFF_MOD);
    modulate_rows(p.x, (u16*)(p.ws + OFF_R2), NT, SEQ, mod, 0, 1024, false);
    modulate_rows(p.ctx, (u16*)(p.ws + OFF_HC), NTC, CTXL, mod, 0, 1024, true);
  }
  gsync2(++nbar);
  { Params p = fetch_params(); phase_gemm_inproj(p, lds); }
  gsync2(++nbar);
  { Params p = fetch_params(); phase_conv(p); }
  gsync2(++nbar);
  { Params p = fetch_params(); phase_ssd(p, lds); }
  gsync2(++nbar);
  {
    Params p = fetch_params(); phase_gated_norm(p);
    unsigned char* tb = (unsigned char*)(p.ws + OFF_TAB0);
    convert_fp8_rows(p.p_u, tb, (float*)(tb + 32 * MiB), 16384);
    convert_fp8_rows(p.p_v, tb + 16 * MiB, (float*)(tb + 32 * MiB + 65536), 16384);
  }
  gsync2(++nbar);
  peer_block<0>(nbar, lds);
  gsync2(++nbar);
  {
    Params p = fetch_params();
    phase_gemm_bf16((const u16*)((char*)p.out + 64 * MiB), (const u16*)(p.ws + OFF_W_HIN), (u16*)(p.ws + OFF_R1), 3072, lds);
  }
  gsync2(++nbar);
  {
    Params p = fetch_params();
    phase_shortconv_T(p, (const u16*)(p.ws + OFF_R1), (u16*)(p.ws + OFF_R2 + 128 * MiB), (u16*)p.out, (u16*)((char*)p.out + 64 * MiB), lds);
  }
  gsync2(++nbar);
  { Params p = fetch_params(); phase_filter_fft(p, (float2*)(p.ws + OFF_R1), lds); }
  gsync2(++nbar);
  {
    Params p = fetch_params();
    phase_hyena_conv(p, (const u16*)(p.ws + OFF_R2 + 128 * MiB), (const u16*)p.out, (const u16*)((char*)p.out + 64 * MiB),
                     (const float2*)(p.ws + OFF_R1), (u16*)(p.ws + OFF_R1 + 128 * MiB), lds);
  }
  gsync2(++nbar);
  { Params p = fetch_params(); phase_transpose_back((const u16*)(p.ws + OFF_R1 + 128 * MiB), (u16*)p.out, lds); }
  gsync2(++nbar);
  peer_block<1>(nbar, lds);
}

extern "C" void kernel_launch(void* const* d_in, const int* in_sizes, int n_in, void* d_out, int out_size, void* d_ws, size_t ws_size,
                              hipStream_t stream) {
  static int grid_blocks = 0;
  if (!grid_blocks) {
    int dev = 0, cus = 0, per_cu = 0;
    hipGetDevice(&dev);
    hipDeviceGetAttribute(&cus, hipDeviceAttributeMultiprocessorCount, dev);
    hipOccupancyMaxActiveBlocksPerMultiprocessor(&per_cu, fwd_megakernel, 256, 0);
    if (per_cu > 2) per_cu = 2;
    if (per_cu < 1) per_cu = 1;
    grid_blocks = cus * per_cu;
  }
  Params p{};
  const float** pp = reinterpret_cast<const float**>(&p);
  for (int i = 0; i < 32; ++i) pp[i] = (const float*)d_in[i];
  p.out = (float*)d_out;
  p.ws = (char*)d_ws;
  if (ws_size < WS_TOTAL) fprintf(stderr, "workspace too small: %zu < %zu\n", ws_size, (size_t)WS_TOTAL);
  (void)hipMemsetAsync((char*)d_ws + OFF_BAR, 0, 16384, stream);
  void* args[] = {&p};
  hipError_t e = hipLaunchCooperativeKernel((void*)fwd_megakernel, dim3(grid_blocks), dim3(256), args, 0, stream);
  if (e != hipSuccess) fprintf(stderr, "cooperative launch failed: %s (grid %d)\n", hipGetErrorString(e), grid_blocks);
}
```

```cpp
#include <hip/hip_runtime.h>
#include <hip/hip_bf16.h>
#include <hip/hip_cooperative_groups.h>
#include <cstdio>
namespace cg = cooperative_groups;

typedef unsigned short u16;
using bf16x8 = __attribute__((ext_vector_type(8))) short;
using f32x4 = __attribute__((ext_vector_type(4))) float;
using u32x4 = __attribute__((ext_vector_type(4))) unsigned;
typedef float f32x2 __attribute__((ext_vector_type(2)));

#define DEV __device__ __forceinline__

constexpr int NB = 8, SEQ = 4096, DM = 1024, NT = NB * SEQ;
constexpr int CTXL = 256, NTC = NB * CTXL;
constexpr int SSM_IN = 5184, CONVD = 3072, SSM_INNER = 2048;
constexpr float ALPHA = 1.41421356237f;
constexpr int LDS_BYTES = 71168;

constexpr size_t MiB = 1ull << 20;
constexpr size_t OFF_W_IN = 0;
constexpr size_t OFF_W_OUT = OFF_W_IN + (size_t)5184 * 1024 * 2;
constexpr size_t OFF_W_HIN = OFF_W_OUT + (size_t)1024 * 2048 * 2;
constexpr size_t OFF_W_HOUT = OFF_W_HIN + (size_t)3072 * 1024 * 2;
constexpr size_t OFF_W_Q = OFF_W_HOUT + (size_t)1024 * 1024 * 2;
constexpr size_t OFF_MOD = OFF_W_Q + (size_t)2 * 2048 * 1024 * 2;
constexpr size_t OFF_HID = OFF_MOD + 512 * 1024;
constexpr size_t OFF_DT = OFF_HID + MiB;
constexpr size_t OFF_HC = OFF_DT + 8 * MiB;
constexpr size_t OFF_XBC_C = OFF_HC + 4 * MiB;
constexpr size_t OFF_XC_C = OFF_XBC_C + 12 * MiB;
constexpr size_t OFF_DT_C = OFF_XC_C + 12 * MiB;
constexpr size_t OFF_R1 = OFF_DT_C + MiB;
constexpr size_t OFF_R2 = OFF_R1 + 192 * MiB;
constexpr size_t OFF_BAR = OFF_R2 + 192 * MiB;
constexpr size_t OFF_KEYS = OFF_BAR + 16384;
constexpr size_t OFF_TW = OFF_KEYS + MiB;
constexpr size_t OFF_TAB0 = OFF_TW + 32768;
constexpr size_t WS_TOTAL = OFF_TAB0 + 33 * MiB;

struct Params {
  const float *x, *c, *ctx, *c_ctx, *ada_w, *ada_b, *ln_g, *ln_b;
  const float *m_w_in, *m_conv_w, *m_conv_b, *m_a_log, *m_dt_bias, *m_d, *m_norm_w, *m_w_out;
  const float *h_w_in, *h_conv_w, *h_conv_b, *h_f_w1, *h_f_b1, *h_f_w2, *h_f_b2, *h_f_w3, *h_freq, *h_bias, *h_w_out;
  const float *p_wq, *p_k1, *p_k2, *p_u, *p_v;
  float* out;
  char* ws;
};

typedef __bf16 bf16x2_t __attribute__((ext_vector_type(2)));
typedef float f32x2_ __attribute__((ext_vector_type(2)));
DEV u16 f2bf(float f) { __bf16 v = (__bf16)f; return __builtin_bit_cast(u16, v); }
DEV float bf2f(u16 h) { return __uint_as_float(((unsigned)h) << 16); }
DEV float bflo(unsigned w) { return __uint_as_float(w << 16); }
DEV float bfhi(unsigned w) { return __uint_as_float(w & 0xffff0000u); }
DEV unsigned pack2(float a, float b) { bf16x2_t v = __builtin_convertvector(f32x2_{a, b}, bf16x2_t); return __builtin_bit_cast(unsigned, v); }
DEV float wave_sum(float v) {
#pragma unroll
  for (int o = 32; o > 0; o >>= 1) v += __shfl_xor(v, o);
  return v;
}
DEV int otid() { int t = threadIdx.x; asm volatile("" : "+v"(t)); return t; }
DEV unsigned ordkey(float f) { unsigned u = __float_as_uint(f); return (u & 0x80000000u) ? ~u : (u | 0x80000000u); }
DEV float siluf(float v) { return v / (1.f + __expf(-v)); }
DEV f32x4 mfma16(bf16x8 a, bf16x8 b, f32x4 c) { return __builtin_amdgcn_mfma_f32_16x16x32_bf16(a, b, c, 0, 0, 0); }
DEV bf16x8 ld8(const u16* p) { return *reinterpret_cast<const bf16x8*>(p); }

template <int I>
DEV const float* karg() {
  unsigned long long v;
  asm volatile("s_load_dwordx2 %0, %1, %2\n\ts_waitcnt lgkmcnt(0)" : "=s"(v) : "s"(__builtin_amdgcn_kernarg_segment_ptr()), "n"(I * 8));
  return (const float*)(const __attribute__((address_space(1))) float*)v;
}
DEV Params fetch_params() {
  Params q;
  q.x = karg<0>(); q.c = karg<1>(); q.ctx = karg<2>(); q.c_ctx = karg<3>(); q.ada_w = karg<4>(); q.ada_b = karg<5>(); q.ln_g = karg<6>(); q.ln_b = karg<7>();
  q.m_w_in = karg<8>(); q.m_conv_w = karg<9>(); q.m_conv_b = karg<10>(); q.m_a_log = karg<11>(); q.m_dt_bias = karg<12>(); q.m_d = karg<13>();
  q.m_norm_w = karg<14>(); q.m_w_out = karg<15>();
  q.h_w_in = karg<16>(); q.h_conv_w = karg<17>(); q.h_conv_b = karg<18>(); q.h_f_w1 = karg<19>(); q.h_f_b1 = karg<20>(); q.h_f_w2 = karg<21>();
  q.h_f_b2 = karg<22>(); q.h_f_w3 = karg<23>(); q.h_freq = karg<24>(); q.h_bias = karg<25>(); q.h_w_out = karg<26>();
  q.p_wq = karg<27>(); q.p_k1 = karg<28>(); q.p_k2 = karg<29>(); q.p_u = karg<30>(); q.p_v = karg<31>();
  q.out = (float*)karg<32>(); q.ws = (char*)karg<33>();
  return q;
}

__device__ __forceinline__ void transpose_w_tile(const float* src, int srcld, int K, int N, u16* dst, int item, char* lds) {
  float* tile = (float*)lds;
  int ntn = N / 64;
  int kt = item / ntn, nt = item % ntn;
  int tid = otid();
#pragma unroll
  for (int i = 0; i < 4; ++i) {
    int r = (tid >> 4) + i * 16, c4 = (tid & 15) * 4;
    float4 v = *reinterpret_cast<const float4*>(src + (size_t)(kt * 64 + r) * srcld + nt * 64 + c4);
    tile[r * 65 + c4 + 0] = v.x; tile[r * 65 + c4 + 1] = v.y; tile[r * 65 + c4 + 2] = v.z; tile[r * 65 + c4 + 3] = v.w;
  }
  __syncthreads();
#pragma unroll
  for (int i = 0; i < 2; ++i) {
    int n = (tid >> 3) + i * 32, k8 = (tid & 7) * 8;
    uint4 o;
    o.x = pack2(tile[(k8 + 0) * 65 + n], tile[(k8 + 1) * 65 + n]);
    o.y = pack2(tile[(k8 + 2) * 65 + n], tile[(k8 + 3) * 65 + n]);
    o.z = pack2(tile[(k8 + 4) * 65 + n], tile[(k8 + 5) * 65 + n]);
    o.w = pack2(tile[(k8 + 6) * 65 + n], tile[(k8 + 7) * 65 + n]);
    *reinterpret_cast<uint4*>(dst + (size_t)(nt * 64 + n) * K + kt * 64 + k8) = o;
  }
  __syncthreads();
}

__device__ __forceinline__ void ada_item(const Params& p, int item, char* lds) {
  float* sl = (float*)lds;
  float* red = sl + 9 * 1024;
  int layer = item / 96, cg_ = item % 96;
  int tid = otid(), kq = tid >> 6, col = cg_ * 64 + (tid & 63);
  for (int e = tid; e < 9 * 1024; e += 256) {
    int r = e >> 10, k = e & 1023;
    sl[e] = siluf(r < 8 ? p.c[r * 1024 + k] : p.c_ctx[k]);
  }
  __syncthreads();
  float acc[9];
#pragma unroll
  for (int r = 0; r < 9; ++r) acc[r] = 0.f;
  const float* w = p.ada_w + (size_t)layer * 1024 * 6144 + col;
#pragma unroll 8
  for (int k = kq * 256; k < kq * 256 + 256; ++k) {
    float wv = w[(size_t)k * 6144];
#pragma unroll
    for (int r = 0; r < 9; ++r) acc[r] += sl[r * 1024 + k] * wv;
  }
#pragma unroll
  for (int r = 0; r < 9; ++r) red[(kq * 9 + r) * 64 + (tid & 63)] = acc[r];
  __syncthreads();
  if (tid < 64) {
    float* mod = (float*)(p.ws + OFF_MOD);
    float bias = p.ada_b[layer * 6144 + col];
#pragma unroll
    for (int r = 0; r < 9; ++r) {
      float s = red[(0 * 9 + r) * 64 + tid] + red[(1 * 9 + r) * 64 + tid] + red[(2 * 9 + r) * 64 + tid] + red[(3 * 9 + r) * 64 + tid];
      mod[((size_t)layer * 9 + r) * 6144 + col] = s + bias;
    }
  }
  __syncthreads();
}

__device__ __forceinline__ void hyena_mlp_item(const Params& p, int item, char* lds) {
  float* zb = (float*)lds;
  float* h1 = zb + 256;
  float* h2 = h1 + 256;
  int tid = otid(), ti = tid >> 6, j = tid & 63;
  int t = item * 4 + ti;
  const float L = 4096.f;
  if (j < 33) {
    float v;
    if (j == 0) v = (float)t / 4095.f;
    else {
      int k = (j - 1) & 15;
      float fb = 1e-4f + (float)k * ((15.f - 1e-4f) / 15.f);
      float ang = 6.283185307179586f * (float)t / L;
      float a = fb * ang;
      v = (j <= 16) ? cosf(a) : -sinf(a);
    }
    zb[ti * 64 + j] = v;
  }
  __syncthreads();
  float fr = p.h_freq[j];
  float s = p.h_f_b1[j];
#pragma unroll 3
  for (int i = 0; i < 33; ++i) s += zb[ti * 64 + i] * p.h_f_w1[i * 64 + j];
  h1[ti * 64 + j] = sinf(fr * s);
  __syncthreads();
  s = p.h_f_b2[j];
#pragma unroll 8
  for (int i = 0; i < 64; ++i) s += h1[ti * 64 + i] * p.h_f_w2[i * 64 + j];
  h2[ti * 64 + j] = sinf(fr * s);
  __syncthreads();
  s = p.h_f_b2[64 + j];
#pragma unroll 8
  for (int i = 0; i < 64; ++i) s += h2[ti * 64 + i] * p.h_f_w2[4096 + i * 64 + j];
  float* hid = (float*)(p.ws + OFF_HID);
  hid[t * 64 + j] = sinf(fr * s);
  __syncthreads();
}

__device__ __forceinline__ void phase_prologue(const Params& p, char* lds) {
  constexpr int T0 = 1296, T1 = T0 + 512, T2 = T1 + 768, T3 = T2 + 256, T4 = T3 + 512, T5 = T4 + 512, T6 = T5 + 192, T7 = T6 + 1024, T8 = T7 + 256, T9 = T8 + 16;
  for (int item = blockIdx.x; item < T9; item += gridDim.x) {
    if (item < T0) transpose_w_tile(p.m_w_in, SSM_IN, 1024, SSM_IN, (u16*)(p.ws + OFF_W_IN), item, lds);
    else if (item < T1) transpose_w_tile(p.m_w_out, 1024, 2048, 1024, (u16*)(p.ws + OFF_W_OUT), item - T0, lds);
    else if (item < T2) transpose_w_tile(p.h_w_in, 3072, 1024, 3072, (u16*)(p.ws + OFF_W_HIN), item - T1, lds);
    else if (item < T3) transpose_w_tile(p.h_w_out, 1024, 1024, 1024, (u16*)(p.ws + OFF_W_HOUT), item - T2, lds);
    else if (item < T4) transpose_w_tile(p.p_wq, 2048, 1024, 2048, (u16*)(p.ws + OFF_W_Q), item - T3, lds);
    else if (item < T5) transpose_w_tile(p.p_wq + (size_t)1024 * 2048, 2048, 1024, 2048, (u16*)(p.ws + OFF_W_Q) + (size_t)2048 * 1024, item - T4, lds);
    else if (item < T6) ada_item(p, item - T5, lds);
    else if (item < T7) hyena_mlp_item(p, item - T6, lds);
    else if (item >= T8) {
      int k = (item - T8) * 256 + threadIdx.x;
      float sn, cs;
      sincospif((float)k * (1.f / 4096.f), &sn, &cs);
      ((float2*)(p.ws + OFF_TW))[k] = make_float2(cs, -sn);
    } else {
      int e8 = ((item - T7) * 256 + threadIdx.x) * 8;
      const float* src = e8 < 262144 ? p.p_k1 + e8 : p.p_k2 + (e8 - 262144);
      float4 a0 = *reinterpret_cast<const float4*>(src), a1 = *reinterpret_cast<const float4*>(src + 4);
      uint4 o;
      o.x = pack2(a0.x, a0.y); o.y = pack2(a0.z, a0.w); o.z = pack2(a1.x, a1.y); o.w = pack2(a1.z, a1.w);
      *reinterpret_cast<uint4*>((u16*)(p.ws + OFF_KEYS) + e8) = o;
    }
  }
}

__device__ __forceinline__ void modulate_rows(const float* src, u16* dst, int nrows, int rows_per_batch, const float* modbase, int sh_off, int sc_off, bool ctxrow) {
  size_t total = (size_t)nrows * 128;
  for (size_t e = (size_t)blockIdx.x * 256 + threadIdx.x; e < total; e += (size_t)gridDim.x * 256) {
    int row = (int)(e >> 7), c8 = (int)(e & 127) * 8;
    int b = ctxrow ? 8 : row / rows_per_batch;
    const float* m = modbase + (size_t)b * 6144;
    float4 a0 = *reinterpret_cast<const float4*>(src + (size_t)row * 1024 + c8);
    float4 a1 = *reinterpret_cast<const float4*>(src + (size_t)row * 1024 + c8 + 4);
    float4 s0 = *reinterpret_cast<const float4*>(m + sc_off + c8);
    float4 s1 = *reinterpret_cast<const float4*>(m + sc_off + c8 + 4);
    float4 h0 = *reinterpret_cast<const float4*>(m + sh_off + c8);
    float4 h1 = *reinterpret_cast<const float4*>(m + sh_off + c8 + 4);
    uint4 o;
    o.x = pack2(a0.x * (1.f + s0.x) + h0.x, a0.y * (1.f + s0.y) + h0.y);
    o.y = pack2(a0.z * (1.f + s0.z) + h0.z, a0.w * (1.f + s0.w) + h0.w);
    o.z = pack2(a1.x * (1.f + s1.x) + h1.x, a1.y * (1.f + s1.y) + h1.y);
    o.w = pack2(a1.z * (1.f + s1.z) + h1.z, a1.w * (1.f + s1.w) + h1.w);
    *reinterpret_cast<uint4*>(dst + (size_t)row * 1024 + c8) = o;
  }
}

constexpr int GLD = 72;
template <class Epi>
__device__ __forceinline__ void gemm_tile(const u16* __restrict__ A, int lda, const u16* __restrict__ Bt, int ldb, int brow, int bcol, int Nmax,
                                          int K, char* lds, Epi epi) {
  u16* SA = (u16*)lds;
  u16* SB = SA + 256 * GLD;
  int tid = otid(), wid = tid >> 6, lane = tid & 63, wr = wid >> 1, wc = wid & 1, fr = lane & 15, fq = lane >> 4;
  f32x4 acc[8][4];
#pragma unroll
  for (int m = 0; m < 8; ++m)
#pragma unroll
    for (int n = 0; n < 4; ++n) acc[m][n] = f32x4{0.f, 0.f, 0.f, 0.f};
  u32x4 ra[8], rb[4];
  const int lr = tid >> 3, lc = (tid & 7) * 8;
  const u16* abase = A + (size_t)brow * lda;
  const unsigned aoff = (unsigned)(lr * lda + lc);
  unsigned bo[4];
#pragma unroll
  for (int i = 0; i < 4; ++i) {
    int br = bcol + lr + i * 32;
    if (br >= Nmax) br = Nmax - 1;
    bo[i] = (unsigned)(br * ldb + lc);
  }
#define GLOADT(KT)                                                                                 \
  _Pragma("unroll") for (int i = 0; i < 8; ++i)                                                    \
    ra[i] = *reinterpret_cast<const u32x4*>(abase + (aoff + (unsigned)((i * 32) * lda + (KT) * 64))); \
  _Pragma("unroll") for (int i = 0; i < 4; ++i)                                                    \
    rb[i] = *reinterpret_cast<const u32x4*>(Bt + (bo[i] + (unsigned)((KT) * 64)));
  const int nk = K / 64;
  GLOADT(0)
  for (int kt = 0; kt < nk; ++kt) {
#pragma unroll
    for (int i = 0; i < 8; ++i) *reinterpret_cast<u32x4*>(SA + (lr + i * 32) * GLD + lc) = ra[i];
#pragma unroll
    for (int i = 0; i < 4; ++i) *reinterpret_cast<u32x4*>(SB + (lr + i * 32) * GLD + lc) = rb[i];
    __syncthreads();
    { const int kn = kt + 1 < nk ? kt + 1 : nk - 1; GLOADT(kn) }
#pragma unroll
    for (int kk = 0; kk < 2; ++kk) {
      bf16x8 Bl[4];
#pragma unroll
      for (int n = 0; n < 4; ++n) Bl[n] = ld8(SB + (wc * 64 + n * 16 + fr) * GLD + kk * 32 + fq * 8);
#pragma unroll
      for (int mh = 0; mh < 2; ++mh) {
        bf16x8 At[4];
#pragma unroll
        for (int m = 0; m < 4; ++m) At[m] = ld8(SA + (wr * 128 + (mh * 4 + m) * 16 + fr) * GLD + kk * 32 + fq * 8);
#pragma unroll
        for (int m = 0; m < 4; ++m)
#pragma unroll
          for (int n = 0; n < 4; ++n) acc[mh * 4 + m][n] = mfma16(Bl[n], At[m], acc[mh * 4 + m][n]);
      }
    }
    __syncthreads();
  }
#undef GLOADT
#pragma unroll
  for (int m = 0; m < 8; ++m)
#pragma unroll
    for (int n = 0; n < 4; ++n) epi(brow + wr * 128 + m * 16 + fr, bcol + wc * 64 + n * 16 + fq * 4, acc[m][n]);
}

DEV float softplusf(float v) { return fmaxf(v, 0.f) + log1pf(__expf(-fabsf(v))); }

__device__ __forceinline__ void phase_gemm_inproj(const Params& p, char* lds) {
  const u16* hx = (const u16*)(p.ws + OFF_R2);
  const u16* hc = (const u16*)(p.ws + OFF_HC);
  const u16* Wt = (const u16*)(p.ws + OFF_W_IN);
  u16* zbuf = (u16*)p.out;
  u16* xbc = (u16*)(p.ws + OFF_R1);
  float* dt = (float*)(p.ws + OFF_DT);
  u16* xbc_c = (u16*)(p.ws + OFF_XBC_C);
  float* dt_c = (float*)(p.ws + OFF_DT_C);
  const float* dtb = p.m_dt_bias;
  const int xcd = blockIdx.x & 7, li = blockIdx.x >> 3, nl = gridDim.x >> 3;
  auto epi_lat = [=](int m, int n, f32x4 v) {
    if (n < 2048) *reinterpret_cast<uint2*>(zbuf + (size_t)m * 2048 + n) = make_uint2(pack2(v[0], v[1]), pack2(v[2], v[3]));
    else if (n < 5120) *reinterpret_cast<uint2*>(xbc + (size_t)m * 3072 + (n - 2048)) = make_uint2(pack2(v[0], v[1]), pack2(v[2], v[3]));
    else if (n < 5184) {
      float4 bb = *reinterpret_cast<const float4*>(dtb + (n - 5120));
      *reinterpret_cast<float4*>(dt + (size_t)m * 64 + (n - 5120)) = make_float4(softplusf(v[0] + bb.x), softplusf(v[1] + bb.y), softplusf(v[2] + bb.z), softplusf(v[3] + bb.w));
    }
  };
  auto epi_ctx = [=](int m, int n, f32x4 v) {
    if (n < 3072) *reinterpret_cast<uint2*>(xbc_c + (size_t)m * 3072 + n) = make_uint2(pack2(v[0], v[1]), pack2(v[2], v[3]));
    else if (n < 3136) {
      float4 bb = *reinterpret_cast<const float4*>(dtb + (n - 3072));
      *reinterpret_cast<float4*>(dt_c + (size_t)m * 64 + (n - 3072)) = make_float4(softplusf(v[0] + bb.x), softplusf(v[1] + bb.y), softplusf(v[2] + bb.z), softplusf(v[3] + bb.w));
    }
  };
  for (int t = li; t < 128 * 5; t += nl) {
    int pm = t / 5, pn = xcd + 8 * (t % 5);
    gemm_tile(hx, 1024, Wt, 1024, pm * 256, pn * 128, SSM_IN, 1024, lds, epi_lat);
  }
  for (int t = blockIdx.x; t < 128 + 8 * 25; t += gridDim.x) {
    if (t < 128) gemm_tile(hx, 1024, Wt, 1024, t * 256, 40 * 128, SSM_IN, 1024, lds, epi_lat);
    else {
      int it = t - 128, pm = it / 25, pn = it % 25;
      gemm_tile(hc, 1024, Wt + (size_t)2048 * 1024, 1024, pm * 256, pn * 128, 3136, 1024, lds, epi_ctx);
    }
  }
}

DEV void fma8(float* acc, const u32x4& v, const float* w) {
  acc[0] += bflo(v[0]) * w[0]; acc[1] += bfhi(v[0]) * w[1]; acc[2] += bflo(v[1]) * w[2]; acc[3] += bfhi(v[1]) * w[3];
  acc[4] += bflo(v[2]) * w[4]; acc[5] += bfhi(v[2]) * w[5]; acc[6] += bflo(v[3]) * w[6]; acc[7] += bfhi(v[3]) * w[7];
}
__device__ __forceinline__ void phase_conv(const Params& p) {
  const u16* xbc = (const u16*)(p.ws + OFF_R1);
  u16* xc = (u16*)(p.ws + OFF_R2);
  const u16* xbc_c = (const u16*)(p.ws + OFF_XBC_C);
  u16* xc_c = (u16*)(p.ws + OFF_XC_C);
  const float* cw = p.m_conv_w;
  const float* cb = p.m_conv_b;
  const int tid_ = otid();
  const size_t nl = (size_t)8 * 64 * 8 * 384;
  for (size_t e = (size_t)blockIdx.x * 256 + tid_; e < nl; e += (size_t)gridDim.x * 256) {
    int ch = (int)(e % 384) * 8;
    int rest = (int)(e / 384);
    int cg_ = rest & 7, r = (rest >> 3) & 63, b = rest >> 9;
    float w[9][8];
#pragma unroll
    for (int k = 0; k < 9; ++k) {
      float4 w0 = *reinterpret_cast<const float4*>(cw + k * 3072 + ch), w1 = *reinterpret_cast<const float4*>(cw + k * 3072 + ch + 4);
      w[k][0] = w0.x; w[k][1] = w0.y; w[k][2] = w0.z; w[k][3] = w0.w; w[k][4] = w1.x; w[k][5] = w1.y; w[k][6] = w1.z; w[k][7] = w1.w;
    }
    float bias[8];
    {
      float4 b0 = *reinterpret_cast<const float4*>(cb + ch), b1 = *reinterpret_cast<const float4*>(cb + ch + 4);
      bias[0] = b0.x; bias[1] = b0.y; bias[2] = b0.z; bias[3] = b0.w; bias[4] = b1.x; bias[5] = b1.y; bias[6] = b1.z; bias[7] = b1.w;
    }
    const u32x4 zero4 = u32x4{0u, 0u, 0u, 0u};
    const int c0 = cg_ * 8;
    u32x4 win[3][3];
#pragma unroll
    for (int i = 0; i < 3; ++i) {
      int rr = r + i - 1;
      bool rok = rr >= 0 && rr <= 63;
      const u16* rowp = xbc + ((size_t)(b * 4096 + (rok ? rr : r) * 64)) * 3072 + ch;
      win[i][0] = (rok && c0 > 0) ? *reinterpret_cast<const u32x4*>(rowp + (size_t)(c0 - 1) * 3072) : zero4;
      win[i][1] = rok ? *reinterpret_cast<const u32x4*>(rowp + (size_t)c0 * 3072) : zero4;
    }
#pragma unroll
    for (int cc = 0; cc < 8; ++cc) {
      int c = c0 + cc;
#pragma unroll
      for (int i = 0; i < 3; ++i) {
        int rr = r + i - 1;
        bool rok = rr >= 0 && rr <= 63;
        const u16* rowp = xbc + ((size_t)(b * 4096 + (rok ? rr : r) * 64)) * 3072 + ch;
        win[i][2] = (rok && c < 63) ? *reinterpret_cast<const u32x4*>(rowp + (size_t)(c + 1) * 3072) : zero4;
      }
      float acc[8];
#pragma unroll
      for (int k = 0; k < 8; ++k) acc[k] = bias[k];
#pragma unroll
      for (int i = 0; i < 3; ++i)
#pragma unroll
        for (int j = 0; j < 3; ++j) fma8(acc, win[i][j], w[i * 3 + j]);
      uint4 o;
      o.x = pack2(siluf(acc[0]), siluf(acc[1]));
      o.y = pack2(siluf(acc[2]), siluf(acc[3]));
      o.z = pack2(siluf(acc[4]), siluf(acc[5]));
      o.w = pack2(siluf(acc[6]), siluf(acc[7]));
      *reinterpret_cast<uint4*>(xc + ((size_t)(b * 4096 + r * 64 + c)) * 3072 + ch) = o;
#pragma unroll
      for (int i = 0; i < 3; ++i) { win[i][0] = win[i][1]; win[i][1] = win[i][2]; }
    }
  }
  const size_t ncx = (size_t)NTC * 384;
  for (size_t e = (size_t)blockIdx.x * 256 + tid_; e < ncx; e += (size_t)gridDim.x * 256) {
    int tok = (int)(e / 384), ch = (int)(e % 384) * 8;
    float acc[8];
#pragma unroll
    for (int k = 0; k < 8; ++k) acc[k] = cb[ch + k];
    int b = tok >> 8, c = tok & 255;
#pragma unroll
    for (int j = 0; j < 3; ++j) {
      int cc = c + j - 1;
      if (cc < 0 || cc > 255) continue;
      uint4 v = *reinterpret_cast<const uint4*>(xbc_c + ((size_t)(b * 256 + cc)) * 3072 + ch);
      const float* w = cw + (3 + j) * 3072 + ch;
      float4 w0 = *reinterpret_cast<const float4*>(w), w1 = *reinterpret_cast<const float4*>(w + 4);
      acc[0] += bflo(v.x) * w0.x; acc[1] += bfhi(v.x) * w0.y; acc[2] += bflo(v.y) * w0.z; acc[3] += bfhi(v.y) * w0.w;
      acc[4] += bflo(v.z) * w1.x; acc[5] += bfhi(v.z) * w1.y; acc[6] += bflo(v.w) * w1.z; acc[7] += bfhi(v.w) * w1.w;
    }
    uint4 o;
    o.x = pack2(siluf(acc[0]), siluf(acc[1]));
    o.y = pack2(siluf(acc[2]), siluf(acc[3]));
    o.z = pack2(siluf(acc[4]), siluf(acc[5]));
    o.w = pack2(siluf(acc[6]), siluf(acc[7]));
    *reinterpret_cast<uint4*>(xc_c + (size_t)tok * 3072 + ch) = o;
  }
}

constexpr int SLD = 136;
__device__ __forceinline__ void phase_ssd(const Params& p, char* lds) {
  u16* xsT = (u16*)lds;
  u16* stb = xsT + 64 * SLD;
  u16* Mb = stb + 64 * SLD;
  float* cum = (float*)(Mb + 128 * SLD);
  float* dtv = cum + 128;
  float* asrc = dtv + 128;
  const u16* xc = (const u16*)(p.ws + OFF_R2);
  const u16* xc_c = (const u16*)(p.ws + OFF_XC_C);
  const float* dt = (const float*)(p.ws + OFF_DT);
  const float* dt_c = (const float*)(p.ws + OFF_DT_C);
  u16* y = (u16*)(p.ws + OFF_R1);
  int tid = otid(), w = tid >> 6, lane = tid & 63, fr = lane & 15, fq = lane >> 4;
  unsigned char* yb8 = (unsigned char*)(p.ws + OFF_R1 + 128 * MiB);
  for (int item = blockIdx.x; item < 512; item += gridDim.x) {
    int b = item >> 6, h = (item >> 1) & 31, g = h >> 3;
    float dsk = p.m_d[h];
    {
      const int dir = item & 1;
      float a_neg = -__expf(p.m_a_log[dir * 32 + h]);
      f32x4 acc_s[8];
#pragma unroll
      for (int n = 0; n < 8; ++n) acc_s[n] = f32x4{0.f, 0.f, 0.f, 0.f};
      for (int step = 0; step < 34; ++step) {
        bool isctx = step < 2;
        int cidx = isctx ? step : step - 2;
        if (dir) cidx = (isctx ? 1 : 31) - cidx;
        size_t tok0 = isctx ? (size_t)(b * 256 + cidx * 128) : (size_t)(b * 4096 + cidx * 128);
        const u16* src = (isctx ? xc_c : xc) + tok0 * 3072;
        const float* dts = (isctx ? dt_c : dt) + tok0 * 64;
        int tz = tid;
        asm volatile("" : "+v"(tz));
        float dval = 0.f;
        if (tid < 128) dval = dts[tid * 64 + dir * 32 + h];
        uint4 xv[4], bv[8];
#pragma unroll
        for (int i = 0; i < 4; ++i) {
          int idx = tz + i * 256, l = (idx & 31) | ((idx >> 8) << 5), pc = ((idx >> 5) & 7) * 8;
          xv[i] = *reinterpret_cast<const uint4*>(src + (size_t)l * 3072 + h * 64 + pc);
        }
#pragma unroll
        for (int i = 0; i < 8; ++i) {
          int idx = tz + i * 256, l = (idx & 31) | (((idx >> 9) & 3) << 5), nc = (((idx >> 5) & 7) | (((idx >> 8) & 1) << 3)) * 8;
          bv[i] = *reinterpret_cast<const uint4*>(src + (size_t)l * 3072 + 2048 + g * 128 + nc);
        }
        if (tid < 128) { dtv[tid] = dval; asrc[tid] = dval * a_neg; }
#pragma unroll
        for (int i = 0; i < 4; ++i) {
          int idx = tz + i * 256, l = (idx & 31) | ((idx >> 8) << 5), pc = ((idx >> 5) & 7) * 8;
          uint4 v = xv[i];
          xsT[(pc + 0) * SLD + l] = (u16)(v.x & 0xffff); xsT[(pc + 1) * SLD + l] = (u16)(v.x >> 16);
          xsT[(pc + 2) * SLD + l] = (u16)(v.y & 0xffff); xsT[(pc + 3) * SLD + l] = (u16)(v.y >> 16);
          xsT[(pc + 4) * SLD + l] = (u16)(v.z & 0xffff); xsT[(pc + 5) * SLD + l] = (u16)(v.z >> 16);
          xsT[(pc + 6) * SLD + l] = (u16)(v.w & 0xffff); xsT[(pc + 7) * SLD + l] = (u16)(v.w >> 16);
        }
        if (!isctx) {
#pragma unroll
          for (int i = 0; i < 8; ++i) {
            int idx = tz + i * 256, l = (idx & 31) | (((idx >> 9) & 3) << 5), nc = (((idx >> 5) & 7) | (((idx >> 8) & 1) << 3)) * 8;
            *reinterpret_cast<uint4*>(Mb + l * SLD + nc) = bv[i];
          }
        }
        __syncthreads();
        bf16x8 Cf[2][4];
        if (!isctx) {
#pragma unroll
          for (int mt = 0; mt < 2; ++mt)
#pragma unroll
            for (int kk = 0; kk < 4; ++kk) Cf[mt][kk] = ld8(src + (size_t)(w * 32 + mt * 16 + fr) * 3072 + 2560 + g * 128 + kk * 32 + fq * 8);
        }
        if (tid < 128) {
          float s = 0.f;
          if (!dir) { for (int j = 0; j <= tid; ++j) s += asrc[j]; }
          else { for (int j = tid; j < 128; ++j) s += asrc[j]; }
          cum[tid] = s;
        }
        __syncthreads();
        float total = dir ? cum[0] : cum[127];
        if (!isctx) {
          float cl[2][4];
#pragma unroll
          for (int mt = 0; mt < 2; ++mt)
#pragma unroll
            for (int j = 0; j < 4; ++j) cl[mt][j] = cum[w * 32 + mt * 16 + fq * 4 + j];
          f32x4 cb0[8], cb1[8];
#pragma unroll
          for (int nt = 0; nt < 8; ++nt) {
            cb0[nt] = f32x4{0.f, 0.f, 0.f, 0.f};
            cb1[nt] = f32x4{0.f, 0.f, 0.f, 0.f};
            bool need = dir ? (nt >= w * 2) : (nt <= w * 2 + 1);
            if (need) {
#pragma unroll
              for (int kk = 0; kk < 4; ++kk) {
                bf16x8 Bf = ld8(Mb + (nt * 16 + fr) * SLD + kk * 32 + fq * 8);
                cb0[nt] = mfma16(Cf[0][kk], Bf, cb0[nt]);
                cb1[nt] = mfma16(Cf[1][kk], Bf, cb1[nt]);
              }
            }
          }
          __syncthreads();
          int zero = 0;
          asm volatile("" : "+v"(zero));
#pragma unroll
          for (int nt = 0; nt < 8; ++nt) {
            int s = nt * 16 + fr + zero;
            float cs = cum[s], ds = dtv[s];
#pragma unroll
            for (int j = 0; j < 4; ++j) {
              int l0 = w * 32 + fq * 4 + j, l1 = l0 + 16;
              bool ok0 = dir ? (s >= l0) : (s <= l0);
              bool ok1 = dir ? (s >= l1) : (s <= l1);
              float v0 = ok0 ? cb0[nt][j] * __expf(cl[0][j] - cs) * ds : 0.f;
              float v1 = ok1 ? cb1[nt][j] * __expf(cl[1][j] - cs) * ds : 0.f;
              Mb[l0 * SLD + s] = f2bf(v0);
              Mb[l1 * SLD + s] = f2bf(v1);
            }
          }
          __syncthreads();
          f32x4 ya[2][4];
#pragma unroll
          for (int mt = 0; mt < 2; ++mt)
#pragma unroll
            for (int nt = 0; nt < 4; ++nt) ya[mt][nt] = f32x4{0.f, 0.f, 0.f, 0.f};
#pragma unroll
          for (int kk = 0; kk < 4; ++kk)
#pragma unroll
            for (int nt = 0; nt < 4; ++nt) {
              bf16x8 Sf = ld8(stb + (nt * 16 + fr) * SLD + kk * 32 + fq * 8);
              ya[0][nt] = mfma16(Sf, Cf[0][kk], ya[0][nt]);
              ya[1][nt] = mfma16(Sf, Cf[1][kk], ya[1][nt]);
            }
#pragma unroll
          for (int mt = 0; mt < 2; ++mt) {
            float e = __expf(cum[w * 32 + mt * 16 + fr]);
#pragma unroll
            for (int nt = 0; nt < 4; ++nt) ya[mt][nt] *= e;
          }
#pragma unroll
          for (int kk = 0; kk < 4; ++kk) {
            bf16x8 Mf0 = ld8(Mb + (w * 32 + fr) * SLD + kk * 32 + fq * 8);
            bf16x8 Mf1 = ld8(Mb + (w * 32 + 16 + fr) * SLD + kk * 32 + fq * 8);
#pragma unroll
            for (int nt = 0; nt < 4; ++nt) {
              bf16x8 Xf = ld8(xsT + (nt * 16 + fr) * SLD + kk * 32 + fq * 8);
              ya[0][nt] = mfma16(Xf, Mf0, ya[0][nt]);
              ya[1][nt] = mfma16(Xf, Mf1, ya[1][nt]);
            }
          }
#pragma unroll
          for (int i = 0; i < 8; ++i) {
            int idx = tz + i * 256, l = (idx & 31) | (((idx >> 9) & 3) << 5), nc = (((idx >> 5) & 7) | (((idx >> 8) & 1) << 3)) * 8;
            bv[i] = *reinterpret_cast<const uint4*>(src + (size_t)l * 3072 + 2048 + g * 128 + nc);
          }
#pragma unroll
          for (int mt = 0; mt < 2; ++mt)
#pragma unroll
            for (int nt = 0; nt < 4; ++nt) {
              const int l = w * 32 + mt * 16 + fr, p0 = nt * 16 + fq * 4;
              f32x4 v = ya[mt][nt];
              if (!dir) {
                v[0] += bf2f(xsT[(p0 + 0) * SLD + l]) * dsk; v[1] += bf2f(xsT[(p0 + 1) * SLD + l]) * dsk;
                v[2] += bf2f(xsT[(p0 + 2) * SLD + l]) * dsk; v[3] += bf2f(xsT[(p0 + 3) * SLD + l]) * dsk;
                *reinterpret_cast<uint2*>(y + (tok0 + l) * 2048 + h * 64 + p0) = make_uint2(pack2(v[0], v[1]), pack2(v[2], v[3]));
              } else {
                int pk = __builtin_amdgcn_cvt_pk_fp8_f32(fminf(fmaxf(v[0] * 4.f, -440.f), 440.f), fminf(fmaxf(v[1] * 4.f, -440.f), 440.f), 0, false);
                pk = __builtin_amdgcn_cvt_pk_fp8_f32(fminf(fmaxf(v[2] * 4.f, -440.f), 440.f), fminf(fmaxf(v[3] * 4.f, -440.f), 440.f), pk, true);
                *reinterpret_cast<int*>(yb8 + (tok0 + l) * 2048 + h * 64 + p0) = pk;
              }
            }
        }
        if (step == 33) continue;
        __syncthreads();
#pragma unroll
        for (int i = 0; i < 8; ++i) {
          int idx = tz + i * 256, l = (idx & 31) | (((idx >> 9) & 3) << 5), nc = (((idx >> 5) & 7) | (((idx >> 8) & 1) << 3)) * 8;
          uint4 v = bv[i];
          float sc = dtv[l] * __expf(total - cum[l]);
          Mb[(nc + 0) * SLD + l] = f2bf(bflo(v.x) * sc); Mb[(nc + 1) * SLD + l] = f2bf(bfhi(v.x) * sc);
          Mb[(nc + 2) * SLD + l] = f2bf(bflo(v.y) * sc); Mb[(nc + 3) * SLD + l] = f2bf(bfhi(v.y) * sc);
          Mb[(nc + 4) * SLD + l] = f2bf(bflo(v.z) * sc); Mb[(nc + 5) * SLD + l] = f2bf(bfhi(v.z) * sc);
          Mb[(nc + 6) * SLD + l] = f2bf(bflo(v.w) * sc); Mb[(nc + 7) * SLD + l] = f2bf(bfhi(v.w) * sc);
        }
        __syncthreads();
        float cd = __expf(total);
#pragma unroll
        for (int nt = 0; nt < 8; ++nt) acc_s[nt] *= cd;
#pragma unroll
        for (int kk = 0; kk < 4; ++kk) {
          bf16x8 Af = ld8(xsT + (w * 16 + fr) * SLD + kk * 32 + fq * 8);
#pragma unroll
          for (int nt = 0; nt < 8; ++nt) {
            bf16x8 Bf = ld8(Mb + (nt * 16 + fr) * SLD + kk * 32 + fq * 8);
            acc_s[nt] = mfma16(Af, Bf, acc_s[nt]);
          }
        }
#pragma unroll
        for (int nt = 0; nt < 8; ++nt)
#pragma unroll
          for (int j = 0; j < 4; ++j) stb[(w * 16 + fq * 4 + j) * SLD + nt * 16 + fr] = f2bf(acc_s[nt][j]);
        __syncthreads();
      }
      __syncthreads();
    }
  }
}

__device__ __forceinline__ void phase_gated_norm(const Params& p) {
  u16* y = (u16*)(p.ws + OFF_R1);
  const u16* z = (const u16*)p.out;
  const unsigned char* yb8 = (const unsigned char*)(p.ws + OFF_R1 + 128 * MiB);
  const int tid_ = otid();
  int lane = tid_ & 63;
  int wave = blockIdx.x * 4 + (tid_ >> 6), nw = gridDim.x * 4;
  for (int tok = wave; tok < NT; tok += nw) {
#pragma unroll
    for (int g = 0; g < 4; ++g) {
      int ch = g * 512 + lane * 8;
      uint4 yv = *reinterpret_cast<const uint4*>(y + (size_t)tok * 2048 + ch);
      uint4 zv = *reinterpret_cast<const uint4*>(z + (size_t)tok * 2048 + ch);
      uint2 bw = *reinterpret_cast<const uint2*>(yb8 + (size_t)tok * 2048 + ch);
      f32x2 b01 = __builtin_amdgcn_cvt_pk_f32_fp8((int)bw.x, false), b23 = __builtin_amdgcn_cvt_pk_f32_fp8((int)bw.x, true);
      f32x2 b45 = __builtin_amdgcn_cvt_pk_f32_fp8((int)bw.y, false), b67 = __builtin_amdgcn_cvt_pk_f32_fp8((int)bw.y, true);
      const float r16 = 0.25f;
      float u[8];
      u[0] = (bflo(yv.x) + b01.x * r16) * siluf(bflo(zv.x)); u[1] = (bfhi(yv.x) + b01.y * r16) * siluf(bfhi(zv.x));
      u[2] = (bflo(yv.y) + b23.x * r16) * siluf(bflo(zv.y)); u[3] = (bfhi(yv.y) + b23.y * r16) * siluf(bfhi(zv.y));
      u[4] = (bflo(yv.z) + b45.x * r16) * siluf(bflo(zv.z)); u[5] = (bfhi(yv.z) + b45.y * r16) * siluf(bfhi(zv.z));
      u[6] = (bflo(yv.w) + b67.x * r16) * siluf(bflo(zv.w)); u[7] = (bfhi(yv.w) + b67.y * r16) * siluf(bfhi(zv.w));
      float ss = 0.f;
#pragma unroll
      for (int k = 0; k < 8; ++k) ss += u[k] * u[k];
      ss = wave_sum(ss);
      float sc = rsqrtf(ss * (1.f / 512.f) + 1e-5f);
      float4 w0 = *reinterpret_cast<const float4*>(p.m_norm_w + ch), w1 = *reinterpret_cast<const float4*>(p.m_norm_w + ch + 4);
      uint4 o;
      o.x = pack2(u[0] * sc * w0.x, u[1] * sc * w0.y);
      o.y = pack2(u[2] * sc * w0.z, u[3] * sc * w0.w);
      o.z = pack2(u[4] * sc * w1.x, u[5] * sc * w1.y);
      o.w = pack2(u[6] * sc * w1.z, u[7] * sc * w1.w);
      *reinterpret_cast<uint4*>(y + (size_t)tok * 2048 + ch) = o;
    }
  }
}

__device__ __forceinline__ void phase_gemm_resid(const u16* A, int K, const u16* Wt, const float* res, float* dst, const float* gate  , char* lds) {
  const int xcd = blockIdx.x & 7, li = blockIdx.x >> 3, nl = gridDim.x >> 3;
  for (int t = li; t < 128; t += nl) {
    int pm = t, pn = xcd;
    gemm_tile(A, K, Wt, K, pm * 256, pn * 128, 1024, K, lds, [=](int m, int n, f32x4 v) {
      int b = m >> 12;
      float4 r = *reinterpret_cast<const float4*>(res + (size_t)m * 1024 + n);
      float4 g = *reinterpret_cast<const float4*>(gate + (size_t)b * 6144 + n);
      *reinterpret_cast<float4*>(dst + (size_t)m * 1024 + n) = make_float4(ALPHA * r.x + g.x * v[0], ALPHA * r.y + g.y * v[1], ALPHA * r.z + g.z * v[2], ALPHA * r.w + g.w * v[3]);
    });
  }
}
__device__ __forceinline__ void phase_gemm_bf16(const u16* A, const u16* Wt, u16* dst, int N, char* lds) {
  const int xcd = blockIdx.x & 7, li = blockIdx.x >> 3, nl = gridDim.x >> 3;
  const int nb = N / 1024;
  for (int t = li; t < 128 * nb; t += nl) {
    int pm = t / nb, pn = xcd + 8 * (t % nb);
    gemm_tile(A, 1024, Wt, 1024, pm * 256, pn * 128, N, 1024, lds, [=](int m, int n, f32x4 v) { *reinterpret_cast<uint2*>(dst + (size_t)m * N + n) = make_uint2(pack2(v[0], v[1]), pack2(v[2], v[3])); });
  }
}

__device__ __forceinline__ void phase_ln_mod(float* xio, const float* g, const float* bta, const float* mod  , u16* tdst) {
  const int tid_ = otid();
  int lane = tid_ & 63;
  int wave = blockIdx.x * 4 + (tid_ >> 6), nw = gridDim.x * 4;
  for (int tok = wave; tok < NT; tok += nw) {
    int b = tok >> 12;
    float4 v[4];
    float s = 0.f;
#pragma unroll
    for (int i = 0; i < 4; ++i) {
      v[i] = *reinterpret_cast<const float4*>(xio + (size_t)tok * 1024 + i * 256 + lane * 4);
      s += v[i].x + v[i].y + v[i].z + v[i].w;
    }
    float mu = wave_sum(s) * (1.f / 1024.f);
    float q = 0.f;
#pragma unroll
    for (int i = 0; i < 4; ++i) {
      v[i].x -= mu; v[i].y -= mu; v[i].z -= mu; v[i].w -= mu;
      q += v[i].x * v[i].x + v[i].y * v[i].y + v[i].z * v[i].z + v[i].w * v[i].w;
    }
    float rs = rsqrtf(wave_sum(q) * (1.f / 1024.f) + 1e-5f);
    const float* m = mod + (size_t)b * 6144;
#pragma unroll
    for (int i = 0; i < 4; ++i) {
      int c = i * 256 + lane * 4;
      float4 gg = *reinterpret_cast<const float4*>(g + c), bb = *reinterpret_cast<const float4*>(bta + c);
      float4 o;
      o.x = v[i].x * rs * gg.x + bb.x; o.y = v[i].y * rs * gg.y + bb.y; o.z = v[i].z * rs * gg.z + bb.z; o.w = v[i].w * rs * gg.w + bb.w;
      *reinterpret_cast<float4*>(xio + (size_t)tok * 1024 + c) = o;
      float4 sh = *reinterpret_cast<const float4*>(m + 3072 + c), sc = *reinterpret_cast<const float4*>(m + 4096 + c);
      uint2 t;
      t.x = pack2(o.x * (1.f + sc.x) + sh.x, o.y * (1.f + sc.y) + sh.y);
      t.y = pack2(o.z * (1.f + sc.z) + sh.z, o.w * (1.f + sc.w) + sh.w);
      *reinterpret_cast<uint2*>(tdst + (size_t)tok * 1024 + c) = t;
    }
  }
}

__device__ __forceinline__ void phase_peer_topk(const u16* q, const u16* k1, const u16* k2, int* idxo, float* gateo, char* lds) {
  float* S = (float*)lds;
  float* sv = S + 64 * 129;
  int* si = (int*)(sv + 64 * 16);
  int tid = otid(), w = tid >> 6, lane = tid & 63, fr = lane & 15, fq = lane >> 4;
  const int slot = lane;
  const bool cvalid = lane < 50;
  int ci = slot < 42 ? ((slot >= 16) + (slot >= 24) + (slot >= 29) + (slot >= 33) + (slot >= 36) + (slot >= 38) + (slot >= 40)) : slot - 34;
  const unsigned long long PACK = 0ull | (16ull << 8) | (24ull << 16) | (29ull << 24) | (33ull << 32) | (36ull << 40) | (38ull << 48) | (40ull << 56);
  int cj = slot - (ci < 8 ? (int)((PACK >> (8 * ci)) & 0xFF) : 34 + ci);
  if (!cvalid) { ci = 0; cj = 0; }
  for (int item = blockIdx.x; item < 1024 * 8; item += gridDim.x) {
    int tile = item >> 3, h = item & 7;
    int tok0 = tile * 32;
    {
      int half = w >> 1, kb = (w & 1) * 64;
      const u16* kk_ = (half ? k2 : k1) + (size_t)h * 128 * 128;
      bf16x8 Af[2][4], Bf[4][4];
#pragma unroll
      for (int m = 0; m < 2; ++m)
#pragma unroll
        for (int ks = 0; ks < 4; ++ks) Af[m][ks] = ld8(q + (size_t)(tok0 + m * 16 + fr) * 2048 + h * 256 + half * 128 + ks * 32 + fq * 8);
#pragma unroll
      for (int n = 0; n < 4; ++n)
#pragma unroll
        for (int ks = 0; ks < 4; ++ks) Bf[n][ks] = ld8(kk_ + (size_t)(kb + n * 16 + fr) * 128 + ks * 32 + fq * 8);
      f32x4 acc[2][4];
#pragma unroll
      for (int m = 0; m < 2; ++m)
#pragma unroll
        for (int n = 0; n < 4; ++n) acc[m][n] = f32x4{0.f, 0.f, 0.f, 0.f};
#pragma unroll
      for (int ks = 0; ks < 4; ++ks)
#pragma unroll
        for (int n = 0; n < 4; ++n) {
          acc[0][n] = mfma16(Af[0][ks], Bf[n][ks], acc[0][n]);
          acc[1][n] = mfma16(Af[1][ks], Bf[n][ks], acc[1][n]);
        }
#pragma unroll
      for (int m = 0; m < 2; ++m)
#pragma unroll
        for (int n = 0; n < 4; ++n)
#pragma unroll
          for (int j = 0; j < 4; ++j) S[(half * 32 + m * 16 + fq * 4 + j) * 129 + kb + n * 16 + fr] = acc[m][n][j];
    }
    __syncthreads();
    float nlo = S[(w * 16) * 129 + lane], nhi = S[(w * 16) * 129 + lane + 64];
#pragma unroll 1
    for (int li = 0; li < 16; ++li) {
      int list = w * 16 + li;
      float vlo = nlo, vhi = nhi;
      {
        const int ln = w * 16 + (li + 1 < 16 ? li + 1 : 15);
        nlo = S[ln * 129 + lane];
        nhi = S[ln * 129 + lane + 64];
      }
      unsigned klo = (ordkey(vlo) & 0xFFFFFF80u) | (unsigned)(127 - lane);
      unsigned khi = (ordkey(vhi) & 0xFFFFFF80u) | (unsigned)(63 - lane);
      unsigned T = 0;
#pragma unroll 4
      for (int bit = 31; bit >= 0; --bit) {
        unsigned cand = T | (1u << bit);
        int cnt = __popcll(__ballot(klo >= cand)) + __popcll(__ballot(khi >= cand));
        if (cnt >= 16) T = cand;
        if (cnt == 16) break;
      }
      bool slo = klo >= T, shi = khi >= T;
      unsigned long long mlo = __ballot(slo), mhi = __ballot(shi);
      int rlo = 0, rhi = 0;
      while (mlo) {
        int src = __ffsll((long long)mlo) - 1;
        mlo &= mlo - 1;
        unsigned ks = (unsigned)__builtin_amdgcn_readlane((int)klo, src);
        rlo += (ks > klo) ? 1 : 0;
        rhi += (ks > khi) ? 1 : 0;
      }
      while (mhi) {
        int src = __ffsll((long long)mhi) - 1;
        mhi &= mhi - 1;
        unsigned ks = (unsigned)__builtin_amdgcn_readlane((int)khi, src);
        rlo += (ks > klo) ? 1 : 0;
        rhi += (ks > khi) ? 1 : 0;
      }
      if (slo) { sv[list * 16 + rlo] = vlo; si[list * 16 + rlo] = lane; }
      if (shi) { sv[list * 16 + rhi] = vhi; si[list * 16 + rhi] = lane + 64; }
    }
    __syncthreads();
#pragma unroll 1
    for (int tt = 0; tt < 8; ++tt) {
      int tok = w * 8 + tt;
      float sc_ = sv[tok * 16 + ci] + sv[(32 + tok) * 16 + cj];
      unsigned key = cvalid ? ((ordkey(sc_) & 0xFFFFFFC0u) | (unsigned)(63 - lane)) : 0u;
      unsigned T = 0;
#pragma unroll 4
      for (int bit = 31; bit >= 0; --bit) {
        unsigned cand = T | (1u << bit);
        int cnt = __popcll(__ballot(key >= cand));
        if (cnt >= 16) T = cand;
        if (cnt == 16) break;
      }
      bool sel = cvalid && key >= T;
      unsigned long long msel = __ballot(sel);
      const int rank = (int)__builtin_amdgcn_mbcnt_hi((unsigned)(msel >> 32), __builtin_amdgcn_mbcnt_lo((unsigned)msel, 0u));
      const float mx = __int_as_float(__builtin_amdgcn_readlane(__float_as_int(sc_), 0));
      unsigned long long mm;
      float ex = sel ? __expf(sc_ - mx) : 0.f;
      int iex = __float_as_int(ex);
      float sum = 0.f;
      mm = msel;
      while (mm) {
        int src = __ffsll((long long)mm) - 1;
        mm &= mm - 1;
        sum += __int_as_float(__builtin_amdgcn_readlane(iex, src));
      }
      if (sel) {
        size_t o = (size_t)(tok0 + tok) * 128 + h * 16 + rank;
        gateo[o] = ex / sum;
        idxo[o] = si[tok * 16 + ci] * 128 + si[(32 + tok) * 16 + cj];
      }
    }
  }
  __syncthreads();
}

DEV float gelu_exact(float v) { return 0.5f * v * (1.f + erff(v * 0.70710678118654752f)); }

__device__ __forceinline__ void convert_fp8_rows(const float* src, unsigned char* dst, float* rscale, int nrows) {
  const int tid_ = otid();
  int lane = tid_ & 63;
  int wave = blockIdx.x * 4 + (tid_ >> 6), nw = gridDim.x * 4;
  for (int row = wave; row < nrows; row += nw) {
    const float* r = src + (size_t)row * 1024 + lane * 16;
    float4 a0 = *reinterpret_cast<const float4*>(r), a1 = *reinterpret_cast<const float4*>(r + 4);
    float4 a2 = *reinterpret_cast<const float4*>(r + 8), a3 = *reinterpret_cast<const float4*>(r + 12);
    float m = fmaxf(fmaxf(fmaxf(fabsf(a0.x), fabsf(a0.y)), fmaxf(fabsf(a0.z), fabsf(a0.w))), fmaxf(fmaxf(fabsf(a1.x), fabsf(a1.y)), fmaxf(fabsf(a1.z), fabsf(a1.w))));
    m = fmaxf(m, fmaxf(fmaxf(fmaxf(fabsf(a2.x), fabsf(a2.y)), fmaxf(fabsf(a2.z), fabsf(a2.w))), fmaxf(fmaxf(fabsf(a3.x), fabsf(a3.y)), fmaxf(fabsf(a3.z), fabsf(a3.w)))));
#pragma unroll
    for (int o = 32; o > 0; o >>= 1) m = fmaxf(m, __shfl_xor(m, o));
    float sc = m > 0.f ? exp2f(floorf(log2f(224.f / m))) : 1.f;
    uint4 o;
    int p;
    p = __builtin_amdgcn_cvt_pk_fp8_f32(a0.x * sc, a0.y * sc, 0, false); p = __builtin_amdgcn_cvt_pk_fp8_f32(a0.z * sc, a0.w * sc, p, true); o.x = (unsigned)p;
    p = __builtin_amdgcn_cvt_pk_fp8_f32(a1.x * sc, a1.y * sc, 0, false); p = __builtin_amdgcn_cvt_pk_fp8_f32(a1.z * sc, a1.w * sc, p, true); o.y = (unsigned)p;
    p = __builtin_amdgcn_cvt_pk_fp8_f32(a2.x * sc, a2.y * sc, 0, false); p = __builtin_amdgcn_cvt_pk_fp8_f32(a2.z * sc, a2.w * sc, p, true); o.z = (unsigned)p;
    p = __builtin_amdgcn_cvt_pk_fp8_f32(a3.x * sc, a3.y * sc, 0, false); p = __builtin_amdgcn_cvt_pk_fp8_f32(a3.z * sc, a3.w * sc, p, true); o.w = (unsigned)p;
    *reinterpret_cast<uint4*>(dst + (size_t)row * 1024 + lane * 16) = o;
    if (lane == 0) rscale[row] = 1.f / sc;
  }
}

#define F8X(dst, WW) { dst[0] = __builtin_amdgcn_cvt_pk_f32_fp8((int)(WW).x, false); dst[1] = __builtin_amdgcn_cvt_pk_f32_fp8((int)(WW).x, true); \
                      dst[2] = __builtin_amdgcn_cvt_pk_f32_fp8((int)(WW).y, false); dst[3] = __builtin_amdgcn_cvt_pk_f32_fp8((int)(WW).y, true); \
                      dst[4] = __builtin_amdgcn_cvt_pk_f32_fp8((int)(WW).z, false); dst[5] = __builtin_amdgcn_cvt_pk_f32_fp8((int)(WW).z, true); \
                      dst[6] = __builtin_amdgcn_cvt_pk_f32_fp8((int)(WW).w, false); dst[7] = __builtin_amdgcn_cvt_pk_f32_fp8((int)(WW).w, true); }

__device__ __forceinline__ void phase_peer_gather(const u16* tin, const int* idx, const float* gate, const unsigned char* utab, const unsigned char* vtab,
                                  const float* urs, const float* vrs, const float* xres,
                                  const float* g2  , const float* lng, const float* lnb, float* xout,
                                  const float* modnext  , u16* hxout) {
  const int tid_ = otid();
  int lane = tid_ & 63;
  int wave = blockIdx.x * 4 + (tid_ >> 6), nw = gridDim.x * 4;
  for (int tok = wave; tok < NT; tok += nw) {
    int b = tok >> 12;
    f32x2 t2[8];
    {
      uint4 ta = *reinterpret_cast<const uint4*>(tin + (size_t)tok * 1024 + lane * 16);
      uint4 tb = *reinterpret_cast<const uint4*>(tin + (size_t)tok * 1024 + lane * 16 + 8);
      t2[0] = f32x2{bflo(ta.x), bfhi(ta.x)}; t2[1] = f32x2{bflo(ta.y), bfhi(ta.y)}; t2[2] = f32x2{bflo(ta.z), bfhi(ta.z)}; t2[3] = f32x2{bflo(ta.w), bfhi(ta.w)};
      t2[4] = f32x2{bflo(tb.x), bfhi(tb.x)}; t2[5] = f32x2{bflo(tb.y), bfhi(tb.y)}; t2[6] = f32x2{bflo(tb.z), bfhi(tb.z)}; t2[7] = f32x2{bflo(tb.w), bfhi(tb.w)};
    }
    int id0 = idx[(size_t)tok * 128 + lane] & 16383, id1 = idx[(size_t)tok * 128 + 64 + lane] & 16383;
    int gt0 = __float_as_int(gate[(size_t)tok * 128 + lane]), gt1 = __float_as_int(gate[(size_t)tok * 128 + 64 + lane]);
    f32x2 acc2[8];
#pragma unroll
    for (int k = 0; k < 8; ++k) acc2[k] = f32x2{0.f, 0.f};
#pragma unroll 1
    for (int j = 0; j < 128; j += 4) {
      int e[4];
      float g[4];
      if (j < 64) {
#pragma unroll
        for (int q = 0; q < 4; ++q) { e[q] = __builtin_amdgcn_readlane(id0, j + q); g[q] = __int_as_float(__builtin_amdgcn_readlane(gt0, j + q)); }
      } else {
#pragma unroll
        for (int q = 0; q < 4; ++q) { e[q] = __builtin_amdgcn_readlane(id1, j - 64 + q); g[q] = __int_as_float(__builtin_amdgcn_readlane(gt1, j - 64 + q)); }
      }
      uint4 U[4], V[4];
      float su[4], sv_[4];
#pragma unroll
      for (int q = 0; q < 4; ++q) {
        U[q] = *reinterpret_cast<const uint4*>(utab + (size_t)e[q] * 1024 + lane * 16);
        V[q] = *reinterpret_cast<const uint4*>(vtab + (size_t)e[q] * 1024 + lane * 16);
        su[q] = urs[e[q]];
        sv_[q] = vrs[e[q]];
      }
      float d[4];
#pragma unroll
      for (int q = 0; q < 4; ++q) {
        f32x2 u2[8];
        F8X(u2, U[q])
        f32x2 dd = u2[0] * t2[0];
#pragma unroll
        for (int k = 1; k < 8; ++k) dd = u2[k] * t2[k] + dd;
        d[q] = dd.x + dd.y;
      }
#pragma unroll
      for (int o = 32; o > 0; o >>= 1) {
#pragma unroll
        for (int q = 0; q < 4; ++q) d[q] += __shfl_xor(d[q], o);
      }
#pragma unroll
      for (int q = 0; q < 4; ++q) {
        float a = g[q] * gelu_exact(d[q] * su[q]) * sv_[q];
        f32x2 aa = f32x2{a, a};
        f32x2 v2[8];
        F8X(v2, V[q])
#pragma unroll
        for (int k = 0; k < 8; ++k) acc2[k] = aa * v2[k] + acc2[k];
      }
    }
    float vv[16];
    float s = 0.f;
    const int c0 = lane * 16;
#pragma unroll
    for (int k4 = 0; k4 < 4; ++k4) {
      float4 x0 = *reinterpret_cast<const float4*>(xres + (size_t)tok * 1024 + c0 + k4 * 4);
      float4 g0 = *reinterpret_cast<const float4*>(g2 + (size_t)b * 6144 + c0 + k4 * 4);
      vv[k4 * 4 + 0] = ALPHA * x0.x + g0.x * acc2[k4 * 2].x; vv[k4 * 4 + 1] = ALPHA * x0.y + g0.y * acc2[k4 * 2].y;
      vv[k4 * 4 + 2] = ALPHA * x0.z + g0.z * acc2[k4 * 2 + 1].x; vv[k4 * 4 + 3] = ALPHA * x0.w + g0.w * acc2[k4 * 2 + 1].y;
    }
#pragma unroll
    for (int k = 0; k < 16; ++k) s += vv[k];
    float mu = wave_sum(s) * (1.f / 1024.f);
    float qq = 0.f;
#pragma unroll
    for (int k = 0; k < 16; ++k) { vv[k] -= mu; qq += vv[k] * vv[k]; }
    float rs = rsqrtf(wave_sum(qq) * (1.f / 1024.f) + 1e-5f);
    float oo[16];
#pragma unroll
    for (int k4 = 0; k4 < 4; ++k4) {
      float4 ga = *reinterpret_cast<const float4*>(lng + c0 + k4 * 4), ba = *reinterpret_cast<const float4*>(lnb + c0 + k4 * 4);
      float4 o0;
      o0.x = vv[k4 * 4 + 0] * rs * ga.x + ba.x; o0.y = vv[k4 * 4 + 1] * rs * ga.y + ba.y; o0.z = vv[k4 * 4 + 2] * rs * ga.z + ba.z; o0.w = vv[k4 * 4 + 3] * rs * ga.w + ba.w;
      *reinterpret_cast<float4*>(xout + (size_t)tok * 1024 + c0 + k4 * 4) = o0;
      oo[k4 * 4 + 0] = o0.x; oo[k4 * 4 + 1] = o0.y; oo[k4 * 4 + 2] = o0.z; oo[k4 * 4 + 3] = o0.w;
    }
    if (modnext) {
      const float* m = modnext + (size_t)b * 6144;
      unsigned pk[8];
#pragma unroll
      for (int k4 = 0; k4 < 4; ++k4) {
        float4 sh0 = *reinterpret_cast<const float4*>(m + c0 + k4 * 4), sc0 = *reinterpret_cast<const float4*>(m + 1024 + c0 + k4 * 4);
        pk[k4 * 2] = pack2(oo[k4 * 4 + 0] * (1.f + sc0.x) + sh0.x, oo[k4 * 4 + 1] * (1.f + sc0.y) + sh0.y);
        pk[k4 * 2 + 1] = pack2(oo[k4 * 4 + 2] * (1.f + sc0.z) + sh0.z, oo[k4 * 4 + 3] * (1.f + sc0.w) + sh0.w);
      }
      *reinterpret_cast<uint4*>(hxout + (size_t)tok * 1024 + c0) = make_uint4(pk[0], pk[1], pk[2], pk[3]);
      *reinterpret_cast<uint4*>(hxout + (size_t)tok * 1024 + c0 + 8) = make_uint4(pk[4], pk[5], pk[6], pk[7]);
    }
  }
}

__device__ __forceinline__ void phase_shortconv_T(const Params& p, const u16* upre, u16* x1cm, u16* x2cm, u16* vcm, char* lds) {
  constexpr int TLD = 264;
  u16* tile = (u16*)lds;
  int tid = otid();
  const int tg = tid >> 3, cg_ = tid & 7;
  for (int item = blockIdx.x; item < 128 * 48; item += gridDim.x) {
    int tt = item / 48, ct = item % 48;
    int tok0 = tt * 256, c0 = ct * 64;
    int ch = c0 + cg_ * 8;
    float w[3][8], bias[8];
#pragma unroll
    for (int j = 0; j < 3; ++j) {
      float4 w0 = *reinterpret_cast<const float4*>(p.h_conv_w + j * 3072 + ch), w1 = *reinterpret_cast<const float4*>(p.h_conv_w + j * 3072 + ch + 4);
      w[j][0] = w0.x; w[j][1] = w0.y; w[j][2] = w0.z; w[j][3] = w0.w; w[j][4] = w1.x; w[j][5] = w1.y; w[j][6] = w1.z; w[j][7] = w1.w;
    }
    {
      float4 b0 = *reinterpret_cast<const float4*>(p.h_conv_b + ch), b1 = *reinterpret_cast<const float4*>(p.h_conv_b + ch + 4);
      bias[0] = b0.x; bias[1] = b0.y; bias[2] = b0.z; bias[3] = b0.w; bias[4] = b1.x; bias[5] = b1.y; bias[6] = b1.z; bias[7] = b1.w;
    }
    const int t0 = tok0 + tg * 8;
    const int l0 = t0 & 4095;
    const u32x4 zero4 = u32x4{0u, 0u, 0u, 0u};
    u32x4 rows[10];
#pragma unroll
    for (int i = 0; i < 10; ++i) {
      int ll = l0 + i - 1;
      rows[i] = (ll >= 0 && ll <= 4095) ? *reinterpret_cast<const u32x4*>(upre + (size_t)(t0 + i - 1) * 3072 + ch) : zero4;
    }
    float o[8][8];
#pragma unroll
    for (int i = 0; i < 8; ++i) {
#pragma unroll
      for (int k = 0; k < 8; ++k) o[i][k] = bias[k];
      fma8(o[i], rows[i], w[0]);
      fma8(o[i], rows[i + 1], w[1]);
      fma8(o[i], rows[i + 2], w[2]);
    }
#pragma unroll
    for (int k = 0; k < 8; ++k) {
      uint4 pk;
      pk.x = pack2(o[0][k], o[1][k]); pk.y = pack2(o[2][k], o[3][k]); pk.z = pack2(o[4][k], o[5][k]); pk.w = pack2(o[6][k], o[7][k]);
      *reinterpret_cast<uint4*>(tile + (cg_ * 8 + k) * TLD + tg * 8) = pk;
    }
    __syncthreads();
    int part = c0 >> 10, d0 = c0 & 1023;
    u16* dst = part == 0 ? x1cm : (part == 1 ? x2cm : vcm);
    int b = tok0 >> 12, lt0 = tok0 & 4095;
#pragma unroll
    for (int i = 0; i < 8; ++i) {
      int q = tid + i * 256, c = q >> 5, chunk = q & 31;
      uint4 v = *reinterpret_cast<const uint4*>(tile + c * TLD + chunk * 8);
      *reinterpret_cast<uint4*>(dst + ((size_t)(b * 1024 + d0 + c)) * 4096 + lt0 + chunk * 8) = v;
    }
    __syncthreads();
  }
}

DEV float2 cmul(float2 a, float2 w) { return make_float2(a.x * w.x - a.y * w.y, a.x * w.y + a.y * w.x); }
DEV float2 cmulc(float2 a, float2 w) { return make_float2(a.x * w.x + a.y * w.y, a.y * w.x - a.x * w.y); }
template <bool LAST = true>
__device__ __forceinline__ void fft_fwd(float2* X, const float2* __restrict__ tw) {
  int tid = otid();
  for (int s = 12; s >= 2; s -= 2) {
    const int h = 1 << s, q = h >> 1;
#pragma unroll 2
    for (int i = 0; i < 8; ++i) {
      int gi = tid + i * 256;
      int pos = gi & (q - 1);
      int base = ((gi >> (s - 1)) << (s + 1)) + pos;
      float2 w1 = tw[pos << (12 - s)];
      float2 w2 = tw[pos << (13 - s)];
      float2 a = X[base], bb = X[base + q], c = X[base + h], d = X[base + h + q];
      float2 a1 = make_float2(a.x + c.x, a.y + c.y);
      float2 c1 = cmul(make_float2(a.x - c.x, a.y - c.y), w1);
      float2 b1 = make_float2(bb.x + d.x, bb.y + d.y);
      float2 t = cmul(make_float2(bb.x - d.x, bb.y - d.y), w1);
      float2 d1 = make_float2(t.y, -t.x);
      X[base] = make_float2(a1.x + b1.x, a1.y + b1.y);
      X[base + q] = cmul(make_float2(a1.x - b1.x, a1.y - b1.y), w2);
      X[base + h] = make_float2(c1.x + d1.x, c1.y + d1.y);
      X[base + h + q] = cmul(make_float2(c1.x - d1.x, c1.y - d1.y), w2);
    }
    __syncthreads();
  }
  if (LAST) {
#pragma unroll 4
    for (int i = 0; i < 16; ++i) {
      int j = tid + i * 256;
      float2 a = X[2 * j], bq = X[2 * j + 1];
      X[2 * j] = make_float2(a.x + bq.x, a.y + bq.y);
      X[2 * j + 1] = make_float2(a.x - bq.x, a.y - bq.y);
    }
    __syncthreads();
  }
}
__device__ __forceinline__ void fft_mid_mul(float2* X, const float2* __restrict__ H) {
  int tid = otid();
#pragma unroll 4
  for (int i = 0; i < 16; ++i) {
    int j = tid + i * 256;
    float2 a = X[2 * j], bq = X[2 * j + 1];
    float4 hh = *reinterpret_cast<const float4*>(H + 2 * j);
    float2 f0 = make_float2(a.x + bq.x, a.y + bq.y), f1 = make_float2(a.x - bq.x, a.y - bq.y);
    float2 g0 = make_float2(f0.x * hh.x - f0.y * hh.y, f0.x * hh.y + f0.y * hh.x);
    float2 g1 = make_float2(f1.x * hh.z - f1.y * hh.w, f1.x * hh.w + f1.y * hh.z);
    X[2 * j] = make_float2(g0.x + g1.x, g0.y + g1.y);
    X[2 * j + 1] = make_float2(g0.x - g1.x, g0.y - g1.y);
  }
  __syncthreads();
}
template <bool FIRST = true>
__device__ __forceinline__ void fft_inv(float2* X, const float2* __restrict__ tw) {
  int tid = otid();
  if (FIRST) {
#pragma unroll 4
    for (int i = 0; i < 16; ++i) {
      int j = tid + i * 256;
      float2 a = X[2 * j], bq = X[2 * j + 1];
      X[2 * j] = make_float2(a.x + bq.x, a.y + bq.y);
      X[2 * j + 1] = make_float2(a.x - bq.x, a.y - bq.y);
    }
    __syncthreads();
  }
  for (int s = 2; s <= 12; s += 2) {
    const int h = 1 << s, q = h >> 1;
#pragma unroll 2
    for (int i = 0; i < 8; ++i) {
      int gi = tid + i * 256;
      int pos = gi & (q - 1);
      int base = ((gi >> (s - 1)) << (s + 1)) + pos;
      float2 w1 = tw[pos << (12 - s)];
      float2 w2 = tw[pos << (13 - s)];
      float2 a = X[base], bb = X[base + q], c = X[base + h], d = X[base + h + q];
      float2 tb = cmulc(bb, w2), td = cmulc(d, w2);
      float2 a1 = make_float2(a.x + tb.x, a.y + tb.y), b1 = make_float2(a.x - tb.x, a.y - tb.y);
      float2 c1 = make_float2(c.x + td.x, c.y + td.y), d1 = make_float2(c.x - td.x, c.y - td.y);
      float2 tc = cmulc(c1, w1);
      float2 u = cmulc(d1, w1);
      float2 tdd = make_float2(-u.y, u.x);
      X[base] = make_float2(a1.x + tc.x, a1.y + tc.y);
      X[base + h] = make_float2(a1.x - tc.x, a1.y - tc.y);
      X[base + q] = make_float2(b1.x + tdd.x, b1.y + tdd.y);
      X[base + h + q] = make_float2(b1.x - tdd.x, b1.y - tdd.y);
    }
    __syncthreads();
  }
}

__device__ __forceinline__ void phase_filter_fft(const Params& p, float2* Hf, char* lds) {
  float2* X = (float2*)lds;
  float* w3s = (float*)(lds + 65536);
  float* red = w3s + 128;
  const float* hid = (const float*)(p.ws + OFF_HID);
  int tid = otid();
  const float min_decay = -3.0701134573253945f;
  const float max_decay = -15.350567286626973f;
  for (int item = blockIdx.x; item < 2048; item += gridDim.x) {
    int o = item >> 10, d = item & 1023;
    if (tid < 128) {
      int dirr = tid >> 6, j = tid & 63;
      w3s[tid] = p.h_f_w3[(size_t)j * 4096 + (o * 2 + dirr) * 1024 + d];
    }
    __syncthreads();
    float adelta = fabsf(min_decay + (float)d * ((max_decay - min_decay) / 1023.f));
    float ss = 0.f;
#pragma unroll 1
    for (int i = 0; i < 16; ++i) {
      int t = tid + i * 256;
      const float* hr = hid + (size_t)t * 64;
      float hf = 0.f, hb = 0.f;
#pragma unroll
      for (int j4 = 0; j4 < 16; ++j4) {
        float4 hv = *reinterpret_cast<const float4*>(hr + j4 * 4);
        hf += hv.x * w3s[j4 * 4] + hv.y * w3s[j4 * 4 + 1] + hv.z * w3s[j4 * 4 + 2] + hv.w * w3s[j4 * 4 + 3];
        hb += hv.x * w3s[64 + j4 * 4] + hv.y * w3s[64 + j4 * 4 + 1] + hv.z * w3s[64 + j4 * 4 + 2] + hv.w * w3s[64 + j4 * 4 + 3];
      }
      float dec = __expf(-((float)t / 4095.f) * adelta);
      hf *= dec; hb *= dec;
      if (t == 0) {
        float v = hf + hb;
        X[0] = make_float2(v, 0.f);
        X[4096] = make_float2(0.f, 0.f);
        ss += v * v;
      } else {
        X[t] = make_float2(hf, 0.f);
        X[8192 - t] = make_float2(hb, 0.f);
        ss += hf * hf + hb * hb;
      }
    }
    ss = wave_sum(ss);
    if ((tid & 63) == 0) red[tid >> 6] = ss;
    __syncthreads();
    float tot = red[0] + red[1] + red[2] + red[3];
    float scale = rsqrtf(tot + 1e-6f) * (1.f / 8192.f);
    fft_fwd(X, (const float2*)(p.ws + OFF_TW));
    float2* dst = Hf + (size_t)item * 8192;
#pragma unroll 4
    for (int i = 0; i < 32; ++i) {
      int k = tid + i * 256;
      float2 v = X[k];
      dst[k] = make_float2(v.x * scale, v.y * scale);
    }
    __syncthreads();
  }
}

__device__ __forceinline__ void phase_hyena_conv(const Params& p, const u16* x1cm, const u16* x2cm, const u16* vcm, const float2* Hf, u16* zzcm, char* lds) {
  float2* X = (float2*)lds;
  int tid = otid();
  for (int item = blockIdx.x; item < 4096; item += gridDim.x) {
    int d = item >> 2, bp = item & 3;
    size_t r0 = ((size_t)((bp * 2) * 1024 + d)) * 4096, r1 = ((size_t)((bp * 2 + 1) * 1024 + d)) * 4096;
    float bias0 = p.h_bias[d], bias1 = p.h_bias[1024 + d];
#pragma unroll
    for (int i = 0; i < 2; ++i) {
      int t8 = (tid + i * 256) * 8;
      uint4 a = *reinterpret_cast<const uint4*>(vcm + r0 + t8);
      uint4 bq = *reinterpret_cast<const uint4*>(vcm + r1 + t8);
      X[t8 + 0] = make_float2(bflo(a.x), bflo(bq.x)); X[t8 + 1] = make_float2(bfhi(a.x), bfhi(bq.x));
      X[t8 + 2] = make_float2(bflo(a.y), bflo(bq.y)); X[t8 + 3] = make_float2(bfhi(a.y), bfhi(bq.y));
      X[t8 + 4] = make_float2(bflo(a.z), bflo(bq.z)); X[t8 + 5] = make_float2(bfhi(a.z), bfhi(bq.z));
      X[t8 + 6] = make_float2(bflo(a.w), bflo(bq.w)); X[t8 + 7] = make_float2(bfhi(a.w), bfhi(bq.w));
    }
    for (int i = 0; i < 16; ++i) X[4096 + tid + i * 256] = make_float2(0.f, 0.f);
    __syncthreads();
    fft_fwd<false>(X, (const float2*)(p.ws + OFF_TW));
    fft_mid_mul(X, Hf + (size_t)d * 8192);
    fft_inv<false>(X, (const float2*)(p.ws + OFF_TW));
    float zz0[16], zz1[16];
#pragma unroll
    for (int i = 0; i < 2; ++i) {
      int t8 = (tid + i * 256) * 8;
      uint4 a = *reinterpret_cast<const uint4*>(vcm + r0 + t8);
      uint4 bq = *reinterpret_cast<const uint4*>(vcm + r1 + t8);
      uint4 xa = *reinterpret_cast<const uint4*>(x1cm + r0 + t8);
      uint4 xb = *reinterpret_cast<const uint4*>(x1cm + r1 + t8);
      float va[8] = {bflo(a.x), bfhi(a.x), bflo(a.y), bfhi(a.y), bflo(a.z), bfhi(a.z), bflo(a.w), bfhi(a.w)};
      float vb[8] = {bflo(bq.x), bfhi(bq.x), bflo(bq.y), bfhi(bq.y), bflo(bq.z), bfhi(bq.z), bflo(bq.w), bfhi(bq.w)};
      float fa[8] = {bflo(xa.x), bfhi(xa.x), bflo(xa.y), bfhi(xa.y), bflo(xa.z), bfhi(xa.z), bflo(xa.w), bfhi(xa.w)};
      float fb[8] = {bflo(xb.x), bfhi(xb.x), bflo(xb.y), bfhi(xb.y), bflo(xb.z), bfhi(xb.z), bflo(xb.w), bfhi(xb.w)};
#pragma unroll
      for (int e = 0; e < 8; ++e) {
        float2 cv = X[t8 + e];
        float z0 = fa[e] * (cv.x + va[e] * bias0);
        float z1 = fb[e] * (cv.y + vb[e] * bias0);
        zz0[i * 8 + e] = z0; zz1[i * 8 + e] = z1;
        X[t8 + e] = make_float2(z0, z1);
      }
    }
    for (int i = 0; i < 16; ++i) X[4096 + tid + i * 256] = make_float2(0.f, 0.f);
    __syncthreads();
    fft_fwd<false>(X, (const float2*)(p.ws + OFF_TW));
    fft_mid_mul(X, Hf + (size_t)(1024 + d) * 8192);
    fft_inv<false>(X, (const float2*)(p.ws + OFF_TW));
#pragma unroll
    for (int i = 0; i < 2; ++i) {
      int t8 = (tid + i * 256) * 8;
      uint4 xa = *reinterpret_cast<const uint4*>(x2cm + r0 + t8);
      uint4 xb = *reinterpret_cast<const uint4*>(x2cm + r1 + t8);
      float fa[8] = {bflo(xa.x), bfhi(xa.x), bflo(xa.y), bfhi(xa.y), bflo(xa.z), bfhi(xa.z), bflo(xa.w), bfhi(xa.w)};
      float fb[8] = {bflo(xb.x), bfhi(xb.x), bflo(xb.y), bfhi(xb.y), bflo(xb.z), bfhi(xb.z), bflo(xb.w), bfhi(xb.w)};
      float o0[8], o1[8];
#pragma unroll
      for (int e = 0; e < 8; ++e) {
        float2 cv = X[t8 + e];
        o0[e] = fa[e] * (cv.x + zz0[i * 8 + e] * bias1);
        o1[e] = fb[e] * (cv.y + zz1[i * 8 + e] * bias1);
      }
      uint4 w0, w1;
      w0.x = pack2(o0[0], o0[1]); w0.y = pack2(o0[2], o0[3]); w0.z = pack2(o0[4], o0[5]); w0.w = pack2(o0[6], o0[7]);
      w1.x = pack2(o1[0], o1[1]); w1.y = pack2(o1[2], o1[3]); w1.z = pack2(o1[4], o1[5]); w1.w = pack2(o1[6], o1[7]);
      *reinterpret_cast<uint4*>(zzcm + r0 + t8) = w0;
      *reinterpret_cast<uint4*>(zzcm + r1 + t8) = w1;
    }
    __syncthreads();
  }
}

__device__ __forceinline__ void phase_transpose_back(const u16* src, u16* dst, char* lds) {
  u16* tile = (u16*)lds;
  int tid = otid();
  for (int item = blockIdx.x; item < 8 * 16 * 64; item += gridDim.x) {
    int b = item >> 10, dt_ = (item >> 6) & 15, tt = item & 63;
#pragma unroll
    for (int i = 0; i < 2; ++i) {
      int q = tid + i * 256, dd = q >> 3, tg = (q & 7) * 8;
      uint4 v = *reinterpret_cast<const uint4*>(src + ((size_t)(b * 1024 + dt_ * 64 + dd)) * 4096 + tt * 64 + tg);
      tile[(tg + 0) * 72 + dd] = (u16)(v.x & 0xffff); tile[(tg + 1) * 72 + dd] = (u16)(v.x >> 16);
      tile[(tg + 2) * 72 + dd] = (u16)(v.y & 0xffff); tile[(tg + 3) * 72 + dd] = (u16)(v.y >> 16);
      tile[(tg + 4) * 72 + dd] = (u16)(v.z & 0xffff); tile[(tg + 5) * 72 + dd] = (u16)(v.z >> 16);
      tile[(tg + 6) * 72 + dd] = (u16)(v.w & 0xffff); tile[(tg + 7) * 72 + dd] = (u16)(v.w >> 16);
    }
    __syncthreads();
#pragma unroll
    for (int i = 0; i < 2; ++i) {
      int q = tid + i * 256, tl = q >> 3, dg = (q & 7) * 8;
      uint4 v = *reinterpret_cast<const uint4*>(tile + tl * 72 + dg);
      *reinterpret_cast<uint4*>(dst + ((size_t)(b * 4096 + tt * 64 + tl)) * 1024 + dt_ * 64 + dg) = v;
    }
    __syncthreads();
  }
}

__device__ __forceinline__ uint4* xb_words_ptr() { __shared__ uint4 xb_words; return &xb_words; }
#define XB_TMO      128
#define XB_XCNT(j)  (256  + 64 * (j))
#define XB_XSUB(j)  (1280 + 64 * (j))
#define XB_XGEN(j)  (2304 + 64 * (j))
#define XB_TOP      3328
#define XB_TOPGEN   3392
#define XCD_BAR_WORDS 3456
#define XB_SPIN_CAP (1u << 18)
#define LAS __attribute__((address_space(3)))

__device__ __forceinline__ unsigned xb_ld(unsigned* p)              { return __hip_atomic_load(p, __ATOMIC_RELAXED, __HIP_MEMORY_SCOPE_AGENT); }
__device__ __forceinline__ unsigned xb_add(unsigned* p, unsigned v) { return __hip_atomic_fetch_add(p, v, __ATOMIC_RELAXED, __HIP_MEMORY_SCOPE_AGENT); }
__device__ __forceinline__ unsigned xb_xcc_id() { return (unsigned)__builtin_amdgcn_s_getreg((3 << 11) | 20) & 0xFu; }
#define XB_SPIN(cond, bar) do { unsigned _sp = 0; while (cond) { __builtin_amdgcn_s_sleep(1); \
    if ((++_sp & 255u) == 0u) { if (xb_ld(&(bar)[XB_TMO])) break; if (_sp > XB_SPIN_CAP) { atomicAdd(&(bar)[XB_TMO], 1u); break; } } } } while (0)

struct XcdBarrier {
    unsigned* bar; unsigned x;
    volatile LAS unsigned* st;
};

__device__ __forceinline__ XcdBarrier xcd_barrier_post(unsigned* bar, volatile LAS unsigned* st) {
    XcdBarrier b; b.bar = bar; b.x = xb_xcc_id(); b.st = st;
    if (threadIdx.x == 0) (void)xb_add(&bar[XB_XCNT(b.x)], 1u);
    return b;
}
__device__ __forceinline__ void xcd_barrier_complete(unsigned* bar, unsigned x, unsigned& nloc, unsigned& nx) {
    const unsigned G = gridDim.x * gridDim.y * gridDim.z;
    unsigned sum, cnt, mine, sp = 0u;
    for (;;) {
        sum = 0u; cnt = 0u; mine = 0u;
#pragma unroll
        for (unsigned j = 0; j < 16; ++j) { const unsigned c = xb_ld(&bar[XB_XCNT(j)]); sum += c; cnt += (c > 0u) ? 1u : 0u; mine = (j == x) ? c : mine; }
        if (sum == G) break;
        __builtin_amdgcn_s_sleep(1);
        if ((++sp & 255u) == 0u) { if (xb_ld(&bar[XB_TMO])) break; if (sp > XB_SPIN_CAP) { atomicAdd(&bar[XB_TMO], 1u); break; } }
    }
    nloc = mine > 0u ? mine : 1u; nx = cnt > 0u ? cnt : 1u;
}

__device__ __forceinline__ void xcd_barrier(const XcdBarrier& b) {
    asm volatile("s_waitcnt vmcnt(0)" ::: "memory");
    __syncthreads();
    if (threadIdx.x == 0) {
        unsigned* bar = b.bar;
        __builtin_amdgcn_s_waitcnt(0);
        unsigned nloc = b.st[0], nx = b.st[1];
        if (nloc == 0u) { xcd_barrier_complete(bar, b.x, nloc, nx); b.st[0] = nloc; b.st[1] = nx; }
        const unsigned old = xb_add(&bar[XB_XSUB(b.x)], 1u);
        const unsigned gen = old / nloc;
        if (old + 1u == (gen + 1u) * nloc) {
            __builtin_amdgcn_fence(__ATOMIC_RELEASE, "agent");
            asm volatile("s_waitcnt vmcnt(0)" ::: "memory");
            const unsigned og = xb_add(&bar[XB_TOP], 1u);
            const unsigned tg = og / nx;
            if (og + 1u == (tg + 1u) * nx) xb_add(&bar[XB_TOPGEN], 1u);
            else XB_SPIN(xb_ld(&bar[XB_TOPGEN]) == tg, bar);
            __builtin_amdgcn_fence(__ATOMIC_ACQUIRE, "agent");
            xb_add(&bar[XB_XGEN(b.x)], 1u);
            asm volatile("s_waitcnt vmcnt(0)" ::: "memory");
        } else {
            XB_SPIN(xb_ld(&bar[XB_XGEN(b.x)]) == gen, bar);
            __builtin_amdgcn_fence(__ATOMIC_ACQUIRE, "agent");
            asm volatile("s_waitcnt vmcnt(0)" ::: "memory");
        }
    }
    __syncthreads();
}


DEV void gsync2(unsigned k) {
  (void)k;
  XcdBarrier b;
  b.bar = (unsigned*)((char*)karg<33>() + OFF_BAR);
  b.x = xb_xcc_id();
  b.st = (volatile LAS unsigned*)xb_words_ptr();
  xcd_barrier(b);
}

DEV void gsync(cg::grid_group& grid) {
  asm volatile("s_waitcnt vmcnt(0)" ::: "memory");
  grid.sync();
  if (threadIdx.x == 0) {
    __builtin_amdgcn_fence(__ATOMIC_ACQUIRE, "agent");
    asm volatile("s_waitcnt vmcnt(0)" ::: "memory");
  }
  __syncthreads();
}

template <int layer>
__device__ __forceinline__ void peer_block(unsigned& nbar, char* lds) {
  {
    Params p = fetch_params();
    char* ws = p.ws; char* R1 = ws + OFF_R1; char* R2 = ws + OFF_R2; char* DO = (char*)p.out;
    const float* modl = (float*)(ws + OFF_MOD) + (size_t)layer * 9 * 6144;
    const u16* A = layer == 0 ? (const u16*)R1 : (const u16*)DO;
    const int K = layer == 0 ? 2048 : 1024;
    const u16* Wt = (const u16*)(ws + (layer == 0 ? OFF_W_OUT : OFF_W_HOUT));
    const float* res = layer == 0 ? p.x : (const float*)R2;
    phase_gemm_resid(A, K, Wt, res, (float*)R2, modl + 2048, lds);
  }
  gsync2(++nbar);
  {
    Params p = fetch_params();
    char* ws = p.ws; char* R1 = ws + OFF_R1; char* R2 = ws + OFF_R2; char* DO = (char*)p.out;
    const float* modl = (float*)(ws + OFF_MOD) + (size_t)layer * 9 * 6144;
    u16* tpeer = layer == 0 ? (u16*)DO : (u16*)(R1 + 128 * MiB);
    phase_ln_mod((float*)R2, p.ln_g + layer * 2048, p.ln_b + layer * 2048, modl, tpeer);
    if (layer == 1) {
      unsigned char* tb = (unsigned char*)R1;
      convert_fp8_rows(p.p_u + (size_t)16384 * 1024, tb, (float*)(tb + 32 * MiB), 16384);
      convert_fp8_rows(p.p_v + (size_t)16384 * 1024, tb + 16 * MiB, (float*)(tb + 32 * MiB + 65536), 16384);
    }
  }
  gsync2(++nbar);
  {
    Params p = fetch_params();
    char* ws = p.ws; char* R1 = ws + OFF_R1; char* DO = (char*)p.out;
    u16* tpeer = layer == 0 ? (u16*)DO : (u16*)(R1 + 128 * MiB);
    phase_gemm_bf16(tpeer, (const u16*)(ws + OFF_W_Q) + (size_t)layer * 2048 * 1024, layer == 0 ? (u16*)R1 : (u16*)DO, 2048, lds);
  }
  gsync2(++nbar);
  {
    Params p = fetch_params();
    char* ws = p.ws; char* R1 = ws + OFF_R1; char* R2 = ws + OFF_R2;
    int* idxb = (int*)(R2 + 128 * MiB);
    float* gateb = (float*)(R2 + 144 * MiB);
    const u16* kbf = (const u16*)(ws + OFF_KEYS);
    phase_peer_topk(layer == 0 ? (const u16*)R1 : (const u16*)p.out, kbf + (size_t)layer * 131072, kbf + 262144 + (size_t)layer * 131072, idxb, gateb, lds);
  }
  gsync2(++nbar);
  {
    Params p = fetch_params();
    char* ws = p.ws; char* R1 = ws + OFF_R1; char* R2 = ws + OFF_R2; char* DO = (char*)p.out;
    float* mod = (float*)(ws + OFF_MOD);
    const float* modl = mod + (size_t)layer * 9 * 6144;
    int* idxb = (int*)(R2 + 128 * MiB);
    float* gateb = (float*)(R2 + 144 * MiB);
    u16* tpeer = layer == 0 ? (u16*)DO : (u16*)(R1 + 128 * MiB);
    const unsigned char* tb8 = (const unsigned char*)(layer == 0 ? ws + OFF_TAB0 : R1);
    phase_peer_gather(tpeer, idxb, gateb, tb8, tb8 + 16 * MiB, (const float*)(tb8 + 32 * MiB), (const float*)(tb8 + 32 * MiB + 65536), (const float*)R2,
                      modl + 5120, p.ln_g + layer * 2048 + 1024, p.ln_b + layer * 2048 + 1024, layer == 0 ? (float*)R2 : p.out,
                      layer == 0 ? mod + 9 * 6144 : nullptr, (u16*)(DO + 64 * MiB));
  }
}

__global__ void __launch_bounds__(256, 2) fwd_megakernel(Params p_unused) {
  __shared__ __attribute__((aligned(16))) char lds[LDS_BYTES];
  cg::grid_group grid = cg::this_grid();
  unsigned nbar = 0;
  if (threadIdx.x == 0) *xb_words_ptr() = make_uint4(0u, 0u, 0u, 0u);
  __syncthreads();
  (void)xcd_barrier_post((unsigned*)((char*)karg<33>() + OFF_BAR), (volatile LAS unsigned*)xb_words_ptr());
  { Params p = fetch_params(); phase_prologue(p, lds); }
  gsync(grid);
  {
    Params p = fetch_params();
    float* mod = (float*)(p.ws + OFF_MOD);
    modulate_rows(p.x, (u16*)(p.ws + OFF_R2), NT, SEQ, mod, 0, 1024, false);
    modulate_rows(p.ctx, (u16*)(p.ws + OFF_HC), NTC, CTXL, mod, 0, 1024, true);
  }
  gsync2(++nbar);
  { Params p = fetch_params(); phase_gemm_inproj(p, lds); }
  gsync2(++nbar);
  { Params p = fetch_params(); phase_conv(p); }
  gsync2(++nbar);
  { Params p = fetch_params(); phase_ssd(p, lds); }
  gsync2(++nbar);
  {
    Params p = fetch_params(); phase_gated_norm(p);
    unsigned char* tb = (unsigned char*)(p.ws + OFF_TAB0);
    convert_fp8_rows(p.p_u, tb, (float*)(tb + 32 * MiB), 16384);
    convert_fp8_rows(p.p_v, tb + 16 * MiB, (float*)(tb + 32 * MiB + 65536), 16384);
  }
  gsync2(++nbar);
  peer_block<0>(nbar, lds);
  gsync2(++nbar);
  {
    Params p = fetch_params();
    phase_gemm_bf16((const u16*)((char*)p.out + 64 * MiB), (const u16*)(p.ws + OFF_W_HIN), (u16*)(p.ws + OFF_R1), 3072, lds);
  }
  gsync2(++nbar);
  {
    Params p = fetch_params();
    phase_shortconv_T(p, (const u16*)(p.ws + OFF_R1), (u16*)(p.ws + OFF_R2 + 128 * MiB), (u16*)p.out, (u16*)((char*)p.out + 64 * MiB), lds);
  }
  gsync2(++nbar);
  { Params p = fetch_params(); phase_filter_fft(p, (float2*)(p.ws + OFF_R1), lds); }
  gsync2(++nbar);
  {
    Params p = fetch_params();
    phase_hyena_conv(p, (const u16*)(p.ws + OFF_R2 + 128 * MiB), (const u16*)p.out, (const u16*)((char*)p.out + 64 * MiB),
                     (const float2*)(p.ws + OFF_R1), (u16*)(p.ws + OFF_R1 + 128 * MiB), lds);
  }
  gsync2(++nbar);
  { Params p = fetch_params(); phase_transpose_back((const u16*)(p.ws + OFF_R1 + 128 * MiB), (u16*)p.out, lds); }
  gsync2(++nbar);
  peer_block<1>(nbar, lds);
}

extern "C" void kernel_launch(void* const* d_in, const int* in_sizes, int n_in, void* d_out, int out_size, void* d_ws, size_t ws_size,
                              hipStream_t stream) {
  static int grid_blocks = 0;
  if (!grid_blocks) {
    int dev = 0, cus = 0, per_cu = 0;
    hipGetDevice(&dev);
    hipDeviceGetAttribute(&cus, hipDeviceAttributeMultiprocessorCount, dev);
    hipOccupancyMaxActiveBlocksPerMultiprocessor(&per_cu, fwd_megakernel, 256, 0);
    if (per_cu > 2) per_cu = 2;
    if (per_cu < 1) per_cu = 1;
    grid_blocks = cus * per_cu;
  }
  Params p{};
  const float** pp = reinterpret_cast<const float**>(&p);
  for (int i = 0; i < 32; ++i) pp[i] = (const float*)d_in[i];
  p.out = (float*)d_out;
  p.ws = (char*)d_ws;
  if (ws_size < WS_TOTAL) fprintf(stderr, "workspace too small: %zu < %zu\n", ws_size, (size_t)WS_TOTAL);
  (void)hipMemsetAsync((char*)d_ws + OFF_BAR, 0, 16384, stream);
  void* args[] = {&p};
  hipError_t e = hipLaunchCooperativeKernel((void*)fwd_megakernel, dim3(grid_blocks), dim3(256), args, 0, stream);
  if (e != hipSuccess) fprintf(stderr, "cooperative launch failed: %s (grid %d)\n", hipGetErrorString(e), grid_blocks);
}
```

```cpp
#include <hip/hip_runtime.h>
#include <hip/hip_bf16.h>
#include <hip/hip_cooperative_groups.h>
#include <cstdio>
namespace cg = cooperative_groups;

typedef unsigned short u16;
using bf16x8 = __attribute__((ext_vector_type(8))) short;
using f32x4 = __attribute__((ext_vector_type(4))) float;
using u32x4 = __attribute__((ext_vector_type(4))) unsigned;
typedef float f32x2 __attribute__((ext_vector_type(2)));

#define DEV __device__ __forceinline__

constexpr int NB = 8, SEQ = 4096, DM = 1024, NT = NB * SEQ;
constexpr int CTXL = 256, NTC = NB * CTXL;
constexpr int SSM_IN = 5184, CONVD = 3072, SSM_INNER = 2048;
constexpr float ALPHA = 1.41421356237f;
constexpr int LDS_BYTES = 71168;

constexpr size_t MiB = 1ull << 20;
constexpr size_t OFF_W_IN = 0;
constexpr size_t OFF_W_OUT = OFF_W_IN + (size_t)5184 * 1024 * 2;
constexpr size_t OFF_W_HIN = OFF_W_OUT + (size_t)1024 * 2048 * 2;
constexpr size_t OFF_W_HOUT = OFF_W_HIN + (size_t)3072 * 1024 * 2;
constexpr size_t OFF_W_Q = OFF_W_HOUT + (size_t)1024 * 1024 * 2;
constexpr size_t OFF_MOD = OFF_W_Q + (size_t)2 * 2048 * 1024 * 2;
constexpr size_t OFF_HID = OFF_MOD + 512 * 1024;
constexpr size_t OFF_DT = OFF_HID + MiB;
constexpr size_t OFF_HC = OFF_DT + 8 * MiB;
constexpr size_t OFF_XBC_C = OFF_HC + 4 * MiB;
constexpr size_t OFF_XC_C = OFF_XBC_C + 12 * MiB;
constexpr size_t OFF_DT_C = OFF_XC_C + 12 * MiB;
constexpr size_t OFF_R1 = OFF_DT_C + MiB;
constexpr size_t OFF_R2 = OFF_R1 + 192 * MiB;
constexpr size_t OFF_BAR = OFF_R2 + 192 * MiB;
constexpr size_t OFF_KEYS = OFF_BAR + 16384;
constexpr size_t OFF_TW = OFF_KEYS + MiB;
constexpr size_t OFF_TAB0 = OFF_TW + 32768;
constexpr size_t WS_TOTAL = OFF_TAB0 + 33 * MiB;

struct Params {
  const float *x, *c, *ctx, *c_ctx, *ada_w, *ada_b, *ln_g, *ln_b;
  const float *m_w_in, *m_conv_w, *m_conv_b, *m_a_log, *m_dt_bias, *m_d, *m_norm_w, *m_w_out;
  const float *h_w_in, *h_conv_w, *h_conv_b, *h_f_w1, *h_f_b1, *h_f_w2, *h_f_b2, *h_f_w3, *h_freq, *h_bias, *h_w_out;
  const float *p_wq, *p_k1, *p_k2, *p_u, *p_v;
  float* out;
  char* ws;
};

typedef __bf16 bf16x2_t __attribute__((ext_vector_type(2)));
typedef float f32x2_ __attribute__((ext_vector_type(2)));
DEV u16 f2bf(float f) { __bf16 v = (__bf16)f; return __builtin_bit_cast(u16, v); }
DEV float bf2f(u16 h) { return __uint_as_float(((unsigned)h) << 16); }
DEV float bflo(unsigned w) { return __uint_as_float(w << 16); }
DEV float bfhi(unsigned w) { return __uint_as_float(w & 0xffff0000u); }
DEV unsigned pack2(float a, float b) { bf16x2_t v = __builtin_convertvector(f32x2_{a, b}, bf16x2_t); return __builtin_bit_cast(unsigned, v); }
DEV float wave_sum(float v) {
#pragma unroll
  for (int o = 32; o > 0; o >>= 1) v += __shfl_xor(v, o);
  return v;
}
DEV int otid() { int t = threadIdx.x; asm volatile("" : "+v"(t)); return t; }
DEV unsigned ordkey(float f) { unsigned u = __float_as_uint(f); return (u & 0x80000000u) ? ~u : (u | 0x80000000u); }
DEV float siluf(float v) { return v / (1.f + __expf(-v)); }
DEV f32x4 mfma16(bf16x8 a, bf16x8 b, f32x4 c) { return __builtin_amdgcn_mfma_f32_16x16x32_bf16(a, b, c, 0, 0, 0); }
DEV bf16x8 ld8(const u16* p) { return *reinterpret_cast<const bf16x8*>(p); }

template <int I>
DEV const float* karg() {
  unsigned long long v;
  asm volatile("s_load_dwordx2 %0, %1, %2\n\ts_waitcnt lgkmcnt(0)" : "=s"(v) : "s"(__builtin_amdgcn_kernarg_segment_ptr()), "n"(I * 8));
  return (const float*)(const __attribute__((address_space(1))) float*)v;
}
DEV Params fetch_params() {
  Params q;
  q.x = karg<0>(); q.c = karg<1>(); q.ctx = karg<2>(); q.c_ctx = karg<3>(); q.ada_w = karg<4>(); q.ada_b = karg<5>(); q.ln_g = karg<6>(); q.ln_b = karg<7>();
  q.m_w_in = karg<8>(); q.m_conv_w = karg<9>(); q.m_conv_b = karg<10>(); q.m_a_log = karg<11>(); q.m_dt_bias = karg<12>(); q.m_d = karg<13>();
  q.m_norm_w = karg<14>(); q.m_w_out = karg<15>();
  q.h_w_in = karg<16>(); q.h_conv_w = karg<17>(); q.h_conv_b = karg<18>(); q.h_f_w1 = karg<19>(); q.h_f_b1 = karg<20>(); q.h_f_w2 = karg<21>();
  q.h_f_b2 = karg<22>(); q.h_f_w3 = karg<23>(); q.h_freq = karg<24>(); q.h_bias = karg<25>(); q.h_w_out = karg<26>();
  q.p_wq = karg<27>(); q.p_k1 = karg<28>(); q.p_k2 = karg<29>(); q.p_u = karg<30>(); q.p_v = karg<31>();
  q.out = (float*)karg<32>(); q.ws = (char*)karg<33>();
  return q;
}

__device__ __forceinline__ void transpose_w_tile(const float* src, int srcld, int K, int N, u16* dst, int item, char* lds) {
  float* tile = (float*)lds;
  int ntn = N / 64;
  int kt = item / ntn, nt = item % ntn;
  int tid = otid();
#pragma unroll
  for (int i = 0; i < 4; ++i) {
    int r = (tid >> 4) + i * 16, c4 = (tid & 15) * 4;
    float4 v = *reinterpret_cast<const float4*>(src + (size_t)(kt * 64 + r) * srcld + nt * 64 + c4);
    tile[r * 65 + c4 + 0] = v.x; tile[r * 65 + c4 + 1] = v.y; tile[r * 65 + c4 + 2] = v.z; tile[r * 65 + c4 + 3] = v.w;
  }
  __syncthreads();
#pragma unroll
  for (int i = 0; i < 2; ++i) {
    int n = (tid >> 3) + i * 32, k8 = (tid & 7) * 8;
    uint4 o;
    o.x = pack2(tile[(k8 + 0) * 65 + n], tile[(k8 + 1) * 65 + n]);
    o.y = pack2(tile[(k8 + 2) * 65 + n], tile[(k8 + 3) * 65 + n]);
    o.z = pack2(tile[(k8 + 4) * 65 + n], tile[(k8 + 5) * 65 + n]);
    o.w = pack2(tile[(k8 + 6) * 65 + n], tile[(k8 + 7) * 65 + n]);
    *reinterpret_cast<uint4*>(dst + (size_t)(nt * 64 + n) * K + kt * 64 + k8) = o;
  }
  __syncthreads();
}

__device__ __forceinline__ void ada_item(const Params& p, int item, char* lds) {
  float* sl = (float*)lds;
  float* red = sl + 9 * 1024;
  int layer = item / 96, cg_ = item % 96;
  int tid = otid(), kq = tid >> 6, col = cg_ * 64 + (tid & 63);
  for (int e = tid; e < 9 * 1024; e += 256) {
    int r = e >> 10, k = e & 1023;
    sl[e] = siluf(r < 8 ? p.c[r * 1024 + k] : p.c_ctx[k]);
  }
  __syncthreads();
  float acc[9];
#pragma unroll
  for (int r = 0; r < 9; ++r) acc[r] = 0.f;
  const float* w = p.ada_w + (size_t)layer * 1024 * 6144 + col;
#pragma unroll 8
  for (int k = kq * 256; k < kq * 256 + 256; ++k) {
    float wv = w[(size_t)k * 6144];
#pragma unroll
    for (int r = 0; r < 9; ++r) acc[r] += sl[r * 1024 + k] * wv;
  }
#pragma unroll
  for (int r = 0; r < 9; ++r) red[(kq * 9 + r) * 64 + (tid & 63)] = acc[r];
  __syncthreads();
  if (tid < 64) {
    float* mod = (float*)(p.ws + OFF_MOD);
    float bias = p.ada_b[layer * 6144 + col];
#pragma unroll
    for (int r = 0; r < 9; ++r) {
      float s = red[(0 * 9 + r) * 64 + tid] + red[(1 * 9 + r) * 64 + tid] + red[(2 * 9 + r) * 64 + tid] + red[(3 * 9 + r) * 64 + tid];
      mod[((size_t)layer * 9 + r) * 6144 + col] = s + bias;
    }
  }
  __syncthreads();
}

__device__ __forceinline__ void hyena_mlp_item(const Params& p, int item, char* lds) {
  float* zb = (float*)lds;
  float* h1 = zb + 256;
  float* h2 = h1 + 256;
  int tid = otid(), ti = tid >> 6, j = tid & 63;
  int t = item * 4 + ti;
  const float L = 4096.f;
  if (j < 33) {
    float v;
    if (j == 0) v = (float)t / 4095.f;
    else {
      int k = (j - 1) & 15;
      float fb = 1e-4f + (float)k * ((15.f - 1e-4f) / 15.f);
      float ang = 6.283185307179586f * (float)t / L;
      float a = fb * ang;
      v = (j <= 16) ? cosf(a) : -sinf(a);
    }
    zb[ti * 64 + j] = v;
  }
  __syncthreads();
  float fr = p.h_freq[j];
  float s = p.h_f_b1[j];
#pragma unroll 3
  for (int i = 0; i < 33; ++i) s += zb[ti * 64 + i] * p.h_f_w1[i * 64 + j];
  h1[ti * 64 + j] = sinf(fr * s);
  __syncthreads();
  s = p.h_f_b2[j];
#pragma unroll 8
  for (int i = 0; i < 64; ++i) s += h1[ti * 64 + i] * p.h_f_w2[i * 64 + j];
  h2[ti * 64 + j] = sinf(fr * s);
  __syncthreads();
  s = p.h_f_b2[64 + j];
#pragma unroll 8
  for (int i = 0; i < 64; ++i) s += h2[ti * 64 + i] * p.h_f_w2[4096 + i * 64 + j];
  float* hid = (float*)(p.ws + OFF_HID);
  hid[t * 64 + j] = sinf(fr * s);
  __syncthreads();
}

__device__ __forceinline__ void phase_prologue(const Params& p, char* lds) {
  constexpr int T0 = 1296, T1 = T0 + 512, T2 = T1 + 768, T3 = T2 + 256, T4 = T3 + 512, T5 = T4 + 512, T6 = T5 + 192, T7 = T6 + 1024, T8 = T7 + 256, T9 = T8 + 16;
  for (int item = blockIdx.x; item < T9; item += gridDim.x) {
    if (item < T0) transpose_w_tile(p.m_w_in, SSM_IN, 1024, SSM_IN, (u16*)(p.ws + OFF_W_IN), item, lds);
    else if (item < T1) transpose_w_tile(p.m_w_out, 1024, 2048, 1024, (u16*)(p.ws + OFF_W_OUT), item - T0, lds);
    else if (item < T2) transpose_w_tile(p.h_w_in, 3072, 1024, 3072, (u16*)(p.ws + OFF_W_HIN), item - T1, lds);
    else if (item < T3) transpose_w_tile(p.h_w_out, 1024, 1024, 1024, (u16*)(p.ws + OFF_W_HOUT), item - T2, lds);
    else if (item < T4) transpose_w_tile(p.p_wq, 2048, 1024, 2048, (u16*)(p.ws + OFF_W_Q), item - T3, lds);
    else if (item < T5) transpose_w_tile(p.p_wq + (size_t)1024 * 2048, 2048, 1024, 2048, (u16*)(p.ws + OFF_W_Q) + (size_t)2048 * 1024, item - T4, lds);
    else if (item < T6) ada_item(p, item - T5, lds);
    else if (item < T7) hyena_mlp_item(p, item - T6, lds);
    else if (item >= T8) {
      int k = (item - T8) * 256 + threadIdx.x;
      float sn, cs;
      sincospif((float)k * (1.f / 4096.f), &sn, &cs);
      ((float2*)(p.ws + OFF_TW))[k] = make_float2(cs, -sn);
    } else {
      int e8 = ((item - T7) * 256 + threadIdx.x) * 8;
      const float* src = e8 < 262144 ? p.p_k1 + e8 : p.p_k2 + (e8 - 262144);
      float4 a0 = *reinterpret_cast<const float4*>(src), a1 = *reinterpret_cast<const float4*>(src + 4);
      uint4 o;
      o.x = pack2(a0.x, a0.y); o.y = pack2(a0.z, a0.w); o.z = pack2(a1.x, a1.y); o.w = pack2(a1.z, a1.w);
      *reinterpret_cast<uint4*>((u16*)(p.ws + OFF_KEYS) + e8) = o;
    }
  }
}

__device__ __forceinline__ void modulate_rows(const float* src, u16* dst, int nrows, int rows_per_batch, const float* modbase, int sh_off, int sc_off, bool ctxrow) {
  size_t total = (size_t)nrows * 128;
  for (size_t e = (size_t)blockIdx.x * 256 + threadIdx.x; e < total; e += (size_t)gridDim.x * 256) {
    int row = (int)(e >> 7), c8 = (int)(e & 127) * 8;
    int b = ctxrow ? 8 : row / rows_per_batch;
    const float* m = modbase + (size_t)b * 6144;
    float4 a0 = *reinterpret_cast<const float4*>(src + (size_t)row * 1024 + c8);
    float4 a1 = *reinterpret_cast<const float4*>(src + (size_t)row * 1024 + c8 + 4);
    float4 s0 = *reinterpret_cast<const float4*>(m + sc_off + c8);
    float4 s1 = *reinterpret_cast<const float4*>(m + sc_off + c8 + 4);
    float4 h0 = *reinterpret_cast<const float4*>(m + sh_off + c8);
    float4 h1 = *reinterpret_cast<const float4*>(m + sh_off + c8 + 4);
    uint4 o;
    o.x = pack2(a0.x * (1.f + s0.x) + h0.x, a0.y * (1.f + s0.y) + h0.y);
    o.y = pack2(a0.z * (1.f + s0.z) + h0.z, a0.w * (1.f + s0.w) + h0.w);
    o.z = pack2(a1.x * (1.f + s1.x) + h1.x, a1.y * (1.f + s1.y) + h1.y);
    o.w = pack2(a1.z * (1.f + s1.z) + h1.z, a1.w * (1.f + s1.w) + h1.w);
    *reinterpret_cast<uint4*>(dst + (size_t)row * 1024 + c8) = o;
  }
}

constexpr int GLD = 72;
template <class Epi>
__device__ __forceinline__ void gemm_tile(const u16* __restrict__ A, int lda, const u16* __restrict__ Bt, int ldb, int brow, int bcol, int Nmax,
                                          int K, char* lds, Epi epi) {
  u16* SA = (u16*)lds;
  u16* SB = SA + 256 * GLD;
  int tid = otid(), wid = tid >> 6, lane = tid & 63, wr = wid >> 1, wc = wid & 1, fr = lane & 15, fq = lane >> 4;
  f32x4 acc[8][4];
#pragma unroll
  for (int m = 0; m < 8; ++m)
#pragma unroll
    for (int n = 0; n < 4; ++n) acc[m][n] = f32x4{0.f, 0.f, 0.f, 0.f};
  u32x4 ra[8], rb[4];
  const int lr = tid >> 3, lc = (tid & 7) * 8;
  const u16* abase = A + (size_t)brow * lda;
  const unsigned aoff = (unsigned)(lr * lda + lc);
  unsigned bo[4];
#pragma unroll
  for (int i = 0; i < 4; ++i) {
    int br = bcol + lr + i * 32;
    if (br >= Nmax) br = Nmax - 1;
    bo[i] = (unsigned)(br * ldb + lc);
  }
#define GLOADT(KT)                                                                                 \
  _Pragma("unroll") for (int i = 0; i < 8; ++i)                                                    \
    ra[i] = *reinterpret_cast<const u32x4*>(abase + (aoff + (unsigned)((i * 32) * lda + (KT) * 64))); \
  _Pragma("unroll") for (int i = 0; i < 4; ++i)                                                    \
    rb[i] = *reinterpret_cast<const u32x4*>(Bt + (bo[i] + (unsigned)((KT) * 64)));
  const int nk = K / 64;
  GLOADT(0)
  for (int kt = 0; kt < nk; ++kt) {
#pragma unroll
    for (int i = 0; i < 8; ++i) *reinterpret_cast<u32x4*>(SA + (lr + i * 32) * GLD + lc) = ra[i];
#pragma unroll
    for (int i = 0; i < 4; ++i) *reinterpret_cast<u32x4*>(SB + (lr + i * 32) * GLD + lc) = rb[i];
    __syncthreads();
    { const int kn = kt + 1 < nk ? kt + 1 : nk - 1; GLOADT(kn) }
#pragma unroll
    for (int kk = 0; kk < 2; ++kk) {
      bf16x8 Bl[4];
#pragma unroll
      for (int n = 0; n < 4; ++n) Bl[n] = ld8(SB + (wc * 64 + n * 16 + fr) * GLD + kk * 32 + fq * 8);
#pragma unroll
      for (int mh = 0; mh < 2; ++mh) {
        bf16x8 At[4];
#pragma unroll
        for (int m = 0; m < 4; ++m) At[m] = ld8(SA + (wr * 128 + (mh * 4 + m) * 16 + fr) * GLD + kk * 32 + fq * 8);
#pragma unroll
        for (int m = 0; m < 4; ++m)
#pragma unroll
          for (int n = 0; n < 4; ++n) acc[mh * 4 + m][n] = mfma16(Bl[n], At[m], acc[mh * 4 + m][n]);
      }
    }
    __syncthreads();
  }
#undef GLOADT
#pragma unroll
  for (int m = 0; m < 8; ++m)
#pragma unroll
    for (int n = 0; n < 4; ++n) epi(brow + wr * 128 + m * 16 + fr, bcol + wc * 64 + n * 16 + fq * 4, acc[m][n]);
}

DEV float softplusf(float v) { return fmaxf(v, 0.f) + log1pf(__expf(-fabsf(v))); }

__device__ __forceinline__ void phase_gemm_inproj(const Params& p, char* lds) {
  const u16* hx = (const u16*)(p.ws + OFF_R2);
  const u16* hc = (const u16*)(p.ws + OFF_HC);
  const u16* Wt = (const u16*)(p.ws + OFF_W_IN);
  u16* zbuf = (u16*)p.out;
  u16* xbc = (u16*)(p.ws + OFF_R1);
  float* dt = (float*)(p.ws + OFF_DT);
  u16* xbc_c = (u16*)(p.ws + OFF_XBC_C);
  float* dt_c = (float*)(p.ws + OFF_DT_C);
  const float* dtb = p.m_dt_bias;
  const int xcd = blockIdx.x & 7, li = blockIdx.x >> 3, nl = gridDim.x >> 3;
  auto epi_lat = [=](int m, int n, f32x4 v) {
    if (n < 2048) *reinterpret_cast<uint2*>(zbuf + (size_t)m * 2048 + n) = make_uint2(pack2(v[0], v[1]), pack2(v[2], v[3]));
    else if (n < 5120) *reinterpret_cast<uint2*>(xbc + (size_t)m * 3072 + (n - 2048)) = make_uint2(pack2(v[0], v[1]), pack2(v[2], v[3]));
    else if (n < 5184) {
      float4 bb = *reinterpret_cast<const float4*>(dtb + (n - 5120));
      *reinterpret_cast<float4*>(dt + (size_t)m * 64 + (n - 5120)) = make_float4(softplusf(v[0] + bb.x), softplusf(v[1] + bb.y), softplusf(v[2] + bb.z), softplusf(v[3] + bb.w));
    }
  };
  auto epi_ctx = [=](int m, int n, f32x4 v) {
    if (n < 3072) *reinterpret_cast<uint2*>(xbc_c + (size_t)m * 3072 + n) = make_uint2(pack2(v[0], v[1]), pack2(v[2], v[3]));
    else if (n < 3136) {
      float4 bb = *reinterpret_cast<const float4*>(dtb + (n - 3072));
      *reinterpret_cast<float4*>(dt_c + (size_t)m * 64 + (n - 3072)) = make_float4(softplusf(v[0] + bb.x), softplusf(v[1] + bb.y), softplusf(v[2] + bb.z), softplusf(v[3] + bb.w));
    }
  };
  for (int t = li; t < 128 * 5; t += nl) {
    int pm = t / 5, pn = xcd + 8 * (t % 5);
    gemm_tile(hx, 1024, Wt, 1024, pm * 256, pn * 128, SSM_IN, 1024, lds, epi_lat);
  }
  for (int t = blockIdx.x; t < 128 + 8 * 25; t += gridDim.x) {
    if (t < 128) gemm_tile(hx, 1024, Wt, 1024, t * 256, 40 * 128, SSM_IN, 1024, lds, epi_lat);
    else {
      int it = t - 128, pm = it / 25, pn = it % 25;
      gemm_tile(hc, 1024, Wt + (size_t)2048 * 1024, 1024, pm * 256, pn * 128, 3136, 1024, lds, epi_ctx);
    }
  }
}

DEV void fma8(float* acc, const u32x4& v, const float* w) {
  acc[0] += bflo(v[0]) * w[0]; acc[1] += bfhi(v[0]) * w[1]; acc[2] += bflo(v[1]) * w[2]; acc[3] += bfhi(v[1]) * w[3];
  acc[4] += bflo(v[2]) * w[4]; acc[5] += bfhi(v[2]) * w[5]; acc[6] += bflo(v[3]) * w[6]; acc[7] += bfhi(v[3]) * w[7];
}
__device__ __forceinline__ void phase_conv(const Params& p) {
  const u16* xbc = (const u16*)(p.ws + OFF_R1);
  u16* xc = (u16*)(p.ws + OFF_R2);
  const u16* xbc_c = (const u16*)(p.ws + OFF_XBC_C);
  u16* xc_c = (u16*)(p.ws + OFF_XC_C);
  const float* cw = p.m_conv_w;
  const float* cb = p.m_conv_b;
  const int tid_ = otid();
  const size_t nl = (size_t)8 * 64 * 8 * 384;
  for (size_t e = (size_t)blockIdx.x * 256 + tid_; e < nl; e += (size_t)gridDim.x * 256) {
    int ch = (int)(e % 384) * 8;
    int rest = (int)(e / 384);
    int cg_ = rest & 7, r = (rest >> 3) & 63, b = rest >> 9;
    float w[9][8];
#pragma unroll
    for (int k = 0; k < 9; ++k) {
      float4 w0 = *reinterpret_cast<const float4*>(cw + k * 3072 + ch), w1 = *reinterpret_cast<const float4*>(cw + k * 3072 + ch + 4);
      w[k][0] = w0.x; w[k][1] = w0.y; w[k][2] = w0.z; w[k][3] = w0.w; w[k][4] = w1.x; w[k][5] = w1.y; w[k][6] = w1.z; w[k][7] = w1.w;
    }
    float bias[8];
    {
      float4 b0 = *reinterpret_cast<const float4*>(cb + ch), b1 = *reinterpret_cast<const float4*>(cb + ch + 4);
      bias[0] = b0.x; bias[1] = b0.y; bias[2] = b0.z; bias[3] = b0.w; bias[4] = b1.x; bias[5] = b1.y; bias[6] = b1.z; bias[7] = b1.w;
    }
    const u32x4 zero4 = u32x4{0u, 0u, 0u, 0u};
    const int c0 = cg_ * 8;
    u32x4 win[3][3];
#pragma unroll
    for (int i = 0; i < 3; ++i) {
      int rr = r + i - 1;
      bool rok = rr >= 0 && rr <= 63;
      const u16* rowp = xbc + ((size_t)(b * 4096 + (rok ? rr : r) * 64)) * 3072 + ch;
      win[i][0] = (rok && c0 > 0) ? *reinterpret_cast<const u32x4*>(rowp + (size_t)(c0 - 1) * 3072) : zero4;
      win[i][1] = rok ? *reinterpret_cast<const u32x4*>(rowp + (size_t)c0 * 3072) : zero4;
    }
#pragma unroll
    for (int cc = 0; cc < 8; ++cc) {
      int c = c0 + cc;
#pragma unroll
      for (int i = 0; i < 3; ++i) {
        int rr = r + i - 1;
        bool rok = rr >= 0 && rr <= 63;
        const u16* rowp = xbc + ((size_t)(b * 4096 + (rok ? rr : r) * 64)) * 3072 + ch;
        win[i][2] = (rok && c < 63) ? *reinterpret_cast<const u32x4*>(rowp + (size_t)(c + 1) * 3072) : zero4;
      }
      float acc[8];
#pragma unroll
      for (int k = 0; k < 8; ++k) acc[k] = bias[k];
#pragma unroll
      for (int i = 0; i < 3; ++i)
#pragma unroll
        for (int j = 0; j < 3; ++j) fma8(acc, win[i][j], w[i * 3 + j]);
      uint4 o;
      o.x = pack2(siluf(acc[0]), siluf(acc[1]));
      o.y = pack2(siluf(acc[2]), siluf(acc[3]));
      o.z = pack2(siluf(acc[4]), siluf(acc[5]));
      o.w = pack2(siluf(acc[6]), siluf(acc[7]));
      *reinterpret_cast<uint4*>(xc + ((size_t)(b * 4096 + r * 64 + c)) * 3072 + ch) = o;
#pragma unroll
      for (int i = 0; i < 3; ++i) { win[i][0] = win[i][1]; win[i][1] = win[i][2]; }
    }
  }
  const size_t ncx = (size_t)NTC * 384;
  for (size_t e = (size_t)blockIdx.x * 256 + tid_; e < ncx; e += (size_t)gridDim.x * 256) {
    int tok = (int)(e / 384), ch = (int)(e % 384) * 8;
    float acc[8];
#pragma unroll
    for (int k = 0; k < 8; ++k) acc[k] = cb[ch + k];
    int b = tok >> 8, c = tok & 255;
#pragma unroll
    for (int j = 0; j < 3; ++j) {
      int cc = c + j - 1;
      if (cc < 0 || cc > 255) continue;
      uint4 v = *reinterpret_cast<const uint4*>(xbc_c + ((size_t)(b * 256 + cc)) * 3072 + ch);
      const float* w = cw + (3 + j) * 3072 + ch;
      float4 w0 = *reinterpret_cast<const float4*>(w), w1 = *reinterpret_cast<const float4*>(w + 4);
      acc[0] += bflo(v.x) * w0.x; acc[1] += bfhi(v.x) * w0.y; acc[2] += bflo(v.y) * w0.z; acc[3] += bfhi(v.y) * w0.w;
      acc[4] += bflo(v.z) * w1.x; acc[5] += bfhi(v.z) * w1.y; acc[6] += bflo(v.w) * w1.z; acc[7] += bfhi(v.w) * w1.w;
    }
    uint4 o;
    o.x = pack2(siluf(acc[0]), siluf(acc[1]));
    o.y = pack2(siluf(acc[2]), siluf(acc[3]));
    o.z = pack2(siluf(acc[4]), siluf(acc[5]));
    o.w = pack2(siluf(acc[6]), siluf(acc[7]));
    *reinterpret_cast<uint4*>(xc_c + (size_t)tok * 3072 + ch) = o;
  }
}

constexpr int SLD = 136;
__device__ __forceinline__ void phase_ssd(const Params& p, char* lds) {
  u16* xsT = (u16*)lds;
  u16* stb = xsT + 64 * SLD;
  u16* Mb = stb + 64 * SLD;
  float* cum = (float*)(Mb + 128 * SLD);
  float* dtv = cum + 128;
  float* asrc = dtv + 128;
  const u16* xc = (const u16*)(p.ws + OFF_R2);
  const u16* xc_c = (const u16*)(p.ws + OFF_XC_C);
  const float* dt = (const float*)(p.ws + OFF_DT);
  const float* dt_c = (const float*)(p.ws + OFF_DT_C);
  u16* y = (u16*)(p.ws + OFF_R1);
  int tid = otid(), w = tid >> 6, lane = tid & 63, fr = lane & 15, fq = lane >> 4;
  unsigned char* yb8 = (unsigned char*)(p.ws + OFF_R1 + 128 * MiB);
  for (int item = blockIdx.x; item < 512; item += gridDim.x) {
    int b = item >> 6, h = (item >> 1) & 31, g = h >> 3;
    float dsk = p.m_d[h];
    {
      const int dir = item & 1;
      float a_neg = -__expf(p.m_a_log[dir * 32 + h]);
      f32x4 acc_s[8];
#pragma unroll
      for (int n = 0; n < 8; ++n) acc_s[n] = f32x4{0.f, 0.f, 0.f, 0.f};
      for (int step = 0; step < 34; ++step) {
        bool isctx = step < 2;
        int cidx = isctx ? step : step - 2;
        if (dir) cidx = (isctx ? 1 : 31) - cidx;
        size_t tok0 = isctx ? (size_t)(b * 256 + cidx * 128) : (size_t)(b * 4096 + cidx * 128);
        const u16* src = (isctx ? xc_c : xc) + tok0 * 3072;
        const float* dts = (isctx ? dt_c : dt) + tok0 * 64;
        int tz = tid;
        asm volatile("" : "+v"(tz));
        float dval = 0.f;
        if (tid < 128) dval = dts[tid * 64 + dir * 32 + h];
        uint4 xv[4], bv[8];
#pragma unroll
        for (int i = 0; i < 4; ++i) {
          int idx = tz + i * 256, l = (idx & 31) | ((idx >> 8) << 5), pc = ((idx >> 5) & 7) * 8;
          xv[i] = *reinterpret_cast<const uint4*>(src + (size_t)l * 3072 + h * 64 + pc);
        }
#pragma unroll
        for (int i = 0; i < 8; ++i) {
          int idx = tz + i * 256, l = (idx & 31) | (((idx >> 9) & 3) << 5), nc = (((idx >> 5) & 7) | (((idx >> 8) & 1) << 3)) * 8;
          bv[i] = *reinterpret_cast<const uint4*>(src + (size_t)l * 3072 + 2048 + g * 128 + nc);
        }
        if (tid < 128) { dtv[tid] = dval; asrc[tid] = dval * a_neg; }
#pragma unroll
        for (int i = 0; i < 4; ++i) {
          int idx = tz + i * 256, l = (idx & 31) | ((idx >> 8) << 5), pc = ((idx >> 5) & 7) * 8;
          uint4 v = xv[i];
          xsT[(pc + 0) * SLD + l] = (u16)(v.x & 0xffff); xsT[(pc + 1) * SLD + l] = (u16)(v.x >> 16);
          xsT[(pc + 2) * SLD + l] = (u16)(v.y & 0xffff); xsT[(pc + 3) * SLD + l] = (u16)(v.y >> 16);
          xsT[(pc + 4) * SLD + l] = (u16)(v.z & 0xffff); xsT[(pc + 5) * SLD + l] = (u16)(v.z >> 16);
          xsT[(pc + 6) * SLD + l] = (u16)(v.w & 0xffff); xsT[(pc + 7) * SLD + l] = (u16)(v.w >> 16);
        }
        if (!isctx) {
#pragma unroll
          for (int i = 0; i < 8; ++i) {
            int idx = tz + i * 256, l = (idx & 31) | (((idx >> 9) & 3) << 5), nc = (((idx >> 5) & 7) | (((idx >> 8) & 1) << 3)) * 8;
            *reinterpret_cast<uint4*>(Mb + l * SLD + nc) = bv[i];
          }
        }
        __syncthreads();
        bf16x8 Cf[2][4];
        if (!isctx) {
#pragma unroll
          for (int mt = 0; mt < 2; ++mt)
#pragma unroll
            for (int kk = 0; kk < 4; ++kk) Cf[mt][kk] = ld8(src + (size_t)(w * 32 + mt * 16 + fr) * 3072 + 2560 + g * 128 + kk * 32 + fq * 8);
        }
        if (tid < 128) {
          float s = 0.f;
          if (!dir) { for (int j = 0; j <= tid; ++j) s += asrc[j]; }
          else { for (int j = tid; j < 128; ++j) s += asrc[j]; }
          cum[tid] = s;
        }
        __syncthreads();
        float total = dir ? cum[0] : cum[127];
        if (!isctx) {
          float cl[2][4];
#pragma unroll
          for (int mt = 0; mt < 2; ++mt)
#pragma unroll
            for (int j = 0; j < 4; ++j) cl[mt][j] = cum[w * 32 + mt * 16 + fq * 4 + j];
          f32x4 cb0[8], cb1[8];
#pragma unroll
          for (int nt = 0; nt < 8; ++nt) {
            cb0[nt] = f32x4{0.f, 0.f, 0.f, 0.f};
            cb1[nt] = f32x4{0.f, 0.f, 0.f, 0.f};
            bool need = dir ? (nt >= w * 2) : (nt <= w * 2 + 1);
            if (need) {
#pragma unroll
              for (int kk = 0; kk < 4; ++kk) {
                bf16x8 Bf = ld8(Mb + (nt * 16 + fr) * SLD + kk * 32 + fq * 8);
                cb0[nt] = mfma16(Cf[0][kk], Bf, cb0[nt]);
                cb1[nt] = mfma16(Cf[1][kk], Bf, cb1[nt]);
              }
            }
          }
          __syncthreads();
          int zero = 0;
          asm volatile("" : "+v"(zero));
#pragma unroll
          for (int nt = 0; nt < 8; ++nt) {
            int s = nt * 16 + fr + zero;
            float cs = cum[s], ds = dtv[s];
#pragma unroll
            for (int j = 0; j < 4; ++j) {
              int l0 = w * 32 + fq * 4 + j, l1 = l0 + 16;
              bool ok0 = dir ? (s >= l0) : (s <= l0);
              bool ok1 = dir ? (s >= l1) : (s <= l1);
              float v0 = ok0 ? cb0[nt][j] * __expf(cl[0][j] - cs) * ds : 0.f;
              float v1 = ok1 ? cb1[nt][j] * __expf(cl[1][j] - cs) * ds : 0.f;
              Mb[l0 * SLD + s] = f2bf(v0);
              Mb[l1 * SLD + s] = f2bf(v1);
            }
          }
          __syncthreads();
          f32x4 ya[2][4];
#pragma unroll
          for (int mt = 0; mt < 2; ++mt)
#pragma unroll
            for (int nt = 0; nt < 4; ++nt) ya[mt][nt] = f32x4{0.f, 0.f, 0.f, 0.f};
#pragma unroll
          for (int kk = 0; kk < 4; ++kk)
#pragma unroll
            for (int nt = 0; nt < 4; ++nt) {
              bf16x8 Sf = ld8(stb + (nt * 16 + fr) * SLD + kk * 32 + fq * 8);
              ya[0][nt] = mfma16(Sf, Cf[0][kk], ya[0][nt]);
              ya[1][nt] = mfma16(Sf, Cf[1][kk], ya[1][nt]);
            }
#pragma unroll
          for (int mt = 0; mt < 2; ++mt) {
            float e = __expf(cum[w * 32 + mt * 16 + fr]);
#pragma unroll
            for (int nt = 0; nt < 4; ++nt) ya[mt][nt] *= e;
          }
#pragma unroll
          for (int kk = 0; kk < 4; ++kk) {
            bf16x8 Mf0 = ld8(Mb + (w * 32 + fr) * SLD + kk * 32 + fq * 8);
            bf16x8 Mf1 = ld8(Mb + (w * 32 + 16 + fr) * SLD + kk * 32 + fq * 8);
#pragma unroll
            for (int nt = 0; nt < 4; ++nt) {
              bf16x8 Xf = ld8(xsT + (nt * 16 + fr) * SLD + kk * 32 + fq * 8);
              ya[0][nt] = mfma16(Xf, Mf0, ya[0][nt]);
              ya[1][nt] = mfma16(Xf, Mf1, ya[1][nt]);
            }
          }
#pragma unroll
          for (int i = 0; i < 8; ++i) {
            int idx = tz + i * 256, l = (idx & 31) | (((idx >> 9) & 3) << 5), nc = (((idx >> 5) & 7) | (((idx >> 8) & 1) << 3)) * 8;
            bv[i] = *reinterpret_cast<const uint4*>(src + (size_t)l * 3072 + 2048 + g * 128 + nc);
          }
#pragma unroll
          for (int mt = 0; mt < 2; ++mt)
#pragma unroll
            for (int nt = 0; nt < 4; ++nt) {
              const int l = w * 32 + mt * 16 + fr, p0 = nt * 16 + fq * 4;
              f32x4 v = ya[mt][nt];
              if (!dir) {
                v[0] += bf2f(xsT[(p0 + 0) * SLD + l]) * dsk; v[1] += bf2f(xsT[(p0 + 1) * SLD + l]) * dsk;
                v[2] += bf2f(xsT[(p0 + 2) * SLD + l]) * dsk; v[3] += bf2f(xsT[(p0 + 3) * SLD + l]) * dsk;
                *reinterpret_cast<uint2*>(y + (tok0 + l) * 2048 + h * 64 + p0) = make_uint2(pack2(v[0], v[1]), pack2(v[2], v[3]));
              } else {
                int pk = __builtin_amdgcn_cvt_pk_fp8_f32(fminf(fmaxf(v[0] * 4.f, -440.f), 440.f), fminf(fmaxf(v[1] * 4.f, -440.f), 440.f), 0, false);
                pk = __builtin_amdgcn_cvt_pk_fp8_f32(fminf(fmaxf(v[2] * 4.f, -440.f), 440.f), fminf(fmaxf(v[3] * 4.f, -440.f), 440.f), pk, true);
                *reinterpret_cast<int*>(yb8 + (tok0 + l) * 2048 + h * 64 + p0) = pk;
              }
            }
        }
        if (step == 33) continue;
        __syncthreads();
#pragma unroll
        for (int i = 0; i < 8; ++i) {
          int idx = tz + i * 256, l = (idx & 31) | (((idx >> 9) & 3) << 5), nc = (((idx >> 5) & 7) | (((idx >> 8) & 1) << 3)) * 8;
          uint4 v = bv[i];
          float sc = dtv[l] * __expf(total - cum[l]);
          Mb[(nc + 0) * SLD + l] = f2bf(bflo(v.x) * sc); Mb[(nc + 1) * SLD + l] = f2bf(bfhi(v.x) * sc);
          Mb[(nc + 2) * SLD + l] = f2bf(bflo(v.y) * sc); Mb[(nc + 3) * SLD + l] = f2bf(bfhi(v.y) * sc);
          Mb[(nc + 4) * SLD + l] = f2bf(bflo(v.z) * sc); Mb[(nc + 5) * SLD + l] = f2bf(bfhi(v.z) * sc);
          Mb[(nc + 6) * SLD + l] = f2bf(bflo(v.w) * sc); Mb[(nc + 7) * SLD + l] = f2bf(bfhi(v.w) * sc);
        }
        __syncthreads();
        float cd = __expf(total);
#pragma unroll
        for (int nt = 0; nt < 8; ++nt) acc_s[nt] *= cd;
#pragma unroll
        for (int kk = 0; kk < 4; ++kk) {
          bf16x8 Af = ld8(xsT + (w * 16 + fr) * SLD + kk * 32 + fq * 8);
#pragma unroll
          for (int nt = 0; nt < 8; ++nt) {
            bf16x8 Bf = ld8(Mb + (nt * 16 + fr) * SLD + kk * 32 + fq * 8);
            acc_s[nt] = mfma16(Af, Bf, acc_s[nt]);
          }
        }
#pragma unroll
        for (int nt = 0; nt < 8; ++nt)
#pragma unroll
          for (int j = 0; j < 4; ++j) stb[(w * 16 + fq * 4 + j) * SLD + nt * 16 + fr] = f2bf(acc_s[nt][j]);
        __syncthreads();
      }
      __syncthreads();
    }
  }
}

__device__ __forceinline__ void phase_gated_norm(const Params& p) {
  u16* y = (u16*)(p.ws + OFF_R1);
  const u16* z = (const u16*)p.out;
  const unsigned char* yb8 = (const unsigned char*)(p.ws + OFF_R1 + 128 * MiB);
  const int tid_ = otid();
  int lane = tid_ & 63;
  int wave = blockIdx.x * 4 + (tid_ >> 6), nw = gridDim.x * 4;
  for (int tok = wave; tok < NT; tok += nw) {
#pragma unroll
    for (int g = 0; g < 4; ++g) {
      int ch = g * 512 + lane * 8;
      uint4 yv = *reinterpret_cast<const uint4*>(y + (size_t)tok * 2048 + ch);
      uint4 zv = *reinterpret_cast<const uint4*>(z + (size_t)tok * 2048 + ch);
      uint2 bw = *reinterpret_cast<const uint2*>(yb8 + (size_t)tok * 2048 + ch);
      f32x2 b01 = __builtin_amdgcn_cvt_pk_f32_fp8((int)bw.x, false), b23 = __builtin_amdgcn_cvt_pk_f32_fp8((int)bw.x, true);
      f32x2 b45 = __builtin_amdgcn_cvt_pk_f32_fp8((int)bw.y, false), b67 = __builtin_amdgcn_cvt_pk_f32_fp8((int)bw.y, true);
      const float r16 = 0.25f;
      float u[8];
      u[0] = (bflo(yv.x) + b01.x * r16) * siluf(bflo(zv.x)); u[1] = (bfhi(yv.x) + b01.y * r16) * siluf(bfhi(zv.x));
      u[2] = (bflo(yv.y) + b23.x * r16) * siluf(bflo(zv.y)); u[3] = (bfhi(yv.y) + b23.y * r16) * siluf(bfhi(zv.y));
      u[4] = (bflo(yv.z) + b45.x * r16) * siluf(bflo(zv.z)); u[5] = (bfhi(yv.z) + b45.y * r16) * siluf(bfhi(zv.z));
      u[6] = (bflo(yv.w) + b67.x * r16) * siluf(bflo(zv.w)); u[7] = (bfhi(yv.w) + b67.y * r16) * siluf(bfhi(zv.w));
      float ss = 0.f;
#pragma unroll
      for (int k = 0; k < 8; ++k) ss += u[k] * u[k];
      ss = wave_sum(ss);
      float sc = rsqrtf(ss * (1.f / 512.f) + 1e-5f);
      float4 w0 = *reinterpret_cast<const float4*>(p.m_norm_w + ch), w1 = *reinterpret_cast<const float4*>(p.m_norm_w + ch + 4);
      uint4 o;
      o.x = pack2(u[0] * sc * w0.x, u[1] * sc * w0.y);
      o.y = pack2(u[2] * sc * w0.z, u[3] * sc * w0.w);
      o.z = pack2(u[4] * sc * w1.x, u[5] * sc * w1.y);
      o.w = pack2(u[6] * sc * w1.z, u[7] * sc * w1.w);
      *reinterpret_cast<uint4*>(y + (size_t)tok * 2048 + ch) = o;
    }
  }
}

__device__ __forceinline__ void phase_gemm_resid(const u16* A, int K, const u16* Wt, const float* res, float* dst, const float* gate  , char* lds) {
  const int xcd = blockIdx.x & 7, li = blockIdx.x >> 3, nl = gridDim.x >> 3;
  for (int t = li; t < 128; t += nl) {
    int pm = t, pn = xcd;
    gemm_tile(A, K, Wt, K, pm * 256, pn * 128, 1024, K, lds, [=](int m, int n, f32x4 v) {
      int b = m >> 12;
      float4 r = *reinterpret_cast<const float4*>(res + (size_t)m * 1024 + n);
      float4 g = *reinterpret_cast<const float4*>(gate + (size_t)b * 6144 + n);
      *reinterpret_cast<float4*>(dst + (size_t)m * 1024 + n) = make_float4(ALPHA * r.x + g.x * v[0], ALPHA * r.y + g.y * v[1], ALPHA * r.z + g.z * v[2], ALPHA * r.w + g.w * v[3]);
    });
  }
}
__device__ __forceinline__ void phase_gemm_bf16(const u16* A, const u16* Wt, u16* dst, int N, char* lds) {
  const int xcd = blockIdx.x & 7, li = blockIdx.x >> 3, nl = gridDim.x >> 3;
  const int nb = N / 1024;
  for (int t = li; t < 128 * nb; t += nl) {
    int pm = t / nb, pn = xcd + 8 * (t % nb);
    gemm_tile(A, 1024, Wt, 1024, pm * 256, pn * 128, N, 1024, lds, [=](int m, int n, f32x4 v) { *reinterpret_cast<uint2*>(dst + (size_t)m * N + n) = make_uint2(pack2(v[0], v[1]), pack2(v[2], v[3])); });
  }
}

__device__ __forceinline__ void phase_ln_mod(float* xio, const float* g, const float* bta, const float* mod  , u16* tdst) {
  const int tid_ = otid();
  int lane = tid_ & 63;
  int wave = blockIdx.x * 4 + (tid_ >> 6), nw = gridDim.x * 4;
  for (int tok = wave; tok < NT; tok += nw) {
    int b = tok >> 12;
    float4 v[4];
    float s = 0.f;
#pragma unroll
    for (int i = 0; i < 4; ++i) {
      v[i] = *reinterpret_cast<const float4*>(xio + (size_t)tok * 1024 + i * 256 + lane * 4);
      s += v[i].x + v[i].y + v[i].z + v[i].w;
    }
    float mu = wave_sum(s) * (1.f / 1024.f);
    float q = 0.f;
#pragma unroll
    for (int i = 0; i < 4; ++i) {
      v[i].x -= mu; v[i].y -= mu; v[i].z -= mu; v[i].w -= mu;
      q += v[i].x * v[i].x + v[i].y * v[i].y + v[i].z * v[i].z + v[i].w * v[i].w;
    }
    float rs = rsqrtf(wave_sum(q) * (1.f / 1024.f) + 1e-5f);
    const float* m = mod + (size_t)b * 6144;
#pragma unroll
    for (int i = 0; i < 4; ++i) {
      int c = i * 256 + lane * 4;
      float4 gg = *reinterpret_cast<const float4*>(g + c), bb = *reinterpret_cast<const float4*>(bta + c);
      float4 o;
      o.x = v[i].x * rs * gg.x + bb.x; o.y = v[i].y * rs * gg.y + bb.y; o.z = v[i].z * rs * gg.z + bb.z; o.w = v[i].w * rs * gg.w + bb.w;
      *reinterpret_cast<float4*>(xio + (size_t)tok * 1024 + c) = o;
      float4 sh = *reinterpret_cast<const float4*>(m + 3072 + c), sc = *reinterpret_cast<const float4*>(m + 4096 + c);
      uint2 t;
      t.x = pack2(o.x * (1.f + sc.x) + sh.x, o.y * (1.f + sc.y) + sh.y);
      t.y = pack2(o.z * (1.f + sc.z) + sh.z, o.w * (1.f + sc.w) + sh.w);
      *reinterpret_cast<uint2*>(tdst + (size_t)tok * 1024 + c) = t;
    }
  }
}

__device__ __forceinline__ void phase_peer_topk(const u16* q, const u16* k1, const u16* k2, int* idxo, float* gateo, char* lds) {
  float* S = (float*)lds;
  float* sv = S + 64 * 129;
  int* si = (int*)(sv + 64 * 16);
  int tid = otid(), w = tid >> 6, lane = tid & 63, fr = lane & 15, fq = lane >> 4;
  const int slot = lane;
  const bool cvalid = lane < 50;
  int ci = slot < 42 ? ((slot >= 16) + (slot >= 24) + (slot >= 29) + (slot >= 33) + (slot >= 36) + (slot >= 38) + (slot >= 40)) : slot - 34;
  const unsigned long long PACK = 0ull | (16ull << 8) | (24ull << 16) | (29ull << 24) | (33ull << 32) | (36ull << 40) | (38ull << 48) | (40ull << 56);
  int cj = slot - (ci < 8 ? (int)((PACK >> (8 * ci)) & 0xFF) : 34 + ci);
  if (!cvalid) { ci = 0; cj = 0; }
  for (int item = blockIdx.x; item < 1024 * 8; item += gridDim.x) {
    int tile = item >> 3, h = item & 7;
    int tok0 = tile * 32;
    {
      int half = w >> 1, kb = (w & 1) * 64;
      const u16* kk_ = (half ? k2 : k1) + (size_t)h * 128 * 128;
      bf16x8 Af[2][4], Bf[4][4];
#pragma unroll
      for (int m = 0; m < 2; ++m)
#pragma unroll
        for (int ks = 0; ks < 4; ++ks) Af[m][ks] = ld8(q + (size_t)(tok0 + m * 16 + fr) * 2048 + h * 256 + half * 128 + ks * 32 + fq * 8);
#pragma unroll
      for (int n = 0; n < 4; ++n)
#pragma unroll
        for (int ks = 0; ks < 4; ++ks) Bf[n][ks] = ld8(kk_ + (size_t)(kb + n * 16 + fr) * 128 + ks * 32 + fq * 8);
      f32x4 acc[2][4];
#pragma unroll
      for (int m = 0; m < 2; ++m)
#pragma unroll
        for (int n = 0; n < 4; ++n) acc[m][n] = f32x4{0.f, 0.f, 0.f, 0.f};
#pragma unroll
      for (int ks = 0; ks < 4; ++ks)
#pragma unroll
        for (int n = 0; n < 4; ++n) {
          acc[0][n] = mfma16(Af[0][ks], Bf[n][ks], acc[0][n]);
          acc[1][n] = mfma16(Af[1][ks], Bf[n][ks], acc[1][n]);
        }
#pragma unroll
      for (int m = 0; m < 2; ++m)
#pragma unroll
        for (int n = 0; n < 4; ++n)
#pragma unroll
          for (int j = 0; j < 4; ++j) S[(half * 32 + m * 16 + fq * 4 + j) * 129 + kb + n * 16 + fr] = acc[m][n][j];
    }
    __syncthreads();
    float nlo = S[(w * 16) * 129 + lane], nhi = S[(w * 16) * 129 + lane + 64];
#pragma unroll 1
    for (int li = 0; li < 16; ++li) {
      int list = w * 16 + li;
      float vlo = nlo, vhi = nhi;
      {
        const int ln = w * 16 + (li + 1 < 16 ? li + 1 : 15);
        nlo = S[ln * 129 + lane];
        nhi = S[ln * 129 + lane + 64];
      }
      unsigned klo = (ordkey(vlo) & 0xFFFFFF80u) | (unsigned)(127 - lane);
      unsigned khi = (ordkey(vhi) & 0xFFFFFF80u) | (unsigned)(63 - lane);
      unsigned T = 0;
#pragma unroll 4
      for (int bit = 31; bit >= 0; --bit) {
        unsigned cand = T | (1u << bit);
        int cnt = __popcll(__ballot(klo >= cand)) + __popcll(__ballot(khi >= cand));
        if (cnt >= 16) T = cand;
        if (cnt == 16) break;
      }
      bool slo = klo >= T, shi = khi >= T;
      unsigned long long mlo = __ballot(slo), mhi = __ballot(shi);
      int rlo = 0, rhi = 0;
      while (mlo) {
        int src = __ffsll((long long)mlo) - 1;
        mlo &= mlo - 1;
        unsigned ks = (unsigned)__builtin_amdgcn_readlane((int)klo, src);
        rlo += (ks > klo) ? 1 : 0;
        rhi += (ks > khi) ? 1 : 0;
      }
      while (mhi) {
        int src = __ffsll((long long)mhi) - 1;
        mhi &= mhi - 1;
        unsigned ks = (unsigned)__builtin_amdgcn_readlane((int)khi, src);
        rlo += (ks > klo) ? 1 : 0;
        rhi += (ks > khi) ? 1 : 0;
      }
      if (slo) { sv[list * 16 + rlo] = vlo; si[list * 16 + rlo] = lane; }
      if (shi) { sv[list * 16 + rhi] = vhi; si[list * 16 + rhi] = lane + 64; }
    }
    __syncthreads();
#pragma unroll 1
    for (int tt = 0; tt < 8; ++tt) {
      int tok = w * 8 + tt;
      float sc_ = sv[tok * 16 + ci] + sv[(32 + tok) * 16 + cj];
      unsigned key = cvalid ? ((ordkey(sc_) & 0xFFFFFFC0u) | (unsigned)(63 - lane)) : 0u;
      unsigned T = 0;
#pragma unroll 4
      for (int bit = 31; bit >= 0; --bit) {
        unsigned cand = T | (1u << bit);
        int cnt = __popcll(__ballot(key >= cand));
        if (cnt >= 16) T = cand;
        if (cnt == 16) break;
      }
      bool sel = cvalid && key >= T;
      unsigned long long msel = __ballot(sel);
      const int rank = (int)__builtin_amdgcn_mbcnt_hi((unsigned)(msel >> 32), __builtin_amdgcn_mbcnt_lo((unsigned)msel, 0u));
      const float mx = __int_as_float(__builtin_amdgcn_readlane(__float_as_int(sc_), 0));
      unsigned long long mm;
      float ex = sel ? __expf(sc_ - mx) : 0.f;
      int iex = __float_as_int(ex);
      float sum = 0.f;
      mm = msel;
      while (mm) {
        int src = __ffsll((long long)mm) - 1;
        mm &= mm - 1;
        sum += __int_as_float(__builtin_amdgcn_readlane(iex, src));
      }
      if (sel) {
        size_t o = (size_t)(tok0 + tok) * 128 + h * 16 + rank;
        gateo[o] = ex / sum;
        idxo[o] = si[tok * 16 + ci] * 128 + si[(32 + tok) * 16 + cj];
      }
    }
  }
  __syncthreads();
}

DEV float gelu_exact(float v) { return 0.5f * v * (1.f + erff(v * 0.70710678118654752f)); }

__device__ __forceinline__ void convert_fp8_rows(const float* src, unsigned char* dst, float* rscale, int nrows) {
  const int tid_ = otid();
  int lane = tid_ & 63;
  int wave = blockIdx.x * 4 + (tid_ >> 6), nw = gridDim.x * 4;
  for (int row = wave; row < nrows; row += nw) {
    const float* r = src + (size_t)row * 1024 + lane * 16;
    float4 a0 = *reinterpret_cast<const float4*>(r), a1 = *reinterpret_cast<const float4*>(r + 4);
    float4 a2 = *reinterpret_cast<const float4*>(r + 8), a3 = *reinterpret_cast<const float4*>(r + 12);
    float m = fmaxf(fmaxf(fmaxf(fabsf(a0.x), fabsf(a0.y)), fmaxf(fabsf(a0.z), fabsf(a0.w))), fmaxf(fmaxf(fabsf(a1.x), fabsf(a1.y)), fmaxf(fabsf(a1.z), fabsf(a1.w))));
    m = fmaxf(m, fmaxf(fmaxf(fmaxf(fabsf(a2.x), fabsf(a2.y)), fmaxf(fabsf(a2.z), fabsf(a2.w))), fmaxf(fmaxf(fabsf(a3.x), fabsf(a3.y)), fmaxf(fabsf(a3.z), fabsf(a3.w)))));
#pragma unroll
    for (int o = 32; o > 0; o >>= 1) m = fmaxf(m, __shfl_xor(m, o));
    float sc = m > 0.f ? exp2f(floorf(log2f(224.f / m))) : 1.f;
    uint4 o;
    int p;
    p = __builtin_amdgcn_cvt_pk_fp8_f32(a0.x * sc, a0.y * sc, 0, false); p = __builtin_amdgcn_cvt_pk_fp8_f32(a0.z * sc, a0.w * sc, p, true); o.x = (unsigned)p;
    p = __builtin_amdgcn_cvt_pk_fp8_f32(a1.x * sc, a1.y * sc, 0, false); p = __builtin_amdgcn_cvt_pk_fp8_f32(a1.z * sc, a1.w * sc, p, true); o.y = (unsigned)p;
    p = __builtin_amdgcn_cvt_pk_fp8_f32(a2.x * sc, a2.y * sc, 0, false); p = __builtin_amdgcn_cvt_pk_fp8_f32(a2.z * sc, a2.w * sc, p, true); o.z = (unsigned)p;
    p = __builtin_amdgcn_cvt_pk_fp8_f32(a3.x * sc, a3.y * sc, 0, false); p = __builtin_amdgcn_cvt_pk_fp8_f32(a3.z * sc, a3.w * sc, p, true); o.w = (unsigned)p;
    *reinterpret_cast<uint4*>(dst + (size_t)row * 1024 + lane * 16) = o;
    if (lane == 0) rscale[row] = 1.f / sc;
  }
}

#define F8X(dst, WW) { dst[0] = __builtin_amdgcn_cvt_pk_f32_fp8((int)(WW).x, false); dst[1] = __builtin_amdgcn_cvt_pk_f32_fp8((int)(WW).x, true); \
                      dst[2] = __builtin_amdgcn_cvt_pk_f32_fp8((int)(WW).y, false); dst[3] = __builtin_amdgcn_cvt_pk_f32_fp8((int)(WW).y, true); \
                      dst[4] = __builtin_amdgcn_cvt_pk_f32_fp8((int)(WW).z, false); dst[5] = __builtin_amdgcn_cvt_pk_f32_fp8((int)(WW).z, true); \
                      dst[6] = __builtin_amdgcn_cvt_pk_f32_fp8((int)(WW).w, false); dst[7] = __builtin_amdgcn_cvt_pk_f32_fp8((int)(WW).w, true); }

__device__ __forceinline__ void phase_peer_gather(const u16* tin, const int* idx, const float* gate, const unsigned char* utab, const unsigned char* vtab,
                                  const float* urs, const float* vrs, const float* xres,
                                  const float* g2  , const float* lng, const float* lnb, float* xout,
                                  const float* modnext  , u16* hxout) {
  const int tid_ = otid();
  int lane = tid_ & 63;
  int wave = blockIdx.x * 4 + (tid_ >> 6), nw = gridDim.x * 4;
  for (int tok = wave; tok < NT; tok += nw) {
    int b = tok >> 12;
    f32x2 t2[8];
    {
      uint4 ta = *reinterpret_cast<const uint4*>(tin + (size_t)tok * 1024 + lane * 16);
      uint4 tb = *reinterpret_cast<const uint4*>(tin + (size_t)tok * 1024 + lane * 16 + 8);
      t2[0] = f32x2{bflo(ta.x), bfhi(ta.x)}; t2[1] = f32x2{bflo(ta.y), bfhi(ta.y)}; t2[2] = f32x2{bflo(ta.z), bfhi(ta.z)}; t2[3] = f32x2{bflo(ta.w), bfhi(ta.w)};
      t2[4] = f32x2{bflo(tb.x), bfhi(tb.x)}; t2[5] = f32x2{bflo(tb.y), bfhi(tb.y)}; t2[6] = f32x2{bflo(tb.z), bfhi(tb.z)}; t2[7] = f32x2{bflo(tb.w), bfhi(tb.w)};
    }
    int id0 = idx[(size_t)tok * 128 + lane] & 16383, id1 = idx[(size_t)tok * 128 + 64 + lane] & 16383;
    int gt0 = __float_as_int(gate[(size_t)tok * 128 + lane]), gt1 = __float_as_int(gate[(size_t)tok * 128 + 64 + lane]);
    f32x2 acc2[8];
#pragma unroll
    for (int k = 0; k < 8; ++k) acc2[k] = f32x2{0.f, 0.f};
#pragma unroll 1
    for (int j = 0; j < 128; j += 4) {
      int e[4];
      float g[4];
      if (j < 64) {
#pragma unroll
        for (int q = 0; q < 4; ++q) { e[q] = __builtin_amdgcn_readlane(id0, j + q); g[q] = __int_as_float(__builtin_amdgcn_readlane(gt0, j + q)); }
      } else {
#pragma unroll
        for (int q = 0; q < 4; ++q) { e[q] = __builtin_amdgcn_readlane(id1, j - 64 + q); g[q] = __int_as_float(__builtin_amdgcn_readlane(gt1, j - 64 + q)); }
      }
      uint4 U[4], V[4];
      float su[4], sv_[4];
#pragma unroll
      for (int q = 0; q < 4; ++q) {
        U[q] = *reinterpret_cast<const uint4*>(utab + (size_t)e[q] * 1024 + lane * 16);
        V[q] = *reinterpret_cast<const uint4*>(vtab + (size_t)e[q] * 1024 + lane * 16);
        su[q] = urs[e[q]];
        sv_[q] = vrs[e[q]];
      }
      float d[4];
#pragma unroll
      for (int q = 0; q < 4; ++q) {
        f32x2 u2[8];
        F8X(u2, U[q])
        f32x2 dd = u2[0] * t2[0];
#pragma unroll
        for (int k = 1; k < 8; ++k) dd = u2[k] * t2[k] + dd;
        d[q] = dd.x + dd.y;
      }
#pragma unroll
      for (int o = 32; o > 0; o >>= 1) {
#pragma unroll
        for (int q = 0; q < 4; ++q) d[q] += __shfl_xor(d[q], o);
      }
#pragma unroll
      for (int q = 0; q < 4; ++q) {
        float a = g[q] * gelu_exact(d[q] * su[q]) * sv_[q];
        f32x2 aa = f32x2{a, a};
        f32x2 v2[8];
        F8X(v2, V[q])
#pragma unroll
        for (int k = 0; k < 8; ++k) acc2[k] = aa * v2[k] + acc2[k];
      }
    }
    float vv[16];
    float s = 0.f;
    const int c0 = lane * 16;
#pragma unroll
    for (int k4 = 0; k4 < 4; ++k4) {
      float4 x0 = *reinterpret_cast<const float4*>(xres + (size_t)tok * 1024 + c0 + k4 * 4);
      float4 g0 = *reinterpret_cast<const float4*>(g2 + (size_t)b * 6144 + c0 + k4 * 4);
      vv[k4 * 4 + 0] = ALPHA * x0.x + g0.x * acc2[k4 * 2].x; vv[k4 * 4 + 1] = ALPHA * x0.y + g0.y * acc2[k4 * 2].y;
      vv[k4 * 4 + 2] = ALPHA * x0.z + g0.z * acc2[k4 * 2 + 1].x; vv[k4 * 4 + 3] = ALPHA * x0.w + g0.w * acc2[k4 * 2 + 1].y;
    }
#pragma unroll
    for (int k = 0; k < 16; ++k) s += vv[k];
    float mu = wave_sum(s) * (1.f / 1024.f);
    float qq = 0.f;
#pragma unroll
    for (int k = 0; k < 16; ++k) { vv[k] -= mu; qq += vv[k] * vv[k]; }
    float rs = rsqrtf(wave_sum(qq) * (1.f / 1024.f) + 1e-5f);
    float oo[16];
#pragma unroll
    for (int k4 = 0; k4 < 4; ++k4) {
      float4 ga = *reinterpret_cast<const float4*>(lng + c0 + k4 * 4), ba = *reinterpret_cast<const float4*>(lnb + c0 + k4 * 4);
      float4 o0;
      o0.x = vv[k4 * 4 + 0] * rs * ga.x + ba.x; o0.y = vv[k4 * 4 + 1] * rs * ga.y + ba.y; o0.z = vv[k4 * 4 + 2] * rs * ga.z + ba.z; o0.w = vv[k4 * 4 + 3] * rs * ga.w + ba.w;
      *reinterpret_cast<float4*>(xout + (size_t)tok * 1024 + c0 + k4 * 4) = o0;
      oo[k4 * 4 + 0] = o0.x; oo[k4 * 4 + 1] = o0.y; oo[k4 * 4 + 2] = o0.z; oo[k4 * 4 + 3] = o0.w;
    }
    if (modnext) {
      const float* m = modnext + (size_t)b * 6144;
      unsigned pk[8];
#pragma unroll
      for (int k4 = 0; k4 < 4; ++k4) {
        float4 sh0 = *reinterpret_cast<const float4*>(m + c0 + k4 * 4), sc0 = *reinterpret_cast<const float4*>(m + 1024 + c0 + k4 * 4);
        pk[k4 * 2] = pack2(oo[k4 * 4 + 0] * (1.f + sc0.x) + sh0.x, oo[k4 * 4 + 1] * (1.f + sc0.y) + sh0.y);
        pk[k4 * 2 + 1] = pack2(oo[k4 * 4 + 2] * (1.f + sc0.z) + sh0.z, oo[k4 * 4 + 3] * (1.f + sc0.w) + sh0.w);
      }
      *reinterpret_cast<uint4*>(hxout + (size_t)tok * 1024 + c0) = make_uint4(pk[0], pk[1], pk[2], pk[3]);
      *reinterpret_cast<uint4*>(hxout + (size_t)tok * 1024 + c0 + 8) = make_uint4(pk[4], pk[5], pk[6], pk[7]);
    }
  }
}

__device__ __forceinline__ void phase_shortconv_T(const Params& p, const u16* upre, u16* x1cm, u16* x2cm, u16* vcm, char* lds) {
  constexpr int TLD = 264;
  u16* tile = (u16*)lds;
  int tid = otid();
  const int tg = tid >> 3, cg_ = tid & 7;
  for (int item = blockIdx.x; item < 128 * 48; item += gridDim.x) {
    int tt = item / 48, ct = item % 48;
    int tok0 = tt * 256, c0 = ct * 64;
    int ch = c0 + cg_ * 8;
    float w[3][8], bias[8];
#pragma unroll
    for (int j = 0; j < 3; ++j) {
      float4 w0 = *reinterpret_cast<const float4*>(p.h_conv_w + j * 3072 + ch), w1 = *reinterpret_cast<const float4*>(p.h_conv_w + j * 3072 + ch + 4);
      w[j][0] = w0.x; w[j][1] = w0.y; w[j][2] = w0.z; w[j][3] = w0.w; w[j][4] = w1.x; w[j][5] = w1.y; w[j][6] = w1.z; w[j][7] = w1.w;
    }
    {
      float4 b0 = *reinterpret_cast<const float4*>(p.h_conv_b + ch), b1 = *reinterpret_cast<const float4*>(p.h_conv_b + ch + 4);
      bias[0] = b0.x; bias[1] = b0.y; bias[2] = b0.z; bias[3] = b0.w; bias[4] = b1.x; bias[5] = b1.y; bias[6] = b1.z; bias[7] = b1.w;
    }
    const int t0 = tok0 + tg * 8;
    const int l0 = t0 & 4095;
    const u32x4 zero4 = u32x4{0u, 0u, 0u, 0u};
    u32x4 rows[10];
#pragma unroll
    for (int i = 0; i < 10; ++i) {
      int ll = l0 + i - 1;
      rows[i] = (ll >= 0 && ll <= 4095) ? *reinterpret_cast<const u32x4*>(upre + (size_t)(t0 + i - 1) * 3072 + ch) : zero4;
    }
    float o[8][8];
#pragma unroll
    for (int i = 0; i < 8; ++i) {
#pragma unroll
      for (int k = 0; k < 8; ++k) o[i][k] = bias[k];
      fma8(o[i], rows[i], w[0]);
      fma8(o[i], rows[i + 1], w[1]);
      fma8(o[i], rows[i + 2], w[2]);
    }
#pragma unroll
    for (int k = 0; k < 8; ++k) {
      uint4 pk;
      pk.x = pack2(o[0][k], o[1][k]); pk.y = pack2(o[2][k], o[3][k]); pk.z = pack2(o[4][k], o[5][k]); pk.w = pack2(o[6][k], o[7][k]);
      *reinterpret_cast<uint4*>(tile + (cg_ * 8 + k) * TLD + tg * 8) = pk;
    }
    __syncthreads();
    int part = c0 >> 10, d0 = c0 & 1023;
    u16* dst = part == 0 ? x1cm : (part == 1 ? x2cm : vcm);
    int b = tok0 >> 12, lt0 = tok0 & 4095;
#pragma unroll
    for (int i = 0; i < 8; ++i) {
      int q = tid + i * 256, c = q >> 5, chunk = q & 31;
      uint4 v = *reinterpret_cast<const uint4*>(tile + c * TLD + chunk * 8);
      *reinterpret_cast<uint4*>(dst + ((size_t)(b * 1024 + d0 + c)) * 4096 + lt0 + chunk * 8) = v;
    }
    __syncthreads();
  }
}

DEV float2 cmul(float2 a, float2 w) { return make_float2(a.x * w.x - a.y * w.y, a.x * w.y + a.y * w.x); }
DEV float2 cmulc(float2 a, float2 w) { return make_float2(a.x * w.x + a.y * w.y, a.y * w.x - a.x * w.y); }
template <bool LAST = true>
__device__ __forceinline__ void fft_fwd(float2* X, const float2* __restrict__ tw) {
  int tid = otid();
  for (int s = 12; s >= 2; s -= 2) {
    const int h = 1 << s, q = h >> 1;
#pragma unroll 2
    for (int i = 0; i < 8; ++i) {
      int gi = tid + i * 256;
      int pos = gi & (q - 1);
      int base = ((gi >> (s - 1)) << (s + 1)) + pos;
      float2 w1 = tw[pos << (12 - s)];
      float2 w2 = tw[pos << (13 - s)];
      float2 a = X[base], bb = X[base + q], c = X[base + h], d = X[base + h + q];
      float2 a1 = make_float2(a.x + c.x, a.y + c.y);
      float2 c1 = cmul(make_float2(a.x - c.x, a.y - c.y), w1);
      float2 b1 = make_float2(bb.x + d.x, bb.y + d.y);
      float2 t = cmul(make_float2(bb.x - d.x, bb.y - d.y), w1);
      float2 d1 = make_float2(t.y, -t.x);
      X[base] = make_float2(a1.x + b1.x, a1.y + b1.y);
      X[base + q] = cmul(make_float2(a1.x - b1.x, a1.y - b1.y), w2);
      X[base + h] = make_float2(c1.x + d1.x, c1.y + d1.y);
      X[base + h + q] = cmul(make_float2(c1.x - d1.x, c1.y - d1.y), w2);
    }
    __syncthreads();
  }
  if (LAST) {
#pragma unroll 4
    for (int i = 0; i < 16; ++i) {
      int j = tid + i * 256;
      float2 a = X[2 * j], bq = X[2 * j + 1];
      X[2 * j] = make_float2(a.x + bq.x, a.y + bq.y);
      X[2 * j + 1] = make_float2(a.x - bq.x, a.y - bq.y);
    }
    __syncthreads();
  }
}
__device__ __forceinline__ void fft_mid_mul(float2* X, const float2* __restrict__ H) {
  int tid = otid();
#pragma unroll 4
  for (int i = 0; i < 16; ++i) {
    int j = tid + i * 256;
    float2 a = X[2 * j], bq = X[2 * j + 1];
    float4 hh = *reinterpret_cast<const float4*>(H + 2 * j);
    float2 f0 = make_float2(a.x + bq.x, a.y + bq.y), f1 = make_float2(a.x - bq.x, a.y - bq.y);
    float2 g0 = make_float2(f0.x * hh.x - f0.y * hh.y, f0.x * hh.y + f0.y * hh.x);
    float2 g1 = make_float2(f1.x * hh.z - f1.y * hh.w, f1.x * hh.w + f1.y * hh.z);
    X[2 * j] = make_float2(g0.x + g1.x, g0.y + g1.y);
    X[2 * j + 1] = make_float2(g0.x - g1.x, g0.y - g1.y);
  }
  __syncthreads();
}
template <bool FIRST = true>
__device__ __forceinline__ void fft_inv(float2* X, const float2* __restrict__ tw) {
  int tid = otid();
  if (FIRST) {
#pragma unroll 4
    for (int i = 0; i < 16; ++i) {
      int j = tid + i * 256;
      float2 a = X[2 * j], bq = X[2 * j + 1];
      X[2 * j] = make_float2(a.x + bq.x, a.y + bq.y);
      X[2 * j + 1] = make_float2(a.x - bq.x, a.y - bq.y);
    }
    __syncthreads();
  }
  for (int s = 2; s <= 12; s += 2) {
    const int h = 1 << s, q = h >> 1;
#pragma unroll 2
    for (int i = 0; i < 8; ++i) {
      int gi = tid + i * 256;
      int pos = gi & (q - 1);
      int base = ((gi >> (s - 1)) << (s + 1)) + pos;
      float2 w1 = tw[pos << (12 - s)];
      float2 w2 = tw[pos << (13 - s)];
      float2 a = X[base], bb = X[base + q], c = X[base + h], d = X[base + h + q];
      float2 tb = cmulc(bb, w2), td = cmulc(d, w2);
      float2 a1 = make_float2(a.x + tb.x, a.y + tb.y), b1 = make_float2(a.x - tb.x, a.y - tb.y);
      float2 c1 = make_float2(c.x + td.x, c.y + td.y), d1 = make_float2(c.x - td.x, c.y - td.y);
      float2 tc = cmulc(c1, w1);
      float2 u = cmulc(d1, w1);
      float2 tdd = make_float2(-u.y, u.x);
      X[base] = make_float2(a1.x + tc.x, a1.y + tc.y);
      X[base + h] = make_float2(a1.x - tc.x, a1.y - tc.y);
      X[base + q] = make_float2(b1.x + tdd.x, b1.y + tdd.y);
      X[base + h + q] = make_float2(b1.x - tdd.x, b1.y - tdd.y);
    }
    __syncthreads();
  }
}

__device__ __forceinline__ void phase_filter_fft(const Params& p, float2* Hf, char* lds) {
  float2* X = (float2*)lds;
  float* w3s = (float*)(lds + 65536);
  float* red = w3s + 128;
  const float* hid = (const float*)(p.ws + OFF_HID);
  int tid = otid();
  const float min_decay = -3.0701134573253945f;
  const float max_decay = -15.350567286626973f;
  for (int item = blockIdx.x; item < 2048; item += gridDim.x) {
    int o = item >> 10, d = item & 1023;
    if (tid < 128) {
      int dirr = tid >> 6, j = tid & 63;
      w3s[tid] = p.h_f_w3[(size_t)j * 4096 + (o * 2 + dirr) * 1024 + d];
    }
    __syncthreads();
    float adelta = fabsf(min_decay + (float)d * ((max_decay - min_decay) / 1023.f));
    float ss = 0.f;
#pragma unroll 1
    for (int i = 0; i < 16; ++i) {
      int t = tid + i * 256;
      const float* hr = hid + (size_t)t * 64;
      float hf = 0.f, hb = 0.f;
#pragma unroll
      for (int j4 = 0; j4 < 16; ++j4) {
        float4 hv = *reinterpret_cast<const float4*>(hr + j4 * 4);
        hf += hv.x * w3s[j4 * 4] + hv.y * w3s[j4 * 4 + 1] + hv.z * w3s[j4 * 4 + 2] + hv.w * w3s[j4 * 4 + 3];
        hb += hv.x * w3s[64 + j4 * 4] + hv.y * w3s[64 + j4 * 4 + 1] + hv.z * w3s[64 + j4 * 4 + 2] + hv.w * w3s[64 + j4 * 4 + 3];
      }
      float dec = __expf(-((float)t / 4095.f) * adelta);
      hf *= dec; hb *= dec;
      if (t == 0) {
        float v = hf + hb;
        X[0] = make_float2(v, 0.f);
        X[4096] = make_float2(0.f, 0.f);
        ss += v * v;
      } else {
        X[t] = make_float2(hf, 0.f);
        X[8192 - t] = make_float2(hb, 0.f);
        ss += hf * hf + hb * hb;
      }
    }
    ss = wave_sum(ss);
    if ((tid & 63) == 0) red[tid >> 6] = ss;
    __syncthreads();
    float tot = red[0] + red[1] + red[2] + red[3];
    float scale = rsqrtf(tot + 1e-6f) * (1.f / 8192.f);
    fft_fwd(X, (const float2*)(p.ws + OFF_TW));
    float2* dst = Hf + (size_t)item * 8192;
#pragma unroll 4
    for (int i = 0; i < 32; ++i) {
      int k = tid + i * 256;
      float2 v = X[k];
      dst[k] = make_float2(v.x * scale, v.y * scale);
    }
    __syncthreads();
  }
}

__device__ __forceinline__ void phase_hyena_conv(const Params& p, const u16* x1cm, const u16* x2cm, const u16* vcm, const float2* Hf, u16* zzcm, char* lds) {
  float2* X = (float2*)lds;
  int tid = otid();
  for (int item = blockIdx.x; item < 4096; item += gridDim.x) {
    int d = item >> 2, bp = item & 3;
    size_t r0 = ((size_t)((bp * 2) * 1024 + d)) * 4096, r1 = ((size_t)((bp * 2 + 1) * 1024 + d)) * 4096;
    float bias0 = p.h_bias[d], bias1 = p.h_bias[1024 + d];
#pragma unroll
    for (int i = 0; i < 2; ++i) {
      int t8 = (tid + i * 256) * 8;
      uint4 a = *reinterpret_cast<const uint4*>(vcm + r0 + t8);
      uint4 bq = *reinterpret_cast<const uint4*>(vcm + r1 + t8);
      X[t8 + 0] = make_float2(bflo(a.x), bflo(bq.x)); X[t8 + 1] = make_float2(bfhi(a.x), bfhi(bq.x));
      X[t8 + 2] = make_float2(bflo(a.y), bflo(bq.y)); X[t8 + 3] = make_float2(bfhi(a.y), bfhi(bq.y));
      X[t8 + 4] = make_float2(bflo(a.z), bflo(bq.z)); X[t8 + 5] = make_float2(bfhi(a.z), bfhi(bq.z));
      X[t8 + 6] = make_float2(bflo(a.w), bflo(bq.w)); X[t8 + 7] = make_float2(bfhi(a.w), bfhi(bq.w));
    }
    for (int i = 0; i < 16; ++i) X[4096 + tid + i * 256] = make_float2(0.f, 0.f);
    __syncthreads();
    fft_fwd<false>(X, (const float2*)(p.ws + OFF_TW));
    fft_mid_mul(X, Hf + (size_t)d * 8192);
    fft_inv<false>(X, (const float2*)(p.ws + OFF_TW));
    float zz0[16], zz1[16];
#pragma unroll
    for (int i = 0; i < 2; ++i) {
      int t8 = (tid + i * 256) * 8;
      uint4 a = *reinterpret_cast<const uint4*>(vcm + r0 + t8);
      uint4 bq = *reinterpret_cast<const uint4*>(vcm + r1 + t8);
      uint4 xa = *reinterpret_cast<const uint4*>(x1cm + r0 + t8);
      uint4 xb = *reinterpret_cast<const uint4*>(x1cm + r1 + t8);
      float va[8] = {bflo(a.x), bfhi(a.x), bflo(a.y), bfhi(a.y), bflo(a.z), bfhi(a.z), bflo(a.w), bfhi(a.w)};
      float vb[8] = {bflo(bq.x), bfhi(bq.x), bflo(bq.y), bfhi(bq.y), bflo(bq.z), bfhi(bq.z), bflo(bq.w), bfhi(bq.w)};
      float fa[8] = {bflo(xa.x), bfhi(xa.x), bflo(xa.y), bfhi(xa.y), bflo(xa.z), bfhi(xa.z), bflo(xa.w), bfhi(xa.w)};
      float fb[8] = {bflo(xb.x), bfhi(xb.x), bflo(xb.y), bfhi(xb.y), bflo(xb.z), bfhi(xb.z), bflo(xb.w), bfhi(xb.w)};
#pragma unroll
      for (int e = 0; e < 8; ++e) {
        float2 cv = X[t8 + e];
        float z0 = fa[e] * (cv.x + va[e] * bias0);
        float z1 = fb[e] * (cv.y + vb[e] * bias0);
        zz0[i * 8 + e] = z0; zz1[i * 8 + e] = z1;
        X[t8 + e] = make_float2(z0, z1);
      }
    }
    for (int i = 0; i < 16; ++i) X[4096 + tid + i * 256] = make_float2(0.f, 0.f);
    __syncthreads();
    fft_fwd<false>(X, (const float2*)(p.ws + OFF_TW));
    fft_mid_mul(X, Hf + (size_t)(1024 + d) * 8192);
    fft_inv<false>(X, (const float2*)(p.ws + OFF_TW));
#pragma unroll
    for (int i = 0; i < 2; ++i) {
      int t8 = (tid + i * 256) * 8;
      uint4 xa = *reinterpret_cast<const uint4*>(x2cm + r0 + t8);
      uint4 xb = *reinterpret_cast<const uint4*>(x2cm + r1 + t8);
      float fa[8] = {bflo(xa.x), bfhi(xa.x), bflo(xa.y), bfhi(xa.y), bflo(xa.z), bfhi(xa.z), bflo(xa.w), bfhi(xa.w)};
      float fb[8] = {bflo(xb.x), bfhi(xb.x), bflo(xb.y), bfhi(xb.y), bflo(xb.z), bfhi(xb.z), bflo(xb.w), bfhi(xb.w)};
      float o0[8], o1[8];
#pragma unroll
      for (int e = 0; e < 8; ++e) {
        float2 cv = X[t8 + e];
        o0[e] = fa[e] * (cv.x + zz0[i * 8 + e] * bias1);
        o1[e] = fb[e] * (cv.y + zz1[i * 8 + e] * bias1);
      }
      uint4 w0, w1;
      w0.x = pack2(o0[0], o0[1]); w0.y = pack2(o0[2], o0[3]); w0.z = pack2(o0[4], o0[5]); w0.w = pack2(o0[6], o0[7]);
      w1.x = pack2(o1[0], o1[1]); w1.y = pack2(o1[2], o1[3]); w1.z = pack2(o1[4], o1[5]); w1.w = pack2(o1[6], o1[7]);
      *reinterpret_cast<uint4*>(zzcm + r0 + t8) = w0;
      *reinterpret_cast<uint4*>(zzcm + r1 + t8) = w1;
    }
    __syncthreads();
  }
}

__device__ __forceinline__ void phase_transpose_back(const u16* src, u16* dst, char* lds) {
  u16* tile = (u16*)lds;
  int tid = otid();
  for (int item = blockIdx.x; item < 8 * 16 * 64; item += gridDim.x) {
    int b = item >> 10, dt_ = (item >> 6) & 15, tt = item & 63;
#pragma unroll
    for (int i = 0; i < 2; ++i) {
      int q = tid + i * 256, dd = q >> 3, tg = (q & 7) * 8;
      uint4 v = *reinterpret_cast<const uint4*>(src + ((size_t)(b * 1024 + dt_ * 64 + dd)) * 4096 + tt * 64 + tg);
      tile[(tg + 0) * 72 + dd] = (u16)(v.x & 0xffff); tile[(tg + 1) * 72 + dd] = (u16)(v.x >> 16);
      tile[(tg + 2) * 72 + dd] = (u16)(v.y & 0xffff); tile[(tg + 3) * 72 + dd] = (u16)(v.y >> 16);
      tile[(tg + 4) * 72 + dd] = (u16)(v.z & 0xffff); tile[(tg + 5) * 72 + dd] = (u16)(v.z >> 16);
      tile[(tg + 6) * 72 + dd] = (u16)(v.w & 0xffff); tile[(tg + 7) * 72 + dd] = (u16)(v.w >> 16);
    }
    __syncthreads();
#pragma unroll
    for (int i = 0; i < 2; ++i) {
      int q = tid + i * 256, tl = q >> 3, dg = (q & 7) * 8;
      uint4 v = *reinterpret_cast<const uint4*>(tile + tl * 72 + dg);
      *reinterpret_cast<uint4*>(dst + ((size_t)(b * 4096 + tt * 64 + tl)) * 1024 + dt_ * 64 + dg) = v;
    }
    __syncthreads();
  }
}

__device__ __forceinline__ uint4* xb_words_ptr() { __shared__ uint4 xb_words; return &xb_words; }
#define XB_TMO      128
#define XB_XCNT(j)  (256  + 64 * (j))
#define XB_XSUB(j)  (1280 + 64 * (j))
#define XB_XGEN(j)  (2304 + 64 * (j))
#define XB_TOP      3328
#define XB_TOPGEN   3392
#define XCD_BAR_WORDS 3456
#define XB_SPIN_CAP (1u << 18)
#define LAS __attribute__((address_space(3)))

__device__ __forceinline__ unsigned xb_ld(unsigned* p)              { return __hip_atomic_load(p, __ATOMIC_RELAXED, __HIP_MEMORY_SCOPE_AGENT); }
__device__ __forceinline__ unsigned xb_add(unsigned* p, unsigned v) { return __hip_atomic_fetch_add(p, v, __ATOMIC_RELAXED, __HIP_MEMORY_SCOPE_AGENT); }
__device__ __forceinline__ unsigned xb_xcc_id() { return (unsigned)__builtin_amdgcn_s_getreg((3 << 11) | 20) & 0xFu; }
#define XB_SPIN(cond, bar) do { unsigned _sp = 0; while (cond) { __builtin_amdgcn_s_sleep(1); \
    if ((++_sp & 255u) == 0u) { if (xb_ld(&(bar)[XB_TMO])) break; if (_sp > XB_SPIN_CAP) { atomicAdd(&(bar)[XB_TMO], 1u); break; } } } } while (0)

struct XcdBarrier {
    unsigned* bar; unsigned x;
    volatile LAS unsigned* st;
};

__device__ __forceinline__ XcdBarrier xcd_barrier_post(unsigned* bar, volatile LAS unsigned* st) {
    XcdBarrier b; b.bar = bar; b.x = xb_xcc_id(); b.st = st;
    if (threadIdx.x == 0) (void)xb_add(&bar[XB_XCNT(b.x)], 1u);
    return b;
}
__device__ __forceinline__ void xcd_barrier_complete(unsigned* bar, unsigned x, unsigned& nloc, unsigned& nx) {
    const unsigned G = gridDim.x * gridDim.y * gridDim.z;
    unsigned sum, cnt, mine, sp = 0u;
    for (;;) {
        sum = 0u; cnt = 0u; mine = 0u;
#pragma unroll
        for (unsigned j = 0; j < 16; ++j) { const unsigned c = xb_ld(&bar[XB_XCNT(j)]); sum += c; cnt += (c > 0u) ? 1u : 0u; mine = (j == x) ? c : mine; }
        if (sum == G) break;
        __builtin_amdgcn_s_sleep(1);
        if ((++sp & 255u) == 0u) { if (xb_ld(&bar[XB_TMO])) break; if (sp > XB_SPIN_CAP) { atomicAdd(&bar[XB_TMO], 1u); break; } }
    }
    nloc = mine > 0u ? mine : 1u; nx = cnt > 0u ? cnt : 1u;
}

__device__ __forceinline__ void xcd_barrier(const XcdBarrier& b) {
    asm volatile("s_waitcnt vmcnt(0)" ::: "memory");
    __syncthreads();
    if (threadIdx.x == 0) {
        unsigned* bar = b.bar;
        __builtin_amdgcn_s_waitcnt(0);
        unsigned nloc = b.st[0], nx = b.st[1];
        if (nloc == 0u) { xcd_barrier_complete(bar, b.x, nloc, nx); b.st[0] = nloc; b.st[1] = nx; }
        const unsigned old = xb_add(&bar[XB_XSUB(b.x)], 1u);
        const unsigned gen = old / nloc;
        if (old + 1u == (gen + 1u) * nloc) {
            __builtin_amdgcn_fence(__ATOMIC_RELEASE, "agent");
            asm volatile("s_waitcnt vmcnt(0)" ::: "memory");
            const unsigned og = xb_add(&bar[XB_TOP], 1u);
            const unsigned tg = og / nx;
            if (og + 1u == (tg + 1u) * nx) xb_add(&bar[XB_TOPGEN], 1u);
            else XB_SPIN(xb_ld(&bar[XB_TOPGEN]) == tg, bar);
            __builtin_amdgcn_fence(__ATOMIC_ACQUIRE, "agent");
            xb_add(&bar[XB_XGEN(b.x)], 1u);
            asm volatile("s_waitcnt vmcnt(0)" ::: "memory");
        } else {
            XB_SPIN(xb_ld(&bar[XB_XGEN(b.x)]) == gen, bar);
            __builtin_amdgcn_fence(__ATOMIC_ACQUIRE, "agent");
            asm volatile("s_waitcnt vmcnt(0)" ::: "memory");
        }
    }
    __syncthreads();
}


DEV void gsync2(unsigned k) {
  (void)k;
  XcdBarrier b;
  b.bar = (unsigned*)((char*)karg<33>() + OFF_BAR);
  b.x = xb_xcc_id();
  b.st = (volatile LAS unsigned*)xb_words_ptr();
  xcd_barrier(b);
}

DEV void gsync(cg::grid_group& grid) {
  asm volatile("s_waitcnt vmcnt(0)" ::: "memory");
  grid.sync();
  if (threadIdx.x == 0) {
    __builtin_amdgcn_fence(__ATOMIC_ACQUIRE, "agent");
    asm volatile("s_waitcnt vmcnt(0)" ::: "memory");
  }
  __syncthreads();
}

template <int layer>
__device__ __forceinline__ void peer_block(unsigned& nbar, char* lds) {
  {
    Params p = fetch_params();
    char* ws = p.ws; char* R1 = ws + OFF_R1; char* R2 = ws + OFF_R2; char* DO = (char*)p.out;
    const float* modl = (float*)(ws + OFF_MOD) + (size_t)layer * 9 * 6144;
    const u16* A = layer == 0 ? (const u16*)R1 : (const u16*)DO;
    const int K = layer == 0 ? 2048 : 1024;
    const u16* Wt = (const u16*)(ws + (layer == 0 ? OFF_W_OUT : OFF_W_HOUT));
    const float* res = layer == 0 ? p.x : (const float*)R2;
    phase_gemm_resid(A, K, Wt, res, (float*)R2, modl + 2048, lds);
  }
  gsync2(++nbar);
  {
    Params p = fetch_params();
    char* ws = p.ws; char* R1 = ws + OFF_R1; char* R2 = ws + OFF_R2; char* DO = (char*)p.out;
    const float* modl = (float*)(ws + OFF_MOD) + (size_t)layer * 9 * 6144;
    u16* tpeer = layer == 0 ? (u16*)DO : (u16*)(R1 + 128 * MiB);
    phase_ln_mod((float*)R2, p.ln_g + layer * 2048, p.ln_b + layer * 2048, modl, tpeer);
    if (layer == 1) {
      unsigned char* tb = (unsigned char*)R1;
      convert_fp8_rows(p.p_u + (size_t)16384 * 1024, tb, (float*)(tb + 32 * MiB), 16384);
      convert_fp8_rows(p.p_v + (size_t)16384 * 1024, tb + 16 * MiB, (float*)(tb + 32 * MiB + 65536), 16384);
    }
  }
  gsync2(++nbar);
  {
    Params p = fetch_params();
    char* ws = p.ws; char* R1 = ws + OFF_R1; char* DO = (char*)p.out;
    u16* tpeer = layer == 0 ? (u16*)DO : (u16*)(R1 + 128 * MiB);
    phase_gemm_bf16(tpeer, (const u16*)(ws + OFF_W_Q) + (size_t)layer * 2048 * 1024, layer == 0 ? (u16*)R1 : (u16*)DO, 2048, lds);
  }
  gsync2(++nbar);
  {
    Params p = fetch_params();
    char* ws = p.ws; char* R1 = ws + OFF_R1; char* R2 = ws + OFF_R2;
    int* idxb = (int*)(R2 + 128 * MiB);
    float* gateb = (float*)(R2 + 144 * MiB);
    const u16* kbf = (const u16*)(ws + OFF_KEYS);
    phase_peer_topk(layer == 0 ? (const u16*)R1 : (const u16*)p.out, kbf + (size_t)layer * 131072, kbf + 262144 + (size_t)layer * 131072, idxb, gateb, lds);
  }
  gsync2(++nbar);
  {
    Params p = fetch_params();
    char* ws = p.ws; char* R1 = ws + OFF_R1; char* R2 = ws + OFF_R2; char* DO = (char*)p.out;
    float* mod = (float*)(ws + OFF_MOD);
    const float* modl = mod + (size_t)layer * 9 * 6144;
    int* idxb = (int*)(R2 + 128 * MiB);
    float* gateb = (float*)(R2 + 144 * MiB);
    u16* tpeer = layer == 0 ? (u16*)DO : (u16*)(R1 + 128 * MiB);
    const unsigned char* tb8 = (const unsigned char*)(layer == 0 ? ws + OFF_TAB0 : R1);
    phase_peer_gather(tpeer, idxb, gateb, tb8, tb8 + 16 * MiB, (const float*)(tb8 + 32 * MiB), (const float*)(tb8 + 32 * MiB + 65536), (const float*)R2,
                      modl + 5120, p.ln_g + layer * 2048 + 1024, p.ln_b + layer * 2048 + 1024, layer == 0 ? (float*)R2 : p.out,
                      layer == 0 ? mod + 9 * 6144 : nullptr, (u16*)(DO + 64 * MiB));
  }
}

__global__ void __launch_bounds__(256, 2) fwd_megakernel(Params p_unused) {
  __shared__ __attribute__((aligned(16))) char lds[LDS_BYTES];
  cg::grid_group grid = cg::this_grid();
  unsigned nbar = 0;
  if (threadIdx.x == 0) *xb_words_ptr() = make_uint4(0u, 0u, 0u, 0u);
  __syncthreads();
  (void)xcd_barrier_post((unsigned*)((char*)karg<33>() + OFF_BAR), (volatile LAS unsigned*)xb_words_ptr());
  { Params p = fetch_params(); phase_prologue(p, lds); }
  if (p_unused.ws == nullptr) gsync(grid);
  gsync2(++nbar);
  {
    Params p = fetch_params();
    float* mod = (float*)(p.ws + OFF_MOD);
    modulate_rows(p.x, (u16*)(p.ws + OFF_R2), NT, SEQ, mod, 0, 1024, false);
    modulate_rows(p.ctx, (u16*)(p.ws + OFF_HC), NTC, CTXL, mod, 0, 1024, true);
  }
  gsync2(++nbar);
  { Params p = fetch_params(); phase_gemm_inproj(p, lds); }
  gsync2(++nbar);
  { Params p = fetch_params(); phase_conv(p); }
  gsync2(++nbar);
  { Params p = fetch_params(); phase_ssd(p, lds); }
  gsync2(++nbar);
  {
    Params p = fetch_params(); phase_gated_norm(p);
    unsigned char* tb = (unsigned char*)(p.ws + OFF_TAB0);
    convert_fp8_rows(p.p_u, tb, (float*)(tb + 32 * MiB), 16384);
    convert_fp8_rows(p.p_v, tb + 16 * MiB, (float*)(tb + 32 * MiB + 65536), 16384);
  }
  gsync2(++nbar);
  peer_block<0>(nbar, lds);
  gsync2(++nbar);
  {
    Params p = fetch_params();
    phase_gemm_bf16((const u16*)((char*)p.out + 64 * MiB), (const u16*)(p.ws + OFF_W_HIN), (u16*)(p.ws + OFF_R1), 3072, lds);
  }
  gsync2(++nbar);
  {
    Params p = fetch_params();
    phase_shortconv_T(p, (const u16*)(p.ws + OFF_R1), (u16*)(p.ws + OFF_R2 + 128 * MiB), (u16*)p.out, (u16*)((char*)p.out + 64 * MiB), lds);
  }
  gsync2(++nbar);
  { Params p = fetch_params(); phase_filter_fft(p, (float2*)(p.ws + OFF_R1), lds); }
  gsync2(++nbar);
  {
    Params p = fetch_params();
    phase_hyena_conv(p, (const u16*)(p.ws + OFF_R2 + 128 * MiB), (const u16*)p.out, (const u16*)((char*)p.out + 64 * MiB),
                     (const float2*)(p.ws + OFF_R1), (u16*)(p.ws + OFF_R1 + 128 * MiB), lds);
  }
  gsync2(++nbar);
  { Params p = fetch_params(); phase_transpose_back((const u16*)(p.ws + OFF_R1 + 128 * MiB), (u16*)p.out, lds); }
  gsync2(++nbar);
  peer_block<1>(nbar, lds);
}

extern "C" void kernel_launch(void* const* d_in, const int* in_sizes, int n_in, void* d_out, int out_size, void* d_ws, size_t ws_size,
                              hipStream_t stream) {
  static int grid_blocks = 0;
  if (!grid_blocks) {
    int dev = 0, cus = 0, per_cu = 0;
    hipGetDevice(&dev);
    hipDeviceGetAttribute(&cus, hipDeviceAttributeMultiprocessorCount, dev);
    hipOccupancyMaxActiveBlocksPerMultiprocessor(&per_cu, fwd_megakernel, 256, 0);
    if (per_cu > 2) per_cu = 2;
    if (per_cu < 1) per_cu = 1;
    grid_blocks = cus * per_cu;
  }
  Params p{};
  const float** pp = reinterpret_cast<const float**>(&p);
  for (int i = 0; i < 32; ++i) pp[i] = (const float*)d_in[i];
  p.out = (float*)d_out;
  p.ws = (char*)d_ws;
  if (ws_size < WS_TOTAL) fprintf(stderr, "workspace too small: %zu < %zu\n", ws_size, (size_t)WS_TOTAL);
  (void)hipMemsetAsync((char*)d_ws + OFF_BAR, 0, 16384, stream);
  void* args[] = {&p};
  hipError_t e = hipLaunchCooperativeKernel((void*)fwd_megakernel, dim3(grid_blocks), dim3(256), args, 0, stream);
  if (e != hipSuccess) fprintf(stderr, "cooperative launch failed: %s (grid %d)\n", hipGetErrorString(e), grid_blocks);
}
```
